# Optimizing an MI355X kernel written in HIP

```python
import jax
import jax.numpy as jnp
from jax import lax
import numpy as np

D_MODEL = 1024
BATCH = 8
SEQ = 2048
DEPTH = 2

HEAD_DIM = 64
NORM_EPS = 1e-6
NEG = -1e30
BIG = 1e30
ATTN_BLOCK = 128

SSD_HEADS = 8
SSD_D_INNER = SSD_HEADS * HEAD_DIM
SSD_STATE = 128
SSD_GROUPS = 2
SSD_CONV = 4
SSD_CHUNK = 128
SSD_CONV_DIM = SSD_D_INNER + 2 * SSD_GROUPS * SSD_STATE

NSA_HEADS = 8
NSA_KV_HEADS = 2
NSA_CMP_BLOCK = 32
NSA_CMP_STRIDE = 16
NSA_CMP_HIDDEN = 64
NSA_SEL_BLOCK = 64
NSA_TOPK = 8
NSA_WINDOW = 512
NSA_SEL_QBLOCK = 64

RWKV_HEADS = 8
RWKV_DIM = RWKV_HEADS * HEAD_DIM
RWKV_W_LORA = 64
RWKV_A_LORA = 64
RWKV_G_LORA = 128
RWKV_IN = 3 * RWKV_DIM + RWKV_W_LORA + RWKV_A_LORA + RWKV_G_LORA
RWKV_GN_EPS = 64e-5

SWA_HEADS = 8
SWA_KV_HEADS = 2
SWA_WINDOW = 128
ROPE_THETA = 150000.0

N_BRANCHES = 4
D_FF = 2816
N_EXPERTS = 8
TOP_K = 2
MOE_BLOCK = 128
N_DENSE = (DEPTH + 1) // 2
N_MOE = DEPTH // 2
PLE_DIM = 256

IN_SPLITS = (SSD_D_INNER, SSD_CONV_DIM, SSD_HEADS,
             NSA_HEADS * HEAD_DIM, 6 * NSA_KV_HEADS * HEAD_DIM, 3 * NSA_HEADS,
             RWKV_IN,
             SWA_HEADS * HEAD_DIM, 2 * SWA_KV_HEADS * HEAD_DIM,
             N_BRANCHES * D_MODEL)
D_IN = sum(IN_SPLITS)

kernel_name = "hybrid_ssd_nsa_rwkv7_swa_moe"


def rmsnorm(x, g):
    xf = x.astype(jnp.float32)
    y = xf * lax.rsqrt(jnp.mean(xf * xf, -1, keepdims=True) + NORM_EPS)
    return (y * g.astype(jnp.float32)).astype(x.dtype)


def split_cols(u, widths):
    offsets = [int(o) for o in np.cumsum(widths)[:-1]]
    return jnp.split(u, offsets, axis=-1)


def swiglu(h, w_gate, w_up, w_down):
    return (jax.nn.silu(h @ w_gate) * (h @ w_up)) @ w_down


def causal_dwconv(x, w, b):
    K, C = w.shape
    y = lax.conv_general_dilated(x, w[:, None, :].astype(x.dtype), window_strides=(1,),
                                 padding=[(K - 1, 0)], dimension_numbers=('NWC', 'WIO', 'NWC'),
                                 feature_group_count=C)
    return y + b.astype(x.dtype)


def rope(x, positions):
    half = HEAD_DIM // 2
    inv_freq = ROPE_THETA ** (-jnp.arange(half, dtype=jnp.float32) / half)
    ang = positions.astype(jnp.float32)[..., None] * inv_freq
    ang = ang.reshape(ang.shape[:2] + (1,) * (x.ndim - 3) + (half,))
    cos, sin = jnp.cos(ang), jnp.sin(ang)
    xf = x.astype(jnp.float32)
    x1, x2 = xf[..., :half], xf[..., half:]
    return jnp.concatenate([x1 * cos - x2 * sin, x2 * cos + x1 * sin], -1).astype(x.dtype)


def banded_attention(q, k, v, window, sinks=None):
    Bsz, S, G, R, dh = q.shape
    nb = S // ATTN_BLOCK
    span = window + ATTN_BLOCK
    kp = jnp.pad(k, ((0, 0), (window, 0), (0, 0), (0, 0)))
    vp = jnp.pad(v, ((0, 0), (window, 0), (0, 0), (0, 0)))
    kidx = jnp.arange(nb)[:, None] * ATTN_BLOCK + jnp.arange(span)[None, :]
    kb = kp[:, kidx]
    vb = vp[:, kidx]
    qb = q.reshape(Bsz, nb, ATTN_BLOCK, G, R, dh)
    s = jnp.einsum('bnqgrd,bnkgd->bngrqk', qb, kb).astype(jnp.float32) * (dh ** -0.5)
    qpos = jnp.arange(S).reshape(nb, ATTN_BLOCK)
    kpos = kidx - window
    rel = qpos[:, :, None] - kpos[:, None, :]
    mask = (rel >= 0) & (rel < window) & (kpos[:, None, :] >= 0)
    mask = mask[None, :, None, None]
    s = jnp.where(mask, s, NEG)
    if sinks is None:
        pr = jax.nn.softmax(s, -1)
    else:
        sk = sinks.astype(jnp.float32).reshape(1, 1, G, R, 1, 1)
        m = jnp.maximum(s.max(-1, keepdims=True), sk)
        e = jnp.exp(s - m)
        pr = e / (e.sum(-1, keepdims=True) + jnp.exp(sk - m))
    o = jnp.einsum('bngrqk,bnkgd->bnqgrd', pr.astype(q.dtype), vb)
    return o.reshape(Bsz, S, G, R, dh)


def ssd_mixer(z, xbc, dt_raw, conv_w, conv_b, dt_bias, a_log, d_skip, norm_w):
    f32 = jnp.float32
    Bsz, S, _ = z.shape
    G, R, P, N, L = SSD_GROUPS, SSD_HEADS // SSD_GROUPS, HEAD_DIM, SSD_STATE, SSD_CHUNK
    nc = S // L
    xbc = jax.nn.silu(causal_dwconv(xbc, conv_w, conv_b))
    xs, Bm, Cm = split_cols(xbc, (SSD_D_INNER, G * N, G * N))
    X = xs.reshape(Bsz, nc, L, G, R, P).astype(f32)
    Bc = Bm.reshape(Bsz, nc, L, G, N).astype(f32)
    Cc = Cm.reshape(Bsz, nc, L, G, N).astype(f32)
    dt = jax.nn.softplus(dt_raw.astype(f32) + dt_bias.astype(f32)).reshape(Bsz, nc, L, G, R)
    A = -jnp.exp(a_log.astype(f32)).reshape(G, R)
    a_cum = jnp.cumsum(dt * A, axis=2)
    tril = jnp.tril(jnp.ones((L, L), bool))[None, None, :, :, None, None]
    seg = a_cum[:, :, :, None] - a_cum[:, :, None, :]
    decay = jnp.exp(jnp.where(tril, seg, -jnp.inf))
    cb = jnp.einsum('bclgn,bcsgn->bclsg', Cc, Bc)
    w_ls = cb[..., None] * decay * dt[:, :, None]
    y_diag = jnp.einsum('bclsgr,bcsgrp->bclgrp', w_ls, X)
    decay_to_end = jnp.exp(a_cum[:, :, -1:] - a_cum)
    states = jnp.einsum('bclgn,bclgr,bclgrp->bcgrpn', Bc, decay_to_end * dt, X)
    chunk_decay = jnp.exp(a_cum[:, :, -1])

    def step(hs, inp):
        st, dec = inp
        return hs * dec[..., None, None] + st, hs

    h0 = jnp.zeros((Bsz, G, R, P, N), f32)
    _, prev = lax.scan(step, h0, (jnp.moveaxis(states, 1, 0), jnp.moveaxis(chunk_decay, 1, 0)))
    prev = jnp.moveaxis(prev, 0, 1)
    y_off = jnp.einsum('bclgn,bcgrpn,bclgr->bclgrp', Cc, prev, jnp.exp(a_cum))
    y = y_diag + y_off + d_skip.astype(f32).reshape(G, R)[..., None] * X
    y = y.reshape(Bsz, S, SSD_D_INNER)
    yg = (y * jax.nn.silu(z.astype(f32))).reshape(Bsz, S, G, SSD_D_INNER // G)
    yg = yg * lax.rsqrt(jnp.mean(yg * yg, -1, keepdims=True) + NORM_EPS)
    return (yg.reshape(Bsz, S, SSD_D_INNER) * norm_w.astype(f32)).astype(z.dtype)


def compress_blocks(kv, pe, w1, w2):
    S = kv.shape[1]
    nc = (S - NSA_CMP_BLOCK) // NSA_CMP_STRIDE + 1
    idx = jnp.arange(nc)[:, None] * NSA_CMP_STRIDE + jnp.arange(NSA_CMP_BLOCK)[None, :]
    blk = kv[:, idx] + pe[None, None, :, None, :].astype(kv.dtype)
    hid = jax.nn.silu(jnp.einsum('bnlgd,ldf->bngf', blk, w1))
    return jnp.einsum('bngf,fd->bngd', hid, w2)


def nsa_mixer(q, kv, gates, cmp_pe, cmp_w1, cmp_w2):
    f32 = jnp.float32
    Bsz, S, _ = q.shape
    G, R, dh = NSA_KV_HEADS, NSA_HEADS // NSA_KV_HEADS, HEAD_DIM
    scale = dh ** -0.5
    q = q.reshape(Bsz, S, G, R, dh)
    k_c, v_c, k_s, v_s, k_w, v_w = [t.reshape(Bsz, S, G, dh) for t in jnp.split(kv, 6, axis=-1)]
    t_pos = jnp.arange(S)
    kc = compress_blocks(k_c, cmp_pe[0], cmp_w1[0], cmp_w2[0])
    vc = compress_blocks(v_c, cmp_pe[1], cmp_w1[1], cmp_w2[1])
    nc = kc.shape[1]
    cmp_end = jnp.arange(nc) * NSA_CMP_STRIDE + NSA_CMP_BLOCK - 1
    cmask = (cmp_end[None, :] <= t_pos[:, None])[None, :, None, None, :]
    s = jnp.einsum('bsgrd,bngd->bsgrn', q, kc).astype(f32) * scale
    s = jnp.where(cmask, s, NEG)
    p_cmp = jnp.where(cmask, jax.nn.softmax(s, -1), 0.0)
    o_cmp = jnp.einsum('bsgrn,bngd->bsgrd', p_cmp.astype(q.dtype), vc)
    n_sel = S // NSA_SEL_BLOCK
    c_start = jnp.arange(nc) * NSA_CMP_STRIDE
    s_start = jnp.arange(n_sel) * NSA_SEL_BLOCK
    overlap = ((c_start[:, None] < s_start[None, :] + NSA_SEL_BLOCK)
               & (c_start[:, None] + NSA_CMP_BLOCK > s_start[None, :])).astype(f32)
    imp = jnp.einsum('bsgrn,nj->bsgj', p_cmp, overlap)
    blk_of_t = t_pos // NSA_SEL_BLOCK
    j = jnp.arange(n_sel)
    valid = (j[None, :] <= blk_of_t[:, None])[None, :, None, :]
    forced = ((j[None, :] == 0) | (j[None, :] == blk_of_t[:, None]))[None, :, None, :]
    score = jnp.where(forced, BIG, jnp.where(valid, imp, NEG))
    k_eff = min(NSA_TOPK, n_sel)
    _, sel_idx = lax.top_k(score, k_eff)
    kb = k_s.reshape(Bsz, n_sel, NSA_SEL_BLOCK, G, dh).transpose(0, 3, 1, 2, 4)
    vb = v_s.reshape(Bsz, n_sel, NSA_SEL_BLOCK, G, dh).transpose(0, 3, 1, 2, 4)
    QB = NSA_SEL_QBLOCK
    nq = S // QB
    bi = jnp.arange(Bsz)[:, None, None, None]
    gi = jnp.arange(G)[None, None, :, None]

    def sel_block(args):
        qb, ib, tb = args
        kg = kb[bi, gi, ib]
        vg = vb[bi, gi, ib]
        sc = jnp.einsum('bqgrd,bqgkld->bqgrkl', qb, kg).astype(f32) * scale
        kpos = ib[..., None] * NSA_SEL_BLOCK + jnp.arange(NSA_SEL_BLOCK)
        m = (kpos <= tb[None, :, None, None, None])[:, :, :, None]
        sc = jnp.where(m, sc, NEG)
        shp = sc.shape
        pr = jax.nn.softmax(sc.reshape(shp[:4] + (-1,)), -1).reshape(shp)
        return jnp.einsum('bqgrkl,bqgkld->bqgrd', pr.astype(qb.dtype), vg)

    qs = q.reshape(Bsz, nq, QB, G, R, dh).swapaxes(0, 1)
    iss = sel_idx.reshape(Bsz, nq, QB, G, k_eff).swapaxes(0, 1)
    ts = t_pos.reshape(nq, QB)
    o_sel = lax.map(sel_block, (qs, iss, ts)).swapaxes(0, 1).reshape(Bsz, S, G, R, dh)
    o_win = banded_attention(q, k_w, v_w, NSA_WINDOW)
    g = jax.nn.sigmoid(gates).reshape(Bsz, S, 3, G, R, 1)
    o = g[:, :, 0] * o_cmp + g[:, :, 1] * o_sel + g[:, :, 2] * o_win
    return o.reshape(Bsz, S, NSA_HEADS * dh).astype(q.dtype)


def rwkv7_mixer(u, mu, w0, w_up, a0, a_up, g_up, k_k, k_a, r_k, ln_w, ln_b):
    f32 = jnp.float32
    Bsz, S, _ = u.shape
    H, N = RWKV_HEADS, HEAD_DIM
    prev = jnp.pad(u, ((0, 0), (1, 0), (0, 0)))[:, :-1]
    u = u + (prev - u) * mu.astype(u.dtype)
    r, k, v, wd, ad, gd = split_cols(u, (RWKV_DIM, RWKV_DIM, RWKV_DIM, RWKV_W_LORA, RWKV_A_LORA, RWKV_G_LORA))
    w = -jax.nn.softplus(-(w0 + jnp.tanh(wd) @ w_up).astype(f32)) - 0.5
    decay = jnp.exp(-jnp.exp(w))
    a = jax.nn.sigmoid((a0 + ad @ a_up).astype(f32))
    g = jax.nn.sigmoid(gd) @ g_up
    r = r.astype(f32)
    k = k.astype(f32)
    v = v.astype(f32)
    kk = (k * k_k.astype(f32)).reshape(Bsz, S, H, N)
    kk = kk / jnp.maximum(jnp.sqrt(jnp.sum(kk * kk, -1, keepdims=True)), 1e-12)
    k = k * (1.0 + (a - 1.0) * k_a.astype(f32))
    heads = lambda t: t.reshape(Bsz, S, H, N)
    r, k, v, decay, a = heads(r), heads(k), heads(v), heads(decay), heads(a)

    def step(state, inp):
        r_t, w_t, k_t, v_t, kk_t, a_t = inp
        sa = jnp.einsum('bhvk,bhk->bhv', state, -kk_t)
        state = (state * w_t[:, :, None, :] + sa[..., None] * (kk_t * a_t)[:, :, None, :]
                 + v_t[..., None] * k_t[:, :, None, :])
        return state, jnp.einsum('bhvk,bhk->bhv', state, r_t)

    xs = tuple(jnp.moveaxis(t, 1, 0) for t in (r, decay, k, v, kk, a))
    _, o = lax.scan(step, jnp.zeros((Bsz, H, N, N), f32), xs)
    o = jnp.moveaxis(o, 0, 1)
    mean = o.mean(-1, keepdims=True)
    var = jnp.mean((o - mean) ** 2, -1, keepdims=True)
    o = ((o - mean) * lax.rsqrt(var + RWKV_GN_EPS)).reshape(Bsz, S, RWKV_DIM)
    o = o * ln_w.astype(f32) + ln_b.astype(f32)
    bonus = jnp.sum(r * k * r_k.astype(f32).reshape(H, N), -1, keepdims=True) * v
    o = o + bonus.reshape(Bsz, S, RWKV_DIM)
    return (o * g.astype(f32)).astype(u.dtype)


def swa_mixer(q, kv, positions, sinks):
    Bsz, S, _ = q.shape
    G, R = SWA_KV_HEADS, SWA_HEADS // SWA_KV_HEADS
    q = rope(q.reshape(Bsz, S, G, R, HEAD_DIM), positions)
    k, v = jnp.split(kv, 2, axis=-1)
    k = rope(k.reshape(Bsz, S, G, HEAD_DIM), positions)
    v = v.reshape(Bsz, S, G, HEAD_DIM)
    o = banded_attention(q, k, v, SWA_WINDOW, sinks)
    return o.reshape(Bsz, S, SWA_HEADS * HEAD_DIM)


def moe_swiglu(h, router, w_gate, w_up, w_down):
    f32 = jnp.float32
    Bsz, S, D = h.shape
    T = Bsz * S
    TK = T * TOP_K
    xt = h.reshape(T, D)
    logits = (xt @ router).astype(f32)
    top_v, top_e = lax.top_k(logits, TOP_K)
    wts = jax.nn.softmax(top_v, -1)
    flat_e = top_e.reshape(-1)
    flat_t = jnp.repeat(jnp.arange(T, dtype=jnp.int32), TOP_K)
    flat_w = wts.reshape(-1)
    order = jnp.argsort(flat_e)
    se = flat_e[order]
    counts = jnp.bincount(flat_e, length=N_EXPERTS)
    starts = jnp.cumsum(counts) - counts
    pcounts = (counts + MOE_BLOCK - 1) // MOE_BLOCK * MOE_BLOCK
    pends = jnp.cumsum(pcounts)
    pstarts = pends - pcounts
    dest = pstarts[se] + jnp.arange(TK) - starts[se]
    nblk = -(-(TK + N_EXPERTS * (MOE_BLOCK - 1)) // MOE_BLOCK)
    P = nblk * MOE_BLOCK
    slot_tok = jnp.full((P,), T, jnp.int32).at[dest].set(flat_t[order])
    slot_w = jnp.zeros((P,), f32).at[dest].set(flat_w[order])
    blk_e = jnp.minimum(jnp.searchsorted(pends, jnp.arange(nblk) * MOE_BLOCK, side='right'), N_EXPERTS - 1)
    xpad = jnp.concatenate([xt, jnp.zeros((1, D), xt.dtype)], 0)
    xb = xpad[slot_tok].reshape(nblk, MOE_BLOCK, D)

    def expert_block(args):
        xs, e = args
        return swiglu(xs, w_gate[e], w_up[e], w_down[e])

    yb = lax.map(expert_block, (xb, blk_e)).reshape(P, D)
    yb = yb * slot_w[:, None].astype(yb.dtype)
    out = jnp.zeros((T + 1, D), yb.dtype).at[slot_tok].add(yb)[:T]
    return out.reshape(Bsz, S, D)


def setup_inputs(seed: int = 0) -> dict:
    key = jax.random.key(seed)
    keys = jax.random.split(key, 64)
    cnt = [0]

    def nk():
        cnt[0] += 1
        return keys[cnt[0] - 1]

    def nrm(shape, scale):
        return jax.random.normal(nk(), shape, jnp.float32) * scale

    def unif(shape, lo, hi):
        return jax.random.uniform(nk(), shape, jnp.float32, lo, hi)

    def gain(shape):
        return 1.0 + nrm(shape, 0.02)

    L = DEPTH
    dt = jnp.exp(unif((L, SSD_HEADS), float(np.log(1e-3)), float(np.log(1e-1))))
    return {
        "x": nrm((BATCH, SEQ, D_MODEL), 1.0),
        "p": nrm((DEPTH, BATCH, SEQ, PLE_DIM), 1.0),
        "positions": jax.random.randint(nk(), (BATCH, 1), 0, 4096, dtype=jnp.int32) + jnp.arange(SEQ, dtype=jnp.int32)[None, :],
        "norm_mix": gain((L, D_MODEL)),
        "w_in": nrm((L, D_MODEL, D_IN), D_MODEL ** -0.5),
        "ssd_conv_w": nrm((L, SSD_CONV, SSD_CONV_DIM), SSD_CONV ** -0.5),
        "ssd_conv_b": nrm((L, SSD_CONV_DIM), 0.02),
        "ssd_dt_bias": dt + jnp.log(-jnp.expm1(-dt)),
        "ssd_a_log": jnp.log(unif((L, SSD_HEADS), 1.0, 16.0)),
        "ssd_d": 1.0 + nrm((L, SSD_HEADS), 0.1),
        "ssd_norm": gain((L, SSD_D_INNER)),
        "nsa_cmp_pe": nrm((L, 2, NSA_CMP_BLOCK, HEAD_DIM), 0.1),
        "nsa_cmp_w1": nrm((L, 2, NSA_CMP_BLOCK, HEAD_DIM, NSA_CMP_HIDDEN), (NSA_CMP_BLOCK * HEAD_DIM) ** -0.5),
        "nsa_cmp_w2": nrm((L, 2, NSA_CMP_HIDDEN, HEAD_DIM), NSA_CMP_HIDDEN ** -0.5),
        "rwkv_mu": unif((L, RWKV_IN), 0.0, 1.0),
        "rwkv_w0": unif((L, RWKV_DIM), -6.0, -1.0),
        "rwkv_w_up": nrm((L, RWKV_W_LORA, RWKV_DIM), 0.1 * RWKV_W_LORA ** -0.5),
        "rwkv_a0": nrm((L, RWKV_DIM), 0.1),
        "rwkv_a_up": nrm((L, RWKV_A_LORA, RWKV_DIM), 0.1 * RWKV_A_LORA ** -0.5),
        "rwkv_g_up": nrm((L, RWKV_G_LORA, RWKV_DIM), RWKV_G_LORA ** -0.5),
        "rwkv_k_k": 0.85 + nrm((L, RWKV_DIM), 0.02),
        "rwkv_k_a": 1.0 + nrm((L, RWKV_DIM), 0.02),
        "rwkv_r_k": nrm((L, RWKV_DIM), 0.1),
        "rwkv_ln_w": gain((L, RWKV_DIM)),
        "rwkv_ln_b": nrm((L, RWKV_DIM), 0.02),
        "swa_sinks": nrm((L, SWA_HEADS), 0.5),
        "w_br_ssd": nrm((L, SSD_D_INNER, D_MODEL), SSD_D_INNER ** -0.5),
        "w_br_nsa": nrm((L, NSA_HEADS * HEAD_DIM, D_MODEL), (NSA_HEADS * HEAD_DIM) ** -0.5),
        "w_br_rwkv": nrm((L, RWKV_DIM, D_MODEL), RWKV_DIM ** -0.5),
        "w_br_swa": nrm((L, SWA_HEADS * HEAD_DIM, D_MODEL), (SWA_HEADS * HEAD_DIM) ** -0.5),
        "w_out": nrm((L, D_MODEL, D_MODEL), D_MODEL ** -0.5),
        "norm_ffn": gain((L, D_MODEL)),
        "ffn_w_gate": nrm((N_DENSE, D_MODEL, D_FF), D_MODEL ** -0.5),
        "ffn_w_up": nrm((N_DENSE, D_MODEL, D_FF), D_MODEL ** -0.5),
        "ffn_w_down": nrm((N_DENSE, D_FF, D_MODEL), D_FF ** -0.5),
        "moe_router": nrm((N_MOE, D_MODEL, N_EXPERTS), D_MODEL ** -0.5),
        "moe_w_gate": nrm((N_MOE, N_EXPERTS, D_MODEL, D_FF), D_MODEL ** -0.5),
        "moe_w_up": nrm((N_MOE, N_EXPERTS, D_MODEL, D_FF), D_MODEL ** -0.5),
        "moe_w_down": nrm((N_MOE, N_EXPERTS, D_FF, D_MODEL), D_FF ** -0.5),
        "ple_proj": nrm((L, PLE_DIM, D_MODEL), PLE_DIM ** -0.5),
        "ple_gate": nrm((L, D_MODEL, D_MODEL), D_MODEL ** -0.5),
        "norm_final": gain((D_MODEL,)),
    }


def reference(x, p, positions, norm_mix, w_in, ssd_conv_w, ssd_conv_b, ssd_dt_bias, ssd_a_log, ssd_d,
              ssd_norm, nsa_cmp_pe, nsa_cmp_w1, nsa_cmp_w2, rwkv_mu, rwkv_w0, rwkv_w_up, rwkv_a0, rwkv_a_up,
              rwkv_g_up, rwkv_k_k, rwkv_k_a, rwkv_r_k, rwkv_ln_w, rwkv_ln_b, swa_sinks, w_br_ssd, w_br_nsa,
              w_br_rwkv, w_br_swa, w_out, norm_ffn, ffn_w_gate, ffn_w_up, ffn_w_down, moe_router, moe_w_gate,
              moe_w_up, moe_w_down, ple_proj, ple_gate, norm_final):
    Bsz, S, _ = x.shape
    for i in range(DEPTH):
        h = rmsnorm(x, norm_mix[i])
        u = h @ w_in[i]
        (z, xbc, dt_raw, nsa_q, nsa_kv, nsa_g, rwkv_u, swa_q, swa_kv, gate_logits) = split_cols(u, IN_SPLITS)
        y_ssd = ssd_mixer(z, xbc, dt_raw, ssd_conv_w[i], ssd_conv_b[i], ssd_dt_bias[i], ssd_a_log[i],
                          ssd_d[i], ssd_norm[i])
        y_nsa = nsa_mixer(nsa_q, nsa_kv, nsa_g, nsa_cmp_pe[i], nsa_cmp_w1[i], nsa_cmp_w2[i])
        y_rwkv = rwkv7_mixer(rwkv_u, rwkv_mu[i], rwkv_w0[i], rwkv_w_up[i], rwkv_a0[i], rwkv_a_up[i],
                             rwkv_g_up[i], rwkv_k_k[i], rwkv_k_a[i], rwkv_r_k[i], rwkv_ln_w[i], rwkv_ln_b[i])
        y_swa = swa_mixer(swa_q, swa_kv, positions, swa_sinks[i])
        g = jax.nn.sigmoid(gate_logits).reshape(Bsz, S, N_BRANCHES, D_MODEL)
        merged = (g[:, :, 0] * (y_ssd @ w_br_ssd[i]) + g[:, :, 1] * (y_nsa @ w_br_nsa[i])
                  + g[:, :, 2] * (y_rwkv @ w_br_rwkv[i]) + g[:, :, 3] * (y_swa @ w_br_swa[i]))
        x = x + merged @ w_out[i]
        h = rmsnorm(x, norm_ffn[i])
        j = i // 2
        if i % 2 == 0:
            x = x + swiglu(h, ffn_w_gate[j], ffn_w_up[j], ffn_w_down[j])
        else:
            x = x + moe_swiglu(h, moe_router[j], moe_w_gate[j], moe_w_up[j], moe_w_down[j])
        x = x + jax.nn.sigmoid(x @ ple_gate[i]) * (p[i] @ ple_proj[i])
    return rmsnorm(x, norm_final)
```

```cpp
#include <hip/hip_runtime.h>
#include <hip/hip_cooperative_groups.h>
#include <cstdio>
#include <cstdint>
namespace cg = cooperative_groups;

#define LAS __attribute__((address_space(3)))
#define GAS __attribute__((address_space(1)))
typedef unsigned short bf16_t;
typedef short bf16x8 __attribute__((ext_vector_type(8)));
typedef short s16x4 __attribute__((ext_vector_type(4)));
typedef float f32x2 __attribute__((ext_vector_type(2)));
typedef float f32x4 __attribute__((ext_vector_type(4)));
typedef float f32x16 __attribute__((ext_vector_type(16)));
typedef unsigned u32x2 __attribute__((ext_vector_type(2)));
typedef unsigned u32x4 __attribute__((ext_vector_type(4)));

#ifdef DIAG_NOINLINE
#define UNIT_INLINE __attribute__((noinline))
#else
#define UNIT_INLINE __forceinline__
#endif
#ifndef MK_MULTI
#define MK_MULTI 0
#endif

constexpr int NB = 8, SEQ = 2048, T = NB * SEQ, DM = 1024, HD = 64;
constexpr int D_IN = 9504, D_FF = 2816, NEXP = 8, PLE = 256;
constexpr int UW = 5376;
constexpr int YW = 2048;
constexpr float NORM_EPS = 1e-6f;
constexpr float LOG2E = 1.4426950408889634f;
constexpr int UC_Z = 0, UC_XBC = 512, UC_XS = 512, UC_BM = 1024, UC_CM = 1280, UC_NQ = 1536, UC_NKV = 2048, UC_RW = 2816, UC_SQ = 4608, UC_SKV = 5120;
constexpr int MOE_MAXROWS = 34816;

constexpr size_t MiB = (size_t)1 << 20;
constexpr size_t WS_CTL = 0, CTL_BYTES = 1 * MiB;
constexpr size_t WS_ROPE = 1 * MiB;
constexpr size_t WS_MISC = 5 * MiB;
constexpr size_t WS_KC = 7 * MiB, WS_VC = 7 * MiB + 256 * 1024;
constexpr size_t WS_SSQ = 7 * MiB + 512 * 1024;
constexpr size_t WS_TOKE = 8 * MiB, WS_TOKP = WS_TOKE + 128 * 1024, WS_TOKW = WS_TOKP + 128 * 1024, WS_TOKS = WS_TOKW + 128 * 1024;
constexpr size_t WS_SRSTD = 8 * MiB + 512 * 1024;
constexpr size_t WS_W1T = 9 * MiB;
constexpr size_t WS_W2T = 10 * MiB;
constexpr size_t WS_PEB = 10 * MiB + 64 * 1024;
constexpr size_t WS_WA = 12 * MiB, WA_STRIDE = 28 * MiB;
constexpr size_t WA_IN = 0, WA_GATE = 11 * MiB, WA_PT = 19 * MiB, WA_OUT = 23 * MiB, WA_PG = 25 * MiB, WA_PP = 27 * MiB;
constexpr size_t WS_FGU = 68 * MiB, WS_FDN = 79 * MiB;
constexpr size_t WS_WB = 85 * MiB, WB_STRIDE = 16 * MiB + 512 * 1024, WB_DN = 11 * MiB;
constexpr size_t WS_XB = 217 * MiB;
constexpr size_t WS_Y = 249 * MiB;
constexpr size_t WS_BIG = 313 * MiB;
constexpr size_t WS_U1 = WS_BIG, WS_GATES = WS_BIG, WS_MERGED = WS_BIG + 128 * MiB, WS_PB = WS_BIG + 160 * MiB, WS_ACT0 = WS_BIG;
constexpr size_t WS_XG = WS_XB, WS_ACT1 = 285 * MiB, WS_YB = WS_XB;
constexpr size_t WS_XB2_L0 = WS_Y, WS_XB2_L1 = 300 * MiB;
constexpr size_t WS_SSP = 482 * MiB;
constexpr size_t WS_END = 488 * MiB;
constexpr int CW_BAR = 4096, CW_QMIX = 8192, CW_MOECNT = 9216;

constexpr int RING_BYTES = 131072;
constexpr int LDS_BYTES = 147456;
constexpr int LDS_USER = LDS_BYTES - 1024;
constexpr int MISC_OFF = LDS_USER;

__device__ __forceinline__ float bf2f(unsigned b) { return __uint_as_float(b << 16); }
__device__ __forceinline__ unsigned f2bf(float f) { unsigned u = __float_as_uint(f); return (u + 0x7fffu + ((u >> 16) & 1u)) >> 16; }
__device__ __forceinline__ unsigned cvt_pk(float lo, float hi) { unsigned r; asm volatile("v_cvt_pk_bf16_f32 %0, %1, %2" : "=v"(r) : "v"(lo), "v"(hi)); return r; }
__device__ __forceinline__ float sigmoidf_(float x) { return 1.0f / (1.0f + __expf(-x)); }
__device__ __forceinline__ float siluf_(float x) { return x / (1.0f + __expf(-x)); }
__device__ __forceinline__ float softplusf_(float x) { return x > 20.f ? x : log1pf(expf(x)); }
__device__ __forceinline__ float wave_sum(float v) {
#pragma unroll
    for (int o = 1; o < 64; o <<= 1) v += __shfl_xor(v, o);
    return v;
}
__device__ __forceinline__ float wave_max(float v) {
#pragma unroll
    for (int o = 1; o < 64; o <<= 1) v = fmaxf(v, __shfl_xor(v, o));
    return v;
}
#define RLX_AGENT __ATOMIC_RELAXED, __HIP_MEMORY_SCOPE_AGENT
__device__ __forceinline__ u32x2 ld_agent_u64(const void* p) {
    unsigned long long v = __hip_atomic_load((const unsigned long long*)p, RLX_AGENT);
    u32x2 r; r.x = (unsigned)v; r.y = (unsigned)(v >> 32); return r;
}

__device__ __forceinline__ float ss_total(const float* ssp, int row) {
    const f32x4* p = (const f32x4*)(ssp + (size_t)row * 16); const f32x4 a = p[0], b = p[1], c = p[2], d = p[3];
    return (((a[0] + a[1]) + (a[2] + a[3])) + ((b[0] + b[1]) + (b[2] + b[3]))) + (((c[0] + c[1]) + (c[2] + c[3])) + ((d[0] + d[1]) + (d[2] + d[3])));
}
__device__ __forceinline__ float rstd_of(const float* ssp, int row) { return rsqrtf(ss_total(ssp, row) * (1.0f / DM) + NORM_EPS); }

namespace pg8 {
constexpr int BM = 256, BK = 64, HALF = 128, HTB = HALF * BK * 2, STAGE_BYTES = 8 * HTB, NXCD = 8, WGM = 8;
__host__ __device__ __forceinline__ int lds_byte(int r, int c) { const int st = (r >> 4) * 2 + (c >> 5), rr = r & 15, cc = c & 31, ob = rr * 64 + cc * 2; return st * 1024 + (ob ^ (((ob >> 9) & 1) << 5)); }
__host__ __device__ __forceinline__ void stage_rc(int b, int& R, int& C) { const int st = b / 1024, sb = b % 1024, swz = sb ^ (((sb >> 9) & 1) << 5); R = (st >> 1) * 16 + swz / 64; C = (st & 1) * 32 + (swz % 64) / 2; }

struct Unit { int pm, pn; const char* pa; const char* pb; };

struct StaticOrder {
    int nM, nN, nwg, G, c;
    __device__ void init(int nM_, int nN_, int G_, int c_) { nM = nM_; nN = nN_; nwg = nM * nN; G = G_; c = c_; }
    __device__ bool next(int i, int& pm, int& pn) const {
        const long L = (long)i * G + c; if (L >= nwg) return false;
        int wgid = (int)L; { const int q = nwg / NXCD, r = nwg % NXCD, xcd = wgid % NXCD, off = wgid / NXCD; wgid = (xcd < r ? xcd * (q + 1) : r * (q + 1) + (xcd - r) * q) + off; }
        const int nig = WGM * nN, gid = wgid / nig, fm = gid * WGM, gsz = (nM - fm) < WGM ? (nM - fm) : WGM;
        pm = fm + ((wgid % nig) % gsz); pn = (wgid % nig) / gsz; return true;
    }
};
struct DenseSched {
    StaticOrder so; const char* A; const char* B; size_t a_tile, b_tile;
    __device__ bool next(int i, Unit& u) const { if (!so.next(i, u.pm, u.pn)) return false; u.pa = A + (size_t)u.pm * a_tile; u.pb = B + (size_t)u.pn * b_tile; return true; }
};

template <class Epi, class Sched>
__device__ __forceinline__ void gemm_phase(LAS unsigned char* lds, const int lda, const int ldb, const int K, const Sched& S, const Epi& E) {
    int tid_ = threadIdx.x; asm volatile("" : "+v"(tid_));
    const int tid = tid_, wid = __builtin_amdgcn_readfirstlane(tid >> 6), lane = tid & 63, wr = wid >> 2, wc = wid & 3, fr = lane & 15, fq = lane >> 4;
    int K_ = K; asm volatile("" : "+s"(K_));
    const int nt = K_ / BK;
    unsigned voffA[2], voffB[2];
#pragma unroll
    for (int i = 0; i < 2; ++i) { int R, C; stage_rc(tid * 16 + i * 8192, R, C); voffA[i] = (unsigned)(R * lda + C) * 2u; voffB[i] = (unsigned)(R * ldb + C) * 2u; }
    const size_t kstep = (size_t)(BK * 2);
    const size_t hstepA = (size_t)HALF * lda * 2, hstepB = (size_t)HALF * ldb * 2;
    const unsigned ldsw = (unsigned)wid * 1024u;
    const int aoff = lds_byte(wr * 64 + fr, fq * 8), boff = lds_byte(wc * 32 + fr, fq * 8);
#define PG8_SA(b, h) (((b) * 2 + (h)) * HTB)
#define PG8_SB(b, h) ((4 + (b) * 2 + (h)) * HTB)
#define PG8_STAGE(bufoff, gbase, voff) do { _Pragma("unroll") for (int _i = 0; _i < 2; ++_i) \
        __builtin_amdgcn_global_load_lds((const unsigned*)((const char*)(gbase) + (voff)[_i]), (LAS unsigned*)(lds + (bufoff) + ldsw + _i * 8192), 16, 0, 0); } while (0)
#define PG8_LDA(dst, b, h) do { _Pragma("unroll") for (int m = 0; m < 4; ++m) _Pragma("unroll") for (int k = 0; k < 2; ++k) dst[m][k] = *(const LAS bf16x8*)(lds + PG8_SA(b, h) + aoff + m * 2048 + k * 1024); } while (0)
#define PG8_LDB(dst, b, h) do { _Pragma("unroll") for (int n = 0; n < 2; ++n) _Pragma("unroll") for (int k = 0; k < 2; ++k) dst[n][k] = *(const LAS bf16x8*)(lds + PG8_SB(b, h) + boff + n * 2048 + k * 1024); } while (0)
#define PG8_MMA(ai, bj, At, Bt) do { __builtin_amdgcn_s_setprio(1); _Pragma("unroll") for (int m = 0; m < 4; ++m) _Pragma("unroll") for (int n = 0; n < 2; ++n) _Pragma("unroll") for (int k = 0; k < 2; ++k) \
        acc[ai][bj][m][n] = __builtin_amdgcn_mfma_f32_16x16x32_bf16(Bt[n][k], At[m][k], acc[ai][bj][m][n], 0, 0, 0); __builtin_amdgcn_s_setprio(0); } while (0)
#define PG8_WAIT_V(n) asm volatile("s_waitcnt vmcnt(" #n ")" ::: "memory")
#define PG8_WAIT_L(n) asm volatile("s_waitcnt lgkmcnt(" #n ")" ::: "memory")
#define PG8_BAR __builtin_amdgcn_s_barrier()
#define PG8_SCHED __builtin_amdgcn_sched_barrier(0)
    Unit cur, nxt; int ui = 0;
    if (!S.next(0, cur)) return;
    f32x4 acc[2][2][4][2];
#pragma unroll
    for (int a = 0; a < 2; ++a)
#pragma unroll
        for (int b = 0; b < 2; ++b)
#pragma unroll
            for (int m = 0; m < 4; ++m)
#pragma unroll
                for (int n = 0; n < 2; ++n) acc[a][b][m][n] = (f32x4){0.f, 0.f, 0.f, 0.f};
    bf16x8 At[4][2], B0[2][2], B1[2][2];
    const char* cA = cur.pa; const char* cB = cur.pb;
    PG8_STAGE(PG8_SB(0, 0), cB, voffB); PG8_STAGE(PG8_SB(0, 1), cB + hstepB, voffB); PG8_STAGE(PG8_SA(0, 0), cA, voffA); PG8_STAGE(PG8_SA(0, 1), cA + hstepA, voffA);
    if (wr == 1) PG8_BAR;
    PG8_WAIT_V(2); PG8_BAR;
    PG8_STAGE(PG8_SB(1, 0), cB + kstep, voffB); PG8_STAGE(PG8_SA(1, 0), cA + kstep, voffA); PG8_STAGE(PG8_SB(1, 1), cB + hstepB + kstep, voffB);
    PG8_WAIT_V(6); PG8_BAR;
    for (;;) {
        const bool has_next = S.next(ui + 1, nxt);
        const char* nA = has_next ? nxt.pa : cA; const char* nB = has_next ? nxt.pb : cB;
        for (int t = 0; t < nt; t += 2) {
            const bool last = (t == nt - 2);
            const char* a1 = cA + (size_t)(t + 1) * kstep;
            const char* a2 = last ? nA : cA + (size_t)(t + 2) * kstep; const char* b2 = last ? nB : cB + (size_t)(t + 2) * kstep;
            const char* a3 = a2 + kstep; const char* b3 = b2 + kstep;
            PG8_LDB(B0, 0, 0); PG8_LDB(B1, 0, 1); PG8_SCHED; PG8_LDA(At, 0, 0); PG8_STAGE(PG8_SA(1, 1), a1 + hstepA, voffA);
            PG8_WAIT_V(8); PG8_WAIT_L(0); PG8_BAR; PG8_MMA(0, 0, At, B0); PG8_MMA(0, 1, At, B1); PG8_BAR; PG8_SCHED;
            PG8_LDA(At, 0, 1); PG8_STAGE(PG8_SB(0, 0), b2, voffB); PG8_STAGE(PG8_SB(0, 1), b2 + hstepB, voffB); PG8_STAGE(PG8_SA(0, 0), a2, voffA);
            PG8_WAIT_V(8); PG8_WAIT_L(0); PG8_BAR; PG8_MMA(1, 0, At, B0); PG8_MMA(1, 1, At, B1); PG8_BAR; PG8_SCHED;
            PG8_LDB(B0, 1, 0); PG8_LDB(B1, 1, 1); PG8_SCHED; PG8_LDA(At, 1, 0); PG8_STAGE(PG8_SA(0, 1), a2 + hstepA, voffA);
            PG8_WAIT_V(8); PG8_WAIT_L(0); PG8_BAR; PG8_MMA(0, 0, At, B0); PG8_MMA(0, 1, At, B1); PG8_BAR; PG8_SCHED;
            PG8_LDA(At, 1, 1); PG8_STAGE(PG8_SB(1, 0), b3, voffB); PG8_STAGE(PG8_SB(1, 1), b3 + hstepB, voffB); PG8_STAGE(PG8_SA(1, 0), a3, voffA);
            PG8_WAIT_V(8); PG8_WAIT_L(0); PG8_BAR; PG8_MMA(1, 0, At, B0); PG8_MMA(1, 1, At, B1); PG8_BAR; PG8_SCHED;
        }
        if (wr == 0) PG8_BAR;
        E(acc, cur, wr, wc, fr, fq);
        if (!has_next) break;
#pragma unroll
        for (int a = 0; a < 2; ++a)
#pragma unroll
            for (int b = 0; b < 2; ++b)
#pragma unroll
                for (int m = 0; m < 4; ++m)
#pragma unroll
                    for (int n = 0; n < 2; ++n) acc[a][b][m][n] = (f32x4){0.f, 0.f, 0.f, 0.f};
        cur = nxt; cA = nA; cB = nB; ++ui;
        if (wr == 1) PG8_BAR;
    }
    PG8_WAIT_V(0);
    PG8_BAR;
#undef PG8_SA
#undef PG8_SB
#undef PG8_STAGE
#undef PG8_LDA
#undef PG8_LDB
#undef PG8_MMA
#undef PG8_WAIT_V
#undef PG8_WAIT_L
#undef PG8_BAR
#undef PG8_SCHED
}
}

#define EPI_ROW(u, ai, m) ((u).pm * 256 + (ai) * 128 + wr * 64 + (m) * 16 + fr)
#define EPI_COL(u, bj, n) ((u).pn * 256 + (bj) * 128 + wc * 32 + (n) * 16 + fq * 4)
typedef f32x4 Acc[2][2][4][2];

__device__ __forceinline__ u32x2 pack4(f32x4 v) { u32x2 w; w.x = cvt_pk(v[0], v[1]); w.y = cvt_pk(v[2], v[3]); return w; }
__device__ __forceinline__ f32x4 unpack4(u32x2 w) { f32x4 v; v[0] = bf2f(w.x & 0xffffu); v[1] = bf2f(w.x >> 16); v[2] = bf2f(w.y & 0xffffu); v[3] = bf2f(w.y >> 16); return v; }

struct EpiIn {
    bf16_t* U; float* misc; const float* ss;
    __device__ __forceinline__ void operator()(const Acc& acc, const pg8::Unit& u, int wr, int wc, int fr, int fq) const {
#pragma unroll
        for (int ai = 0; ai < 2; ++ai)
#pragma unroll
            for (int m = 0; m < 4; ++m) {
                const int row = EPI_ROW(u, ai, m); const float rs = rstd_of(ss, row);
                if (u.pn < 21) {
#pragma unroll
                    for (int bj = 0; bj < 2; ++bj)
#pragma unroll
                        for (int n = 0; n < 2; ++n) *(u32x2*)(U + (size_t)row * UW + EPI_COL(u, bj, n)) = pack4(acc[ai][bj][m][n] * rs);
                } else if (wc == 0) {
#pragma unroll
                    for (int n = 0; n < 2; ++n) *(f32x4*)(misc + (size_t)row * 32 + n * 16 + fq * 4) = acc[ai][0][m][n] * rs;
                }
            }
    }
};
struct EpiGates {
    bf16_t* G; const float* ss;
    __device__ __forceinline__ void operator()(const Acc& acc, const pg8::Unit& u, int wr, int wc, int fr, int fq) const {
#pragma unroll
        for (int ai = 0; ai < 2; ++ai)
#pragma unroll
            for (int m = 0; m < 4; ++m) {
                const int row = EPI_ROW(u, ai, m); const float rs = rstd_of(ss, row);
#pragma unroll
                for (int bj = 0; bj < 2; ++bj)
#pragma unroll
                    for (int n = 0; n < 2; ++n) { f32x4 v = acc[ai][bj][m][n] * rs; v[0] = sigmoidf_(v[0]); v[1] = sigmoidf_(v[1]); v[2] = sigmoidf_(v[2]); v[3] = sigmoidf_(v[3]);
                        *(u32x2*)(G + (size_t)row * 4096 + EPI_COL(u, bj, n)) = pack4(v); }
            }
    }
};
template <int MB> struct EpiBr {
    bf16_t* MG; const bf16_t* G;
    __device__ __forceinline__ void operator()(const Acc& acc, const pg8::Unit& u, int wr, int wc, int fr, int fq) const {
#pragma unroll
        for (int ai = 0; ai < 2; ++ai)
#pragma unroll
            for (int m = 0; m < 4; ++m) {
                const int row = EPI_ROW(u, ai, m);
#pragma unroll
                for (int bj = 0; bj < 2; ++bj)
#pragma unroll
                    for (int n = 0; n < 2; ++n) { const int col = EPI_COL(u, bj, n);
                        const f32x4 g = unpack4(*(const u32x2*)(G + (size_t)row * 4096 + MB * 1024 + col));
                        f32x4 v = acc[ai][bj][m][n] * g;
                        bf16_t* mp = MG + (size_t)row * DM + col;
                        if (MB > 0) v += unpack4(ld_agent_u64(mp));
                        *(u32x2*)mp = pack4(v); }
                asm volatile("" ::: "memory");
            }
    }
};
template <bool WRITE_XB, bool ACC_SS> struct EpiRes {
    const float* xin; float* xo; bf16_t* xb; float* ss;
    __device__ __forceinline__ void operator()(const Acc& acc, const pg8::Unit& u, int wr, int wc, int fr, int fq) const {
#pragma unroll
        for (int ai = 0; ai < 2; ++ai)
#pragma unroll
            for (int m = 0; m < 4; ++m) {
                const int row = EPI_ROW(u, ai, m); float s = 0.f;
#pragma unroll
                for (int bj = 0; bj < 2; ++bj)
#pragma unroll
                    for (int n = 0; n < 2; ++n) { const size_t off = (size_t)row * DM + EPI_COL(u, bj, n);
                        const f32x4 v = *(const f32x4*)(xin + off) + acc[ai][bj][m][n];
                        *(f32x4*)(xo + off) = v;
                        if (WRITE_XB) *(u32x2*)(xb + off) = pack4(v);
                        if (ACC_SS) s += (v[0] * v[0] + v[1] * v[1]) + (v[2] * v[2] + v[3] * v[3]); }
                if (ACC_SS) { s += __shfl_xor(s, 16); s += __shfl_xor(s, 32); if (fq == 0) ss[(size_t)row * 16 + u.pn * 4 + wc] = s; }
                asm volatile("" ::: "memory");
            }
    }
};
template <bool MOE> struct EpiFfn1 {
    bf16_t* ACT; const float* ss;
    __device__ __forceinline__ void operator()(const Acc& acc, const pg8::Unit& u, int wr, int wc, int fr, int fq) const {
#pragma unroll
        for (int ai = 0; ai < 2; ++ai)
#pragma unroll
            for (int m = 0; m < 4; ++m) {
                const int row = EPI_ROW(u, ai, m); const float rs = MOE ? ss[row] : rstd_of(ss, row);
#pragma unroll
                for (int n = 0; n < 2; ++n) { const f32x4 g = acc[ai][0][m][n] * rs, up = acc[ai][1][m][n] * rs; f32x4 v;
                    v[0] = siluf_(g[0]) * up[0]; v[1] = siluf_(g[1]) * up[1]; v[2] = siluf_(g[2]) * up[2]; v[3] = siluf_(g[3]) * up[3];
                    *(u32x2*)(ACT + (size_t)row * D_FF + u.pn * 128 + wc * 32 + n * 16 + fq * 4) = pack4(v); }
            }
    }
};
template <bool SIG> struct EpiBf16 {
    bf16_t* O;
    __device__ __forceinline__ void operator()(const Acc& acc, const pg8::Unit& u, int wr, int wc, int fr, int fq) const {
#pragma unroll
        for (int ai = 0; ai < 2; ++ai)
#pragma unroll
            for (int m = 0; m < 4; ++m) {
                const int row = EPI_ROW(u, ai, m);
#pragma unroll
                for (int bj = 0; bj < 2; ++bj)
#pragma unroll
                    for (int n = 0; n < 2; ++n) { f32x4 v = acc[ai][bj][m][n];
                        if (SIG) { v[0] = sigmoidf_(v[0]); v[1] = sigmoidf_(v[1]); v[2] = sigmoidf_(v[2]); v[3] = sigmoidf_(v[3]); }
                        *(u32x2*)(O + (size_t)row * DM + EPI_COL(u, bj, n)) = pack4(v); }
            }
    }
};
template <bool WRITE_XB> struct EpiPle2 {
    float* xo; const bf16_t* G; bf16_t* xb; float* ss;
    __device__ __forceinline__ void operator()(const Acc& acc, const pg8::Unit& u, int wr, int wc, int fr, int fq) const {
#pragma unroll
        for (int ai = 0; ai < 2; ++ai)
#pragma unroll
            for (int m = 0; m < 4; ++m) {
                const int row = EPI_ROW(u, ai, m); float s = 0.f;
#pragma unroll
                for (int bj = 0; bj < 2; ++bj)
#pragma unroll
                    for (int n = 0; n < 2; ++n) { const size_t off = (size_t)row * DM + EPI_COL(u, bj, n);
                        const f32x4 g = unpack4(ld_agent_u64(G + off));
                        const f32x4 v = *(const f32x4*)(xo + off) + g * acc[ai][bj][m][n];
                        *(f32x4*)(xo + off) = v;
                        if (WRITE_XB) *(u32x2*)(xb + off) = pack4(v);
                        s += (v[0] * v[0] + v[1] * v[1]) + (v[2] * v[2] + v[3] * v[3]); }
                s += __shfl_xor(s, 16); s += __shfl_xor(s, 32); if (fq == 0) ss[(size_t)row * 16 + u.pn * 4 + wc] = s;
                asm volatile("" ::: "memory");
            }
    }
};

struct MoeTables { int ps1, ps2, ps3, ps4, ps5, ps6, ps7, ps8; };
__device__ __forceinline__ int moe_expert_of_row(const MoeTables& mt, int row) {
    return (row >= mt.ps1) + (row >= mt.ps2) + (row >= mt.ps3) + (row >= mt.ps4) + (row >= mt.ps5) + (row >= mt.ps6) + (row >= mt.ps7);
}
struct MoeSched {
    MoeTables mt; int nN, G, c; const char* A; const char* B; size_t a_tile, b_tile, b_expert;
    __device__ bool next(int i, pg8::Unit& u) const {
        const long L = (long)i * G + c; const int ntiles = mt.ps8 >> 8;
        if (L >= (long)ntiles * nN) return false;
        u.pm = (int)(L / nN); u.pn = (int)(L % nN);
        const int e = moe_expert_of_row(mt, u.pm * 256);
        u.pa = A + (size_t)u.pm * a_tile; u.pb = B + (size_t)e * b_expert + (size_t)u.pn * b_tile; return true;
    }
};

struct Args { const void* in[42]; float* out; unsigned char* ws; int ph_lo, ph_hi; };
typedef const __attribute__((address_space(4))) Args* KArgs;
__device__ __forceinline__ KArgs kargs() { KArgs p = (KArgs)__builtin_amdgcn_kernarg_segment_ptr(); asm volatile("" : "+s"(p)); return p; }
struct Frame {
    LAS unsigned char* lds; int tid, lane, wave, G, bid;
    unsigned char* ws; unsigned* ctl;
};
#define IN_F(k) ((const float*)KA->in[k])

struct TJob { const float* src; int ldw, K, ncols, ldt, mode; bf16_t* dst; const float* gain; };
__device__ __forceinline__ void tr_item(const TJob& J, LAS float* scr, int item, int lane) {
    const int nblk = J.ncols / 32, kb = item / nblk, nb = item % nblk, k0 = 64 * kb, n0 = 32 * nb;
    const int c = lane & 31;
    const int scol = (J.mode == 3) ? (c < 8 ? 1536 + c : 2816 + c) : n0 + c;
#pragma unroll 8
    for (int i = 0; i < 32; ++i) { const int kk = 2 * i + (lane >> 5); float v = J.src[(size_t)(k0 + kk) * J.ldw + scol]; if (J.gain) v *= J.gain[k0 + kk]; scr[kk * 33 + c] = v; }
    asm volatile("s_waitcnt lgkmcnt(0)" ::: "memory");
    int drow0 = n0;
    if (J.mode == 1 || J.mode == 2) drow0 = (n0 / 128) * 256 + (n0 % 128) + (J.mode == 2 ? 128 : 0);
    const int c8 = lane & 7;
#pragma unroll
    for (int j = 0; j < 4; ++j) { const int n = (lane >> 3) + 8 * j; const LAS float* s = scr + (8 * c8) * 33 + n;
        u32x4 o; o.x = cvt_pk(s[0 * 33], s[1 * 33]); o.y = cvt_pk(s[2 * 33], s[3 * 33]); o.z = cvt_pk(s[4 * 33], s[5 * 33]); o.w = cvt_pk(s[6 * 33], s[7 * 33]);
        *(u32x4*)(J.dst + (size_t)(drow0 + n) * J.ldt + k0 + 8 * c8) = o; }
    asm volatile("s_waitcnt lgkmcnt(0)" ::: "memory");
}
constexpr int NJOBS = 32 + 3 + 24 + 8;
__device__ __forceinline__ bool get_job(KArgs KA, int jid, TJob& J) {
    unsigned char* ws = KA->ws;
    J.gain = nullptr; J.mode = 0;
    if (jid < 32) {
        const int L = jid >> 4, j = jid & 15;
        unsigned char* wa = ws + WS_WA + (size_t)L * WA_STRIDE;
        if (j <= 8) {
            const float* w = IN_F(4) + (size_t)L * DM * D_IN; J.ldw = D_IN; J.K = DM; J.ldt = DM; J.gain = IN_F(3) + L * DM;
            int sc, nc, dr;
            switch (j) { case 0: sc = 0; nc = 512; dr = 0; break; case 1: sc = 512; nc = 1024; dr = 512; break; case 2: sc = 1544; nc = 512; dr = 1536; break;
                case 3: sc = 2056; nc = 768; dr = 2048; break; case 4: sc = 2848; nc = 1792; dr = 2816; break; case 5: sc = 4640; nc = 512; dr = 4608; break;
                case 6: sc = 5152; nc = 256; dr = 5120; break; case 7: sc = 0; nc = 32; dr = 5376; J.mode = 3; break; default: sc = 5408; nc = 4096; dr = 0; break; }
            J.src = w + sc; J.ncols = nc; J.dst = (bf16_t*)(wa + (j == 8 ? WA_GATE : WA_IN)) + (size_t)dr * DM;
            return true;
        }
        if (j <= 12) { const int m = j - 9; J.src = IN_F(26 + m) + (size_t)L * 512 * DM; J.ldw = DM; J.K = 512; J.ncols = DM; J.ldt = 512; J.dst = (bf16_t*)(wa + WA_PT + (size_t)m * MiB); return true; }
        if (j == 13) { J.src = IN_F(30) + (size_t)L * DM * DM; J.ldw = DM; J.K = DM; J.ncols = DM; J.ldt = DM; J.dst = (bf16_t*)(wa + WA_OUT); return true; }
        if (j == 14) { J.src = IN_F(40) + (size_t)L * DM * DM; J.ldw = DM; J.K = DM; J.ncols = DM; J.ldt = DM; J.dst = (bf16_t*)(wa + WA_PG); return true; }
        J.src = IN_F(39) + (size_t)L * PLE * DM; J.ldw = DM; J.K = PLE; J.ncols = DM; J.ldt = PLE; J.dst = (bf16_t*)(wa + WA_PP); return true;
    }
    if (jid < 35) {
        const int j = jid - 32;
        if (j < 2) { J.src = IN_F(32 + j); J.ldw = D_FF; J.K = DM; J.ncols = D_FF; J.ldt = DM; J.gain = IN_F(31); J.mode = 1 + j; J.dst = (bf16_t*)(ws + WS_FGU); return true; }
        J.src = IN_F(34); J.ldw = DM; J.K = D_FF; J.ncols = DM; J.ldt = D_FF; J.dst = (bf16_t*)(ws + WS_FDN); return true;
    }
    if (jid < 59) {
        const int e = (jid - 35) / 3, j = (jid - 35) % 3;
        unsigned char* wb = ws + WS_WB + (size_t)e * WB_STRIDE;
        if (j < 2) { J.src = IN_F(36 + j) + (size_t)e * DM * D_FF; J.ldw = D_FF; J.K = DM; J.ncols = D_FF; J.ldt = DM; J.gain = IN_F(31) + DM; J.mode = 1 + j; J.dst = (bf16_t*)wb; return true; }
        J.src = IN_F(38) + (size_t)e * D_FF * DM; J.ldw = DM; J.K = D_FF; J.ncols = DM; J.ldt = D_FF; J.dst = (bf16_t*)(wb + WB_DN); return true;
    }
    {
        const int j = jid - 59, idx = j & 3;
        if (j < 4) { J.src = IN_F(12) + (size_t)idx * 2048 * 64; J.ldw = 64; J.K = 2048; J.ncols = 64; J.ldt = 2048; J.dst = (bf16_t*)(ws + WS_W1T) + (size_t)idx * 64 * 2048; return true; }
        J.src = IN_F(13) + (size_t)idx * 64 * 64; J.ldw = 64; J.K = 64; J.ncols = 64; J.ldt = 64; J.dst = (bf16_t*)(ws + WS_W2T) + (size_t)idx * 64 * 64; return true;
    }
}
__device__ UNIT_INLINE void p0_prologue(KArgs KA, Frame& F) {
    LAS float* scr = (LAS float*)(F.lds + F.wave * 16384);
    const int gw = F.bid * 8 + F.wave, NGW = F.G * 8;
    unsigned char* ws = KA->ws;
    for (int jid = 0; jid < NJOBS; ++jid) {
        TJob J; get_job(KA, jid, J);
        const int nitems = (J.K / 64) * (J.ncols / 32);
        for (int it = gw; it < nitems; it += NGW) tr_item(J, scr, it, F.lane);
    }
    for (int L = 0; L < 2; ++L) {
        u32x4* z = (u32x4*)((bf16_t*)(ws + WS_WA + (size_t)L * WA_STRIDE + WA_IN) + (size_t)5408 * DM);
        const int n16 = 224 * DM * 2 / 16;
        for (int i = gw * 64 + F.lane; i < n16; i += NGW * 64) z[i] = (u32x4){0u, 0u, 0u, 0u};
    }
    if (gw < 4) {
        const float* pe = IN_F(11) + (size_t)gw * 2048; const float* w1 = IN_F(12) + (size_t)gw * 2048 * 64; float s = 0.f;
        for (int k = 0; k < 2048; ++k) s += pe[k] * w1[(size_t)k * 64 + F.lane];
        ((float*)(ws + WS_PEB))[gw * 64 + F.lane] = s;
    }
    {
        const float* x = IN_F(0); bf16_t* xb = (bf16_t*)(ws + WS_XB); float* ss = (float*)(ws + WS_SSP);
        for (int m = gw; m < T; m += NGW) {
            const f32x4* xr = (const f32x4*)(x + (size_t)m * DM) + F.lane; float s = 0.f;
            u32x2* o = (u32x2*)(xb + (size_t)m * DM) + F.lane;
#pragma unroll
            for (int j = 0; j < 4; ++j) { const f32x4 v = xr[64 * j]; s += (v[0] * v[0] + v[1] * v[1]) + (v[2] * v[2] + v[3] * v[3]); o[64 * j] = pack4(v); }
            s = wave_sum(s); if (F.lane < 16) ss[(size_t)m * 16 + F.lane] = (F.lane == 0) ? s : 0.f;
        }
    }
    {
        const int* pos = (const int*)KA->in[2]; float* rc = (float*)(ws + WS_ROPE); float* rsn = rc + (size_t)T * 32;
        for (int i = (gw * 64 + F.lane); i < T * 32; i += NGW * 64) {
            const int t = i >> 5, k = i & 31;
            const float inv = (float)exp2(-(double)k * (1.0 / 32.0) * 17.194602975157967);
            const float ang = (float)pos[t] * inv;
            rc[i] = cosf(ang); rsn[i] = sinf(ang);
        }
    }
}

__device__ UNIT_INLINE void rope_pass(Frame& F, bf16_t* U1, const float* rc, const float* rsn) {
    const int gt = F.bid * 512 + F.tid, NT = F.G * 512;
    for (int i = gt; i < T * 40; i += NT) {
        const int t = i / 40, r = i % 40, slot = r >> 2, ch = r & 3;
        bf16_t* base = U1 + (size_t)t * UW + (slot < 8 ? UC_SQ + slot * 64 : UC_SKV + (slot - 8) * 64) + ch * 8;
        const u32x4 a = *(const u32x4*)base, b = *(const u32x4*)(base + 32);
        const f32x4 c0 = *(const f32x4*)(rc + (size_t)t * 32 + ch * 8), c1 = *(const f32x4*)(rc + (size_t)t * 32 + ch * 8 + 4);
        const f32x4 s0 = *(const f32x4*)(rsn + (size_t)t * 32 + ch * 8), s1 = *(const f32x4*)(rsn + (size_t)t * 32 + ch * 8 + 4);
        float x1[8], x2[8], cs[8], sn[8];
#pragma unroll
        for (int j = 0; j < 4; ++j) { x1[2 * j] = bf2f(a[j] & 0xffffu); x1[2 * j + 1] = bf2f(a[j] >> 16); x2[2 * j] = bf2f(b[j] & 0xffffu); x2[2 * j + 1] = bf2f(b[j] >> 16);
            cs[j] = c0[j]; cs[4 + j] = c1[j]; sn[j] = s0[j]; sn[4 + j] = s1[j]; }
        u32x4 oa, ob;
#pragma unroll
        for (int j = 0; j < 4; ++j) {
            const float y1a = x1[2 * j] * cs[2 * j] - x2[2 * j] * sn[2 * j], y1b = x1[2 * j + 1] * cs[2 * j + 1] - x2[2 * j + 1] * sn[2 * j + 1];
            const float y2a = x2[2 * j] * cs[2 * j] + x1[2 * j] * sn[2 * j], y2b = x2[2 * j + 1] * cs[2 * j + 1] + x1[2 * j + 1] * sn[2 * j + 1];
            oa[j] = cvt_pk(y1a, y1b); ob[j] = cvt_pk(y2a, y2b);
        }
        *(u32x4*)base = oa; *(u32x4*)(base + 32) = ob;
    }
}
__device__ UNIT_INLINE void compress_unit(Frame& F, int unit, int L, const bf16_t* U1, unsigned char* ws) {
    const int nc = unit & 3, kv = (unit >> 2) & 1, g = (unit >> 3) & 1, b = unit >> 4;
    const int n0 = nc * 32, tok0 = n0 * 16;
    LAS bf16_t* tok = (LAS bf16_t*)F.lds;
    LAS bf16_t* hid = (LAS bf16_t*)(F.lds + 528 * 72 * 2);
    const bf16_t* src = U1 + (size_t)(b * SEQ) * UW + UC_NKV + kv * 128 + g * 64;
    __syncthreads();
    for (int i = F.tid; i < 528 * 8; i += 512) { const int r = i >> 3, ch = i & 7; const int t = tok0 + r;
        u32x4 v = (u32x4){0u, 0u, 0u, 0u}; if (t < SEQ) v = *(const u32x4*)(src + (size_t)t * UW + ch * 8);
        *(LAS u32x4*)(tok + r * 72 + ch * 8) = v; }
    __syncthreads();
    const int idx = L * 2 + kv;
    const bf16_t* w1t = (const bf16_t*)(ws + WS_W1T) + (size_t)idx * 64 * 2048;
    const bf16_t* w2t = (const bf16_t*)(ws + WS_W2T) + (size_t)idx * 64 * 64;
    const float* peb = (const float*)(ws + WS_PEB) + idx * 64;
    const int mt = F.wave >> 2, ntile = F.wave & 3, r16 = F.lane & 15, kg = F.lane >> 4;
    f32x4 acc = (f32x4){0.f, 0.f, 0.f, 0.f};
    const int nl = mt * 16 + r16;
    const bf16_t* bp = w1t + (size_t)(ntile * 16 + r16) * 2048 + kg * 8;
#pragma unroll 4
    for (int ks = 0; ks < 64; ++ks) {
        const int l = ks >> 1, db = (ks & 1) * 32 + kg * 8;
        const bf16x8 a = *(const LAS bf16x8*)(tok + (16 * nl + l) * 72 + db);
        const bf16x8 bb = *(const bf16x8*)(bp + ks * 32);
        acc = __builtin_amdgcn_mfma_f32_16x16x32_bf16(a, bb, acc, 0, 0, 0);
    }
    { const int f = ntile * 16 + r16; const float pb = peb[f];
#pragma unroll
      for (int r = 0; r < 4; ++r) hid[(mt * 16 + 4 * kg + r) * 72 + f] = (bf16_t)f2bf(siluf_(acc[r] + pb)); }
    __syncthreads();
    f32x4 o = (f32x4){0.f, 0.f, 0.f, 0.f};
#pragma unroll
    for (int ks = 0; ks < 2; ++ks) {
        const bf16x8 a = *(const LAS bf16x8*)(hid + nl * 72 + ks * 32 + kg * 8);
        const bf16x8 bb = *(const bf16x8*)(w2t + (size_t)(ntile * 16 + r16) * 64 + ks * 32 + kg * 8);
        o = __builtin_amdgcn_mfma_f32_16x16x32_bf16(a, bb, o, 0, 0, 0);
    }
    bf16_t* dst = (bf16_t*)(ws + (kv ? WS_VC : WS_KC)) + (size_t)((b * 2 + g) * 128) * 64;
#pragma unroll
    for (int r = 0; r < 4; ++r) { const int n = n0 + mt * 16 + 4 * kg + r; dst[(size_t)n * 64 + ntile * 16 + r16] = (n < 127) ? (bf16_t)f2bf(o[r]) : (bf16_t)0; }
}

__device__ __forceinline__ int crow(int r, int hi) { return (r & 3) + 8 * (r >> 2) + 4 * hi; }
constexpr int KS_LD = 72;
struct AttnSt { float m, l; f32x16 o0, o1; };
__device__ __forceinline__ void attn_init(AttnSt& s) { s.m = -INFINITY; s.l = 0.f;
#pragma unroll
    for (int r = 0; r < 16; ++r) { s.o0[r] = 0.f; s.o1[r] = 0.f; } }
__device__ __forceinline__ void stage_kv(const bf16_t* Kg, int ldk, const bf16_t* Vg, int ldv, LAS bf16_t* Ks, LAS bf16_t* Vt, int tid) {
    const int key = tid >> 3, ch = tid & 7;
    const u32x4 kv = *(const u32x4*)(Kg + (size_t)key * ldk + ch * 8);
    const u32x4 vv = *(const u32x4*)(Vg + (size_t)key * ldv + ch * 8);
    *(LAS u32x4*)(Ks + key * KS_LD + ch * 8) = kv;
#pragma unroll
    for (int j = 0; j < 4; ++j) { Vt[(ch * 8 + 2 * j) * KS_LD + key] = (bf16_t)(vv[j] & 0xffffu); Vt[(ch * 8 + 2 * j + 1) * KS_LD + key] = (bf16_t)(vv[j] >> 16); }
}
__device__ __forceinline__ void attn_scores(const LAS bf16_t* Ks, const bf16x8 (&qr)[4], f32x16& p0, f32x16& p1, int r32, int hi) {
#pragma unroll
    for (int r = 0; r < 16; ++r) { p0[r] = 0.f; p1[r] = 0.f; }
#pragma unroll
    for (int d0 = 0; d0 < 4; ++d0) {
        const bf16x8 k0 = *(const LAS bf16x8*)(Ks + r32 * KS_LD + d0 * 16 + hi * 8);
        const bf16x8 k1 = *(const LAS bf16x8*)(Ks + (32 + r32) * KS_LD + d0 * 16 + hi * 8);
        p0 = __builtin_amdgcn_mfma_f32_32x32x16_bf16(k0, qr[d0], p0, 0, 0, 0);
        p1 = __builtin_amdgcn_mfma_f32_32x32x16_bf16(k1, qr[d0], p1, 0, 0, 0);
    }
}
__device__ __forceinline__ void attn_pv(const LAS bf16_t* Vt, const f32x16& p0, const f32x16& p1, f32x16& o0, f32x16& o1, int r32, int hi) {
    bf16x8 pa[4];
#pragma unroll
    for (int s = 0; s < 2; ++s) {
        u32x4 w0, w1;
#pragma unroll
        for (int j = 0; j < 4; ++j) { w0[j] = cvt_pk(p0[8 * s + 2 * j], p0[8 * s + 2 * j + 1]); w1[j] = cvt_pk(p1[8 * s + 2 * j], p1[8 * s + 2 * j + 1]); }
        pa[s] = __builtin_bit_cast(bf16x8, w0); pa[2 + s] = __builtin_bit_cast(bf16x8, w1);
    }
#pragma unroll
    for (int s = 0; s < 4; ++s) {
        const int kbase = 16 * s + 4 * hi;
#pragma unroll
        for (int dh = 0; dh < 2; ++dh) {
            const LAS bf16_t* vp = Vt + (32 * dh + r32) * KS_LD + kbase;
            const s16x4 lo = *(const LAS s16x4*)vp, hi4 = *(const LAS s16x4*)(vp + 8);
            const bf16x8 vb = (bf16x8){lo[0], lo[1], lo[2], lo[3], hi4[0], hi4[1], hi4[2], hi4[3]};
            if (dh == 0) o0 = __builtin_amdgcn_mfma_f32_32x32x16_bf16(pa[s], vb, o0, 0, 0, 0);
            else         o1 = __builtin_amdgcn_mfma_f32_32x32x16_bf16(pa[s], vb, o1, 0, 0, 0);
        }
    }
}
__device__ __forceinline__ void attn_online(const LAS bf16_t* Vt, f32x16& x0, f32x16& x1, AttnSt& st, LAS float* wsf, int r32, int hi) {
    float mx = -INFINITY;
#pragma unroll
    for (int r = 0; r < 16; ++r) mx = fmaxf(mx, fmaxf(x0[r], x1[r]));
    mx = fmaxf(mx, __shfl_xor(mx, 32));
    const float mn = fmaxf(st.m, mx), ms = (mn == -INFINITY) ? 0.f : mn;
    const float f = exp2f((st.m - ms) * LOG2E);
    if (hi == 0) wsf[r32] = f;
    float rs = 0.f;
#pragma unroll
    for (int r = 0; r < 16; ++r) { x0[r] = exp2f((x0[r] - ms) * LOG2E); x1[r] = exp2f((x1[r] - ms) * LOG2E); rs += x0[r] + x1[r]; }
    st.l = st.l * f + rs; st.m = mn;
    const LAS float* wr_ = wsf + 4 * hi;
#pragma unroll
    for (int r = 0; r < 16; ++r) { const float fr_ = wr_[(r & 3) + 8 * (r >> 2)]; st.o0[r] *= fr_; st.o1[r] *= fr_; }
    attn_pv(Vt, x0, x1, st.o0, st.o1, r32, hi);
}
__device__ __forceinline__ void attn_scale_rows(f32x16& o0, f32x16& o1, float inv, LAS float* wsf, int r32, int hi) {
    if (hi == 0) wsf[r32] = inv;
    const LAS float* wr_ = wsf + 4 * hi;
#pragma unroll
    for (int r = 0; r < 16; ++r) { const float f = wr_[(r & 3) + 8 * (r >> 2)]; o0[r] *= f; o1[r] *= f; }
}

__device__ UNIT_INLINE void swa_unit(Frame& F, int unit, const bf16_t* U1, bf16_t* Y, const float* sinks) {
    const int qb = unit & 31, g = (unit >> 5) & 1, b = unit >> 6;
    const int r32 = F.lane & 31, hi = F.lane >> 5, hr = F.wave >> 1, qs = F.wave & 1, head = g * 4 + hr;
    const int q0 = qb * 64, tq = q0 + qs * 32 + r32;
    LAS bf16_t* Ks = (LAS bf16_t*)F.lds; LAS bf16_t* Vt = Ks + 64 * KS_LD;
    LAS float* wsf = (LAS float*)(F.lds + 2 * 64 * KS_LD * 2) + F.wave * 32;
    const bf16_t* rowb = U1 + (size_t)(b * SEQ) * UW;
    bf16x8 qr[4];
#pragma unroll
    for (int d0 = 0; d0 < 4; ++d0) qr[d0] = *(const bf16x8*)(rowb + (size_t)tq * UW + UC_SQ + head * 64 + d0 * 16 + hi * 8);
    AttnSt st; attn_init(st);
    for (int kt = (qb >= 2 ? qb - 2 : 0); kt <= qb; ++kt) {
        __syncthreads();
        stage_kv(rowb + (size_t)(kt * 64) * UW + UC_SKV + g * 64, UW, rowb + (size_t)(kt * 64) * UW + UC_SKV + 128 + g * 64, UW, Ks, Vt, F.tid);
        __syncthreads();
        f32x16 x0, x1; attn_scores(Ks, qr, x0, x1, r32, hi);
#pragma unroll
        for (int r = 0; r < 16; ++r) { const int s0 = kt * 64 + crow(r, hi), s1 = s0 + 32;
            x0[r] = (tq - s0 >= 0 && tq - s0 < 128) ? x0[r] * 0.125f : -INFINITY;
            x1[r] = (tq - s1 >= 0 && tq - s1 < 128) ? x1[r] * 0.125f : -INFINITY; }
        attn_online(Vt, x0, x1, st, wsf, r32, hi);
    }
    const float l = st.l + __shfl_xor(st.l, 32), sk = sinks[head];
    const float mf = fmaxf(st.m, sk), a = exp2f((st.m - mf) * LOG2E), inv = a / (l * a + exp2f((sk - mf) * LOG2E));
    attn_scale_rows(st.o0, st.o1, inv, wsf, r32, hi);
    bf16_t* yb = Y + (size_t)(b * SEQ + q0 + qs * 32) * YW + 3 * 512 + head * 64 + r32;
#pragma unroll
    for (int r = 0; r < 16; ++r) { bf16_t* yp = yb + (size_t)crow(r, hi) * YW; yp[0] = (bf16_t)f2bf(st.o0[r]); yp[32] = (bf16_t)f2bf(st.o1[r]); }
}

constexpr int NSA_K1_OFF = 2 * 64 * KS_LD * 2;
constexpr int NSA_PS_OFF = 4 * 64 * KS_LD * 2;
constexpr int NSA_IMP_OFF = NSA_PS_OFF + 64 * 128 * 4;
constexpr int NSA_SEL_OFF = NSA_IMP_OFF + 64 * 33 * 4;
__device__ __forceinline__ float nsa_gate(const float* gbase, int r, int i) { return sigmoidf_(gbase[((r & 3) + 8 * (r >> 2)) * 32 + i * 8]); }
__device__ UNIT_INLINE void nsa_unit(Frame& F, int unit, const bf16_t* U1, bf16_t* Y, const float* misc, const unsigned char* ws) {
    const int qb = 31 - (unit & 31), g = (unit >> 5) & 1, b = unit >> 6;
    const int r32 = F.lane & 31, hi = F.lane >> 5, hr = F.wave >> 1, qs = F.wave & 1, head = g * 4 + hr;
    const int q0 = qb * 64, ql = qs * 32 + r32, tq = q0 + ql;
    LAS bf16_t* Ks = (LAS bf16_t*)F.lds; LAS bf16_t* Vt = Ks + 64 * KS_LD;
    LAS bf16_t* Ks1 = (LAS bf16_t*)(F.lds + NSA_K1_OFF); LAS bf16_t* Vt1 = Ks1 + 64 * KS_LD;
    LAS unsigned* psum = (LAS unsigned*)(F.lds + NSA_PS_OFF);
    LAS float* impb = (LAS float*)(F.lds + NSA_IMP_OFF);
    LAS unsigned* selm = (LAS unsigned*)(F.lds + NSA_SEL_OFF);
    LAS float* wsf = (LAS float*)(F.lds + NSA_SEL_OFF + 256) + F.wave * 32;
    const bf16_t* rowb = U1 + (size_t)(b * SEQ) * UW;
    const int grow = b * SEQ + q0 + qs * 32;
    const float* gbase = misc + (size_t)(grow + 4 * hi) * 32 + 8 + head;
    bf16x8 qr[4];
#pragma unroll
    for (int d0 = 0; d0 < 4; ++d0) qr[d0] = *(const bf16x8*)(rowb + (size_t)tq * UW + UC_NQ + head * 64 + d0 * 16 + hi * 8);
    f32x16 ya0, ya1;
#pragma unroll
    for (int r = 0; r < 16; ++r) { ya0[r] = 0.f; ya1[r] = 0.f; }
    __syncthreads();
    for (int i = F.tid; i < 64 * 128; i += 512) psum[i] = 0u;
#ifndef NSA_NO_CMP
    {
        const bf16_t* kc = (const bf16_t*)(ws + WS_KC) + (size_t)((b * 2 + g) * 128) * 64;
        const bf16_t* vc = (const bf16_t*)(ws + WS_VC) + (size_t)((b * 2 + g) * 128) * 64;
        stage_kv(kc, 64, vc, 64, Ks, Vt, F.tid);
        stage_kv(kc + 64 * 64, 64, vc + 64 * 64, 64, Ks1, Vt1, F.tid);
        __syncthreads();
        float m = -INFINITY, l = 0.f;
#pragma unroll 1
        for (int tl = 0; tl < 2; ++tl) {
            f32x16 x0, x1; attn_scores(tl ? Ks1 : Ks, qr, x0, x1, r32, hi);
            float mx = -INFINITY;
#pragma unroll
            for (int r = 0; r < 16; ++r) { const int n0 = tl * 64 + crow(r, hi), n1 = n0 + 32;
                x0[r] = (16 * n0 + 31 <= tq) ? x0[r] * 0.125f : -INFINITY; x1[r] = (16 * n1 + 31 <= tq) ? x1[r] * 0.125f : -INFINITY; mx = fmaxf(mx, fmaxf(x0[r], x1[r])); }
            mx = fmaxf(mx, __shfl_xor(mx, 32));
            const float mn = fmaxf(m, mx), ms = (mn == -INFINITY) ? 0.f : mn;
            float rs = 0.f;
#pragma unroll
            for (int r = 0; r < 16; ++r) rs += exp2f((x0[r] - ms) * LOG2E) + exp2f((x1[r] - ms) * LOG2E);
            l = l * exp2f((m - ms) * LOG2E) + rs; m = mn;
        }
        l += __shfl_xor(l, 32);
        const float inv = l > 0.f ? 1.0f / l : 0.f, ms = (m == -INFINITY) ? 0.f : m;
        f32x16 oc0, oc1;
#pragma unroll
        for (int r = 0; r < 16; ++r) { oc0[r] = 0.f; oc1[r] = 0.f; }
#pragma unroll 1
        for (int tl = 0; tl < 2; ++tl) {
            f32x16 x0, x1; attn_scores(tl ? Ks1 : Ks, qr, x0, x1, r32, hi);
#pragma unroll
            for (int r = 0; r < 16; ++r) { const int n0 = tl * 64 + crow(r, hi), n1 = n0 + 32;
                x0[r] = (16 * n0 + 31 <= tq) ? exp2f((x0[r] * 0.125f - ms) * LOG2E) * inv : 0.f;
                x1[r] = (16 * n1 + 31 <= tq) ? exp2f((x1[r] * 0.125f - ms) * LOG2E) * inv : 0.f;
                atomicAdd((unsigned*)(psum + ql * 128 + n0), (unsigned)(x0[r] * 16777216.0f + 0.5f)); atomicAdd((unsigned*)(psum + ql * 128 + n1), (unsigned)(x1[r] * 16777216.0f + 0.5f)); }
            attn_pv(tl ? Vt1 : Vt, x0, x1, oc0, oc1, r32, hi);
        }
#pragma unroll
        for (int r = 0; r < 16; ++r) { const float gt = nsa_gate(gbase, r, 0); ya0[r] += gt * oc0[r]; ya1[r] += gt * oc1[r]; }
    }
#endif
    __syncthreads();
#ifndef NSA_NO_TOPK
    if (qb <= 7) { if (F.tid < 64) selm[F.tid] = (2u << qb) - 1u; }
    else {
        const int q = F.tid & 63, jg = F.tid >> 6;
#pragma unroll
        for (int jj = 0; jj < 4; ++jj) { const int j = jg * 4 + jj; unsigned sacc = 0u;
#pragma unroll
            for (int d = -1; d <= 3; ++d) { const int n = 4 * j + d; if (n >= 0 && n < 127) sacc += psum[q * 128 + n]; }
            impb[q * 33 + j] = (float)sacc; }
        if (jg == 0) selm[q] = 1u | (1u << qb);
        __syncthreads();
        unsigned bits = 0u;
#pragma unroll 1
        for (int jj = 0; jj < 4; ++jj) { const int j = jg * 4 + jj;
            if (j >= 1 && j < qb) { const float vj = impb[q * 33 + j]; int rank = 0;
#pragma unroll 1
                for (int i2 = 1; i2 < qb; ++i2) { const float vi = impb[q * 33 + i2]; rank += (vi > vj || (vi == vj && i2 < j)) ? 1 : 0; }
                if (rank < 6) bits |= 1u << j; } }
        if (bits) atomicOr((unsigned*)(selm + q), bits);
    }
#endif
    __syncthreads();
    unsigned uni;
    { unsigned v = selm[F.lane];
#pragma unroll
      for (int o = 1; o < 64; o <<= 1) v |= __shfl_xor(v, o);
      uni = __builtin_amdgcn_readfirstlane(v); }
    const unsigned mysel = selm[ql];
#pragma unroll 1
    for (int br = 0; br < 2; ++br) {
        const unsigned lowm = (qb >= 8) ? ~((1u << (qb - 8)) - 1u) : 0xffffffffu;
        const unsigned tmask = (br == 0) ? uni : (((2u << qb) - 1u) & lowm);
        const unsigned qsel = (br == 0) ? mysel : 0xffffffffu;
        const int wlim = (br == 0) ? (1 << 30) : 512;
        const int kcol = UC_NKV + (2 + 2 * br) * 128 + g * 64;
        AttnSt st; attn_init(st);
#pragma unroll 1
        for (int j = 0; j <= qb; ++j) {
            if (!((tmask >> j) & 1u)) continue;
            __syncthreads();
            stage_kv(rowb + (size_t)(j * 64) * UW + kcol, UW, rowb + (size_t)(j * 64) * UW + kcol + 128, UW, Ks, Vt, F.tid);
            __syncthreads();
            f32x16 x0, x1; attn_scores(Ks, qr, x0, x1, r32, hi);
            const bool sel = (qsel >> j) & 1u;
#pragma unroll
            for (int r = 0; r < 16; ++r) { const int d0 = tq - (j * 64 + crow(r, hi)), d1 = d0 - 32;
                x0[r] = (sel && d0 >= 0 && d0 < wlim) ? x0[r] * 0.125f : -INFINITY; x1[r] = (sel && d1 >= 0 && d1 < wlim) ? x1[r] * 0.125f : -INFINITY; }
            attn_online(Vt, x0, x1, st, wsf, r32, hi);
        }
        const float l = st.l + __shfl_xor(st.l, 32), inv = l > 0.f ? 1.0f / l : 0.f;
        attn_scale_rows(st.o0, st.o1, inv, wsf, r32, hi);
#pragma unroll
        for (int r = 0; r < 16; ++r) { const float gt = nsa_gate(gbase, r, 1 + br); ya0[r] += gt * st.o0[r]; ya1[r] += gt * st.o1[r]; }
    }
    bf16_t* yb = Y + (size_t)grow * YW + 1 * 512 + head * 64 + r32;
#pragma unroll
    for (int r = 0; r < 16; ++r) { bf16_t* yp = yb + (size_t)crow(r, hi) * YW; yp[0] = (bf16_t)f2bf(ya0[r]); yp[32] = (bf16_t)f2bf(ya1[r]); }
}

constexpr int SL = 136;
constexpr int SSD_CS = 0, SSD_BS = SSD_CS + 128 * SL * 2, SSD_BT = SSD_BS + 128 * SL * 2, SSD_XT = SSD_BT + 128 * SL * 2, SSD_PV = SSD_XT + 64 * SL * 2,
              SSD_DT = SSD_PV + 64 * SL * 2, SSD_AC = SSD_DT + 512, SSD_A = SSD_AC + 512, SSD_END = SSD_A + 512;
static_assert(SSD_END <= LDS_USER, "ssd lds");
__device__ UNIT_INLINE void ssd_unit(Frame& F, int unit, int L, KArgs KA, const bf16_t* U1, bf16_t* Y, const float* misc, float* ssq) {
    const int h = unit & 7, b = unit >> 3, g = h >> 2;
    LAS bf16_t* Cs = (LAS bf16_t*)(F.lds + SSD_CS); LAS bf16_t* Bs = (LAS bf16_t*)(F.lds + SSD_BS); LAS bf16_t* Bt = (LAS bf16_t*)(F.lds + SSD_BT);
    LAS bf16_t* Xt = (LAS bf16_t*)(F.lds + SSD_XT); LAS bf16_t* Pv = (LAS bf16_t*)(F.lds + SSD_PV);
    LAS float* dts = (LAS float*)(F.lds + SSD_DT); LAS float* acs = (LAS float*)(F.lds + SSD_AC); LAS float* as_ = (LAS float*)(F.lds + SSD_A);
    const float* cw = IN_F(5) + (size_t)L * 4 * 1024; const float* cb = IN_F(6) + (size_t)L * 1024;
    const float dtb = IN_F(7)[L * 8 + h], Ah = -expf(IN_F(8)[L * 8 + h]), Dh = IN_F(9)[L * 8 + h];
    const int r16 = F.lane & 15, kg = F.lane >> 4, w = F.wave;
    const bf16_t* rowb = U1 + (size_t)(b * SEQ) * UW;
    f32x4 stt[4];
#pragma unroll
    for (int j = 0; j < 4; ++j) stt[j] = (f32x4){0.f, 0.f, 0.f, 0.f};
    __syncthreads();
    for (int i = F.tid; i < 64 * SL / 2; i += 512) ((LAS unsigned*)Pv)[i] = 0u;
    for (int c = 0; c < 16; ++c) {
        const int t0 = c * 128;
        __syncthreads();
        for (int i = F.tid; i < 40 * 128; i += 512) {
            const int ch = i % 40, l = i / 40;
            const int cidx = (ch < 8) ? (h * 64 + ch * 8) : (ch < 24 ? 512 + g * 128 + (ch - 8) * 8 : 768 + g * 128 + (ch - 24) * 8);
            float a8[8];
            { const f32x4 b0 = *(const f32x4*)(cb + cidx), b1 = *(const f32x4*)(cb + cidx + 4);
#pragma unroll
              for (int j = 0; j < 4; ++j) { a8[j] = b0[j]; a8[4 + j] = b1[j]; } }
#pragma unroll
            for (int k = 0; k < 4; ++k) {
                const int t = t0 + l - 3 + k;
                if (t >= 0) {
                    const u32x4 xv = *(const u32x4*)(rowb + (size_t)t * UW + UC_XBC + cidx);
                    const f32x4 w0 = *(const f32x4*)(cw + k * 1024 + cidx), w1 = *(const f32x4*)(cw + k * 1024 + cidx + 4);
#pragma unroll
                    for (int j = 0; j < 4; ++j) { a8[2 * j] += bf2f(xv[j] & 0xffffu) * (j < 2 ? w0[2 * j] : w1[2 * j - 4]); a8[2 * j + 1] += bf2f(xv[j] >> 16) * (j < 2 ? w0[2 * j + 1] : w1[2 * j - 3]); }
                }
            }
            unsigned short o[8];
#pragma unroll
            for (int j = 0; j < 8; ++j) o[j] = (unsigned short)f2bf(siluf_(a8[j]));
            if (ch < 8) {
#pragma unroll
                for (int j = 0; j < 8; ++j) Xt[(ch * 8 + j) * SL + l] = o[j];
            } else if (ch < 24) {
                const int n0 = (ch - 8) * 8;
                u32x4 pk; pk.x = o[0] | ((unsigned)o[1] << 16); pk.y = o[2] | ((unsigned)o[3] << 16); pk.z = o[4] | ((unsigned)o[5] << 16); pk.w = o[6] | ((unsigned)o[7] << 16);
                *(LAS u32x4*)(Bs + l * SL + n0) = pk;
#pragma unroll
                for (int j = 0; j < 8; ++j) Bt[(n0 + j) * SL + l] = o[j];
            } else {
                const int n0 = (ch - 24) * 8;
                u32x4 pk; pk.x = o[0] | ((unsigned)o[1] << 16); pk.y = o[2] | ((unsigned)o[3] << 16); pk.z = o[4] | ((unsigned)o[5] << 16); pk.w = o[6] | ((unsigned)o[7] << 16);
                *(LAS u32x4*)(Cs + l * SL + n0) = pk;
            }
        }
        if (F.tid < 128) { const float dt = softplusf_(misc[(size_t)(b * SEQ + t0 + F.tid) * 32 + h] + dtb); dts[F.tid] = dt; as_[F.tid] = dt * Ah; }
        __syncthreads();
        if (F.tid < 128) { float s = 0.f; for (int j = 0; j <= F.tid; ++j) s += as_[j]; acs[F.tid] = s; }
        __syncthreads();
        f32x4 cbv[8];
#pragma unroll
        for (int j = 0; j < 8; ++j) cbv[j] = (f32x4){0.f, 0.f, 0.f, 0.f};
#pragma unroll
        for (int ks = 0; ks < 4; ++ks) {
            const bf16x8 a = *(const LAS bf16x8*)(Cs + (16 * w + r16) * SL + ks * 32 + kg * 8);
#pragma unroll
            for (int j = 0; j < 8; ++j) { const bf16x8 bb = *(const LAS bf16x8*)(Bs + (16 * j + r16) * SL + ks * 32 + kg * 8); cbv[j] = __builtin_amdgcn_mfma_f32_16x16x32_bf16(a, bb, cbv[j], 0, 0, 0); }
        }
        __syncthreads();
        LAS bf16_t* Ws = Bs;
#pragma unroll
        for (int j = 0; j < 8; ++j)
#pragma unroll
            for (int r = 0; r < 4; ++r) { const int l = 16 * w + 4 * kg + r, s = 16 * j + r16;
                const float wv = (s <= l) ? cbv[j][r] * __expf(acs[l] - acs[s]) * dts[s] : 0.f;
                Ws[l * SL + s] = (bf16_t)f2bf(wv); }
        __syncthreads();
        f32x4 yd[4], yo[4];
#pragma unroll
        for (int j = 0; j < 4; ++j) { yd[j] = (f32x4){0.f, 0.f, 0.f, 0.f}; yo[j] = (f32x4){0.f, 0.f, 0.f, 0.f}; }
#pragma unroll
        for (int ks = 0; ks < 4; ++ks) {
            const bf16x8 aw = *(const LAS bf16x8*)(Ws + (16 * w + r16) * SL + ks * 32 + kg * 8);
            const bf16x8 ac = *(const LAS bf16x8*)(Cs + (16 * w + r16) * SL + ks * 32 + kg * 8);
#pragma unroll
            for (int j = 0; j < 4; ++j) {
                const bf16x8 bx = *(const LAS bf16x8*)(Xt + (16 * j + r16) * SL + ks * 32 + kg * 8);
                const bf16x8 bp = *(const LAS bf16x8*)(Pv + (16 * j + r16) * SL + ks * 32 + kg * 8);
                yd[j] = __builtin_amdgcn_mfma_f32_16x16x32_bf16(aw, bx, yd[j], 0, 0, 0);
                yo[j] = __builtin_amdgcn_mfma_f32_16x16x32_bf16(ac, bp, yo[j], 0, 0, 0);
            }
        }
#pragma unroll
        for (int r = 0; r < 4; ++r) {
            const int l = 16 * w + 4 * kg + r; const float ea = __expf(acs[l]); const size_t trow = (size_t)(b * SEQ + t0 + l);
            float sq = 0.f;
#pragma unroll
            for (int j = 0; j < 4; ++j) { const int p = 16 * j + r16;
                const float x = bf2f(Xt[p * SL + l]);
                const float z = bf2f(rowb[(size_t)(t0 + l) * UW + UC_Z + h * 64 + p]);
                const float yv = (yd[j][r] + yo[j][r] * ea + Dh * x) * siluf_(z);
                sq += yv * yv;
                Y[trow * YW + h * 64 + p] = (bf16_t)f2bf(yv); }
            sq += __shfl_xor(sq, 1); sq += __shfl_xor(sq, 2); sq += __shfl_xor(sq, 4); sq += __shfl_xor(sq, 8);
            if (r16 == 0) ssq[trow * 8 + h] = sq;
        }
        __syncthreads();
        { const float aend = acs[127];
          for (int i = F.tid; i < 64 * 128; i += 512) { const int p = i >> 7, l = i & 127; Xt[p * SL + l] = (bf16_t)f2bf(bf2f(Xt[p * SL + l]) * dts[l] * __expf(aend - acs[l])); } }
        __syncthreads();
        { const float cd = __expf(acs[127]); const int pt = w & 3;
#pragma unroll
          for (int j = 0; j < 4; ++j) stt[j] *= cd;
#pragma unroll
          for (int ks = 0; ks < 4; ++ks) {
              const bf16x8 a = *(const LAS bf16x8*)(Xt + (16 * pt + r16) * SL + ks * 32 + kg * 8);
#pragma unroll
              for (int j = 0; j < 4; ++j) { const int nt = (w >> 2) * 4 + j; const bf16x8 bb = *(const LAS bf16x8*)(Bt + (16 * nt + r16) * SL + ks * 32 + kg * 8);
                  stt[j] = __builtin_amdgcn_mfma_f32_16x16x32_bf16(a, bb, stt[j], 0, 0, 0); }
          }
#pragma unroll
          for (int j = 0; j < 4; ++j) { const int nt = (w >> 2) * 4 + j;
#pragma unroll
              for (int r = 0; r < 4; ++r) Pv[(16 * pt + 4 * kg + r) * SL + 16 * nt + r16] = (bf16_t)f2bf(stt[j][r]); }
        }
    }
}

constexpr int RW_CT = 32;
constexpr int RW_R = 0, RW_K = 8192, RW_V = 16384, RW_DEC = 24576, RW_NB = 32768, RW_CC = 40960, RW_G = 49152, RW_OUT = 57344, RW_WD = 65536, RW_AD = 73728, RW_GD = 81920, RW_BS = 98304, RW_END = RW_BS + 128;
__device__ UNIT_INLINE void rwkv_unit(Frame& F, int unit, int L, KArgs KA, const bf16_t* U1, bf16_t* Y) {
    const int h = unit & 7, b = unit >> 3;
    LAS float* sR = (LAS float*)(F.lds + RW_R); LAS float* sK = (LAS float*)(F.lds + RW_K); LAS float* sV = (LAS float*)(F.lds + RW_V);
    LAS float* sDEC = (LAS float*)(F.lds + RW_DEC); LAS float* sNB = (LAS float*)(F.lds + RW_NB); LAS float* sCC = (LAS float*)(F.lds + RW_CC);
    LAS float* sG = (LAS float*)(F.lds + RW_G); LAS float* sOUT = (LAS float*)(F.lds + RW_OUT);
    LAS float* sWD = (LAS float*)(F.lds + RW_WD); LAS float* sAD = (LAS float*)(F.lds + RW_AD); LAS float* sGD = (LAS float*)(F.lds + RW_GD); LAS float* sBS = (LAS float*)(F.lds + RW_BS);
    const float* mu = IN_F(14) + (size_t)L * 1792;
    const float* w_up = IN_F(16) + (size_t)L * 64 * 512 + h * 64; const float* a_up = IN_F(18) + (size_t)L * 64 * 512 + h * 64; const float* g_up = IN_F(19) + (size_t)L * 128 * 512 + h * 64;
    const int c = F.lane, tg = F.wave, hc = h * 64 + c;
    const float w0 = IN_F(15)[L * 512 + hc], a0 = IN_F(17)[L * 512 + hc], k_k = IN_F(20)[L * 512 + hc], k_a = IN_F(21)[L * 512 + hc], r_k = IN_F(22)[L * 512 + hc];
    const float ln_w = IN_F(23)[L * 512 + hc], ln_b = IN_F(24)[L * 512 + hc];
    const bf16_t* rowb = U1 + (size_t)(b * SEQ) * UW + UC_RW;
    const int sv = F.tid >> 3, kq = F.tid & 7;
    float st[8];
#pragma unroll
    for (int j = 0; j < 8; ++j) st[j] = 0.f;
    for (int ck = 0; ck < SEQ / RW_CT; ++ck) {
        const int t0 = ck * RW_CT;
        __syncthreads();
        for (int i = F.tid; i < RW_CT * 56; i += 512) {
            const int ti = i / 56, ch = i % 56; const int t = t0 + ti;
            int col; LAS float* dst; int kind;
            if (ch < 8) { col = hc - c + ch * 8; dst = sR + ti * 64 + ch * 8; kind = 0; }
            else if (ch < 16) { col = 512 + h * 64 + (ch - 8) * 8; dst = sK + ti * 64 + (ch - 8) * 8; kind = 0; }
            else if (ch < 24) { col = 1024 + h * 64 + (ch - 16) * 8; dst = sV + ti * 64 + (ch - 16) * 8; kind = 0; }
            else if (ch < 32) { col = 1536 + (ch - 24) * 8; dst = sWD + ti * 64 + (ch - 24) * 8; kind = 1; }
            else if (ch < 40) { col = 1600 + (ch - 32) * 8; dst = sAD + ti * 64 + (ch - 32) * 8; kind = 0; }
            else { col = 1664 + (ch - 40) * 8; dst = sGD + ti * 128 + (ch - 40) * 8; kind = 2; }
            const u32x4 cur = *(const u32x4*)(rowb + (size_t)t * UW + col);
            u32x4 prv = (u32x4){0u, 0u, 0u, 0u}; if (t > 0) prv = *(const u32x4*)(rowb + (size_t)(t - 1) * UW + col);
            const f32x4 m0 = *(const f32x4*)(mu + col), m1 = *(const f32x4*)(mu + col + 4);
#pragma unroll
            for (int j = 0; j < 4; ++j) {
                const float x0 = bf2f(cur[j] & 0xffffu), x1 = bf2f(cur[j] >> 16), p0 = bf2f(prv[j] & 0xffffu), p1 = bf2f(prv[j] >> 16);
                float y0 = x0 + (p0 - x0) * (j < 2 ? m0[2 * j] : m1[2 * j - 4]), y1 = x1 + (p1 - x1) * (j < 2 ? m0[2 * j + 1] : m1[2 * j - 3]);
                if (kind == 1) { y0 = tanhf(y0); y1 = tanhf(y1); } else if (kind == 2) { y0 = sigmoidf_(y0); y1 = sigmoidf_(y1); }
                dst[2 * j] = y0; dst[2 * j + 1] = y1;
            }
        }
        __syncthreads();
        {
            float wa[4], aa[4], ga[4];
#pragma unroll
            for (int q = 0; q < 4; ++q) { wa[q] = w0; aa[q] = a0; ga[q] = 0.f; }
            for (int j = 0; j < 64; ++j) { const float wu = w_up[(size_t)j * 512 + c], au = a_up[(size_t)j * 512 + c];
#pragma unroll
                for (int q = 0; q < 4; ++q) { wa[q] += sWD[(tg * 4 + q) * 64 + j] * wu; aa[q] += sAD[(tg * 4 + q) * 64 + j] * au; } }
            for (int j = 0; j < 128; ++j) { const float gu = g_up[(size_t)j * 512 + c];
#pragma unroll
                for (int q = 0; q < 4; ++q) ga[q] += sGD[(tg * 4 + q) * 128 + j] * gu; }
#pragma unroll
            for (int q = 0; q < 4; ++q) {
                const int ti = tg * 4 + q;
                const float wv = -softplusf_(-wa[q]) - 0.5f; const float dec = expf(-expf(wv));
                const float a = sigmoidf_(aa[q]);
                const float kraw = sK[ti * 64 + c], rr = sR[ti * 64 + c];
                const float kk = kraw * k_k; const float nrm = fmaxf(sqrtf(wave_sum(kk * kk)), 1e-12f); const float kkn = kk / nrm;
                const float k2 = kraw * (1.0f + (a - 1.0f) * k_a);
                const float bs = wave_sum(rr * k2 * r_k);
                sDEC[ti * 64 + c] = dec; sNB[ti * 64 + c] = -kkn; sCC[ti * 64 + c] = kkn * a; sG[ti * 64 + c] = ga[q];
                if (c == 0) sBS[ti] = bs;
                sK[ti * 64 + c] = k2;
            }
        }
        __syncthreads();
        for (int ti = 0; ti < RW_CT; ++ti) {
            const f32x4 nb0 = *(const LAS f32x4*)(sNB + ti * 64 + kq * 8), nb1 = *(const LAS f32x4*)(sNB + ti * 64 + kq * 8 + 4);
            const f32x4 dc0 = *(const LAS f32x4*)(sDEC + ti * 64 + kq * 8), dc1 = *(const LAS f32x4*)(sDEC + ti * 64 + kq * 8 + 4);
            const f32x4 cc0 = *(const LAS f32x4*)(sCC + ti * 64 + kq * 8), cc1 = *(const LAS f32x4*)(sCC + ti * 64 + kq * 8 + 4);
            const f32x4 kk0 = *(const LAS f32x4*)(sK + ti * 64 + kq * 8), kk1 = *(const LAS f32x4*)(sK + ti * 64 + kq * 8 + 4);
            const f32x4 rr0 = *(const LAS f32x4*)(sR + ti * 64 + kq * 8), rr1 = *(const LAS f32x4*)(sR + ti * 64 + kq * 8 + 4);
            const float vv = sV[ti * 64 + sv];
            float sa = (st[0] * nb0[0] + st[1] * nb0[1]) + (st[2] * nb0[2] + st[3] * nb0[3]) + (st[4] * nb1[0] + st[5] * nb1[1]) + (st[6] * nb1[2] + st[7] * nb1[3]);
            sa += __shfl_xor(sa, 1); sa += __shfl_xor(sa, 2); sa += __shfl_xor(sa, 4);
#pragma unroll
            for (int j = 0; j < 4; ++j) { st[j] = st[j] * dc0[j] + (sa * cc0[j] + vv * kk0[j]); st[4 + j] = st[4 + j] * dc1[j] + (sa * cc1[j] + vv * kk1[j]); }
            float o = (st[0] * rr0[0] + st[1] * rr0[1]) + (st[2] * rr0[2] + st[3] * rr0[3]) + (st[4] * rr1[0] + st[5] * rr1[1]) + (st[6] * rr1[2] + st[7] * rr1[3]);
            o += __shfl_xor(o, 1); o += __shfl_xor(o, 2); o += __shfl_xor(o, 4);
            if (kq == 0) sOUT[ti * 64 + sv] = o;
        }
        __syncthreads();
#pragma unroll
        for (int q = 0; q < 4; ++q) {
            const int ti = tg * 4 + q; const float o = sOUT[ti * 64 + c];
            const float mean = wave_sum(o) * (1.0f / 64.0f); const float d = o - mean; const float var = wave_sum(d * d) * (1.0f / 64.0f);
            float y = d * rsqrtf(var + 64e-5f) * ln_w + ln_b;
            y += sBS[ti] * sV[ti * 64 + c];
            y *= sG[ti * 64 + c];
            Y[(size_t)(b * SEQ + t0 + ti) * YW + 2 * 512 + hc] = (bf16_t)f2bf(y);
        }
    }
}

__device__ UNIT_INLINE void ssd_fixup_and_pb(Frame& F, int L, KArgs KA, bf16_t* Y, const float* ssq, bf16_t* PB) {
    const int gt = F.bid * 512 + F.tid, NT = F.G * 512;
    const float* nw = IN_F(10) + (size_t)L * 512;
    for (int i = gt; i < T * 64; i += NT) {
        const int t = i >> 6, ch = i & 63, g = ch >> 5;
        const f32x4 q = *(const f32x4*)(ssq + (size_t)t * 8 + g * 4);
        const float rs = rsqrtf(((q[0] + q[1]) + (q[2] + q[3])) * (1.0f / 256.0f) + NORM_EPS);
        bf16_t* yp = Y + (size_t)t * YW + ch * 8;
        const u32x4 v = *(const u32x4*)yp; const f32x4 n0 = *(const f32x4*)(nw + ch * 8), n1 = *(const f32x4*)(nw + ch * 8 + 4);
        u32x4 o;
        o.x = cvt_pk(bf2f(v.x & 0xffffu) * rs * n0[0], bf2f(v.x >> 16) * rs * n0[1]); o.y = cvt_pk(bf2f(v.y & 0xffffu) * rs * n0[2], bf2f(v.y >> 16) * rs * n0[3]);
        o.z = cvt_pk(bf2f(v.z & 0xffffu) * rs * n1[0], bf2f(v.z >> 16) * rs * n1[1]); o.w = cvt_pk(bf2f(v.w & 0xffffu) * rs * n1[2], bf2f(v.w >> 16) * rs * n1[3]);
        *(u32x4*)yp = o;
    }
    const float* p = IN_F(1) + (size_t)L * T * PLE;
    for (int i = gt; i < T * PLE / 8; i += NT) {
        const f32x4 a = *(const f32x4*)(p + (size_t)i * 8), b = *(const f32x4*)(p + (size_t)i * 8 + 4);
        u32x4 o; o.x = cvt_pk(a[0], a[1]); o.y = cvt_pk(a[2], a[3]); o.z = cvt_pk(b[0], b[1]); o.w = cvt_pk(b[2], b[3]);
        *(u32x4*)(PB + (size_t)i * 8) = o;
    }
}
__device__ UNIT_INLINE void moe_router(Frame& F, KArgs KA, const float* xo, unsigned* cnt, int* toke, int* tokp, float* tokw) {
    const int gw = F.bid * 8 + F.wave, NGW = F.G * 8;
    const float* gff = IN_F(31) + DM; const float* router = IN_F(35);
    for (int m = gw; m < T; m += NGW) {
        const f32x4* xr = (const f32x4*)(xo + (size_t)m * DM) + F.lane; f32x4 v[4]; float s = 0.f;
#pragma unroll
        for (int j = 0; j < 4; ++j) { v[j] = xr[64 * j]; s += (v[j][0] * v[j][0] + v[j][1] * v[j][1]) + (v[j][2] * v[j][2] + v[j][3] * v[j][3]); }
        const float rstd = rsqrtf(wave_sum(s) * (1.0f / DM) + NORM_EPS);
        float lg[8];
#pragma unroll
        for (int e = 0; e < 8; ++e) lg[e] = 0.f;
#pragma unroll
        for (int j = 0; j < 4; ++j) { const f32x4 gg = *((const f32x4*)gff + F.lane + 64 * j);
#pragma unroll
            for (int i = 0; i < 4; ++i) { const int k = 4 * F.lane + 256 * j + i; const float hv = v[j][i] * rstd * gg[i];
                const f32x4 r0 = *(const f32x4*)(router + (size_t)k * 8), r1 = *(const f32x4*)(router + (size_t)k * 8 + 4);
                lg[0] += hv * r0[0]; lg[1] += hv * r0[1]; lg[2] += hv * r0[2]; lg[3] += hv * r0[3]; lg[4] += hv * r1[0]; lg[5] += hv * r1[1]; lg[6] += hv * r1[2]; lg[7] += hv * r1[3]; } }
#pragma unroll
        for (int e = 0; e < 8; ++e) lg[e] = wave_sum(lg[e]);
        if (F.lane == 0) {
            int e1 = 0; float v1 = lg[0];
#pragma unroll
            for (int e = 1; e < 8; ++e) if (lg[e] > v1) { v1 = lg[e]; e1 = e; }
            int e2 = -1; float v2 = -INFINITY;
#pragma unroll
            for (int e = 0; e < 8; ++e) if (e != e1 && lg[e] > v2) { v2 = lg[e]; e2 = e; }
            const float ex = __expf(v2 - v1), w1 = 1.0f / (1.0f + ex), w2 = ex / (1.0f + ex);
            const int p1 = (int)atomicAdd(cnt + 64 * e1, 1u), p2 = (int)atomicAdd(cnt + 64 * e2, 1u);
            toke[2 * m] = e1; toke[2 * m + 1] = e2; tokp[2 * m] = p1; tokp[2 * m + 1] = p2; tokw[2 * m] = w1; tokw[2 * m + 1] = w2;
        }
    }
}
__device__ __forceinline__ void moe_tables(const unsigned* cnt, MoeTables& mt, int (&c)[8]) {
#pragma unroll
    for (int e = 0; e < 8; ++e) c[e] = (int)__hip_atomic_load(cnt + 64 * e, RLX_AGENT);
    int ps = 0;
    ps += (c[0] + 255) & ~255; mt.ps1 = ps; ps += (c[1] + 255) & ~255; mt.ps2 = ps; ps += (c[2] + 255) & ~255; mt.ps3 = ps; ps += (c[3] + 255) & ~255; mt.ps4 = ps;
    ps += (c[4] + 255) & ~255; mt.ps5 = ps; ps += (c[5] + 255) & ~255; mt.ps6 = ps; ps += (c[6] + 255) & ~255; mt.ps7 = ps; ps += (c[7] + 255) & ~255; mt.ps8 = ps;
}
__device__ __forceinline__ int moe_pstart(const MoeTables& mt, int e) {
    return e == 0 ? 0 : e == 1 ? mt.ps1 : e == 2 ? mt.ps2 : e == 3 ? mt.ps3 : e == 4 ? mt.ps4 : e == 5 ? mt.ps5 : e == 6 ? mt.ps6 : mt.ps7;
}
__device__ UNIT_INLINE void moe_slots(Frame& F, const float* xo, const float* ss2, const unsigned* cnt, const int* toke, const int* tokp, int* toks, bf16_t* XG, float* srstd) {
    const int gw = F.bid * 8 + F.wave, NGW = F.G * 8;
    MoeTables mt; int c[8]; moe_tables(cnt, mt, c);
    for (int m = gw; m < T; m += NGW) {
        const f32x4* xr = (const f32x4*)(xo + (size_t)m * DM) + F.lane; u32x2 pk[4];
#pragma unroll
        for (int j = 0; j < 4; ++j) pk[j] = pack4(xr[64 * j]);
        const float rs = rstd_of(ss2, m);
#pragma unroll
        for (int k = 0; k < 2; ++k) {
            const int e = toke[2 * m + k], slot = moe_pstart(mt, e) + tokp[2 * m + k];
            u32x2* o = (u32x2*)(XG + (size_t)slot * DM) + F.lane;
#pragma unroll
            for (int j = 0; j < 4; ++j) o[64 * j] = pk[j];
            if (F.lane == 0) { toks[2 * m + k] = slot; srstd[slot] = rs; }
        }
    }
    for (int idx = gw; idx < 8 * 256; idx += NGW) {
        const int e = idx >> 8, r = idx & 255;
        int ce = 0;
#pragma unroll
        for (int q = 0; q < 8; ++q) if (q == e) ce = c[q];
        const int row = moe_pstart(mt, e) + ce + r, end = (e == 7) ? mt.ps8 : moe_pstart(mt, e + 1);
        if (row < end) { u32x2* o = (u32x2*)(XG + (size_t)row * DM) + F.lane;
#pragma unroll
            for (int j = 0; j < 4; ++j) o[64 * j] = (u32x2){0u, 0u};
            if (F.lane == 0) srstd[row] = 0.f; }
    }
}
__device__ UNIT_INLINE void moe_combine(Frame& F, float* xo, const bf16_t* YB, const int* toks, const float* tokw, bf16_t* XB2) {
    const int gw = F.bid * 8 + F.wave, NGW = F.G * 8;
    for (int m = gw; m < T; m += NGW) {
        const int s0 = toks[2 * m], s1 = toks[2 * m + 1]; const float w0 = tokw[2 * m], w1 = tokw[2 * m + 1];
        f32x4* xr = (f32x4*)(xo + (size_t)m * DM) + F.lane; const u32x2* y0 = (const u32x2*)(YB + (size_t)s0 * DM) + F.lane; const u32x2* y1 = (const u32x2*)(YB + (size_t)s1 * DM) + F.lane;
        u32x2* xb = (u32x2*)(XB2 + (size_t)m * DM) + F.lane;
#pragma unroll
        for (int j = 0; j < 4; ++j) { const f32x4 v = xr[64 * j] + (unpack4(y0[64 * j]) * w0 + unpack4(y1[64 * j]) * w1); xr[64 * j] = v; xb[64 * j] = pack4(v); }
    }
}
__device__ UNIT_INLINE void final_norm(Frame& F, KArgs KA, float* xo) {
    const int gw = F.bid * 8 + F.wave, NGW = F.G * 8; const float* gf = IN_F(41);
    for (int m = gw; m < T; m += NGW) {
        f32x4* xr = (f32x4*)(xo + (size_t)m * DM) + F.lane; f32x4 v[4]; float s = 0.f;
#pragma unroll
        for (int j = 0; j < 4; ++j) { v[j] = xr[64 * j]; s += (v[j][0] * v[j][0] + v[j][1] * v[j][1]) + (v[j][2] * v[j][2] + v[j][3] * v[j][3]); }
        const float rstd = rsqrtf(wave_sum(s) * (1.0f / DM) + NORM_EPS);
#pragma unroll
        for (int j = 0; j < 4; ++j) xr[64 * j] = v[j] * rstd * *((const f32x4*)gf + F.lane + 64 * j);
    }
}

constexpr int NPH = 23;
__device__ __forceinline__ unsigned char* opq(unsigned char* p) { asm volatile("" : "+s"(p)); return p; }
__global__ void __launch_bounds__(512, 2) mega_fwd(Args args) {
    extern __shared__ __attribute__((aligned(16))) unsigned char lds_raw[];
    Frame F;
    F.lds = (LAS unsigned char*)lds_raw; F.tid = threadIdx.x; F.lane = F.tid & 63; F.wave = __builtin_amdgcn_readfirstlane(F.tid >> 6);
    F.G = gridDim.x; F.bid = blockIdx.x; F.ws = nullptr; F.ctl = nullptr;
    const int lo = args.ph_lo, hi = args.ph_hi;
    LAS unsigned* s_uid = (LAS unsigned*)(F.lds + LDS_USER + 64);
#if MK_MULTI
#define GSYNC(k) do {} while (0)
#else
#define GSYNC(k) do { if ((k) + 1 < hi) { cg::this_grid().sync(); } } while (0)
#endif
#ifdef ONLY_PH
#define RUN(k) ((k) == ONLY_PH)
#else
#define RUN(k) (lo <= (k) && (k) < hi)
#endif
#define PH_PTRS KArgs KA = kargs(); unsigned char* ws = KA->ws; float* out = KA->out; (void)out; \
    Frame P = F; asm volatile("" : "+s"(P.G), "+s"(P.bid), "+v"(P.tid)); P.lane = P.tid & 63; P.wave = __builtin_amdgcn_readfirstlane(P.tid >> 6); \
    unsigned char* wa = ws + WS_WA + (size_t)L * WA_STRIDE; (void)wa; float* ssb = (float*)(ws + WS_SSP); \
    float* ss1 = ssb + (size_t)(2 * L) * T * 16; float* ss2 = ssb + (size_t)(2 * L + 1) * T * 16; float* ssn = ssb + (size_t)(2 * L + 2) * T * 16; (void)ss1; (void)ss2; (void)ssn; \
    bf16_t* XB = (bf16_t*)(ws + WS_XB); bf16_t* Y = (bf16_t*)(ws + WS_Y); bf16_t* U1 = (bf16_t*)(ws + WS_U1); (void)XB; (void)Y; (void)U1; \
    bf16_t* GATES = (bf16_t*)(ws + WS_GATES); bf16_t* MERGED = (bf16_t*)(ws + WS_MERGED); bf16_t* PB = (bf16_t*)(ws + WS_PB); (void)GATES; (void)MERGED; (void)PB; \
    float* MISC = (float*)(ws + WS_MISC); float* SSQ = (float*)(ws + WS_SSQ); (void)MISC; (void)SSQ; \
    bf16_t* XB2 = (bf16_t*)(ws + (L == 0 ? WS_XB2_L0 : WS_XB2_L1)); (void)XB2;
    const size_t TILE1K = (size_t)256 * 1024 * 2;
    if (RUN(0)) { const int L = 0; PH_PTRS p0_prologue(KA, P); GSYNC(0); }
#pragma unroll 1
    for (int L = 0; L < 2; ++L) {
        const int pb0 = 1 + (L == 0 ? 0 : 9);
        if (RUN(pb0)) { PH_PTRS
            pg8::DenseSched S; S.so.init(64, 22, P.G, P.bid); S.A = (const char*)XB; S.B = (const char*)(wa + WA_IN); S.a_tile = TILE1K; S.b_tile = TILE1K;
            EpiIn E{U1, MISC, ss1};
            pg8::gemm_phase(P.lds, DM, DM, DM, S, E); GSYNC(pb0);
        }
        if (RUN(pb0 + 1)) { PH_PTRS
            rope_pass(P, U1, (const float*)(ws + WS_ROPE), (const float*)(ws + WS_ROPE) + (size_t)T * 32);
            for (int u = P.bid; u < 128; u += P.G) compress_unit(P, u, L, U1, ws);
            GSYNC(pb0 + 1);
        }
        if (RUN(pb0 + 2)) {
            { PH_PTRS
            unsigned* q = (unsigned*)(ws + WS_CTL) + CW_QMIX + 256 * L;
            for (;;) {
                __syncthreads();
                if (P.tid == 0) *s_uid = atomicAdd(q, 1u);
                __syncthreads();
                const int uid = (int)*s_uid;
                if (uid >= 128) break;
                if (uid < 64) {
#ifndef SKIP_RWKV
                    rwkv_unit(P, uid, L, KA, U1, Y);
#endif
                } else {
#ifndef SKIP_SSD
                    ssd_unit(P, uid - 64, L, KA, U1, Y, MISC, SSQ);
#endif
                }
            } }
            { PH_PTRS
            unsigned* q = (unsigned*)(ws + WS_CTL) + CW_QMIX + 256 * L;
            for (;;) {
                __syncthreads();
                if (P.tid == 0) *s_uid = atomicAdd(q + 64, 1u);
                __syncthreads();
                const int uid = (int)*s_uid;
                if (uid >= 512) break;
#ifndef SKIP_NSA
                nsa_unit(P, uid, U1, Y, MISC, ws);
#endif
            } }
            { PH_PTRS
            unsigned* q = (unsigned*)(ws + WS_CTL) + CW_QMIX + 256 * L;
            for (;;) {
                __syncthreads();
                if (P.tid == 0) *s_uid = atomicAdd(q + 128, 1u);
                __syncthreads();
                const int uid = (int)*s_uid;
                if (uid >= 512) break;
#ifndef SKIP_SWA
                swa_unit(P, uid, U1, Y, IN_F(25) + L * 8);
#endif
            } }
            GSYNC(pb0 + 2);
        }
        if (RUN(pb0 + 3)) { PH_PTRS
            pg8::DenseSched S; S.so.init(64, 16, P.G, P.bid); S.A = (const char*)XB; S.B = (const char*)(wa + WA_GATE); S.a_tile = TILE1K; S.b_tile = TILE1K;
            EpiGates E{GATES, ss1};
            pg8::gemm_phase(P.lds, DM, DM, DM, S, E);
            ssd_fixup_and_pb(P, L, KA, Y, SSQ, PB);
            GSYNC(pb0 + 3);
        }
        if (RUN(pb0 + 4)) {
            { PH_PTRS pg8::DenseSched S; S.so.init(64, 4, P.G, P.bid); S.a_tile = (size_t)256 * YW * 2; S.b_tile = (size_t)256 * 512 * 2;
              S.A = (const char*)Y; S.B = (const char*)(wa + WA_PT);
              EpiBr<0> E{MERGED, GATES}; pg8::gemm_phase(P.lds, YW, 512, 512, S, E); }
            { PH_PTRS pg8::DenseSched S; S.so.init(64, 4, P.G, P.bid); S.a_tile = (size_t)256 * YW * 2; S.b_tile = (size_t)256 * 512 * 2;
              S.A = (const char*)(Y + 512); S.B = (const char*)(wa + WA_PT + 1 * MiB);
              EpiBr<1> E{MERGED, GATES}; pg8::gemm_phase(P.lds, YW, 512, 512, S, E); }
            { PH_PTRS pg8::DenseSched S; S.so.init(64, 4, P.G, P.bid); S.a_tile = (size_t)256 * YW * 2; S.b_tile = (size_t)256 * 512 * 2;
              S.A = (const char*)(Y + 1024); S.B = (const char*)(wa + WA_PT + 2 * MiB);
              EpiBr<2> E{MERGED, GATES}; pg8::gemm_phase(P.lds, YW, 512, 512, S, E); }
            { PH_PTRS pg8::DenseSched S; S.so.init(64, 4, P.G, P.bid); S.a_tile = (size_t)256 * YW * 2; S.b_tile = (size_t)256 * 512 * 2;
              S.A = (const char*)(Y + 1536); S.B = (const char*)(wa + WA_PT + 3 * MiB);
              EpiBr<3> E{MERGED, GATES}; pg8::gemm_phase(P.lds, YW, 512, 512, S, E); }
            GSYNC(pb0 + 4);
        }
        if (RUN(pb0 + 5)) { PH_PTRS
            pg8::DenseSched S; S.so.init(64, 4, P.G, P.bid); S.A = (const char*)MERGED; S.B = (const char*)(wa + WA_OUT); S.a_tile = TILE1K; S.b_tile = TILE1K;
            if (L == 0) { EpiRes<true, true> E{IN_F(0), out, XB, ss2}; pg8::gemm_phase(P.lds, DM, DM, DM, S, E); }
            else { EpiRes<false, true> E{out, out, XB, ss2}; pg8::gemm_phase(P.lds, DM, DM, DM, S, E); }
            GSYNC(pb0 + 5);
        }
        if (L == 0) {
            if (RUN(7)) { PH_PTRS
                pg8::DenseSched S; S.so.init(64, 22, P.G, P.bid); S.A = (const char*)XB; S.B = (const char*)(ws + WS_FGU); S.a_tile = TILE1K; S.b_tile = TILE1K;
                EpiFfn1<false> E{(bf16_t*)(ws + WS_ACT0), ss2};
                pg8::gemm_phase(P.lds, DM, DM, DM, S, E); GSYNC(7);
            }
            if (RUN(8)) { PH_PTRS
                pg8::DenseSched S; S.so.init(64, 4, P.G, P.bid); S.A = (const char*)(ws + WS_ACT0); S.B = (const char*)(ws + WS_FDN); S.a_tile = (size_t)256 * D_FF * 2; S.b_tile = (size_t)256 * D_FF * 2;
                EpiRes<true, false> E{out, out, XB2, nullptr};
                pg8::gemm_phase(P.lds, D_FF, D_FF, D_FF, S, E); GSYNC(8);
            }
        } else {
#define MOE_PTRS unsigned* cnt = (unsigned*)(ws + WS_CTL) + CW_MOECNT; (void)cnt; int* toke = (int*)(ws + WS_TOKE); int* tokp = (int*)(ws + WS_TOKP); float* tokw = (float*)(ws + WS_TOKW); int* toks = (int*)(ws + WS_TOKS); \
            (void)toke; (void)tokp; (void)tokw; (void)toks; float* srstd = (float*)(ws + WS_SRSTD); (void)srstd; \
            bf16_t* XG = (bf16_t*)(ws + WS_XG); bf16_t* ACT1 = (bf16_t*)(ws + WS_ACT1); bf16_t* YB = (bf16_t*)(ws + WS_YB); (void)XG; (void)ACT1; (void)YB;
            if (RUN(16)) { PH_PTRS MOE_PTRS moe_router(P, KA, out, cnt, toke, tokp, tokw); GSYNC(16); }
            if (RUN(17)) { PH_PTRS MOE_PTRS moe_slots(P, out, ss2, cnt, toke, tokp, toks, XG, srstd); GSYNC(17); }
            if (RUN(18)) { PH_PTRS MOE_PTRS
                MoeSched S; int c[8]; moe_tables(cnt, S.mt, c); S.nN = 22; S.G = P.G; S.c = P.bid; S.A = (const char*)XG; S.B = (const char*)(ws + WS_WB); S.a_tile = TILE1K; S.b_tile = TILE1K; S.b_expert = WB_STRIDE;
                EpiFfn1<true> E{ACT1, srstd};
                pg8::gemm_phase(P.lds, DM, DM, DM, S, E); GSYNC(18);
            }
            if (RUN(19)) { PH_PTRS MOE_PTRS
                MoeSched S; int c[8]; moe_tables(cnt, S.mt, c); S.nN = 4; S.G = P.G; S.c = P.bid; S.A = (const char*)ACT1; S.B = (const char*)(ws + WS_WB + WB_DN); S.a_tile = (size_t)256 * D_FF * 2; S.b_tile = (size_t)256 * D_FF * 2; S.b_expert = WB_STRIDE;
                EpiBf16<false> E{YB};
                pg8::gemm_phase(P.lds, D_FF, D_FF, D_FF, S, E); GSYNC(19);
            }
            if (RUN(20)) { PH_PTRS MOE_PTRS moe_combine(P, out, YB, toks, tokw, XB2); GSYNC(20); }
        }
        const int pple = (L == 0) ? 9 : 21;
        if (RUN(pple)) {
            { PH_PTRS pg8::DenseSched S; S.so.init(64, 4, P.G, P.bid); S.A = (const char*)XB2; S.B = (const char*)(wa + WA_PG); S.a_tile = TILE1K; S.b_tile = TILE1K;
              EpiBf16<true> E{MERGED}; pg8::gemm_phase(P.lds, DM, DM, DM, S, E); }
            { PH_PTRS pg8::DenseSched S; S.so.init(64, 4, P.G, P.bid);
              S.A = (const char*)PB; S.B = (const char*)(wa + WA_PP); S.a_tile = (size_t)256 * PLE * 2; S.b_tile = (size_t)256 * PLE * 2;
              if (L == 0) { EpiPle2<true> E{out, MERGED, XB, ssn}; pg8::gemm_phase(P.lds, PLE, PLE, PLE, S, E); }
              else { EpiPle2<false> E{out, MERGED, XB, ssn}; pg8::gemm_phase(P.lds, PLE, PLE, PLE, S, E); } }
            GSYNC(pple);
        }
    }
    if (RUN(22)) { const int L = 0; PH_PTRS final_norm(P, KA, out); }
}

extern "C" void kernel_launch(void* const* d_in, const int* in_sizes, int n_in, void* d_out, int out_size, void* d_ws, size_t ws_size, hipStream_t stream) {
    static int grid = 0;
    if (grid == 0) {
        if (n_in != 42 || out_size != T * DM || ws_size < WS_END) { fprintf(stderr, "kernel_launch: unexpected problem (n_in %d out %d ws %zu)\n", n_in, out_size, ws_size); grid = -1; return; }
        int dev = 0, cus = 0, per_cu = 0;
        hipGetDevice(&dev); hipDeviceGetAttribute(&cus, hipDeviceAttributeMultiprocessorCount, dev);
        hipFuncSetAttribute((const void*)mega_fwd, hipFuncAttributeMaxDynamicSharedMemorySize, LDS_BYTES);
        hipOccupancyMaxActiveBlocksPerMultiprocessor(&per_cu, (const void*)mega_fwd, 512, LDS_BYTES);
        if (per_cu < 1) { fprintf(stderr, "kernel_launch: occupancy query says %d blocks per CU\n", per_cu); per_cu = 1; }
        (void)hipGetLastError();
        grid = cus;
    }
    if (grid < 0) return;
    hipMemsetAsync((char*)d_ws + WS_CTL, 0, CTL_BYTES, stream);
    Args a{};
    for (int i = 0; i < 42; ++i) a.in[i] = d_in[i];
    a.out = (float*)d_out; a.ws = (unsigned char*)d_ws;
#if MK_MULTI
    for (int k = 0; k < NPH; ++k) { a.ph_lo = k; a.ph_hi = k + 1; hipLaunchKernelGGL(mega_fwd, dim3(grid), dim3(512), LDS_BYTES, stream, a); }
#else
    a.ph_lo = 0; a.ph_hi = NPH;
    void* kargs[] = {&a};
    hipError_t e = hipLaunchCooperativeKernel((const void*)mega_fwd, dim3(grid), dim3(512), kargs, LDS_BYTES, stream);
    if (e != hipSuccess) fprintf(stderr, "kernel_launch: cooperative launch failed: %s\n", hipGetErrorString(e));
#endif
}
```

```cpp
#include <hip/hip_runtime.h>
#include <hip/hip_cooperative_groups.h>
#include <cstdio>
#include <cstdint>
namespace cg = cooperative_groups;

#define LAS __attribute__((address_space(3)))
#define GAS __attribute__((address_space(1)))
typedef unsigned short bf16_t;
typedef short bf16x8 __attribute__((ext_vector_type(8)));
typedef short s16x4 __attribute__((ext_vector_type(4)));
typedef float f32x2 __attribute__((ext_vector_type(2)));
typedef float f32x4 __attribute__((ext_vector_type(4)));
typedef float f32x16 __attribute__((ext_vector_type(16)));
typedef unsigned u32x2 __attribute__((ext_vector_type(2)));
typedef unsigned u32x4 __attribute__((ext_vector_type(4)));

#ifdef DIAG_NOINLINE
#define UNIT_INLINE __attribute__((noinline))
#else
#define UNIT_INLINE __forceinline__
#endif
#ifndef MK_MULTI
#define MK_MULTI 0
#endif

constexpr int NB = 8, SEQ = 2048, T = NB * SEQ, DM = 1024, HD = 64;
constexpr int D_IN = 9504, D_FF = 2816, NEXP = 8, PLE = 256;
constexpr int UW = 5376;
constexpr int YW = 2048;
constexpr float NORM_EPS = 1e-6f;
constexpr float LOG2E = 1.4426950408889634f;
constexpr int UC_Z = 0, UC_XBC = 512, UC_XS = 512, UC_BM = 1024, UC_CM = 1280, UC_NQ = 1536, UC_NKV = 2048, UC_RW = 2816, UC_SQ = 4608, UC_SKV = 5120;
constexpr int MOE_MAXROWS = 34816;

constexpr size_t MiB = (size_t)1 << 20;
constexpr size_t WS_CTL = 0, CTL_BYTES = 1 * MiB;
constexpr size_t WS_ROPE = 1 * MiB;
constexpr size_t WS_MISC = 5 * MiB;
constexpr size_t WS_KC = 7 * MiB, WS_VC = 7 * MiB + 256 * 1024;
constexpr size_t WS_SSQ = 7 * MiB + 512 * 1024;
constexpr size_t WS_TOKE = 8 * MiB, WS_TOKP = WS_TOKE + 128 * 1024, WS_TOKW = WS_TOKP + 128 * 1024, WS_TOKS = WS_TOKW + 128 * 1024;
constexpr size_t WS_SRSTD = 8 * MiB + 512 * 1024;
constexpr size_t WS_W1T = 9 * MiB;
constexpr size_t WS_W2T = 10 * MiB;
constexpr size_t WS_PEB = 10 * MiB + 64 * 1024;
constexpr size_t WS_WA = 12 * MiB, WA_STRIDE = 28 * MiB;
constexpr size_t WA_IN = 0, WA_GATE = 11 * MiB, WA_PT = 19 * MiB, WA_OUT = 23 * MiB, WA_PG = 25 * MiB, WA_PP = 27 * MiB;
constexpr size_t WS_FGU = 68 * MiB, WS_FDN = 79 * MiB;
constexpr size_t WS_WB = 85 * MiB, WB_STRIDE = 16 * MiB + 512 * 1024, WB_DN = 11 * MiB;
constexpr size_t WS_XB = 217 * MiB;
constexpr size_t WS_Y = 249 * MiB;
constexpr size_t WS_BIG = 313 * MiB;
constexpr size_t WS_U1 = WS_BIG, WS_GATES = WS_BIG, WS_MERGED = WS_BIG + 128 * MiB, WS_PB = WS_BIG + 160 * MiB, WS_ACT0 = WS_BIG;
constexpr size_t WS_XG = WS_XB, WS_ACT1 = 285 * MiB, WS_YB = WS_XB;
constexpr size_t WS_XB2_L0 = WS_Y, WS_XB2_L1 = 300 * MiB;
constexpr size_t WS_SSP = 482 * MiB;
constexpr size_t WS_END = 488 * MiB;
constexpr int CW_BAR = 4096, CW_QMIX = 8192, CW_MOECNT = 9216;

constexpr int RING_BYTES = 131072;
constexpr int LDS_BYTES = 147456;
constexpr int LDS_USER = LDS_BYTES - 1024;
constexpr int MISC_OFF = LDS_USER;

__device__ __forceinline__ float bf2f(unsigned b) { return __uint_as_float(b << 16); }
__device__ __forceinline__ unsigned f2bf(float f) { unsigned u = __float_as_uint(f); return (u + 0x7fffu + ((u >> 16) & 1u)) >> 16; }
__device__ __forceinline__ unsigned cvt_pk(float lo, float hi) { unsigned r; asm volatile("v_cvt_pk_bf16_f32 %0, %1, %2" : "=v"(r) : "v"(lo), "v"(hi)); return r; }
__device__ __forceinline__ float sigmoidf_(float x) { return 1.0f / (1.0f + __expf(-x)); }
__device__ __forceinline__ float siluf_(float x) { return x / (1.0f + __expf(-x)); }
__device__ __forceinline__ float softplusf_(float x) { return x > 20.f ? x : log1pf(expf(x)); }
__device__ __forceinline__ float wave_sum(float v) {
#pragma unroll
    for (int o = 1; o < 64; o <<= 1) v += __shfl_xor(v, o);
    return v;
}
__device__ __forceinline__ float wave_max(float v) {
#pragma unroll
    for (int o = 1; o < 64; o <<= 1) v = fmaxf(v, __shfl_xor(v, o));
    return v;
}
#define RLX_AGENT __ATOMIC_RELAXED, __HIP_MEMORY_SCOPE_AGENT
__device__ __forceinline__ u32x2 ld_agent_u64(const void* p) {
    unsigned long long v = __hip_atomic_load((const unsigned long long*)p, RLX_AGENT);
    u32x2 r; r.x = (unsigned)v; r.y = (unsigned)(v >> 32); return r;
}

__device__ __forceinline__ float ss_total(const float* ssp, int row) {
    const f32x4* p = (const f32x4*)(ssp + (size_t)row * 16); const f32x4 a = p[0], b = p[1], c = p[2], d = p[3];
    return (((a[0] + a[1]) + (a[2] + a[3])) + ((b[0] + b[1]) + (b[2] + b[3]))) + (((c[0] + c[1]) + (c[2] + c[3])) + ((d[0] + d[1]) + (d[2] + d[3])));
}
__device__ __forceinline__ float rstd_of(const float* ssp, int row) { return rsqrtf(ss_total(ssp, row) * (1.0f / DM) + NORM_EPS); }

namespace pg8 {
constexpr int BM = 256, BK = 64, HALF = 128, HTB = HALF * BK * 2, STAGE_BYTES = 8 * HTB, NXCD = 8, WGM = 8;
__host__ __device__ __forceinline__ int lds_byte(int r, int c) { const int st = (r >> 4) * 2 + (c >> 5), rr = r & 15, cc = c & 31, ob = rr * 64 + cc * 2; return st * 1024 + (ob ^ (((ob >> 9) & 1) << 5)); }
__host__ __device__ __forceinline__ void stage_rc(int b, int& R, int& C) { const int st = b / 1024, sb = b % 1024, swz = sb ^ (((sb >> 9) & 1) << 5); R = (st >> 1) * 16 + swz / 64; C = (st & 1) * 32 + (swz % 64) / 2; }

struct Unit { int pm, pn; const char* pa; const char* pb; };

struct StaticOrder {
    int nM, nN, nwg, G, c;
    __device__ void init(int nM_, int nN_, int G_, int c_) { nM = nM_; nN = nN_; nwg = nM * nN; G = G_; c = c_; }
    __device__ bool next(int i, int& pm, int& pn) const {
        const long L = (long)i * G + c; if (L >= nwg) return false;
        int wgid = (int)L; { const int q = nwg / NXCD, r = nwg % NXCD, xcd = wgid % NXCD, off = wgid / NXCD; wgid = (xcd < r ? xcd * (q + 1) : r * (q + 1) + (xcd - r) * q) + off; }
        const int nig = WGM * nN, gid = wgid / nig, fm = gid * WGM, gsz = (nM - fm) < WGM ? (nM - fm) : WGM;
        pm = fm + ((wgid % nig) % gsz); pn = (wgid % nig) / gsz; return true;
    }
};
struct DenseSched {
    StaticOrder so; const char* A; const char* B; size_t a_tile, b_tile;
    __device__ bool next(int i, Unit& u) const { if (!so.next(i, u.pm, u.pn)) return false; u.pa = A + (size_t)u.pm * a_tile; u.pb = B + (size_t)u.pn * b_tile; return true; }
};

template <class Epi, class Sched>
__device__ __forceinline__ void gemm_phase(LAS unsigned char* lds, const int lda, const int ldb, const int K, const Sched& S, const Epi& E) {
    int tid_ = threadIdx.x; asm volatile("" : "+v"(tid_));
    const int tid = tid_, wid = __builtin_amdgcn_readfirstlane(tid >> 6), lane = tid & 63, wr = wid >> 2, wc = wid & 3, fr = lane & 15, fq = lane >> 4;
    int K_ = K; asm volatile("" : "+s"(K_));
    const int nt = K_ / BK;
    unsigned voffA[2], voffB[2];
#pragma unroll
    for (int i = 0; i < 2; ++i) { int R, C; stage_rc(tid * 16 + i * 8192, R, C); voffA[i] = (unsigned)(R * lda + C) * 2u; voffB[i] = (unsigned)(R * ldb + C) * 2u; }
    const size_t kstep = (size_t)(BK * 2);
    const size_t hstepA = (size_t)HALF * lda * 2, hstepB = (size_t)HALF * ldb * 2;
    const unsigned ldsw = (unsigned)wid * 1024u;
    const int aoff = lds_byte(wr * 64 + fr, fq * 8), boff = lds_byte(wc * 32 + fr, fq * 8);
#define PG8_SA(b, h) (((b) * 2 + (h)) * HTB)
#define PG8_SB(b, h) ((4 + (b) * 2 + (h)) * HTB)
#define PG8_STAGE(bufoff, gbase, voff) do { _Pragma("unroll") for (int _i = 0; _i < 2; ++_i) \
        __builtin_amdgcn_global_load_lds((const unsigned*)((const char*)(gbase) + (voff)[_i]), (LAS unsigned*)(lds + (bufoff) + ldsw + _i * 8192), 16, 0, 0); } while (0)
#define PG8_LDA(dst, b, h) do { _Pragma("unroll") for (int m = 0; m < 4; ++m) _Pragma("unroll") for (int k = 0; k < 2; ++k) dst[m][k] = *(const LAS bf16x8*)(lds + PG8_SA(b, h) + aoff + m * 2048 + k * 1024); } while (0)
#define PG8_LDB(dst, b, h) do { _Pragma("unroll") for (int n = 0; n < 2; ++n) _Pragma("unroll") for (int k = 0; k < 2; ++k) dst[n][k] = *(const LAS bf16x8*)(lds + PG8_SB(b, h) + boff + n * 2048 + k * 1024); } while (0)
#define PG8_MMA(ai, bj, At, Bt) do { __builtin_amdgcn_s_setprio(1); _Pragma("unroll") for (int m = 0; m < 4; ++m) _Pragma("unroll") for (int n = 0; n < 2; ++n) _Pragma("unroll") for (int k = 0; k < 2; ++k) \
        acc[ai][bj][m][n] = __builtin_amdgcn_mfma_f32_16x16x32_bf16(Bt[n][k], At[m][k], acc[ai][bj][m][n], 0, 0, 0); __builtin_amdgcn_s_setprio(0); } while (0)
#define PG8_WAIT_V(n) asm volatile("s_waitcnt vmcnt(" #n ")" ::: "memory")
#define PG8_WAIT_L(n) asm volatile("s_waitcnt lgkmcnt(" #n ")" ::: "memory")
#define PG8_BAR __builtin_amdgcn_s_barrier()
#define PG8_SCHED __builtin_amdgcn_sched_barrier(0)
    Unit cur, nxt; int ui = 0;
    if (!S.next(0, cur)) return;
    f32x4 acc[2][2][4][2];
#pragma unroll
    for (int a = 0; a < 2; ++a)
#pragma unroll
        for (int b = 0; b < 2; ++b)
#pragma unroll
            for (int m = 0; m < 4; ++m)
#pragma unroll
                for (int n = 0; n < 2; ++n) acc[a][b][m][n] = (f32x4){0.f, 0.f, 0.f, 0.f};
    bf16x8 At[4][2], B0[2][2], B1[2][2];
    const char* cA = cur.pa; const char* cB = cur.pb;
    PG8_STAGE(PG8_SB(0, 0), cB, voffB); PG8_STAGE(PG8_SB(0, 1), cB + hstepB, voffB); PG8_STAGE(PG8_SA(0, 0), cA, voffA); PG8_STAGE(PG8_SA(0, 1), cA + hstepA, voffA);
    if (wr == 1) PG8_BAR;
    PG8_WAIT_V(2); PG8_BAR;
    PG8_STAGE(PG8_SB(1, 0), cB + kstep, voffB); PG8_STAGE(PG8_SA(1, 0), cA + kstep, voffA); PG8_STAGE(PG8_SB(1, 1), cB + hstepB + kstep, voffB);
    PG8_WAIT_V(6); PG8_BAR;
    for (;;) {
        const bool has_next = S.next(ui + 1, nxt);
        const char* nA = has_next ? nxt.pa : cA; const char* nB = has_next ? nxt.pb : cB;
        for (int t = 0; t < nt; t += 2) {
            const bool last = (t == nt - 2);
            const char* a1 = cA + (size_t)(t + 1) * kstep;
            const char* a2 = last ? nA : cA + (size_t)(t + 2) * kstep; const char* b2 = last ? nB : cB + (size_t)(t + 2) * kstep;
            const char* a3 = a2 + kstep; const char* b3 = b2 + kstep;
            PG8_LDB(B0, 0, 0); PG8_LDB(B1, 0, 1); PG8_SCHED; PG8_LDA(At, 0, 0); PG8_STAGE(PG8_SA(1, 1), a1 + hstepA, voffA);
            PG8_WAIT_V(8); PG8_WAIT_L(0); PG8_BAR; PG8_MMA(0, 0, At, B0); PG8_MMA(0, 1, At, B1); PG8_BAR; PG8_SCHED;
            PG8_LDA(At, 0, 1); PG8_STAGE(PG8_SB(0, 0), b2, voffB); PG8_STAGE(PG8_SB(0, 1), b2 + hstepB, voffB); PG8_STAGE(PG8_SA(0, 0), a2, voffA);
            PG8_WAIT_V(8); PG8_WAIT_L(0); PG8_BAR; PG8_MMA(1, 0, At, B0); PG8_MMA(1, 1, At, B1); PG8_BAR; PG8_SCHED;
            PG8_LDB(B0, 1, 0); PG8_LDB(B1, 1, 1); PG8_SCHED; PG8_LDA(At, 1, 0); PG8_STAGE(PG8_SA(0, 1), a2 + hstepA, voffA);
            PG8_WAIT_V(8); PG8_WAIT_L(0); PG8_BAR; PG8_MMA(0, 0, At, B0); PG8_MMA(0, 1, At, B1); PG8_BAR; PG8_SCHED;
            PG8_LDA(At, 1, 1); PG8_STAGE(PG8_SB(1, 0), b3, voffB); PG8_STAGE(PG8_SB(1, 1), b3 + hstepB, voffB); PG8_STAGE(PG8_SA(1, 0), a3, voffA);
            PG8_WAIT_V(8); PG8_WAIT_L(0); PG8_BAR; PG8_MMA(1, 0, At, B0); PG8_MMA(1, 1, At, B1); PG8_BAR; PG8_SCHED;
        }
        if (wr == 0) PG8_BAR;
        E(acc, cur, wr, wc, fr, fq);
        if (!has_next) break;
#pragma unroll
        for (int a = 0; a < 2; ++a)
#pragma unroll
            for (int b = 0; b < 2; ++b)
#pragma unroll
                for (int m = 0; m < 4; ++m)
#pragma unroll
                    for (int n = 0; n < 2; ++n) acc[a][b][m][n] = (f32x4){0.f, 0.f, 0.f, 0.f};
        cur = nxt; cA = nA; cB = nB; ++ui;
        if (wr == 1) PG8_BAR;
    }
    PG8_WAIT_V(0);
    PG8_BAR;
#undef PG8_SA
#undef PG8_SB
#undef PG8_STAGE
#undef PG8_LDA
#undef PG8_LDB
#undef PG8_MMA
#undef PG8_WAIT_V
#undef PG8_WAIT_L
#undef PG8_BAR
#undef PG8_SCHED
}
}

#define EPI_ROW(u, ai, m) ((u).pm * 256 + (ai) * 128 + wr * 64 + (m) * 16 + fr)
#define EPI_COL(u, bj, n) ((u).pn * 256 + (bj) * 128 + wc * 32 + (n) * 16 + fq * 4)
typedef f32x4 Acc[2][2][4][2];

__device__ __forceinline__ u32x2 pack4(f32x4 v) { u32x2 w; w.x = cvt_pk(v[0], v[1]); w.y = cvt_pk(v[2], v[3]); return w; }
__device__ __forceinline__ f32x4 unpack4(u32x2 w) { f32x4 v; v[0] = bf2f(w.x & 0xffffu); v[1] = bf2f(w.x >> 16); v[2] = bf2f(w.y & 0xffffu); v[3] = bf2f(w.y >> 16); return v; }

struct EpiIn {
    bf16_t* U; float* misc; const float* ss;
    __device__ __forceinline__ void operator()(const Acc& acc, const pg8::Unit& u, int wr, int wc, int fr, int fq) const {
#pragma unroll
        for (int ai = 0; ai < 2; ++ai)
#pragma unroll
            for (int m = 0; m < 4; ++m) {
                const int row = EPI_ROW(u, ai, m); const float rs = rstd_of(ss, row);
                if (u.pn < 21) {
#pragma unroll
                    for (int bj = 0; bj < 2; ++bj)
#pragma unroll
                        for (int n = 0; n < 2; ++n) *(u32x2*)(U + (size_t)row * UW + EPI_COL(u, bj, n)) = pack4(acc[ai][bj][m][n] * rs);
                } else if (wc == 0) {
#pragma unroll
                    for (int n = 0; n < 2; ++n) *(f32x4*)(misc + (size_t)row * 32 + n * 16 + fq * 4) = acc[ai][0][m][n] * rs;
                }
            }
    }
};
struct EpiGates {
    bf16_t* G; const float* ss;
    __device__ __forceinline__ void operator()(const Acc& acc, const pg8::Unit& u, int wr, int wc, int fr, int fq) const {
#pragma unroll
        for (int ai = 0; ai < 2; ++ai)
#pragma unroll
            for (int m = 0; m < 4; ++m) {
                const int row = EPI_ROW(u, ai, m); const float rs = rstd_of(ss, row);
#pragma unroll
                for (int bj = 0; bj < 2; ++bj)
#pragma unroll
                    for (int n = 0; n < 2; ++n) { f32x4 v = acc[ai][bj][m][n] * rs; v[0] = sigmoidf_(v[0]); v[1] = sigmoidf_(v[1]); v[2] = sigmoidf_(v[2]); v[3] = sigmoidf_(v[3]);
                        *(u32x2*)(G + (size_t)row * 4096 + EPI_COL(u, bj, n)) = pack4(v); }
            }
    }
};
template <int MB> struct EpiBr {
    bf16_t* MG; const bf16_t* G;
    __device__ __forceinline__ void operator()(const Acc& acc, const pg8::Unit& u, int wr, int wc, int fr, int fq) const {
#pragma unroll
        for (int ai = 0; ai < 2; ++ai)
#pragma unroll
            for (int m = 0; m < 4; ++m) {
                const int row = EPI_ROW(u, ai, m);
#pragma unroll
                for (int bj = 0; bj < 2; ++bj)
#pragma unroll
                    for (int n = 0; n < 2; ++n) { const int col = EPI_COL(u, bj, n);
                        const f32x4 g = unpack4(*(const u32x2*)(G + (size_t)row * 4096 + MB * 1024 + col));
                        f32x4 v = acc[ai][bj][m][n] * g;
                        bf16_t* mp = MG + (size_t)row * DM + col;
                        if (MB > 0) v += unpack4(ld_agent_u64(mp));
                        *(u32x2*)mp = pack4(v); }
                asm volatile("" ::: "memory");
            }
    }
};
template <bool WRITE_XB, bool ACC_SS> struct EpiRes {
    const float* xin; float* xo; bf16_t* xb; float* ss;
    __device__ __forceinline__ void operator()(const Acc& acc, const pg8::Unit& u, int wr, int wc, int fr, int fq) const {
#pragma unroll
        for (int ai = 0; ai < 2; ++ai)
#pragma unroll
            for (int m = 0; m < 4; ++m) {
                const int row = EPI_ROW(u, ai, m); float s = 0.f;
#pragma unroll
                for (int bj = 0; bj < 2; ++bj)
#pragma unroll
                    for (int n = 0; n < 2; ++n) { const size_t off = (size_t)row * DM + EPI_COL(u, bj, n);
                        const f32x4 v = *(const f32x4*)(xin + off) + acc[ai][bj][m][n];
                        *(f32x4*)(xo + off) = v;
                        if (WRITE_XB) *(u32x2*)(xb + off) = pack4(v);
                        if (ACC_SS) s += (v[0] * v[0] + v[1] * v[1]) + (v[2] * v[2] + v[3] * v[3]); }
                if (ACC_SS) { s += __shfl_xor(s, 16); s += __shfl_xor(s, 32); if (fq == 0) ss[(size_t)row * 16 + u.pn * 4 + wc] = s; }
                asm volatile("" ::: "memory");
            }
    }
};
template <bool MOE> struct EpiFfn1 {
    bf16_t* ACT; const float* ss;
    __device__ __forceinline__ void operator()(const Acc& acc, const pg8::Unit& u, int wr, int wc, int fr, int fq) const {
#pragma unroll
        for (int ai = 0; ai < 2; ++ai)
#pragma unroll
            for (int m = 0; m < 4; ++m) {
                const int row = EPI_ROW(u, ai, m); const float rs = MOE ? ss[row] : rstd_of(ss, row);
#pragma unroll
                for (int n = 0; n < 2; ++n) { const f32x4 g = acc[ai][0][m][n] * rs, up = acc[ai][1][m][n] * rs; f32x4 v;
                    v[0] = siluf_(g[0]) * up[0]; v[1] = siluf_(g[1]) * up[1]; v[2] = siluf_(g[2]) * up[2]; v[3] = siluf_(g[3]) * up[3];
                    *(u32x2*)(ACT + (size_t)row * D_FF + u.pn * 128 + wc * 32 + n * 16 + fq * 4) = pack4(v); }
            }
    }
};
template <bool SIG> struct EpiBf16 {
    bf16_t* O;
    __device__ __forceinline__ void operator()(const Acc& acc, const pg8::Unit& u, int wr, int wc, int fr, int fq) const {
#pragma unroll
        for (int ai = 0; ai < 2; ++ai)
#pragma unroll
            for (int m = 0; m < 4; ++m) {
                const int row = EPI_ROW(u, ai, m);
#pragma unroll
                for (int bj = 0; bj < 2; ++bj)
#pragma unroll
                    for (int n = 0; n < 2; ++n) { f32x4 v = acc[ai][bj][m][n];
                        if (SIG) { v[0] = sigmoidf_(v[0]); v[1] = sigmoidf_(v[1]); v[2] = sigmoidf_(v[2]); v[3] = sigmoidf_(v[3]); }
                        *(u32x2*)(O + (size_t)row * DM + EPI_COL(u, bj, n)) = pack4(v); }
            }
    }
};
template <bool WRITE_XB> struct EpiPle2 {
    float* xo; const bf16_t* G; bf16_t* xb; float* ss;
    __device__ __forceinline__ void operator()(const Acc& acc, const pg8::Unit& u, int wr, int wc, int fr, int fq) const {
#pragma unroll
        for (int ai = 0; ai < 2; ++ai)
#pragma unroll
            for (int m = 0; m < 4; ++m) {
                const int row = EPI_ROW(u, ai, m); float s = 0.f;
#pragma unroll
                for (int bj = 0; bj < 2; ++bj)
#pragma unroll
                    for (int n = 0; n < 2; ++n) { const size_t off = (size_t)row * DM + EPI_COL(u, bj, n);
                        const f32x4 g = unpack4(ld_agent_u64(G + off));
                        const f32x4 v = *(const f32x4*)(xo + off) + g * acc[ai][bj][m][n];
                        *(f32x4*)(xo + off) = v;
                        if (WRITE_XB) *(u32x2*)(xb + off) = pack4(v);
                        s += (v[0] * v[0] + v[1] * v[1]) + (v[2] * v[2] + v[3] * v[3]); }
                s += __shfl_xor(s, 16); s += __shfl_xor(s, 32); if (fq == 0) ss[(size_t)row * 16 + u.pn * 4 + wc] = s;
                asm volatile("" ::: "memory");
            }
    }
};

struct MoeTables { int ps1, ps2, ps3, ps4, ps5, ps6, ps7, ps8; };
__device__ __forceinline__ int moe_expert_of_row(const MoeTables& mt, int row) {
    return (row >= mt.ps1) + (row >= mt.ps2) + (row >= mt.ps3) + (row >= mt.ps4) + (row >= mt.ps5) + (row >= mt.ps6) + (row >= mt.ps7);
}
struct MoeSched {
    MoeTables mt; int nN, G, c; const char* A; const char* B; size_t a_tile, b_tile, b_expert;
    __device__ bool next(int i, pg8::Unit& u) const {
        const long L = (long)i * G + c; const int ntiles = mt.ps8 >> 8;
        if (L >= (long)ntiles * nN) return false;
        u.pm = (int)(L / nN); u.pn = (int)(L % nN);
        const int e = moe_expert_of_row(mt, u.pm * 256);
        u.pa = A + (size_t)u.pm * a_tile; u.pb = B + (size_t)e * b_expert + (size_t)u.pn * b_tile; return true;
    }
};

struct Args { const void* in[42]; float* out; unsigned char* ws; int ph_lo, ph_hi; };
typedef const __attribute__((address_space(4))) Args* KArgs;
__device__ __forceinline__ KArgs kargs() { KArgs p = (KArgs)__builtin_amdgcn_kernarg_segment_ptr(); asm volatile("" : "+s"(p)); return p; }
struct Frame {
    LAS unsigned char* lds; int tid, lane, wave, G, bid;
    unsigned char* ws; unsigned* ctl;
};
#define IN_F(k) ((const float*)KA->in[k])

struct TJob { const float* src; int ldw, K, ncols, ldt, mode; bf16_t* dst; const float* gain; };
__device__ __forceinline__ void tr_item(const TJob& J, LAS float* scr, int item, int lane) {
    const int nblk = J.ncols / 32, kb = item / nblk, nb = item % nblk, k0 = 64 * kb, n0 = 32 * nb;
    const int c = lane & 31;
    const int scol = (J.mode == 3) ? (c < 8 ? 1536 + c : 2816 + c) : n0 + c;
#pragma unroll 8
    for (int i = 0; i < 32; ++i) { const int kk = 2 * i + (lane >> 5); float v = J.src[(size_t)(k0 + kk) * J.ldw + scol]; if (J.gain) v *= J.gain[k0 + kk]; scr[kk * 33 + c] = v; }
    asm volatile("s_waitcnt lgkmcnt(0)" ::: "memory");
    int drow0 = n0;
    if (J.mode == 1 || J.mode == 2) drow0 = (n0 / 128) * 256 + (n0 % 128) + (J.mode == 2 ? 128 : 0);
    const int c8 = lane & 7;
#pragma unroll
    for (int j = 0; j < 4; ++j) { const int n = (lane >> 3) + 8 * j; const LAS float* s = scr + (8 * c8) * 33 + n;
        u32x4 o; o.x = cvt_pk(s[0 * 33], s[1 * 33]); o.y = cvt_pk(s[2 * 33], s[3 * 33]); o.z = cvt_pk(s[4 * 33], s[5 * 33]); o.w = cvt_pk(s[6 * 33], s[7 * 33]);
        *(u32x4*)(J.dst + (size_t)(drow0 + n) * J.ldt + k0 + 8 * c8) = o; }
    asm volatile("s_waitcnt lgkmcnt(0)" ::: "memory");
}
constexpr int NJOBS = 32 + 3 + 24 + 8;
__device__ __forceinline__ bool get_job(KArgs KA, int jid, TJob& J) {
    unsigned char* ws = KA->ws;
    J.gain = nullptr; J.mode = 0;
    if (jid < 32) {
        const int L = jid >> 4, j = jid & 15;
        unsigned char* wa = ws + WS_WA + (size_t)L * WA_STRIDE;
        if (j <= 8) {
            const float* w = IN_F(4) + (size_t)L * DM * D_IN; J.ldw = D_IN; J.K = DM; J.ldt = DM; J.gain = IN_F(3) + L * DM;
            int sc, nc, dr;
            switch (j) { case 0: sc = 0; nc = 512; dr = 0; break; case 1: sc = 512; nc = 1024; dr = 512; break; case 2: sc = 1544; nc = 512; dr = 1536; break;
                case 3: sc = 2056; nc = 768; dr = 2048; break; case 4: sc = 2848; nc = 1792; dr = 2816; break; case 5: sc = 4640; nc = 512; dr = 4608; break;
                case 6: sc = 5152; nc = 256; dr = 5120; break; case 7: sc = 0; nc = 32; dr = 5376; J.mode = 3; break; default: sc = 5408; nc = 4096; dr = 0; break; }
            J.src = w + sc; J.ncols = nc; J.dst = (bf16_t*)(wa + (j == 8 ? WA_GATE : WA_IN)) + (size_t)dr * DM;
            return true;
        }
        if (j <= 12) { const int m = j - 9; J.src = IN_F(26 + m) + (size_t)L * 512 * DM; J.ldw = DM; J.K = 512; J.ncols = DM; J.ldt = 512; J.dst = (bf16_t*)(wa + WA_PT + (size_t)m * MiB); return true; }
        if (j == 13) { J.src = IN_F(30) + (size_t)L * DM * DM; J.ldw = DM; J.K = DM; J.ncols = DM; J.ldt = DM; J.dst = (bf16_t*)(wa + WA_OUT); return true; }
        if (j == 14) { J.src = IN_F(40) + (size_t)L * DM * DM; J.ldw = DM; J.K = DM; J.ncols = DM; J.ldt = DM; J.dst = (bf16_t*)(wa + WA_PG); return true; }
        J.src = IN_F(39) + (size_t)L * PLE * DM; J.ldw = DM; J.K = PLE; J.ncols = DM; J.ldt = PLE; J.dst = (bf16_t*)(wa + WA_PP); return true;
    }
    if (jid < 35) {
        const int j = jid - 32;
        if (j < 2) { J.src = IN_F(32 + j); J.ldw = D_FF; J.K = DM; J.ncols = D_FF; J.ldt = DM; J.gain = IN_F(31); J.mode = 1 + j; J.dst = (bf16_t*)(ws + WS_FGU); return true; }
        J.src = IN_F(34); J.ldw = DM; J.K = D_FF; J.ncols = DM; J.ldt = D_FF; J.dst = (bf16_t*)(ws + WS_FDN); return true;
    }
    if (jid < 59) {
        const int e = (jid - 35) / 3, j = (jid - 35) % 3;
        unsigned char* wb = ws + WS_WB + (size_t)e * WB_STRIDE;
        if (j < 2) { J.src = IN_F(36 + j) + (size_t)e * DM * D_FF; J.ldw = D_FF; J.K = DM; J.ncols = D_FF; J.ldt = DM; J.gain = IN_F(31) + DM; J.mode = 1 + j; J.dst = (bf16_t*)wb; return true; }
        J.src = IN_F(38) + (size_t)e * D_FF * DM; J.ldw = DM; J.K = D_FF; J.ncols = DM; J.ldt = D_FF; J.dst = (bf16_t*)(wb + WB_DN); return true;
    }
    {
        const int j = jid - 59, idx = j & 3;
        if (j < 4) { J.src = IN_F(12) + (size_t)idx * 2048 * 64; J.ldw = 64; J.K = 2048; J.ncols = 64; J.ldt = 2048; J.dst = (bf16_t*)(ws + WS_W1T) + (size_t)idx * 64 * 2048; return true; }
        J.src = IN_F(13) + (size_t)idx * 64 * 64; J.ldw = 64; J.K = 64; J.ncols = 64; J.ldt = 64; J.dst = (bf16_t*)(ws + WS_W2T) + (size_t)idx * 64 * 64; return true;
    }
}
__device__ UNIT_INLINE void p0_prologue(KArgs KA, Frame& F) {
    LAS float* scr = (LAS float*)(F.lds + F.wave * 16384);
    const int gw = F.bid * 8 + F.wave, NGW = F.G * 8;
    unsigned char* ws = KA->ws;
    for (int jid = 0; jid < NJOBS; ++jid) {
        TJob J; get_job(KA, jid, J);
        const int nitems = (J.K / 64) * (J.ncols / 32);
        for (int it = gw; it < nitems; it += NGW) tr_item(J, scr, it, F.lane);
    }
    for (int L = 0; L < 2; ++L) {
        u32x4* z = (u32x4*)((bf16_t*)(ws + WS_WA + (size_t)L * WA_STRIDE + WA_IN) + (size_t)5408 * DM);
        const int n16 = 224 * DM * 2 / 16;
        for (int i = gw * 64 + F.lane; i < n16; i += NGW * 64) z[i] = (u32x4){0u, 0u, 0u, 0u};
    }
    if (gw < 4) {
        const float* pe = IN_F(11) + (size_t)gw * 2048; const float* w1 = IN_F(12) + (size_t)gw * 2048 * 64; float s = 0.f;
        for (int k = 0; k < 2048; ++k) s += pe[k] * w1[(size_t)k * 64 + F.lane];
        ((float*)(ws + WS_PEB))[gw * 64 + F.lane] = s;
    }
    {
        const float* x = IN_F(0); bf16_t* xb = (bf16_t*)(ws + WS_XB); float* ss = (float*)(ws + WS_SSP);
        for (int m = gw; m < T; m += NGW) {
            const f32x4* xr = (const f32x4*)(x + (size_t)m * DM) + F.lane; float s = 0.f;
            u32x2* o = (u32x2*)(xb + (size_t)m * DM) + F.lane;
#pragma unroll
            for (int j = 0; j < 4; ++j) { const f32x4 v = xr[64 * j]; s += (v[0] * v[0] + v[1] * v[1]) + (v[2] * v[2] + v[3] * v[3]); o[64 * j] = pack4(v); }
            s = wave_sum(s); if (F.lane < 16) ss[(size_t)m * 16 + F.lane] = (F.lane == 0) ? s : 0.f;
        }
    }
    {
        const int* pos = (const int*)KA->in[2]; float* rc = (float*)(ws + WS_ROPE); float* rsn = rc + (size_t)T * 32;
        for (int i = (gw * 64 + F.lane); i < T * 32; i += NGW * 64) {
            const int t = i >> 5, k = i & 31;
            const float inv = (float)exp2(-(double)k * (1.0 / 32.0) * 17.194602975157967);
            const float ang = (float)pos[t] * inv;
            rc[i] = cosf(ang); rsn[i] = sinf(ang);
        }
    }
}

__device__ UNIT_INLINE void rope_pass(Frame& F, bf16_t* U1, const float* rc, const float* rsn) {
    const int gt = F.bid * 512 + F.tid, NT = F.G * 512;
    for (int i = gt; i < T * 40; i += NT) {
        const int t = i / 40, r = i % 40, slot = r >> 2, ch = r & 3;
        bf16_t* base = U1 + (size_t)t * UW + (slot < 8 ? UC_SQ + slot * 64 : UC_SKV + (slot - 8) * 64) + ch * 8;
        const u32x4 a = *(const u32x4*)base, b = *(const u32x4*)(base + 32);
        const f32x4 c0 = *(const f32x4*)(rc + (size_t)t * 32 + ch * 8), c1 = *(const f32x4*)(rc + (size_t)t * 32 + ch * 8 + 4);
        const f32x4 s0 = *(const f32x4*)(rsn + (size_t)t * 32 + ch * 8), s1 = *(const f32x4*)(rsn + (size_t)t * 32 + ch * 8 + 4);
        float x1[8], x2[8], cs[8], sn[8];
#pragma unroll
        for (int j = 0; j < 4; ++j) { x1[2 * j] = bf2f(a[j] & 0xffffu); x1[2 * j + 1] = bf2f(a[j] >> 16); x2[2 * j] = bf2f(b[j] & 0xffffu); x2[2 * j + 1] = bf2f(b[j] >> 16);
            cs[j] = c0[j]; cs[4 + j] = c1[j]; sn[j] = s0[j]; sn[4 + j] = s1[j]; }
        u32x4 oa, ob;
#pragma unroll
        for (int j = 0; j < 4; ++j) {
            const float y1a = x1[2 * j] * cs[2 * j] - x2[2 * j] * sn[2 * j], y1b = x1[2 * j + 1] * cs[2 * j + 1] - x2[2 * j + 1] * sn[2 * j + 1];
            const float y2a = x2[2 * j] * cs[2 * j] + x1[2 * j] * sn[2 * j], y2b = x2[2 * j + 1] * cs[2 * j + 1] + x1[2 * j + 1] * sn[2 * j + 1];
            oa[j] = cvt_pk(y1a, y1b); ob[j] = cvt_pk(y2a, y2b);
        }
        *(u32x4*)base = oa; *(u32x4*)(base + 32) = ob;
    }
}
__device__ UNIT_INLINE void compress_unit(Frame& F, int unit, int L, const bf16_t* U1, unsigned char* ws) {
    const int nc = unit & 3, kv = (unit >> 2) & 1, g = (unit >> 3) & 1, b = unit >> 4;
    const int n0 = nc * 32, tok0 = n0 * 16;
    LAS bf16_t* tok = (LAS bf16_t*)F.lds;
    LAS bf16_t* hid = (LAS bf16_t*)(F.lds + 528 * 72 * 2);
    const bf16_t* src = U1 + (size_t)(b * SEQ) * UW + UC_NKV + kv * 128 + g * 64;
    __syncthreads();
    for (int i = F.tid; i < 528 * 8; i += 512) { const int r = i >> 3, ch = i & 7; const int t = tok0 + r;
        u32x4 v = (u32x4){0u, 0u, 0u, 0u}; if (t < SEQ) v = *(const u32x4*)(src + (size_t)t * UW + ch * 8);
        *(LAS u32x4*)(tok + r * 72 + ch * 8) = v; }
    __syncthreads();
    const int idx = L * 2 + kv;
    const bf16_t* w1t = (const bf16_t*)(ws + WS_W1T) + (size_t)idx * 64 * 2048;
    const bf16_t* w2t = (const bf16_t*)(ws + WS_W2T) + (size_t)idx * 64 * 64;
    const float* peb = (const float*)(ws + WS_PEB) + idx * 64;
    const int mt = F.wave >> 2, ntile = F.wave & 3, r16 = F.lane & 15, kg = F.lane >> 4;
    f32x4 acc = (f32x4){0.f, 0.f, 0.f, 0.f};
    const int nl = mt * 16 + r16;
    const bf16_t* bp = w1t + (size_t)(ntile * 16 + r16) * 2048 + kg * 8;
#pragma unroll 4
    for (int ks = 0; ks < 64; ++ks) {
        const int l = ks >> 1, db = (ks & 1) * 32 + kg * 8;
        const bf16x8 a = *(const LAS bf16x8*)(tok + (16 * nl + l) * 72 + db);
        const bf16x8 bb = *(const bf16x8*)(bp + ks * 32);
        acc = __builtin_amdgcn_mfma_f32_16x16x32_bf16(a, bb, acc, 0, 0, 0);
    }
    { const int f = ntile * 16 + r16; const float pb = peb[f];
#pragma unroll
      for (int r = 0; r < 4; ++r) hid[(mt * 16 + 4 * kg + r) * 72 + f] = (bf16_t)f2bf(siluf_(acc[r] + pb)); }
    __syncthreads();
    f32x4 o = (f32x4){0.f, 0.f, 0.f, 0.f};
#pragma unroll
    for (int ks = 0; ks < 2; ++ks) {
        const bf16x8 a = *(const LAS bf16x8*)(hid + nl * 72 + ks * 32 + kg * 8);
        const bf16x8 bb = *(const bf16x8*)(w2t + (size_t)(ntile * 16 + r16) * 64 + ks * 32 + kg * 8);
        o = __builtin_amdgcn_mfma_f32_16x16x32_bf16(a, bb, o, 0, 0, 0);
    }
    bf16_t* dst = (bf16_t*)(ws + (kv ? WS_VC : WS_KC)) + (size_t)((b * 2 + g) * 128) * 64;
#pragma unroll
    for (int r = 0; r < 4; ++r) { const int n = n0 + mt * 16 + 4 * kg + r; dst[(size_t)n * 64 + ntile * 16 + r16] = (n < 127) ? (bf16_t)f2bf(o[r]) : (bf16_t)0; }
}

__device__ __forceinline__ int crow(int r, int hi) { return (r & 3) + 8 * (r >> 2) + 4 * hi; }
constexpr int KS_LD = 72;
struct AttnSt { float m, l; f32x16 o0, o1; };
__device__ __forceinline__ void attn_init(AttnSt& s) { s.m = -INFINITY; s.l = 0.f;
#pragma unroll
    for (int r = 0; r < 16; ++r) { s.o0[r] = 0.f; s.o1[r] = 0.f; } }
__device__ __forceinline__ void stage_kv(const bf16_t* Kg, int ldk, const bf16_t* Vg, int ldv, LAS bf16_t* Ks, LAS bf16_t* Vt, int tid) {
    const int key = tid >> 3, ch = tid & 7;
    const u32x4 kv = *(const u32x4*)(Kg + (size_t)key * ldk + ch * 8);
    const u32x4 vv = *(const u32x4*)(Vg + (size_t)key * ldv + ch * 8);
    *(LAS u32x4*)(Ks + key * KS_LD + ch * 8) = kv;
#pragma unroll
    for (int j = 0; j < 4; ++j) { Vt[(ch * 8 + 2 * j) * KS_LD + key] = (bf16_t)(vv[j] & 0xffffu); Vt[(ch * 8 + 2 * j + 1) * KS_LD + key] = (bf16_t)(vv[j] >> 16); }
}
__device__ __forceinline__ void attn_scores(const LAS bf16_t* Ks, const bf16x8 (&qr)[4], f32x16& p0, f32x16& p1, int r32, int hi) {
#pragma unroll
    for (int r = 0; r < 16; ++r) { p0[r] = 0.f; p1[r] = 0.f; }
#pragma unroll
    for (int d0 = 0; d0 < 4; ++d0) {
        const bf16x8 k0 = *(const LAS bf16x8*)(Ks + r32 * KS_LD + d0 * 16 + hi * 8);
        const bf16x8 k1 = *(const LAS bf16x8*)(Ks + (32 + r32) * KS_LD + d0 * 16 + hi * 8);
        p0 = __builtin_amdgcn_mfma_f32_32x32x16_bf16(k0, qr[d0], p0, 0, 0, 0);
        p1 = __builtin_amdgcn_mfma_f32_32x32x16_bf16(k1, qr[d0], p1, 0, 0, 0);
    }
}
__device__ __forceinline__ void attn_pv(const LAS bf16_t* Vt, const f32x16& p0, const f32x16& p1, f32x16& o0, f32x16& o1, int r32, int hi) {
    bf16x8 pa[4];
#pragma unroll
    for (int s = 0; s < 2; ++s) {
        u32x4 w0, w1;
#pragma unroll
        for (int j = 0; j < 4; ++j) { w0[j] = cvt_pk(p0[8 * s + 2 * j], p0[8 * s + 2 * j + 1]); w1[j] = cvt_pk(p1[8 * s + 2 * j], p1[8 * s + 2 * j + 1]); }
        pa[s] = __builtin_bit_cast(bf16x8, w0); pa[2 + s] = __builtin_bit_cast(bf16x8, w1);
    }
#pragma unroll
    for (int s = 0; s < 4; ++s) {
        const int kbase = 16 * s + 4 * hi;
#pragma unroll
        for (int dh = 0; dh < 2; ++dh) {
            const LAS bf16_t* vp = Vt + (32 * dh + r32) * KS_LD + kbase;
            const s16x4 lo = *(const LAS s16x4*)vp, hi4 = *(const LAS s16x4*)(vp + 8);
            const bf16x8 vb = (bf16x8){lo[0], lo[1], lo[2], lo[3], hi4[0], hi4[1], hi4[2], hi4[3]};
            if (dh == 0) o0 = __builtin_amdgcn_mfma_f32_32x32x16_bf16(pa[s], vb, o0, 0, 0, 0);
            else         o1 = __builtin_amdgcn_mfma_f32_32x32x16_bf16(pa[s], vb, o1, 0, 0, 0);
        }
    }
}
__device__ __forceinline__ void attn_online(const LAS bf16_t* Vt, f32x16& x0, f32x16& x1, AttnSt& st, LAS float* wsf, int r32, int hi) {
    float mx = -INFINITY;
#pragma unroll
    for (int r = 0; r < 16; ++r) mx = fmaxf(mx, fmaxf(x0[r], x1[r]));
    mx = fmaxf(mx, __shfl_xor(mx, 32));
    const float mn = fmaxf(st.m, mx), ms = (mn == -INFINITY) ? 0.f : mn;
    const float f = exp2f((st.m - ms) * LOG2E);
    if (hi == 0) wsf[r32] = f;
    float rs = 0.f;
#pragma unroll
    for (int r = 0; r < 16; ++r) { x0[r] = exp2f((x0[r] - ms) * LOG2E); x1[r] = exp2f((x1[r] - ms) * LOG2E); rs += x0[r] + x1[r]; }
    st.l = st.l * f + rs; st.m = mn;
    const LAS float* wr_ = wsf + 4 * hi;
#pragma unroll
    for (int r = 0; r < 16; ++r) { const float fr_ = wr_[(r & 3) + 8 * (r >> 2)]; st.o0[r] *= fr_; st.o1[r] *= fr_; }
    attn_pv(Vt, x0, x1, st.o0, st.o1, r32, hi);
}
__device__ __forceinline__ void attn_scale_rows(f32x16& o0, f32x16& o1, float inv, LAS float* wsf, int r32, int hi) {
    if (hi == 0) wsf[r32] = inv;
    const LAS float* wr_ = wsf + 4 * hi;
#pragma unroll
    for (int r = 0; r < 16; ++r) { const float f = wr_[(r & 3) + 8 * (r >> 2)]; o0[r] *= f; o1[r] *= f; }
}

__device__ UNIT_INLINE void swa_unit(Frame& F, int unit, const bf16_t* U1, bf16_t* Y, const float* sinks) {
    const int qb = unit & 31, g = (unit >> 5) & 1, b = unit >> 6;
    const int r32 = F.lane & 31, hi = F.lane >> 5, hr = F.wave >> 1, qs = F.wave & 1, head = g * 4 + hr;
    const int q0 = qb * 64, tq = q0 + qs * 32 + r32;
    LAS bf16_t* Ks = (LAS bf16_t*)F.lds; LAS bf16_t* Vt = Ks + 64 * KS_LD;
    LAS float* wsf = (LAS float*)(F.lds + 2 * 64 * KS_LD * 2) + F.wave * 32;
    const bf16_t* rowb = U1 + (size_t)(b * SEQ) * UW;
    bf16x8 qr[4];
#pragma unroll
    for (int d0 = 0; d0 < 4; ++d0) qr[d0] = *(const bf16x8*)(rowb + (size_t)tq * UW + UC_SQ + head * 64 + d0 * 16 + hi * 8);
    AttnSt st; attn_init(st);
    for (int kt = (qb >= 2 ? qb - 2 : 0); kt <= qb; ++kt) {
        __syncthreads();
        stage_kv(rowb + (size_t)(kt * 64) * UW + UC_SKV + g * 64, UW, rowb + (size_t)(kt * 64) * UW + UC_SKV + 128 + g * 64, UW, Ks, Vt, F.tid);
        __syncthreads();
        f32x16 x0, x1; attn_scores(Ks, qr, x0, x1, r32, hi);
#pragma unroll
        for (int r = 0; r < 16; ++r) { const int s0 = kt * 64 + crow(r, hi), s1 = s0 + 32;
            x0[r] = (tq - s0 >= 0 && tq - s0 < 128) ? x0[r] * 0.125f : -INFINITY;
            x1[r] = (tq - s1 >= 0 && tq - s1 < 128) ? x1[r] * 0.125f : -INFINITY; }
        attn_online(Vt, x0, x1, st, wsf, r32, hi);
    }
    const float l = st.l + __shfl_xor(st.l, 32), sk = sinks[head];
    const float mf = fmaxf(st.m, sk), a = exp2f((st.m - mf) * LOG2E), inv = a / (l * a + exp2f((sk - mf) * LOG2E));
    attn_scale_rows(st.o0, st.o1, inv, wsf, r32, hi);
    bf16_t* yb = Y + (size_t)(b * SEQ + q0 + qs * 32) * YW + 3 * 512 + head * 64 + r32;
#pragma unroll
    for (int r = 0; r < 16; ++r) { bf16_t* yp = yb + (size_t)crow(r, hi) * YW; yp[0] = (bf16_t)f2bf(st.o0[r]); yp[32] = (bf16_t)f2bf(st.o1[r]); }
}

constexpr int NSA_K1_OFF = 2 * 64 * KS_LD * 2;
constexpr int NSA_PS_OFF = 4 * 64 * KS_LD * 2;
constexpr int NSA_IMP_OFF = NSA_PS_OFF + 64 * 128 * 4;
constexpr int NSA_SEL_OFF = NSA_IMP_OFF + 64 * 33 * 4;
__device__ __forceinline__ float nsa_gate(const float* gbase, int r, int i) { return sigmoidf_(gbase[((r & 3) + 8 * (r >> 2)) * 32 + i * 8]); }
__device__ UNIT_INLINE void nsa_unit(Frame& F, int unit, const bf16_t* U1, bf16_t* Y, const float* misc, const unsigned char* ws) {
    const int qb = 31 - (unit & 31), g = (unit >> 5) & 1, b = unit >> 6;
    const int r32 = F.lane & 31, hi = F.lane >> 5, hr = F.wave >> 1, qs = F.wave & 1, head = g * 4 + hr;
    const int q0 = qb * 64, ql = qs * 32 + r32, tq = q0 + ql;
    LAS bf16_t* Ks = (LAS bf16_t*)F.lds; LAS bf16_t* Vt = Ks + 64 * KS_LD;
    LAS bf16_t* Ks1 = (LAS bf16_t*)(F.lds + NSA_K1_OFF); LAS bf16_t* Vt1 = Ks1 + 64 * KS_LD;
    LAS unsigned* psum = (LAS unsigned*)(F.lds + NSA_PS_OFF);
    LAS float* impb = (LAS float*)(F.lds + NSA_IMP_OFF);
    LAS unsigned* selm = (LAS unsigned*)(F.lds + NSA_SEL_OFF);
    LAS float* wsf = (LAS float*)(F.lds + NSA_SEL_OFF + 256) + F.wave * 32;
    const bf16_t* rowb = U1 + (size_t)(b * SEQ) * UW;
    const int grow = b * SEQ + q0 + qs * 32;
    const float* gbase = misc + (size_t)(grow + 4 * hi) * 32 + 8 + head;
    bf16x8 qr[4];
#pragma unroll
    for (int d0 = 0; d0 < 4; ++d0) qr[d0] = *(const bf16x8*)(rowb + (size_t)tq * UW + UC_NQ + head * 64 + d0 * 16 + hi * 8);
    f32x16 ya0, ya1;
#pragma unroll
    for (int r = 0; r < 16; ++r) { ya0[r] = 0.f; ya1[r] = 0.f; }
    __syncthreads();
    for (int i = F.tid; i < 64 * 128; i += 512) psum[i] = 0u;
#ifndef NSA_NO_CMP
    {
        const bf16_t* kc = (const bf16_t*)(ws + WS_KC) + (size_t)((b * 2 + g) * 128) * 64;
        const bf16_t* vc = (const bf16_t*)(ws + WS_VC) + (size_t)((b * 2 + g) * 128) * 64;
        stage_kv(kc, 64, vc, 64, Ks, Vt, F.tid);
        stage_kv(kc + 64 * 64, 64, vc + 64 * 64, 64, Ks1, Vt1, F.tid);
        __syncthreads();
        float m = -INFINITY, l = 0.f;
#pragma unroll 1
        for (int tl = 0; tl < 2; ++tl) {
            f32x16 x0, x1; attn_scores(tl ? Ks1 : Ks, qr, x0, x1, r32, hi);
            float mx = -INFINITY;
#pragma unroll
            for (int r = 0; r < 16; ++r) { const int n0 = tl * 64 + crow(r, hi), n1 = n0 + 32;
                x0[r] = (16 * n0 + 31 <= tq) ? x0[r] * 0.125f : -INFINITY; x1[r] = (16 * n1 + 31 <= tq) ? x1[r] * 0.125f : -INFINITY; mx = fmaxf(mx, fmaxf(x0[r], x1[r])); }
            mx = fmaxf(mx, __shfl_xor(mx, 32));
            const float mn = fmaxf(m, mx), ms = (mn == -INFINITY) ? 0.f : mn;
            float rs = 0.f;
#pragma unroll
            for (int r = 0; r < 16; ++r) rs += exp2f((x0[r] - ms) * LOG2E) + exp2f((x1[r] - ms) * LOG2E);
            l = l * exp2f((m - ms) * LOG2E) + rs; m = mn;
        }
        l += __shfl_xor(l, 32);
        const float inv = l > 0.f ? 1.0f / l : 0.f, ms = (m == -INFINITY) ? 0.f : m;
        f32x16 oc0, oc1;
#pragma unroll
        for (int r = 0; r < 16; ++r) { oc0[r] = 0.f; oc1[r] = 0.f; }
#pragma unroll 1
        for (int tl = 0; tl < 2; ++tl) {
            f32x16 x0, x1; attn_scores(tl ? Ks1 : Ks, qr, x0, x1, r32, hi);
#pragma unroll
            for (int r = 0; r < 16; ++r) { const int n0 = tl * 64 + crow(r, hi), n1 = n0 + 32;
                x0[r] = (16 * n0 + 31 <= tq) ? exp2f((x0[r] * 0.125f - ms) * LOG2E) * inv : 0.f;
                x1[r] = (16 * n1 + 31 <= tq) ? exp2f((x1[r] * 0.125f - ms) * LOG2E) * inv : 0.f;
                atomicAdd((unsigned*)(psum + ql * 128 + n0), (unsigned)(x0[r] * 16777216.0f + 0.5f)); atomicAdd((unsigned*)(psum + ql * 128 + n1), (unsigned)(x1[r] * 16777216.0f + 0.5f)); }
            attn_pv(tl ? Vt1 : Vt, x0, x1, oc0, oc1, r32, hi);
        }
#pragma unroll
        for (int r = 0; r < 16; ++r) { const float gt = nsa_gate(gbase, r, 0); ya0[r] += gt * oc0[r]; ya1[r] += gt * oc1[r]; }
    }
#endif
    __syncthreads();
#ifndef NSA_NO_TOPK
    if (qb <= 7) { if (F.tid < 64) selm[F.tid] = (2u << qb) - 1u; }
    else {
        const int q = F.tid & 63, jg = F.tid >> 6;
#pragma unroll
        for (int jj = 0; jj < 4; ++jj) { const int j = jg * 4 + jj; unsigned sacc = 0u;
#pragma unroll
            for (int d = -1; d <= 3; ++d) { const int n = 4 * j + d; if (n >= 0 && n < 127) sacc += psum[q * 128 + n]; }
            impb[q * 33 + j] = (float)sacc; }
        if (jg == 0) selm[q] = 1u | (1u << qb);
        __syncthreads();
        unsigned bits = 0u;
#pragma unroll 1
        for (int jj = 0; jj < 4; ++jj) { const int j = jg * 4 + jj;
            if (j >= 1 && j < qb) { const float vj = impb[q * 33 + j]; int rank = 0;
#pragma unroll 1
                for (int i2 = 1; i2 < qb; ++i2) { const float vi = impb[q * 33 + i2]; rank += (vi > vj || (vi == vj && i2 < j)) ? 1 : 0; }
                if (rank < 6) bits |= 1u << j; } }
        if (bits) atomicOr((unsigned*)(selm + q), bits);
    }
#endif
    __syncthreads();
    unsigned uni;
    { unsigned v = selm[F.lane];
#pragma unroll
      for (int o = 1; o < 64; o <<= 1) v |= __shfl_xor(v, o);
      uni = __builtin_amdgcn_readfirstlane(v); }
    const unsigned mysel = selm[ql];
#pragma unroll 1
    for (int br = 0; br < 2; ++br) {
        const unsigned lowm = (qb >= 8) ? ~((1u << (qb - 8)) - 1u) : 0xffffffffu;
        const unsigned tmask = (br == 0) ? uni : (((2u << qb) - 1u) & lowm);
        const unsigned qsel = (br == 0) ? mysel : 0xffffffffu;
        const int wlim = (br == 0) ? (1 << 30) : 512;
        const int kcol = UC_NKV + (2 + 2 * br) * 128 + g * 64;
        AttnSt st; attn_init(st);
#pragma unroll 1
        for (int j = 0; j <= qb; ++j) {
            if (!((tmask >> j) & 1u)) continue;
            __syncthreads();
            stage_kv(rowb + (size_t)(j * 64) * UW + kcol, UW, rowb + (size_t)(j * 64) * UW + kcol + 128, UW, Ks, Vt, F.tid);
            __syncthreads();
            f32x16 x0, x1; attn_scores(Ks, qr, x0, x1, r32, hi);
            const bool sel = (qsel >> j) & 1u;
#pragma unroll
            for (int r = 0; r < 16; ++r) { const int d0 = tq - (j * 64 + crow(r, hi)), d1 = d0 - 32;
                x0[r] = (sel && d0 >= 0 && d0 < wlim) ? x0[r] * 0.125f : -INFINITY; x1[r] = (sel && d1 >= 0 && d1 < wlim) ? x1[r] * 0.125f : -INFINITY; }
            attn_online(Vt, x0, x1, st, wsf, r32, hi);
        }
        const float l = st.l + __shfl_xor(st.l, 32), inv = l > 0.f ? 1.0f / l : 0.f;
        attn_scale_rows(st.o0, st.o1, inv, wsf, r32, hi);
#pragma unroll
        for (int r = 0; r < 16; ++r) { const float gt = nsa_gate(gbase, r, 1 + br); ya0[r] += gt * st.o0[r]; ya1[r] += gt * st.o1[r]; }
    }
    bf16_t* yb = Y + (size_t)grow * YW + 1 * 512 + head * 64 + r32;
#pragma unroll
    for (int r = 0; r < 16; ++r) { bf16_t* yp = yb + (size_t)crow(r, hi) * YW; yp[0] = (bf16_t)f2bf(ya0[r]); yp[32] = (bf16_t)f2bf(ya1[r]); }
}

constexpr int SL = 136;
constexpr int SSD_CS = 0, SSD_BS = SSD_CS + 128 * SL * 2, SSD_BT = SSD_BS + 128 * SL * 2, SSD_XT = SSD_BT + 128 * SL * 2, SSD_PV = SSD_XT + 64 * SL * 2,
              SSD_DT = SSD_PV + 64 * SL * 2, SSD_AC = SSD_DT + 512, SSD_A = SSD_AC + 512, SSD_END = SSD_A + 512;
static_assert(SSD_END <= LDS_USER, "ssd lds");
__device__ UNIT_INLINE void ssd_unit(Frame& F, int unit, int L, KArgs KA, const bf16_t* U1, bf16_t* Y, const float* misc, float* ssq) {
    const int h = unit & 7, b = unit >> 3, g = h >> 2;
    LAS bf16_t* Cs = (LAS bf16_t*)(F.lds + SSD_CS); LAS bf16_t* Bs = (LAS bf16_t*)(F.lds + SSD_BS); LAS bf16_t* Bt = (LAS bf16_t*)(F.lds + SSD_BT);
    LAS bf16_t* Xt = (LAS bf16_t*)(F.lds + SSD_XT); LAS bf16_t* Pv = (LAS bf16_t*)(F.lds + SSD_PV);
    LAS float* dts = (LAS float*)(F.lds + SSD_DT); LAS float* acs = (LAS float*)(F.lds + SSD_AC); LAS float* as_ = (LAS float*)(F.lds + SSD_A);
    const float* cw = IN_F(5) + (size_t)L * 4 * 1024; const float* cb = IN_F(6) + (size_t)L * 1024;
    const float dtb = IN_F(7)[L * 8 + h], Ah = -expf(IN_F(8)[L * 8 + h]), Dh = IN_F(9)[L * 8 + h];
    const int r16 = F.lane & 15, kg = F.lane >> 4, w = F.wave;
    const bf16_t* rowb = U1 + (size_t)(b * SEQ) * UW;
    f32x4 stt[4];
#pragma unroll
    for (int j = 0; j < 4; ++j) stt[j] = (f32x4){0.f, 0.f, 0.f, 0.f};
    __syncthreads();
    for (int i = F.tid; i < 64 * SL / 2; i += 512) ((LAS unsigned*)Pv)[i] = 0u;
    for (int c = 0; c < 16; ++c) {
        const int t0 = c * 128;
        __syncthreads();
        for (int i = F.tid; i < 40 * 128; i += 512) {
            const int ch = i % 40, l = i / 40;
            const int cidx = (ch < 8) ? (h * 64 + ch * 8) : (ch < 24 ? 512 + g * 128 + (ch - 8) * 8 : 768 + g * 128 + (ch - 24) * 8);
            float a8[8];
            { const f32x4 b0 = *(const f32x4*)(cb + cidx), b1 = *(const f32x4*)(cb + cidx + 4);
#pragma unroll
              for (int j = 0; j < 4; ++j) { a8[j] = b0[j]; a8[4 + j] = b1[j]; } }
#pragma unroll
            for (int k = 0; k < 4; ++k) {
                const int t = t0 + l - 3 + k;
                if (t >= 0) {
                    const u32x4 xv = *(const u32x4*)(rowb + (size_t)t * UW + UC_XBC + cidx);
                    const f32x4 w0 = *(const f32x4*)(cw + k * 1024 + cidx), w1 = *(const f32x4*)(cw + k * 1024 + cidx + 4);
#pragma unroll
                    for (int j = 0; j < 4; ++j) { a8[2 * j] += bf2f(xv[j] & 0xffffu) * (j < 2 ? w0[2 * j] : w1[2 * j - 4]); a8[2 * j + 1] += bf2f(xv[j] >> 16) * (j < 2 ? w0[2 * j + 1] : w1[2 * j - 3]); }
                }
            }
            unsigned short o[8];
#pragma unroll
            for (int j = 0; j < 8; ++j) o[j] = (unsigned short)f2bf(siluf_(a8[j]));
            if (ch < 8) {
#pragma unroll
                for (int j = 0; j < 8; ++j) Xt[(ch * 8 + j) * SL + l] = o[j];
            } else if (ch < 24) {
                const int n0 = (ch - 8) * 8;
                u32x4 pk; pk.x = o[0] | ((unsigned)o[1] << 16); pk.y = o[2] | ((unsigned)o[3] << 16); pk.z = o[4] | ((unsigned)o[5] << 16); pk.w = o[6] | ((unsigned)o[7] << 16);
                *(LAS u32x4*)(Bs + l * SL + n0) = pk;
#pragma unroll
                for (int j = 0; j < 8; ++j) Bt[(n0 + j) * SL + l] = o[j];
            } else {
                const int n0 = (ch - 24) * 8;
                u32x4 pk; pk.x = o[0] | ((unsigned)o[1] << 16); pk.y = o[2] | ((unsigned)o[3] << 16); pk.z = o[4] | ((unsigned)o[5] << 16); pk.w = o[6] | ((unsigned)o[7] << 16);
                *(LAS u32x4*)(Cs + l * SL + n0) = pk;
            }
        }
        if (F.tid < 128) { const float dt = softplusf_(misc[(size_t)(b * SEQ + t0 + F.tid) * 32 + h] + dtb); dts[F.tid] = dt; as_[F.tid] = dt * Ah; }
        __syncthreads();
        if (F.tid < 128) { float s = 0.f; for (int j = 0; j <= F.tid; ++j) s += as_[j]; acs[F.tid] = s; }
        __syncthreads();
        f32x4 cbv[8];
#pragma unroll
        for (int j = 0; j < 8; ++j) cbv[j] = (f32x4){0.f, 0.f, 0.f, 0.f};
#pragma unroll
        for (int ks = 0; ks < 4; ++ks) {
            const bf16x8 a = *(const LAS bf16x8*)(Cs + (16 * w + r16) * SL + ks * 32 + kg * 8);
#pragma unroll
            for (int j = 0; j < 8; ++j) { const bf16x8 bb = *(const LAS bf16x8*)(Bs + (16 * j + r16) * SL + ks * 32 + kg * 8); cbv[j] = __builtin_amdgcn_mfma_f32_16x16x32_bf16(a, bb, cbv[j], 0, 0, 0); }
        }
        __syncthreads();
        LAS bf16_t* Ws = Bs;
#pragma unroll
        for (int j = 0; j < 8; ++j)
#pragma unroll
            for (int r = 0; r < 4; ++r) { const int l = 16 * w + 4 * kg + r, s = 16 * j + r16;
                const float wv = (s <= l) ? cbv[j][r] * __expf(acs[l] - acs[s]) * dts[s] : 0.f;
                Ws[l * SL + s] = (bf16_t)f2bf(wv); }
        __syncthreads();
        f32x4 yd[4], yo[4];
#pragma unroll
        for (int j = 0; j < 4; ++j) { yd[j] = (f32x4){0.f, 0.f, 0.f, 0.f}; yo[j] = (f32x4){0.f, 0.f, 0.f, 0.f}; }
#pragma unroll
        for (int ks = 0; ks < 4; ++ks) {
            const bf16x8 aw = *(const LAS bf16x8*)(Ws + (16 * w + r16) * SL + ks * 32 + kg * 8);
            const bf16x8 ac = *(const LAS bf16x8*)(Cs + (16 * w + r16) * SL + ks * 32 + kg * 8);
#pragma unroll
            for (int j = 0; j < 4; ++j) {
                const bf16x8 bx = *(const LAS bf16x8*)(Xt + (16 * j + r16) * SL + ks * 32 + kg * 8);
                const bf16x8 bp = *(const LAS bf16x8*)(Pv + (16 * j + r16) * SL + ks * 32 + kg * 8);
                yd[j] = __builtin_amdgcn_mfma_f32_16x16x32_bf16(aw, bx, yd[j], 0, 0, 0);
                yo[j] = __builtin_amdgcn_mfma_f32_16x16x32_bf16(ac, bp, yo[j], 0, 0, 0);
            }
        }
#pragma unroll
        for (int r = 0; r < 4; ++r) {
            const int l = 16 * w + 4 * kg + r; const float ea = __expf(acs[l]); const size_t trow = (size_t)(b * SEQ + t0 + l);
            float sq = 0.f;
#pragma unroll
            for (int j = 0; j < 4; ++j) { const int p = 16 * j + r16;
                const float x = bf2f(Xt[p * SL + l]);
                const float z = bf2f(rowb[(size_t)(t0 + l) * UW + UC_Z + h * 64 + p]);
                const float yv = (yd[j][r] + yo[j][r] * ea + Dh * x) * siluf_(z);
                sq += yv * yv;
                Y[trow * YW + h * 64 + p] = (bf16_t)f2bf(yv); }
            sq += __shfl_xor(sq, 1); sq += __shfl_xor(sq, 2); sq += __shfl_xor(sq, 4); sq += __shfl_xor(sq, 8);
            if (r16 == 0) ssq[trow * 8 + h] = sq;
        }
        __syncthreads();
        { const float aend = acs[127];
          for (int i = F.tid; i < 64 * 128; i += 512) { const int p = i >> 7, l = i & 127; Xt[p * SL + l] = (bf16_t)f2bf(bf2f(Xt[p * SL + l]) * dts[l] * __expf(aend - acs[l])); } }
        __syncthreads();
        { const float cd = __expf(acs[127]); const int pt = w & 3;
#pragma unroll
          for (int j = 0; j < 4; ++j) stt[j] *= cd;
#pragma unroll
          for (int ks = 0; ks < 4; ++ks) {
              const bf16x8 a = *(const LAS bf16x8*)(Xt + (16 * pt + r16) * SL + ks * 32 + kg * 8);
#pragma unroll
              for (int j = 0; j < 4; ++j) { const int nt = (w >> 2) * 4 + j; const bf16x8 bb = *(const LAS bf16x8*)(Bt + (16 * nt + r16) * SL + ks * 32 + kg * 8);
                  stt[j] = __builtin_amdgcn_mfma_f32_16x16x32_bf16(a, bb, stt[j], 0, 0, 0); }
          }
#pragma unroll
          for (int j = 0; j < 4; ++j) { const int nt = (w >> 2) * 4 + j;
#pragma unroll
              for (int r = 0; r < 4; ++r) Pv[(16 * pt + 4 * kg + r) * SL + 16 * nt + r16] = (bf16_t)f2bf(stt[j][r]); }
        }
    }
}

constexpr int RW_CT = 32;
constexpr int RW_R = 0, RW_K = 8192, RW_V = 16384, RW_DEC = 24576, RW_NB = 32768, RW_CC = 40960, RW_G = 49152, RW_OUT = 57344,
              RW_WDH = 65536, RW_ADH = RW_WDH + 32 * 72 * 2, RW_GDH = RW_ADH + 32 * 72 * 2, RW_BS = RW_GDH + 32 * 136 * 2, RW_END = RW_BS + 128;
template <int CTRL> __device__ __forceinline__ float dppf(float x) { return __int_as_float(__builtin_amdgcn_update_dpp(0, __float_as_int(x), CTRL, 0xf, 0xf, false)); }
__device__ __forceinline__ float reduce8(float x) { x += dppf<0xB1>(x); x += dppf<0x4E>(x); x += dppf<0x141>(x); return x; }
struct RwVec { f32x4 nb0, nb1, dc0, dc1, cc0, cc1, kk0, kk1, rr0, rr1; float vv; };
__device__ __forceinline__ RwVec rw_load(const LAS float* sNB, const LAS float* sDEC, const LAS float* sCC, const LAS float* sK, const LAS float* sR, const LAS float* sV, int ti, int kq, int sv) {
    RwVec v; const int o = ti * 64 + kq * 8;
    v.nb0 = *(const LAS f32x4*)(sNB + o); v.nb1 = *(const LAS f32x4*)(sNB + o + 4); v.dc0 = *(const LAS f32x4*)(sDEC + o); v.dc1 = *(const LAS f32x4*)(sDEC + o + 4);
    v.cc0 = *(const LAS f32x4*)(sCC + o); v.cc1 = *(const LAS f32x4*)(sCC + o + 4); v.kk0 = *(const LAS f32x4*)(sK + o); v.kk1 = *(const LAS f32x4*)(sK + o + 4);
    v.rr0 = *(const LAS f32x4*)(sR + o); v.rr1 = *(const LAS f32x4*)(sR + o + 4); v.vv = sV[ti * 64 + sv]; return v;
}
__device__ UNIT_INLINE void rwkv_unit(Frame& F, int unit, int L, KArgs KA, const bf16_t* U1, bf16_t* Y) {
    const int h = unit & 7, b = unit >> 3;
    LAS float* sR = (LAS float*)(F.lds + RW_R); LAS float* sK = (LAS float*)(F.lds + RW_K); LAS float* sV = (LAS float*)(F.lds + RW_V);
    LAS float* sDEC = (LAS float*)(F.lds + RW_DEC); LAS float* sNB = (LAS float*)(F.lds + RW_NB); LAS float* sCC = (LAS float*)(F.lds + RW_CC);
    LAS float* sG = (LAS float*)(F.lds + RW_G); LAS float* sOUT = (LAS float*)(F.lds + RW_OUT);
    LAS bf16_t* sWDh = (LAS bf16_t*)(F.lds + RW_WDH); LAS bf16_t* sADh = (LAS bf16_t*)(F.lds + RW_ADH); LAS bf16_t* sGDh = (LAS bf16_t*)(F.lds + RW_GDH); LAS float* sBS = (LAS float*)(F.lds + RW_BS);
    const float* mu = IN_F(14) + (size_t)L * 1792;
    const int c = F.lane, tg = F.wave, hc = h * 64 + c;
    const float k_k = IN_F(20)[L * 512 + hc], k_a = IN_F(21)[L * 512 + hc], r_k = IN_F(22)[L * 512 + hc];
    const float ln_w = IN_F(23)[L * 512 + hc], ln_b = IN_F(24)[L * 512 + hc];
    const bf16_t* rowb = U1 + (size_t)(b * SEQ) * UW + UC_RW;
    const int mt = F.wave >> 2, nt = F.wave & 3, r16 = F.lane & 15, kg = F.lane >> 4, cn = h * 64 + 16 * nt + r16;
    bf16x8 Bw[2], Ba[2], Bg[4];
    {
        const float* w_up = IN_F(16) + (size_t)L * 64 * 512 + cn; const float* a_up = IN_F(18) + (size_t)L * 64 * 512 + cn; const float* g_up = IN_F(19) + (size_t)L * 128 * 512 + cn;
#pragma unroll
        for (int ks = 0; ks < 2; ++ks) { u32x4 pw, pa;
#pragma unroll
            for (int j = 0; j < 4; ++j) { const int k = 32 * ks + 8 * kg + 2 * j; pw[j] = cvt_pk(w_up[(size_t)k * 512], w_up[(size_t)(k + 1) * 512]); pa[j] = cvt_pk(a_up[(size_t)k * 512], a_up[(size_t)(k + 1) * 512]); }
            Bw[ks] = __builtin_bit_cast(bf16x8, pw); Ba[ks] = __builtin_bit_cast(bf16x8, pa); }
#pragma unroll
        for (int ks = 0; ks < 4; ++ks) { u32x4 pg;
#pragma unroll
            for (int j = 0; j < 4; ++j) { const int k = 32 * ks + 8 * kg + 2 * j; pg[j] = cvt_pk(g_up[(size_t)k * 512], g_up[(size_t)(k + 1) * 512]); }
            Bg[ks] = __builtin_bit_cast(bf16x8, pg); }
    }
    const float w0n = IN_F(15)[L * 512 + cn], a0n = IN_F(17)[L * 512 + cn];
    const int sv = F.tid >> 3, kq = F.tid & 7;
    float st[8];
#pragma unroll
    for (int j = 0; j < 8; ++j) st[j] = 0.f;
#pragma unroll 1
    for (int ck = 0; ck < SEQ / RW_CT; ++ck) {
        const int t0 = ck * RW_CT;
        __syncthreads();
        for (int i = F.tid; i < RW_CT * 56; i += 512) {
            const int ti = i / 56, ch = i % 56; const int t = t0 + ti;
            int col; if (ch < 8) col = h * 64 + ch * 8; else if (ch < 16) col = 512 + h * 64 + (ch - 8) * 8; else if (ch < 24) col = 1024 + h * 64 + (ch - 16) * 8; else col = 1536 + (ch - 24) * 8;
            const u32x4 cur = *(const u32x4*)(rowb + (size_t)t * UW + col);
            u32x4 prv = (u32x4){0u, 0u, 0u, 0u}; if (t > 0) prv = *(const u32x4*)(rowb + (size_t)(t - 1) * UW + col);
            const f32x4 m0 = *(const f32x4*)(mu + col), m1 = *(const f32x4*)(mu + col + 4);
            float y[8];
#pragma unroll
            for (int j = 0; j < 4; ++j) {
                const float x0 = bf2f(cur[j] & 0xffffu), x1 = bf2f(cur[j] >> 16), p0 = bf2f(prv[j] & 0xffffu), p1 = bf2f(prv[j] >> 16);
                y[2 * j] = x0 + (p0 - x0) * (j < 2 ? m0[2 * j] : m1[2 * j - 4]); y[2 * j + 1] = x1 + (p1 - x1) * (j < 2 ? m0[2 * j + 1] : m1[2 * j - 3]);
            }
            if (ch < 24) {
                LAS float* dst = (ch < 8 ? sR + ch * 8 : ch < 16 ? sK + (ch - 8) * 8 : sV + (ch - 16) * 8) + ti * 64;
                *(LAS f32x4*)dst = (f32x4){y[0], y[1], y[2], y[3]}; *(LAS f32x4*)(dst + 4) = (f32x4){y[4], y[5], y[6], y[7]};
            } else {
                LAS bf16_t* dst;
                if (ch < 32) { dst = sWDh + ti * 72 + (ch - 24) * 8;
#pragma unroll
                    for (int j = 0; j < 8; ++j) y[j] = tanhf(y[j]); }
                else if (ch < 40) dst = sADh + ti * 72 + (ch - 32) * 8;
                else { dst = sGDh + ti * 136 + (ch - 40) * 8;
#pragma unroll
                    for (int j = 0; j < 8; ++j) y[j] = sigmoidf_(y[j]); }
                u32x4 pk; pk.x = cvt_pk(y[0], y[1]); pk.y = cvt_pk(y[2], y[3]); pk.z = cvt_pk(y[4], y[5]); pk.w = cvt_pk(y[6], y[7]);
                *(LAS u32x4*)dst = pk;
            }
        }
        __syncthreads();
        {
            f32x4 aw = (f32x4){0.f, 0.f, 0.f, 0.f}, aa = aw, ag = aw;
#pragma unroll
            for (int ks = 0; ks < 2; ++ks) {
                const bf16x8 xw = *(const LAS bf16x8*)(sWDh + (16 * mt + r16) * 72 + 32 * ks + 8 * kg), xa = *(const LAS bf16x8*)(sADh + (16 * mt + r16) * 72 + 32 * ks + 8 * kg);
                aw = __builtin_amdgcn_mfma_f32_16x16x32_bf16(xw, Bw[ks], aw, 0, 0, 0); aa = __builtin_amdgcn_mfma_f32_16x16x32_bf16(xa, Ba[ks], aa, 0, 0, 0);
            }
#pragma unroll
            for (int ks = 0; ks < 4; ++ks) { const bf16x8 xg = *(const LAS bf16x8*)(sGDh + (16 * mt + r16) * 136 + 32 * ks + 8 * kg); ag = __builtin_amdgcn_mfma_f32_16x16x32_bf16(xg, Bg[ks], ag, 0, 0, 0); }
#pragma unroll
            for (int r = 0; r < 4; ++r) { const int o = (16 * mt + 4 * kg + r) * 64 + 16 * nt + r16; sDEC[o] = aw[r] + w0n; sCC[o] = aa[r] + a0n; sG[o] = ag[r]; }
        }
        __syncthreads();
#pragma unroll
        for (int q = 0; q < 4; ++q) {
            const int ti = tg * 4 + q, o = ti * 64 + c;
            const float wv = -softplusf_(-sDEC[o]) - 0.5f; const float dec = __expf(-__expf(wv));
            const float a = sigmoidf_(sCC[o]);
            const float kraw = sK[o], rr = sR[o];
            const float kk = kraw * k_k; const float nrm = fmaxf(sqrtf(wave_sum(kk * kk)), 1e-12f); const float kkn = kk / nrm;
            const float k2 = kraw * (1.0f + (a - 1.0f) * k_a);
            const float bs = wave_sum(rr * k2 * r_k);
            sDEC[o] = dec; sNB[o] = -kkn; sCC[o] = kkn * a; sK[o] = k2;
            if (c == 0) sBS[ti] = bs;
        }
        __syncthreads();
        {
            RwVec cur = rw_load(sNB, sDEC, sCC, sK, sR, sV, 0, kq, sv);
#pragma unroll 4
            for (int ti = 0; ti < RW_CT; ++ti) {
                RwVec nx = cur; if (ti + 1 < RW_CT) nx = rw_load(sNB, sDEC, sCC, sK, sR, sV, ti + 1, kq, sv);
                float sa = ((st[0] * cur.nb0[0] + st[1] * cur.nb0[1]) + (st[2] * cur.nb0[2] + st[3] * cur.nb0[3])) + ((st[4] * cur.nb1[0] + st[5] * cur.nb1[1]) + (st[6] * cur.nb1[2] + st[7] * cur.nb1[3]));
                sa = reduce8(sa);
#pragma unroll
                for (int j = 0; j < 4; ++j) { st[j] = st[j] * cur.dc0[j] + (sa * cur.cc0[j] + cur.vv * cur.kk0[j]); st[4 + j] = st[4 + j] * cur.dc1[j] + (sa * cur.cc1[j] + cur.vv * cur.kk1[j]); }
                float o = ((st[0] * cur.rr0[0] + st[1] * cur.rr0[1]) + (st[2] * cur.rr0[2] + st[3] * cur.rr0[3])) + ((st[4] * cur.rr1[0] + st[5] * cur.rr1[1]) + (st[6] * cur.rr1[2] + st[7] * cur.rr1[3]));
                o = reduce8(o);
                if (kq == 0) sOUT[ti * 64 + sv] = o;
                cur = nx;
            }
        }
        __syncthreads();
#pragma unroll
        for (int q = 0; q < 4; ++q) {
            const int ti = tg * 4 + q; const float o = sOUT[ti * 64 + c];
            const float mean = wave_sum(o) * (1.0f / 64.0f); const float d = o - mean; const float var = wave_sum(d * d) * (1.0f / 64.0f);
            float y = d * rsqrtf(var + 64e-5f) * ln_w + ln_b;
            y += sBS[ti] * sV[ti * 64 + c];
            y *= sG[ti * 64 + c];
            Y[(size_t)(b * SEQ + t0 + ti) * YW + 2 * 512 + hc] = (bf16_t)f2bf(y);
        }
    }
}

__device__ UNIT_INLINE void ssd_fixup_and_pb(Frame& F, int L, KArgs KA, bf16_t* Y, const float* ssq, bf16_t* PB) {
    const int gt = F.bid * 512 + F.tid, NT = F.G * 512;
    const float* nw = IN_F(10) + (size_t)L * 512;
    for (int i = gt; i < T * 64; i += NT) {
        const int t = i >> 6, ch = i & 63, g = ch >> 5;
        const f32x4 q = *(const f32x4*)(ssq + (size_t)t * 8 + g * 4);
        const float rs = rsqrtf(((q[0] + q[1]) + (q[2] + q[3])) * (1.0f / 256.0f) + NORM_EPS);
        bf16_t* yp = Y + (size_t)t * YW + ch * 8;
        const u32x4 v = *(const u32x4*)yp; const f32x4 n0 = *(const f32x4*)(nw + ch * 8), n1 = *(const f32x4*)(nw + ch * 8 + 4);
        u32x4 o;
        o.x = cvt_pk(bf2f(v.x & 0xffffu) * rs * n0[0], bf2f(v.x >> 16) * rs * n0[1]); o.y = cvt_pk(bf2f(v.y & 0xffffu) * rs * n0[2], bf2f(v.y >> 16) * rs * n0[3]);
        o.z = cvt_pk(bf2f(v.z & 0xffffu) * rs * n1[0], bf2f(v.z >> 16) * rs * n1[1]); o.w = cvt_pk(bf2f(v.w & 0xffffu) * rs * n1[2], bf2f(v.w >> 16) * rs * n1[3]);
        *(u32x4*)yp = o;
    }
    const float* p = IN_F(1) + (size_t)L * T * PLE;
    for (int i = gt; i < T * PLE / 8; i += NT) {
        const f32x4 a = *(const f32x4*)(p + (size_t)i * 8), b = *(const f32x4*)(p + (size_t)i * 8 + 4);
        u32x4 o; o.x = cvt_pk(a[0], a[1]); o.y = cvt_pk(a[2], a[3]); o.z = cvt_pk(b[0], b[1]); o.w = cvt_pk(b[2], b[3]);
        *(u32x4*)(PB + (size_t)i * 8) = o;
    }
}
__device__ UNIT_INLINE void moe_router(Frame& F, KArgs KA, const float* xo, unsigned* cnt, int* toke, int* tokp, float* tokw) {
    const int gw = F.bid * 8 + F.wave, NGW = F.G * 8;
    const float* gff = IN_F(31) + DM; const float* router = IN_F(35);
    for (int m = gw; m < T; m += NGW) {
        const f32x4* xr = (const f32x4*)(xo + (size_t)m * DM) + F.lane; f32x4 v[4]; float s = 0.f;
#pragma unroll
        for (int j = 0; j < 4; ++j) { v[j] = xr[64 * j]; s += (v[j][0] * v[j][0] + v[j][1] * v[j][1]) + (v[j][2] * v[j][2] + v[j][3] * v[j][3]); }
        const float rstd = rsqrtf(wave_sum(s) * (1.0f / DM) + NORM_EPS);
        float lg[8];
#pragma unroll
        for (int e = 0; e < 8; ++e) lg[e] = 0.f;
#pragma unroll
        for (int j = 0; j < 4; ++j) { const f32x4 gg = *((const f32x4*)gff + F.lane + 64 * j);
#pragma unroll
            for (int i = 0; i < 4; ++i) { const int k = 4 * F.lane + 256 * j + i; const float hv = v[j][i] * rstd * gg[i];
                const f32x4 r0 = *(const f32x4*)(router + (size_t)k * 8), r1 = *(const f32x4*)(router + (size_t)k * 8 + 4);
                lg[0] += hv * r0[0]; lg[1] += hv * r0[1]; lg[2] += hv * r0[2]; lg[3] += hv * r0[3]; lg[4] += hv * r1[0]; lg[5] += hv * r1[1]; lg[6] += hv * r1[2]; lg[7] += hv * r1[3]; } }
#pragma unroll
        for (int e = 0; e < 8; ++e) lg[e] = wave_sum(lg[e]);
        if (F.lane == 0) {
            int e1 = 0; float v1 = lg[0];
#pragma unroll
            for (int e = 1; e < 8; ++e) if (lg[e] > v1) { v1 = lg[e]; e1 = e; }
            int e2 = -1; float v2 = -INFINITY;
#pragma unroll
            for (int e = 0; e < 8; ++e) if (e != e1 && lg[e] > v2) { v2 = lg[e]; e2 = e; }
            const float ex = __expf(v2 - v1), w1 = 1.0f / (1.0f + ex), w2 = ex / (1.0f + ex);
            const int p1 = (int)atomicAdd(cnt + 64 * e1, 1u), p2 = (int)atomicAdd(cnt + 64 * e2, 1u);
            toke[2 * m] = e1; toke[2 * m + 1] = e2; tokp[2 * m] = p1; tokp[2 * m + 1] = p2; tokw[2 * m] = w1; tokw[2 * m + 1] = w2;
        }
    }
}
__device__ __forceinline__ void moe_tables(const unsigned* cnt, MoeTables& mt, int (&c)[8]) {
#pragma unroll
    for (int e = 0; e < 8; ++e) c[e] = (int)__hip_atomic_load(cnt + 64 * e, RLX_AGENT);
    int ps = 0;
    ps += (c[0] + 255) & ~255; mt.ps1 = ps; ps += (c[1] + 255) & ~255; mt.ps2 = ps; ps += (c[2] + 255) & ~255; mt.ps3 = ps; ps += (c[3] + 255) & ~255; mt.ps4 = ps;
    ps += (c[4] + 255) & ~255; mt.ps5 = ps; ps += (c[5] + 255) & ~255; mt.ps6 = ps; ps += (c[6] + 255) & ~255; mt.ps7 = ps; ps += (c[7] + 255) & ~255; mt.ps8 = ps;
}
__device__ __forceinline__ int moe_pstart(const MoeTables& mt, int e) {
    return e == 0 ? 0 : e == 1 ? mt.ps1 : e == 2 ? mt.ps2 : e == 3 ? mt.ps3 : e == 4 ? mt.ps4 : e == 5 ? mt.ps5 : e == 6 ? mt.ps6 : mt.ps7;
}
__device__ UNIT_INLINE void moe_slots(Frame& F, const float* xo, const float* ss2, const unsigned* cnt, const int* toke, const int* tokp, int* toks, bf16_t* XG, float* srstd) {
    const int gw = F.bid * 8 + F.wave, NGW = F.G * 8;
    MoeTables mt; int c[8]; moe_tables(cnt, mt, c);
    for (int m = gw; m < T; m += NGW) {
        const f32x4* xr = (const f32x4*)(xo + (size_t)m * DM) + F.lane; u32x2 pk[4];
#pragma unroll
        for (int j = 0; j < 4; ++j) pk[j] = pack4(xr[64 * j]);
        const float rs = rstd_of(ss2, m);
#pragma unroll
        for (int k = 0; k < 2; ++k) {
            const int e = toke[2 * m + k], slot = moe_pstart(mt, e) + tokp[2 * m + k];
            u32x2* o = (u32x2*)(XG + (size_t)slot * DM) + F.lane;
#pragma unroll
            for (int j = 0; j < 4; ++j) o[64 * j] = pk[j];
            if (F.lane == 0) { toks[2 * m + k] = slot; srstd[slot] = rs; }
        }
    }
    for (int idx = gw; idx < 8 * 256; idx += NGW) {
        const int e = idx >> 8, r = idx & 255;
        int ce = 0;
#pragma unroll
        for (int q = 0; q < 8; ++q) if (q == e) ce = c[q];
        const int row = moe_pstart(mt, e) + ce + r, end = (e == 7) ? mt.ps8 : moe_pstart(mt, e + 1);
        if (row < end) { u32x2* o = (u32x2*)(XG + (size_t)row * DM) + F.lane;
#pragma unroll
            for (int j = 0; j < 4; ++j) o[64 * j] = (u32x2){0u, 0u};
            if (F.lane == 0) srstd[row] = 0.f; }
    }
}
__device__ UNIT_INLINE void moe_combine(Frame& F, float* xo, const bf16_t* YB, const int* toks, const float* tokw, bf16_t* XB2) {
    const int gw = F.bid * 8 + F.wave, NGW = F.G * 8;
    for (int m = gw; m < T; m += NGW) {
        const int s0 = toks[2 * m], s1 = toks[2 * m + 1]; const float w0 = tokw[2 * m], w1 = tokw[2 * m + 1];
        f32x4* xr = (f32x4*)(xo + (size_t)m * DM) + F.lane; const u32x2* y0 = (const u32x2*)(YB + (size_t)s0 * DM) + F.lane; const u32x2* y1 = (const u32x2*)(YB + (size_t)s1 * DM) + F.lane;
        u32x2* xb = (u32x2*)(XB2 + (size_t)m * DM) + F.lane;
#pragma unroll
        for (int j = 0; j < 4; ++j) { const f32x4 v = xr[64 * j] + (unpack4(y0[64 * j]) * w0 + unpack4(y1[64 * j]) * w1); xr[64 * j] = v; xb[64 * j] = pack4(v); }
    }
}
__device__ UNIT_INLINE void final_norm(Frame& F, KArgs KA, float* xo) {
    const int gw = F.bid * 8 + F.wave, NGW = F.G * 8; const float* gf = IN_F(41);
    for (int m = gw; m < T; m += NGW) {
        f32x4* xr = (f32x4*)(xo + (size_t)m * DM) + F.lane; f32x4 v[4]; float s = 0.f;
#pragma unroll
        for (int j = 0; j < 4; ++j) { v[j] = xr[64 * j]; s += (v[j][0] * v[j][0] + v[j][1] * v[j][1]) + (v[j][2] * v[j][2] + v[j][3] * v[j][3]); }
        const float rstd = rsqrtf(wave_sum(s) * (1.0f / DM) + NORM_EPS);
#pragma unroll
        for (int j = 0; j < 4; ++j) xr[64 * j] = v[j] * rstd * *((const f32x4*)gf + F.lane + 64 * j);
    }
}

constexpr int NPH = 23;
__device__ __forceinline__ unsigned char* opq(unsigned char* p) { asm volatile("" : "+s"(p)); return p; }
__global__ void __launch_bounds__(512, 2) mega_fwd(Args args) {
    extern __shared__ __attribute__((aligned(16))) unsigned char lds_raw[];
    Frame F;
    F.lds = (LAS unsigned char*)lds_raw; F.tid = threadIdx.x; F.lane = F.tid & 63; F.wave = __builtin_amdgcn_readfirstlane(F.tid >> 6);
    F.G = gridDim.x; F.bid = blockIdx.x; F.ws = nullptr; F.ctl = nullptr;
    const int lo = args.ph_lo, hi = args.ph_hi;
    LAS unsigned* s_uid = (LAS unsigned*)(F.lds + LDS_USER + 64);
#if MK_MULTI
#define GSYNC(k) do {} while (0)
#else
#define GSYNC(k) do { if ((k) + 1 < hi) { cg::this_grid().sync(); } } while (0)
#endif
#ifdef ONLY_PH
#define RUN(k) ((k) == ONLY_PH)
#else
#define RUN(k) (lo <= (k) && (k) < hi)
#endif
#define PH_PTRS KArgs KA = kargs(); unsigned char* ws = KA->ws; float* out = KA->out; (void)out; \
    Frame P = F; asm volatile("" : "+s"(P.G), "+s"(P.bid), "+v"(P.tid)); P.lane = P.tid & 63; P.wave = __builtin_amdgcn_readfirstlane(P.tid >> 6); \
    unsigned char* wa = ws + WS_WA + (size_t)L * WA_STRIDE; (void)wa; float* ssb = (float*)(ws + WS_SSP); \
    float* ss1 = ssb + (size_t)(2 * L) * T * 16; float* ss2 = ssb + (size_t)(2 * L + 1) * T * 16; float* ssn = ssb + (size_t)(2 * L + 2) * T * 16; (void)ss1; (void)ss2; (void)ssn; \
    bf16_t* XB = (bf16_t*)(ws + WS_XB); bf16_t* Y = (bf16_t*)(ws + WS_Y); bf16_t* U1 = (bf16_t*)(ws + WS_U1); (void)XB; (void)Y; (void)U1; \
    bf16_t* GATES = (bf16_t*)(ws + WS_GATES); bf16_t* MERGED = (bf16_t*)(ws + WS_MERGED); bf16_t* PB = (bf16_t*)(ws + WS_PB); (void)GATES; (void)MERGED; (void)PB; \
    float* MISC = (float*)(ws + WS_MISC); float* SSQ = (float*)(ws + WS_SSQ); (void)MISC; (void)SSQ; \
    bf16_t* XB2 = (bf16_t*)(ws + (L == 0 ? WS_XB2_L0 : WS_XB2_L1)); (void)XB2;
    const size_t TILE1K = (size_t)256 * 1024 * 2;
    if (RUN(0)) { const int L = 0; PH_PTRS p0_prologue(KA, P); GSYNC(0); }
#pragma unroll 1
    for (int L = 0; L < 2; ++L) {
        const int pb0 = 1 + (L == 0 ? 0 : 9);
        if (RUN(pb0)) { PH_PTRS
            pg8::DenseSched S; S.so.init(64, 22, P.G, P.bid); S.A = (const char*)XB; S.B = (const char*)(wa + WA_IN); S.a_tile = TILE1K; S.b_tile = TILE1K;
            EpiIn E{U1, MISC, ss1};
            pg8::gemm_phase(P.lds, DM, DM, DM, S, E); GSYNC(pb0);
        }
        if (RUN(pb0 + 1)) { PH_PTRS
            rope_pass(P, U1, (const float*)(ws + WS_ROPE), (const float*)(ws + WS_ROPE) + (size_t)T * 32);
            for (int u = P.bid; u < 128; u += P.G) compress_unit(P, u, L, U1, ws);
            GSYNC(pb0 + 1);
        }
        if (RUN(pb0 + 2)) {
            { PH_PTRS
            unsigned* q = (unsigned*)(ws + WS_CTL) + CW_QMIX + 256 * L;
            for (;;) {
                __syncthreads();
                if (P.tid == 0) *s_uid = atomicAdd(q, 1u);
                __syncthreads();
                const int uid = (int)*s_uid;
                if (uid >= 64) break;
#ifndef SKIP_RWKV
                rwkv_unit(P, uid, L, KA, U1, Y);
#endif
            } }
            { PH_PTRS
            unsigned* q = (unsigned*)(ws + WS_CTL) + CW_QMIX + 256 * L;
            for (;;) {
                __syncthreads();
                if (P.tid == 0) *s_uid = atomicAdd(q + 192, 1u);
                __syncthreads();
                const int uid = (int)*s_uid;
                if (uid >= 64) break;
#ifndef SKIP_SSD
                ssd_unit(P, uid, L, KA, U1, Y, MISC, SSQ);
#endif
            } }
            { PH_PTRS
            unsigned* q = (unsigned*)(ws + WS_CTL) + CW_QMIX + 256 * L;
            for (;;) {
                __syncthreads();
                if (P.tid == 0) *s_uid = atomicAdd(q + 64, 1u);
                __syncthreads();
                const int uid = (int)*s_uid;
                if (uid >= 512) break;
#ifndef SKIP_NSA
                nsa_unit(P, uid, U1, Y, MISC, ws);
#endif
            } }
            { PH_PTRS
            unsigned* q = (unsigned*)(ws + WS_CTL) + CW_QMIX + 256 * L;
            for (;;) {
                __syncthreads();
                if (P.tid == 0) *s_uid = atomicAdd(q + 128, 1u);
                __syncthreads();
                const int uid = (int)*s_uid;
                if (uid >= 512) break;
#ifndef SKIP_SWA
                swa_unit(P, uid, U1, Y, IN_F(25) + L * 8);
#endif
            } }
            GSYNC(pb0 + 2);
        }
        if (RUN(pb0 + 3)) { PH_PTRS
            pg8::DenseSched S; S.so.init(64, 16, P.G, P.bid); S.A = (const char*)XB; S.B = (const char*)(wa + WA_GATE); S.a_tile = TILE1K; S.b_tile = TILE1K;
            EpiGates E{GATES, ss1};
            pg8::gemm_phase(P.lds, DM, DM, DM, S, E);
            ssd_fixup_and_pb(P, L, KA, Y, SSQ, PB);
            GSYNC(pb0 + 3);
        }
        if (RUN(pb0 + 4)) {
            { PH_PTRS pg8::DenseSched S; S.so.init(64, 4, P.G, P.bid); S.a_tile = (size_t)256 * YW * 2; S.b_tile = (size_t)256 * 512 * 2;
              S.A = (const char*)Y; S.B = (const char*)(wa + WA_PT);
              EpiBr<0> E{MERGED, GATES}; pg8::gemm_phase(P.lds, YW, 512, 512, S, E); }
            { PH_PTRS pg8::DenseSched S; S.so.init(64, 4, P.G, P.bid); S.a_tile = (size_t)256 * YW * 2; S.b_tile = (size_t)256 * 512 * 2;
              S.A = (const char*)(Y + 512); S.B = (const char*)(wa + WA_PT + 1 * MiB);
              EpiBr<1> E{MERGED, GATES}; pg8::gemm_phase(P.lds, YW, 512, 512, S, E); }
            { PH_PTRS pg8::DenseSched S; S.so.init(64, 4, P.G, P.bid); S.a_tile = (size_t)256 * YW * 2; S.b_tile = (size_t)256 * 512 * 2;
              S.A = (const char*)(Y + 1024); S.B = (const char*)(wa + WA_PT + 2 * MiB);
              EpiBr<2> E{MERGED, GATES}; pg8::gemm_phase(P.lds, YW, 512, 512, S, E); }
            { PH_PTRS pg8::DenseSched S; S.so.init(64, 4, P.G, P.bid); S.a_tile = (size_t)256 * YW * 2; S.b_tile = (size_t)256 * 512 * 2;
              S.A = (const char*)(Y + 1536); S.B = (const char*)(wa + WA_PT + 3 * MiB);
              EpiBr<3> E{MERGED, GATES}; pg8::gemm_phase(P.lds, YW, 512, 512, S, E); }
            GSYNC(pb0 + 4);
        }
        if (RUN(pb0 + 5)) { PH_PTRS
            pg8::DenseSched S; S.so.init(64, 4, P.G, P.bid); S.A = (const char*)MERGED; S.B = (const char*)(wa + WA_OUT); S.a_tile = TILE1K; S.b_tile = TILE1K;
            if (L == 0) { EpiRes<true, true> E{IN_F(0), out, XB, ss2}; pg8::gemm_phase(P.lds, DM, DM, DM, S, E); }
            else { EpiRes<false, true> E{out, out, XB, ss2}; pg8::gemm_phase(P.lds, DM, DM, DM, S, E); }
            GSYNC(pb0 + 5);
        }
        if (L == 0) {
            if (RUN(7)) { PH_PTRS
                pg8::DenseSched S; S.so.init(64, 22, P.G, P.bid); S.A = (const char*)XB; S.B = (const char*)(ws + WS_FGU); S.a_tile = TILE1K; S.b_tile = TILE1K;
                EpiFfn1<false> E{(bf16_t*)(ws + WS_ACT0), ss2};
                pg8::gemm_phase(P.lds, DM, DM, DM, S, E); GSYNC(7);
            }
            if (RUN(8)) { PH_PTRS
                pg8::DenseSched S; S.so.init(64, 4, P.G, P.bid); S.A = (const char*)(ws + WS_ACT0); S.B = (const char*)(ws + WS_FDN); S.a_tile = (size_t)256 * D_FF * 2; S.b_tile = (size_t)256 * D_FF * 2;
                EpiRes<true, false> E{out, out, XB2, nullptr};
                pg8::gemm_phase(P.lds, D_FF, D_FF, D_FF, S, E); GSYNC(8);
            }
        } else {
#define MOE_PTRS unsigned* cnt = (unsigned*)(ws + WS_CTL) + CW_MOECNT; (void)cnt; int* toke = (int*)(ws + WS_TOKE); int* tokp = (int*)(ws + WS_TOKP); float* tokw = (float*)(ws + WS_TOKW); int* toks = (int*)(ws + WS_TOKS); \
            (void)toke; (void)tokp; (void)tokw; (void)toks; float* srstd = (float*)(ws + WS_SRSTD); (void)srstd; \
            bf16_t* XG = (bf16_t*)(ws + WS_XG); bf16_t* ACT1 = (bf16_t*)(ws + WS_ACT1); bf16_t* YB = (bf16_t*)(ws + WS_YB); (void)XG; (void)ACT1; (void)YB;
            if (RUN(16)) { PH_PTRS MOE_PTRS moe_router(P, KA, out, cnt, toke, tokp, tokw); GSYNC(16); }
            if (RUN(17)) { PH_PTRS MOE_PTRS moe_slots(P, out, ss2, cnt, toke, tokp, toks, XG, srstd); GSYNC(17); }
            if (RUN(18)) { PH_PTRS MOE_PTRS
                MoeSched S; int c[8]; moe_tables(cnt, S.mt, c); S.nN = 22; S.G = P.G; S.c = P.bid; S.A = (const char*)XG; S.B = (const char*)(ws + WS_WB); S.a_tile = TILE1K; S.b_tile = TILE1K; S.b_expert = WB_STRIDE;
                EpiFfn1<true> E{ACT1, srstd};
                pg8::gemm_phase(P.lds, DM, DM, DM, S, E); GSYNC(18);
            }
            if (RUN(19)) { PH_PTRS MOE_PTRS
                MoeSched S; int c[8]; moe_tables(cnt, S.mt, c); S.nN = 4; S.G = P.G; S.c = P.bid; S.A = (const char*)ACT1; S.B = (const char*)(ws + WS_WB + WB_DN); S.a_tile = (size_t)256 * D_FF * 2; S.b_tile = (size_t)256 * D_FF * 2; S.b_expert = WB_STRIDE;
                EpiBf16<false> E{YB};
                pg8::gemm_phase(P.lds, D_FF, D_FF, D_FF, S, E); GSYNC(19);
            }
            if (RUN(20)) { PH_PTRS MOE_PTRS moe_combine(P, out, YB, toks, tokw, XB2); GSYNC(20); }
        }
        const int pple = (L == 0) ? 9 : 21;
        if (RUN(pple)) {
            { PH_PTRS pg8::DenseSched S; S.so.init(64, 4, P.G, P.bid); S.A = (const char*)XB2; S.B = (const char*)(wa + WA_PG); S.a_tile = TILE1K; S.b_tile = TILE1K;
              EpiBf16<true> E{MERGED}; pg8::gemm_phase(P.lds, DM, DM, DM, S, E); }
            { PH_PTRS pg8::DenseSched S; S.so.init(64, 4, P.G, P.bid);
              S.A = (const char*)PB; S.B = (const char*)(wa + WA_PP); S.a_tile = (size_t)256 * PLE * 2; S.b_tile = (size_t)256 * PLE * 2;
              if (L == 0) { EpiPle2<true> E{out, MERGED, XB, ssn}; pg8::gemm_phase(P.lds, PLE, PLE, PLE, S, E); }
              else { EpiPle2<false> E{out, MERGED, XB, ssn}; pg8::gemm_phase(P.lds, PLE, PLE, PLE, S, E); } }
            GSYNC(pple);
        }
    }
    if (RUN(22)) { const int L = 0; PH_PTRS final_norm(P, KA, out); }
}

extern "C" void kernel_launch(void* const* d_in, const int* in_sizes, int n_in, void* d_out, int out_size, void* d_ws, size_t ws_size, hipStream_t stream) {
    static int grid = 0;
    if (grid == 0) {
        if (n_in != 42 || out_size != T * DM || ws_size < WS_END) { fprintf(stderr, "kernel_launch: unexpected problem (n_in %d out %d ws %zu)\n", n_in, out_size, ws_size); grid = -1; return; }
        int dev = 0, cus = 0, per_cu = 0;
        hipGetDevice(&dev); hipDeviceGetAttribute(&cus, hipDeviceAttributeMultiprocessorCount, dev);
        hipFuncSetAttribute((const void*)mega_fwd, hipFuncAttributeMaxDynamicSharedMemorySize, LDS_BYTES);
        hipOccupancyMaxActiveBlocksPerMultiprocessor(&per_cu, (const void*)mega_fwd, 512, LDS_BYTES);
        if (per_cu < 1) { fprintf(stderr, "kernel_launch: occupancy query says %d blocks per CU\n", per_cu); per_cu = 1; }
        (void)hipGetLastError();
        grid = cus;
    }
    if (grid < 0) return;
    hipMemsetAsync((char*)d_ws + WS_CTL, 0, CTL_BYTES, stream);
    Args a{};
    for (int i = 0; i < 42; ++i) a.in[i] = d_in[i];
    a.out = (float*)d_out; a.ws = (unsigned char*)d_ws;
#if MK_MULTI
    for (int k = 0; k < NPH; ++k) { a.ph_lo = k; a.ph_hi = k + 1; hipLaunchKernelGGL(mega_fwd, dim3(grid), dim3(512), LDS_BYTES, stream, a); }
#else
    a.ph_lo = 0; a.ph_hi = NPH;
    void* kargs[] = {&a};
    hipError_t e = hipLaunchCooperativeKernel((const void*)mega_fwd, dim3(grid), dim3(512), kargs, LDS_BYTES, stream);
    if (e != hipSuccess) fprintf(stderr, "kernel_launch: cooperative launch failed: %s\n", hipGetErrorString(e));
#endif
}
```

```cpp
#include <hip/hip_runtime.h>
#include <hip/hip_cooperative_groups.h>
#include <cstdio>
#include <cstdint>
namespace cg = cooperative_groups;

#define LAS __attribute__((address_space(3)))
#define GAS __attribute__((address_space(1)))
typedef unsigned short bf16_t;
typedef short bf16x8 __attribute__((ext_vector_type(8)));
typedef short s16x4 __attribute__((ext_vector_type(4)));
typedef float f32x2 __attribute__((ext_vector_type(2)));
typedef float f32x4 __attribute__((ext_vector_type(4)));
typedef float f32x16 __attribute__((ext_vector_type(16)));
typedef unsigned u32x2 __attribute__((ext_vector_type(2)));
typedef unsigned u32x4 __attribute__((ext_vector_type(4)));

#ifdef DIAG_NOINLINE
#define UNIT_INLINE __attribute__((noinline))
#else
#define UNIT_INLINE __forceinline__
#endif
#ifndef REP_PH
#define REP_PH -1
#endif
#ifndef REP_N
#define REP_N 1
#endif
#ifndef REP_UNIT
#define REP_UNIT -1
#endif
#ifndef MK_MULTI
#define MK_MULTI 0
#endif

constexpr int NB = 8, SEQ = 2048, T = NB * SEQ, DM = 1024, HD = 64;
constexpr int D_IN = 9504, D_FF = 2816, NEXP = 8, PLE = 256;
constexpr int UW = 5376;
constexpr int YW = 2048;
constexpr float NORM_EPS = 1e-6f;
constexpr float LOG2E = 1.4426950408889634f;
constexpr int UC_Z = 0, UC_XBC = 512, UC_XS = 512, UC_BM = 1024, UC_CM = 1280, UC_NQ = 1536, UC_NKV = 2048, UC_RW = 2816, UC_SQ = 4608, UC_SKV = 5120;
constexpr int MOE_MAXROWS = 34816;

constexpr size_t MiB = (size_t)1 << 20;
constexpr size_t WS_CTL = 0, CTL_BYTES = 1 * MiB;
constexpr size_t WS_ROPE = 1 * MiB;
constexpr size_t WS_MISC = 5 * MiB;
constexpr size_t WS_KC = 7 * MiB, WS_VC = 7 * MiB + 256 * 1024;
constexpr size_t WS_SSQ = 7 * MiB + 512 * 1024;
constexpr size_t WS_TOKE = 8 * MiB, WS_TOKP = WS_TOKE + 128 * 1024, WS_TOKW = WS_TOKP + 128 * 1024, WS_TOKS = WS_TOKW + 128 * 1024;
constexpr size_t WS_SRSTD = 8 * MiB + 512 * 1024;
constexpr size_t WS_W1T = 9 * MiB;
constexpr size_t WS_W2T = 10 * MiB;
constexpr size_t WS_PEB = 10 * MiB + 64 * 1024;
constexpr size_t WS_LW = 10 * MiB + 128 * 1024;
constexpr size_t WS_WA = 12 * MiB, WA_STRIDE = 28 * MiB;
constexpr size_t WA_IN = 0, WA_GATE = 11 * MiB, WA_PT = 19 * MiB, WA_OUT = 23 * MiB, WA_PG = 25 * MiB, WA_PP = 27 * MiB;
constexpr size_t WS_FGU = 68 * MiB, WS_FDN = 79 * MiB;
constexpr size_t WS_WB = 85 * MiB, WB_STRIDE = 16 * MiB + 512 * 1024, WB_DN = 11 * MiB;
constexpr size_t WS_XB = 217 * MiB;
constexpr size_t WS_Y = 249 * MiB;
constexpr size_t WS_BIG = 313 * MiB;
constexpr size_t WS_U1 = WS_BIG, WS_GATES = WS_BIG, WS_MERGED = WS_BIG + 128 * MiB, WS_PB = WS_BIG + 160 * MiB, WS_ACT0 = WS_BIG;
constexpr size_t WS_XG = WS_XB, WS_ACT1 = 285 * MiB, WS_YB = WS_XB;
constexpr size_t WS_XB2_L0 = WS_Y, WS_XB2_L1 = 300 * MiB;
constexpr size_t WS_SSP = 482 * MiB;
constexpr size_t WS_END = 488 * MiB;
constexpr int CW_BAR = 4096, CW_QMIX = 16384, CW_MOECNT = 9216;

constexpr int RING_BYTES = 131072;
constexpr int LDS_BYTES = 147456;
constexpr int LDS_USER = LDS_BYTES - 1024;
constexpr int MISC_OFF = LDS_USER;

__device__ __forceinline__ float bf2f(unsigned b) { return __uint_as_float(b << 16); }
__device__ __forceinline__ unsigned f2bf(float f) { unsigned u = __float_as_uint(f); return (u + 0x7fffu + ((u >> 16) & 1u)) >> 16; }
__device__ __forceinline__ unsigned cvt_pk(float lo, float hi) { unsigned r; asm volatile("v_cvt_pk_bf16_f32 %0, %1, %2" : "=v"(r) : "v"(lo), "v"(hi)); return r; }
__device__ __forceinline__ float sigmoidf_(float x) { return 1.0f / (1.0f + __expf(-x)); }
__device__ __forceinline__ float siluf_(float x) { return x / (1.0f + __expf(-x)); }
__device__ __forceinline__ float softplusf_(float x) { return x > 20.f ? x : log1pf(expf(x)); }
__device__ __forceinline__ float wave_sum(float v) {
#pragma unroll
    for (int o = 1; o < 64; o <<= 1) v += __shfl_xor(v, o);
    return v;
}
__device__ __forceinline__ float wave_max(float v) {
#pragma unroll
    for (int o = 1; o < 64; o <<= 1) v = fmaxf(v, __shfl_xor(v, o));
    return v;
}
#define RLX_AGENT __ATOMIC_RELAXED, __HIP_MEMORY_SCOPE_AGENT
__device__ __forceinline__ u32x2 ld_agent_u64(const void* p) {
    unsigned long long v = __hip_atomic_load((const unsigned long long*)p, RLX_AGENT);
    u32x2 r; r.x = (unsigned)v; r.y = (unsigned)(v >> 32); return r;
}

__device__ __forceinline__ float ss_total(const float* ssp, int row) {
    const f32x4* p = (const f32x4*)(ssp + (size_t)row * 16); const f32x4 a = p[0], b = p[1], c = p[2], d = p[3];
    return (((a[0] + a[1]) + (a[2] + a[3])) + ((b[0] + b[1]) + (b[2] + b[3]))) + (((c[0] + c[1]) + (c[2] + c[3])) + ((d[0] + d[1]) + (d[2] + d[3])));
}
__device__ __forceinline__ float rstd_of(const float* ssp, int row) { return rsqrtf(ss_total(ssp, row) * (1.0f / DM) + NORM_EPS); }

namespace pg8 {
constexpr int BM = 256, BK = 64, HALF = 128, HTB = HALF * BK * 2, STAGE_BYTES = 8 * HTB, NXCD = 8, WGM = 8;
__host__ __device__ __forceinline__ int lds_byte(int r, int c) { const int st = (r >> 4) * 2 + (c >> 5), rr = r & 15, cc = c & 31, ob = rr * 64 + cc * 2; return st * 1024 + (ob ^ (((ob >> 9) & 1) << 5)); }
__host__ __device__ __forceinline__ void stage_rc(int b, int& R, int& C) { const int st = b / 1024, sb = b % 1024, swz = sb ^ (((sb >> 9) & 1) << 5); R = (st >> 1) * 16 + swz / 64; C = (st & 1) * 32 + (swz % 64) / 2; }

struct Unit { int pm, pn; const char* pa; const char* pb; };

struct StaticOrder {
    int nM, nN, nwg, G, c;
    __device__ void init(int nM_, int nN_, int G_, int c_) { nM = nM_; nN = nN_; nwg = nM * nN; G = G_; c = c_; }
    __device__ bool next(int i, int& pm, int& pn) const {
        const long L = (long)i * G + c; if (L >= nwg) return false;
        int wgid = (int)L; { const int q = nwg / NXCD, r = nwg % NXCD, xcd = wgid % NXCD, off = wgid / NXCD; wgid = (xcd < r ? xcd * (q + 1) : r * (q + 1) + (xcd - r) * q) + off; }
        const int nig = WGM * nN, gid = wgid / nig, fm = gid * WGM, gsz = (nM - fm) < WGM ? (nM - fm) : WGM;
        pm = fm + ((wgid % nig) % gsz); pn = (wgid % nig) / gsz; return true;
    }
};
struct DenseSched {
    StaticOrder so; const char* A; const char* B; size_t a_tile, b_tile;
    __device__ bool next(int i, Unit& u) const { if (!so.next(i, u.pm, u.pn)) return false; u.pa = A + (size_t)u.pm * a_tile; u.pb = B + (size_t)u.pn * b_tile; return true; }
};

template <class Epi, class Sched>
__device__ __forceinline__ void gemm_phase(LAS unsigned char* lds, const int lda, const int ldb, const int K, const Sched& S, const Epi& E) {
    int tid_ = threadIdx.x; asm volatile("" : "+v"(tid_));
    const int tid = tid_, wid = __builtin_amdgcn_readfirstlane(tid >> 6), lane = tid & 63, wr = wid >> 2, wc = wid & 3, fr = lane & 15, fq = lane >> 4;
    int K_ = K; asm volatile("" : "+s"(K_));
    const int nt = K_ / BK;
    unsigned voffA[2], voffB[2];
#pragma unroll
    for (int i = 0; i < 2; ++i) { int R, C; stage_rc(tid * 16 + i * 8192, R, C); voffA[i] = (unsigned)(R * lda + C) * 2u; voffB[i] = (unsigned)(R * ldb + C) * 2u; }
    const size_t kstep = (size_t)(BK * 2);
    const size_t hstepA = (size_t)HALF * lda * 2, hstepB = (size_t)HALF * ldb * 2;
    const unsigned ldsw = (unsigned)wid * 1024u;
    const int aoff = lds_byte(wr * 64 + fr, fq * 8), boff = lds_byte(wc * 32 + fr, fq * 8);
#define PG8_SA(b, h) (((b) * 2 + (h)) * HTB)
#define PG8_SB(b, h) ((4 + (b) * 2 + (h)) * HTB)
#define PG8_STAGE(bufoff, gbase, voff) do { _Pragma("unroll") for (int _i = 0; _i < 2; ++_i) \
        __builtin_amdgcn_global_load_lds((const unsigned*)((const char*)(gbase) + (voff)[_i]), (LAS unsigned*)(lds + (bufoff) + ldsw + _i * 8192), 16, 0, 0); } while (0)
#define PG8_LDA(dst, b, h) do { _Pragma("unroll") for (int m = 0; m < 4; ++m) _Pragma("unroll") for (int k = 0; k < 2; ++k) dst[m][k] = *(const LAS bf16x8*)(lds + PG8_SA(b, h) + aoff + m * 2048 + k * 1024); } while (0)
#define PG8_LDB(dst, b, h) do { _Pragma("unroll") for (int n = 0; n < 2; ++n) _Pragma("unroll") for (int k = 0; k < 2; ++k) dst[n][k] = *(const LAS bf16x8*)(lds + PG8_SB(b, h) + boff + n * 2048 + k * 1024); } while (0)
#define PG8_MMA(ai, bj, At, Bt) do { __builtin_amdgcn_s_setprio(1); _Pragma("unroll") for (int m = 0; m < 4; ++m) _Pragma("unroll") for (int n = 0; n < 2; ++n) _Pragma("unroll") for (int k = 0; k < 2; ++k) \
        acc[ai][bj][m][n] = __builtin_amdgcn_mfma_f32_16x16x32_bf16(Bt[n][k], At[m][k], acc[ai][bj][m][n], 0, 0, 0); __builtin_amdgcn_s_setprio(0); } while (0)
#define PG8_WAIT_V(n) asm volatile("s_waitcnt vmcnt(" #n ")" ::: "memory")
#define PG8_WAIT_L(n) asm volatile("s_waitcnt lgkmcnt(" #n ")" ::: "memory")
#define PG8_BAR __builtin_amdgcn_s_barrier()
#define PG8_SCHED __builtin_amdgcn_sched_barrier(0)
    Unit cur, nxt; int ui = 0;
    if (!S.next(0, cur)) return;
    f32x4 acc[2][2][4][2];
#pragma unroll
    for (int a = 0; a < 2; ++a)
#pragma unroll
        for (int b = 0; b < 2; ++b)
#pragma unroll
            for (int m = 0; m < 4; ++m)
#pragma unroll
                for (int n = 0; n < 2; ++n) acc[a][b][m][n] = (f32x4){0.f, 0.f, 0.f, 0.f};
    bf16x8 At[4][2], B0[2][2], B1[2][2];
    const char* cA = cur.pa; const char* cB = cur.pb;
    PG8_STAGE(PG8_SB(0, 0), cB, voffB); PG8_STAGE(PG8_SB(0, 1), cB + hstepB, voffB); PG8_STAGE(PG8_SA(0, 0), cA, voffA); PG8_STAGE(PG8_SA(0, 1), cA + hstepA, voffA);
    if (wr == 1) PG8_BAR;
    PG8_WAIT_V(2); PG8_BAR;
    PG8_STAGE(PG8_SB(1, 0), cB + kstep, voffB); PG8_STAGE(PG8_SA(1, 0), cA + kstep, voffA); PG8_STAGE(PG8_SB(1, 1), cB + hstepB + kstep, voffB);
    PG8_WAIT_V(6); PG8_BAR;
    for (;;) {
        const bool has_next = S.next(ui + 1, nxt);
        const char* nA = has_next ? nxt.pa : cA; const char* nB = has_next ? nxt.pb : cB;
        for (int t = 0; t < nt; t += 2) {
            const bool last = (t == nt - 2);
            const char* a1 = cA + (size_t)(t + 1) * kstep;
            const char* a2 = last ? nA : cA + (size_t)(t + 2) * kstep; const char* b2 = last ? nB : cB + (size_t)(t + 2) * kstep;
            const char* a3 = a2 + kstep; const char* b3 = b2 + kstep;
            PG8_LDB(B0, 0, 0); PG8_LDB(B1, 0, 1); PG8_SCHED; PG8_LDA(At, 0, 0); PG8_STAGE(PG8_SA(1, 1), a1 + hstepA, voffA);
            PG8_WAIT_V(8); PG8_WAIT_L(0); PG8_BAR; PG8_MMA(0, 0, At, B0); PG8_MMA(0, 1, At, B1); PG8_BAR; PG8_SCHED;
            PG8_LDA(At, 0, 1); PG8_STAGE(PG8_SB(0, 0), b2, voffB); PG8_STAGE(PG8_SB(0, 1), b2 + hstepB, voffB); PG8_STAGE(PG8_SA(0, 0), a2, voffA);
            PG8_WAIT_V(8); PG8_WAIT_L(0); PG8_BAR; PG8_MMA(1, 0, At, B0); PG8_MMA(1, 1, At, B1); PG8_BAR; PG8_SCHED;
            PG8_LDB(B0, 1, 0); PG8_LDB(B1, 1, 1); PG8_SCHED; PG8_LDA(At, 1, 0); PG8_STAGE(PG8_SA(0, 1), a2 + hstepA, voffA);
            PG8_WAIT_V(8); PG8_WAIT_L(0); PG8_BAR; PG8_MMA(0, 0, At, B0); PG8_MMA(0, 1, At, B1); PG8_BAR; PG8_SCHED;
            PG8_LDA(At, 1, 1); PG8_STAGE(PG8_SB(1, 0), b3, voffB); PG8_STAGE(PG8_SB(1, 1), b3 + hstepB, voffB); PG8_STAGE(PG8_SA(1, 0), a3, voffA);
            PG8_WAIT_V(8); PG8_WAIT_L(0); PG8_BAR; PG8_MMA(1, 0, At, B0); PG8_MMA(1, 1, At, B1); PG8_BAR; PG8_SCHED;
        }
        if (wr == 0) PG8_BAR;
        E(acc, cur, wr, wc, fr, fq);
        if (!has_next) break;
#pragma unroll
        for (int a = 0; a < 2; ++a)
#pragma unroll
            for (int b = 0; b < 2; ++b)
#pragma unroll
                for (int m = 0; m < 4; ++m)
#pragma unroll
                    for (int n = 0; n < 2; ++n) acc[a][b][m][n] = (f32x4){0.f, 0.f, 0.f, 0.f};
        cur = nxt; cA = nA; cB = nB; ++ui;
        if (wr == 1) PG8_BAR;
    }
    PG8_WAIT_V(0);
    PG8_BAR;
#undef PG8_SA
#undef PG8_SB
#undef PG8_STAGE
#undef PG8_LDA
#undef PG8_LDB
#undef PG8_MMA
#undef PG8_WAIT_V
#undef PG8_WAIT_L
#undef PG8_BAR
#undef PG8_SCHED
}
}

#define EPI_ROW(u, ai, m) ((u).pm * 256 + (ai) * 128 + wr * 64 + (m) * 16 + fr)
#define EPI_COL(u, bj, n) ((u).pn * 256 + (bj) * 128 + wc * 32 + (n) * 16 + fq * 4)
typedef f32x4 Acc[2][2][4][2];

__device__ __forceinline__ u32x2 pack4(f32x4 v) { u32x2 w; w.x = cvt_pk(v[0], v[1]); w.y = cvt_pk(v[2], v[3]); return w; }
__device__ __forceinline__ f32x4 unpack4(u32x2 w) { f32x4 v; v[0] = bf2f(w.x & 0xffffu); v[1] = bf2f(w.x >> 16); v[2] = bf2f(w.y & 0xffffu); v[3] = bf2f(w.y >> 16); return v; }

struct EpiIn {
    bf16_t* U; float* misc; const float* ss;
    __device__ __forceinline__ void operator()(const Acc& acc, const pg8::Unit& u, int wr, int wc, int fr, int fq) const {
#pragma unroll
        for (int ai = 0; ai < 2; ++ai)
#pragma unroll
            for (int m = 0; m < 4; ++m) {
                const int row = EPI_ROW(u, ai, m); const float rs = rstd_of(ss, row);
                if (u.pn < 21) {
#pragma unroll
                    for (int bj = 0; bj < 2; ++bj)
#pragma unroll
                        for (int n = 0; n < 2; ++n) *(u32x2*)(U + (size_t)row * UW + EPI_COL(u, bj, n)) = pack4(acc[ai][bj][m][n] * rs);
                } else if (wc == 0) {
#pragma unroll
                    for (int n = 0; n < 2; ++n) *(f32x4*)(misc + (size_t)row * 32 + n * 16 + fq * 4) = acc[ai][0][m][n] * rs;
                }
            }
    }
};
struct EpiGates {
    bf16_t* G; const float* ss;
    __device__ __forceinline__ void operator()(const Acc& acc, const pg8::Unit& u, int wr, int wc, int fr, int fq) const {
#pragma unroll
        for (int ai = 0; ai < 2; ++ai)
#pragma unroll
            for (int m = 0; m < 4; ++m) {
                const int row = EPI_ROW(u, ai, m); const float rs = rstd_of(ss, row);
#pragma unroll
                for (int bj = 0; bj < 2; ++bj)
#pragma unroll
                    for (int n = 0; n < 2; ++n) { f32x4 v = acc[ai][bj][m][n] * rs; v[0] = sigmoidf_(v[0]); v[1] = sigmoidf_(v[1]); v[2] = sigmoidf_(v[2]); v[3] = sigmoidf_(v[3]);
                        *(u32x2*)(G + (size_t)row * 4096 + EPI_COL(u, bj, n)) = pack4(v); }
            }
    }
};
template <int MB> struct EpiBr {
    bf16_t* MG; const bf16_t* G;
    __device__ __forceinline__ void operator()(const Acc& acc, const pg8::Unit& u, int wr, int wc, int fr, int fq) const {
#pragma unroll
        for (int ai = 0; ai < 2; ++ai)
#pragma unroll
            for (int m = 0; m < 4; ++m) {
                const int row = EPI_ROW(u, ai, m);
#pragma unroll
                for (int bj = 0; bj < 2; ++bj)
#pragma unroll
                    for (int n = 0; n < 2; ++n) { const int col = EPI_COL(u, bj, n);
                        const f32x4 g = unpack4(*(const u32x2*)(G + (size_t)row * 4096 + MB * 1024 + col));
                        f32x4 v = acc[ai][bj][m][n] * g;
                        bf16_t* mp = MG + (size_t)row * DM + col;
                        if (MB > 0) v += unpack4(ld_agent_u64(mp));
                        *(u32x2*)mp = pack4(v); }
                asm volatile("" ::: "memory");
            }
    }
};
template <bool WRITE_XB, bool ACC_SS> struct EpiRes {
    const float* xin; float* xo; bf16_t* xb; float* ss;
    __device__ __forceinline__ void operator()(const Acc& acc, const pg8::Unit& u, int wr, int wc, int fr, int fq) const {
#pragma unroll
        for (int ai = 0; ai < 2; ++ai)
#pragma unroll
            for (int m = 0; m < 4; ++m) {
                const int row = EPI_ROW(u, ai, m); float s = 0.f;
#pragma unroll
                for (int bj = 0; bj < 2; ++bj)
#pragma unroll
                    for (int n = 0; n < 2; ++n) { const size_t off = (size_t)row * DM + EPI_COL(u, bj, n);
                        const f32x4 v = *(const f32x4*)(xin + off) + acc[ai][bj][m][n];
                        *(f32x4*)(xo + off) = v;
                        if (WRITE_XB) *(u32x2*)(xb + off) = pack4(v);
                        if (ACC_SS) s += (v[0] * v[0] + v[1] * v[1]) + (v[2] * v[2] + v[3] * v[3]); }
                if (ACC_SS) { s += __shfl_xor(s, 16); s += __shfl_xor(s, 32); if (fq == 0) ss[(size_t)row * 16 + u.pn * 4 + wc] = s; }
                asm volatile("" ::: "memory");
            }
    }
};
template <bool MOE> struct EpiFfn1 {
    bf16_t* ACT; const float* ss;
    __device__ __forceinline__ void operator()(const Acc& acc, const pg8::Unit& u, int wr, int wc, int fr, int fq) const {
#pragma unroll
        for (int ai = 0; ai < 2; ++ai)
#pragma unroll
            for (int m = 0; m < 4; ++m) {
                const int row = EPI_ROW(u, ai, m); const float rs = MOE ? ss[row] : rstd_of(ss, row);
#pragma unroll
                for (int n = 0; n < 2; ++n) { const f32x4 g = acc[ai][0][m][n] * rs, up = acc[ai][1][m][n] * rs; f32x4 v;
                    v[0] = siluf_(g[0]) * up[0]; v[1] = siluf_(g[1]) * up[1]; v[2] = siluf_(g[2]) * up[2]; v[3] = siluf_(g[3]) * up[3];
                    *(u32x2*)(ACT + (size_t)row * D_FF + u.pn * 128 + wc * 32 + n * 16 + fq * 4) = pack4(v); }
            }
    }
};
template <bool SIG> struct EpiBf16 {
    bf16_t* O;
    __device__ __forceinline__ void operator()(const Acc& acc, const pg8::Unit& u, int wr, int wc, int fr, int fq) const {
#pragma unroll
        for (int ai = 0; ai < 2; ++ai)
#pragma unroll
            for (int m = 0; m < 4; ++m) {
                const int row = EPI_ROW(u, ai, m);
#pragma unroll
                for (int bj = 0; bj < 2; ++bj)
#pragma unroll
                    for (int n = 0; n < 2; ++n) { f32x4 v = acc[ai][bj][m][n];
                        if (SIG) { v[0] = sigmoidf_(v[0]); v[1] = sigmoidf_(v[1]); v[2] = sigmoidf_(v[2]); v[3] = sigmoidf_(v[3]); }
                        *(u32x2*)(O + (size_t)row * DM + EPI_COL(u, bj, n)) = pack4(v); }
            }
    }
};
template <bool WRITE_XB> struct EpiPle2 {
    float* xo; const bf16_t* G; bf16_t* xb; float* ss;
    __device__ __forceinline__ void operator()(const Acc& acc, const pg8::Unit& u, int wr, int wc, int fr, int fq) const {
#pragma unroll
        for (int ai = 0; ai < 2; ++ai)
#pragma unroll
            for (int m = 0; m < 4; ++m) {
                const int row = EPI_ROW(u, ai, m); float s = 0.f;
#pragma unroll
                for (int bj = 0; bj < 2; ++bj)
#pragma unroll
                    for (int n = 0; n < 2; ++n) { const size_t off = (size_t)row * DM + EPI_COL(u, bj, n);
                        const f32x4 g = unpack4(ld_agent_u64(G + off));
                        const f32x4 v = *(const f32x4*)(xo + off) + g * acc[ai][bj][m][n];
                        *(f32x4*)(xo + off) = v;
                        if (WRITE_XB) *(u32x2*)(xb + off) = pack4(v);
                        s += (v[0] * v[0] + v[1] * v[1]) + (v[2] * v[2] + v[3] * v[3]); }
                s += __shfl_xor(s, 16); s += __shfl_xor(s, 32); if (fq == 0) ss[(size_t)row * 16 + u.pn * 4 + wc] = s;
                asm volatile("" ::: "memory");
            }
    }
};

struct MoeTables { int ps1, ps2, ps3, ps4, ps5, ps6, ps7, ps8; };
__device__ __forceinline__ int moe_expert_of_row(const MoeTables& mt, int row) {
    return (row >= mt.ps1) + (row >= mt.ps2) + (row >= mt.ps3) + (row >= mt.ps4) + (row >= mt.ps5) + (row >= mt.ps6) + (row >= mt.ps7);
}
struct MoeSched {
    MoeTables mt; int nN, G, c; const char* A; const char* B; size_t a_tile, b_tile, b_expert;
    __device__ bool next(int i, pg8::Unit& u) const {
        const long L = (long)i * G + c; const int ntiles = mt.ps8 >> 8;
        if (L >= (long)ntiles * nN) return false;
        u.pm = (int)(L / nN); u.pn = (int)(L % nN);
        const int e = moe_expert_of_row(mt, u.pm * 256);
        u.pa = A + (size_t)u.pm * a_tile; u.pb = B + (size_t)e * b_expert + (size_t)u.pn * b_tile; return true;
    }
};

struct Args { const void* in[42]; float* out; unsigned char* ws; int ph_lo, ph_hi; };
typedef const __attribute__((address_space(4))) Args* KArgs;
__device__ __forceinline__ KArgs kargs() { KArgs p = (KArgs)__builtin_amdgcn_kernarg_segment_ptr(); asm volatile("" : "+s"(p)); return p; }
struct Frame {
    LAS unsigned char* lds; int tid, lane, wave, G, bid;
    unsigned char* ws; unsigned* ctl;
};
#define IN_F(k) ((const float*)KA->in[k])

struct TJob { const float* src; int ldw, K, ncols, ldt, mode; bf16_t* dst; const float* gain; };
__device__ __forceinline__ void tr_item(const TJob& J, LAS float* scr, int item, int lane) {
    const int nblk = J.ncols / 32, kb = item / nblk, nb = item % nblk, k0 = 64 * kb, n0 = 32 * nb;
    const int c = lane & 31;
    const int scol = (J.mode == 3) ? (c < 8 ? 1536 + c : 2816 + c) : n0 + c;
#pragma unroll 8
    for (int i = 0; i < 32; ++i) { const int kk = 2 * i + (lane >> 5); float v = J.src[(size_t)(k0 + kk) * J.ldw + scol]; if (J.gain) v *= J.gain[k0 + kk]; scr[kk * 33 + c] = v; }
    asm volatile("s_waitcnt lgkmcnt(0)" ::: "memory");
    int drow0 = n0;
    if (J.mode == 1 || J.mode == 2) drow0 = (n0 / 128) * 256 + (n0 % 128) + (J.mode == 2 ? 128 : 0);
    const int c8 = lane & 7;
#pragma unroll
    for (int j = 0; j < 4; ++j) { const int n = (lane >> 3) + 8 * j; const LAS float* s = scr + (8 * c8) * 33 + n;
        u32x4 o; o.x = cvt_pk(s[0 * 33], s[1 * 33]); o.y = cvt_pk(s[2 * 33], s[3 * 33]); o.z = cvt_pk(s[4 * 33], s[5 * 33]); o.w = cvt_pk(s[6 * 33], s[7 * 33]);
        *(u32x4*)(J.dst + (size_t)(drow0 + n) * J.ldt + k0 + 8 * c8) = o; }
    asm volatile("s_waitcnt lgkmcnt(0)" ::: "memory");
}
constexpr int NJOBS = 32 + 3 + 24 + 8;
__device__ __forceinline__ bool get_job(KArgs KA, int jid, TJob& J) {
    unsigned char* ws = KA->ws;
    J.gain = nullptr; J.mode = 0;
    if (jid < 32) {
        const int L = jid >> 4, j = jid & 15;
        unsigned char* wa = ws + WS_WA + (size_t)L * WA_STRIDE;
        if (j <= 8) {
            const float* w = IN_F(4) + (size_t)L * DM * D_IN; J.ldw = D_IN; J.K = DM; J.ldt = DM; J.gain = IN_F(3) + L * DM;
            int sc, nc, dr;
            switch (j) { case 0: sc = 0; nc = 512; dr = 0; break; case 1: sc = 512; nc = 1024; dr = 512; break; case 2: sc = 1544; nc = 512; dr = 1536; break;
                case 3: sc = 2056; nc = 768; dr = 2048; break; case 4: sc = 2848; nc = 1792; dr = 2816; break; case 5: sc = 4640; nc = 512; dr = 4608; break;
                case 6: sc = 5152; nc = 256; dr = 5120; break; case 7: sc = 0; nc = 32; dr = 5376; J.mode = 3; break; default: sc = 5408; nc = 4096; dr = 0; break; }
            J.src = w + sc; J.ncols = nc; J.dst = (bf16_t*)(wa + (j == 8 ? WA_GATE : WA_IN)) + (size_t)dr * DM;
            return true;
        }
        if (j <= 12) { const int m = j - 9; J.src = IN_F(26 + m) + (size_t)L * 512 * DM; J.ldw = DM; J.K = 512; J.ncols = DM; J.ldt = 512; J.dst = (bf16_t*)(wa + WA_PT + (size_t)m * MiB); return true; }
        if (j == 13) { J.src = IN_F(30) + (size_t)L * DM * DM; J.ldw = DM; J.K = DM; J.ncols = DM; J.ldt = DM; J.dst = (bf16_t*)(wa + WA_OUT); return true; }
        if (j == 14) { J.src = IN_F(40) + (size_t)L * DM * DM; J.ldw = DM; J.K = DM; J.ncols = DM; J.ldt = DM; J.dst = (bf16_t*)(wa + WA_PG); return true; }
        J.src = IN_F(39) + (size_t)L * PLE * DM; J.ldw = DM; J.K = PLE; J.ncols = DM; J.ldt = PLE; J.dst = (bf16_t*)(wa + WA_PP); return true;
    }
    if (jid < 35) {
        const int j = jid - 32;
        if (j < 2) { J.src = IN_F(32 + j); J.ldw = D_FF; J.K = DM; J.ncols = D_FF; J.ldt = DM; J.gain = IN_F(31); J.mode = 1 + j; J.dst = (bf16_t*)(ws + WS_FGU); return true; }
        J.src = IN_F(34); J.ldw = DM; J.K = D_FF; J.ncols = DM; J.ldt = D_FF; J.dst = (bf16_t*)(ws + WS_FDN); return true;
    }
    if (jid < 59) {
        const int e = (jid - 35) / 3, j = (jid - 35) % 3;
        unsigned char* wb = ws + WS_WB + (size_t)e * WB_STRIDE;
        if (j < 2) { J.src = IN_F(36 + j) + (size_t)e * DM * D_FF; J.ldw = D_FF; J.K = DM; J.ncols = D_FF; J.ldt = DM; J.gain = IN_F(31) + DM; J.mode = 1 + j; J.dst = (bf16_t*)wb; return true; }
        J.src = IN_F(38) + (size_t)e * D_FF * DM; J.ldw = DM; J.K = D_FF; J.ncols = DM; J.ldt = D_FF; J.dst = (bf16_t*)(wb + WB_DN); return true;
    }
    {
        const int j = jid - 59, idx = j & 3;
        if (j < 4) { J.src = IN_F(12) + (size_t)idx * 2048 * 64; J.ldw = 64; J.K = 2048; J.ncols = 64; J.ldt = 2048; J.dst = (bf16_t*)(ws + WS_W1T) + (size_t)idx * 64 * 2048; return true; }
        J.src = IN_F(13) + (size_t)idx * 64 * 64; J.ldw = 64; J.K = 64; J.ncols = 64; J.ldt = 64; J.dst = (bf16_t*)(ws + WS_W2T) + (size_t)idx * 64 * 64; return true;
    }
}
__device__ UNIT_INLINE void p0_prologue(KArgs KA, Frame& F) {
    LAS float* scr = (LAS float*)(F.lds + F.wave * 16384);
    const int gw = F.bid * 8 + F.wave, NGW = F.G * 8;
    unsigned char* ws = KA->ws;
    for (int jid = 0; jid < NJOBS; ++jid) {
        TJob J; get_job(KA, jid, J);
        const int nitems = (J.K / 64) * (J.ncols / 32);
        for (int it = gw; it < nitems; it += NGW) tr_item(J, scr, it, F.lane);
    }
    for (int L = 0; L < 2; ++L) {
        u32x4* z = (u32x4*)((bf16_t*)(ws + WS_WA + (size_t)L * WA_STRIDE + WA_IN) + (size_t)5408 * DM);
        const int n16 = 224 * DM * 2 / 16;
        for (int i = gw * 64 + F.lane; i < n16; i += NGW * 64) z[i] = (u32x4){0u, 0u, 0u, 0u};
    }
    for (int o = gw; o < 256; o += NGW) {
        const int idx = o >> 6, f = o & 63;
        const float* pe = IN_F(11) + (size_t)idx * 2048; const float* w1 = IN_F(12) + (size_t)idx * 2048 * 64 + f; float s = 0.f;
#pragma unroll 8
        for (int k = F.lane; k < 2048; k += 64) s += pe[k] * w1[(size_t)k * 64];
        s = wave_sum(s);
        if (F.lane == 0) ((float*)(ws + WS_PEB))[o] = s;
    }
    for (int i = gw * 64 + F.lane; i < 2 * 8 * 4 * 8 * 64; i += NGW * 64) {
        const int ln = i & 63, fr = (i >> 6) & 7, nt = (i >> 9) & 3, hh = (i >> 11) & 7, LL = i >> 14;
        const int cn = hh * 64 + 16 * nt + (ln & 15), kgl = ln >> 4;
        const float* W = (fr < 2) ? IN_F(16) + (size_t)LL * 64 * 512 : (fr < 4) ? IN_F(18) + (size_t)LL * 64 * 512 : IN_F(19) + (size_t)LL * 128 * 512;
        const int ks = (fr < 2) ? fr : (fr < 4) ? fr - 2 : fr - 4;
        u32x4 o;
#pragma unroll
        for (int j = 0; j < 4; ++j) { const int k = 32 * ks + 8 * kgl + 2 * j; o[j] = cvt_pk(W[(size_t)k * 512 + cn], W[(size_t)(k + 1) * 512 + cn]); }
        ((u32x4*)(ws + WS_LW))[i] = o;
    }
    {
        const float* x = IN_F(0); bf16_t* xb = (bf16_t*)(ws + WS_XB); float* ss = (float*)(ws + WS_SSP);
        for (int m = gw; m < T; m += NGW) {
            const f32x4* xr = (const f32x4*)(x + (size_t)m * DM) + F.lane; float s = 0.f;
            u32x2* o = (u32x2*)(xb + (size_t)m * DM) + F.lane;
#pragma unroll
            for (int j = 0; j < 4; ++j) { const f32x4 v = xr[64 * j]; s += (v[0] * v[0] + v[1] * v[1]) + (v[2] * v[2] + v[3] * v[3]); o[64 * j] = pack4(v); }
            s = wave_sum(s); if (F.lane < 16) ss[(size_t)m * 16 + F.lane] = (F.lane == 0) ? s : 0.f;
        }
    }
    {
        const int* pos = (const int*)KA->in[2]; float* rc = (float*)(ws + WS_ROPE); float* rsn = rc + (size_t)T * 32;
        for (int i = (gw * 64 + F.lane); i < T * 32; i += NGW * 64) {
            const int t = i >> 5, k = i & 31;
            const float inv = (float)exp2(-(double)k * (1.0 / 32.0) * 17.194602975157967);
            const float ang = (float)pos[t] * inv;
            rc[i] = cosf(ang); rsn[i] = sinf(ang);
        }
    }
}

__device__ UNIT_INLINE void rope_pass(Frame& F, bf16_t* U1, const float* rc, const float* rsn) {
    const int gt = F.bid * 512 + F.tid, NT = F.G * 512;
    for (int i = gt; i < T * 40; i += NT) {
        const int t = i / 40, r = i % 40, slot = r >> 2, ch = r & 3;
        bf16_t* base = U1 + (size_t)t * UW + (slot < 8 ? UC_SQ + slot * 64 : UC_SKV + (slot - 8) * 64) + ch * 8;
        const u32x4 a = *(const u32x4*)base, b = *(const u32x4*)(base + 32);
        const f32x4 c0 = *(const f32x4*)(rc + (size_t)t * 32 + ch * 8), c1 = *(const f32x4*)(rc + (size_t)t * 32 + ch * 8 + 4);
        const f32x4 s0 = *(const f32x4*)(rsn + (size_t)t * 32 + ch * 8), s1 = *(const f32x4*)(rsn + (size_t)t * 32 + ch * 8 + 4);
        float x1[8], x2[8], cs[8], sn[8];
#pragma unroll
        for (int j = 0; j < 4; ++j) { x1[2 * j] = bf2f(a[j] & 0xffffu); x1[2 * j + 1] = bf2f(a[j] >> 16); x2[2 * j] = bf2f(b[j] & 0xffffu); x2[2 * j + 1] = bf2f(b[j] >> 16);
            cs[j] = c0[j]; cs[4 + j] = c1[j]; sn[j] = s0[j]; sn[4 + j] = s1[j]; }
        u32x4 oa, ob;
#pragma unroll
        for (int j = 0; j < 4; ++j) {
            const float y1a = x1[2 * j] * cs[2 * j] - x2[2 * j] * sn[2 * j], y1b = x1[2 * j + 1] * cs[2 * j + 1] - x2[2 * j + 1] * sn[2 * j + 1];
            const float y2a = x2[2 * j] * cs[2 * j] + x1[2 * j] * sn[2 * j], y2b = x2[2 * j + 1] * cs[2 * j + 1] + x1[2 * j + 1] * sn[2 * j + 1];
            oa[j] = cvt_pk(y1a, y1b); ob[j] = cvt_pk(y2a, y2b);
        }
        *(u32x4*)base = oa; *(u32x4*)(base + 32) = ob;
    }
}
__device__ UNIT_INLINE void compress_unit(Frame& F, int unit, int L, const bf16_t* U1, unsigned char* ws) {
    const int nc = unit & 3, kv = (unit >> 2) & 1, g = (unit >> 3) & 1, b = unit >> 4;
    const int n0 = nc * 32, tok0 = n0 * 16;
    LAS bf16_t* tok = (LAS bf16_t*)F.lds;
    LAS bf16_t* hid = (LAS bf16_t*)(F.lds + 528 * 72 * 2);
    const bf16_t* src = U1 + (size_t)(b * SEQ) * UW + UC_NKV + kv * 128 + g * 64;
    __syncthreads();
    for (int i = F.tid; i < 528 * 8; i += 512) { const int r = i >> 3, ch = i & 7; const int t = tok0 + r;
        u32x4 v = (u32x4){0u, 0u, 0u, 0u}; if (t < SEQ) v = *(const u32x4*)(src + (size_t)t * UW + ch * 8);
        *(LAS u32x4*)(tok + r * 72 + ch * 8) = v; }
    __syncthreads();
    const int idx = L * 2 + kv;
    const bf16_t* w1t = (const bf16_t*)(ws + WS_W1T) + (size_t)idx * 64 * 2048;
    const bf16_t* w2t = (const bf16_t*)(ws + WS_W2T) + (size_t)idx * 64 * 64;
    const float* peb = (const float*)(ws + WS_PEB) + idx * 64;
    const int mt = F.wave >> 2, ntile = F.wave & 3, r16 = F.lane & 15, kg = F.lane >> 4;
    f32x4 acc = (f32x4){0.f, 0.f, 0.f, 0.f};
    const int nl = mt * 16 + r16;
    const bf16_t* bp = w1t + (size_t)(ntile * 16 + r16) * 2048 + kg * 8;
#pragma unroll 4
    for (int ks = 0; ks < 64; ++ks) {
        const int l = ks >> 1, db = (ks & 1) * 32 + kg * 8;
        const bf16x8 a = *(const LAS bf16x8*)(tok + (16 * nl + l) * 72 + db);
        const bf16x8 bb = *(const bf16x8*)(bp + ks * 32);
        acc = __builtin_amdgcn_mfma_f32_16x16x32_bf16(a, bb, acc, 0, 0, 0);
    }
    { const int f = ntile * 16 + r16; const float pb = peb[f];
#pragma unroll
      for (int r = 0; r < 4; ++r) hid[(mt * 16 + 4 * kg + r) * 72 + f] = (bf16_t)f2bf(siluf_(acc[r] + pb)); }
    __syncthreads();
    f32x4 o = (f32x4){0.f, 0.f, 0.f, 0.f};
#pragma unroll
    for (int ks = 0; ks < 2; ++ks) {
        const bf16x8 a = *(const LAS bf16x8*)(hid + nl * 72 + ks * 32 + kg * 8);
        const bf16x8 bb = *(const bf16x8*)(w2t + (size_t)(ntile * 16 + r16) * 64 + ks * 32 + kg * 8);
        o = __builtin_amdgcn_mfma_f32_16x16x32_bf16(a, bb, o, 0, 0, 0);
    }
    bf16_t* dst = (bf16_t*)(ws + (kv ? WS_VC : WS_KC)) + (size_t)((b * 2 + g) * 128) * 64;
#pragma unroll
    for (int r = 0; r < 4; ++r) { const int n = n0 + mt * 16 + 4 * kg + r; dst[(size_t)n * 64 + ntile * 16 + r16] = (n < 127) ? (bf16_t)f2bf(o[r]) : (bf16_t)0; }
}

__device__ __forceinline__ int crow(int r, int hi) { return (r & 3) + 8 * (r >> 2) + 4 * hi; }
constexpr int KS_LD = 72;
struct AttnSt { float m, l; f32x16 o0, o1; };
__device__ __forceinline__ void attn_init(AttnSt& s) { s.m = -INFINITY; s.l = 0.f;
#pragma unroll
    for (int r = 0; r < 16; ++r) { s.o0[r] = 0.f; s.o1[r] = 0.f; } }
__device__ __forceinline__ void stage_kv(const bf16_t* Kg, int ldk, const bf16_t* Vg, int ldv, LAS bf16_t* Ks, LAS bf16_t* Vt, int tid) {
    const int key = tid >> 3, ch = tid & 7;
    const u32x4 kv = *(const u32x4*)(Kg + (size_t)key * ldk + ch * 8);
    const u32x4 vv = *(const u32x4*)(Vg + (size_t)key * ldv + ch * 8);
    *(LAS u32x4*)(Ks + key * KS_LD + ch * 8) = kv;
#pragma unroll
    for (int j = 0; j < 4; ++j) { Vt[(ch * 8 + 2 * j) * KS_LD + key] = (bf16_t)(vv[j] & 0xffffu); Vt[(ch * 8 + 2 * j + 1) * KS_LD + key] = (bf16_t)(vv[j] >> 16); }
}
__device__ __forceinline__ void attn_scores(const LAS bf16_t* Ks, const bf16x8 (&qr)[4], f32x16& p0, f32x16& p1, int r32, int hi) {
#pragma unroll
    for (int r = 0; r < 16; ++r) { p0[r] = 0.f; p1[r] = 0.f; }
#pragma unroll
    for (int d0 = 0; d0 < 4; ++d0) {
        const bf16x8 k0 = *(const LAS bf16x8*)(Ks + r32 * KS_LD + d0 * 16 + hi * 8);
        const bf16x8 k1 = *(const LAS bf16x8*)(Ks + (32 + r32) * KS_LD + d0 * 16 + hi * 8);
        p0 = __builtin_amdgcn_mfma_f32_32x32x16_bf16(k0, qr[d0], p0, 0, 0, 0);
        p1 = __builtin_amdgcn_mfma_f32_32x32x16_bf16(k1, qr[d0], p1, 0, 0, 0);
    }
}
__device__ __forceinline__ void attn_pv(const LAS bf16_t* Vt, const f32x16& p0, const f32x16& p1, f32x16& o0, f32x16& o1, int r32, int hi) {
    bf16x8 pa[4];
#pragma unroll
    for (int s = 0; s < 2; ++s) {
        u32x4 w0, w1;
#pragma unroll
        for (int j = 0; j < 4; ++j) { w0[j] = cvt_pk(p0[8 * s + 2 * j], p0[8 * s + 2 * j + 1]); w1[j] = cvt_pk(p1[8 * s + 2 * j], p1[8 * s + 2 * j + 1]); }
        pa[s] = __builtin_bit_cast(bf16x8, w0); pa[2 + s] = __builtin_bit_cast(bf16x8, w1);
    }
#pragma unroll
    for (int s = 0; s < 4; ++s) {
        const int kbase = 16 * s + 4 * hi;
#pragma unroll
        for (int dh = 0; dh < 2; ++dh) {
            const LAS bf16_t* vp = Vt + (32 * dh + r32) * KS_LD + kbase;
            const s16x4 lo = *(const LAS s16x4*)vp, hi4 = *(const LAS s16x4*)(vp + 8);
            const bf16x8 vb = (bf16x8){lo[0], lo[1], lo[2], lo[3], hi4[0], hi4[1], hi4[2], hi4[3]};
            if (dh == 0) o0 = __builtin_amdgcn_mfma_f32_32x32x16_bf16(pa[s], vb, o0, 0, 0, 0);
            else         o1 = __builtin_amdgcn_mfma_f32_32x32x16_bf16(pa[s], vb, o1, 0, 0, 0);
        }
    }
}
__device__ __forceinline__ void attn_online(const LAS bf16_t* Vt, f32x16& x0, f32x16& x1, AttnSt& st, LAS float* wsf, int r32, int hi) {
    float mx = -INFINITY;
#pragma unroll
    for (int r = 0; r < 16; ++r) mx = fmaxf(mx, fmaxf(x0[r], x1[r]));
    mx = fmaxf(mx, __shfl_xor(mx, 32));
    const float mn = fmaxf(st.m, mx), ms = (mn == -INFINITY) ? 0.f : mn;
    const float f = exp2f((st.m - ms) * LOG2E);
    if (hi == 0) wsf[r32] = f;
    float rs = 0.f;
#pragma unroll
    for (int r = 0; r < 16; ++r) { x0[r] = exp2f((x0[r] - ms) * LOG2E); x1[r] = exp2f((x1[r] - ms) * LOG2E); rs += x0[r] + x1[r]; }
    st.l = st.l * f + rs; st.m = mn;
    const LAS float* wr_ = wsf + 4 * hi;
#pragma unroll
    for (int r = 0; r < 16; ++r) { const float fr_ = wr_[(r & 3) + 8 * (r >> 2)]; st.o0[r] *= fr_; st.o1[r] *= fr_; }
    attn_pv(Vt, x0, x1, st.o0, st.o1, r32, hi);
}
__device__ __forceinline__ void attn_scale_rows(f32x16& o0, f32x16& o1, float inv, LAS float* wsf, int r32, int hi) {
    if (hi == 0) wsf[r32] = inv;
    const LAS float* wr_ = wsf + 4 * hi;
#pragma unroll
    for (int r = 0; r < 16; ++r) { const float f = wr_[(r & 3) + 8 * (r >> 2)]; o0[r] *= f; o1[r] *= f; }
}

__device__ UNIT_INLINE void swa_unit(Frame& F, int unit, const bf16_t* U1, bf16_t* Y, const float* sinks) {
    const int qb = unit & 31, g = (unit >> 5) & 1, b = unit >> 6;
    const int r32 = F.lane & 31, hi = F.lane >> 5, hr = F.wave >> 1, qs = F.wave & 1, head = g * 4 + hr;
    const int q0 = qb * 64, tq = q0 + qs * 32 + r32;
    LAS bf16_t* Ks = (LAS bf16_t*)F.lds; LAS bf16_t* Vt = Ks + 64 * KS_LD;
    LAS float* wsf = (LAS float*)(F.lds + 2 * 64 * KS_LD * 2) + F.wave * 32;
    const bf16_t* rowb = U1 + (size_t)(b * SEQ) * UW;
    bf16x8 qr[4];
#pragma unroll
    for (int d0 = 0; d0 < 4; ++d0) qr[d0] = *(const bf16x8*)(rowb + (size_t)tq * UW + UC_SQ + head * 64 + d0 * 16 + hi * 8);
    AttnSt st; attn_init(st);
    for (int kt = (qb >= 2 ? qb - 2 : 0); kt <= qb; ++kt) {
        __syncthreads();
        stage_kv(rowb + (size_t)(kt * 64) * UW + UC_SKV + g * 64, UW, rowb + (size_t)(kt * 64) * UW + UC_SKV + 128 + g * 64, UW, Ks, Vt, F.tid);
        __syncthreads();
        f32x16 x0, x1; attn_scores(Ks, qr, x0, x1, r32, hi);
#pragma unroll
        for (int r = 0; r < 16; ++r) { const int s0 = kt * 64 + crow(r, hi), s1 = s0 + 32;
            x0[r] = (tq - s0 >= 0 && tq - s0 < 128) ? x0[r] * 0.125f : -INFINITY;
            x1[r] = (tq - s1 >= 0 && tq - s1 < 128) ? x1[r] * 0.125f : -INFINITY; }
        attn_online(Vt, x0, x1, st, wsf, r32, hi);
    }
    const float l = st.l + __shfl_xor(st.l, 32), sk = sinks[head];
    const float mf = fmaxf(st.m, sk), a = exp2f((st.m - mf) * LOG2E), inv = a / (l * a + exp2f((sk - mf) * LOG2E));
    attn_scale_rows(st.o0, st.o1, inv, wsf, r32, hi);
    bf16_t* yb = Y + (size_t)(b * SEQ + q0 + qs * 32) * YW + 3 * 512 + head * 64 + r32;
#pragma unroll
    for (int r = 0; r < 16; ++r) { bf16_t* yp = yb + (size_t)crow(r, hi) * YW; yp[0] = (bf16_t)f2bf(st.o0[r]); yp[32] = (bf16_t)f2bf(st.o1[r]); }
}

constexpr int NSA_K1_OFF = 2 * 64 * KS_LD * 2;
constexpr int NSA_PS_OFF = 4 * 64 * KS_LD * 2;
constexpr int NSA_IMP_OFF = NSA_PS_OFF + 64 * 128 * 4;
constexpr int NSA_SEL_OFF = NSA_IMP_OFF + 64 * 33 * 4;
__device__ __forceinline__ float nsa_gate(const float* gbase, int r, int i) { return sigmoidf_(gbase[((r & 3) + 8 * (r >> 2)) * 32 + i * 8]); }
__device__ UNIT_INLINE void nsa_unit(Frame& F, int unit, const bf16_t* U1, bf16_t* Y, const float* misc, const unsigned char* ws) {
    const int qb = 31 - (unit & 31), g = (unit >> 5) & 1, b = unit >> 6;
    const int r32 = F.lane & 31, hi = F.lane >> 5, hr = F.wave >> 1, qs = F.wave & 1, head = g * 4 + hr;
    const int q0 = qb * 64, ql = qs * 32 + r32, tq = q0 + ql;
    LAS bf16_t* Ks = (LAS bf16_t*)F.lds; LAS bf16_t* Vt = Ks + 64 * KS_LD;
    LAS bf16_t* Ks1 = (LAS bf16_t*)(F.lds + NSA_K1_OFF); LAS bf16_t* Vt1 = Ks1 + 64 * KS_LD;
    LAS unsigned* psum = (LAS unsigned*)(F.lds + NSA_PS_OFF);
    LAS float* impb = (LAS float*)(F.lds + NSA_IMP_OFF);
    LAS unsigned* selm = (LAS unsigned*)(F.lds + NSA_SEL_OFF);
    LAS float* wsf = (LAS float*)(F.lds + NSA_SEL_OFF + 256) + F.wave * 32;
    const bf16_t* rowb = U1 + (size_t)(b * SEQ) * UW;
    const int grow = b * SEQ + q0 + qs * 32;
    const float* gbase = misc + (size_t)(grow + 4 * hi) * 32 + 8 + head;
    bf16x8 qr[4];
#pragma unroll
    for (int d0 = 0; d0 < 4; ++d0) qr[d0] = *(const bf16x8*)(rowb + (size_t)tq * UW + UC_NQ + head * 64 + d0 * 16 + hi * 8);
    f32x16 ya0, ya1;
#pragma unroll
    for (int r = 0; r < 16; ++r) { ya0[r] = 0.f; ya1[r] = 0.f; }
    __syncthreads();
    for (int i = F.tid; i < 64 * 128; i += 512) psum[i] = 0u;
#ifndef NSA_NO_CMP
    {
        const bf16_t* kc = (const bf16_t*)(ws + WS_KC) + (size_t)((b * 2 + g) * 128) * 64;
        const bf16_t* vc = (const bf16_t*)(ws + WS_VC) + (size_t)((b * 2 + g) * 128) * 64;
        stage_kv(kc, 64, vc, 64, Ks, Vt, F.tid);
        stage_kv(kc + 64 * 64, 64, vc + 64 * 64, 64, Ks1, Vt1, F.tid);
        __syncthreads();
        float m = -INFINITY, l = 0.f;
#pragma unroll 1
        for (int tl = 0; tl < 2; ++tl) {
            f32x16 x0, x1; attn_scores(tl ? Ks1 : Ks, qr, x0, x1, r32, hi);
            float mx = -INFINITY;
#pragma unroll
            for (int r = 0; r < 16; ++r) { const int n0 = tl * 64 + crow(r, hi), n1 = n0 + 32;
                x0[r] = (16 * n0 + 31 <= tq) ? x0[r] * 0.125f : -INFINITY; x1[r] = (16 * n1 + 31 <= tq) ? x1[r] * 0.125f : -INFINITY; mx = fmaxf(mx, fmaxf(x0[r], x1[r])); }
            mx = fmaxf(mx, __shfl_xor(mx, 32));
            const float mn = fmaxf(m, mx), ms = (mn == -INFINITY) ? 0.f : mn;
            float rs = 0.f;
#pragma unroll
            for (int r = 0; r < 16; ++r) rs += exp2f((x0[r] - ms) * LOG2E) + exp2f((x1[r] - ms) * LOG2E);
            l = l * exp2f((m - ms) * LOG2E) + rs; m = mn;
        }
        l += __shfl_xor(l, 32);
        const float inv = l > 0.f ? 1.0f / l : 0.f, ms = (m == -INFINITY) ? 0.f : m;
        f32x16 oc0, oc1;
#pragma unroll
        for (int r = 0; r < 16; ++r) { oc0[r] = 0.f; oc1[r] = 0.f; }
#pragma unroll 1
        for (int tl = 0; tl < 2; ++tl) {
            f32x16 x0, x1; attn_scores(tl ? Ks1 : Ks, qr, x0, x1, r32, hi);
#pragma unroll
            for (int r = 0; r < 16; ++r) { const int n0 = tl * 64 + crow(r, hi), n1 = n0 + 32;
                x0[r] = (16 * n0 + 31 <= tq) ? exp2f((x0[r] * 0.125f - ms) * LOG2E) * inv : 0.f;
                x1[r] = (16 * n1 + 31 <= tq) ? exp2f((x1[r] * 0.125f - ms) * LOG2E) * inv : 0.f;
                atomicAdd((unsigned*)(psum + ql * 128 + n0), (unsigned)(x0[r] * 16777216.0f + 0.5f)); atomicAdd((unsigned*)(psum + ql * 128 + n1), (unsigned)(x1[r] * 16777216.0f + 0.5f)); }
            attn_pv(tl ? Vt1 : Vt, x0, x1, oc0, oc1, r32, hi);
        }
#pragma unroll
        for (int r = 0; r < 16; ++r) { const float gt = nsa_gate(gbase, r, 0); ya0[r] += gt * oc0[r]; ya1[r] += gt * oc1[r]; }
    }
#endif
    __syncthreads();
#ifndef NSA_NO_TOPK
    if (qb <= 7) { if (F.tid < 64) selm[F.tid] = (2u << qb) - 1u; }
    else {
        const int q = F.tid & 63, jg = F.tid >> 6;
#pragma unroll
        for (int jj = 0; jj < 4; ++jj) { const int j = jg * 4 + jj; unsigned sacc = 0u;
#pragma unroll
            for (int d = -1; d <= 3; ++d) { const int n = 4 * j + d; if (n >= 0 && n < 127) sacc += psum[q * 128 + n]; }
            impb[q * 33 + j] = (float)sacc; }
        if (jg == 0) selm[q] = 1u | (1u << qb);
        __syncthreads();
        unsigned bits = 0u;
#pragma unroll 1
        for (int jj = 0; jj < 4; ++jj) { const int j = jg * 4 + jj;
            if (j >= 1 && j < qb) { const float vj = impb[q * 33 + j]; int rank = 0;
#pragma unroll 1
                for (int i2 = 1; i2 < qb; ++i2) { const float vi = impb[q * 33 + i2]; rank += (vi > vj || (vi == vj && i2 < j)) ? 1 : 0; }
                if (rank < 6) bits |= 1u << j; } }
        if (bits) atomicOr((unsigned*)(selm + q), bits);
    }
#endif
    __syncthreads();
    unsigned uni;
    { unsigned v = selm[F.lane];
#pragma unroll
      for (int o = 1; o < 64; o <<= 1) v |= __shfl_xor(v, o);
      uni = __builtin_amdgcn_readfirstlane(v); }
    const unsigned mysel = selm[ql];
#pragma unroll 1
    for (int br = 0; br < 2; ++br) {
        const unsigned lowm = (qb >= 8) ? ~((1u << (qb - 8)) - 1u) : 0xffffffffu;
        const unsigned tmask = (br == 0) ? uni : (((2u << qb) - 1u) & lowm);
        const unsigned qsel = (br == 0) ? mysel : 0xffffffffu;
        const int wlim = (br == 0) ? (1 << 30) : 512;
        const int kcol = UC_NKV + (2 + 2 * br) * 128 + g * 64;
        AttnSt st; attn_init(st);
#pragma unroll 1
        for (int j = 0; j <= qb; ++j) {
            if (!((tmask >> j) & 1u)) continue;
            __syncthreads();
            stage_kv(rowb + (size_t)(j * 64) * UW + kcol, UW, rowb + (size_t)(j * 64) * UW + kcol + 128, UW, Ks, Vt, F.tid);
            __syncthreads();
            f32x16 x0, x1; attn_scores(Ks, qr, x0, x1, r32, hi);
            const bool sel = (qsel >> j) & 1u;
#pragma unroll
            for (int r = 0; r < 16; ++r) { const int d0 = tq - (j * 64 + crow(r, hi)), d1 = d0 - 32;
                x0[r] = (sel && d0 >= 0 && d0 < wlim) ? x0[r] * 0.125f : -INFINITY; x1[r] = (sel && d1 >= 0 && d1 < wlim) ? x1[r] * 0.125f : -INFINITY; }
            attn_online(Vt, x0, x1, st, wsf, r32, hi);
        }
        const float l = st.l + __shfl_xor(st.l, 32), inv = l > 0.f ? 1.0f / l : 0.f;
        attn_scale_rows(st.o0, st.o1, inv, wsf, r32, hi);
#pragma unroll
        for (int r = 0; r < 16; ++r) { const float gt = nsa_gate(gbase, r, 1 + br); ya0[r] += gt * st.o0[r]; ya1[r] += gt * st.o1[r]; }
    }
    bf16_t* yb = Y + (size_t)grow * YW + 1 * 512 + head * 64 + r32;
#pragma unroll
    for (int r = 0; r < 16; ++r) { bf16_t* yp = yb + (size_t)crow(r, hi) * YW; yp[0] = (bf16_t)f2bf(ya0[r]); yp[32] = (bf16_t)f2bf(ya1[r]); }
}

constexpr int SL = 136;
constexpr int SSD_CS = 0, SSD_BS = SSD_CS + 128 * SL * 2, SSD_BT = SSD_BS + 128 * SL * 2, SSD_XT = SSD_BT + 128 * SL * 2, SSD_PV = SSD_XT + 64 * SL * 2,
              SSD_DT = SSD_PV + 64 * SL * 2, SSD_AC = SSD_DT + 512, SSD_A = SSD_AC + 512, SSD_END = SSD_A + 512;
static_assert(SSD_END <= LDS_USER, "ssd lds");
__device__ UNIT_INLINE void ssd_unit(Frame& F, int unit, int L, KArgs KA, const bf16_t* U1, bf16_t* Y, const float* misc, float* ssq) {
    const int h = unit & 7, b = unit >> 3, g = h >> 2;
    LAS bf16_t* Cs = (LAS bf16_t*)(F.lds + SSD_CS); LAS bf16_t* Bs = (LAS bf16_t*)(F.lds + SSD_BS); LAS bf16_t* Bt = (LAS bf16_t*)(F.lds + SSD_BT);
    LAS bf16_t* Xt = (LAS bf16_t*)(F.lds + SSD_XT); LAS bf16_t* Pv = (LAS bf16_t*)(F.lds + SSD_PV);
    LAS float* dts = (LAS float*)(F.lds + SSD_DT); LAS float* acs = (LAS float*)(F.lds + SSD_AC); LAS float* as_ = (LAS float*)(F.lds + SSD_A);
    const float* cw = IN_F(5) + (size_t)L * 4 * 1024; const float* cb = IN_F(6) + (size_t)L * 1024;
    const float dtb = IN_F(7)[L * 8 + h], Ah = -expf(IN_F(8)[L * 8 + h]), Dh = IN_F(9)[L * 8 + h];
    const int r16 = F.lane & 15, kg = F.lane >> 4, w = F.wave;
    const bf16_t* rowb = U1 + (size_t)(b * SEQ) * UW;
    f32x4 stt[4];
#pragma unroll
    for (int j = 0; j < 4; ++j) stt[j] = (f32x4){0.f, 0.f, 0.f, 0.f};
    __syncthreads();
    for (int i = F.tid; i < 64 * SL / 2; i += 512) ((LAS unsigned*)Pv)[i] = 0u;
    for (int c = 0; c < 16; ++c) {
        const int t0 = c * 128;
        __syncthreads();
        for (int i = F.tid; i < 40 * 128; i += 512) {
            const int ch = i % 40, l = i / 40;
            const int cidx = (ch < 8) ? (h * 64 + ch * 8) : (ch < 24 ? 512 + g * 128 + (ch - 8) * 8 : 768 + g * 128 + (ch - 24) * 8);
            float a8[8];
            { const f32x4 b0 = *(const f32x4*)(cb + cidx), b1 = *(const f32x4*)(cb + cidx + 4);
#pragma unroll
              for (int j = 0; j < 4; ++j) { a8[j] = b0[j]; a8[4 + j] = b1[j]; } }
#pragma unroll
            for (int k = 0; k < 4; ++k) {
                const int t = t0 + l - 3 + k;
                if (t >= 0) {
                    const u32x4 xv = *(const u32x4*)(rowb + (size_t)t * UW + UC_XBC + cidx);
                    const f32x4 w0 = *(const f32x4*)(cw + k * 1024 + cidx), w1 = *(const f32x4*)(cw + k * 1024 + cidx + 4);
#pragma unroll
                    for (int j = 0; j < 4; ++j) { a8[2 * j] += bf2f(xv[j] & 0xffffu) * (j < 2 ? w0[2 * j] : w1[2 * j - 4]); a8[2 * j + 1] += bf2f(xv[j] >> 16) * (j < 2 ? w0[2 * j + 1] : w1[2 * j - 3]); }
                }
            }
            unsigned short o[8];
#pragma unroll
            for (int j = 0; j < 8; ++j) o[j] = (unsigned short)f2bf(siluf_(a8[j]));
            if (ch < 8) {
#pragma unroll
                for (int j = 0; j < 8; ++j) Xt[(ch * 8 + j) * SL + l] = o[j];
            } else if (ch < 24) {
                const int n0 = (ch - 8) * 8;
                u32x4 pk; pk.x = o[0] | ((unsigned)o[1] << 16); pk.y = o[2] | ((unsigned)o[3] << 16); pk.z = o[4] | ((unsigned)o[5] << 16); pk.w = o[6] | ((unsigned)o[7] << 16);
                *(LAS u32x4*)(Bs + l * SL + n0) = pk;
#pragma unroll
                for (int j = 0; j < 8; ++j) Bt[(n0 + j) * SL + l] = o[j];
            } else {
                const int n0 = (ch - 24) * 8;
                u32x4 pk; pk.x = o[0] | ((unsigned)o[1] << 16); pk.y = o[2] | ((unsigned)o[3] << 16); pk.z = o[4] | ((unsigned)o[5] << 16); pk.w = o[6] | ((unsigned)o[7] << 16);
                *(LAS u32x4*)(Cs + l * SL + n0) = pk;
            }
        }
        if (F.tid < 128) { const float dt = softplusf_(misc[(size_t)(b * SEQ + t0 + F.tid) * 32 + h] + dtb); dts[F.tid] = dt; as_[F.tid] = dt * Ah; }
        __syncthreads();
        if (F.tid < 128) { float s = 0.f; for (int j = 0; j <= F.tid; ++j) s += as_[j]; acs[F.tid] = s; }
        __syncthreads();
        f32x4 cbv[8];
#pragma unroll
        for (int j = 0; j < 8; ++j) cbv[j] = (f32x4){0.f, 0.f, 0.f, 0.f};
#pragma unroll
        for (int ks = 0; ks < 4; ++ks) {
            const bf16x8 a = *(const LAS bf16x8*)(Cs + (16 * w + r16) * SL + ks * 32 + kg * 8);
#pragma unroll
            for (int j = 0; j < 8; ++j) { const bf16x8 bb = *(const LAS bf16x8*)(Bs + (16 * j + r16) * SL + ks * 32 + kg * 8); cbv[j] = __builtin_amdgcn_mfma_f32_16x16x32_bf16(a, bb, cbv[j], 0, 0, 0); }
        }
        __syncthreads();
        LAS bf16_t* Ws = Bs;
#pragma unroll
        for (int j = 0; j < 8; ++j)
#pragma unroll
            for (int r = 0; r < 4; ++r) { const int l = 16 * w + 4 * kg + r, s = 16 * j + r16;
                const float wv = (s <= l) ? cbv[j][r] * __expf(acs[l] - acs[s]) * dts[s] : 0.f;
                Ws[l * SL + s] = (bf16_t)f2bf(wv); }
        __syncthreads();
        f32x4 yd[4], yo[4];
#pragma unroll
        for (int j = 0; j < 4; ++j) { yd[j] = (f32x4){0.f, 0.f, 0.f, 0.f}; yo[j] = (f32x4){0.f, 0.f, 0.f, 0.f}; }
#pragma unroll
        for (int ks = 0; ks < 4; ++ks) {
            const bf16x8 aw = *(const LAS bf16x8*)(Ws + (16 * w + r16) * SL + ks * 32 + kg * 8);
            const bf16x8 ac = *(const LAS bf16x8*)(Cs + (16 * w + r16) * SL + ks * 32 + kg * 8);
#pragma unroll
            for (int j = 0; j < 4; ++j) {
                const bf16x8 bx = *(const LAS bf16x8*)(Xt + (16 * j + r16) * SL + ks * 32 + kg * 8);
                const bf16x8 bp = *(const LAS bf16x8*)(Pv + (16 * j + r16) * SL + ks * 32 + kg * 8);
                yd[j] = __builtin_amdgcn_mfma_f32_16x16x32_bf16(aw, bx, yd[j], 0, 0, 0);
                yo[j] = __builtin_amdgcn_mfma_f32_16x16x32_bf16(ac, bp, yo[j], 0, 0, 0);
            }
        }
#pragma unroll
        for (int r = 0; r < 4; ++r) {
            const int l = 16 * w + 4 * kg + r; const float ea = __expf(acs[l]); const size_t trow = (size_t)(b * SEQ + t0 + l);
            float sq = 0.f;
#pragma unroll
            for (int j = 0; j < 4; ++j) { const int p = 16 * j + r16;
                const float x = bf2f(Xt[p * SL + l]);
                const float z = bf2f(rowb[(size_t)(t0 + l) * UW + UC_Z + h * 64 + p]);
                const float yv = (yd[j][r] + yo[j][r] * ea + Dh * x) * siluf_(z);
                sq += yv * yv;
                Y[trow * YW + h * 64 + p] = (bf16_t)f2bf(yv); }
            sq += __shfl_xor(sq, 1); sq += __shfl_xor(sq, 2); sq += __shfl_xor(sq, 4); sq += __shfl_xor(sq, 8);
            if (r16 == 0) ssq[trow * 8 + h] = sq;
        }
        __syncthreads();
        { const float aend = acs[127];
          for (int i = F.tid; i < 64 * 128; i += 512) { const int p = i >> 7, l = i & 127; Xt[p * SL + l] = (bf16_t)f2bf(bf2f(Xt[p * SL + l]) * dts[l] * __expf(aend - acs[l])); } }
        __syncthreads();
        { const float cd = __expf(acs[127]); const int pt = w & 3;
#pragma unroll
          for (int j = 0; j < 4; ++j) stt[j] *= cd;
#pragma unroll
          for (int ks = 0; ks < 4; ++ks) {
              const bf16x8 a = *(const LAS bf16x8*)(Xt + (16 * pt + r16) * SL + ks * 32 + kg * 8);
#pragma unroll
              for (int j = 0; j < 4; ++j) { const int nt = (w >> 2) * 4 + j; const bf16x8 bb = *(const LAS bf16x8*)(Bt + (16 * nt + r16) * SL + ks * 32 + kg * 8);
                  stt[j] = __builtin_amdgcn_mfma_f32_16x16x32_bf16(a, bb, stt[j], 0, 0, 0); }
          }
#pragma unroll
          for (int j = 0; j < 4; ++j) { const int nt = (w >> 2) * 4 + j;
#pragma unroll
              for (int r = 0; r < 4; ++r) Pv[(16 * pt + 4 * kg + r) * SL + 16 * nt + r16] = (bf16_t)f2bf(stt[j][r]); }
        }
    }
}

constexpr int RW_CT = 16, RW_NC = SEQ / RW_CT;
constexpr int RB_DEC = 0, RB_NB = 4096, RB_CC = 8192, RB_K = 12288, RB_R = 16384, RB_V = 20480, RB_G = 24576  , RB_BS = 26624, RB_SIZE = 26880;
constexpr int RW_OUT = 2 * RB_SIZE, RW_WDH = RW_OUT + 2 * 4096, RW_ADH = RW_WDH + 16 * 72 * 2, RW_GDH = RW_ADH + 16 * 72 * 2, RW_CONST = RW_GDH + 16 * 136 * 2  ,
              RW_MU = RW_CONST + 5 * 256  , RW_LW = RW_MU + 448 * 4  , RW_RAW = RW_LW + 32768,
              RAW_R = 0, RAW_K = 3072, RAW_V = 6144, RAW_L = 9216, RAW_SIZE = 18432, RW_END = RW_RAW + 2 * RAW_SIZE;
static_assert(RW_END <= LDS_USER && RW_RAW % 16 == 0 && RW_LW % 16 == 0, "rwkv lds");
template <int CTRL> __device__ __forceinline__ float dppf(float x) { return __int_as_float(__builtin_amdgcn_update_dpp(0, __float_as_int(x), CTRL, 0xf, 0xf, false)); }
__device__ __forceinline__ float reduce8(float x) { x += dppf<0xB1>(x); x += dppf<0x4E>(x); x += dppf<0x141>(x); return x; }
__device__ __forceinline__ float reduce16(float x) { x = reduce8(x); x += dppf<0x140>(x); return x; }
__device__ __forceinline__ float fast_tanh(float x) { const float e = __expf(2.0f * x); return 1.0f - 2.0f / (e + 1.0f); }
#define RW_BAR() do { asm volatile("s_waitcnt lgkmcnt(0)" ::: "memory"); __builtin_amdgcn_s_barrier(); asm volatile("" ::: "memory"); } while (0)
struct RwEarly { f32x2 nb[4], dc[4]; };
struct RwLate { f32x2 cc[4], kk[4], rr[4]; f32x2 vv; };
__device__ __forceinline__ void rw_load_early(RwEarly& v, const LAS unsigned char* buf, int ti, int kq) {
    const int o = (ti * 64 + kq * 8) * 4;
#pragma unroll
    for (int j = 0; j < 2; ++j) {
        const f32x4 a = *(const LAS f32x4*)(buf + RB_NB + o + 16 * j), b = *(const LAS f32x4*)(buf + RB_DEC + o + 16 * j);
        v.nb[2 * j] = (f32x2){a[0], a[1]}; v.nb[2 * j + 1] = (f32x2){a[2], a[3]}; v.dc[2 * j] = (f32x2){b[0], b[1]}; v.dc[2 * j + 1] = (f32x2){b[2], b[3]};
    }
}
__device__ __forceinline__ void rw_load_late(RwLate& v, const LAS unsigned char* buf, int ti, int kq, int rp) {
    const int o = (ti * 64 + kq * 8) * 4;
#pragma unroll
    for (int j = 0; j < 2; ++j) {
        const f32x4 c = *(const LAS f32x4*)(buf + RB_CC + o + 16 * j), d = *(const LAS f32x4*)(buf + RB_K + o + 16 * j), e = *(const LAS f32x4*)(buf + RB_R + o + 16 * j);
        v.cc[2 * j] = (f32x2){c[0], c[1]}; v.cc[2 * j + 1] = (f32x2){c[2], c[3]}; v.kk[2 * j] = (f32x2){d[0], d[1]}; v.kk[2 * j + 1] = (f32x2){d[2], d[3]};
        v.rr[2 * j] = (f32x2){e[0], e[1]}; v.rr[2 * j + 1] = (f32x2){e[2], e[3]};
    }
    v.vv = *(const LAS f32x2*)(buf + RB_V + (ti * 64 + 2 * rp) * 4);
}
__device__ __forceinline__ void rw_post(const LAS unsigned char* lds, const LAS unsigned char* buf, const LAS float* out, bf16_t* yrow0, int ti, int cg) {
    const int o = ti * 64 + cg * 4;
    const f32x4 x = *(const LAS f32x4*)(out + o), v = *(const LAS f32x4*)((const LAS float*)(buf + RB_V) + o);
    const u32x2 gq = *(const LAS u32x2*)((const LAS bf16_t*)(buf + RB_G) + o);
    const LAS float* cst = (const LAS float*)(lds + RW_CONST) + cg * 4;
    const f32x4 lw = *(const LAS f32x4*)(cst + 192), lb = *(const LAS f32x4*)(cst + 256);
    const float bs = ((const LAS float*)(buf + RB_BS))[ti];
    const float mean = reduce16((x[0] + x[1]) + (x[2] + x[3])) * (1.0f / 64.0f);
    const f32x4 d = x - mean;
    const float rstd = rsqrtf(reduce16((d[0] * d[0] + d[1] * d[1]) + (d[2] * d[2] + d[3] * d[3])) * (1.0f / 64.0f) + 64e-5f);
    const f32x4 g = unpack4(gq);
    const f32x4 y = (d * rstd * lw + lb + v * bs) * g;
    *(u32x2*)(yrow0 + (size_t)ti * YW + cg * 4) = pack4(y);
}
__device__ UNIT_INLINE void rwkv_unit(Frame& F, int unit, int L, KArgs KA, const bf16_t* U1, bf16_t* Y) {
    const int h = unit & 7, b = unit >> 3;
    const bool scanner = F.wave < 4;
    LAS unsigned char* lds = F.lds;
    const bf16_t* rowb = U1 + (size_t)(b * SEQ) * UW + UC_RW;
    bf16_t* ybase = Y + (size_t)(b * SEQ) * YW + 2 * 512 + h * 64;
    const int rp = (F.tid >> 3) & 31, kq = F.tid & 7;
    f32x2 s0[4], s1[4];
#pragma unroll
    for (int j = 0; j < 4; ++j) { s0[j] = (f32x2){0.f, 0.f}; s1[j] = (f32x2){0.f, 0.f}; }
    const int ww = F.wave & 3, wtid = F.tid & 255, r16 = F.lane & 15, kg = F.lane >> 4;
    const int wti = wtid >> 4, wcg = wtid & 15;
    float w0n = 0.f, a0n = 0.f;
    __syncthreads();
    if (!scanner) { const int cn = h * 64 + 16 * ww + r16; w0n = IN_F(15)[L * 512 + cn]; a0n = IN_F(17)[L * 512 + cn]; }
    if (F.tid < 320) { const int v = F.tid >> 6; ((LAS float*)(lds + RW_CONST))[F.tid] = IN_F(20 + v)[L * 512 + h * 64 + (F.tid & 63)]; }
    if (F.tid < 448) { const int i = F.tid; const int col = i < 64 ? h * 64 + i : i < 128 ? 512 + h * 64 + (i - 64) : i < 192 ? 1024 + h * 64 + (i - 128) : 1536 + (i - 192);
        ((LAS float*)(lds + RW_MU))[i] = IN_F(14)[(size_t)L * 1792 + col]; }
    { const u32x4* lw = (const u32x4*)(KA->ws + WS_LW) + (size_t)((L * 8 + h) * 4) * 8 * 64;
      for (int i = F.tid; i < 2048; i += 512) *(LAS u32x4*)(lds + RW_LW + i * 16) = lw[i]; }
    asm volatile("s_waitcnt vmcnt(0)" ::: "memory");
    __syncthreads();
#define RW_DMA(cc) do { const int t0_ = (cc) * RW_CT - 1; LAS unsigned char* rb_ = lds + RW_RAW + ((cc) & 1) * RAW_SIZE; \
        _Pragma("unroll") for (int q_ = 0; q_ < 5; ++q_) { const int ix_ = ww + 4 * q_; if (ix_ < 18) { \
            int tok_, col_, dst_; \
            if (ix_ < 9) { const int kind_ = ix_ / 3, p_ = ix_ % 3; tok_ = 8 * p_ + (F.lane >> 3); col_ = kind_ * 512 + h * 64 + (F.lane & 7) * 8; dst_ = kind_ * 3072 + p_ * 1024; } \
            else { const int p_ = ix_ - 9; tok_ = 2 * p_ + (F.lane >> 5); col_ = 1536 + (F.lane & 31) * 8; dst_ = RAW_L + p_ * 1024; } \
            int t_ = t0_ + (tok_ > 16 ? 16 : tok_); t_ = t_ < 0 ? 0 : t_; \
            __builtin_amdgcn_global_load_lds((const unsigned*)(rowb + (size_t)t_ * UW + col_), (LAS unsigned*)(rb_ + dst_), 16, 0, 0); } } } while (0)
#pragma unroll 1
    for (int ck = -2; ck < RW_NC; ++ck) {
        LAS unsigned char* bcur = lds + (ck & 1) * RB_SIZE;
        LAS unsigned char* bnxt = lds + ((ck + 1) & 1) * RB_SIZE;
        LAS float* ocur = (LAS float*)(lds + RW_OUT + (ck & 1) * 4096); const LAS float* oprv = (const LAS float*)(lds + RW_OUT + ((ck + 1) & 1) * 4096);
        const bool do_scan = scanner && ck >= 0, do_post = !scanner && ck >= 1, do_prep = !scanner && ck + 1 >= 0 && ck + 1 < RW_NC, do_dma = !scanner && ck + 2 < RW_NC;
        RwEarly cur;
        if (do_scan) rw_load_early(cur, bcur, 0, kq);
#define RW_SCAN_SEG(T0) if (do_scan) { _Pragma("unroll") for (int ti = (T0); ti < (T0) + 4; ++ti) { \
            RwLate lt; rw_load_late(lt, bcur, ti, kq, rp); \
            RwEarly nx = cur; if (ti + 1 < RW_CT) rw_load_early(nx, bcur, ti + 1, kq); \
            f32x2 a0 = s0[0] * cur.nb[0], a1 = s1[0] * cur.nb[0]; \
            _Pragma("unroll") for (int j = 1; j < 4; ++j) { a0 += s0[j] * cur.nb[j]; a1 += s1[j] * cur.nb[j]; } \
            const float sa0 = reduce8(a0[0] + a0[1]), sa1 = reduce8(a1[0] + a1[1]); \
            _Pragma("unroll") for (int j = 0; j < 4; ++j) { s0[j] = s0[j] * cur.dc[j] + (lt.cc[j] * sa0 + lt.kk[j] * lt.vv[0]); s1[j] = s1[j] * cur.dc[j] + (lt.cc[j] * sa1 + lt.kk[j] * lt.vv[1]); } \
            f32x2 o0 = s0[0] * lt.rr[0], o1 = s1[0] * lt.rr[0]; \
            _Pragma("unroll") for (int j = 1; j < 4; ++j) { o0 += s0[j] * lt.rr[j]; o1 += s1[j] * lt.rr[j]; } \
            const float q0 = reduce8(o0[0] + o0[1]), q1 = reduce8(o1[0] + o1[1]); \
            if (kq == 0) *(LAS f32x2*)(ocur + ti * 64 + 2 * rp) = (f32x2){q0, q1}; \
            cur = nx; } }
        RW_SCAN_SEG(0)
        if (!scanner) asm volatile("s_waitcnt vmcnt(0)" ::: "memory");
        if (do_dma) RW_DMA(ck + 2);
        if (do_post) rw_post(lds, bnxt, oprv, ybase + (size_t)((ck - 1) * RW_CT) * YW, wti, wcg);
        RW_BAR();
        RW_SCAN_SEG(4)
        if (do_prep) {
            const LAS unsigned char* raw = lds + RW_RAW + ((ck + 1) & 1) * RAW_SIZE;
            const bool first = (ck + 1 == 0);
#pragma unroll
            for (int n = 0; n < 4; ++n) {
                const int i = wtid + 256 * n;
                if (i < 896) {
                    const int kind = i < 768 ? i >> 7 : 5;
                    const int idx = i - (kind < 5 ? kind * 128 : 640);
                    const int tok = kind < 5 ? idx >> 3 : idx >> 4, piece = kind < 5 ? idx & 7 : idx & 15;
                    int so, mo;
                    if (kind < 3) { so = kind * 3072 + (tok + 1) * 128 + piece * 16; mo = kind * 64 + piece * 8; }
                    else { const int lp = (kind == 3 ? 0 : kind == 4 ? 8 : 16) + piece; so = RAW_L + (tok + 1) * 512 + lp * 16; mo = 192 + lp * 8; }
                    const u32x4 rc = *(const LAS u32x4*)(raw + so);
                    u32x4 rv = *(const LAS u32x4*)(raw + so - (kind < 3 ? 128 : 512));
                    if (first && tok == 0) rv = (u32x4){0u, 0u, 0u, 0u};
                    const f32x4 m0 = *(const LAS f32x4*)((const LAS float*)(lds + RW_MU) + mo), m1 = *(const LAS f32x4*)((const LAS float*)(lds + RW_MU) + mo + 4);
                    float y[8];
#pragma unroll
                    for (int j = 0; j < 4; ++j) {
                        const float x0 = bf2f(rc[j] & 0xffffu), x1 = bf2f(rc[j] >> 16), p0 = bf2f(rv[j] & 0xffffu), p1 = bf2f(rv[j] >> 16);
                        y[2 * j] = x0 + (p0 - x0) * (j < 2 ? m0[2 * j] : m1[2 * j - 4]); y[2 * j + 1] = x1 + (p1 - x1) * (j < 2 ? m0[2 * j + 1] : m1[2 * j - 3]);
                    }
                    if (kind < 3) {
                        LAS float* dst = (LAS float*)(bnxt + (kind == 0 ? RB_R : kind == 1 ? RB_K : RB_V)) + tok * 64 + piece * 8;
                        *(LAS f32x4*)dst = (f32x4){y[0], y[1], y[2], y[3]}; *(LAS f32x4*)(dst + 4) = (f32x4){y[4], y[5], y[6], y[7]};
                    } else {
                        LAS bf16_t* dst;
                        if (kind == 3) { dst = (LAS bf16_t*)(lds + RW_WDH) + tok * 72 + piece * 8;
#pragma unroll
                            for (int j = 0; j < 8; ++j) y[j] = fast_tanh(y[j]); }
                        else if (kind == 4) dst = (LAS bf16_t*)(lds + RW_ADH) + tok * 72 + piece * 8;
                        else { dst = (LAS bf16_t*)(lds + RW_GDH) + tok * 136 + piece * 8;
#pragma unroll
                            for (int j = 0; j < 8; ++j) y[j] = sigmoidf_(y[j]); }
                        u32x4 pk; pk.x = cvt_pk(y[0], y[1]); pk.y = cvt_pk(y[2], y[3]); pk.z = cvt_pk(y[4], y[5]); pk.w = cvt_pk(y[6], y[7]);
                        *(LAS u32x4*)dst = pk;
                    }
                }
            }
        }
        RW_BAR();
        RW_SCAN_SEG(8)
        if (do_prep) {
            LAS float* sDEC = (LAS float*)(bnxt + RB_DEC); LAS float* sCC = (LAS float*)(bnxt + RB_CC); LAS bf16_t* sG = (LAS bf16_t*)(bnxt + RB_G);
            const LAS bf16_t* sWDh = (const LAS bf16_t*)(lds + RW_WDH); const LAS bf16_t* sADh = (const LAS bf16_t*)(lds + RW_ADH); const LAS bf16_t* sGDh = (const LAS bf16_t*)(lds + RW_GDH);
            const LAS bf16x8* Bf = (const LAS bf16x8*)(lds + RW_LW) + ww * 8 * 64 + F.lane;
            f32x4 aw = (f32x4){0.f, 0.f, 0.f, 0.f}, aa = aw, ag = aw;
#pragma unroll
            for (int ks = 0; ks < 2; ++ks) {
                const bf16x8 xw = *(const LAS bf16x8*)(sWDh + r16 * 72 + 32 * ks + 8 * kg), xa = *(const LAS bf16x8*)(sADh + r16 * 72 + 32 * ks + 8 * kg);
                aw = __builtin_amdgcn_mfma_f32_16x16x32_bf16(xw, Bf[ks * 64], aw, 0, 0, 0); aa = __builtin_amdgcn_mfma_f32_16x16x32_bf16(xa, Bf[(2 + ks) * 64], aa, 0, 0, 0);
            }
#pragma unroll
            for (int ks = 0; ks < 4; ++ks) { const bf16x8 xg = *(const LAS bf16x8*)(sGDh + r16 * 136 + 32 * ks + 8 * kg); ag = __builtin_amdgcn_mfma_f32_16x16x32_bf16(xg, Bf[(4 + ks) * 64], ag, 0, 0, 0); }
#pragma unroll
            for (int r = 0; r < 4; ++r) { const int o = (4 * kg + r) * 64 + 16 * ww + r16; sDEC[o] = aw[r] + w0n; sCC[o] = aa[r] + a0n; sG[o] = (bf16_t)f2bf(ag[r]); }
        }
        RW_BAR();
        RW_SCAN_SEG(12)
        if (do_prep) {
            const int o = wti * 64 + wcg * 4;
            LAS float* pDEC = (LAS float*)(bnxt + RB_DEC) + o; LAS float* pNB = (LAS float*)(bnxt + RB_NB) + o; LAS float* pCC = (LAS float*)(bnxt + RB_CC) + o;
            LAS float* pK = (LAS float*)(bnxt + RB_K) + o; const LAS float* pR = (const LAS float*)(bnxt + RB_R) + o;
            const LAS float* cst = (const LAS float*)(lds + RW_CONST) + wcg * 4;
            const f32x4 wp = *(const LAS f32x4*)pDEC, ap = *(const LAS f32x4*)pCC, kr = *(const LAS f32x4*)pK, rr = *(const LAS f32x4*)pR;
            const f32x4 ckk = *(const LAS f32x4*)cst, cka = *(const LAS f32x4*)(cst + 64), crk = *(const LAS f32x4*)(cst + 128);
            f32x4 dec, a, kk, k2;
#pragma unroll
            for (int j = 0; j < 4; ++j) {
                const float sp = (-wp[j] > 20.f) ? -wp[j] : __logf(1.0f + __expf(-wp[j]));
                dec[j] = __expf(-__expf(-sp - 0.5f)); a[j] = sigmoidf_(ap[j]);
            }
            kk = kr * ckk; k2 = kr * ((a - 1.0f) * cka + 1.0f);
            const f32x4 bb = rr * k2 * crk;
            const float sq = reduce16((kk[0] * kk[0] + kk[1] * kk[1]) + (kk[2] * kk[2] + kk[3] * kk[3]));
            const float bsum = reduce16((bb[0] + bb[1]) + (bb[2] + bb[3]));
            const float rn = 1.0f / fmaxf(sqrtf(sq), 1e-12f);
            const f32x4 kn = kk * rn;
            *(LAS f32x4*)pDEC = dec; *(LAS f32x4*)pNB = -kn; *(LAS f32x4*)pCC = kn * a; *(LAS f32x4*)pK = k2;
            if (wcg == 0) ((LAS float*)(bnxt + RB_BS))[wti] = bsum;
        }
        RW_BAR();
#undef RW_SCAN_SEG
    }
#undef RW_DMA
    if (!scanner) rw_post(lds, lds + RB_SIZE, (const LAS float*)(lds + RW_OUT + 4096), ybase + (size_t)(SEQ - RW_CT) * YW, wti, wcg);
}

__device__ UNIT_INLINE void ssd_fixup_and_pb(Frame& F, int L, KArgs KA, bf16_t* Y, const float* ssq, bf16_t* PB) {
    const int gt = F.bid * 512 + F.tid, NT = F.G * 512;
    const float* nw = IN_F(10) + (size_t)L * 512;
    for (int i = gt; i < T * 64; i += NT) {
        const int t = i >> 6, ch = i & 63, g = ch >> 5;
        const f32x4 q = *(const f32x4*)(ssq + (size_t)t * 8 + g * 4);
        const float rs = rsqrtf(((q[0] + q[1]) + (q[2] + q[3])) * (1.0f / 256.0f) + NORM_EPS);
        bf16_t* yp = Y + (size_t)t * YW + ch * 8;
        const u32x4 v = *(const u32x4*)yp; const f32x4 n0 = *(const f32x4*)(nw + ch * 8), n1 = *(const f32x4*)(nw + ch * 8 + 4);
        u32x4 o;
        o.x = cvt_pk(bf2f(v.x & 0xffffu) * rs * n0[0], bf2f(v.x >> 16) * rs * n0[1]); o.y = cvt_pk(bf2f(v.y & 0xffffu) * rs * n0[2], bf2f(v.y >> 16) * rs * n0[3]);
        o.z = cvt_pk(bf2f(v.z & 0xffffu) * rs * n1[0], bf2f(v.z >> 16) * rs * n1[1]); o.w = cvt_pk(bf2f(v.w & 0xffffu) * rs * n1[2], bf2f(v.w >> 16) * rs * n1[3]);
        *(u32x4*)yp = o;
    }
    const float* p = IN_F(1) + (size_t)L * T * PLE;
    for (int i = gt; i < T * PLE / 8; i += NT) {
        const f32x4 a = *(const f32x4*)(p + (size_t)i * 8), b = *(const f32x4*)(p + (size_t)i * 8 + 4);
        u32x4 o; o.x = cvt_pk(a[0], a[1]); o.y = cvt_pk(a[2], a[3]); o.z = cvt_pk(b[0], b[1]); o.w = cvt_pk(b[2], b[3]);
        *(u32x4*)(PB + (size_t)i * 8) = o;
    }
}
__device__ UNIT_INLINE void moe_router(Frame& F, KArgs KA, const float* xo, unsigned* cnt, int* toke, int* tokp, float* tokw) {
    const int gw = F.bid * 8 + F.wave, NGW = F.G * 8;
    const float* gff = IN_F(31) + DM; const float* router = IN_F(35);
    for (int m = gw; m < T; m += NGW) {
        const f32x4* xr = (const f32x4*)(xo + (size_t)m * DM) + F.lane; f32x4 v[4]; float s = 0.f;
#pragma unroll
        for (int j = 0; j < 4; ++j) { v[j] = xr[64 * j]; s += (v[j][0] * v[j][0] + v[j][1] * v[j][1]) + (v[j][2] * v[j][2] + v[j][3] * v[j][3]); }
        const float rstd = rsqrtf(wave_sum(s) * (1.0f / DM) + NORM_EPS);
        float lg[8];
#pragma unroll
        for (int e = 0; e < 8; ++e) lg[e] = 0.f;
#pragma unroll
        for (int j = 0; j < 4; ++j) { const f32x4 gg = *((const f32x4*)gff + F.lane + 64 * j);
#pragma unroll
            for (int i = 0; i < 4; ++i) { const int k = 4 * F.lane + 256 * j + i; const float hv = v[j][i] * rstd * gg[i];
                const f32x4 r0 = *(const f32x4*)(router + (size_t)k * 8), r1 = *(const f32x4*)(router + (size_t)k * 8 + 4);
                lg[0] += hv * r0[0]; lg[1] += hv * r0[1]; lg[2] += hv * r0[2]; lg[3] += hv * r0[3]; lg[4] += hv * r1[0]; lg[5] += hv * r1[1]; lg[6] += hv * r1[2]; lg[7] += hv * r1[3]; } }
#pragma unroll
        for (int e = 0; e < 8; ++e) lg[e] = wave_sum(lg[e]);
        if (F.lane == 0) {
            int e1 = 0; float v1 = lg[0];
#pragma unroll
            for (int e = 1; e < 8; ++e) if (lg[e] > v1) { v1 = lg[e]; e1 = e; }
            int e2 = -1; float v2 = -INFINITY;
#pragma unroll
            for (int e = 0; e < 8; ++e) if (e != e1 && lg[e] > v2) { v2 = lg[e]; e2 = e; }
            const float ex = __expf(v2 - v1), w1 = 1.0f / (1.0f + ex), w2 = ex / (1.0f + ex);
            const int p1 = (int)atomicAdd(cnt + 64 * e1, 1u), p2 = (int)atomicAdd(cnt + 64 * e2, 1u);
            toke[2 * m] = e1; toke[2 * m + 1] = e2; tokp[2 * m] = p1; tokp[2 * m + 1] = p2; tokw[2 * m] = w1; tokw[2 * m + 1] = w2;
        }
    }
}
__device__ __forceinline__ void moe_tables(const unsigned* cnt, MoeTables& mt, int (&c)[8]) {
#pragma unroll
    for (int e = 0; e < 8; ++e) c[e] = (int)__hip_atomic_load(cnt + 64 * e, RLX_AGENT);
    int ps = 0;
    ps += (c[0] + 255) & ~255; mt.ps1 = ps; ps += (c[1] + 255) & ~255; mt.ps2 = ps; ps += (c[2] + 255) & ~255; mt.ps3 = ps; ps += (c[3] + 255) & ~255; mt.ps4 = ps;
    ps += (c[4] + 255) & ~255; mt.ps5 = ps; ps += (c[5] + 255) & ~255; mt.ps6 = ps; ps += (c[6] + 255) & ~255; mt.ps7 = ps; ps += (c[7] + 255) & ~255; mt.ps8 = ps;
}
__device__ __forceinline__ int moe_pstart(const MoeTables& mt, int e) {
    return e == 0 ? 0 : e == 1 ? mt.ps1 : e == 2 ? mt.ps2 : e == 3 ? mt.ps3 : e == 4 ? mt.ps4 : e == 5 ? mt.ps5 : e == 6 ? mt.ps6 : mt.ps7;
}
__device__ UNIT_INLINE void moe_slots(Frame& F, const float* xo, const float* ss2, const unsigned* cnt, const int* toke, const int* tokp, int* toks, bf16_t* XG, float* srstd) {
    const int gw = F.bid * 8 + F.wave, NGW = F.G * 8;
    MoeTables mt; int c[8]; moe_tables(cnt, mt, c);
    for (int m = gw; m < T; m += NGW) {
        const f32x4* xr = (const f32x4*)(xo + (size_t)m * DM) + F.lane; u32x2 pk[4];
#pragma unroll
        for (int j = 0; j < 4; ++j) pk[j] = pack4(xr[64 * j]);
        const float rs = rstd_of(ss2, m);
#pragma unroll
        for (int k = 0; k < 2; ++k) {
            const int e = toke[2 * m + k], slot = moe_pstart(mt, e) + tokp[2 * m + k];
            u32x2* o = (u32x2*)(XG + (size_t)slot * DM) + F.lane;
#pragma unroll
            for (int j = 0; j < 4; ++j) o[64 * j] = pk[j];
            if (F.lane == 0) { toks[2 * m + k] = slot; srstd[slot] = rs; }
        }
    }
    for (int idx = gw; idx < 8 * 256; idx += NGW) {
        const int e = idx >> 8, r = idx & 255;
        int ce = 0;
#pragma unroll
        for (int q = 0; q < 8; ++q) if (q == e) ce = c[q];
        const int row = moe_pstart(mt, e) + ce + r, end = (e == 7) ? mt.ps8 : moe_pstart(mt, e + 1);
        if (row < end) { u32x2* o = (u32x2*)(XG + (size_t)row * DM) + F.lane;
#pragma unroll
            for (int j = 0; j < 4; ++j) o[64 * j] = (u32x2){0u, 0u};
            if (F.lane == 0) srstd[row] = 0.f; }
    }
}
__device__ UNIT_INLINE void moe_combine(Frame& F, float* xo, const bf16_t* YB, const int* toks, const float* tokw, bf16_t* XB2) {
    const int gw = F.bid * 8 + F.wave, NGW = F.G * 8;
    for (int m = gw; m < T; m += NGW) {
        const int s0 = toks[2 * m], s1 = toks[2 * m + 1]; const float w0 = tokw[2 * m], w1 = tokw[2 * m + 1];
        f32x4* xr = (f32x4*)(xo + (size_t)m * DM) + F.lane; const u32x2* y0 = (const u32x2*)(YB + (size_t)s0 * DM) + F.lane; const u32x2* y1 = (const u32x2*)(YB + (size_t)s1 * DM) + F.lane;
        u32x2* xb = (u32x2*)(XB2 + (size_t)m * DM) + F.lane;
#pragma unroll
        for (int j = 0; j < 4; ++j) { const f32x4 v = xr[64 * j] + (unpack4(y0[64 * j]) * w0 + unpack4(y1[64 * j]) * w1); xr[64 * j] = v; xb[64 * j] = pack4(v); }
    }
}
__device__ UNIT_INLINE void final_norm(Frame& F, KArgs KA, float* xo) {
    const int gw = F.bid * 8 + F.wave, NGW = F.G * 8; const float* gf = IN_F(41);
    for (int m = gw; m < T; m += NGW) {
        f32x4* xr = (f32x4*)(xo + (size_t)m * DM) + F.lane; f32x4 v[4]; float s = 0.f;
#pragma unroll
        for (int j = 0; j < 4; ++j) { v[j] = xr[64 * j]; s += (v[j][0] * v[j][0] + v[j][1] * v[j][1]) + (v[j][2] * v[j][2] + v[j][3] * v[j][3]); }
        const float rstd = rsqrtf(wave_sum(s) * (1.0f / DM) + NORM_EPS);
#pragma unroll
        for (int j = 0; j < 4; ++j) xr[64 * j] = v[j] * rstd * *((const f32x4*)gf + F.lane + 64 * j);
    }
}


#define XB_TMO      128
#define XB_XCNT(j)  (256  + 64 * (j))
#define XB_XSUB(j)  (1280 + 64 * (j))
#define XB_XGEN(j)  (2304 + 64 * (j))
#define XB_TOP      3328
#define XB_TOPGEN   3392
#define XCD_BAR_WORDS 3456
#define XB_SPIN_CAP (1u << 22)
__device__ __forceinline__ unsigned xb_ld(unsigned* p)              { return __hip_atomic_load(p, __ATOMIC_RELAXED, __HIP_MEMORY_SCOPE_AGENT); }
__device__ __forceinline__ unsigned xb_add(unsigned* p, unsigned v) { return __hip_atomic_fetch_add(p, v, __ATOMIC_RELAXED, __HIP_MEMORY_SCOPE_AGENT); }
__device__ __forceinline__ unsigned xb_xcc_id() { return (unsigned)__builtin_amdgcn_s_getreg((3 << 11) | 20) & 0xFu; }
#define XB_SPIN(cond, bar) do { unsigned _sp = 0; while (cond) { __builtin_amdgcn_s_sleep(1); \
    if ((++_sp & 255u) == 0u) { if (xb_ld(&(bar)[XB_TMO])) break; if (_sp > XB_SPIN_CAP) { atomicAdd(&(bar)[XB_TMO], 1u); break; } } } } while (0)
struct XcdBarrier { unsigned* bar; unsigned x; volatile LAS unsigned* st; };
__device__ __forceinline__ XcdBarrier xcd_barrier_post(unsigned* bar, volatile LAS unsigned* st) {
    XcdBarrier b; b.bar = bar; b.x = xb_xcc_id(); b.st = st;
    if (threadIdx.x == 0) (void)xb_add(&bar[XB_XCNT(b.x)], 1u);
    return b;
}
__device__ __forceinline__ void xcd_barrier_complete(unsigned* bar, unsigned x, unsigned& nloc, unsigned& nx) {
    const unsigned G = gridDim.x * gridDim.y * gridDim.z;
    unsigned sum, cnt, mine, sp = 0u;
    for (;;) {
        sum = 0u; cnt = 0u; mine = 0u;
#pragma unroll
        for (unsigned j = 0; j < 16; ++j) { const unsigned c = xb_ld(&bar[XB_XCNT(j)]); sum += c; cnt += (c > 0u) ? 1u : 0u; mine = (j == x) ? c : mine; }
        if (sum == G) break;
        __builtin_amdgcn_s_sleep(1);
        if ((++sp & 255u) == 0u) { if (xb_ld(&bar[XB_TMO])) break; if (sp > XB_SPIN_CAP) { atomicAdd(&bar[XB_TMO], 1u); break; } }
    }
    nloc = mine > 0u ? mine : 1u; nx = cnt > 0u ? cnt : 1u;
}
__device__ __forceinline__ void xcd_barrier(const XcdBarrier& b, bool leader) {
    asm volatile("s_waitcnt vmcnt(0)" ::: "memory");
    __syncthreads();
    if (leader) {
        unsigned* bar = b.bar;
        __builtin_amdgcn_s_waitcnt(0);
        unsigned nloc = b.st[0], nx = b.st[1];
        if (nloc == 0u) { xcd_barrier_complete(bar, b.x, nloc, nx); b.st[0] = nloc; b.st[1] = nx; }
        const unsigned old = xb_add(&bar[XB_XSUB(b.x)], 1u);
        const unsigned gen = old / nloc;
        if (old + 1u == (gen + 1u) * nloc) {
            __builtin_amdgcn_fence(__ATOMIC_RELEASE, "agent");
            asm volatile("s_waitcnt vmcnt(0)" ::: "memory");
            const unsigned og = xb_add(&bar[XB_TOP], 1u);
            const unsigned tg = og / nx;
            if (og + 1u == (tg + 1u) * nx) xb_add(&bar[XB_TOPGEN], 1u);
            else XB_SPIN(xb_ld(&bar[XB_TOPGEN]) == tg, bar);
            __builtin_amdgcn_fence(__ATOMIC_ACQUIRE, "agent");
            xb_add(&bar[XB_XGEN(b.x)], 1u);
            asm volatile("s_waitcnt vmcnt(0)" ::: "memory");
        } else {
            XB_SPIN(xb_ld(&bar[XB_XGEN(b.x)]) == gen, bar);
            __builtin_amdgcn_fence(__ATOMIC_ACQUIRE, "agent");
            asm volatile("s_waitcnt vmcnt(0)" ::: "memory");
        }
    }
    __syncthreads();
}

constexpr int NPH = 23;
__device__ __forceinline__ unsigned char* opq(unsigned char* p) { asm volatile("" : "+s"(p)); return p; }
__global__ void __launch_bounds__(512, 2) mega_fwd(Args args) {
    extern __shared__ __attribute__((aligned(16))) unsigned char lds_raw[];
    Frame F;
    F.lds = (LAS unsigned char*)lds_raw; F.tid = 0; F.lane = 0; F.wave = __builtin_amdgcn_readfirstlane((int)threadIdx.x >> 6);
    F.G = gridDim.x; F.bid = blockIdx.x; F.ws = nullptr; F.ctl = nullptr;
    const int lo = args.ph_lo, hi = args.ph_hi;
    LAS unsigned* s_uid = (LAS unsigned*)(F.lds + LDS_USER + 64);
    if (threadIdx.x < 16) ((LAS unsigned*)(F.lds + LDS_USER))[threadIdx.x] = 0u;
    __syncthreads();
    (void)xcd_barrier_post((unsigned*)(args.ws + WS_CTL) + CW_BAR, (volatile LAS unsigned*)(F.lds + LDS_USER + 32));
#if MK_MULTI
#define GSYNC(k) do {} while (0)
#else
#define GSYNC(k) do { if ((k) + 1 < hi || rep_ + 1 < ((k) == REP_PH ? REP_N : 1)) { if ((k) == 0) cg::this_grid().sync(); else { XcdBarrier xb_; xb_.bar = (unsigned*)(KA->ws + WS_CTL) + CW_BAR; xb_.x = xb_xcc_id(); xb_.st = (volatile LAS unsigned*)(P.lds + LDS_USER + 32); xcd_barrier(xb_, P.tid == 0); } } } while (0)
#endif
#ifdef ONLY_PH
#define RUN(k) ((k) == ONLY_PH)
#else
#define RUN(k) (lo <= (k) && (k) < hi)
#endif
#define REPS(k) for (int rep_ = 0; rep_ < ((k) == REP_PH ? REP_N : 1); ++rep_)
#define PH_PTRS KArgs KA = kargs(); unsigned char* ws = KA->ws; float* out = KA->out; (void)out; \
    Frame P = F; asm volatile("" : "+s"(P.G), "+s"(P.bid), "+s"(P.wave)); asm volatile("v_mbcnt_lo_u32_b32 %0, -1, 0\n\tv_mbcnt_hi_u32_b32 %0, -1, %0" : "=v"(P.lane)); P.tid = P.wave * 64 + P.lane; \
    unsigned char* wa = ws + WS_WA + (size_t)L * WA_STRIDE; (void)wa; float* ssb = (float*)(ws + WS_SSP); \
    float* ss1 = ssb + (size_t)(2 * L) * T * 16; float* ss2 = ssb + (size_t)(2 * L + 1) * T * 16; float* ssn = ssb + (size_t)(2 * L + 2) * T * 16; (void)ss1; (void)ss2; (void)ssn; \
    bf16_t* XB = (bf16_t*)(ws + WS_XB); bf16_t* Y = (bf16_t*)(ws + WS_Y); bf16_t* U1 = (bf16_t*)(ws + WS_U1); (void)XB; (void)Y; (void)U1; \
    bf16_t* GATES = (bf16_t*)(ws + WS_GATES); bf16_t* MERGED = (bf16_t*)(ws + WS_MERGED); bf16_t* PB = (bf16_t*)(ws + WS_PB); (void)GATES; (void)MERGED; (void)PB; \
    float* MISC = (float*)(ws + WS_MISC); float* SSQ = (float*)(ws + WS_SSQ); (void)MISC; (void)SSQ; \
    bf16_t* XB2 = (bf16_t*)(ws + (L == 0 ? WS_XB2_L0 : WS_XB2_L1)); (void)XB2;
    const size_t TILE1K = (size_t)256 * 1024 * 2;
    if (RUN(0)) REPS(0) { const int L = 0; PH_PTRS p0_prologue(KA, P); GSYNC(0); }
#pragma unroll 1
    for (int L = 0; L < 2; ++L) {
        const int pb0 = 1 + (L == 0 ? 0 : 9);
        if (RUN(pb0)) REPS(pb0) { PH_PTRS
            pg8::DenseSched S; S.so.init(64, 22, P.G, P.bid); S.A = (const char*)XB; S.B = (const char*)(wa + WA_IN); S.a_tile = TILE1K; S.b_tile = TILE1K;
            EpiIn E{U1, MISC, ss1};
            pg8::gemm_phase(P.lds, DM, DM, DM, S, E); GSYNC(pb0);
        }
        if (RUN(pb0 + 1)) REPS(pb0 + 1) { PH_PTRS
            rope_pass(P, U1, (const float*)(ws + WS_ROPE), (const float*)(ws + WS_ROPE) + (size_t)T * 32);
            for (int u = P.bid; u < 128; u += P.G) compress_unit(P, u, L, U1, ws);
            GSYNC(pb0 + 1);
        }
        if (RUN(pb0 + 2)) REPS(pb0 + 2) {
            { PH_PTRS
            { const int rep2_ = 0;
            unsigned* q = (unsigned*)(ws + WS_CTL) + CW_QMIX + 256 * L + 1024 * rep_ + 2048 * rep2_;
            for (;;) {
                __syncthreads();
                if (P.tid == 0) *s_uid = atomicAdd(q, 1u);
                __syncthreads();
                const int uid = (int)*s_uid;
                if (uid >= 64) break;
#ifndef SKIP_RWKV
                for (int r3 = 0; r3 < (REP_UNIT == 0 ? REP_N : 1); ++r3) rwkv_unit(P, uid, L, KA, U1, Y);
#endif
            } } }
            { PH_PTRS
            { const int rep2_ = 0;
            unsigned* q = (unsigned*)(ws + WS_CTL) + CW_QMIX + 256 * L + 1024 * rep_ + 2048 * rep2_;
            for (;;) {
                __syncthreads();
                if (P.tid == 0) *s_uid = atomicAdd(q + 192, 1u);
                __syncthreads();
                const int uid = (int)*s_uid;
                if (uid >= 64) break;
#ifndef SKIP_SSD
                for (int r3 = 0; r3 < (REP_UNIT == 1 ? REP_N : 1); ++r3) ssd_unit(P, uid, L, KA, U1, Y, MISC, SSQ);
#endif
            } } }
            { PH_PTRS
            { const int rep2_ = 0;
            unsigned* q = (unsigned*)(ws + WS_CTL) + CW_QMIX + 256 * L + 1024 * rep_ + 2048 * rep2_;
            for (;;) {
                __syncthreads();
                if (P.tid == 0) *s_uid = atomicAdd(q + 64, 1u);
                __syncthreads();
                const int uid = (int)*s_uid;
                if (uid >= 512) break;
#ifndef SKIP_NSA
                for (int r3 = 0; r3 < (REP_UNIT == 2 ? REP_N : 1); ++r3) nsa_unit(P, uid, U1, Y, MISC, ws);
#endif
            } } }
            { PH_PTRS
            { const int rep2_ = 0;
            unsigned* q = (unsigned*)(ws + WS_CTL) + CW_QMIX + 256 * L + 1024 * rep_ + 2048 * rep2_;
            for (;;) {
                __syncthreads();
                if (P.tid == 0) *s_uid = atomicAdd(q + 128, 1u);
                __syncthreads();
                const int uid = (int)*s_uid;
                if (uid >= 512) break;
#ifndef SKIP_SWA
                for (int r3 = 0; r3 < (REP_UNIT == 3 ? REP_N : 1); ++r3) swa_unit(P, uid, U1, Y, IN_F(25) + L * 8);
#endif
            } } }
            { PH_PTRS GSYNC(pb0 + 2); }
        }
        if (RUN(pb0 + 3)) REPS(pb0 + 3) { PH_PTRS
            pg8::DenseSched S; S.so.init(64, 16, P.G, P.bid); S.A = (const char*)XB; S.B = (const char*)(wa + WA_GATE); S.a_tile = TILE1K; S.b_tile = TILE1K;
            EpiGates E{GATES, ss1};
            pg8::gemm_phase(P.lds, DM, DM, DM, S, E);
            ssd_fixup_and_pb(P, L, KA, Y, SSQ, PB);
            GSYNC(pb0 + 3);
        }
        if (RUN(pb0 + 4)) REPS(pb0 + 4) {
            { PH_PTRS pg8::DenseSched S; S.so.init(64, 4, P.G, P.bid); S.a_tile = (size_t)256 * YW * 2; S.b_tile = (size_t)256 * 512 * 2;
              S.A = (const char*)Y; S.B = (const char*)(wa + WA_PT);
              EpiBr<0> E{MERGED, GATES}; pg8::gemm_phase(P.lds, YW, 512, 512, S, E); }
            { PH_PTRS pg8::DenseSched S; S.so.init(64, 4, P.G, P.bid); S.a_tile = (size_t)256 * YW * 2; S.b_tile = (size_t)256 * 512 * 2;
              S.A = (const char*)(Y + 512); S.B = (const char*)(wa + WA_PT + 1 * MiB);
              EpiBr<1> E{MERGED, GATES}; pg8::gemm_phase(P.lds, YW, 512, 512, S, E); }
            { PH_PTRS pg8::DenseSched S; S.so.init(64, 4, P.G, P.bid); S.a_tile = (size_t)256 * YW * 2; S.b_tile = (size_t)256 * 512 * 2;
              S.A = (const char*)(Y + 1024); S.B = (const char*)(wa + WA_PT + 2 * MiB);
              EpiBr<2> E{MERGED, GATES}; pg8::gemm_phase(P.lds, YW, 512, 512, S, E); }
            { PH_PTRS pg8::DenseSched S; S.so.init(64, 4, P.G, P.bid); S.a_tile = (size_t)256 * YW * 2; S.b_tile = (size_t)256 * 512 * 2;
              S.A = (const char*)(Y + 1536); S.B = (const char*)(wa + WA_PT + 3 * MiB);
              EpiBr<3> E{MERGED, GATES}; pg8::gemm_phase(P.lds, YW, 512, 512, S, E); }
            { PH_PTRS GSYNC(pb0 + 4); }
        }
        if (RUN(pb0 + 5)) REPS(pb0 + 5) { PH_PTRS
            pg8::DenseSched S; S.so.init(64, 4, P.G, P.bid); S.A = (const char*)MERGED; S.B = (const char*)(wa + WA_OUT); S.a_tile = TILE1K; S.b_tile = TILE1K;
            if (L == 0) { EpiRes<true, true> E{IN_F(0), out, XB, ss2}; pg8::gemm_phase(P.lds, DM, DM, DM, S, E); }
            else { EpiRes<false, true> E{out, out, XB, ss2}; pg8::gemm_phase(P.lds, DM, DM, DM, S, E); }
            GSYNC(pb0 + 5);
        }
        if (L == 0) {
            if (RUN(7)) REPS(7) { PH_PTRS
                pg8::DenseSched S; S.so.init(64, 22, P.G, P.bid); S.A = (const char*)XB; S.B = (const char*)(ws + WS_FGU); S.a_tile = TILE1K; S.b_tile = TILE1K;
                EpiFfn1<false> E{(bf16_t*)(ws + WS_ACT0), ss2};
                pg8::gemm_phase(P.lds, DM, DM, DM, S, E); GSYNC(7);
            }
            if (RUN(8)) REPS(8) { PH_PTRS
                pg8::DenseSched S; S.so.init(64, 4, P.G, P.bid); S.A = (const char*)(ws + WS_ACT0); S.B = (const char*)(ws + WS_FDN); S.a_tile = (size_t)256 * D_FF * 2; S.b_tile = (size_t)256 * D_FF * 2;
                EpiRes<true, false> E{out, out, XB2, nullptr};
                pg8::gemm_phase(P.lds, D_FF, D_FF, D_FF, S, E); GSYNC(8);
            }
        } else {
#define MOE_PTRS unsigned* cnt = (unsigned*)(ws + WS_CTL) + CW_MOECNT; (void)cnt; int* toke = (int*)(ws + WS_TOKE); int* tokp = (int*)(ws + WS_TOKP); float* tokw = (float*)(ws + WS_TOKW); int* toks = (int*)(ws + WS_TOKS); \
            (void)toke; (void)tokp; (void)tokw; (void)toks; float* srstd = (float*)(ws + WS_SRSTD); (void)srstd; \
            bf16_t* XG = (bf16_t*)(ws + WS_XG); bf16_t* ACT1 = (bf16_t*)(ws + WS_ACT1); bf16_t* YB = (bf16_t*)(ws + WS_YB); (void)XG; (void)ACT1; (void)YB;
            if (RUN(16)) REPS(16) { PH_PTRS MOE_PTRS moe_router(P, KA, out, cnt, toke, tokp, tokw); GSYNC(16); }
            if (RUN(17)) REPS(17) { PH_PTRS MOE_PTRS moe_slots(P, out, ss2, cnt, toke, tokp, toks, XG, srstd); GSYNC(17); }
            if (RUN(18)) REPS(18) { PH_PTRS MOE_PTRS
                MoeSched S; int c[8]; moe_tables(cnt, S.mt, c); S.nN = 22; S.G = P.G; S.c = P.bid; S.A = (const char*)XG; S.B = (const char*)(ws + WS_WB); S.a_tile = TILE1K; S.b_tile = TILE1K; S.b_expert = WB_STRIDE;
                EpiFfn1<true> E{ACT1, srstd};
                pg8::gemm_phase(P.lds, DM, DM, DM, S, E); GSYNC(18);
            }
            if (RUN(19)) REPS(19) { PH_PTRS MOE_PTRS
                MoeSched S; int c[8]; moe_tables(cnt, S.mt, c); S.nN = 4; S.G = P.G; S.c = P.bid; S.A = (const char*)ACT1; S.B = (const char*)(ws + WS_WB + WB_DN); S.a_tile = (size_t)256 * D_FF * 2; S.b_tile = (size_t)256 * D_FF * 2; S.b_expert = WB_STRIDE;
                EpiBf16<false> E{YB};
                pg8::gemm_phase(P.lds, D_FF, D_FF, D_FF, S, E); GSYNC(19);
            }
            if (RUN(20)) REPS(20) { PH_PTRS MOE_PTRS moe_combine(P, out, YB, toks, tokw, XB2); GSYNC(20); }
        }
        const int pple = (L == 0) ? 9 : 21;
        if (RUN(pple)) REPS(pple) {
            { PH_PTRS pg8::DenseSched S; S.so.init(64, 4, P.G, P.bid); S.A = (const char*)XB2; S.B = (const char*)(wa + WA_PG); S.a_tile = TILE1K; S.b_tile = TILE1K;
              EpiBf16<true> E{MERGED}; pg8::gemm_phase(P.lds, DM, DM, DM, S, E); }
            { PH_PTRS pg8::DenseSched S; S.so.init(64, 4, P.G, P.bid);
              S.A = (const char*)PB; S.B = (const char*)(wa + WA_PP); S.a_tile = (size_t)256 * PLE * 2; S.b_tile = (size_t)256 * PLE * 2;
              if (L == 0) { EpiPle2<true> E{out, MERGED, XB, ssn}; pg8::gemm_phase(P.lds, PLE, PLE, PLE, S, E); }
              else { EpiPle2<false> E{out, MERGED, XB, ssn}; pg8::gemm_phase(P.lds, PLE, PLE, PLE, S, E); } }
            { PH_PTRS GSYNC(pple); }
        }
    }
    if (RUN(22)) REPS(22) { const int L = 0; PH_PTRS final_norm(P, KA, out); }
}

extern "C" void kernel_launch(void* const* d_in, const int* in_sizes, int n_in, void* d_out, int out_size, void* d_ws, size_t ws_size, hipStream_t stream) {
    static int grid = 0;
    if (grid == 0) {
        if (n_in != 42 || out_size != T * DM || ws_size < WS_END) { fprintf(stderr, "kernel_launch: unexpected problem (n_in %d out %d ws %zu)\n", n_in, out_size, ws_size); grid = -1; return; }
        int dev = 0, cus = 0, per_cu = 0;
        hipGetDevice(&dev); hipDeviceGetAttribute(&cus, hipDeviceAttributeMultiprocessorCount, dev);
        hipFuncSetAttribute((const void*)mega_fwd, hipFuncAttributeMaxDynamicSharedMemorySize, LDS_BYTES);
        hipOccupancyMaxActiveBlocksPerMultiprocessor(&per_cu, (const void*)mega_fwd, 512, LDS_BYTES);
        if (per_cu < 1) { fprintf(stderr, "kernel_launch: occupancy query says %d blocks per CU\n", per_cu); per_cu = 1; }
        (void)hipGetLastError();
        grid = cus;
    }
    if (grid < 0) return;
    hipMemsetAsync((char*)d_ws + WS_CTL, 0, CTL_BYTES, stream);
    Args a{};
    for (int i = 0; i < 42; ++i) a.in[i] = d_in[i];
    a.out = (float*)d_out; a.ws = (unsigned char*)d_ws;
#if MK_MULTI
    for (int k = 0; k < NPH; ++k) { a.ph_lo = k; a.ph_hi = k + 1; hipLaunchKernelGGL(mega_fwd, dim3(grid), dim3(512), LDS_BYTES, stream, a); }
#else
    a.ph_lo = 0; a.ph_hi = NPH;
    void* kargs[] = {&a};
    hipError_t e = hipLaunchCooperativeKernel((const void*)mega_fwd, dim3(grid), dim3(512), kargs, LDS_BYTES, stream);
    if (e != hipSuccess) fprintf(stderr, "kernel_launch: cooperative launch failed: %s\n", hipGetErrorString(e));
#endif
}
```

```cpp
#include <hip/hip_runtime.h>
#include <hip/hip_cooperative_groups.h>
#include <cstdio>
#include <cstdint>
namespace cg = cooperative_groups;

#define LAS __attribute__((address_space(3)))
#define GAS __attribute__((address_space(1)))
typedef unsigned short bf16_t;
typedef short bf16x8 __attribute__((ext_vector_type(8)));
typedef short s16x4 __attribute__((ext_vector_type(4)));
typedef float f32x2 __attribute__((ext_vector_type(2)));
typedef float f32x4 __attribute__((ext_vector_type(4)));
typedef float f32x16 __attribute__((ext_vector_type(16)));
typedef unsigned u32x2 __attribute__((ext_vector_type(2)));
typedef unsigned u32x4 __attribute__((ext_vector_type(4)));

#ifdef DIAG_NOINLINE
#define UNIT_INLINE __attribute__((noinline))
#else
#define UNIT_INLINE __forceinline__
#endif
#ifndef REP_PH
#define REP_PH -1
#endif
#ifndef REP_N
#define REP_N 1
#endif
#ifndef REP_UNIT
#define REP_UNIT -1
#endif
#ifndef MK_MULTI
#define MK_MULTI 0
#endif

constexpr int NB = 8, SEQ = 2048, T = NB * SEQ, DM = 1024, HD = 64;
constexpr int D_IN = 9504, D_FF = 2816, NEXP = 8, PLE = 256;
constexpr int UW = 5376;
constexpr int YW = 2048;
constexpr float NORM_EPS = 1e-6f;
constexpr float LOG2E = 1.4426950408889634f;
constexpr int UC_Z = 0, UC_XBC = 512, UC_XS = 512, UC_BM = 1024, UC_CM = 1280, UC_NQ = 1536, UC_NKV = 2048, UC_RW = 2816, UC_SQ = 4608, UC_SKV = 5120;
constexpr int MOE_MAXROWS = 34816;

constexpr size_t MiB = (size_t)1 << 20;
constexpr size_t WS_CTL = 0, CTL_BYTES = 1 * MiB;
constexpr size_t WS_ROPE = 1 * MiB;
constexpr size_t WS_MISC = 5 * MiB;
constexpr size_t WS_KC = 7 * MiB, WS_VC = 7 * MiB + 256 * 1024;
constexpr size_t WS_SSQ = 7 * MiB + 512 * 1024;
constexpr size_t WS_TOKE = 8 * MiB, WS_TOKP = WS_TOKE + 128 * 1024, WS_TOKW = WS_TOKP + 128 * 1024, WS_TOKS = WS_TOKW + 128 * 1024;
constexpr size_t WS_SRSTD = 8 * MiB + 512 * 1024;
constexpr size_t WS_W1T = 9 * MiB;
constexpr size_t WS_W2T = 10 * MiB;
constexpr size_t WS_PEB = 10 * MiB + 64 * 1024;
constexpr size_t WS_LW = 10 * MiB + 128 * 1024;
constexpr size_t WS_WA = 12 * MiB, WA_STRIDE = 28 * MiB;
constexpr size_t WA_IN = 0, WA_GATE = 11 * MiB, WA_PT = 19 * MiB, WA_OUT = 23 * MiB, WA_PG = 25 * MiB, WA_PP = 27 * MiB;
constexpr size_t WS_FGU = 68 * MiB, WS_FDN = 79 * MiB;
constexpr size_t WS_WB = 85 * MiB, WB_STRIDE = 16 * MiB + 512 * 1024, WB_DN = 11 * MiB;
constexpr size_t WS_XB = 217 * MiB;
constexpr size_t WS_Y = 249 * MiB;
constexpr size_t WS_BIG = 313 * MiB;
constexpr size_t WS_U1 = WS_BIG, WS_GATES = WS_BIG, WS_MERGED = WS_BIG + 128 * MiB, WS_PB = WS_BIG + 160 * MiB, WS_ACT0 = WS_BIG;
constexpr size_t WS_XG = WS_XB, WS_ACT1 = 285 * MiB, WS_YB = WS_XB;
constexpr size_t WS_XB2_L0 = WS_Y, WS_XB2_L1 = 300 * MiB;
constexpr size_t WS_SSP = 482 * MiB;
constexpr size_t WS_END = 488 * MiB;
constexpr int CW_BAR = 4096, CW_QMIX = 16384, CW_MOECNT = 9216;

constexpr int RING_BYTES = 131072;
constexpr int LDS_BYTES = 147456;
constexpr int LDS_USER = LDS_BYTES - 1024;
constexpr int MISC_OFF = LDS_USER;

__device__ __forceinline__ float bf2f(unsigned b) { return __uint_as_float(b << 16); }
__device__ __forceinline__ unsigned f2bf(float f) { unsigned u = __float_as_uint(f); return (u + 0x7fffu + ((u >> 16) & 1u)) >> 16; }
__device__ __forceinline__ unsigned cvt_pk(float lo, float hi) { unsigned r; asm volatile("v_cvt_pk_bf16_f32 %0, %1, %2" : "=v"(r) : "v"(lo), "v"(hi)); return r; }
__device__ __forceinline__ float sigmoidf_(float x) { return 1.0f / (1.0f + __expf(-x)); }
__device__ __forceinline__ float siluf_(float x) { return x / (1.0f + __expf(-x)); }
__device__ __forceinline__ float softplusf_(float x) { return x > 20.f ? x : log1pf(expf(x)); }
__device__ __forceinline__ float wave_sum(float v) {
#pragma unroll
    for (int o = 1; o < 64; o <<= 1) v += __shfl_xor(v, o);
    return v;
}
__device__ __forceinline__ float wave_max(float v) {
#pragma unroll
    for (int o = 1; o < 64; o <<= 1) v = fmaxf(v, __shfl_xor(v, o));
    return v;
}
#define RLX_AGENT __ATOMIC_RELAXED, __HIP_MEMORY_SCOPE_AGENT
__device__ __forceinline__ u32x2 ld_agent_u64(const void* p) {
    unsigned long long v = __hip_atomic_load((const unsigned long long*)p, RLX_AGENT);
    u32x2 r; r.x = (unsigned)v; r.y = (unsigned)(v >> 32); return r;
}

__device__ __forceinline__ float ss_total(const float* ssp, int row) {
    const f32x4* p = (const f32x4*)(ssp + (size_t)row * 16); const f32x4 a = p[0], b = p[1], c = p[2], d = p[3];
    return (((a[0] + a[1]) + (a[2] + a[3])) + ((b[0] + b[1]) + (b[2] + b[3]))) + (((c[0] + c[1]) + (c[2] + c[3])) + ((d[0] + d[1]) + (d[2] + d[3])));
}
__device__ __forceinline__ float rstd_of(const float* ssp, int row) { return rsqrtf(ss_total(ssp, row) * (1.0f / DM) + NORM_EPS); }

namespace pg8 {
constexpr int BM = 256, BK = 64, HALF = 128, HTB = HALF * BK * 2, STAGE_BYTES = 8 * HTB, NXCD = 8, WGM = 8;
__host__ __device__ __forceinline__ int lds_byte(int r, int c) { const int st = (r >> 4) * 2 + (c >> 5), rr = r & 15, cc = c & 31, ob = rr * 64 + cc * 2; return st * 1024 + (ob ^ (((ob >> 9) & 1) << 5)); }
__host__ __device__ __forceinline__ void stage_rc(int b, int& R, int& C) { const int st = b / 1024, sb = b % 1024, swz = sb ^ (((sb >> 9) & 1) << 5); R = (st >> 1) * 16 + swz / 64; C = (st & 1) * 32 + (swz % 64) / 2; }

struct Unit { int pm, pn; const char* pa; const char* pb; };

struct StaticOrder {
    int nM, nN, nwg, G, c;
    __device__ void init(int nM_, int nN_, int G_, int c_) { nM = nM_; nN = nN_; nwg = nM * nN; G = G_; c = c_; }
    __device__ bool next(int i, int& pm, int& pn) const {
        const long L = (long)i * G + c; if (L >= nwg) return false;
        int wgid = (int)L; { const int q = nwg / NXCD, r = nwg % NXCD, xcd = wgid % NXCD, off = wgid / NXCD; wgid = (xcd < r ? xcd * (q + 1) : r * (q + 1) + (xcd - r) * q) + off; }
        const int nig = WGM * nN, gid = wgid / nig, fm = gid * WGM, gsz = (nM - fm) < WGM ? (nM - fm) : WGM;
        pm = fm + ((wgid % nig) % gsz); pn = (wgid % nig) / gsz; return true;
    }
};
struct DenseSched {
    StaticOrder so; const char* A; const char* B; size_t a_tile, b_tile;
    __device__ bool next(int i, Unit& u) const { if (!so.next(i, u.pm, u.pn)) return false; u.pa = A + (size_t)u.pm * a_tile; u.pb = B + (size_t)u.pn * b_tile; return true; }
};

template <class Epi, class Sched>
__device__ __forceinline__ void gemm_phase(LAS unsigned char* lds, const int lda, const int ldb, const int K, const Sched& S, const Epi& E) {
    int tid_ = threadIdx.x; asm volatile("" : "+v"(tid_));
    const int tid = tid_, wid = __builtin_amdgcn_readfirstlane(tid >> 6), lane = tid & 63, wr = wid >> 2, wc = wid & 3, fr = lane & 15, fq = lane >> 4;
    int K_ = K; asm volatile("" : "+s"(K_));
    const int nt = K_ / BK;
    unsigned voffA[2], voffB[2];
#pragma unroll
    for (int i = 0; i < 2; ++i) { int R, C; stage_rc(tid * 16 + i * 8192, R, C); voffA[i] = (unsigned)(R * lda + C) * 2u; voffB[i] = (unsigned)(R * ldb + C) * 2u; }
    const size_t kstep = (size_t)(BK * 2);
    const size_t hstepA = (size_t)HALF * lda * 2, hstepB = (size_t)HALF * ldb * 2;
    const unsigned ldsw = (unsigned)wid * 1024u;
    const int aoff = lds_byte(wr * 64 + fr, fq * 8), boff = lds_byte(wc * 32 + fr, fq * 8);
#define PG8_SA(b, h) (((b) * 2 + (h)) * HTB)
#define PG8_SB(b, h) ((4 + (b) * 2 + (h)) * HTB)
#define PG8_STAGE(bufoff, gbase, voff) do { _Pragma("unroll") for (int _i = 0; _i < 2; ++_i) \
        __builtin_amdgcn_global_load_lds((const unsigned*)((const char*)(gbase) + (voff)[_i]), (LAS unsigned*)(lds + (bufoff) + ldsw + _i * 8192), 16, 0, 0); } while (0)
#define PG8_LDA(dst, b, h) do { _Pragma("unroll") for (int m = 0; m < 4; ++m) _Pragma("unroll") for (int k = 0; k < 2; ++k) dst[m][k] = *(const LAS bf16x8*)(lds + PG8_SA(b, h) + aoff + m * 2048 + k * 1024); } while (0)
#define PG8_LDB(dst, b, h) do { _Pragma("unroll") for (int n = 0; n < 2; ++n) _Pragma("unroll") for (int k = 0; k < 2; ++k) dst[n][k] = *(const LAS bf16x8*)(lds + PG8_SB(b, h) + boff + n * 2048 + k * 1024); } while (0)
#define PG8_MMA(ai, bj, At, Bt) do { __builtin_amdgcn_s_setprio(1); _Pragma("unroll") for (int m = 0; m < 4; ++m) _Pragma("unroll") for (int n = 0; n < 2; ++n) _Pragma("unroll") for (int k = 0; k < 2; ++k) \
        acc[ai][bj][m][n] = __builtin_amdgcn_mfma_f32_16x16x32_bf16(Bt[n][k], At[m][k], acc[ai][bj][m][n], 0, 0, 0); __builtin_amdgcn_s_setprio(0); } while (0)
#define PG8_WAIT_V(n) asm volatile("s_waitcnt vmcnt(" #n ")" ::: "memory")
#define PG8_WAIT_L(n) asm volatile("s_waitcnt lgkmcnt(" #n ")" ::: "memory")
#define PG8_BAR __builtin_amdgcn_s_barrier()
#define PG8_SCHED __builtin_amdgcn_sched_barrier(0)
    Unit cur, nxt; int ui = 0;
    if (!S.next(0, cur)) return;
    f32x4 acc[2][2][4][2];
#pragma unroll
    for (int a = 0; a < 2; ++a)
#pragma unroll
        for (int b = 0; b < 2; ++b)
#pragma unroll
            for (int m = 0; m < 4; ++m)
#pragma unroll
                for (int n = 0; n < 2; ++n) acc[a][b][m][n] = (f32x4){0.f, 0.f, 0.f, 0.f};
    bf16x8 At[4][2], B0[2][2], B1[2][2];
    const char* cA = cur.pa; const char* cB = cur.pb;
    PG8_STAGE(PG8_SB(0, 0), cB, voffB); PG8_STAGE(PG8_SB(0, 1), cB + hstepB, voffB); PG8_STAGE(PG8_SA(0, 0), cA, voffA); PG8_STAGE(PG8_SA(0, 1), cA + hstepA, voffA);
    if (wr == 1) PG8_BAR;
    PG8_WAIT_V(2); PG8_BAR;
    PG8_STAGE(PG8_SB(1, 0), cB + kstep, voffB); PG8_STAGE(PG8_SA(1, 0), cA + kstep, voffA); PG8_STAGE(PG8_SB(1, 1), cB + hstepB + kstep, voffB);
    PG8_WAIT_V(6); PG8_BAR;
    for (;;) {
        const bool has_next = S.next(ui + 1, nxt);
        const char* nA = has_next ? nxt.pa : cA; const char* nB = has_next ? nxt.pb : cB;
        for (int t = 0; t < nt; t += 2) {
            const bool last = (t == nt - 2);
            const char* a1 = cA + (size_t)(t + 1) * kstep;
            const char* a2 = last ? nA : cA + (size_t)(t + 2) * kstep; const char* b2 = last ? nB : cB + (size_t)(t + 2) * kstep;
            const char* a3 = a2 + kstep; const char* b3 = b2 + kstep;
            PG8_LDB(B0, 0, 0); PG8_LDB(B1, 0, 1); PG8_SCHED; PG8_LDA(At, 0, 0); PG8_STAGE(PG8_SA(1, 1), a1 + hstepA, voffA);
            PG8_WAIT_V(8); PG8_WAIT_L(0); PG8_BAR; PG8_MMA(0, 0, At, B0); PG8_MMA(0, 1, At, B1); PG8_BAR; PG8_SCHED;
            PG8_LDA(At, 0, 1); PG8_STAGE(PG8_SB(0, 0), b2, voffB); PG8_STAGE(PG8_SB(0, 1), b2 + hstepB, voffB); PG8_STAGE(PG8_SA(0, 0), a2, voffA);
            PG8_WAIT_V(8); PG8_WAIT_L(0); PG8_BAR; PG8_MMA(1, 0, At, B0); PG8_MMA(1, 1, At, B1); PG8_BAR; PG8_SCHED;
            PG8_LDB(B0, 1, 0); PG8_LDB(B1, 1, 1); PG8_SCHED; PG8_LDA(At, 1, 0); PG8_STAGE(PG8_SA(0, 1), a2 + hstepA, voffA);
            PG8_WAIT_V(8); PG8_WAIT_L(0); PG8_BAR; PG8_MMA(0, 0, At, B0); PG8_MMA(0, 1, At, B1); PG8_BAR; PG8_SCHED;
            PG8_LDA(At, 1, 1); PG8_STAGE(PG8_SB(1, 0), b3, voffB); PG8_STAGE(PG8_SB(1, 1), b3 + hstepB, voffB); PG8_STAGE(PG8_SA(1, 0), a3, voffA);
            PG8_WAIT_V(8); PG8_WAIT_L(0); PG8_BAR; PG8_MMA(1, 0, At, B0); PG8_MMA(1, 1, At, B1); PG8_BAR; PG8_SCHED;
        }
        if (wr == 0) PG8_BAR;
        E(acc, cur, wr, wc, fr, fq);
        if (!has_next) break;
#pragma unroll
        for (int a = 0; a < 2; ++a)
#pragma unroll
            for (int b = 0; b < 2; ++b)
#pragma unroll
                for (int m = 0; m < 4; ++m)
#pragma unroll
                    for (int n = 0; n < 2; ++n) acc[a][b][m][n] = (f32x4){0.f, 0.f, 0.f, 0.f};
        cur = nxt; cA = nA; cB = nB; ++ui;
        if (wr == 1) PG8_BAR;
    }
    PG8_WAIT_V(0);
    PG8_BAR;
#undef PG8_SA
#undef PG8_SB
#undef PG8_STAGE
#undef PG8_LDA
#undef PG8_LDB
#undef PG8_MMA
#undef PG8_WAIT_V
#undef PG8_WAIT_L
#undef PG8_BAR
#undef PG8_SCHED
}
}

#define EPI_ROW(u, ai, m) ((u).pm * 256 + (ai) * 128 + wr * 64 + (m) * 16 + fr)
#define EPI_COL(u, bj, n) ((u).pn * 256 + (bj) * 128 + wc * 32 + (n) * 16 + fq * 4)
typedef f32x4 Acc[2][2][4][2];

__device__ __forceinline__ u32x2 pack4(f32x4 v) { u32x2 w; w.x = cvt_pk(v[0], v[1]); w.y = cvt_pk(v[2], v[3]); return w; }
__device__ __forceinline__ f32x4 unpack4(u32x2 w) { f32x4 v; v[0] = bf2f(w.x & 0xffffu); v[1] = bf2f(w.x >> 16); v[2] = bf2f(w.y & 0xffffu); v[3] = bf2f(w.y >> 16); return v; }

struct EpiIn {
    bf16_t* U; float* misc; const float* ss;
    __device__ __forceinline__ void operator()(const Acc& acc, const pg8::Unit& u, int wr, int wc, int fr, int fq) const {
#pragma unroll
        for (int ai = 0; ai < 2; ++ai)
#pragma unroll
            for (int m = 0; m < 4; ++m) {
                const int row = EPI_ROW(u, ai, m); const float rs = rstd_of(ss, row);
                if (u.pn < 21) {
#pragma unroll
                    for (int bj = 0; bj < 2; ++bj)
#pragma unroll
                        for (int n = 0; n < 2; ++n) *(u32x2*)(U + (size_t)row * UW + EPI_COL(u, bj, n)) = pack4(acc[ai][bj][m][n] * rs);
                } else if (wc == 0) {
#pragma unroll
                    for (int n = 0; n < 2; ++n) *(f32x4*)(misc + (size_t)row * 32 + n * 16 + fq * 4) = acc[ai][0][m][n] * rs;
                }
            }
    }
};
struct EpiGates {
    bf16_t* G; const float* ss;
    __device__ __forceinline__ void operator()(const Acc& acc, const pg8::Unit& u, int wr, int wc, int fr, int fq) const {
#pragma unroll
        for (int ai = 0; ai < 2; ++ai)
#pragma unroll
            for (int m = 0; m < 4; ++m) {
                const int row = EPI_ROW(u, ai, m); const float rs = rstd_of(ss, row);
#pragma unroll
                for (int bj = 0; bj < 2; ++bj)
#pragma unroll
                    for (int n = 0; n < 2; ++n) { f32x4 v = acc[ai][bj][m][n] * rs; v[0] = sigmoidf_(v[0]); v[1] = sigmoidf_(v[1]); v[2] = sigmoidf_(v[2]); v[3] = sigmoidf_(v[3]);
                        *(u32x2*)(G + (size_t)row * 4096 + EPI_COL(u, bj, n)) = pack4(v); }
            }
    }
};
template <int MB> struct EpiBr {
    bf16_t* MG; const bf16_t* G;
    __device__ __forceinline__ void operator()(const Acc& acc, const pg8::Unit& u, int wr, int wc, int fr, int fq) const {
#pragma unroll
        for (int ai = 0; ai < 2; ++ai)
#pragma unroll
            for (int m = 0; m < 4; ++m) {
                const int row = EPI_ROW(u, ai, m);
#pragma unroll
                for (int bj = 0; bj < 2; ++bj)
#pragma unroll
                    for (int n = 0; n < 2; ++n) { const int col = EPI_COL(u, bj, n);
                        const f32x4 g = unpack4(*(const u32x2*)(G + (size_t)row * 4096 + MB * 1024 + col));
                        f32x4 v = acc[ai][bj][m][n] * g;
                        bf16_t* mp = MG + (size_t)row * DM + col;
                        if (MB > 0) v += unpack4(ld_agent_u64(mp));
                        *(u32x2*)mp = pack4(v); }
                asm volatile("" ::: "memory");
            }
    }
};
template <bool WRITE_XB, bool ACC_SS> struct EpiRes {
    const float* xin; float* xo; bf16_t* xb; float* ss;
    __device__ __forceinline__ void operator()(const Acc& acc, const pg8::Unit& u, int wr, int wc, int fr, int fq) const {
#pragma unroll
        for (int ai = 0; ai < 2; ++ai)
#pragma unroll
            for (int m = 0; m < 4; ++m) {
                const int row = EPI_ROW(u, ai, m); float s = 0.f;
#pragma unroll
                for (int bj = 0; bj < 2; ++bj)
#pragma unroll
                    for (int n = 0; n < 2; ++n) { const size_t off = (size_t)row * DM + EPI_COL(u, bj, n);
                        const f32x4 v = *(const f32x4*)(xin + off) + acc[ai][bj][m][n];
                        *(f32x4*)(xo + off) = v;
                        if (WRITE_XB) *(u32x2*)(xb + off) = pack4(v);
                        if (ACC_SS) s += (v[0] * v[0] + v[1] * v[1]) + (v[2] * v[2] + v[3] * v[3]); }
                if (ACC_SS) { s += __shfl_xor(s, 16); s += __shfl_xor(s, 32); if (fq == 0) ss[(size_t)row * 16 + u.pn * 4 + wc] = s; }
                asm volatile("" ::: "memory");
            }
    }
};
template <bool MOE> struct EpiFfn1 {
    bf16_t* ACT; const float* ss;
    __device__ __forceinline__ void operator()(const Acc& acc, const pg8::Unit& u, int wr, int wc, int fr, int fq) const {
#pragma unroll
        for (int ai = 0; ai < 2; ++ai)
#pragma unroll
            for (int m = 0; m < 4; ++m) {
                const int row = EPI_ROW(u, ai, m); const float rs = MOE ? ss[row] : rstd_of(ss, row);
#pragma unroll
                for (int n = 0; n < 2; ++n) { const f32x4 g = acc[ai][0][m][n] * rs, up = acc[ai][1][m][n] * rs; f32x4 v;
                    v[0] = siluf_(g[0]) * up[0]; v[1] = siluf_(g[1]) * up[1]; v[2] = siluf_(g[2]) * up[2]; v[3] = siluf_(g[3]) * up[3];
                    *(u32x2*)(ACT + (size_t)row * D_FF + u.pn * 128 + wc * 32 + n * 16 + fq * 4) = pack4(v); }
            }
    }
};
template <bool SIG> struct EpiBf16 {
    bf16_t* O;
    __device__ __forceinline__ void operator()(const Acc& acc, const pg8::Unit& u, int wr, int wc, int fr, int fq) const {
#pragma unroll
        for (int ai = 0; ai < 2; ++ai)
#pragma unroll
            for (int m = 0; m < 4; ++m) {
                const int row = EPI_ROW(u, ai, m);
#pragma unroll
                for (int bj = 0; bj < 2; ++bj)
#pragma unroll
                    for (int n = 0; n < 2; ++n) { f32x4 v = acc[ai][bj][m][n];
                        if (SIG) { v[0] = sigmoidf_(v[0]); v[1] = sigmoidf_(v[1]); v[2] = sigmoidf_(v[2]); v[3] = sigmoidf_(v[3]); }
                        *(u32x2*)(O + (size_t)row * DM + EPI_COL(u, bj, n)) = pack4(v); }
            }
    }
};
template <bool WRITE_XB> struct EpiPle2 {
    float* xo; const bf16_t* G; bf16_t* xb; float* ss;
    __device__ __forceinline__ void operator()(const Acc& acc, const pg8::Unit& u, int wr, int wc, int fr, int fq) const {
#pragma unroll
        for (int ai = 0; ai < 2; ++ai)
#pragma unroll
            for (int m = 0; m < 4; ++m) {
                const int row = EPI_ROW(u, ai, m); float s = 0.f;
#pragma unroll
                for (int bj = 0; bj < 2; ++bj)
#pragma unroll
                    for (int n = 0; n < 2; ++n) { const size_t off = (size_t)row * DM + EPI_COL(u, bj, n);
                        const f32x4 g = unpack4(ld_agent_u64(G + off));
                        const f32x4 v = *(const f32x4*)(xo + off) + g * acc[ai][bj][m][n];
                        *(f32x4*)(xo + off) = v;
                        if (WRITE_XB) *(u32x2*)(xb + off) = pack4(v);
                        s += (v[0] * v[0] + v[1] * v[1]) + (v[2] * v[2] + v[3] * v[3]); }
                s += __shfl_xor(s, 16); s += __shfl_xor(s, 32); if (fq == 0) ss[(size_t)row * 16 + u.pn * 4 + wc] = s;
                asm volatile("" ::: "memory");
            }
    }
};

struct BatchSched {
    int pm, pn0, n; const char* A; const char* B; size_t a_tile, b_tile;
    __device__ bool next(int i, pg8::Unit& u) const { if (i >= n) return false; u.pm = pm; u.pn = pn0 + i; u.pa = A + (size_t)pm * a_tile; u.pb = B + (size_t)u.pn * b_tile; return true; }
};
struct MoeTables { int ps1, ps2, ps3, ps4, ps5, ps6, ps7, ps8; };
__device__ __forceinline__ int moe_expert_of_row(const MoeTables& mt, int row) {
    return (row >= mt.ps1) + (row >= mt.ps2) + (row >= mt.ps3) + (row >= mt.ps4) + (row >= mt.ps5) + (row >= mt.ps6) + (row >= mt.ps7);
}
struct MoeSched {
    MoeTables mt; int nN, G, c; const char* A; const char* B; size_t a_tile, b_tile, b_expert;
    __device__ bool next(int i, pg8::Unit& u) const {
        const long L = (long)i * G + c; const int ntiles = mt.ps8 >> 8;
        if (L >= (long)ntiles * nN) return false;
        u.pm = (int)(L / nN); u.pn = (int)(L % nN);
        const int e = moe_expert_of_row(mt, u.pm * 256);
        u.pa = A + (size_t)u.pm * a_tile; u.pb = B + (size_t)e * b_expert + (size_t)u.pn * b_tile; return true;
    }
};

struct Args { const void* in[42]; float* out; unsigned char* ws; int ph_lo, ph_hi; };
typedef const __attribute__((address_space(4))) Args* KArgs;
__device__ __forceinline__ KArgs kargs() { KArgs p = (KArgs)__builtin_amdgcn_kernarg_segment_ptr(); asm volatile("" : "+s"(p)); return p; }
struct Frame {
    LAS unsigned char* lds; int tid, lane, wave, G, bid;
    unsigned char* ws; unsigned* ctl;
};
#define IN_F(k) ((const float*)KA->in[k])

constexpr int DEFER_ITEMS = 3472 + 16896;
struct TJob { const float* src; int ldw, K, ncols, ldt, mode; bf16_t* dst; const float* gain; };
__device__ __forceinline__ void tr_item(const TJob& J, LAS float* scr, int item, int lane) {
    const int nblk = J.ncols / 64, kb = item / nblk, nb = item % nblk, k0 = 64 * kb, n0 = 64 * nb;
    const int c = lane;
    const bool live = (J.mode != 3) || c < 32;
    const int scol = (J.mode == 3) ? (c < 8 ? 1536 + c : (c < 32 ? 2816 + c : 0)) : n0 + c;
    const float* sp = J.src + (size_t)k0 * J.ldw + scol;
    float v[64];
#pragma unroll
    for (int i = 0; i < 64; ++i) v[i] = sp[(size_t)i * J.ldw];
#pragma unroll
    for (int i = 0; i < 64; ++i) { float x = live ? v[i] : 0.f; if (J.gain) x *= J.gain[k0 + i]; scr[i * 65 + c] = x; }
    asm volatile("s_waitcnt lgkmcnt(0)" ::: "memory");
    int drow0 = n0;
    if (J.mode == 1 || J.mode == 2) drow0 = (n0 / 128) * 256 + (n0 % 128) + (J.mode == 2 ? 128 : 0);
    const int c8 = lane & 7;
#pragma unroll
    for (int j = 0; j < 8; ++j) { const int n = (lane >> 3) + 8 * j; const LAS float* sq = scr + (8 * c8) * 65 + n;
        u32x4 o; o.x = cvt_pk(sq[0 * 65], sq[1 * 65]); o.y = cvt_pk(sq[2 * 65], sq[3 * 65]); o.z = cvt_pk(sq[4 * 65], sq[5 * 65]); o.w = cvt_pk(sq[6 * 65], sq[7 * 65]);
        *(u32x4*)(J.dst + (size_t)(drow0 + n) * J.ldt + k0 + 8 * c8) = o; }
    asm volatile("s_waitcnt lgkmcnt(0)" ::: "memory");
}
constexpr int NJOBS = 32 + 3 + 24 + 8;
__device__ __forceinline__ bool job_deferred(int jid) { return (jid >= 16 && jid < 32) || (jid >= 35 && jid < 59); }
__device__ __forceinline__ bool get_job(KArgs KA, int jid, TJob& J) {
    unsigned char* ws = KA->ws;
    J.gain = nullptr; J.mode = 0;
    if (jid < 32) {
        const int L = jid >> 4, j = jid & 15;
        unsigned char* wa = ws + WS_WA + (size_t)L * WA_STRIDE;
        if (j <= 8) {
            const float* w = IN_F(4) + (size_t)L * DM * D_IN; J.ldw = D_IN; J.K = DM; J.ldt = DM; J.gain = IN_F(3) + L * DM;
            int sc, nc, dr;
            switch (j) { case 0: sc = 0; nc = 512; dr = 0; break; case 1: sc = 512; nc = 1024; dr = 512; break; case 2: sc = 1544; nc = 512; dr = 1536; break;
                case 3: sc = 2056; nc = 768; dr = 2048; break; case 4: sc = 2848; nc = 1792; dr = 2816; break; case 5: sc = 4640; nc = 512; dr = 4608; break;
                case 6: sc = 5152; nc = 256; dr = 5120; break; case 7: sc = 0; nc = 64; dr = 5376; J.mode = 3; break; default: sc = 5408; nc = 4096; dr = 0; break; }
            J.src = w + sc; J.ncols = nc; J.dst = (bf16_t*)(wa + (j == 8 ? WA_GATE : WA_IN)) + (size_t)dr * DM;
            return true;
        }
        if (j <= 12) { const int m = j - 9; J.src = IN_F(26 + m) + (size_t)L * 512 * DM; J.ldw = DM; J.K = 512; J.ncols = DM; J.ldt = 512; J.dst = (bf16_t*)(wa + WA_PT + (size_t)m * MiB); return true; }
        if (j == 13) { J.src = IN_F(30) + (size_t)L * DM * DM; J.ldw = DM; J.K = DM; J.ncols = DM; J.ldt = DM; J.dst = (bf16_t*)(wa + WA_OUT); return true; }
        if (j == 14) { J.src = IN_F(40) + (size_t)L * DM * DM; J.ldw = DM; J.K = DM; J.ncols = DM; J.ldt = DM; J.dst = (bf16_t*)(wa + WA_PG); return true; }
        J.src = IN_F(39) + (size_t)L * PLE * DM; J.ldw = DM; J.K = PLE; J.ncols = DM; J.ldt = PLE; J.dst = (bf16_t*)(wa + WA_PP); return true;
    }
    if (jid < 35) {
        const int j = jid - 32;
        if (j < 2) { J.src = IN_F(32 + j); J.ldw = D_FF; J.K = DM; J.ncols = D_FF; J.ldt = DM; J.gain = IN_F(31); J.mode = 1 + j; J.dst = (bf16_t*)(ws + WS_FGU); return true; }
        J.src = IN_F(34); J.ldw = DM; J.K = D_FF; J.ncols = DM; J.ldt = D_FF; J.dst = (bf16_t*)(ws + WS_FDN); return true;
    }
    if (jid < 59) {
        const int e = (jid - 35) / 3, j = (jid - 35) % 3;
        unsigned char* wb = ws + WS_WB + (size_t)e * WB_STRIDE;
        if (j < 2) { J.src = IN_F(36 + j) + (size_t)e * DM * D_FF; J.ldw = D_FF; J.K = DM; J.ncols = D_FF; J.ldt = DM; J.gain = IN_F(31) + DM; J.mode = 1 + j; J.dst = (bf16_t*)wb; return true; }
        J.src = IN_F(38) + (size_t)e * D_FF * DM; J.ldw = DM; J.K = D_FF; J.ncols = DM; J.ldt = D_FF; J.dst = (bf16_t*)(wb + WB_DN); return true;
    }
    {
        const int j = jid - 59, idx = j & 3;
        if (j < 4) { J.src = IN_F(12) + (size_t)idx * 2048 * 64; J.ldw = 64; J.K = 2048; J.ncols = 64; J.ldt = 2048; J.dst = (bf16_t*)(ws + WS_W1T) + (size_t)idx * 64 * 2048; return true; }
        J.src = IN_F(13) + (size_t)idx * 64 * 64; J.ldw = 64; J.K = 64; J.ncols = 64; J.ldt = 64; J.dst = (bf16_t*)(ws + WS_W2T) + (size_t)idx * 64 * 64; return true;
    }
}
__device__ UNIT_INLINE void p0_prologue(KArgs KA, Frame& F) {
    LAS float* scr = (LAS float*)(F.lds + F.wave * 16640);
    const int gw = F.bid * 8 + F.wave, NGW = F.G * 8;
    unsigned char* ws = KA->ws;
    {
        int jid = 0, loc = gw; TJob J; get_job(KA, 0, J); int nit = (J.K / 64) * (J.ncols / 64);
        for (;;) {
            while (jid < NJOBS && loc >= nit) { loc -= nit; ++jid; if (jid < NJOBS) { get_job(KA, jid, J); nit = job_deferred(jid) ? 0 : (J.K / 64) * (J.ncols / 64); } }
            if (jid >= NJOBS) break;
            tr_item(J, scr, loc, F.lane);
            loc += NGW;
        }
    }
    for (int L = 0; L < 2; ++L) {
        u32x4* z = (u32x4*)((bf16_t*)(ws + WS_WA + (size_t)L * WA_STRIDE + WA_IN) + (size_t)5440 * DM);
        const int n16 = 192 * DM * 2 / 16;
        for (int i = gw * 64 + F.lane; i < n16; i += NGW * 64) z[i] = (u32x4){0u, 0u, 0u, 0u};
    }
    for (int o = gw; o < 256; o += NGW) {
        const int idx = o >> 6, f = o & 63;
        const float* pe = IN_F(11) + (size_t)idx * 2048; const float* w1 = IN_F(12) + (size_t)idx * 2048 * 64 + f; float s = 0.f;
#pragma unroll 8
        for (int k = F.lane; k < 2048; k += 64) s += pe[k] * w1[(size_t)k * 64];
        s = wave_sum(s);
        if (F.lane == 0) ((float*)(ws + WS_PEB))[o] = s;
    }
    for (int i = gw * 64 + F.lane; i < 2 * 8 * 4 * 8 * 64; i += NGW * 64) {
        const int ln = i & 63, fr = (i >> 6) & 7, nt = (i >> 9) & 3, hh = (i >> 11) & 7, LL = i >> 14;
        const int cn = hh * 64 + 16 * nt + (ln & 15), kgl = ln >> 4;
        const float* W = (fr < 2) ? IN_F(16) + (size_t)LL * 64 * 512 : (fr < 4) ? IN_F(18) + (size_t)LL * 64 * 512 : IN_F(19) + (size_t)LL * 128 * 512;
        const int ks = (fr < 2) ? fr : (fr < 4) ? fr - 2 : fr - 4;
        u32x4 o;
#pragma unroll
        for (int j = 0; j < 4; ++j) { const int k = 32 * ks + 8 * kgl + 2 * j; o[j] = cvt_pk(W[(size_t)k * 512 + cn], W[(size_t)(k + 1) * 512 + cn]); }
        ((u32x4*)(ws + WS_LW))[i] = o;
    }
    {
        const float* x = IN_F(0); bf16_t* xb = (bf16_t*)(ws + WS_XB); float* ss = (float*)(ws + WS_SSP);
        for (int m = gw; m < T; m += NGW) {
            const f32x4* xr = (const f32x4*)(x + (size_t)m * DM) + F.lane; float s = 0.f;
            u32x2* o = (u32x2*)(xb + (size_t)m * DM) + F.lane;
#pragma unroll
            for (int j = 0; j < 4; ++j) { const f32x4 v = xr[64 * j]; s += (v[0] * v[0] + v[1] * v[1]) + (v[2] * v[2] + v[3] * v[3]); o[64 * j] = pack4(v); }
            s = wave_sum(s); if (F.lane < 16) ss[(size_t)m * 16 + F.lane] = (F.lane == 0) ? s : 0.f;
        }
    }
    {
        const int* pos = (const int*)KA->in[2]; float* rc = (float*)(ws + WS_ROPE); float* rsn = rc + (size_t)T * 32;
        for (int i = (gw * 64 + F.lane); i < T * 32; i += NGW * 64) {
            const int t = i >> 5, k = i & 31;
            const float inv = (float)exp2(-(double)k * (1.0 / 32.0) * 17.194602975157967);
            const float ang = (float)pos[t] * inv;
            rc[i] = cosf(ang); rsn[i] = sinf(ang);
        }
    }
}


__device__ UNIT_INLINE void deferred_convert(KArgs KA, Frame& F, unsigned* q, LAS unsigned* s_uid, int jlo, int jhi, int nitems) {
    LAS float* scr = (LAS float*)(F.lds + F.wave * 16640);
    for (;;) {
        __syncthreads();
        if (F.tid == 0) *s_uid = atomicAdd(q, 1u);
        __syncthreads();
        int loc = (int)*s_uid * 8 + F.wave;
        int jid = jlo; TJob J; bool found = false;
        for (; jid < jhi; ++jid) { if (!job_deferred(jid)) continue; get_job(KA, jid, J); const int nit = (J.K / 64) * (J.ncols / 64); if (loc < nit) { found = true; break; } loc -= nit; }
        if (found) tr_item(J, scr, loc, F.lane);
        if ((int)*s_uid * 8 >= nitems) break;
    }
}

__device__ UNIT_INLINE void rope_pass(Frame& F, bf16_t* U1, const float* rc, const float* rsn) {
    const int gt = F.bid * 512 + F.tid, NT = F.G * 512;
    for (int i = gt; i < T * 40; i += NT) {
        const int t = i / 40, r = i % 40, slot = r >> 2, ch = r & 3;
        bf16_t* base = U1 + (size_t)t * UW + (slot < 8 ? UC_SQ + slot * 64 : UC_SKV + (slot - 8) * 64) + ch * 8;
        const u32x4 a = *(const u32x4*)base, b = *(const u32x4*)(base + 32);
        const f32x4 c0 = *(const f32x4*)(rc + (size_t)t * 32 + ch * 8), c1 = *(const f32x4*)(rc + (size_t)t * 32 + ch * 8 + 4);
        const f32x4 s0 = *(const f32x4*)(rsn + (size_t)t * 32 + ch * 8), s1 = *(const f32x4*)(rsn + (size_t)t * 32 + ch * 8 + 4);
        float x1[8], x2[8], cs[8], sn[8];
#pragma unroll
        for (int j = 0; j < 4; ++j) { x1[2 * j] = bf2f(a[j] & 0xffffu); x1[2 * j + 1] = bf2f(a[j] >> 16); x2[2 * j] = bf2f(b[j] & 0xffffu); x2[2 * j + 1] = bf2f(b[j] >> 16);
            cs[j] = c0[j]; cs[4 + j] = c1[j]; sn[j] = s0[j]; sn[4 + j] = s1[j]; }
        u32x4 oa, ob;
#pragma unroll
        for (int j = 0; j < 4; ++j) {
            const float y1a = x1[2 * j] * cs[2 * j] - x2[2 * j] * sn[2 * j], y1b = x1[2 * j + 1] * cs[2 * j + 1] - x2[2 * j + 1] * sn[2 * j + 1];
            const float y2a = x2[2 * j] * cs[2 * j] + x1[2 * j] * sn[2 * j], y2b = x2[2 * j + 1] * cs[2 * j + 1] + x1[2 * j + 1] * sn[2 * j + 1];
            oa[j] = cvt_pk(y1a, y1b); ob[j] = cvt_pk(y2a, y2b);
        }
        *(u32x4*)base = oa; *(u32x4*)(base + 32) = ob;
    }
}
__device__ UNIT_INLINE void compress_unit(Frame& F, int unit, int L, const bf16_t* U1, unsigned char* ws) {
    const int nc = unit & 3, kv = (unit >> 2) & 1, g = (unit >> 3) & 1, b = unit >> 4;
    const int n0 = nc * 32, tok0 = n0 * 16;
    LAS bf16_t* tok = (LAS bf16_t*)F.lds;
    LAS bf16_t* hid = (LAS bf16_t*)(F.lds + 528 * 72 * 2);
    const bf16_t* src = U1 + (size_t)(b * SEQ) * UW + UC_NKV + kv * 128 + g * 64;
    __syncthreads();
    for (int i = F.tid; i < 528 * 8; i += 512) { const int r = i >> 3, ch = i & 7; const int t = tok0 + r;
        u32x4 v = (u32x4){0u, 0u, 0u, 0u}; if (t < SEQ) v = *(const u32x4*)(src + (size_t)t * UW + ch * 8);
        *(LAS u32x4*)(tok + r * 72 + ch * 8) = v; }
    __syncthreads();
    const int idx = L * 2 + kv;
    const bf16_t* w1t = (const bf16_t*)(ws + WS_W1T) + (size_t)idx * 64 * 2048;
    const bf16_t* w2t = (const bf16_t*)(ws + WS_W2T) + (size_t)idx * 64 * 64;
    const float* peb = (const float*)(ws + WS_PEB) + idx * 64;
    const int mt = F.wave >> 2, ntile = F.wave & 3, r16 = F.lane & 15, kg = F.lane >> 4;
    f32x4 acc = (f32x4){0.f, 0.f, 0.f, 0.f};
    const int nl = mt * 16 + r16;
    const bf16_t* bp = w1t + (size_t)(ntile * 16 + r16) * 2048 + kg * 8;
#pragma unroll 4
    for (int ks = 0; ks < 64; ++ks) {
        const int l = ks >> 1, db = (ks & 1) * 32 + kg * 8;
        const bf16x8 a = *(const LAS bf16x8*)(tok + (16 * nl + l) * 72 + db);
        const bf16x8 bb = *(const bf16x8*)(bp + ks * 32);
        acc = __builtin_amdgcn_mfma_f32_16x16x32_bf16(a, bb, acc, 0, 0, 0);
    }
    { const int f = ntile * 16 + r16; const float pb = peb[f];
#pragma unroll
      for (int r = 0; r < 4; ++r) hid[(mt * 16 + 4 * kg + r) * 72 + f] = (bf16_t)f2bf(siluf_(acc[r] + pb)); }
    __syncthreads();
    f32x4 o = (f32x4){0.f, 0.f, 0.f, 0.f};
#pragma unroll
    for (int ks = 0; ks < 2; ++ks) {
        const bf16x8 a = *(const LAS bf16x8*)(hid + nl * 72 + ks * 32 + kg * 8);
        const bf16x8 bb = *(const bf16x8*)(w2t + (size_t)(ntile * 16 + r16) * 64 + ks * 32 + kg * 8);
        o = __builtin_amdgcn_mfma_f32_16x16x32_bf16(a, bb, o, 0, 0, 0);
    }
    bf16_t* dst = (bf16_t*)(ws + (kv ? WS_VC : WS_KC)) + (size_t)((b * 2 + g) * 128) * 64;
#pragma unroll
    for (int r = 0; r < 4; ++r) { const int n = n0 + mt * 16 + 4 * kg + r; dst[(size_t)n * 64 + ntile * 16 + r16] = (n < 127) ? (bf16_t)f2bf(o[r]) : (bf16_t)0; }
}

__device__ __forceinline__ int crow(int r, int hi) { return (r & 3) + 8 * (r >> 2) + 4 * hi; }
constexpr int KS_LD = 72;
struct AttnSt { float m, l; f32x16 o0, o1; };
__device__ __forceinline__ void attn_init(AttnSt& s) { s.m = -INFINITY; s.l = 0.f;
#pragma unroll
    for (int r = 0; r < 16; ++r) { s.o0[r] = 0.f; s.o1[r] = 0.f; } }
constexpr int TILE_EL = 64 * 64;
__device__ __forceinline__ void dma_kv(const bf16_t* Kg, int ldk, const bf16_t* Vg, int ldv, LAS bf16_t* Ks, LAS bf16_t* Vs, int wave, int lane) {
    const int key = 8 * wave + (lane >> 3), ch = (lane & 7) ^ (key & 7);
    __builtin_amdgcn_global_load_lds((const unsigned*)(Kg + (size_t)key * ldk + ch * 8), (LAS unsigned*)(Ks + wave * 512), 16, 0, 0);
    __builtin_amdgcn_global_load_lds((const unsigned*)(Vg + (size_t)key * ldv + ch * 8), (LAS unsigned*)(Vs + wave * 512), 16, 0, 0);
}
__device__ __forceinline__ int swz_el(int key, int chunk) { return key * 64 + ((chunk ^ (key & 7)) << 3); }
__device__ __forceinline__ void attn_scores(const LAS bf16_t* Ks, const bf16x8 (&qr)[4], f32x16& p0, f32x16& p1, int r32, int hi) {
#pragma unroll
    for (int r = 0; r < 16; ++r) { p0[r] = 0.f; p1[r] = 0.f; }
#pragma unroll
    for (int d0 = 0; d0 < 4; ++d0) {
        const bf16x8 k0 = *(const LAS bf16x8*)(Ks + swz_el(r32, 2 * d0 + hi));
        const bf16x8 k1 = *(const LAS bf16x8*)(Ks + swz_el(32 + r32, 2 * d0 + hi));
        p0 = __builtin_amdgcn_mfma_f32_32x32x16_bf16(k0, qr[d0], p0, 0, 0, 0);
        p1 = __builtin_amdgcn_mfma_f32_32x32x16_bf16(k1, qr[d0], p1, 0, 0, 0);
    }
}
typedef short v4i16_t __attribute__((ext_vector_type(4)));
__device__ __forceinline__ void attn_pv(const LAS bf16_t* Vs, const f32x16& p0, const f32x16& p1, f32x16& o0, f32x16& o1, int r32, int hi) {
    bf16x8 pa[4];
#pragma unroll
    for (int s = 0; s < 2; ++s) {
        u32x4 w0, w1;
#pragma unroll
        for (int j = 0; j < 4; ++j) { w0[j] = cvt_pk(p0[8 * s + 2 * j], p0[8 * s + 2 * j + 1]); w1[j] = cvt_pk(p1[8 * s + 2 * j], p1[8 * s + 2 * j + 1]); }
        pa[s] = __builtin_bit_cast(bf16x8, w0); pa[2 + s] = __builtin_bit_cast(bf16x8, w1);
    }
    const int lane = hi * 32 + r32;
    const int krow = 4 * hi + ((lane & 15) >> 2), cb = 2 * ((lane >> 4) & 1) + ((lane & 3) >> 1), sub = 4 * (lane & 1);
#pragma unroll
    for (int s = 0; s < 4; ++s) {
#pragma unroll
        for (int dh = 0; dh < 2; ++dh) {
            const int k0 = 16 * s + krow, k1 = k0 + 8;
            const s16x4 lo = __builtin_bit_cast(s16x4, __builtin_amdgcn_ds_read_tr16_b64_v4i16((LAS v4i16_t*)(Vs + swz_el(k0, 4 * dh + cb) + sub)));
            const s16x4 hi4 = __builtin_bit_cast(s16x4, __builtin_amdgcn_ds_read_tr16_b64_v4i16((LAS v4i16_t*)(Vs + swz_el(k1, 4 * dh + cb) + sub)));
            const bf16x8 vfr = (bf16x8){lo[0], lo[1], lo[2], lo[3], hi4[0], hi4[1], hi4[2], hi4[3]};
            if (dh == 0) o0 = __builtin_amdgcn_mfma_f32_32x32x16_bf16(pa[s], vfr, o0, 0, 0, 0);
            else         o1 = __builtin_amdgcn_mfma_f32_32x32x16_bf16(pa[s], vfr, o1, 0, 0, 0);
        }
    }
}
__device__ __forceinline__ void attn_online(const LAS bf16_t* Vt, f32x16& x0, f32x16& x1, AttnSt& st, LAS float* wsf, int r32, int hi) {
    float mx = -INFINITY;
#pragma unroll
    for (int r = 0; r < 16; ++r) mx = fmaxf(mx, fmaxf(x0[r], x1[r]));
    mx = fmaxf(mx, __shfl_xor(mx, 32));
    const float mn = fmaxf(st.m, mx), ms = (mn == -INFINITY) ? 0.f : mn;
    const float f = exp2f((st.m - ms) * LOG2E);
    if (hi == 0) wsf[r32] = f;
    float rs = 0.f;
#pragma unroll
    for (int r = 0; r < 16; ++r) { x0[r] = exp2f((x0[r] - ms) * LOG2E); x1[r] = exp2f((x1[r] - ms) * LOG2E); rs += x0[r] + x1[r]; }
    st.l = st.l * f + rs; st.m = mn;
    const LAS float* wr_ = wsf + 4 * hi;
#pragma unroll
    for (int r = 0; r < 16; ++r) { const float fr_ = wr_[(r & 3) + 8 * (r >> 2)]; st.o0[r] *= fr_; st.o1[r] *= fr_; }
    attn_pv(Vt, x0, x1, st.o0, st.o1, r32, hi);
}
__device__ __forceinline__ void attn_scale_rows(f32x16& o0, f32x16& o1, float inv, LAS float* wsf, int r32, int hi) {
    if (hi == 0) wsf[r32] = inv;
    const LAS float* wr_ = wsf + 4 * hi;
#pragma unroll
    for (int r = 0; r < 16; ++r) { const float f = wr_[(r & 3) + 8 * (r >> 2)]; o0[r] *= f; o1[r] *= f; }
}

__device__ UNIT_INLINE void swa_unit(Frame& F, int unit, const bf16_t* U1, bf16_t* Y, const float* sinks) {
    const int qb = unit & 31, g = (unit >> 5) & 1, b = unit >> 6;
    const int r32 = F.lane & 31, hi = F.lane >> 5, hr = F.wave >> 1, qs = F.wave & 1, head = g * 4 + hr;
    const int q0 = qb * 64, tq = q0 + qs * 32 + r32;
    LAS bf16_t* Ks = (LAS bf16_t*)F.lds; LAS bf16_t* Vt = Ks + TILE_EL; LAS bf16_t* Ks1 = Vt + TILE_EL; LAS bf16_t* Vt1 = Ks1 + TILE_EL;
    LAS float* wsf = (LAS float*)(F.lds + 4 * TILE_EL * 2) + F.wave * 32;
    const bf16_t* rowb = U1 + (size_t)(b * SEQ) * UW;
    bf16x8 qr[4];
#pragma unroll
    for (int d0 = 0; d0 < 4; ++d0) qr[d0] = *(const bf16x8*)(rowb + (size_t)tq * UW + UC_SQ + head * 64 + d0 * 16 + hi * 8);
    AttnSt st; attn_init(st);
    {
        const int kt0 = (qb >= 2 ? qb - 2 : 0);
        const bf16_t* kg = rowb + UC_SKV + g * 64; const bf16_t* vg = kg + 128;
        __syncthreads();
        dma_kv(kg + (size_t)(kt0 * 64) * UW, UW, vg + (size_t)(kt0 * 64) * UW, UW, Ks, Vt, F.wave, F.lane);
        __syncthreads();
        int cur = 0;
#pragma unroll 1
        for (int kt = kt0; kt <= qb; ++kt) {
            if (kt < qb) dma_kv(kg + (size_t)((kt + 1) * 64) * UW, UW, vg + (size_t)((kt + 1) * 64) * UW, UW, cur ? Ks : Ks1, cur ? Vt : Vt1, F.wave, F.lane);
            const LAS bf16_t* kc_ = cur ? Ks1 : Ks; const LAS bf16_t* vc_ = cur ? Vt1 : Vt;
            f32x16 x0, x1; attn_scores(kc_, qr, x0, x1, r32, hi);
#pragma unroll
            for (int r = 0; r < 16; ++r) { const int d0 = tq - (kt * 64 + crow(r, hi)), d1 = d0 - 32;
                x0[r] = (d0 >= 0 && d0 < 128) ? x0[r] * 0.125f : -INFINITY; x1[r] = (d1 >= 0 && d1 < 128) ? x1[r] * 0.125f : -INFINITY; }
            attn_online(vc_, x0, x1, st, wsf, r32, hi);
            __syncthreads();
            cur ^= 1;
        }
    }
    const float l = st.l + __shfl_xor(st.l, 32), sk = sinks[head];
    const float mf = fmaxf(st.m, sk), a = exp2f((st.m - mf) * LOG2E), inv = a / (l * a + exp2f((sk - mf) * LOG2E));
    attn_scale_rows(st.o0, st.o1, inv, wsf, r32, hi);
    bf16_t* yb = Y + (size_t)(b * SEQ + q0 + qs * 32) * YW + 3 * 512 + head * 64 + r32;
#pragma unroll
    for (int r = 0; r < 16; ++r) { bf16_t* yp = yb + (size_t)crow(r, hi) * YW; yp[0] = (bf16_t)f2bf(st.o0[r]); yp[32] = (bf16_t)f2bf(st.o1[r]); }
}

constexpr int NSA_K1_OFF = 2 * TILE_EL * 2;
constexpr int NSA_PS_OFF = 4 * TILE_EL * 2;
constexpr int NSA_IMP_OFF = NSA_PS_OFF + 64 * 128 * 4;
constexpr int NSA_SEL_OFF = NSA_IMP_OFF + 64 * 33 * 4;
__device__ __forceinline__ float nsa_gate(const float* gbase, int r, int i) { return sigmoidf_(gbase[((r & 3) + 8 * (r >> 2)) * 32 + i * 8]); }
__device__ UNIT_INLINE void nsa_unit(Frame& F, int unit, const bf16_t* U1, bf16_t* Y, const float* misc, const unsigned char* ws) {
    const int qb = 31 - (unit & 31), g = (unit >> 5) & 1, b = unit >> 6;
    const int r32 = F.lane & 31, hi = F.lane >> 5, hr = F.wave >> 1, qs = F.wave & 1, head = g * 4 + hr;
    const int q0 = qb * 64, ql = qs * 32 + r32, tq = q0 + ql;
    LAS bf16_t* Ks = (LAS bf16_t*)F.lds; LAS bf16_t* Vt = Ks + TILE_EL;
    LAS bf16_t* Ks1 = (LAS bf16_t*)(F.lds + NSA_K1_OFF); LAS bf16_t* Vt1 = Ks1 + TILE_EL;
    LAS unsigned* psum = (LAS unsigned*)(F.lds + NSA_PS_OFF);
    LAS float* impb = (LAS float*)(F.lds + NSA_IMP_OFF);
    LAS unsigned* selm = (LAS unsigned*)(F.lds + NSA_SEL_OFF);
    LAS float* wsf = (LAS float*)(F.lds + NSA_SEL_OFF + 256) + F.wave * 32;
    const bf16_t* rowb = U1 + (size_t)(b * SEQ) * UW;
    const int grow = b * SEQ + q0 + qs * 32;
    const float* gbase = misc + (size_t)(grow + 4 * hi) * 32 + 8 + head;
    bf16x8 qr[4];
#pragma unroll
    for (int d0 = 0; d0 < 4; ++d0) qr[d0] = *(const bf16x8*)(rowb + (size_t)tq * UW + UC_NQ + head * 64 + d0 * 16 + hi * 8);
    f32x16 ya0, ya1;
#pragma unroll
    for (int r = 0; r < 16; ++r) { ya0[r] = 0.f; ya1[r] = 0.f; }
    __syncthreads();
    for (int i = F.tid; i < 64 * 128; i += 512) psum[i] = 0u;
#ifndef NSA_NO_CMP
    {
        const bf16_t* kc = (const bf16_t*)(ws + WS_KC) + (size_t)((b * 2 + g) * 128) * 64;
        const bf16_t* vc = (const bf16_t*)(ws + WS_VC) + (size_t)((b * 2 + g) * 128) * 64;
        dma_kv(kc, 64, vc, 64, Ks, Vt, F.wave, F.lane);
        dma_kv(kc + 64 * 64, 64, vc + 64 * 64, 64, Ks1, Vt1, F.wave, F.lane);
        __syncthreads();
        float m = -INFINITY, l = 0.f;
#pragma unroll 1
        for (int tl = 0; tl < 2; ++tl) {
            f32x16 x0, x1; attn_scores(tl ? Ks1 : Ks, qr, x0, x1, r32, hi);
            float mx = -INFINITY;
#pragma unroll
            for (int r = 0; r < 16; ++r) { const int n0 = tl * 64 + crow(r, hi), n1 = n0 + 32;
                x0[r] = (16 * n0 + 31 <= tq) ? x0[r] * 0.125f : -INFINITY; x1[r] = (16 * n1 + 31 <= tq) ? x1[r] * 0.125f : -INFINITY; mx = fmaxf(mx, fmaxf(x0[r], x1[r])); }
            mx = fmaxf(mx, __shfl_xor(mx, 32));
            const float mn = fmaxf(m, mx), ms = (mn == -INFINITY) ? 0.f : mn;
            float rs = 0.f;
#pragma unroll
            for (int r = 0; r < 16; ++r) rs += exp2f((x0[r] - ms) * LOG2E) + exp2f((x1[r] - ms) * LOG2E);
            l = l * exp2f((m - ms) * LOG2E) + rs; m = mn;
        }
        l += __shfl_xor(l, 32);
        const float inv = l > 0.f ? 1.0f / l : 0.f, ms = (m == -INFINITY) ? 0.f : m;
        f32x16 oc0, oc1;
#pragma unroll
        for (int r = 0; r < 16; ++r) { oc0[r] = 0.f; oc1[r] = 0.f; }
#pragma unroll 1
        for (int tl = 0; tl < 2; ++tl) {
            f32x16 x0, x1; attn_scores(tl ? Ks1 : Ks, qr, x0, x1, r32, hi);
#pragma unroll
            for (int r = 0; r < 16; ++r) { const int n0 = tl * 64 + crow(r, hi), n1 = n0 + 32;
                x0[r] = (16 * n0 + 31 <= tq) ? exp2f((x0[r] * 0.125f - ms) * LOG2E) * inv : 0.f;
                x1[r] = (16 * n1 + 31 <= tq) ? exp2f((x1[r] * 0.125f - ms) * LOG2E) * inv : 0.f;
                atomicAdd((unsigned*)(psum + ql * 128 + n0), (unsigned)(x0[r] * 16777216.0f + 0.5f)); atomicAdd((unsigned*)(psum + ql * 128 + n1), (unsigned)(x1[r] * 16777216.0f + 0.5f)); }
            attn_pv(tl ? Vt1 : Vt, x0, x1, oc0, oc1, r32, hi);
        }
#pragma unroll
        for (int r = 0; r < 16; ++r) { const float gt = nsa_gate(gbase, r, 0); ya0[r] += gt * oc0[r]; ya1[r] += gt * oc1[r]; }
    }
#endif
    __syncthreads();
#ifndef NSA_NO_TOPK
    if (qb <= 7) { if (F.tid < 64) selm[F.tid] = (2u << qb) - 1u; }
    else {
        const int q = F.tid & 63, jg = F.tid >> 6;
#pragma unroll
        for (int jj = 0; jj < 4; ++jj) { const int j = jg * 4 + jj; unsigned sacc = 0u;
#pragma unroll
            for (int d = -1; d <= 3; ++d) { const int n = 4 * j + d; if (n >= 0 && n < 127) sacc += psum[q * 128 + n]; }
            impb[q * 33 + j] = (float)sacc; }
        if (jg == 0) selm[q] = 1u | (1u << qb);
        __syncthreads();
        unsigned bits = 0u;
#pragma unroll 1
        for (int jj = 0; jj < 4; ++jj) { const int j = jg * 4 + jj;
            if (j >= 1 && j < qb) { const float vj = impb[q * 33 + j]; int rank = 0;
#pragma unroll 1
                for (int i2 = 1; i2 < qb; ++i2) { const float vi = impb[q * 33 + i2]; rank += (vi > vj || (vi == vj && i2 < j)) ? 1 : 0; }
                if (rank < 6) bits |= 1u << j; } }
        if (bits) atomicOr((unsigned*)(selm + q), bits);
    }
#endif
    __syncthreads();
    unsigned uni;
    { unsigned v = selm[F.lane];
#pragma unroll
      for (int o = 1; o < 64; o <<= 1) v |= __shfl_xor(v, o);
      uni = __builtin_amdgcn_readfirstlane(v); }
    const unsigned mysel = selm[ql];
#pragma unroll 1
    for (int br = 0; br < 2; ++br) {
        const unsigned lowm = (qb >= 8) ? ~((1u << (qb - 8)) - 1u) : 0xffffffffu;
        const unsigned tmask = (br == 0) ? uni : (((2u << qb) - 1u) & lowm);
        const unsigned qsel = (br == 0) ? mysel : 0xffffffffu;
        const int wlim = (br == 0) ? (1 << 30) : 512;
        const int kcol = UC_NKV + (2 + 2 * br) * 128 + g * 64;
        AttnSt st; attn_init(st);
        {
            const bf16_t* kg = rowb + kcol; const bf16_t* vg = kg + 128;
            unsigned rem = tmask;
            int j = __builtin_ctz(rem); rem &= rem - 1u;
            __syncthreads();
            dma_kv(kg + (size_t)(j * 64) * UW, UW, vg + (size_t)(j * 64) * UW, UW, Ks, Vt, F.wave, F.lane);
            __syncthreads();
            int cur = 0;
#pragma unroll 1
            for (;;) {
                const int jn = rem ? __builtin_ctz(rem) : -1; rem &= rem - 1u;
                if (jn >= 0) dma_kv(kg + (size_t)(jn * 64) * UW, UW, vg + (size_t)(jn * 64) * UW, UW, cur ? Ks : Ks1, cur ? Vt : Vt1, F.wave, F.lane);
                const LAS bf16_t* kc_ = cur ? Ks1 : Ks; const LAS bf16_t* vc_ = cur ? Vt1 : Vt;
                f32x16 x0, x1; attn_scores(kc_, qr, x0, x1, r32, hi);
                const bool sel = (qsel >> j) & 1u;
#pragma unroll
                for (int r = 0; r < 16; ++r) { const int d0 = tq - (j * 64 + crow(r, hi)), d1 = d0 - 32;
                    x0[r] = (sel && d0 >= 0 && d0 < wlim) ? x0[r] * 0.125f : -INFINITY; x1[r] = (sel && d1 >= 0 && d1 < wlim) ? x1[r] * 0.125f : -INFINITY; }
                attn_online(vc_, x0, x1, st, wsf, r32, hi);
                __syncthreads();
                if (jn < 0) break;
                j = jn; cur ^= 1;
            }
        }
        const float l = st.l + __shfl_xor(st.l, 32), inv = l > 0.f ? 1.0f / l : 0.f;
        attn_scale_rows(st.o0, st.o1, inv, wsf, r32, hi);
#pragma unroll
        for (int r = 0; r < 16; ++r) { const float gt = nsa_gate(gbase, r, 1 + br); ya0[r] += gt * st.o0[r]; ya1[r] += gt * st.o1[r]; }
    }
    bf16_t* yb = Y + (size_t)grow * YW + 1 * 512 + head * 64 + r32;
#pragma unroll
    for (int r = 0; r < 16; ++r) { bf16_t* yp = yb + (size_t)crow(r, hi) * YW; yp[0] = (bf16_t)f2bf(ya0[r]); yp[32] = (bf16_t)f2bf(ya1[r]); }
}

constexpr int SL = 136;
constexpr int SSD_CS = 0, SSD_BS = SSD_CS + 128 * SL * 2, SSD_BT = SSD_BS + 128 * SL * 2, SSD_XT = SSD_BT + 128 * SL * 2, SSD_PV = SSD_XT + 64 * SL * 2,
              SSD_DT = SSD_PV + 64 * SL * 2, SSD_AC = SSD_DT + 512, SSD_A = SSD_AC + 512, SSD_END = SSD_A + 512;
static_assert(SSD_END <= LDS_USER, "ssd lds");
__device__ UNIT_INLINE void ssd_unit(Frame& F, int unit, int L, KArgs KA, const bf16_t* U1, bf16_t* Y, const float* misc, float* ssq) {
    const int h = unit & 7, b = unit >> 3, g = h >> 2;
    LAS bf16_t* Cs = (LAS bf16_t*)(F.lds + SSD_CS); LAS bf16_t* Bs = (LAS bf16_t*)(F.lds + SSD_BS); LAS bf16_t* Bt = (LAS bf16_t*)(F.lds + SSD_BT);
    LAS bf16_t* Xt = (LAS bf16_t*)(F.lds + SSD_XT); LAS bf16_t* Pv = (LAS bf16_t*)(F.lds + SSD_PV);
    LAS float* dts = (LAS float*)(F.lds + SSD_DT); LAS float* acs = (LAS float*)(F.lds + SSD_AC); LAS float* as_ = (LAS float*)(F.lds + SSD_A);
    const float* cw = IN_F(5) + (size_t)L * 4 * 1024; const float* cb = IN_F(6) + (size_t)L * 1024;
    const float dtb = IN_F(7)[L * 8 + h], Ah = -expf(IN_F(8)[L * 8 + h]), Dh = IN_F(9)[L * 8 + h];
    const int r16 = F.lane & 15, kg = F.lane >> 4, w = F.wave;
    const bf16_t* rowb = U1 + (size_t)(b * SEQ) * UW;
    f32x4 stt[4];
#pragma unroll
    for (int j = 0; j < 4; ++j) stt[j] = (f32x4){0.f, 0.f, 0.f, 0.f};
    __syncthreads();
    for (int i = F.tid; i < 64 * SL / 2; i += 512) ((LAS unsigned*)Pv)[i] = 0u;
    for (int c = 0; c < 16; ++c) {
        const int t0 = c * 128;
        __syncthreads();
        for (int i = F.tid; i < 40 * 128; i += 512) {
            const int ch = i % 40, l = i / 40;
            const int cidx = (ch < 8) ? (h * 64 + ch * 8) : (ch < 24 ? 512 + g * 128 + (ch - 8) * 8 : 768 + g * 128 + (ch - 24) * 8);
            float a8[8];
            { const f32x4 b0 = *(const f32x4*)(cb + cidx), b1 = *(const f32x4*)(cb + cidx + 4);
#pragma unroll
              for (int j = 0; j < 4; ++j) { a8[j] = b0[j]; a8[4 + j] = b1[j]; } }
#pragma unroll
            for (int k = 0; k < 4; ++k) {
                const int t = t0 + l - 3 + k;
                if (t >= 0) {
                    const u32x4 xv = *(const u32x4*)(rowb + (size_t)t * UW + UC_XBC + cidx);
                    const f32x4 w0 = *(const f32x4*)(cw + k * 1024 + cidx), w1 = *(const f32x4*)(cw + k * 1024 + cidx + 4);
#pragma unroll
                    for (int j = 0; j < 4; ++j) { a8[2 * j] += bf2f(xv[j] & 0xffffu) * (j < 2 ? w0[2 * j] : w1[2 * j - 4]); a8[2 * j + 1] += bf2f(xv[j] >> 16) * (j < 2 ? w0[2 * j + 1] : w1[2 * j - 3]); }
                }
            }
            unsigned short o[8];
#pragma unroll
            for (int j = 0; j < 8; ++j) o[j] = (unsigned short)f2bf(siluf_(a8[j]));
            if (ch < 8) {
#pragma unroll
                for (int j = 0; j < 8; ++j) Xt[(ch * 8 + j) * SL + l] = o[j];
            } else if (ch < 24) {
                const int n0 = (ch - 8) * 8;
                u32x4 pk; pk.x = o[0] | ((unsigned)o[1] << 16); pk.y = o[2] | ((unsigned)o[3] << 16); pk.z = o[4] | ((unsigned)o[5] << 16); pk.w = o[6] | ((unsigned)o[7] << 16);
                *(LAS u32x4*)(Bs + l * SL + n0) = pk;
#pragma unroll
                for (int j = 0; j < 8; ++j) Bt[(n0 + j) * SL + l] = o[j];
            } else {
                const int n0 = (ch - 24) * 8;
                u32x4 pk; pk.x = o[0] | ((unsigned)o[1] << 16); pk.y = o[2] | ((unsigned)o[3] << 16); pk.z = o[4] | ((unsigned)o[5] << 16); pk.w = o[6] | ((unsigned)o[7] << 16);
                *(LAS u32x4*)(Cs + l * SL + n0) = pk;
            }
        }
        if (F.tid < 128) { const float dt = softplusf_(misc[(size_t)(b * SEQ + t0 + F.tid) * 32 + h] + dtb); dts[F.tid] = dt; as_[F.tid] = dt * Ah; }
        __syncthreads();
        if (F.tid < 128) { float s = 0.f; for (int j = 0; j <= F.tid; ++j) s += as_[j]; acs[F.tid] = s; }
        __syncthreads();
        f32x4 cbv[8];
#pragma unroll
        for (int j = 0; j < 8; ++j) cbv[j] = (f32x4){0.f, 0.f, 0.f, 0.f};
#pragma unroll
        for (int ks = 0; ks < 4; ++ks) {
            const bf16x8 a = *(const LAS bf16x8*)(Cs + (16 * w + r16) * SL + ks * 32 + kg * 8);
#pragma unroll
            for (int j = 0; j < 8; ++j) { const bf16x8 bb = *(const LAS bf16x8*)(Bs + (16 * j + r16) * SL + ks * 32 + kg * 8); cbv[j] = __builtin_amdgcn_mfma_f32_16x16x32_bf16(a, bb, cbv[j], 0, 0, 0); }
        }
        __syncthreads();
        LAS bf16_t* Ws = Bs;
#pragma unroll
        for (int j = 0; j < 8; ++j)
#pragma unroll
            for (int r = 0; r < 4; ++r) { const int l = 16 * w + 4 * kg + r, s = 16 * j + r16;
                const float wv = (s <= l) ? cbv[j][r] * __expf(acs[l] - acs[s]) * dts[s] : 0.f;
                Ws[l * SL + s] = (bf16_t)f2bf(wv); }
        __syncthreads();
        f32x4 yd[4], yo[4];
#pragma unroll
        for (int j = 0; j < 4; ++j) { yd[j] = (f32x4){0.f, 0.f, 0.f, 0.f}; yo[j] = (f32x4){0.f, 0.f, 0.f, 0.f}; }
#pragma unroll
        for (int ks = 0; ks < 4; ++ks) {
            const bf16x8 aw = *(const LAS bf16x8*)(Ws + (16 * w + r16) * SL + ks * 32 + kg * 8);
            const bf16x8 ac = *(const LAS bf16x8*)(Cs + (16 * w + r16) * SL + ks * 32 + kg * 8);
#pragma unroll
            for (int j = 0; j < 4; ++j) {
                const bf16x8 bx = *(const LAS bf16x8*)(Xt + (16 * j + r16) * SL + ks * 32 + kg * 8);
                const bf16x8 bp = *(const LAS bf16x8*)(Pv + (16 * j + r16) * SL + ks * 32 + kg * 8);
                yd[j] = __builtin_amdgcn_mfma_f32_16x16x32_bf16(aw, bx, yd[j], 0, 0, 0);
                yo[j] = __builtin_amdgcn_mfma_f32_16x16x32_bf16(ac, bp, yo[j], 0, 0, 0);
            }
        }
#pragma unroll
        for (int r = 0; r < 4; ++r) {
            const int l = 16 * w + 4 * kg + r; const float ea = __expf(acs[l]); const size_t trow = (size_t)(b * SEQ + t0 + l);
            float sq = 0.f;
#pragma unroll
            for (int j = 0; j < 4; ++j) { const int p = 16 * j + r16;
                const float x = bf2f(Xt[p * SL + l]);
                const float z = bf2f(rowb[(size_t)(t0 + l) * UW + UC_Z + h * 64 + p]);
                const float yv = (yd[j][r] + yo[j][r] * ea + Dh * x) * siluf_(z);
                sq += yv * yv;
                Y[trow * YW + h * 64 + p] = (bf16_t)f2bf(yv); }
            sq += __shfl_xor(sq, 1); sq += __shfl_xor(sq, 2); sq += __shfl_xor(sq, 4); sq += __shfl_xor(sq, 8);
            if (r16 == 0) ssq[trow * 8 + h] = sq;
        }
        __syncthreads();
        { const float aend = acs[127];
          for (int i = F.tid; i < 64 * 128; i += 512) { const int p = i >> 7, l = i & 127; Xt[p * SL + l] = (bf16_t)f2bf(bf2f(Xt[p * SL + l]) * dts[l] * __expf(aend - acs[l])); } }
        __syncthreads();
        { const float cd = __expf(acs[127]); const int pt = w & 3;
#pragma unroll
          for (int j = 0; j < 4; ++j) stt[j] *= cd;
#pragma unroll
          for (int ks = 0; ks < 4; ++ks) {
              const bf16x8 a = *(const LAS bf16x8*)(Xt + (16 * pt + r16) * SL + ks * 32 + kg * 8);
#pragma unroll
              for (int j = 0; j < 4; ++j) { const int nt = (w >> 2) * 4 + j; const bf16x8 bb = *(const LAS bf16x8*)(Bt + (16 * nt + r16) * SL + ks * 32 + kg * 8);
                  stt[j] = __builtin_amdgcn_mfma_f32_16x16x32_bf16(a, bb, stt[j], 0, 0, 0); }
          }
#pragma unroll
          for (int j = 0; j < 4; ++j) { const int nt = (w >> 2) * 4 + j;
#pragma unroll
              for (int r = 0; r < 4; ++r) Pv[(16 * pt + 4 * kg + r) * SL + 16 * nt + r16] = (bf16_t)f2bf(stt[j][r]); }
        }
    }
}

constexpr int RW_CT = 16, RW_NC = SEQ / RW_CT;
constexpr int RB_DEC = 0, RB_NB = 4096, RB_CC = 8192, RB_K = 12288, RB_R = 16384, RB_V = 20480, RB_G = 24576  , RB_BS = 26624, RB_SIZE = 26880;
constexpr int RW_OUT = 2 * RB_SIZE, RW_WDH = RW_OUT + 2 * 4096, RW_ADH = RW_WDH + 16 * 72 * 2, RW_GDH = RW_ADH + 16 * 72 * 2, RW_CONST = RW_GDH + 16 * 136 * 2  ,
              RW_MU = RW_CONST + 5 * 256  , RW_LW = RW_MU + 448 * 4  , RW_RAW = RW_LW + 32768,
              RAW_R = 0, RAW_K = 3072, RAW_V = 6144, RAW_L = 9216, RAW_SIZE = 18432, RW_END = RW_RAW + 2 * RAW_SIZE;
static_assert(RW_END <= LDS_USER && RW_RAW % 16 == 0 && RW_LW % 16 == 0, "rwkv lds");
template <int CTRL> __device__ __forceinline__ float dppf(float x) { return __int_as_float(__builtin_amdgcn_update_dpp(0, __float_as_int(x), CTRL, 0xf, 0xf, false)); }
__device__ __forceinline__ float reduce8(float x) { x += dppf<0xB1>(x); x += dppf<0x4E>(x); x += dppf<0x141>(x); return x; }
__device__ __forceinline__ float reduce16(float x) { x = reduce8(x); x += dppf<0x140>(x); return x; }
__device__ __forceinline__ float fast_tanh(float x) { const float e = __expf(2.0f * x); return 1.0f - 2.0f / (e + 1.0f); }
#define RW_BAR() do { asm volatile("s_waitcnt lgkmcnt(0)" ::: "memory"); __builtin_amdgcn_s_barrier(); asm volatile("" ::: "memory"); } while (0)
struct RwEarly { f32x2 nb[4], dc[4]; };
struct RwLate { f32x2 cc[4], kk[4], rr[4]; f32x2 vv; };
__device__ __forceinline__ void rw_load_early(RwEarly& v, const LAS unsigned char* buf, int ti, int kq) {
    const int o = (ti * 64 + kq * 8) * 4;
#pragma unroll
    for (int j = 0; j < 2; ++j) {
        const f32x4 a = *(const LAS f32x4*)(buf + RB_NB + o + 16 * j), b = *(const LAS f32x4*)(buf + RB_DEC + o + 16 * j);
        v.nb[2 * j] = (f32x2){a[0], a[1]}; v.nb[2 * j + 1] = (f32x2){a[2], a[3]}; v.dc[2 * j] = (f32x2){b[0], b[1]}; v.dc[2 * j + 1] = (f32x2){b[2], b[3]};
    }
}
__device__ __forceinline__ void rw_load_late(RwLate& v, const LAS unsigned char* buf, int ti, int kq, int rp) {
    const int o = (ti * 64 + kq * 8) * 4;
#pragma unroll
    for (int j = 0; j < 2; ++j) {
        const f32x4 c = *(const LAS f32x4*)(buf + RB_CC + o + 16 * j), d = *(const LAS f32x4*)(buf + RB_K + o + 16 * j), e = *(const LAS f32x4*)(buf + RB_R + o + 16 * j);
        v.cc[2 * j] = (f32x2){c[0], c[1]}; v.cc[2 * j + 1] = (f32x2){c[2], c[3]}; v.kk[2 * j] = (f32x2){d[0], d[1]}; v.kk[2 * j + 1] = (f32x2){d[2], d[3]};
        v.rr[2 * j] = (f32x2){e[0], e[1]}; v.rr[2 * j + 1] = (f32x2){e[2], e[3]};
    }
    v.vv = *(const LAS f32x2*)(buf + RB_V + (ti * 64 + 2 * rp) * 4);
}
__device__ __forceinline__ void rw_post(const LAS unsigned char* lds, const LAS unsigned char* buf, const LAS float* out, bf16_t* yrow0, int ti, int cg) {
    const int o = ti * 64 + cg * 4;
    const f32x4 x = *(const LAS f32x4*)(out + o), v = *(const LAS f32x4*)((const LAS float*)(buf + RB_V) + o);
    const u32x2 gq = *(const LAS u32x2*)((const LAS bf16_t*)(buf + RB_G) + o);
    const LAS float* cst = (const LAS float*)(lds + RW_CONST) + cg * 4;
    const f32x4 lw = *(const LAS f32x4*)(cst + 192), lb = *(const LAS f32x4*)(cst + 256);
    const float bs = ((const LAS float*)(buf + RB_BS))[ti];
    const float mean = reduce16((x[0] + x[1]) + (x[2] + x[3])) * (1.0f / 64.0f);
    const f32x4 d = x - mean;
    const float rstd = rsqrtf(reduce16((d[0] * d[0] + d[1] * d[1]) + (d[2] * d[2] + d[3] * d[3])) * (1.0f / 64.0f) + 64e-5f);
    const f32x4 g = unpack4(gq);
    const f32x4 y = (d * rstd * lw + lb + v * bs) * g;
    *(u32x2*)(yrow0 + (size_t)ti * YW + cg * 4) = pack4(y);
}
__device__ UNIT_INLINE void rwkv_unit(Frame& F, int unit, int L, KArgs KA, const bf16_t* U1, bf16_t* Y) {
    const int h = unit & 7, b = unit >> 3;
    const bool scanner = F.wave < 4;
    LAS unsigned char* lds = F.lds;
    const bf16_t* rowb = U1 + (size_t)(b * SEQ) * UW + UC_RW;
    bf16_t* ybase = Y + (size_t)(b * SEQ) * YW + 2 * 512 + h * 64;
    const int rp = (F.tid >> 3) & 31, kq = F.tid & 7;
    f32x2 s0[4], s1[4];
#pragma unroll
    for (int j = 0; j < 4; ++j) { s0[j] = (f32x2){0.f, 0.f}; s1[j] = (f32x2){0.f, 0.f}; }
    const int ww = F.wave & 3, wtid = F.tid & 255, r16 = F.lane & 15, kg = F.lane >> 4;
    const int wti = wtid >> 4, wcg = wtid & 15;
    float w0n = 0.f, a0n = 0.f;
    __syncthreads();
    if (!scanner) { const int cn = h * 64 + 16 * ww + r16; w0n = IN_F(15)[L * 512 + cn]; a0n = IN_F(17)[L * 512 + cn]; }
    if (F.tid < 320) { const int v = F.tid >> 6; ((LAS float*)(lds + RW_CONST))[F.tid] = IN_F(20 + v)[L * 512 + h * 64 + (F.tid & 63)]; }
    if (F.tid < 448) { const int i = F.tid; const int col = i < 64 ? h * 64 + i : i < 128 ? 512 + h * 64 + (i - 64) : i < 192 ? 1024 + h * 64 + (i - 128) : 1536 + (i - 192);
        ((LAS float*)(lds + RW_MU))[i] = IN_F(14)[(size_t)L * 1792 + col]; }
    { const u32x4* lw = (const u32x4*)(KA->ws + WS_LW) + (size_t)((L * 8 + h) * 4) * 8 * 64;
      for (int i = F.tid; i < 2048; i += 512) *(LAS u32x4*)(lds + RW_LW + i * 16) = lw[i]; }
    asm volatile("s_waitcnt vmcnt(0)" ::: "memory");
    __syncthreads();
#define RW_DMA(cc) do { const int t0_ = (cc) * RW_CT - 1; LAS unsigned char* rb_ = lds + RW_RAW + ((cc) & 1) * RAW_SIZE; \
        _Pragma("unroll") for (int q_ = 0; q_ < 5; ++q_) { const int ix_ = ww + 4 * q_; if (ix_ < 18) { \
            int tok_, col_, dst_; \
            if (ix_ < 9) { const int kind_ = ix_ / 3, p_ = ix_ % 3; tok_ = 8 * p_ + (F.lane >> 3); col_ = kind_ * 512 + h * 64 + (F.lane & 7) * 8; dst_ = kind_ * 3072 + p_ * 1024; } \
            else { const int p_ = ix_ - 9; tok_ = 2 * p_ + (F.lane >> 5); col_ = 1536 + (F.lane & 31) * 8; dst_ = RAW_L + p_ * 1024; } \
            int t_ = t0_ + (tok_ > 16 ? 16 : tok_); t_ = t_ < 0 ? 0 : t_; \
            __builtin_amdgcn_global_load_lds((const unsigned*)(rowb + (size_t)t_ * UW + col_), (LAS unsigned*)(rb_ + dst_), 16, 0, 0); } } } while (0)
#pragma unroll 1
    for (int ck = -2; ck < RW_NC; ++ck) {
        LAS unsigned char* bcur = lds + (ck & 1) * RB_SIZE;
        LAS unsigned char* bnxt = lds + ((ck + 1) & 1) * RB_SIZE;
        LAS float* ocur = (LAS float*)(lds + RW_OUT + (ck & 1) * 4096); const LAS float* oprv = (const LAS float*)(lds + RW_OUT + ((ck + 1) & 1) * 4096);
        const bool do_scan = scanner && ck >= 0, do_post = !scanner && ck >= 1, do_prep = !scanner && ck + 1 >= 0 && ck + 1 < RW_NC, do_dma = !scanner && ck + 2 < RW_NC;
        RwEarly cur;
        if (do_scan) rw_load_early(cur, bcur, 0, kq);
#define RW_SCAN_SEG(T0) if (do_scan) { _Pragma("unroll") for (int ti = (T0); ti < (T0) + 4; ++ti) { \
            RwLate lt; rw_load_late(lt, bcur, ti, kq, rp); \
            RwEarly nx = cur; if (ti + 1 < RW_CT) rw_load_early(nx, bcur, ti + 1, kq); \
            f32x2 a0 = s0[0] * cur.nb[0], a1 = s1[0] * cur.nb[0]; \
            _Pragma("unroll") for (int j = 1; j < 4; ++j) { a0 += s0[j] * cur.nb[j]; a1 += s1[j] * cur.nb[j]; } \
            const float sa0 = reduce8(a0[0] + a0[1]), sa1 = reduce8(a1[0] + a1[1]); \
            _Pragma("unroll") for (int j = 0; j < 4; ++j) { s0[j] = s0[j] * cur.dc[j] + (lt.cc[j] * sa0 + lt.kk[j] * lt.vv[0]); s1[j] = s1[j] * cur.dc[j] + (lt.cc[j] * sa1 + lt.kk[j] * lt.vv[1]); } \
            f32x2 o0 = s0[0] * lt.rr[0], o1 = s1[0] * lt.rr[0]; \
            _Pragma("unroll") for (int j = 1; j < 4; ++j) { o0 += s0[j] * lt.rr[j]; o1 += s1[j] * lt.rr[j]; } \
            const float q0 = reduce8(o0[0] + o0[1]), q1 = reduce8(o1[0] + o1[1]); \
            if (kq == 0) *(LAS f32x2*)(ocur + ti * 64 + 2 * rp) = (f32x2){q0, q1}; \
            cur = nx; } }
        RW_SCAN_SEG(0)
        if (!scanner) asm volatile("s_waitcnt vmcnt(0)" ::: "memory");
        if (do_dma) RW_DMA(ck + 2);
        if (do_post) rw_post(lds, bnxt, oprv, ybase + (size_t)((ck - 1) * RW_CT) * YW, wti, wcg);
        RW_BAR();
        RW_SCAN_SEG(4)
        if (do_prep) {
            const LAS unsigned char* raw = lds + RW_RAW + ((ck + 1) & 1) * RAW_SIZE;
            const bool first = (ck + 1 == 0);
#pragma unroll
            for (int n = 0; n < 4; ++n) {
                const int i = wtid + 256 * n;
                if (i < 896) {
                    const int kind = i < 768 ? i >> 7 : 5;
                    const int idx = i - (kind < 5 ? kind * 128 : 640);
                    const int tok = kind < 5 ? idx >> 3 : idx >> 4, piece = kind < 5 ? idx & 7 : idx & 15;
                    int so, mo;
                    if (kind < 3) { so = kind * 3072 + (tok + 1) * 128 + piece * 16; mo = kind * 64 + piece * 8; }
                    else { const int lp = (kind == 3 ? 0 : kind == 4 ? 8 : 16) + piece; so = RAW_L + (tok + 1) * 512 + lp * 16; mo = 192 + lp * 8; }
                    const u32x4 rc = *(const LAS u32x4*)(raw + so);
                    u32x4 rv = *(const LAS u32x4*)(raw + so - (kind < 3 ? 128 : 512));
                    if (first && tok == 0) rv = (u32x4){0u, 0u, 0u, 0u};
                    const f32x4 m0 = *(const LAS f32x4*)((const LAS float*)(lds + RW_MU) + mo), m1 = *(const LAS f32x4*)((const LAS float*)(lds + RW_MU) + mo + 4);
                    float y[8];
#pragma unroll
                    for (int j = 0; j < 4; ++j) {
                        const float x0 = bf2f(rc[j] & 0xffffu), x1 = bf2f(rc[j] >> 16), p0 = bf2f(rv[j] & 0xffffu), p1 = bf2f(rv[j] >> 16);
                        y[2 * j] = x0 + (p0 - x0) * (j < 2 ? m0[2 * j] : m1[2 * j - 4]); y[2 * j + 1] = x1 + (p1 - x1) * (j < 2 ? m0[2 * j + 1] : m1[2 * j - 3]);
                    }
                    if (kind < 3) {
                        LAS float* dst = (LAS float*)(bnxt + (kind == 0 ? RB_R : kind == 1 ? RB_K : RB_V)) + tok * 64 + piece * 8;
                        *(LAS f32x4*)dst = (f32x4){y[0], y[1], y[2], y[3]}; *(LAS f32x4*)(dst + 4) = (f32x4){y[4], y[5], y[6], y[7]};
                    } else {
                        LAS bf16_t* dst;
                        if (kind == 3) { dst = (LAS bf16_t*)(lds + RW_WDH) + tok * 72 + piece * 8;
#pragma unroll
                            for (int j = 0; j < 8; ++j) y[j] = fast_tanh(y[j]); }
                        else if (kind == 4) dst = (LAS bf16_t*)(lds + RW_ADH) + tok * 72 + piece * 8;
                        else { dst = (LAS bf16_t*)(lds + RW_GDH) + tok * 136 + piece * 8;
#pragma unroll
                            for (int j = 0; j < 8; ++j) y[j] = sigmoidf_(y[j]); }
                        u32x4 pk; pk.x = cvt_pk(y[0], y[1]); pk.y = cvt_pk(y[2], y[3]); pk.z = cvt_pk(y[4], y[5]); pk.w = cvt_pk(y[6], y[7]);
                        *(LAS u32x4*)dst = pk;
                    }
                }
            }
        }
        RW_BAR();
        RW_SCAN_SEG(8)
        if (do_prep) {
            LAS float* sDEC = (LAS float*)(bnxt + RB_DEC); LAS float* sCC = (LAS float*)(bnxt + RB_CC); LAS bf16_t* sG = (LAS bf16_t*)(bnxt + RB_G);
            const LAS bf16_t* sWDh = (const LAS bf16_t*)(lds + RW_WDH); const LAS bf16_t* sADh = (const LAS bf16_t*)(lds + RW_ADH); const LAS bf16_t* sGDh = (const LAS bf16_t*)(lds + RW_GDH);
            const LAS bf16x8* Bf = (const LAS bf16x8*)(lds + RW_LW) + ww * 8 * 64 + F.lane;
            f32x4 aw = (f32x4){0.f, 0.f, 0.f, 0.f}, aa = aw, ag = aw;
#pragma unroll
            for (int ks = 0; ks < 2; ++ks) {
                const bf16x8 xw = *(const LAS bf16x8*)(sWDh + r16 * 72 + 32 * ks + 8 * kg), xa = *(const LAS bf16x8*)(sADh + r16 * 72 + 32 * ks + 8 * kg);
                aw = __builtin_amdgcn_mfma_f32_16x16x32_bf16(xw, Bf[ks * 64], aw, 0, 0, 0); aa = __builtin_amdgcn_mfma_f32_16x16x32_bf16(xa, Bf[(2 + ks) * 64], aa, 0, 0, 0);
            }
#pragma unroll
            for (int ks = 0; ks < 4; ++ks) { const bf16x8 xg = *(const LAS bf16x8*)(sGDh + r16 * 136 + 32 * ks + 8 * kg); ag = __builtin_amdgcn_mfma_f32_16x16x32_bf16(xg, Bf[(4 + ks) * 64], ag, 0, 0, 0); }
#pragma unroll
            for (int r = 0; r < 4; ++r) { const int o = (4 * kg + r) * 64 + 16 * ww + r16; sDEC[o] = aw[r] + w0n; sCC[o] = aa[r] + a0n; sG[o] = (bf16_t)f2bf(ag[r]); }
        }
        RW_BAR();
        RW_SCAN_SEG(12)
        if (do_prep) {
            const int o = wti * 64 + wcg * 4;
            LAS float* pDEC = (LAS float*)(bnxt + RB_DEC) + o; LAS float* pNB = (LAS float*)(bnxt + RB_NB) + o; LAS float* pCC = (LAS float*)(bnxt + RB_CC) + o;
            LAS float* pK = (LAS float*)(bnxt + RB_K) + o; const LAS float* pR = (const LAS float*)(bnxt + RB_R) + o;
            const LAS float* cst = (const LAS float*)(lds + RW_CONST) + wcg * 4;
            const f32x4 wp = *(const LAS f32x4*)pDEC, ap = *(const LAS f32x4*)pCC, kr = *(const LAS f32x4*)pK, rr = *(const LAS f32x4*)pR;
            const f32x4 ckk = *(const LAS f32x4*)cst, cka = *(const LAS f32x4*)(cst + 64), crk = *(const LAS f32x4*)(cst + 128);
            f32x4 dec, a, kk, k2;
#pragma unroll
            for (int j = 0; j < 4; ++j) {
                const float sp = (-wp[j] > 20.f) ? -wp[j] : __logf(1.0f + __expf(-wp[j]));
                dec[j] = __expf(-__expf(-sp - 0.5f)); a[j] = sigmoidf_(ap[j]);
            }
            kk = kr * ckk; k2 = kr * ((a - 1.0f) * cka + 1.0f);
            const f32x4 bb = rr * k2 * crk;
            const float sq = reduce16((kk[0] * kk[0] + kk[1] * kk[1]) + (kk[2] * kk[2] + kk[3] * kk[3]));
            const float bsum = reduce16((bb[0] + bb[1]) + (bb[2] + bb[3]));
            const float rn = 1.0f / fmaxf(sqrtf(sq), 1e-12f);
            const f32x4 kn = kk * rn;
            *(LAS f32x4*)pDEC = dec; *(LAS f32x4*)pNB = -kn; *(LAS f32x4*)pCC = kn * a; *(LAS f32x4*)pK = k2;
            if (wcg == 0) ((LAS float*)(bnxt + RB_BS))[wti] = bsum;
        }
        RW_BAR();
#undef RW_SCAN_SEG
    }
#undef RW_DMA
    if (!scanner) rw_post(lds, lds + RB_SIZE, (const LAS float*)(lds + RW_OUT + 4096), ybase + (size_t)(SEQ - RW_CT) * YW, wti, wcg);
}

__device__ UNIT_INLINE void ssd_fixup_and_pb(Frame& F, int L, KArgs KA, bf16_t* Y, const float* ssq, bf16_t* PB) {
    const int gt = F.bid * 512 + F.tid, NT = F.G * 512;
    const float* nw = IN_F(10) + (size_t)L * 512;
    for (int i = gt; i < T * 64; i += NT) {
        const int t = i >> 6, ch = i & 63, g = ch >> 5;
        const f32x4 q = *(const f32x4*)(ssq + (size_t)t * 8 + g * 4);
        const float rs = rsqrtf(((q[0] + q[1]) + (q[2] + q[3])) * (1.0f / 256.0f) + NORM_EPS);
        bf16_t* yp = Y + (size_t)t * YW + ch * 8;
        const u32x4 v = *(const u32x4*)yp; const f32x4 n0 = *(const f32x4*)(nw + ch * 8), n1 = *(const f32x4*)(nw + ch * 8 + 4);
        u32x4 o;
        o.x = cvt_pk(bf2f(v.x & 0xffffu) * rs * n0[0], bf2f(v.x >> 16) * rs * n0[1]); o.y = cvt_pk(bf2f(v.y & 0xffffu) * rs * n0[2], bf2f(v.y >> 16) * rs * n0[3]);
        o.z = cvt_pk(bf2f(v.z & 0xffffu) * rs * n1[0], bf2f(v.z >> 16) * rs * n1[1]); o.w = cvt_pk(bf2f(v.w & 0xffffu) * rs * n1[2], bf2f(v.w >> 16) * rs * n1[3]);
        *(u32x4*)yp = o;
    }
    const float* p = IN_F(1) + (size_t)L * T * PLE;
    for (int i = gt; i < T * PLE / 8; i += NT) {
        const f32x4 a = *(const f32x4*)(p + (size_t)i * 8), b = *(const f32x4*)(p + (size_t)i * 8 + 4);
        u32x4 o; o.x = cvt_pk(a[0], a[1]); o.y = cvt_pk(a[2], a[3]); o.z = cvt_pk(b[0], b[1]); o.w = cvt_pk(b[2], b[3]);
        *(u32x4*)(PB + (size_t)i * 8) = o;
    }
}
__device__ UNIT_INLINE void moe_router(Frame& F, KArgs KA, const float* xo, unsigned* cnt, int* toke, int* tokp, float* tokw) {
    const int gw = F.bid * 8 + F.wave, NGW = F.G * 8;
    const float* gff = IN_F(31) + DM; const float* router = IN_F(35);
    for (int m = gw; m < T; m += NGW) {
        const f32x4* xr = (const f32x4*)(xo + (size_t)m * DM) + F.lane; f32x4 v[4]; float s = 0.f;
#pragma unroll
        for (int j = 0; j < 4; ++j) { v[j] = xr[64 * j]; s += (v[j][0] * v[j][0] + v[j][1] * v[j][1]) + (v[j][2] * v[j][2] + v[j][3] * v[j][3]); }
        const float rstd = rsqrtf(wave_sum(s) * (1.0f / DM) + NORM_EPS);
        float lg[8];
#pragma unroll
        for (int e = 0; e < 8; ++e) lg[e] = 0.f;
#pragma unroll
        for (int j = 0; j < 4; ++j) { const f32x4 gg = *((const f32x4*)gff + F.lane + 64 * j);
#pragma unroll
            for (int i = 0; i < 4; ++i) { const int k = 4 * F.lane + 256 * j + i; const float hv = v[j][i] * rstd * gg[i];
                const f32x4 r0 = *(const f32x4*)(router + (size_t)k * 8), r1 = *(const f32x4*)(router + (size_t)k * 8 + 4);
                lg[0] += hv * r0[0]; lg[1] += hv * r0[1]; lg[2] += hv * r0[2]; lg[3] += hv * r0[3]; lg[4] += hv * r1[0]; lg[5] += hv * r1[1]; lg[6] += hv * r1[2]; lg[7] += hv * r1[3]; } }
#pragma unroll
        for (int e = 0; e < 8; ++e) lg[e] = wave_sum(lg[e]);
        if (F.lane == 0) {
            int e1 = 0; float v1 = lg[0];
#pragma unroll
            for (int e = 1; e < 8; ++e) if (lg[e] > v1) { v1 = lg[e]; e1 = e; }
            int e2 = -1; float v2 = -INFINITY;
#pragma unroll
            for (int e = 0; e < 8; ++e) if (e != e1 && lg[e] > v2) { v2 = lg[e]; e2 = e; }
            const float ex = __expf(v2 - v1), w1 = 1.0f / (1.0f + ex), w2 = ex / (1.0f + ex);
            const int p1 = (int)atomicAdd(cnt + 64 * e1, 1u), p2 = (int)atomicAdd(cnt + 64 * e2, 1u);
            toke[2 * m] = e1; toke[2 * m + 1] = e2; tokp[2 * m] = p1; tokp[2 * m + 1] = p2; tokw[2 * m] = w1; tokw[2 * m + 1] = w2;
        }
    }
}
__device__ __forceinline__ void moe_tables(const unsigned* cnt, MoeTables& mt, int (&c)[8]) {
#pragma unroll
    for (int e = 0; e < 8; ++e) c[e] = (int)__hip_atomic_load(cnt + 64 * e, RLX_AGENT);
    int ps = 0;
    ps += (c[0] + 255) & ~255; mt.ps1 = ps; ps += (c[1] + 255) & ~255; mt.ps2 = ps; ps += (c[2] + 255) & ~255; mt.ps3 = ps; ps += (c[3] + 255) & ~255; mt.ps4 = ps;
    ps += (c[4] + 255) & ~255; mt.ps5 = ps; ps += (c[5] + 255) & ~255; mt.ps6 = ps; ps += (c[6] + 255) & ~255; mt.ps7 = ps; ps += (c[7] + 255) & ~255; mt.ps8 = ps;
}
__device__ __forceinline__ int moe_pstart(const MoeTables& mt, int e) {
    return e == 0 ? 0 : e == 1 ? mt.ps1 : e == 2 ? mt.ps2 : e == 3 ? mt.ps3 : e == 4 ? mt.ps4 : e == 5 ? mt.ps5 : e == 6 ? mt.ps6 : mt.ps7;
}
__device__ UNIT_INLINE void moe_slots(Frame& F, const float* xo, const float* ss2, const unsigned* cnt, const int* toke, const int* tokp, int* toks, bf16_t* XG, float* srstd) {
    const int gw = F.bid * 8 + F.wave, NGW = F.G * 8;
    MoeTables mt; int c[8]; moe_tables(cnt, mt, c);
    for (int m = gw; m < T; m += NGW) {
        const f32x4* xr = (const f32x4*)(xo + (size_t)m * DM) + F.lane; u32x2 pk[4];
#pragma unroll
        for (int j = 0; j < 4; ++j) pk[j] = pack4(xr[64 * j]);
        const float rs = rstd_of(ss2, m);
#pragma unroll
        for (int k = 0; k < 2; ++k) {
            const int e = toke[2 * m + k], slot = moe_pstart(mt, e) + tokp[2 * m + k];
            u32x2* o = (u32x2*)(XG + (size_t)slot * DM) + F.lane;
#pragma unroll
            for (int j = 0; j < 4; ++j) o[64 * j] = pk[j];
            if (F.lane == 0) { toks[2 * m + k] = slot; srstd[slot] = rs; }
        }
    }
    for (int idx = gw; idx < 8 * 256; idx += NGW) {
        const int e = idx >> 8, r = idx & 255;
        int ce = 0;
#pragma unroll
        for (int q = 0; q < 8; ++q) if (q == e) ce = c[q];
        const int row = moe_pstart(mt, e) + ce + r, end = (e == 7) ? mt.ps8 : moe_pstart(mt, e + 1);
        if (row < end) { u32x2* o = (u32x2*)(XG + (size_t)row * DM) + F.lane;
#pragma unroll
            for (int j = 0; j < 4; ++j) o[64 * j] = (u32x2){0u, 0u};
            if (F.lane == 0) srstd[row] = 0.f; }
    }
}
__device__ UNIT_INLINE void moe_combine(Frame& F, float* xo, const bf16_t* YB, const int* toks, const float* tokw, bf16_t* XB2) {
    const int gw = F.bid * 8 + F.wave, NGW = F.G * 8;
    for (int m = gw; m < T; m += NGW) {
        const int s0 = toks[2 * m], s1 = toks[2 * m + 1]; const float w0 = tokw[2 * m], w1 = tokw[2 * m + 1];
        f32x4* xr = (f32x4*)(xo + (size_t)m * DM) + F.lane; const u32x2* y0 = (const u32x2*)(YB + (size_t)s0 * DM) + F.lane; const u32x2* y1 = (const u32x2*)(YB + (size_t)s1 * DM) + F.lane;
        u32x2* xb = (u32x2*)(XB2 + (size_t)m * DM) + F.lane;
#pragma unroll
        for (int j = 0; j < 4; ++j) { const f32x4 v = xr[64 * j] + (unpack4(y0[64 * j]) * w0 + unpack4(y1[64 * j]) * w1); xr[64 * j] = v; xb[64 * j] = pack4(v); }
    }
}
__device__ UNIT_INLINE void final_norm(Frame& F, KArgs KA, float* xo) {
    const int gw = F.bid * 8 + F.wave, NGW = F.G * 8; const float* gf = IN_F(41);
    for (int m = gw; m < T; m += NGW) {
        f32x4* xr = (f32x4*)(xo + (size_t)m * DM) + F.lane; f32x4 v[4]; float s = 0.f;
#pragma unroll
        for (int j = 0; j < 4; ++j) { v[j] = xr[64 * j]; s += (v[j][0] * v[j][0] + v[j][1] * v[j][1]) + (v[j][2] * v[j][2] + v[j][3] * v[j][3]); }
        const float rstd = rsqrtf(wave_sum(s) * (1.0f / DM) + NORM_EPS);
#pragma unroll
        for (int j = 0; j < 4; ++j) xr[64 * j] = v[j] * rstd * *((const f32x4*)gf + F.lane + 64 * j);
    }
}


#define XB_TMO      128
#define XB_XCNT(j)  (256  + 64 * (j))
#define XB_XSUB(j)  (1280 + 64 * (j))
#define XB_XGEN(j)  (2304 + 64 * (j))
#define XB_TOP      3328
#define XB_TOPGEN   3392
#define XCD_BAR_WORDS 3456
#define XB_SPIN_CAP (1u << 22)
__device__ __forceinline__ unsigned xb_ld(unsigned* p)              { return __hip_atomic_load(p, __ATOMIC_RELAXED, __HIP_MEMORY_SCOPE_AGENT); }
__device__ __forceinline__ unsigned xb_add(unsigned* p, unsigned v) { return __hip_atomic_fetch_add(p, v, __ATOMIC_RELAXED, __HIP_MEMORY_SCOPE_AGENT); }
__device__ __forceinline__ unsigned xb_xcc_id() { return (unsigned)__builtin_amdgcn_s_getreg((3 << 11) | 20) & 0xFu; }
#define XB_SPIN(cond, bar) do { unsigned _sp = 0; while (cond) { __builtin_amdgcn_s_sleep(1); \
    if ((++_sp & 255u) == 0u) { if (xb_ld(&(bar)[XB_TMO])) break; if (_sp > XB_SPIN_CAP) { atomicAdd(&(bar)[XB_TMO], 1u); break; } } } } while (0)
struct XcdBarrier { unsigned* bar; unsigned x; volatile LAS unsigned* st; };
__device__ __forceinline__ XcdBarrier xcd_barrier_post(unsigned* bar, volatile LAS unsigned* st) {
    XcdBarrier b; b.bar = bar; b.x = xb_xcc_id(); b.st = st;
    if (threadIdx.x == 0) (void)xb_add(&bar[XB_XCNT(b.x)], 1u);
    return b;
}
__device__ __forceinline__ void xcd_barrier_complete(unsigned* bar, unsigned x, unsigned& nloc, unsigned& nx) {
    const unsigned G = gridDim.x * gridDim.y * gridDim.z;
    unsigned sum, cnt, mine, sp = 0u;
    for (;;) {
        sum = 0u; cnt = 0u; mine = 0u;
#pragma unroll
        for (unsigned j = 0; j < 16; ++j) { const unsigned c = xb_ld(&bar[XB_XCNT(j)]); sum += c; cnt += (c > 0u) ? 1u : 0u; mine = (j == x) ? c : mine; }
        if (sum == G) break;
        __builtin_amdgcn_s_sleep(1);
        if ((++sp & 255u) == 0u) { if (xb_ld(&bar[XB_TMO])) break; if (sp > XB_SPIN_CAP) { atomicAdd(&bar[XB_TMO], 1u); break; } }
    }
    nloc = mine > 0u ? mine : 1u; nx = cnt > 0u ? cnt : 1u;
}
__device__ __forceinline__ void xcd_barrier(const XcdBarrier& b, bool leader) {
    asm volatile("s_waitcnt vmcnt(0)" ::: "memory");
    __syncthreads();
    if (leader) {
        unsigned* bar = b.bar;
        __builtin_amdgcn_s_waitcnt(0);
        unsigned nloc = b.st[0], nx = b.st[1];
        if (nloc == 0u) { xcd_barrier_complete(bar, b.x, nloc, nx); b.st[0] = nloc; b.st[1] = nx; }
        const unsigned old = xb_add(&bar[XB_XSUB(b.x)], 1u);
        const unsigned gen = old / nloc;
        if (old + 1u == (gen + 1u) * nloc) {
            __builtin_amdgcn_fence(__ATOMIC_RELEASE, "agent");
            asm volatile("s_waitcnt vmcnt(0)" ::: "memory");
            const unsigned og = xb_add(&bar[XB_TOP], 1u);
            const unsigned tg = og / nx;
            if (og + 1u == (tg + 1u) * nx) xb_add(&bar[XB_TOPGEN], 1u);
            else XB_SPIN(xb_ld(&bar[XB_TOPGEN]) == tg, bar);
            __builtin_amdgcn_fence(__ATOMIC_ACQUIRE, "agent");
            xb_add(&bar[XB_XGEN(b.x)], 1u);
            asm volatile("s_waitcnt vmcnt(0)" ::: "memory");
        } else {
            XB_SPIN(xb_ld(&bar[XB_XGEN(b.x)]) == gen, bar);
            __builtin_amdgcn_fence(__ATOMIC_ACQUIRE, "agent");
            asm volatile("s_waitcnt vmcnt(0)" ::: "memory");
        }
    }
    __syncthreads();
}

constexpr int NPH = 23;
__device__ __forceinline__ unsigned char* opq(unsigned char* p) { asm volatile("" : "+s"(p)); return p; }
__global__ void __launch_bounds__(512, 2) mega_fwd(Args args) {
    extern __shared__ __attribute__((aligned(16))) unsigned char lds_raw[];
    Frame F;
    F.lds = (LAS unsigned char*)lds_raw; F.tid = 0; F.lane = 0; F.wave = __builtin_amdgcn_readfirstlane((int)threadIdx.x >> 6);
    F.G = gridDim.x; F.bid = blockIdx.x; F.ws = nullptr; F.ctl = nullptr;
    const int lo = args.ph_lo, hi = args.ph_hi;
    LAS unsigned* s_uid = (LAS unsigned*)(F.lds + LDS_USER + 64);
    if (threadIdx.x < 16) ((LAS unsigned*)(F.lds + LDS_USER))[threadIdx.x] = 0u;
    __syncthreads();
    (void)xcd_barrier_post((unsigned*)(args.ws + WS_CTL) + CW_BAR, (volatile LAS unsigned*)(F.lds + LDS_USER + 32));
#if MK_MULTI
#define GSYNC(k) do {} while (0)
#else
#define GSYNC(k) do { if ((k) + 1 < hi || rep_ + 1 < ((k) == REP_PH ? REP_N : 1)) { if ((k) == 0) cg::this_grid().sync(); else { XcdBarrier xb_; xb_.bar = (unsigned*)(KA->ws + WS_CTL) + CW_BAR; xb_.x = xb_xcc_id(); xb_.st = (volatile LAS unsigned*)(P.lds + LDS_USER + 32); xcd_barrier(xb_, P.tid == 0); } } } while (0)
#endif
#ifdef ONLY_PH
#define RUN(k) ((k) == ONLY_PH)
#else
#define RUN(k) (lo <= (k) && (k) < hi)
#endif
#define REPS(k) for (int rep_ = 0; rep_ < ((k) == REP_PH ? REP_N : 1); ++rep_)
#define PH_PTRS KArgs KA = kargs(); unsigned char* ws = KA->ws; float* out = KA->out; (void)out; \
    Frame P = F; asm volatile("" : "+s"(P.G), "+s"(P.bid), "+s"(P.wave)); asm volatile("v_mbcnt_lo_u32_b32 %0, -1, 0\n\tv_mbcnt_hi_u32_b32 %0, -1, %0" : "=v"(P.lane)); P.tid = P.wave * 64 + P.lane; \
    unsigned char* wa = ws + WS_WA + (size_t)L * WA_STRIDE; (void)wa; float* ssb = (float*)(ws + WS_SSP); \
    float* ss1 = ssb + (size_t)(2 * L) * T * 16; float* ss2 = ssb + (size_t)(2 * L + 1) * T * 16; float* ssn = ssb + (size_t)(2 * L + 2) * T * 16; (void)ss1; (void)ss2; (void)ssn; \
    bf16_t* XB = (bf16_t*)(ws + WS_XB); bf16_t* Y = (bf16_t*)(ws + WS_Y); bf16_t* U1 = (bf16_t*)(ws + WS_U1); (void)XB; (void)Y; (void)U1; \
    bf16_t* GATES = (bf16_t*)(ws + (L == 0 ? WS_WB : WS_GATES)); bf16_t* MERGED = (bf16_t*)(ws + WS_MERGED); bf16_t* PB = (bf16_t*)(ws + WS_PB); (void)GATES; (void)MERGED; (void)PB; \
    float* MISC = (float*)(ws + WS_MISC); float* SSQ = (float*)(ws + WS_SSQ); (void)MISC; (void)SSQ; \
    bf16_t* XB2 = (bf16_t*)(ws + (L == 0 ? WS_XB2_L0 : WS_XB2_L1)); (void)XB2;
    const size_t TILE1K = (size_t)256 * 1024 * 2;
    if (RUN(0)) REPS(0) { const int L = 0; PH_PTRS p0_prologue(KA, P); GSYNC(0); }
#pragma unroll 1
    for (int L = 0; L < 2; ++L) {
        const int pb0 = 1 + (L == 0 ? 0 : 9);
        if (RUN(pb0)) REPS(pb0) { PH_PTRS
            pg8::DenseSched S; S.so.init(64, 22, P.G, P.bid); S.A = (const char*)XB; S.B = (const char*)(wa + WA_IN); S.a_tile = TILE1K; S.b_tile = TILE1K;
            EpiIn E{U1, MISC, ss1};
            pg8::gemm_phase(P.lds, DM, DM, DM, S, E); GSYNC(pb0);
        }
        if (RUN(pb0 + 1)) REPS(pb0 + 1) { PH_PTRS
            rope_pass(P, U1, (const float*)(ws + WS_ROPE), (const float*)(ws + WS_ROPE) + (size_t)T * 32);
            for (int u = P.bid; u < 128; u += P.G) compress_unit(P, u, L, U1, ws);
            GSYNC(pb0 + 1);
        }
        if (RUN(pb0 + 2)) REPS(pb0 + 2) {
            { PH_PTRS
            { const int rep2_ = 0;
            unsigned* q = (unsigned*)(ws + WS_CTL) + CW_QMIX + 256 * L + 1024 * rep_ + 2048 * rep2_;
            for (;;) {
                __syncthreads();
                if (P.tid == 0) *s_uid = atomicAdd(q, 1u);
                __syncthreads();
                const int uid = (int)*s_uid;
                if (uid >= 64) break;
#ifndef SKIP_RWKV
                for (int r3 = 0; r3 < (REP_UNIT == 0 ? REP_N : 1); ++r3) rwkv_unit(P, uid, L, KA, U1, Y);
#endif
            } } }
            { PH_PTRS
            { const int rep2_ = 0;
            unsigned* q = (unsigned*)(ws + WS_CTL) + CW_QMIX + 256 * L + 1024 * rep_ + 2048 * rep2_;
            for (;;) {
                __syncthreads();
                if (P.tid == 0) *s_uid = atomicAdd(q + 192, 1u);
                __syncthreads();
                const int uid = (int)*s_uid;
                if (uid >= 64) break;
#ifndef SKIP_SSD
                for (int r3 = 0; r3 < (REP_UNIT == 1 ? REP_N : 1); ++r3) ssd_unit(P, uid, L, KA, U1, Y, MISC, SSQ);
#endif
            } } }
            { PH_PTRS
            { const int rep2_ = 0;
            unsigned* q = (unsigned*)(ws + WS_CTL) + CW_QMIX + 256 * L + 1024 * rep_ + 2048 * rep2_;
            for (;;) {
                __syncthreads();
                if (P.tid == 0) *s_uid = atomicAdd(q + 64, 1u);
                __syncthreads();
                const int uid = (int)*s_uid;
                if (uid >= 512) break;
#ifndef SKIP_NSA
                for (int r3 = 0; r3 < (REP_UNIT == 2 ? REP_N : 1); ++r3) nsa_unit(P, uid, U1, Y, MISC, ws);
#endif
            } } }
            { PH_PTRS
            { const int rep2_ = 0;
            unsigned* q = (unsigned*)(ws + WS_CTL) + CW_QMIX + 256 * L + 1024 * rep_ + 2048 * rep2_;
            for (;;) {
                __syncthreads();
                if (P.tid == 0) *s_uid = atomicAdd(q + 128, 1u);
                __syncthreads();
                const int uid = (int)*s_uid;
                if (uid >= 512) break;
#ifndef SKIP_SWA
                for (int r3 = 0; r3 < (REP_UNIT == 3 ? REP_N : 1); ++r3) swa_unit(P, uid, U1, Y, IN_F(25) + L * 8);
#endif
            } } }
            if (L == 0) { PH_PTRS
                unsigned* qg = (unsigned*)(ws + WS_CTL) + CW_QMIX + 576 + 1024 * rep_;
                for (;;) {
                    __syncthreads();
                    if (P.tid == 0) *s_uid = atomicAdd(qg, 1u);
                    __syncthreads();
                    const int t = (int)*s_uid;
                    if (t >= 256) break;
                    BatchSched S; S.pm = t >> 2; S.pn0 = (t & 3) * 4; S.n = 4; S.A = (const char*)XB; S.B = (const char*)(wa + WA_GATE); S.a_tile = TILE1K; S.b_tile = TILE1K;
                    EpiGates E{GATES, ss1};
                    pg8::gemm_phase(P.lds, DM, DM, DM, S, E);
                }
            }
            { PH_PTRS
              if (L == 0) deferred_convert(KA, P, (unsigned*)(ws + WS_CTL) + CW_QMIX + 512 + 1024 * rep_, s_uid, 16, 32, 3472);
              else deferred_convert(KA, P, (unsigned*)(ws + WS_CTL) + CW_QMIX + 768 + 1024 * rep_, s_uid, 35, 59, 16896); }
            { PH_PTRS GSYNC(pb0 + 2); }
        }
        if (RUN(pb0 + 3)) REPS(pb0 + 3) { PH_PTRS
            if (L != 0) {
            pg8::DenseSched S; S.so.init(64, 16, P.G, P.bid); S.A = (const char*)XB; S.B = (const char*)(wa + WA_GATE); S.a_tile = TILE1K; S.b_tile = TILE1K;
            EpiGates E{GATES, ss1};
            pg8::gemm_phase(P.lds, DM, DM, DM, S, E);
            }
            ssd_fixup_and_pb(P, L, KA, Y, SSQ, PB);
            GSYNC(pb0 + 3);
        }
        if (RUN(pb0 + 4)) REPS(pb0 + 4) {
            { PH_PTRS pg8::DenseSched S; S.so.init(64, 4, P.G, P.bid); S.a_tile = (size_t)256 * YW * 2; S.b_tile = (size_t)256 * 512 * 2;
              S.A = (const char*)Y; S.B = (const char*)(wa + WA_PT);
              EpiBr<0> E{MERGED, GATES}; pg8::gemm_phase(P.lds, YW, 512, 512, S, E); }
            { PH_PTRS pg8::DenseSched S; S.so.init(64, 4, P.G, P.bid); S.a_tile = (size_t)256 * YW * 2; S.b_tile = (size_t)256 * 512 * 2;
              S.A = (const char*)(Y + 512); S.B = (const char*)(wa + WA_PT + 1 * MiB);
              EpiBr<1> E{MERGED, GATES}; pg8::gemm_phase(P.lds, YW, 512, 512, S, E); }
            { PH_PTRS pg8::DenseSched S; S.so.init(64, 4, P.G, P.bid); S.a_tile = (size_t)256 * YW * 2; S.b_tile = (size_t)256 * 512 * 2;
              S.A = (const char*)(Y + 1024); S.B = (const char*)(wa + WA_PT + 2 * MiB);
              EpiBr<2> E{MERGED, GATES}; pg8::gemm_phase(P.lds, YW, 512, 512, S, E); }
            { PH_PTRS pg8::DenseSched S; S.so.init(64, 4, P.G, P.bid); S.a_tile = (size_t)256 * YW * 2; S.b_tile = (size_t)256 * 512 * 2;
              S.A = (const char*)(Y + 1536); S.B = (const char*)(wa + WA_PT + 3 * MiB);
              EpiBr<3> E{MERGED, GATES}; pg8::gemm_phase(P.lds, YW, 512, 512, S, E); }
            { PH_PTRS GSYNC(pb0 + 4); }
        }
        if (RUN(pb0 + 5)) REPS(pb0 + 5) { PH_PTRS
            pg8::DenseSched S; S.so.init(64, 4, P.G, P.bid); S.A = (const char*)MERGED; S.B = (const char*)(wa + WA_OUT); S.a_tile = TILE1K; S.b_tile = TILE1K;
            if (L == 0) { EpiRes<true, true> E{IN_F(0), out, XB, ss2}; pg8::gemm_phase(P.lds, DM, DM, DM, S, E); }
            else { EpiRes<false, true> E{out, out, XB, ss2}; pg8::gemm_phase(P.lds, DM, DM, DM, S, E); }
            GSYNC(pb0 + 5);
        }
        if (L == 0) {
            if (RUN(7)) REPS(7) { PH_PTRS
                pg8::DenseSched S; S.so.init(64, 22, P.G, P.bid); S.A = (const char*)XB; S.B = (const char*)(ws + WS_FGU); S.a_tile = TILE1K; S.b_tile = TILE1K;
                EpiFfn1<false> E{(bf16_t*)(ws + WS_ACT0), ss2};
                pg8::gemm_phase(P.lds, DM, DM, DM, S, E); GSYNC(7);
            }
            if (RUN(8)) REPS(8) { PH_PTRS
                pg8::DenseSched S; S.so.init(64, 4, P.G, P.bid); S.A = (const char*)(ws + WS_ACT0); S.B = (const char*)(ws + WS_FDN); S.a_tile = (size_t)256 * D_FF * 2; S.b_tile = (size_t)256 * D_FF * 2;
                EpiRes<true, false> E{out, out, XB2, nullptr};
                pg8::gemm_phase(P.lds, D_FF, D_FF, D_FF, S, E); GSYNC(8);
            }
        } else {
#define MOE_PTRS unsigned* cnt = (unsigned*)(ws + WS_CTL) + CW_MOECNT; (void)cnt; int* toke = (int*)(ws + WS_TOKE); int* tokp = (int*)(ws + WS_TOKP); float* tokw = (float*)(ws + WS_TOKW); int* toks = (int*)(ws + WS_TOKS); \
            (void)toke; (void)tokp; (void)tokw; (void)toks; float* srstd = (float*)(ws + WS_SRSTD); (void)srstd; \
            bf16_t* XG = (bf16_t*)(ws + WS_XG); bf16_t* ACT1 = (bf16_t*)(ws + WS_ACT1); bf16_t* YB = (bf16_t*)(ws + WS_YB); (void)XG; (void)ACT1; (void)YB;
            if (RUN(16)) REPS(16) { PH_PTRS MOE_PTRS moe_router(P, KA, out, cnt, toke, tokp, tokw); GSYNC(16); }
            if (RUN(17)) REPS(17) { PH_PTRS MOE_PTRS moe_slots(P, out, ss2, cnt, toke, tokp, toks, XG, srstd); GSYNC(17); }
            if (RUN(18)) REPS(18) { PH_PTRS MOE_PTRS
                MoeSched S; int c[8]; moe_tables(cnt, S.mt, c); S.nN = 22; S.G = P.G; S.c = P.bid; S.A = (const char*)XG; S.B = (const char*)(ws + WS_WB); S.a_tile = TILE1K; S.b_tile = TILE1K; S.b_expert = WB_STRIDE;
                EpiFfn1<true> E{ACT1, srstd};
                pg8::gemm_phase(P.lds, DM, DM, DM, S, E); GSYNC(18);
            }
            if (RUN(19)) REPS(19) { PH_PTRS MOE_PTRS
                MoeSched S; int c[8]; moe_tables(cnt, S.mt, c); S.nN = 4; S.G = P.G; S.c = P.bid; S.A = (const char*)ACT1; S.B = (const char*)(ws + WS_WB + WB_DN); S.a_tile = (size_t)256 * D_FF * 2; S.b_tile = (size_t)256 * D_FF * 2; S.b_expert = WB_STRIDE;
                EpiBf16<false> E{YB};
                pg8::gemm_phase(P.lds, D_FF, D_FF, D_FF, S, E); GSYNC(19);
            }
            if (RUN(20)) REPS(20) { PH_PTRS MOE_PTRS moe_combine(P, out, YB, toks, tokw, XB2); GSYNC(20); }
        }
        const int pple = (L == 0) ? 9 : 21;
        if (RUN(pple)) REPS(pple) {
            { PH_PTRS pg8::DenseSched S; S.so.init(64, 4, P.G, P.bid); S.A = (const char*)XB2; S.B = (const char*)(wa + WA_PG); S.a_tile = TILE1K; S.b_tile = TILE1K;
              EpiBf16<true> E{MERGED}; pg8::gemm_phase(P.lds, DM, DM, DM, S, E); }
            { PH_PTRS pg8::DenseSched S; S.so.init(64, 4, P.G, P.bid);
              S.A = (const char*)PB; S.B = (const char*)(wa + WA_PP); S.a_tile = (size_t)256 * PLE * 2; S.b_tile = (size_t)256 * PLE * 2;
              if (L == 0) { EpiPle2<true> E{out, MERGED, XB, ssn}; pg8::gemm_phase(P.lds, PLE, PLE, PLE, S, E); }
              else { EpiPle2<false> E{out, MERGED, XB, ssn}; pg8::gemm_phase(P.lds, PLE, PLE, PLE, S, E); } }
            { PH_PTRS GSYNC(pple); }
        }
    }
    if (RUN(22)) REPS(22) { const int L = 0; PH_PTRS final_norm(P, KA, out); }
}

extern "C" void kernel_launch(void* const* d_in, const int* in_sizes, int n_in, void* d_out, int out_size, void* d_ws, size_t ws_size, hipStream_t stream) {
    static int grid = 0;
    if (grid == 0) {
        if (n_in != 42 || out_size != T * DM || ws_size < WS_END) { fprintf(stderr, "kernel_launch: unexpected problem (n_in %d out %d ws %zu)\n", n_in, out_size, ws_size); grid = -1; return; }
        int dev = 0, cus = 0, per_cu = 0;
        hipGetDevice(&dev); hipDeviceGetAttribute(&cus, hipDeviceAttributeMultiprocessorCount, dev);
        hipFuncSetAttribute((const void*)mega_fwd, hipFuncAttributeMaxDynamicSharedMemorySize, LDS_BYTES);
        hipOccupancyMaxActiveBlocksPerMultiprocessor(&per_cu, (const void*)mega_fwd, 512, LDS_BYTES);
        if (per_cu < 1) { fprintf(stderr, "kernel_launch: occupancy query says %d blocks per CU\n", per_cu); per_cu = 1; }
        (void)hipGetLastError();
        grid = cus;
    }
    if (grid < 0) return;
    hipMemsetAsync((char*)d_ws + WS_CTL, 0, CTL_BYTES, stream);
    Args a{};
    for (int i = 0; i < 42; ++i) a.in[i] = d_in[i];
    a.out = (float*)d_out; a.ws = (unsigned char*)d_ws;
#if MK_MULTI
    for (int k = 0; k < NPH; ++k) { a.ph_lo = k; a.ph_hi = k + 1; hipLaunchKernelGGL(mega_fwd, dim3(grid), dim3(512), LDS_BYTES, stream, a); }
#else
    a.ph_lo = 0; a.ph_hi = NPH;
    void* kargs[] = {&a};
    hipError_t e = hipLaunchCooperativeKernel((const void*)mega_fwd, dim3(grid), dim3(512), kargs, LDS_BYTES, stream);
    if (e != hipSuccess) fprintf(stderr, "kernel_launch: cooperative launch failed: %s\n", hipGetErrorString(e));
#endif
}
```

```cpp
#include <hip/hip_runtime.h>
#include <hip/hip_cooperative_groups.h>
#include <cstdio>
#include <cstdint>
namespace cg = cooperative_groups;

#define LAS __attribute__((address_space(3)))
#define GAS __attribute__((address_space(1)))
typedef unsigned short bf16_t;
typedef short bf16x8 __attribute__((ext_vector_type(8)));
typedef short s16x4 __attribute__((ext_vector_type(4)));
typedef float f32x2 __attribute__((ext_vector_type(2)));
typedef float f32x4 __attribute__((ext_vector_type(4)));
typedef float f32x16 __attribute__((ext_vector_type(16)));
typedef unsigned u32x2 __attribute__((ext_vector_type(2)));
typedef unsigned u32x4 __attribute__((ext_vector_type(4)));

#ifdef DIAG_NOINLINE
#define UNIT_INLINE __attribute__((noinline))
#else
#define UNIT_INLINE __forceinline__
#endif
#ifndef REP_PH
#define REP_PH -1
#endif
#ifndef REP_N
#define REP_N 1
#endif
#ifndef REP_UNIT
#define REP_UNIT -1
#endif
#ifndef MK_MULTI
#define MK_MULTI 0
#endif

constexpr int NB = 8, SEQ = 2048, T = NB * SEQ, DM = 1024, HD = 64;
constexpr int D_IN = 9504, D_FF = 2816, NEXP = 8, PLE = 256;
constexpr int UW = 5376;
constexpr int YW = 2048;
constexpr float NORM_EPS = 1e-6f;
constexpr float LOG2E = 1.4426950408889634f;
constexpr int UC_Z = 0, UC_XBC = 512, UC_XS = 512, UC_BM = 1024, UC_CM = 1280, UC_NQ = 1536, UC_NKV = 2048, UC_RW = 2816, UC_SQ = 4608, UC_SKV = 5120;
constexpr int MOE_MAXROWS = 34816;

constexpr size_t MiB = (size_t)1 << 20;
constexpr size_t WS_CTL = 0, CTL_BYTES = 1 * MiB;
constexpr size_t WS_ROPE = 1 * MiB;
constexpr size_t WS_MISC = 5 * MiB;
constexpr size_t WS_KC = 7 * MiB, WS_VC = 7 * MiB + 256 * 1024;
constexpr size_t WS_SSQ = 7 * MiB + 512 * 1024;
constexpr size_t WS_TOKE = 8 * MiB, WS_TOKP = WS_TOKE + 128 * 1024, WS_TOKW = WS_TOKP + 128 * 1024, WS_TOKS = WS_TOKW + 128 * 1024;
constexpr size_t WS_SRSTD = 8 * MiB + 512 * 1024;
constexpr size_t WS_W1T = 9 * MiB;
constexpr size_t WS_W2T = 10 * MiB;
constexpr size_t WS_PEB = 10 * MiB + 64 * 1024;
constexpr size_t WS_LW = 10 * MiB + 128 * 1024;
constexpr size_t WS_WA = 12 * MiB, WA_STRIDE = 28 * MiB;
constexpr size_t WA_IN = 0, WA_GATE = 11 * MiB, WA_PT = 19 * MiB, WA_OUT = 23 * MiB, WA_PG = 25 * MiB, WA_PP = 27 * MiB;
constexpr size_t WS_FGU = 68 * MiB, WS_FDN = 79 * MiB;
constexpr size_t WS_WB = 85 * MiB, WB_STRIDE = 16 * MiB + 512 * 1024, WB_DN = 11 * MiB;
constexpr size_t WS_XB = 217 * MiB;
constexpr size_t WS_Y = 249 * MiB;
constexpr size_t WS_BIG = 313 * MiB;
constexpr size_t WS_U1 = WS_BIG, WS_GATES = WS_BIG, WS_MERGED = WS_BIG + 128 * MiB, WS_PB = WS_BIG + 160 * MiB, WS_ACT0 = WS_BIG;
constexpr size_t WS_XG = WS_XB, WS_ACT1 = 285 * MiB, WS_YB = WS_XB;
constexpr size_t WS_XB2_L0 = WS_Y, WS_XB2_L1 = 300 * MiB;
constexpr size_t WS_SSP = 482 * MiB;
constexpr size_t WS_END = 488 * MiB;
constexpr int CW_BAR = 4096, CW_QMIX = 16384, CW_MOECNT = 9216;
constexpr int CW_DEP = 32768;

constexpr int RING_BYTES = 131072;
constexpr int LDS_BYTES = 147456;
constexpr int LDS_USER = LDS_BYTES - 1024;
constexpr int MISC_OFF = LDS_USER;

__device__ __forceinline__ float bf2f(unsigned b) { return __uint_as_float(b << 16); }
__device__ __forceinline__ unsigned f2bf(float f) { unsigned u = __float_as_uint(f); return (u + 0x7fffu + ((u >> 16) & 1u)) >> 16; }
__device__ __forceinline__ unsigned cvt_pk(float lo, float hi) { unsigned r; asm volatile("v_cvt_pk_bf16_f32 %0, %1, %2" : "=v"(r) : "v"(lo), "v"(hi)); return r; }
__device__ __forceinline__ float sigmoidf_(float x) { return 1.0f / (1.0f + __expf(-x)); }
__device__ __forceinline__ float siluf_(float x) { return x / (1.0f + __expf(-x)); }
__device__ __forceinline__ float softplusf_(float x) { return x > 20.f ? x : __logf(1.0f + __expf(x)); }
__device__ __forceinline__ float wave_sum(float v) {
#pragma unroll
    for (int o = 1; o < 64; o <<= 1) v += __shfl_xor(v, o);
    return v;
}
__device__ __forceinline__ float wave_max(float v) {
#pragma unroll
    for (int o = 1; o < 64; o <<= 1) v = fmaxf(v, __shfl_xor(v, o));
    return v;
}
#define RLX_AGENT __ATOMIC_RELAXED, __HIP_MEMORY_SCOPE_AGENT
__device__ __forceinline__ u32x2 ld_agent_u64(const void* p) {
    unsigned long long v = __hip_atomic_load((const unsigned long long*)p, RLX_AGENT);
    u32x2 r; r.x = (unsigned)v; r.y = (unsigned)(v >> 32); return r;
}

__device__ __forceinline__ float ss_total(const float* ssp, int row) {
    const f32x4* p = (const f32x4*)(ssp + (size_t)row * 16); const f32x4 a = p[0], b = p[1], c = p[2], d = p[3];
    return (((a[0] + a[1]) + (a[2] + a[3])) + ((b[0] + b[1]) + (b[2] + b[3]))) + (((c[0] + c[1]) + (c[2] + c[3])) + ((d[0] + d[1]) + (d[2] + d[3])));
}
__device__ __forceinline__ float rstd_of(const float* ssp, int row) { return rsqrtf(ss_total(ssp, row) * (1.0f / DM) + NORM_EPS); }

namespace pg8 {
constexpr int BM = 256, BK = 64, HALF = 128, HTB = HALF * BK * 2, STAGE_BYTES = 8 * HTB, NXCD = 8, WGM = 8;
__host__ __device__ __forceinline__ int lds_byte(int r, int c) { const int st = (r >> 4) * 2 + (c >> 5), rr = r & 15, cc = c & 31, ob = rr * 64 + cc * 2; return st * 1024 + (ob ^ (((ob >> 9) & 1) << 5)); }
__host__ __device__ __forceinline__ void stage_rc(int b, int& R, int& C) { const int st = b / 1024, sb = b % 1024, swz = sb ^ (((sb >> 9) & 1) << 5); R = (st >> 1) * 16 + swz / 64; C = (st & 1) * 32 + (swz % 64) / 2; }

struct Unit { int pm, pn; const char* pa; const char* pb; };

struct StaticOrder {
    int nM, nN, nwg, G, c;
    __device__ void init(int nM_, int nN_, int G_, int c_) { nM = nM_; nN = nN_; nwg = nM * nN; G = G_; c = c_; }
    __device__ bool next(int i, int& pm, int& pn) const {
        const long L = (long)i * G + c; if (L >= nwg) return false;
        int wgid = (int)L; { const int q = nwg / NXCD, r = nwg % NXCD, xcd = wgid % NXCD, off = wgid / NXCD; wgid = (xcd < r ? xcd * (q + 1) : r * (q + 1) + (xcd - r) * q) + off; }
        const int nig = WGM * nN, gid = wgid / nig, fm = gid * WGM, gsz = (nM - fm) < WGM ? (nM - fm) : WGM;
        pm = fm + ((wgid % nig) % gsz); pn = (wgid % nig) / gsz; return true;
    }
};
struct DenseSched {
    StaticOrder so; const char* A; const char* B; size_t a_tile, b_tile;
    __device__ bool next(int i, Unit& u) const { if (!so.next(i, u.pm, u.pn)) return false; u.pa = A + (size_t)u.pm * a_tile; u.pb = B + (size_t)u.pn * b_tile; return true; }
};

template <class Epi, class Sched>
__device__ __forceinline__ void gemm_phase(LAS unsigned char* lds, const int lda, const int ldb, const int K, const Sched& S, const Epi& E) {
    int tid_ = threadIdx.x; asm volatile("" : "+v"(tid_));
    const int tid = tid_, wid = __builtin_amdgcn_readfirstlane(tid >> 6), lane = tid & 63, wr = wid >> 2, wc = wid & 3, fr = lane & 15, fq = lane >> 4;
    int K_ = K; asm volatile("" : "+s"(K_));
    const int nt = K_ / BK;
    unsigned voffA[2], voffB[2];
#pragma unroll
    for (int i = 0; i < 2; ++i) { int R, C; stage_rc(tid * 16 + i * 8192, R, C); voffA[i] = (unsigned)(R * lda + C) * 2u; voffB[i] = (unsigned)(R * ldb + C) * 2u; }
    const size_t kstep = (size_t)(BK * 2);
    const size_t hstepA = (size_t)HALF * lda * 2, hstepB = (size_t)HALF * ldb * 2;
    const unsigned ldsw = (unsigned)wid * 1024u;
    const int aoff = lds_byte(wr * 64 + fr, fq * 8), boff = lds_byte(wc * 32 + fr, fq * 8);
#define PG8_SA(b, h) (((b) * 2 + (h)) * HTB)
#define PG8_SB(b, h) ((4 + (b) * 2 + (h)) * HTB)
#define PG8_STAGE(bufoff, gbase, voff) do { _Pragma("unroll") for (int _i = 0; _i < 2; ++_i) \
        __builtin_amdgcn_global_load_lds((const unsigned*)((const char*)(gbase) + (voff)[_i]), (LAS unsigned*)(lds + (bufoff) + ldsw + _i * 8192), 16, 0, 0); } while (0)
#define PG8_LDA(dst, b, h) do { _Pragma("unroll") for (int m = 0; m < 4; ++m) _Pragma("unroll") for (int k = 0; k < 2; ++k) dst[m][k] = *(const LAS bf16x8*)(lds + PG8_SA(b, h) + aoff + m * 2048 + k * 1024); } while (0)
#define PG8_LDB(dst, b, h) do { _Pragma("unroll") for (int n = 0; n < 2; ++n) _Pragma("unroll") for (int k = 0; k < 2; ++k) dst[n][k] = *(const LAS bf16x8*)(lds + PG8_SB(b, h) + boff + n * 2048 + k * 1024); } while (0)
#define PG8_MMA(ai, bj, At, Bt) do { __builtin_amdgcn_s_setprio(1); _Pragma("unroll") for (int m = 0; m < 4; ++m) _Pragma("unroll") for (int n = 0; n < 2; ++n) _Pragma("unroll") for (int k = 0; k < 2; ++k) \
        acc[ai][bj][m][n] = __builtin_amdgcn_mfma_f32_16x16x32_bf16(Bt[n][k], At[m][k], acc[ai][bj][m][n], 0, 0, 0); __builtin_amdgcn_s_setprio(0); } while (0)
#define PG8_WAIT_V(n) asm volatile("s_waitcnt vmcnt(" #n ")" ::: "memory")
#define PG8_WAIT_L(n) asm volatile("s_waitcnt lgkmcnt(" #n ")" ::: "memory")
#define PG8_BAR __builtin_amdgcn_s_barrier()
#define PG8_SCHED __builtin_amdgcn_sched_barrier(0)
    Unit cur, nxt; int ui = 0;
    if (!S.next(0, cur)) return;
    f32x4 acc[2][2][4][2];
#pragma unroll
    for (int a = 0; a < 2; ++a)
#pragma unroll
        for (int b = 0; b < 2; ++b)
#pragma unroll
            for (int m = 0; m < 4; ++m)
#pragma unroll
                for (int n = 0; n < 2; ++n) acc[a][b][m][n] = (f32x4){0.f, 0.f, 0.f, 0.f};
    bf16x8 At[4][2], B0[2][2], B1[2][2];
    const char* cA = cur.pa; const char* cB = cur.pb;
    PG8_STAGE(PG8_SB(0, 0), cB, voffB); PG8_STAGE(PG8_SB(0, 1), cB + hstepB, voffB); PG8_STAGE(PG8_SA(0, 0), cA, voffA); PG8_STAGE(PG8_SA(0, 1), cA + hstepA, voffA);
    if (wr == 1) PG8_BAR;
    PG8_WAIT_V(2); PG8_BAR;
    PG8_STAGE(PG8_SB(1, 0), cB + kstep, voffB); PG8_STAGE(PG8_SA(1, 0), cA + kstep, voffA); PG8_STAGE(PG8_SB(1, 1), cB + hstepB + kstep, voffB);
    PG8_WAIT_V(6); PG8_BAR;
    for (;;) {
        const bool has_next = S.next(ui + 1, nxt);
        const char* nA = has_next ? nxt.pa : cA; const char* nB = has_next ? nxt.pb : cB;
        for (int t = 0; t < nt; t += 2) {
            const bool last = (t == nt - 2);
            const char* a1 = cA + (size_t)(t + 1) * kstep;
            const char* a2 = last ? nA : cA + (size_t)(t + 2) * kstep; const char* b2 = last ? nB : cB + (size_t)(t + 2) * kstep;
            const char* a3 = a2 + kstep; const char* b3 = b2 + kstep;
            PG8_LDB(B0, 0, 0); PG8_LDB(B1, 0, 1); PG8_SCHED; PG8_LDA(At, 0, 0); PG8_STAGE(PG8_SA(1, 1), a1 + hstepA, voffA);
            PG8_WAIT_V(8); PG8_WAIT_L(0); PG8_BAR; PG8_MMA(0, 0, At, B0); PG8_MMA(0, 1, At, B1); PG8_BAR; PG8_SCHED;
            PG8_LDA(At, 0, 1); PG8_STAGE(PG8_SB(0, 0), b2, voffB); PG8_STAGE(PG8_SB(0, 1), b2 + hstepB, voffB); PG8_STAGE(PG8_SA(0, 0), a2, voffA);
            PG8_WAIT_V(8); PG8_WAIT_L(0); PG8_BAR; PG8_MMA(1, 0, At, B0); PG8_MMA(1, 1, At, B1); PG8_BAR; PG8_SCHED;
            PG8_LDB(B0, 1, 0); PG8_LDB(B1, 1, 1); PG8_SCHED; PG8_LDA(At, 1, 0); PG8_STAGE(PG8_SA(0, 1), a2 + hstepA, voffA);
            PG8_WAIT_V(8); PG8_WAIT_L(0); PG8_BAR; PG8_MMA(0, 0, At, B0); PG8_MMA(0, 1, At, B1); PG8_BAR; PG8_SCHED;
            PG8_LDA(At, 1, 1); PG8_STAGE(PG8_SB(1, 0), b3, voffB); PG8_STAGE(PG8_SB(1, 1), b3 + hstepB, voffB); PG8_STAGE(PG8_SA(1, 0), a3, voffA);
            PG8_WAIT_V(8); PG8_WAIT_L(0); PG8_BAR; PG8_MMA(1, 0, At, B0); PG8_MMA(1, 1, At, B1); PG8_BAR; PG8_SCHED;
        }
        if (wr == 0) PG8_BAR;
        E(acc, cur, wr, wc, fr, fq);
        if (!has_next) break;
#pragma unroll
        for (int a = 0; a < 2; ++a)
#pragma unroll
            for (int b = 0; b < 2; ++b)
#pragma unroll
                for (int m = 0; m < 4; ++m)
#pragma unroll
                    for (int n = 0; n < 2; ++n) acc[a][b][m][n] = (f32x4){0.f, 0.f, 0.f, 0.f};
        cur = nxt; cA = nA; cB = nB; ++ui;
        if (wr == 1) PG8_BAR;
    }
    PG8_WAIT_V(0);
    PG8_BAR;
#undef PG8_SA
#undef PG8_SB
#undef PG8_STAGE
#undef PG8_LDA
#undef PG8_LDB
#undef PG8_MMA
#undef PG8_WAIT_V
#undef PG8_WAIT_L
#undef PG8_BAR
#undef PG8_SCHED
}
}

#define EPI_ROW(u, ai, m) ((u).pm * 256 + (ai) * 128 + wr * 64 + (m) * 16 + fr)
#define EPI_COL(u, bj, n) ((u).pn * 256 + (bj) * 128 + wc * 32 + (n) * 16 + fq * 4)
typedef f32x4 Acc[2][2][4][2];

__device__ __forceinline__ u32x2 pack4(f32x4 v) { u32x2 w; w.x = cvt_pk(v[0], v[1]); w.y = cvt_pk(v[2], v[3]); return w; }
__device__ __forceinline__ f32x4 unpack4(u32x2 w) { f32x4 v; v[0] = bf2f(w.x & 0xffffu); v[1] = bf2f(w.x >> 16); v[2] = bf2f(w.y & 0xffffu); v[3] = bf2f(w.y >> 16); return v; }

template <bool WT> struct EpiInT {
    bf16_t* U; float* misc; const float* ss;
    __device__ __forceinline__ void st8(void* p, u32x2 v) const {
        if (WT) __hip_atomic_store((unsigned long long*)p, ((unsigned long long)v.y << 32) | v.x, RLX_AGENT); else *(u32x2*)p = v;
    }
    __device__ __forceinline__ void operator()(const Acc& acc, const pg8::Unit& u, int wr, int wc, int fr, int fq) const {
#pragma unroll
        for (int ai = 0; ai < 2; ++ai)
#pragma unroll
            for (int m = 0; m < 4; ++m) {
                const int row = EPI_ROW(u, ai, m); const float rs = rstd_of(ss, row);
                if (u.pn < 21) {
#pragma unroll
                    for (int bj = 0; bj < 2; ++bj)
#pragma unroll
                        for (int n = 0; n < 2; ++n) st8(U + (size_t)row * UW + EPI_COL(u, bj, n), pack4(acc[ai][bj][m][n] * rs));
                } else if (wc == 0) {
#pragma unroll
                    for (int n = 0; n < 2; ++n) { const f32x4 v = acc[ai][0][m][n] * rs; float* mp = misc + (size_t)row * 32 + n * 16 + fq * 4;
                        st8(mp, (u32x2){__float_as_uint(v[0]), __float_as_uint(v[1])}); st8(mp + 2, (u32x2){__float_as_uint(v[2]), __float_as_uint(v[3])}); }
                }
            }
    }
};
typedef EpiInT<false> EpiIn;
struct EpiGates {
    bf16_t* G; const float* ss;
    __device__ __forceinline__ void operator()(const Acc& acc, const pg8::Unit& u, int wr, int wc, int fr, int fq) const {
#pragma unroll
        for (int ai = 0; ai < 2; ++ai)
#pragma unroll
            for (int m = 0; m < 4; ++m) {
                const int row = EPI_ROW(u, ai, m); const float rs = rstd_of(ss, row);
#pragma unroll
                for (int bj = 0; bj < 2; ++bj)
#pragma unroll
                    for (int n = 0; n < 2; ++n) { f32x4 v = acc[ai][bj][m][n] * rs; v[0] = sigmoidf_(v[0]); v[1] = sigmoidf_(v[1]); v[2] = sigmoidf_(v[2]); v[3] = sigmoidf_(v[3]);
                        *(u32x2*)(G + (size_t)row * 4096 + EPI_COL(u, bj, n)) = pack4(v); }
            }
    }
};
template <int MB> struct EpiBr {
    bf16_t* MG; const bf16_t* G;
    __device__ __forceinline__ void operator()(const Acc& acc, const pg8::Unit& u, int wr, int wc, int fr, int fq) const {
#pragma unroll
        for (int ai = 0; ai < 2; ++ai)
#pragma unroll
            for (int m = 0; m < 4; ++m) {
                const int row = EPI_ROW(u, ai, m);
#pragma unroll
                for (int bj = 0; bj < 2; ++bj)
#pragma unroll
                    for (int n = 0; n < 2; ++n) { const int col = EPI_COL(u, bj, n);
                        const f32x4 g = unpack4(*(const u32x2*)(G + (size_t)row * 4096 + MB * 1024 + col));
                        f32x4 v = acc[ai][bj][m][n] * g;
                        bf16_t* mp = MG + (size_t)row * DM + col;
                        if (MB > 0) v += unpack4(ld_agent_u64(mp));
                        *(u32x2*)mp = pack4(v); }
                asm volatile("" ::: "memory");
            }
    }
};
template <bool WRITE_XB, bool ACC_SS> struct EpiRes {
    const float* xin; float* xo; bf16_t* xb; float* ss;
    __device__ __forceinline__ void operator()(const Acc& acc, const pg8::Unit& u, int wr, int wc, int fr, int fq) const {
#pragma unroll
        for (int ai = 0; ai < 2; ++ai)
#pragma unroll
            for (int m = 0; m < 4; ++m) {
                const int row = EPI_ROW(u, ai, m); float s = 0.f;
#pragma unroll
                for (int bj = 0; bj < 2; ++bj)
#pragma unroll
                    for (int n = 0; n < 2; ++n) { const size_t off = (size_t)row * DM + EPI_COL(u, bj, n);
                        const f32x4 v = *(const f32x4*)(xin + off) + acc[ai][bj][m][n];
                        *(f32x4*)(xo + off) = v;
                        if (WRITE_XB) *(u32x2*)(xb + off) = pack4(v);
                        if (ACC_SS) s += (v[0] * v[0] + v[1] * v[1]) + (v[2] * v[2] + v[3] * v[3]); }
                if (ACC_SS) { s += __shfl_xor(s, 16); s += __shfl_xor(s, 32); if (fq == 0) ss[(size_t)row * 16 + u.pn * 4 + wc] = s; }
                asm volatile("" ::: "memory");
            }
    }
};
template <bool MOE> struct EpiFfn1 {
    bf16_t* ACT; const float* ss;
    __device__ __forceinline__ void operator()(const Acc& acc, const pg8::Unit& u, int wr, int wc, int fr, int fq) const {
#pragma unroll
        for (int ai = 0; ai < 2; ++ai)
#pragma unroll
            for (int m = 0; m < 4; ++m) {
                const int row = EPI_ROW(u, ai, m); const float rs = MOE ? ss[row] : rstd_of(ss, row);
#pragma unroll
                for (int n = 0; n < 2; ++n) { const f32x4 g = acc[ai][0][m][n] * rs, up = acc[ai][1][m][n] * rs; f32x4 v;
                    v[0] = siluf_(g[0]) * up[0]; v[1] = siluf_(g[1]) * up[1]; v[2] = siluf_(g[2]) * up[2]; v[3] = siluf_(g[3]) * up[3];
                    *(u32x2*)(ACT + (size_t)row * D_FF + u.pn * 128 + wc * 32 + n * 16 + fq * 4) = pack4(v); }
            }
    }
};
template <bool SIG> struct EpiBf16 {
    bf16_t* O;
    __device__ __forceinline__ void operator()(const Acc& acc, const pg8::Unit& u, int wr, int wc, int fr, int fq) const {
#pragma unroll
        for (int ai = 0; ai < 2; ++ai)
#pragma unroll
            for (int m = 0; m < 4; ++m) {
                const int row = EPI_ROW(u, ai, m);
#pragma unroll
                for (int bj = 0; bj < 2; ++bj)
#pragma unroll
                    for (int n = 0; n < 2; ++n) { f32x4 v = acc[ai][bj][m][n];
                        if (SIG) { v[0] = sigmoidf_(v[0]); v[1] = sigmoidf_(v[1]); v[2] = sigmoidf_(v[2]); v[3] = sigmoidf_(v[3]); }
                        *(u32x2*)(O + (size_t)row * DM + EPI_COL(u, bj, n)) = pack4(v); }
            }
    }
};
template <bool WRITE_XB> struct EpiPle2 {
    float* xo; const bf16_t* G; bf16_t* xb; float* ss;
    __device__ __forceinline__ void operator()(const Acc& acc, const pg8::Unit& u, int wr, int wc, int fr, int fq) const {
#pragma unroll
        for (int ai = 0; ai < 2; ++ai)
#pragma unroll
            for (int m = 0; m < 4; ++m) {
                const int row = EPI_ROW(u, ai, m); float s = 0.f;
#pragma unroll
                for (int bj = 0; bj < 2; ++bj)
#pragma unroll
                    for (int n = 0; n < 2; ++n) { const size_t off = (size_t)row * DM + EPI_COL(u, bj, n);
                        const f32x4 g = unpack4(ld_agent_u64(G + off));
                        const f32x4 v = *(const f32x4*)(xo + off) + g * acc[ai][bj][m][n];
                        *(f32x4*)(xo + off) = v;
                        if (WRITE_XB) *(u32x2*)(xb + off) = pack4(v);
                        s += (v[0] * v[0] + v[1] * v[1]) + (v[2] * v[2] + v[3] * v[3]); }
                s += __shfl_xor(s, 16); s += __shfl_xor(s, 32); if (fq == 0) ss[(size_t)row * 16 + u.pn * 4 + wc] = s;
                asm volatile("" ::: "memory");
            }
    }
};

struct BatchSched {
    int pm, pn0, n; const char* A; const char* B; size_t a_tile, b_tile;
    __device__ bool next(int i, pg8::Unit& u) const { if (i >= n) return false; u.pm = pm; u.pn = pn0 + i; u.pa = A + (size_t)pm * a_tile; u.pb = B + (size_t)u.pn * b_tile; return true; }
};
struct InBatchSched {
    int pm, kind, i0, n; const char* A; const char* B; size_t a_tile, b_tile;
    __device__ bool next(int ii, pg8::Unit& u) const {
        if (ii >= n) return false;
        const int i = i0 + ii; int pn;
        if (kind == 0) pn = 11 + i;
        else if (kind == 1) pn = i < 6 ? i : 21;
        else pn = i < 5 ? 6 + i : 13 + i;
        u.pm = pm; u.pn = pn; u.pa = A + (size_t)pm * a_tile; u.pb = B + (size_t)pn * b_tile; return true;
    }
};
struct MoeTables { int ps1, ps2, ps3, ps4, ps5, ps6, ps7, ps8; };
__device__ __forceinline__ int moe_expert_of_row(const MoeTables& mt, int row) {
    return (row >= mt.ps1) + (row >= mt.ps2) + (row >= mt.ps3) + (row >= mt.ps4) + (row >= mt.ps5) + (row >= mt.ps6) + (row >= mt.ps7);
}
struct MoeSched {
    MoeTables mt; int nN, G, c; const char* A; const char* B; size_t a_tile, b_tile, b_expert;
    __device__ bool next(int i, pg8::Unit& u) const {
        const long L = (long)i * G + c; const int ntiles = mt.ps8 >> 8;
        if (L >= (long)ntiles * nN) return false;
        u.pm = (int)(L / nN); u.pn = (int)(L % nN);
        const int e = moe_expert_of_row(mt, u.pm * 256);
        u.pa = A + (size_t)u.pm * a_tile; u.pb = B + (size_t)e * b_expert + (size_t)u.pn * b_tile; return true;
    }
};

struct Args { const void* in[42]; float* out; unsigned char* ws; int ph_lo, ph_hi; };
typedef const __attribute__((address_space(4))) Args* KArgs;
__device__ __forceinline__ KArgs kargs() { KArgs p = (KArgs)__builtin_amdgcn_kernarg_segment_ptr(); asm volatile("" : "+s"(p)); return p; }
struct Frame {
    LAS unsigned char* lds; int tid, lane, wave, G, bid;
    unsigned char* ws; unsigned* ctl;
};
#define IN_F(k) ((const float*)KA->in[k])

constexpr int DEFER_ITEMS = 3472 + 16896;
struct TJob { const float* src; int ldw, K, ncols, ldt, mode; bf16_t* dst; const float* gain; };
__device__ __forceinline__ void tr_item(const TJob& J, LAS float* scr, int item, int lane) {
    const int nblk = J.ncols / 64, kb = item / nblk, nb = item % nblk, k0 = 64 * kb, n0 = 64 * nb;
    const int c = lane;
    const bool live = (J.mode != 3) || c < 32;
    const int scol = (J.mode == 3) ? (c < 8 ? 1536 + c : (c < 32 ? 2816 + c : 0)) : n0 + c;
    const float* sp = J.src + (size_t)k0 * J.ldw + scol;
    float v[64];
#pragma unroll
    for (int i = 0; i < 64; ++i) v[i] = sp[(size_t)i * J.ldw];
#pragma unroll
    for (int i = 0; i < 64; ++i) { float x = live ? v[i] : 0.f; if (J.gain) x *= J.gain[k0 + i]; scr[i * 65 + c] = x; }
    asm volatile("s_waitcnt lgkmcnt(0)" ::: "memory");
    int drow0 = n0;
    if (J.mode == 1 || J.mode == 2) drow0 = (n0 / 128) * 256 + (n0 % 128) + (J.mode == 2 ? 128 : 0);
    const int c8 = lane & 7;
#pragma unroll
    for (int j = 0; j < 8; ++j) { const int n = (lane >> 3) + 8 * j; const LAS float* sq = scr + (8 * c8) * 65 + n;
        u32x4 o; o.x = cvt_pk(sq[0 * 65], sq[1 * 65]); o.y = cvt_pk(sq[2 * 65], sq[3 * 65]); o.z = cvt_pk(sq[4 * 65], sq[5 * 65]); o.w = cvt_pk(sq[6 * 65], sq[7 * 65]);
        *(u32x4*)(J.dst + (size_t)(drow0 + n) * J.ldt + k0 + 8 * c8) = o; }
    asm volatile("s_waitcnt lgkmcnt(0)" ::: "memory");
}
constexpr int NJOBS = 32 + 3 + 24 + 8;
__device__ __forceinline__ bool job_deferred(int jid) { return (jid >= 16 && jid < 32) || (jid >= 35 && jid < 59); }
__device__ __forceinline__ bool get_job(KArgs KA, int jid, TJob& J) {
    unsigned char* ws = KA->ws;
    J.gain = nullptr; J.mode = 0;
    if (jid < 32) {
        const int L = jid >> 4, j = jid & 15;
        unsigned char* wa = ws + WS_WA + (size_t)L * WA_STRIDE;
        if (j <= 8) {
            const float* w = IN_F(4) + (size_t)L * DM * D_IN; J.ldw = D_IN; J.K = DM; J.ldt = DM; J.gain = IN_F(3) + L * DM;
            int sc, nc, dr;
            switch (j) { case 0: sc = 0; nc = 512; dr = 0; break; case 1: sc = 512; nc = 1024; dr = 512; break; case 2: sc = 1544; nc = 512; dr = 1536; break;
                case 3: sc = 2056; nc = 768; dr = 2048; break; case 4: sc = 2848; nc = 1792; dr = 2816; break; case 5: sc = 4640; nc = 512; dr = 4608; break;
                case 6: sc = 5152; nc = 256; dr = 5120; break; case 7: sc = 0; nc = 64; dr = 5376; J.mode = 3; break; default: sc = 5408; nc = 4096; dr = 0; break; }
            J.src = w + sc; J.ncols = nc; J.dst = (bf16_t*)(wa + (j == 8 ? WA_GATE : WA_IN)) + (size_t)dr * DM;
            return true;
        }
        if (j <= 12) { const int m = j - 9; J.src = IN_F(26 + m) + (size_t)L * 512 * DM; J.ldw = DM; J.K = 512; J.ncols = DM; J.ldt = 512; J.dst = (bf16_t*)(wa + WA_PT + (size_t)m * MiB); return true; }
        if (j == 13) { J.src = IN_F(30) + (size_t)L * DM * DM; J.ldw = DM; J.K = DM; J.ncols = DM; J.ldt = DM; J.dst = (bf16_t*)(wa + WA_OUT); return true; }
        if (j == 14) { J.src = IN_F(40) + (size_t)L * DM * DM; J.ldw = DM; J.K = DM; J.ncols = DM; J.ldt = DM; J.dst = (bf16_t*)(wa + WA_PG); return true; }
        J.src = IN_F(39) + (size_t)L * PLE * DM; J.ldw = DM; J.K = PLE; J.ncols = DM; J.ldt = PLE; J.dst = (bf16_t*)(wa + WA_PP); return true;
    }
    if (jid < 35) {
        const int j = jid - 32;
        if (j < 2) { J.src = IN_F(32 + j); J.ldw = D_FF; J.K = DM; J.ncols = D_FF; J.ldt = DM; J.gain = IN_F(31); J.mode = 1 + j; J.dst = (bf16_t*)(ws + WS_FGU); return true; }
        J.src = IN_F(34); J.ldw = DM; J.K = D_FF; J.ncols = DM; J.ldt = D_FF; J.dst = (bf16_t*)(ws + WS_FDN); return true;
    }
    if (jid < 59) {
        const int e = (jid - 35) / 3, j = (jid - 35) % 3;
        unsigned char* wb = ws + WS_WB + (size_t)e * WB_STRIDE;
        if (j < 2) { J.src = IN_F(36 + j) + (size_t)e * DM * D_FF; J.ldw = D_FF; J.K = DM; J.ncols = D_FF; J.ldt = DM; J.gain = IN_F(31) + DM; J.mode = 1 + j; J.dst = (bf16_t*)wb; return true; }
        J.src = IN_F(38) + (size_t)e * D_FF * DM; J.ldw = DM; J.K = D_FF; J.ncols = DM; J.ldt = D_FF; J.dst = (bf16_t*)(wb + WB_DN); return true;
    }
    {
        const int j = jid - 59, idx = j & 3;
        if (j < 4) { J.src = IN_F(12) + (size_t)idx * 2048 * 64; J.ldw = 64; J.K = 2048; J.ncols = 64; J.ldt = 2048; J.dst = (bf16_t*)(ws + WS_W1T) + (size_t)idx * 64 * 2048; return true; }
        J.src = IN_F(13) + (size_t)idx * 64 * 64; J.ldw = 64; J.K = 64; J.ncols = 64; J.ldt = 64; J.dst = (bf16_t*)(ws + WS_W2T) + (size_t)idx * 64 * 64; return true;
    }
}
__device__ UNIT_INLINE void p0_prologue(KArgs KA, Frame& F) {
    LAS float* scr = (LAS float*)(F.lds + F.wave * 16640);
    const int gw = F.bid * 8 + F.wave, NGW = F.G * 8;
    unsigned char* ws = KA->ws;
    {
        int jid = 0, loc = gw; TJob J; get_job(KA, 0, J); int nit = (J.K / 64) * (J.ncols / 64);
        for (;;) {
            while (jid < NJOBS && loc >= nit) { loc -= nit; ++jid; if (jid < NJOBS) { get_job(KA, jid, J); nit = job_deferred(jid) ? 0 : (J.K / 64) * (J.ncols / 64); } }
            if (jid >= NJOBS) break;
            tr_item(J, scr, loc, F.lane);
            loc += NGW;
        }
    }
    for (int L = 0; L < 2; ++L) {
        u32x4* z = (u32x4*)((bf16_t*)(ws + WS_WA + (size_t)L * WA_STRIDE + WA_IN) + (size_t)5440 * DM);
        const int n16 = 192 * DM * 2 / 16;
        for (int i = gw * 64 + F.lane; i < n16; i += NGW * 64) z[i] = (u32x4){0u, 0u, 0u, 0u};
    }
    for (int o = gw; o < 256; o += NGW) {
        const int idx = o >> 6, f = o & 63;
        const float* pe = IN_F(11) + (size_t)idx * 2048; const float* w1 = IN_F(12) + (size_t)idx * 2048 * 64 + f; float s = 0.f;
#pragma unroll 8
        for (int k = F.lane; k < 2048; k += 64) s += pe[k] * w1[(size_t)k * 64];
        s = wave_sum(s);
        if (F.lane == 0) ((float*)(ws + WS_PEB))[o] = s;
    }
    for (int i = gw * 64 + F.lane; i < 2 * 8 * 4 * 8 * 64; i += NGW * 64) {
        const int ln = i & 63, fr = (i >> 6) & 7, nt = (i >> 9) & 3, hh = (i >> 11) & 7, LL = i >> 14;
        const int cn = hh * 64 + 16 * nt + (ln & 15), kgl = ln >> 4;
        const float* W = (fr < 2) ? IN_F(16) + (size_t)LL * 64 * 512 : (fr < 4) ? IN_F(18) + (size_t)LL * 64 * 512 : IN_F(19) + (size_t)LL * 128 * 512;
        const int ks = (fr < 2) ? fr : (fr < 4) ? fr - 2 : fr - 4;
        u32x4 o;
#pragma unroll
        for (int j = 0; j < 4; ++j) { const int k = 32 * ks + 8 * kgl + 2 * j; o[j] = cvt_pk(W[(size_t)k * 512 + cn], W[(size_t)(k + 1) * 512 + cn]); }
        ((u32x4*)(ws + WS_LW))[i] = o;
    }
    {
        const float* x = IN_F(0); bf16_t* xb = (bf16_t*)(ws + WS_XB); float* ss = (float*)(ws + WS_SSP);
        for (int m = gw; m < T; m += NGW) {
            const f32x4* xr = (const f32x4*)(x + (size_t)m * DM) + F.lane; float s = 0.f;
            u32x2* o = (u32x2*)(xb + (size_t)m * DM) + F.lane;
#pragma unroll
            for (int j = 0; j < 4; ++j) { const f32x4 v = xr[64 * j]; s += (v[0] * v[0] + v[1] * v[1]) + (v[2] * v[2] + v[3] * v[3]); o[64 * j] = pack4(v); }
            s = wave_sum(s); if (F.lane < 16) ss[(size_t)m * 16 + F.lane] = (F.lane == 0) ? s : 0.f;
        }
    }
    {
        const int* pos = (const int*)KA->in[2]; float* rc = (float*)(ws + WS_ROPE); float* rsn = rc + (size_t)T * 32;
        for (int i = (gw * 64 + F.lane); i < T * 32; i += NGW * 64) {
            const int t = i >> 5, k = i & 31;
            const float inv = (float)exp2(-(double)k * (1.0 / 32.0) * 17.194602975157967);
            const float ang = (float)pos[t] * inv;
            rc[i] = cosf(ang); rsn[i] = sinf(ang);
        }
    }
}


__device__ UNIT_INLINE void deferred_convert(KArgs KA, Frame& F, unsigned* q, LAS unsigned* s_uid, int jlo, int jhi, int nitems) {
    LAS float* scr = (LAS float*)(F.lds + F.wave * 16640);
    for (;;) {
        __syncthreads();
        if (F.tid == 0) *s_uid = atomicAdd(q, 1u);
        __syncthreads();
        int loc = (int)*s_uid * 8 + F.wave;
        int jid = jlo; TJob J; bool found = false;
        for (; jid < jhi; ++jid) { if (!job_deferred(jid)) continue; get_job(KA, jid, J); const int nit = (J.K / 64) * (J.ncols / 64); if (loc < nit) { found = true; break; } loc -= nit; }
        if (found) tr_item(J, scr, loc, F.lane);
        if ((int)*s_uid * 8 >= nitems) break;
    }
}


__device__ __forceinline__ void dep_signal(unsigned* c0, unsigned* c1, bool leader) {
    asm volatile("s_waitcnt vmcnt(0)" ::: "memory");
    __syncthreads();
    if (leader) {
        __builtin_amdgcn_fence(__ATOMIC_RELEASE, "agent");
        asm volatile("s_waitcnt vmcnt(0)" ::: "memory");
        __hip_atomic_fetch_add(c0, 1u, __ATOMIC_RELAXED, __HIP_MEMORY_SCOPE_AGENT);
        if (c1) __hip_atomic_fetch_add(c1, 1u, __ATOMIC_RELAXED, __HIP_MEMORY_SCOPE_AGENT);
    }
}
__device__ __forceinline__ void dep_signal_wt(unsigned* c0, unsigned* c1, bool leader) {
    asm volatile("s_waitcnt vmcnt(0)" ::: "memory");
    __syncthreads();
    if (leader) { __hip_atomic_fetch_add(c0, 1u, __ATOMIC_RELAXED, __HIP_MEMORY_SCOPE_AGENT); if (c1) __hip_atomic_fetch_add(c1, 1u, __ATOMIC_RELAXED, __HIP_MEMORY_SCOPE_AGENT); }
}
__device__ __forceinline__ void dep_poll_lane(unsigned* c, unsigned target) {
    unsigned spins = 0;
    while (__hip_atomic_load(c, __ATOMIC_RELAXED, __HIP_MEMORY_SCOPE_AGENT) < target) { __builtin_amdgcn_s_sleep(2); if (++spins > (1u << 24)) break; }
}
__device__ __forceinline__ void dep_wait_lane(unsigned* c, unsigned target) {
    unsigned spins = 0;
    while (__hip_atomic_load(c, __ATOMIC_RELAXED, __HIP_MEMORY_SCOPE_AGENT) < target) { __builtin_amdgcn_s_sleep(2); if (++spins > (1u << 24)) break; }
    __builtin_amdgcn_fence(__ATOMIC_ACQUIRE, "agent");
    asm volatile("s_waitcnt vmcnt(0)" ::: "memory");
}
__device__ __forceinline__ void dep_wait(unsigned* c, unsigned target, bool leader) {
    if (leader) dep_poll_lane(c, target);
    __syncthreads();
}

__device__ UNIT_INLINE void rope_pass(Frame& F, bf16_t* U1, const float* rc, const float* rsn) {
    const int gt = F.bid * 512 + F.tid, NT = F.G * 512;
    for (int i = gt; i < T * 40; i += NT) {
        const int t = i / 40, r = i % 40, slot = r >> 2, ch = r & 3;
        bf16_t* base = U1 + (size_t)t * UW + (slot < 8 ? UC_SQ + slot * 64 : UC_SKV + (slot - 8) * 64) + ch * 8;
        const u32x4 a = *(const u32x4*)base, b = *(const u32x4*)(base + 32);
        const f32x4 c0 = *(const f32x4*)(rc + (size_t)t * 32 + ch * 8), c1 = *(const f32x4*)(rc + (size_t)t * 32 + ch * 8 + 4);
        const f32x4 s0 = *(const f32x4*)(rsn + (size_t)t * 32 + ch * 8), s1 = *(const f32x4*)(rsn + (size_t)t * 32 + ch * 8 + 4);
        float x1[8], x2[8], cs[8], sn[8];
#pragma unroll
        for (int j = 0; j < 4; ++j) { x1[2 * j] = bf2f(a[j] & 0xffffu); x1[2 * j + 1] = bf2f(a[j] >> 16); x2[2 * j] = bf2f(b[j] & 0xffffu); x2[2 * j + 1] = bf2f(b[j] >> 16);
            cs[j] = c0[j]; cs[4 + j] = c1[j]; sn[j] = s0[j]; sn[4 + j] = s1[j]; }
        u32x4 oa, ob;
#pragma unroll
        for (int j = 0; j < 4; ++j) {
            const float y1a = x1[2 * j] * cs[2 * j] - x2[2 * j] * sn[2 * j], y1b = x1[2 * j + 1] * cs[2 * j + 1] - x2[2 * j + 1] * sn[2 * j + 1];
            const float y2a = x2[2 * j] * cs[2 * j] + x1[2 * j] * sn[2 * j], y2b = x2[2 * j + 1] * cs[2 * j + 1] + x1[2 * j + 1] * sn[2 * j + 1];
            oa[j] = cvt_pk(y1a, y1b); ob[j] = cvt_pk(y2a, y2b);
        }
        *(u32x4*)base = oa; *(u32x4*)(base + 32) = ob;
    }
}
__device__ UNIT_INLINE void rope_slice(Frame& F, bf16_t* U1, const float* rc, const float* rsn, int slice) {
    for (int i = slice * 5120 + F.tid; i < (slice + 1) * 5120; i += 512) {
        const int t = i / 40, r = i % 40, slot = r >> 2, ch = r & 3;
        bf16_t* base = U1 + (size_t)t * UW + (slot < 8 ? UC_SQ + slot * 64 : UC_SKV + (slot - 8) * 64) + ch * 8;
        const u32x4 a = *(const u32x4*)base, b = *(const u32x4*)(base + 32);
        const f32x4 c0 = *(const f32x4*)(rc + (size_t)t * 32 + ch * 8), c1 = *(const f32x4*)(rc + (size_t)t * 32 + ch * 8 + 4);
        const f32x4 s0 = *(const f32x4*)(rsn + (size_t)t * 32 + ch * 8), s1 = *(const f32x4*)(rsn + (size_t)t * 32 + ch * 8 + 4);
        u32x4 oa, ob;
#pragma unroll
        for (int j = 0; j < 4; ++j) {
            const float xa = bf2f(a[j] & 0xffffu), xb = bf2f(a[j] >> 16), ya = bf2f(b[j] & 0xffffu), yb = bf2f(b[j] >> 16);
            const float ca = j < 2 ? c0[2 * j] : c1[2 * j - 4], cb = j < 2 ? c0[2 * j + 1] : c1[2 * j - 3], sa = j < 2 ? s0[2 * j] : s1[2 * j - 4], sb = j < 2 ? s0[2 * j + 1] : s1[2 * j - 3];
            oa[j] = cvt_pk(xa * ca - ya * sa, xb * cb - yb * sb); ob[j] = cvt_pk(ya * ca + xa * sa, yb * cb + xb * sb);
        }
        *(u32x4*)base = oa; *(u32x4*)(base + 32) = ob;
    }
}
__device__ UNIT_INLINE void compress_unit(Frame& F, int unit, int L, const bf16_t* U1, unsigned char* ws) {
    const int nc = unit & 3, kv = (unit >> 2) & 1, g = (unit >> 3) & 1, b = unit >> 4;
    const int n0 = nc * 32, tok0 = n0 * 16;
    LAS bf16_t* tok = (LAS bf16_t*)F.lds;
    LAS bf16_t* hid = (LAS bf16_t*)(F.lds + 528 * 72 * 2);
    const bf16_t* src = U1 + (size_t)(b * SEQ) * UW + UC_NKV + kv * 128 + g * 64;
    __syncthreads();
    for (int i = F.tid; i < 528 * 8; i += 512) { const int r = i >> 3, ch = i & 7; const int t = tok0 + r;
        u32x4 v = (u32x4){0u, 0u, 0u, 0u}; if (t < SEQ) v = *(const u32x4*)(src + (size_t)t * UW + ch * 8);
        *(LAS u32x4*)(tok + r * 72 + ch * 8) = v; }
    __syncthreads();
    const int idx = L * 2 + kv;
    const bf16_t* w1t = (const bf16_t*)(ws + WS_W1T) + (size_t)idx * 64 * 2048;
    const bf16_t* w2t = (const bf16_t*)(ws + WS_W2T) + (size_t)idx * 64 * 64;
    const float* peb = (const float*)(ws + WS_PEB) + idx * 64;
    const int mt = F.wave >> 2, ntile = F.wave & 3, r16 = F.lane & 15, kg = F.lane >> 4;
    f32x4 acc = (f32x4){0.f, 0.f, 0.f, 0.f};
    const int nl = mt * 16 + r16;
    const bf16_t* bp = w1t + (size_t)(ntile * 16 + r16) * 2048 + kg * 8;
#pragma unroll 4
    for (int ks = 0; ks < 64; ++ks) {
        const int l = ks >> 1, db = (ks & 1) * 32 + kg * 8;
        const bf16x8 a = *(const LAS bf16x8*)(tok + (16 * nl + l) * 72 + db);
        const bf16x8 bb = *(const bf16x8*)(bp + ks * 32);
        acc = __builtin_amdgcn_mfma_f32_16x16x32_bf16(a, bb, acc, 0, 0, 0);
    }
    { const int f = ntile * 16 + r16; const float pb = peb[f];
#pragma unroll
      for (int r = 0; r < 4; ++r) hid[(mt * 16 + 4 * kg + r) * 72 + f] = (bf16_t)f2bf(siluf_(acc[r] + pb)); }
    __syncthreads();
    f32x4 o = (f32x4){0.f, 0.f, 0.f, 0.f};
#pragma unroll
    for (int ks = 0; ks < 2; ++ks) {
        const bf16x8 a = *(const LAS bf16x8*)(hid + nl * 72 + ks * 32 + kg * 8);
        const bf16x8 bb = *(const bf16x8*)(w2t + (size_t)(ntile * 16 + r16) * 64 + ks * 32 + kg * 8);
        o = __builtin_amdgcn_mfma_f32_16x16x32_bf16(a, bb, o, 0, 0, 0);
    }
    bf16_t* dst = (bf16_t*)(ws + (kv ? WS_VC : WS_KC)) + (size_t)((b * 2 + g) * 128) * 64;
#pragma unroll
    for (int r = 0; r < 4; ++r) { const int n = n0 + mt * 16 + 4 * kg + r; dst[(size_t)n * 64 + ntile * 16 + r16] = (n < 127) ? (bf16_t)f2bf(o[r]) : (bf16_t)0; }
}

__device__ __forceinline__ int crow(int r, int hi) { return (r & 3) + 8 * (r >> 2) + 4 * hi; }
constexpr int KS_LD = 72;
struct AttnSt { float m, l; f32x16 o0, o1; };
__device__ __forceinline__ void attn_init(AttnSt& s) { s.m = -INFINITY; s.l = 0.f;
#pragma unroll
    for (int r = 0; r < 16; ++r) { s.o0[r] = 0.f; s.o1[r] = 0.f; } }
constexpr int TILE_EL = 64 * 64;
__device__ __forceinline__ void dma_kv(const bf16_t* Kg, int ldk, const bf16_t* Vg, int ldv, LAS bf16_t* Ks, LAS bf16_t* Vs, int wave, int lane) {
    const int key = 8 * wave + (lane >> 3), ch = (lane & 7) ^ (key & 7);
    __builtin_amdgcn_global_load_lds((const unsigned*)(Kg + (size_t)key * ldk + ch * 8), (LAS unsigned*)(Ks + wave * 512), 16, 0, 0);
    __builtin_amdgcn_global_load_lds((const unsigned*)(Vg + (size_t)key * ldv + ch * 8), (LAS unsigned*)(Vs + wave * 512), 16, 0, 0);
}
__device__ __forceinline__ int swz_el(int key, int chunk) { return key * 64 + ((chunk ^ (key & 7)) << 3); }
__device__ __forceinline__ void attn_scores(const LAS bf16_t* Ks, const bf16x8 (&qr)[4], f32x16& p0, f32x16& p1, int r32, int hi) {
#pragma unroll
    for (int r = 0; r < 16; ++r) { p0[r] = 0.f; p1[r] = 0.f; }
#pragma unroll
    for (int d0 = 0; d0 < 4; ++d0) {
        const bf16x8 k0 = *(const LAS bf16x8*)(Ks + swz_el(r32, 2 * d0 + hi));
        const bf16x8 k1 = *(const LAS bf16x8*)(Ks + swz_el(32 + r32, 2 * d0 + hi));
        p0 = __builtin_amdgcn_mfma_f32_32x32x16_bf16(k0, qr[d0], p0, 0, 0, 0);
        p1 = __builtin_amdgcn_mfma_f32_32x32x16_bf16(k1, qr[d0], p1, 0, 0, 0);
    }
}
typedef short v4i16_t __attribute__((ext_vector_type(4)));
__device__ __forceinline__ void attn_pv(const LAS bf16_t* Vs, const f32x16& p0, const f32x16& p1, f32x16& o0, f32x16& o1, int r32, int hi) {
    bf16x8 pa[4];
#pragma unroll
    for (int s = 0; s < 2; ++s) {
        u32x4 w0, w1;
#pragma unroll
        for (int j = 0; j < 4; ++j) { w0[j] = cvt_pk(p0[8 * s + 2 * j], p0[8 * s + 2 * j + 1]); w1[j] = cvt_pk(p1[8 * s + 2 * j], p1[8 * s + 2 * j + 1]); }
        pa[s] = __builtin_bit_cast(bf16x8, w0); pa[2 + s] = __builtin_bit_cast(bf16x8, w1);
    }
    const int lane = hi * 32 + r32;
    const int krow = 4 * hi + ((lane & 15) >> 2), cb = 2 * ((lane >> 4) & 1) + ((lane & 3) >> 1), sub = 4 * (lane & 1);
#pragma unroll
    for (int s = 0; s < 4; ++s) {
#pragma unroll
        for (int dh = 0; dh < 2; ++dh) {
            const int k0 = 16 * s + krow, k1 = k0 + 8;
            const s16x4 lo = __builtin_bit_cast(s16x4, __builtin_amdgcn_ds_read_tr16_b64_v4i16((LAS v4i16_t*)(Vs + swz_el(k0, 4 * dh + cb) + sub)));
            const s16x4 hi4 = __builtin_bit_cast(s16x4, __builtin_amdgcn_ds_read_tr16_b64_v4i16((LAS v4i16_t*)(Vs + swz_el(k1, 4 * dh + cb) + sub)));
            const bf16x8 vfr = (bf16x8){lo[0], lo[1], lo[2], lo[3], hi4[0], hi4[1], hi4[2], hi4[3]};
            if (dh == 0) o0 = __builtin_amdgcn_mfma_f32_32x32x16_bf16(pa[s], vfr, o0, 0, 0, 0);
            else         o1 = __builtin_amdgcn_mfma_f32_32x32x16_bf16(pa[s], vfr, o1, 0, 0, 0);
        }
    }
}
__device__ __forceinline__ void attn_online(const LAS bf16_t* Vt, f32x16& x0, f32x16& x1, AttnSt& st, LAS float* wsf, int r32, int hi) {
    float mx = -INFINITY;
#pragma unroll
    for (int r = 0; r < 16; ++r) mx = fmaxf(mx, fmaxf(x0[r], x1[r]));
    mx = fmaxf(mx, __shfl_xor(mx, 32));
    const float mn = fmaxf(st.m, mx), ms = (mn == -INFINITY) ? 0.f : mn;
    const float f = exp2f((st.m - ms) * LOG2E);
    if (hi == 0) wsf[r32] = f;
    float rs = 0.f;
#pragma unroll
    for (int r = 0; r < 16; ++r) { x0[r] = exp2f((x0[r] - ms) * LOG2E); x1[r] = exp2f((x1[r] - ms) * LOG2E); rs += x0[r] + x1[r]; }
    st.l = st.l * f + rs; st.m = mn;
    const LAS float* wr_ = wsf + 4 * hi;
#pragma unroll
    for (int r = 0; r < 16; ++r) { const float fr_ = wr_[(r & 3) + 8 * (r >> 2)]; st.o0[r] *= fr_; st.o1[r] *= fr_; }
    attn_pv(Vt, x0, x1, st.o0, st.o1, r32, hi);
}
__device__ __forceinline__ void attn_scale_rows(f32x16& o0, f32x16& o1, float inv, LAS float* wsf, int r32, int hi) {
    if (hi == 0) wsf[r32] = inv;
    const LAS float* wr_ = wsf + 4 * hi;
#pragma unroll
    for (int r = 0; r < 16; ++r) { const float f = wr_[(r & 3) + 8 * (r >> 2)]; o0[r] *= f; o1[r] *= f; }
}

__device__ UNIT_INLINE void swa_unit(Frame& F, int unit, const bf16_t* U1, bf16_t* Y, const float* sinks) {
    const int qb = unit & 31, g = (unit >> 5) & 1, b = unit >> 6;
    const int r32 = F.lane & 31, hi = F.lane >> 5, hr = F.wave >> 1, qs = F.wave & 1, head = g * 4 + hr;
    const int q0 = qb * 64, tq = q0 + qs * 32 + r32;
    LAS bf16_t* Ks = (LAS bf16_t*)F.lds; LAS bf16_t* Vt = Ks + TILE_EL; LAS bf16_t* Ks1 = Vt + TILE_EL; LAS bf16_t* Vt1 = Ks1 + TILE_EL;
    LAS float* wsf = (LAS float*)(F.lds + 4 * TILE_EL * 2) + F.wave * 32;
    const bf16_t* rowb = U1 + (size_t)(b * SEQ) * UW;
    bf16x8 qr[4];
#pragma unroll
    for (int d0 = 0; d0 < 4; ++d0) qr[d0] = *(const bf16x8*)(rowb + (size_t)tq * UW + UC_SQ + head * 64 + d0 * 16 + hi * 8);
    AttnSt st; attn_init(st);
    {
        const int kt0 = (qb >= 2 ? qb - 2 : 0);
        const bf16_t* kg = rowb + UC_SKV + g * 64; const bf16_t* vg = kg + 128;
        __syncthreads();
        dma_kv(kg + (size_t)(kt0 * 64) * UW, UW, vg + (size_t)(kt0 * 64) * UW, UW, Ks, Vt, F.wave, F.lane);
        __syncthreads();
        int cur = 0;
#pragma unroll 1
        for (int kt = kt0; kt <= qb; ++kt) {
            if (kt < qb) dma_kv(kg + (size_t)((kt + 1) * 64) * UW, UW, vg + (size_t)((kt + 1) * 64) * UW, UW, cur ? Ks : Ks1, cur ? Vt : Vt1, F.wave, F.lane);
            const LAS bf16_t* kc_ = cur ? Ks1 : Ks; const LAS bf16_t* vc_ = cur ? Vt1 : Vt;
            f32x16 x0, x1; attn_scores(kc_, qr, x0, x1, r32, hi);
#pragma unroll
            for (int r = 0; r < 16; ++r) { const int d0 = tq - (kt * 64 + crow(r, hi)), d1 = d0 - 32;
                x0[r] = (d0 >= 0 && d0 < 128) ? x0[r] * 0.125f : -INFINITY; x1[r] = (d1 >= 0 && d1 < 128) ? x1[r] * 0.125f : -INFINITY; }
            attn_online(vc_, x0, x1, st, wsf, r32, hi);
            __syncthreads();
            cur ^= 1;
        }
    }
    const float l = st.l + __shfl_xor(st.l, 32), sk = sinks[head];
    const float mf = fmaxf(st.m, sk), a = exp2f((st.m - mf) * LOG2E), inv = a / (l * a + exp2f((sk - mf) * LOG2E));
    attn_scale_rows(st.o0, st.o1, inv, wsf, r32, hi);
    bf16_t* yb = Y + (size_t)(b * SEQ + q0 + qs * 32) * YW + 3 * 512 + head * 64 + r32;
#pragma unroll
    for (int r = 0; r < 16; ++r) { bf16_t* yp = yb + (size_t)crow(r, hi) * YW; yp[0] = (bf16_t)f2bf(st.o0[r]); yp[32] = (bf16_t)f2bf(st.o1[r]); }
}

constexpr int NSA_K1_OFF = 2 * TILE_EL * 2;
constexpr int NSA_PS_OFF = 4 * TILE_EL * 2;
constexpr int NSA_IMP_OFF = NSA_PS_OFF + 64 * 128 * 4;
constexpr int NSA_SEL_OFF = NSA_IMP_OFF + 64 * 33 * 4;
__device__ __forceinline__ float nsa_gate(const float* gbase, int r, int i) { return sigmoidf_(gbase[((r & 3) + 8 * (r >> 2)) * 32 + i * 8]); }
__device__ UNIT_INLINE void nsa_unit(Frame& F, int unit, const bf16_t* U1, bf16_t* Y, const float* misc, const unsigned char* ws) {
    const int qb = 31 - (unit & 31), g = (unit >> 5) & 1, b = unit >> 6;
    const int r32 = F.lane & 31, hi = F.lane >> 5, hr = F.wave >> 1, qs = F.wave & 1, head = g * 4 + hr;
    const int q0 = qb * 64, ql = qs * 32 + r32, tq = q0 + ql;
    LAS bf16_t* Ks = (LAS bf16_t*)F.lds; LAS bf16_t* Vt = Ks + TILE_EL;
    LAS bf16_t* Ks1 = (LAS bf16_t*)(F.lds + NSA_K1_OFF); LAS bf16_t* Vt1 = Ks1 + TILE_EL;
    LAS unsigned* psum = (LAS unsigned*)(F.lds + NSA_PS_OFF);
    LAS float* impb = (LAS float*)(F.lds + NSA_IMP_OFF);
    LAS unsigned* selm = (LAS unsigned*)(F.lds + NSA_SEL_OFF);
    LAS float* wsf = (LAS float*)(F.lds + NSA_SEL_OFF + 256) + F.wave * 32;
    const bf16_t* rowb = U1 + (size_t)(b * SEQ) * UW;
    const int grow = b * SEQ + q0 + qs * 32;
    const float* gbase = misc + (size_t)(grow + 4 * hi) * 32 + 8 + head;
    bf16x8 qr[4];
#pragma unroll
    for (int d0 = 0; d0 < 4; ++d0) qr[d0] = *(const bf16x8*)(rowb + (size_t)tq * UW + UC_NQ + head * 64 + d0 * 16 + hi * 8);
    f32x16 ya0, ya1;
#pragma unroll
    for (int r = 0; r < 16; ++r) { ya0[r] = 0.f; ya1[r] = 0.f; }
    __syncthreads();
    for (int i = F.tid; i < 64 * 128; i += 512) psum[i] = 0u;
#ifndef NSA_NO_CMP
    {
        const bf16_t* kc = (const bf16_t*)(ws + WS_KC) + (size_t)((b * 2 + g) * 128) * 64;
        const bf16_t* vc = (const bf16_t*)(ws + WS_VC) + (size_t)((b * 2 + g) * 128) * 64;
        dma_kv(kc, 64, vc, 64, Ks, Vt, F.wave, F.lane);
        dma_kv(kc + 64 * 64, 64, vc + 64 * 64, 64, Ks1, Vt1, F.wave, F.lane);
        __syncthreads();
        float m = -INFINITY, l = 0.f;
#pragma unroll 1
        for (int tl = 0; tl < 2; ++tl) {
            f32x16 x0, x1; attn_scores(tl ? Ks1 : Ks, qr, x0, x1, r32, hi);
            float mx = -INFINITY;
#pragma unroll
            for (int r = 0; r < 16; ++r) { const int n0 = tl * 64 + crow(r, hi), n1 = n0 + 32;
                x0[r] = (16 * n0 + 31 <= tq) ? x0[r] * 0.125f : -INFINITY; x1[r] = (16 * n1 + 31 <= tq) ? x1[r] * 0.125f : -INFINITY; mx = fmaxf(mx, fmaxf(x0[r], x1[r])); }
            mx = fmaxf(mx, __shfl_xor(mx, 32));
            const float mn = fmaxf(m, mx), ms = (mn == -INFINITY) ? 0.f : mn;
            float rs = 0.f;
#pragma unroll
            for (int r = 0; r < 16; ++r) rs += exp2f((x0[r] - ms) * LOG2E) + exp2f((x1[r] - ms) * LOG2E);
            l = l * exp2f((m - ms) * LOG2E) + rs; m = mn;
        }
        l += __shfl_xor(l, 32);
        const float inv = l > 0.f ? 1.0f / l : 0.f, ms = (m == -INFINITY) ? 0.f : m;
        f32x16 oc0, oc1;
#pragma unroll
        for (int r = 0; r < 16; ++r) { oc0[r] = 0.f; oc1[r] = 0.f; }
#pragma unroll 1
        for (int tl = 0; tl < 2; ++tl) {
            f32x16 x0, x1; attn_scores(tl ? Ks1 : Ks, qr, x0, x1, r32, hi);
#pragma unroll
            for (int r = 0; r < 16; ++r) { const int n0 = tl * 64 + crow(r, hi), n1 = n0 + 32;
                x0[r] = (16 * n0 + 31 <= tq) ? exp2f((x0[r] * 0.125f - ms) * LOG2E) * inv : 0.f;
                x1[r] = (16 * n1 + 31 <= tq) ? exp2f((x1[r] * 0.125f - ms) * LOG2E) * inv : 0.f;
                atomicAdd((unsigned*)(psum + ql * 128 + n0), (unsigned)(x0[r] * 16777216.0f + 0.5f)); atomicAdd((unsigned*)(psum + ql * 128 + n1), (unsigned)(x1[r] * 16777216.0f + 0.5f)); }
            attn_pv(tl ? Vt1 : Vt, x0, x1, oc0, oc1, r32, hi);
        }
#pragma unroll
        for (int r = 0; r < 16; ++r) { const float gt = nsa_gate(gbase, r, 0); ya0[r] += gt * oc0[r]; ya1[r] += gt * oc1[r]; }
    }
#endif
    __syncthreads();
#ifndef NSA_NO_TOPK
    if (qb <= 7) { if (F.tid < 64) selm[F.tid] = (2u << qb) - 1u; }
    else {
        const int q = F.tid & 63, jg = F.tid >> 6;
#pragma unroll
        for (int jj = 0; jj < 4; ++jj) { const int j = jg * 4 + jj; unsigned sacc = 0u;
#pragma unroll
            for (int d = -1; d <= 3; ++d) { const int n = 4 * j + d; if (n >= 0 && n < 127) sacc += psum[q * 128 + n]; }
            impb[q * 33 + j] = (float)sacc; }
        if (jg == 0) selm[q] = 1u | (1u << qb);
        __syncthreads();
        unsigned bits = 0u;
#pragma unroll 1
        for (int jj = 0; jj < 4; ++jj) { const int j = jg * 4 + jj;
            if (j >= 1 && j < qb) { const float vj = impb[q * 33 + j]; int rank = 0;
#pragma unroll 1
                for (int i2 = 1; i2 < qb; ++i2) { const float vi = impb[q * 33 + i2]; rank += (vi > vj || (vi == vj && i2 < j)) ? 1 : 0; }
                if (rank < 6) bits |= 1u << j; } }
        if (bits) atomicOr((unsigned*)(selm + q), bits);
    }
#endif
    __syncthreads();
    unsigned uni;
    { unsigned v = selm[F.lane];
#pragma unroll
      for (int o = 1; o < 64; o <<= 1) v |= __shfl_xor(v, o);
      uni = __builtin_amdgcn_readfirstlane(v); }
    const unsigned mysel = selm[ql];
#pragma unroll 1
    for (int br = 0; br < 2; ++br) {
        const unsigned lowm = (qb >= 8) ? ~((1u << (qb - 8)) - 1u) : 0xffffffffu;
        const unsigned tmask = (br == 0) ? uni : (((2u << qb) - 1u) & lowm);
        const unsigned qsel = (br == 0) ? mysel : 0xffffffffu;
        const int wlim = (br == 0) ? (1 << 30) : 512;
        const int kcol = UC_NKV + (2 + 2 * br) * 128 + g * 64;
        AttnSt st; attn_init(st);
        {
            const bf16_t* kg = rowb + kcol; const bf16_t* vg = kg + 128;
            unsigned rem = tmask;
            int j = __builtin_ctz(rem); rem &= rem - 1u;
            __syncthreads();
            dma_kv(kg + (size_t)(j * 64) * UW, UW, vg + (size_t)(j * 64) * UW, UW, Ks, Vt, F.wave, F.lane);
            __syncthreads();
            int cur = 0;
#pragma unroll 1
            for (;;) {
                const int jn = rem ? __builtin_ctz(rem) : -1; rem &= rem - 1u;
                if (jn >= 0) dma_kv(kg + (size_t)(jn * 64) * UW, UW, vg + (size_t)(jn * 64) * UW, UW, cur ? Ks : Ks1, cur ? Vt : Vt1, F.wave, F.lane);
                const LAS bf16_t* kc_ = cur ? Ks1 : Ks; const LAS bf16_t* vc_ = cur ? Vt1 : Vt;
                f32x16 x0, x1; attn_scores(kc_, qr, x0, x1, r32, hi);
                const bool sel = (qsel >> j) & 1u;
#pragma unroll
                for (int r = 0; r < 16; ++r) { const int d0 = tq - (j * 64 + crow(r, hi)), d1 = d0 - 32;
                    x0[r] = (sel && d0 >= 0 && d0 < wlim) ? x0[r] * 0.125f : -INFINITY; x1[r] = (sel && d1 >= 0 && d1 < wlim) ? x1[r] * 0.125f : -INFINITY; }
                attn_online(vc_, x0, x1, st, wsf, r32, hi);
                __syncthreads();
                if (jn < 0) break;
                j = jn; cur ^= 1;
            }
        }
        const float l = st.l + __shfl_xor(st.l, 32), inv = l > 0.f ? 1.0f / l : 0.f;
        attn_scale_rows(st.o0, st.o1, inv, wsf, r32, hi);
#pragma unroll
        for (int r = 0; r < 16; ++r) { const float gt = nsa_gate(gbase, r, 1 + br); ya0[r] += gt * st.o0[r]; ya1[r] += gt * st.o1[r]; }
    }
    bf16_t* yb = Y + (size_t)grow * YW + 1 * 512 + head * 64 + r32;
#pragma unroll
    for (int r = 0; r < 16; ++r) { bf16_t* yp = yb + (size_t)crow(r, hi) * YW; yp[0] = (bf16_t)f2bf(ya0[r]); yp[32] = (bf16_t)f2bf(ya1[r]); }
}

__device__ __forceinline__ void ld4x16_sys(u32x4& a, u32x4& b, u32x4& c, u32x4& d, const void* pa, const void* pb, const void* pc, const void* pd) {
    asm volatile("global_load_dwordx4 %0, %4, off sc0 sc1\n\tglobal_load_dwordx4 %1, %5, off sc0 sc1\n\tglobal_load_dwordx4 %2, %6, off sc0 sc1\n\tglobal_load_dwordx4 %3, %7, off sc0 sc1\n\ts_waitcnt vmcnt(0)"
                 : "=&v"(a), "=&v"(b), "=&v"(c), "=&v"(d) : "v"(pa), "v"(pb), "v"(pc), "v"(pd) : "memory");
}
constexpr int SL = 136;
constexpr int SSD_CS = 0, SSD_BS = SSD_CS + 128 * SL * 2, SSD_BT = SSD_BS + 128 * SL * 2, SSD_XT = SSD_BT + 128 * SL * 2, SSD_PV = SSD_XT + 64 * SL * 2,
              SSD_DT = SSD_PV + 64 * SL * 2, SSD_AC = SSD_DT + 512, SSD_A = SSD_AC + 512, SSD_END = SSD_A + 512;
static_assert(SSD_END <= LDS_USER, "ssd lds");
__device__ UNIT_INLINE void ssd_unit(Frame& F, int unit, int L, KArgs KA, const bf16_t* U1, bf16_t* Y, const float* misc, float* ssq, unsigned* rdy) {
    const int h = unit & 7, b = unit >> 3, g = h >> 2;
    LAS bf16_t* Cs = (LAS bf16_t*)(F.lds + SSD_CS); LAS bf16_t* Bs = (LAS bf16_t*)(F.lds + SSD_BS); LAS bf16_t* Bt = (LAS bf16_t*)(F.lds + SSD_BT);
    LAS bf16_t* Xt = (LAS bf16_t*)(F.lds + SSD_XT); LAS bf16_t* Pv = (LAS bf16_t*)(F.lds + SSD_PV);
    LAS float* dts = (LAS float*)(F.lds + SSD_DT); LAS float* acs = (LAS float*)(F.lds + SSD_AC); LAS float* as_ = (LAS float*)(F.lds + SSD_A);
    const float* cw = IN_F(5) + (size_t)L * 4 * 1024; const float* cb = IN_F(6) + (size_t)L * 1024;
    const float dtb = IN_F(7)[L * 8 + h], Ah = -expf(IN_F(8)[L * 8 + h]), Dh = IN_F(9)[L * 8 + h];
    const int r16 = F.lane & 15, kg = F.lane >> 4, w = F.wave;
    const bf16_t* rowb = U1 + (size_t)(b * SEQ) * UW;
    f32x4 stt[4];
#pragma unroll
    for (int j = 0; j < 4; ++j) stt[j] = (f32x4){0.f, 0.f, 0.f, 0.f};
    __syncthreads();
    for (int i = F.tid; i < 64 * SL / 2; i += 512) ((LAS unsigned*)Pv)[i] = 0u;
    for (int c = 0; c < 16; ++c) {
        const int t0 = c * 128;
        __syncthreads();
        if (rdy && (c & 1) == 0) { if (F.tid == 0) dep_poll_lane(rdy + 64 * (8 * b + (c >> 1)), 7u); __syncthreads(); }
        for (int i = F.tid; i < 40 * 128; i += 512) {
            const int ch = i % 40, l = i / 40;
            const int cidx = (ch < 8) ? (h * 64 + ch * 8) : (ch < 24 ? 512 + g * 128 + (ch - 8) * 8 : 768 + g * 128 + (ch - 24) * 8);
            float a8[8];
            { const f32x4 b0 = *(const f32x4*)(cb + cidx), b1 = *(const f32x4*)(cb + cidx + 4);
#pragma unroll
              for (int j = 0; j < 4; ++j) { a8[j] = b0[j]; a8[4 + j] = b1[j]; } }
            u32x4 xq[4];
            { const int tb = t0 + l - 3; const bf16_t* pb_ = rowb + UC_XBC + cidx;
              xq[0] = *(const u32x4*)(pb_ + (size_t)(tb < 0 ? 0 : tb) * UW); xq[1] = *(const u32x4*)(pb_ + (size_t)(tb + 1 < 0 ? 0 : tb + 1) * UW); xq[2] = *(const u32x4*)(pb_ + (size_t)(tb + 2 < 0 ? 0 : tb + 2) * UW); xq[3] = *(const u32x4*)(pb_ + (size_t)(tb + 3) * UW); }
#pragma unroll
            for (int k = 0; k < 4; ++k) {
                const int t = t0 + l - 3 + k;
                if (t >= 0) {
                    const u32x4 xv = xq[k];
                    const f32x4 w0 = *(const f32x4*)(cw + k * 1024 + cidx), w1 = *(const f32x4*)(cw + k * 1024 + cidx + 4);
#pragma unroll
                    for (int j = 0; j < 4; ++j) { a8[2 * j] += bf2f(xv[j] & 0xffffu) * (j < 2 ? w0[2 * j] : w1[2 * j - 4]); a8[2 * j + 1] += bf2f(xv[j] >> 16) * (j < 2 ? w0[2 * j + 1] : w1[2 * j - 3]); }
                }
            }
            unsigned short o[8];
#pragma unroll
            for (int j = 0; j < 8; ++j) o[j] = (unsigned short)f2bf(siluf_(a8[j]));
            if (ch < 8) {
#pragma unroll
                for (int j = 0; j < 8; ++j) Xt[(ch * 8 + j) * SL + l] = o[j];
            } else if (ch < 24) {
                const int n0 = (ch - 8) * 8;
                u32x4 pk; pk.x = o[0] | ((unsigned)o[1] << 16); pk.y = o[2] | ((unsigned)o[3] << 16); pk.z = o[4] | ((unsigned)o[5] << 16); pk.w = o[6] | ((unsigned)o[7] << 16);
                *(LAS u32x4*)(Bs + l * SL + n0) = pk;
#pragma unroll
                for (int j = 0; j < 8; ++j) Bt[(n0 + j) * SL + l] = o[j];
            } else {
                const int n0 = (ch - 24) * 8;
                u32x4 pk; pk.x = o[0] | ((unsigned)o[1] << 16); pk.y = o[2] | ((unsigned)o[3] << 16); pk.z = o[4] | ((unsigned)o[5] << 16); pk.w = o[6] | ((unsigned)o[7] << 16);
                *(LAS u32x4*)(Cs + l * SL + n0) = pk;
            }
        }
        if (F.tid < 128) { const float dt = softplusf_(misc[(size_t)(b * SEQ + t0 + F.tid) * 32 + h] + dtb); dts[F.tid] = dt; as_[F.tid] = dt * Ah; }
        __syncthreads();
        if (F.tid < 128) { float s = 0.f; for (int j = 0; j <= F.tid; ++j) s += as_[j]; acs[F.tid] = s; }
        __syncthreads();
        f32x4 cbv[8];
#pragma unroll
        for (int j = 0; j < 8; ++j) cbv[j] = (f32x4){0.f, 0.f, 0.f, 0.f};
#pragma unroll
        for (int ks = 0; ks < 4; ++ks) {
            const bf16x8 a = *(const LAS bf16x8*)(Cs + (16 * w + r16) * SL + ks * 32 + kg * 8);
#pragma unroll
            for (int j = 0; j < 8; ++j) { const bf16x8 bb = *(const LAS bf16x8*)(Bs + (16 * j + r16) * SL + ks * 32 + kg * 8); cbv[j] = __builtin_amdgcn_mfma_f32_16x16x32_bf16(a, bb, cbv[j], 0, 0, 0); }
        }
        __syncthreads();
        LAS bf16_t* Ws = Bs;
#pragma unroll
        for (int j = 0; j < 8; ++j)
#pragma unroll
            for (int r = 0; r < 4; ++r) { const int l = 16 * w + 4 * kg + r, s = 16 * j + r16;
                const float wv = (s <= l) ? cbv[j][r] * __expf(acs[l] - acs[s]) * dts[s] : 0.f;
                Ws[l * SL + s] = (bf16_t)f2bf(wv); }
        __syncthreads();
        f32x4 yd[4], yo[4];
#pragma unroll
        for (int j = 0; j < 4; ++j) { yd[j] = (f32x4){0.f, 0.f, 0.f, 0.f}; yo[j] = (f32x4){0.f, 0.f, 0.f, 0.f}; }
#pragma unroll
        for (int ks = 0; ks < 4; ++ks) {
            const bf16x8 aw = *(const LAS bf16x8*)(Ws + (16 * w + r16) * SL + ks * 32 + kg * 8);
            const bf16x8 ac = *(const LAS bf16x8*)(Cs + (16 * w + r16) * SL + ks * 32 + kg * 8);
#pragma unroll
            for (int j = 0; j < 4; ++j) {
                const bf16x8 bx = *(const LAS bf16x8*)(Xt + (16 * j + r16) * SL + ks * 32 + kg * 8);
                const bf16x8 bp = *(const LAS bf16x8*)(Pv + (16 * j + r16) * SL + ks * 32 + kg * 8);
                yd[j] = __builtin_amdgcn_mfma_f32_16x16x32_bf16(aw, bx, yd[j], 0, 0, 0);
                yo[j] = __builtin_amdgcn_mfma_f32_16x16x32_bf16(ac, bp, yo[j], 0, 0, 0);
            }
        }
#pragma unroll
        for (int r = 0; r < 4; ++r) {
            const int l = 16 * w + 4 * kg + r; const float ea = __expf(acs[l]); const size_t trow = (size_t)(b * SEQ + t0 + l);
            float sq = 0.f;
#pragma unroll
            for (int j = 0; j < 4; ++j) { const int p = 16 * j + r16;
                const float x = bf2f(Xt[p * SL + l]);
                const float z = bf2f(rowb[(size_t)(t0 + l) * UW + UC_Z + h * 64 + p]);
                const float yv = (yd[j][r] + yo[j][r] * ea + Dh * x) * siluf_(z);
                sq += yv * yv;
                Y[trow * YW + h * 64 + p] = (bf16_t)f2bf(yv); }
            sq += __shfl_xor(sq, 1); sq += __shfl_xor(sq, 2); sq += __shfl_xor(sq, 4); sq += __shfl_xor(sq, 8);
            if (r16 == 0) ssq[trow * 8 + h] = sq;
        }
        __syncthreads();
        { const float aend = acs[127];
          for (int i = F.tid; i < 64 * 128; i += 512) { const int p = i >> 7, l = i & 127; Xt[p * SL + l] = (bf16_t)f2bf(bf2f(Xt[p * SL + l]) * dts[l] * __expf(aend - acs[l])); } }
        __syncthreads();
        { const float cd = __expf(acs[127]); const int pt = w & 3;
#pragma unroll
          for (int j = 0; j < 4; ++j) stt[j] *= cd;
#pragma unroll
          for (int ks = 0; ks < 4; ++ks) {
              const bf16x8 a = *(const LAS bf16x8*)(Xt + (16 * pt + r16) * SL + ks * 32 + kg * 8);
#pragma unroll
              for (int j = 0; j < 4; ++j) { const int nt = (w >> 2) * 4 + j; const bf16x8 bb = *(const LAS bf16x8*)(Bt + (16 * nt + r16) * SL + ks * 32 + kg * 8);
                  stt[j] = __builtin_amdgcn_mfma_f32_16x16x32_bf16(a, bb, stt[j], 0, 0, 0); }
          }
#pragma unroll
          for (int j = 0; j < 4; ++j) { const int nt = (w >> 2) * 4 + j;
#pragma unroll
              for (int r = 0; r < 4; ++r) Pv[(16 * pt + 4 * kg + r) * SL + 16 * nt + r16] = (bf16_t)f2bf(stt[j][r]); }
        }
    }
}

constexpr int RW_CT = 16, RW_NC = SEQ / RW_CT;
constexpr int RB_DEC = 0, RB_NB = 4096, RB_CC = 8192, RB_K = 12288, RB_R = 16384, RB_V = 20480, RB_G = 24576  , RB_BS = 26624, RB_SIZE = 26880;
constexpr int RW_OUT = 2 * RB_SIZE, RW_WDH = RW_OUT + 2 * 4096, RW_ADH = RW_WDH + 16 * 72 * 2, RW_GDH = RW_ADH + 16 * 72 * 2, RW_CONST = RW_GDH + 16 * 136 * 2  ,
              RW_MU = RW_CONST + 5 * 256  , RW_LW = RW_MU + 448 * 4  , RW_RAW = RW_LW + 32768,
              RAW_R = 0, RAW_K = 3072, RAW_V = 6144, RAW_L = 9216, RAW_SIZE = 18432, RW_END = RW_RAW + 2 * RAW_SIZE;
static_assert(RW_END <= LDS_USER && RW_RAW % 16 == 0 && RW_LW % 16 == 0, "rwkv lds");
template <int CTRL> __device__ __forceinline__ float dppf(float x) { return __int_as_float(__builtin_amdgcn_update_dpp(0, __float_as_int(x), CTRL, 0xf, 0xf, false)); }
__device__ __forceinline__ float reduce8(float x) { x += dppf<0xB1>(x); x += dppf<0x4E>(x); x += dppf<0x141>(x); return x; }
__device__ __forceinline__ float reduce16(float x) { x = reduce8(x); x += dppf<0x140>(x); return x; }
__device__ __forceinline__ float fast_tanh(float x) { const float e = __expf(2.0f * x); return 1.0f - 2.0f / (e + 1.0f); }
#define RW_BAR() do { asm volatile("s_waitcnt lgkmcnt(0)" ::: "memory"); __builtin_amdgcn_s_barrier(); asm volatile("" ::: "memory"); } while (0)
struct RwEarly { f32x2 nb[4], dc[4]; };
struct RwLate { f32x2 cc[4], kk[4], rr[4]; f32x2 vv; };
__device__ __forceinline__ void rw_load_early(RwEarly& v, const LAS unsigned char* buf, int ti, int kq) {
    const int o = (ti * 64 + kq * 8) * 4;
#pragma unroll
    for (int j = 0; j < 2; ++j) {
        const f32x4 a = *(const LAS f32x4*)(buf + RB_NB + o + 16 * j), b = *(const LAS f32x4*)(buf + RB_DEC + o + 16 * j);
        v.nb[2 * j] = (f32x2){a[0], a[1]}; v.nb[2 * j + 1] = (f32x2){a[2], a[3]}; v.dc[2 * j] = (f32x2){b[0], b[1]}; v.dc[2 * j + 1] = (f32x2){b[2], b[3]};
    }
}
__device__ __forceinline__ void rw_load_late(RwLate& v, const LAS unsigned char* buf, int ti, int kq, int rp) {
    const int o = (ti * 64 + kq * 8) * 4;
#pragma unroll
    for (int j = 0; j < 2; ++j) {
        const f32x4 c = *(const LAS f32x4*)(buf + RB_CC + o + 16 * j), d = *(const LAS f32x4*)(buf + RB_K + o + 16 * j), e = *(const LAS f32x4*)(buf + RB_R + o + 16 * j);
        v.cc[2 * j] = (f32x2){c[0], c[1]}; v.cc[2 * j + 1] = (f32x2){c[2], c[3]}; v.kk[2 * j] = (f32x2){d[0], d[1]}; v.kk[2 * j + 1] = (f32x2){d[2], d[3]};
        v.rr[2 * j] = (f32x2){e[0], e[1]}; v.rr[2 * j + 1] = (f32x2){e[2], e[3]};
    }
    v.vv = *(const LAS f32x2*)(buf + RB_V + (ti * 64 + 2 * rp) * 4);
}
__device__ __forceinline__ void rw_post(const LAS unsigned char* lds, const LAS unsigned char* buf, const LAS float* out, bf16_t* yrow0, int ti, int cg) {
    const int o = ti * 64 + cg * 4;
    const f32x4 x = *(const LAS f32x4*)(out + o), v = *(const LAS f32x4*)((const LAS float*)(buf + RB_V) + o);
    const u32x2 gq = *(const LAS u32x2*)((const LAS bf16_t*)(buf + RB_G) + o);
    const LAS float* cst = (const LAS float*)(lds + RW_CONST) + cg * 4;
    const f32x4 lw = *(const LAS f32x4*)(cst + 192), lb = *(const LAS f32x4*)(cst + 256);
    const float bs = ((const LAS float*)(buf + RB_BS))[ti];
    const float mean = reduce16((x[0] + x[1]) + (x[2] + x[3])) * (1.0f / 64.0f);
    const f32x4 d = x - mean;
    const float rstd = rsqrtf(reduce16((d[0] * d[0] + d[1] * d[1]) + (d[2] * d[2] + d[3] * d[3])) * (1.0f / 64.0f) + 64e-5f);
    const f32x4 g = unpack4(gq);
    const f32x4 y = (d * rstd * lw + lb + v * bs) * g;
    *(u32x2*)(yrow0 + (size_t)ti * YW + cg * 4) = pack4(y);
}
__device__ UNIT_INLINE void rwkv_unit(Frame& F, int unit, int L, KArgs KA, const bf16_t* U1, bf16_t* Y, unsigned* rdy) {
    const int h = unit & 7, b = unit >> 3;
    const bool scanner = F.wave < 4;
    LAS unsigned char* lds = F.lds;
    const bf16_t* rowb = U1 + (size_t)(b * SEQ) * UW + UC_RW;
    bf16_t* ybase = Y + (size_t)(b * SEQ) * YW + 2 * 512 + h * 64;
    const int rp = (F.tid >> 3) & 31, kq = F.tid & 7;
    f32x2 s0[4], s1[4];
#pragma unroll
    for (int j = 0; j < 4; ++j) { s0[j] = (f32x2){0.f, 0.f}; s1[j] = (f32x2){0.f, 0.f}; }
    const int ww = F.wave & 3, wtid = F.tid & 255, r16 = F.lane & 15, kg = F.lane >> 4;
    const int wti = wtid >> 4, wcg = wtid & 15;
    float w0n = 0.f, a0n = 0.f;
    __syncthreads();
    if (!scanner) { const int cn = h * 64 + 16 * ww + r16; w0n = IN_F(15)[L * 512 + cn]; a0n = IN_F(17)[L * 512 + cn]; }
    if (F.tid < 320) { const int v = F.tid >> 6; ((LAS float*)(lds + RW_CONST))[F.tid] = IN_F(20 + v)[L * 512 + h * 64 + (F.tid & 63)]; }
    if (F.tid < 448) { const int i = F.tid; const int col = i < 64 ? h * 64 + i : i < 128 ? 512 + h * 64 + (i - 64) : i < 192 ? 1024 + h * 64 + (i - 128) : 1536 + (i - 192);
        ((LAS float*)(lds + RW_MU))[i] = IN_F(14)[(size_t)L * 1792 + col]; }
    { const u32x4* lw = (const u32x4*)(KA->ws + WS_LW) + (size_t)((L * 8 + h) * 4) * 8 * 64;
      for (int i = F.tid; i < 2048; i += 512) *(LAS u32x4*)(lds + RW_LW + i * 16) = lw[i]; }
    asm volatile("s_waitcnt vmcnt(0)" ::: "memory");
    __syncthreads();
#define RW_DMA(cc) do { const int t0_ = (cc) * RW_CT - 1; LAS unsigned char* rb_ = lds + RW_RAW + ((cc) & 1) * RAW_SIZE; \
        _Pragma("unroll") for (int q_ = 0; q_ < 5; ++q_) { const int ix_ = ww + 4 * q_; if (ix_ < 18) { \
            int tok_, col_, dst_; \
            if (ix_ < 9) { const int kind_ = ix_ / 3, p_ = ix_ % 3; tok_ = 8 * p_ + (F.lane >> 3); col_ = kind_ * 512 + h * 64 + (F.lane & 7) * 8; dst_ = kind_ * 3072 + p_ * 1024; } \
            else { const int p_ = ix_ - 9; tok_ = 2 * p_ + (F.lane >> 5); col_ = 1536 + (F.lane & 31) * 8; dst_ = RAW_L + p_ * 1024; } \
            int t_ = t0_ + (tok_ > 16 ? 16 : tok_); t_ = t_ < 0 ? 0 : t_; \
            __builtin_amdgcn_global_load_lds((const unsigned*)(rowb + (size_t)t_ * UW + col_), (LAS unsigned*)(rb_ + dst_), 16, 0, 0); } } } while (0)
#pragma unroll 1
    for (int ck = -2; ck < RW_NC; ++ck) {
        LAS unsigned char* bcur = lds + (ck & 1) * RB_SIZE;
        LAS unsigned char* bnxt = lds + ((ck + 1) & 1) * RB_SIZE;
        LAS float* ocur = (LAS float*)(lds + RW_OUT + (ck & 1) * 4096); const LAS float* oprv = (const LAS float*)(lds + RW_OUT + ((ck + 1) & 1) * 4096);
        const bool do_scan = scanner && ck >= 0, do_post = !scanner && ck >= 1, do_prep = !scanner && ck + 1 >= 0 && ck + 1 < RW_NC, do_dma = !scanner && ck + 2 < RW_NC;
        RwEarly cur;
        if (do_scan) rw_load_early(cur, bcur, 0, kq);
#define RW_SCAN_SEG(T0) if (do_scan) { _Pragma("unroll") for (int ti = (T0); ti < (T0) + 4; ++ti) { \
            RwLate lt; rw_load_late(lt, bcur, ti, kq, rp); \
            RwEarly nx = cur; if (ti + 1 < RW_CT) rw_load_early(nx, bcur, ti + 1, kq); \
            f32x2 a0 = s0[0] * cur.nb[0], a1 = s1[0] * cur.nb[0]; \
            _Pragma("unroll") for (int j = 1; j < 4; ++j) { a0 += s0[j] * cur.nb[j]; a1 += s1[j] * cur.nb[j]; } \
            const float sa0 = reduce8(a0[0] + a0[1]), sa1 = reduce8(a1[0] + a1[1]); \
            _Pragma("unroll") for (int j = 0; j < 4; ++j) { s0[j] = s0[j] * cur.dc[j] + (lt.cc[j] * sa0 + lt.kk[j] * lt.vv[0]); s1[j] = s1[j] * cur.dc[j] + (lt.cc[j] * sa1 + lt.kk[j] * lt.vv[1]); } \
            f32x2 o0 = s0[0] * lt.rr[0], o1 = s1[0] * lt.rr[0]; \
            _Pragma("unroll") for (int j = 1; j < 4; ++j) { o0 += s0[j] * lt.rr[j]; o1 += s1[j] * lt.rr[j]; } \
            const float q0 = reduce8(o0[0] + o0[1]), q1 = reduce8(o1[0] + o1[1]); \
            if (kq == 0) *(LAS f32x2*)(ocur + ti * 64 + 2 * rp) = (f32x2){q0, q1}; \
            cur = nx; } }
        RW_SCAN_SEG(0)
        if (!scanner) asm volatile("s_waitcnt vmcnt(0)" ::: "memory");
        if (rdy && do_dma && ((ck + 2) & 15) == 0) dep_poll_lane(rdy + 64 * (8 * b + ((ck + 2) >> 4)), 7u);
        if (do_dma) RW_DMA(ck + 2);
        if (do_post) rw_post(lds, bnxt, oprv, ybase + (size_t)((ck - 1) * RW_CT) * YW, wti, wcg);
        RW_BAR();
        RW_SCAN_SEG(4)
        if (do_prep) {
            const LAS unsigned char* raw = lds + RW_RAW + ((ck + 1) & 1) * RAW_SIZE;
            const bool first = (ck + 1 == 0);
#pragma unroll
            for (int n = 0; n < 4; ++n) {
                const int i = wtid + 256 * n;
                if (i < 896) {
                    const int kind = i < 768 ? i >> 7 : 5;
                    const int idx = i - (kind < 5 ? kind * 128 : 640);
                    const int tok = kind < 5 ? idx >> 3 : idx >> 4, piece = kind < 5 ? idx & 7 : idx & 15;
                    int so, mo;
                    if (kind < 3) { so = kind * 3072 + (tok + 1) * 128 + piece * 16; mo = kind * 64 + piece * 8; }
                    else { const int lp = (kind == 3 ? 0 : kind == 4 ? 8 : 16) + piece; so = RAW_L + (tok + 1) * 512 + lp * 16; mo = 192 + lp * 8; }
                    const u32x4 rc = *(const LAS u32x4*)(raw + so);
                    u32x4 rv = *(const LAS u32x4*)(raw + so - (kind < 3 ? 128 : 512));
                    if (first && tok == 0) rv = (u32x4){0u, 0u, 0u, 0u};
                    const f32x4 m0 = *(const LAS f32x4*)((const LAS float*)(lds + RW_MU) + mo), m1 = *(const LAS f32x4*)((const LAS float*)(lds + RW_MU) + mo + 4);
                    float y[8];
#pragma unroll
                    for (int j = 0; j < 4; ++j) {
                        const float x0 = bf2f(rc[j] & 0xffffu), x1 = bf2f(rc[j] >> 16), p0 = bf2f(rv[j] & 0xffffu), p1 = bf2f(rv[j] >> 16);
                        y[2 * j] = x0 + (p0 - x0) * (j < 2 ? m0[2 * j] : m1[2 * j - 4]); y[2 * j + 1] = x1 + (p1 - x1) * (j < 2 ? m0[2 * j + 1] : m1[2 * j - 3]);
                    }
                    if (kind < 3) {
                        LAS float* dst = (LAS float*)(bnxt + (kind == 0 ? RB_R : kind == 1 ? RB_K : RB_V)) + tok * 64 + piece * 8;
                        *(LAS f32x4*)dst = (f32x4){y[0], y[1], y[2], y[3]}; *(LAS f32x4*)(dst + 4) = (f32x4){y[4], y[5], y[6], y[7]};
                    } else {
                        LAS bf16_t* dst;
                        if (kind == 3) { dst = (LAS bf16_t*)(lds + RW_WDH) + tok * 72 + piece * 8;
#pragma unroll
                            for (int j = 0; j < 8; ++j) y[j] = fast_tanh(y[j]); }
                        else if (kind == 4) dst = (LAS bf16_t*)(lds + RW_ADH) + tok * 72 + piece * 8;
                        else { dst = (LAS bf16_t*)(lds + RW_GDH) + tok * 136 + piece * 8;
#pragma unroll
                            for (int j = 0; j < 8; ++j) y[j] = sigmoidf_(y[j]); }
                        u32x4 pk; pk.x = cvt_pk(y[0], y[1]); pk.y = cvt_pk(y[2], y[3]); pk.z = cvt_pk(y[4], y[5]); pk.w = cvt_pk(y[6], y[7]);
                        *(LAS u32x4*)dst = pk;
                    }
                }
            }
        }
        RW_BAR();
        RW_SCAN_SEG(8)
        if (do_prep) {
            LAS float* sDEC = (LAS float*)(bnxt + RB_DEC); LAS float* sCC = (LAS float*)(bnxt + RB_CC); LAS bf16_t* sG = (LAS bf16_t*)(bnxt + RB_G);
            const LAS bf16_t* sWDh = (const LAS bf16_t*)(lds + RW_WDH); const LAS bf16_t* sADh = (const LAS bf16_t*)(lds + RW_ADH); const LAS bf16_t* sGDh = (const LAS bf16_t*)(lds + RW_GDH);
            const LAS bf16x8* Bf = (const LAS bf16x8*)(lds + RW_LW) + ww * 8 * 64 + F.lane;
            f32x4 aw = (f32x4){0.f, 0.f, 0.f, 0.f}, aa = aw, ag = aw;
#pragma unroll
            for (int ks = 0; ks < 2; ++ks) {
                const bf16x8 xw = *(const LAS bf16x8*)(sWDh + r16 * 72 + 32 * ks + 8 * kg), xa = *(const LAS bf16x8*)(sADh + r16 * 72 + 32 * ks + 8 * kg);
                aw = __builtin_amdgcn_mfma_f32_16x16x32_bf16(xw, Bf[ks * 64], aw, 0, 0, 0); aa = __builtin_amdgcn_mfma_f32_16x16x32_bf16(xa, Bf[(2 + ks) * 64], aa, 0, 0, 0);
            }
#pragma unroll
            for (int ks = 0; ks < 4; ++ks) { const bf16x8 xg = *(const LAS bf16x8*)(sGDh + r16 * 136 + 32 * ks + 8 * kg); ag = __builtin_amdgcn_mfma_f32_16x16x32_bf16(xg, Bf[(4 + ks) * 64], ag, 0, 0, 0); }
#pragma unroll
            for (int r = 0; r < 4; ++r) { const int o = (4 * kg + r) * 64 + 16 * ww + r16; sDEC[o] = aw[r] + w0n; sCC[o] = aa[r] + a0n; sG[o] = (bf16_t)f2bf(ag[r]); }
        }
        RW_BAR();
        RW_SCAN_SEG(12)
        if (do_prep) {
            const int o = wti * 64 + wcg * 4;
            LAS float* pDEC = (LAS float*)(bnxt + RB_DEC) + o; LAS float* pNB = (LAS float*)(bnxt + RB_NB) + o; LAS float* pCC = (LAS float*)(bnxt + RB_CC) + o;
            LAS float* pK = (LAS float*)(bnxt + RB_K) + o; const LAS float* pR = (const LAS float*)(bnxt + RB_R) + o;
            const LAS float* cst = (const LAS float*)(lds + RW_CONST) + wcg * 4;
            const f32x4 wp = *(const LAS f32x4*)pDEC, ap = *(const LAS f32x4*)pCC, kr = *(const LAS f32x4*)pK, rr = *(const LAS f32x4*)pR;
            const f32x4 ckk = *(const LAS f32x4*)cst, cka = *(const LAS f32x4*)(cst + 64), crk = *(const LAS f32x4*)(cst + 128);
            f32x4 dec, a, kk, k2;
#pragma unroll
            for (int j = 0; j < 4; ++j) {
                const float sp = (-wp[j] > 20.f) ? -wp[j] : __logf(1.0f + __expf(-wp[j]));
                dec[j] = __expf(-__expf(-sp - 0.5f)); a[j] = sigmoidf_(ap[j]);
            }
            kk = kr * ckk; k2 = kr * ((a - 1.0f) * cka + 1.0f);
            const f32x4 bb = rr * k2 * crk;
            const float sq = reduce16((kk[0] * kk[0] + kk[1] * kk[1]) + (kk[2] * kk[2] + kk[3] * kk[3]));
            const float bsum = reduce16((bb[0] + bb[1]) + (bb[2] + bb[3]));
            const float rn = 1.0f / fmaxf(sqrtf(sq), 1e-12f);
            const f32x4 kn = kk * rn;
            *(LAS f32x4*)pDEC = dec; *(LAS f32x4*)pNB = -kn; *(LAS f32x4*)pCC = kn * a; *(LAS f32x4*)pK = k2;
            if (wcg == 0) ((LAS float*)(bnxt + RB_BS))[wti] = bsum;
        }
        RW_BAR();
#undef RW_SCAN_SEG
    }
#undef RW_DMA
    if (!scanner) rw_post(lds, lds + RB_SIZE, (const LAS float*)(lds + RW_OUT + 4096), ybase + (size_t)(SEQ - RW_CT) * YW, wti, wcg);
}

__device__ UNIT_INLINE void ssd_fixup_and_pb(Frame& F, int L, KArgs KA, bf16_t* Y, const float* ssq, bf16_t* PB) {
    const int gt = F.bid * 512 + F.tid, NT = F.G * 512;
    const float* nw = IN_F(10) + (size_t)L * 512;
    for (int i = gt; i < T * 64; i += NT) {
        const int t = i >> 6, ch = i & 63, g = ch >> 5;
        const f32x4 q = *(const f32x4*)(ssq + (size_t)t * 8 + g * 4);
        const float rs = rsqrtf(((q[0] + q[1]) + (q[2] + q[3])) * (1.0f / 256.0f) + NORM_EPS);
        bf16_t* yp = Y + (size_t)t * YW + ch * 8;
        const u32x4 v = *(const u32x4*)yp; const f32x4 n0 = *(const f32x4*)(nw + ch * 8), n1 = *(const f32x4*)(nw + ch * 8 + 4);
        u32x4 o;
        o.x = cvt_pk(bf2f(v.x & 0xffffu) * rs * n0[0], bf2f(v.x >> 16) * rs * n0[1]); o.y = cvt_pk(bf2f(v.y & 0xffffu) * rs * n0[2], bf2f(v.y >> 16) * rs * n0[3]);
        o.z = cvt_pk(bf2f(v.z & 0xffffu) * rs * n1[0], bf2f(v.z >> 16) * rs * n1[1]); o.w = cvt_pk(bf2f(v.w & 0xffffu) * rs * n1[2], bf2f(v.w >> 16) * rs * n1[3]);
        *(u32x4*)yp = o;
    }
    const float* p = IN_F(1) + (size_t)L * T * PLE;
    for (int i = gt; i < T * PLE / 8; i += NT) {
        const f32x4 a = *(const f32x4*)(p + (size_t)i * 8), b = *(const f32x4*)(p + (size_t)i * 8 + 4);
        u32x4 o; o.x = cvt_pk(a[0], a[1]); o.y = cvt_pk(a[2], a[3]); o.z = cvt_pk(b[0], b[1]); o.w = cvt_pk(b[2], b[3]);
        *(u32x4*)(PB + (size_t)i * 8) = o;
    }
}
__device__ UNIT_INLINE void moe_router(Frame& F, KArgs KA, const float* xo, unsigned* cnt, int* toke, int* tokp, float* tokw) {
    const int gw = F.bid * 8 + F.wave, NGW = F.G * 8;
    const float* gff = IN_F(31) + DM; const float* router = IN_F(35);
    for (int m = gw; m < T; m += NGW) {
        const f32x4* xr = (const f32x4*)(xo + (size_t)m * DM) + F.lane; f32x4 v[4]; float s = 0.f;
#pragma unroll
        for (int j = 0; j < 4; ++j) { v[j] = xr[64 * j]; s += (v[j][0] * v[j][0] + v[j][1] * v[j][1]) + (v[j][2] * v[j][2] + v[j][3] * v[j][3]); }
        const float rstd = rsqrtf(wave_sum(s) * (1.0f / DM) + NORM_EPS);
        float lg[8];
#pragma unroll
        for (int e = 0; e < 8; ++e) lg[e] = 0.f;
#pragma unroll
        for (int j = 0; j < 4; ++j) { const f32x4 gg = *((const f32x4*)gff + F.lane + 64 * j);
#pragma unroll
            for (int i = 0; i < 4; ++i) { const int k = 4 * F.lane + 256 * j + i; const float hv = v[j][i] * rstd * gg[i];
                const f32x4 r0 = *(const f32x4*)(router + (size_t)k * 8), r1 = *(const f32x4*)(router + (size_t)k * 8 + 4);
                lg[0] += hv * r0[0]; lg[1] += hv * r0[1]; lg[2] += hv * r0[2]; lg[3] += hv * r0[3]; lg[4] += hv * r1[0]; lg[5] += hv * r1[1]; lg[6] += hv * r1[2]; lg[7] += hv * r1[3]; } }
#pragma unroll
        for (int e = 0; e < 8; ++e) lg[e] = wave_sum(lg[e]);
        if (F.lane == 0) {
            int e1 = 0; float v1 = lg[0];
#pragma unroll
            for (int e = 1; e < 8; ++e) if (lg[e] > v1) { v1 = lg[e]; e1 = e; }
            int e2 = -1; float v2 = -INFINITY;
#pragma unroll
            for (int e = 0; e < 8; ++e) if (e != e1 && lg[e] > v2) { v2 = lg[e]; e2 = e; }
            const float ex = __expf(v2 - v1), w1 = 1.0f / (1.0f + ex), w2 = ex / (1.0f + ex);
            const int p1 = (int)atomicAdd(cnt + 64 * e1, 1u), p2 = (int)atomicAdd(cnt + 64 * e2, 1u);
            toke[2 * m] = e1; toke[2 * m + 1] = e2; tokp[2 * m] = p1; tokp[2 * m + 1] = p2; tokw[2 * m] = w1; tokw[2 * m + 1] = w2;
        }
    }
}
__device__ __forceinline__ void moe_tables(const unsigned* cnt, MoeTables& mt, int (&c)[8]) {
#pragma unroll
    for (int e = 0; e < 8; ++e) c[e] = (int)__hip_atomic_load(cnt + 64 * e, RLX_AGENT);
    int ps = 0;
    ps += (c[0] + 255) & ~255; mt.ps1 = ps; ps += (c[1] + 255) & ~255; mt.ps2 = ps; ps += (c[2] + 255) & ~255; mt.ps3 = ps; ps += (c[3] + 255) & ~255; mt.ps4 = ps;
    ps += (c[4] + 255) & ~255; mt.ps5 = ps; ps += (c[5] + 255) & ~255; mt.ps6 = ps; ps += (c[6] + 255) & ~255; mt.ps7 = ps; ps += (c[7] + 255) & ~255; mt.ps8 = ps;
}
__device__ __forceinline__ int moe_pstart(const MoeTables& mt, int e) {
    return e == 0 ? 0 : e == 1 ? mt.ps1 : e == 2 ? mt.ps2 : e == 3 ? mt.ps3 : e == 4 ? mt.ps4 : e == 5 ? mt.ps5 : e == 6 ? mt.ps6 : mt.ps7;
}
__device__ UNIT_INLINE void moe_slots(Frame& F, const float* xo, const float* ss2, const unsigned* cnt, const int* toke, const int* tokp, int* toks, bf16_t* XG, float* srstd) {
    const int gw = F.bid * 8 + F.wave, NGW = F.G * 8;
    MoeTables mt; int c[8]; moe_tables(cnt, mt, c);
    for (int m = gw; m < T; m += NGW) {
        const f32x4* xr = (const f32x4*)(xo + (size_t)m * DM) + F.lane; u32x2 pk[4];
#pragma unroll
        for (int j = 0; j < 4; ++j) pk[j] = pack4(xr[64 * j]);
        const float rs = rstd_of(ss2, m);
#pragma unroll
        for (int k = 0; k < 2; ++k) {
            const int e = toke[2 * m + k], slot = moe_pstart(mt, e) + tokp[2 * m + k];
            u32x2* o = (u32x2*)(XG + (size_t)slot * DM) + F.lane;
#pragma unroll
            for (int j = 0; j < 4; ++j) o[64 * j] = pk[j];
            if (F.lane == 0) { toks[2 * m + k] = slot; srstd[slot] = rs; }
        }
    }
    for (int idx = gw; idx < 8 * 256; idx += NGW) {
        const int e = idx >> 8, r = idx & 255;
        int ce = 0;
#pragma unroll
        for (int q = 0; q < 8; ++q) if (q == e) ce = c[q];
        const int row = moe_pstart(mt, e) + ce + r, end = (e == 7) ? mt.ps8 : moe_pstart(mt, e + 1);
        if (row < end) { u32x2* o = (u32x2*)(XG + (size_t)row * DM) + F.lane;
#pragma unroll
            for (int j = 0; j < 4; ++j) o[64 * j] = (u32x2){0u, 0u};
            if (F.lane == 0) srstd[row] = 0.f; }
    }
}
__device__ UNIT_INLINE void moe_combine(Frame& F, float* xo, const bf16_t* YB, const int* toks, const float* tokw, bf16_t* XB2) {
    const int gw = F.bid * 8 + F.wave, NGW = F.G * 8;
    for (int m = gw; m < T; m += NGW) {
        const int s0 = toks[2 * m], s1 = toks[2 * m + 1]; const float w0 = tokw[2 * m], w1 = tokw[2 * m + 1];
        f32x4* xr = (f32x4*)(xo + (size_t)m * DM) + F.lane; const u32x2* y0 = (const u32x2*)(YB + (size_t)s0 * DM) + F.lane; const u32x2* y1 = (const u32x2*)(YB + (size_t)s1 * DM) + F.lane;
        u32x2* xb = (u32x2*)(XB2 + (size_t)m * DM) + F.lane;
#pragma unroll
        for (int j = 0; j < 4; ++j) { const f32x4 v = xr[64 * j] + (unpack4(y0[64 * j]) * w0 + unpack4(y1[64 * j]) * w1); xr[64 * j] = v; xb[64 * j] = pack4(v); }
    }
}
__device__ UNIT_INLINE void final_norm(Frame& F, KArgs KA, float* xo) {
    const int gw = F.bid * 8 + F.wave, NGW = F.G * 8; const float* gf = IN_F(41);
    for (int m = gw; m < T; m += NGW) {
        f32x4* xr = (f32x4*)(xo + (size_t)m * DM) + F.lane; f32x4 v[4]; float s = 0.f;
#pragma unroll
        for (int j = 0; j < 4; ++j) { v[j] = xr[64 * j]; s += (v[j][0] * v[j][0] + v[j][1] * v[j][1]) + (v[j][2] * v[j][2] + v[j][3] * v[j][3]); }
        const float rstd = rsqrtf(wave_sum(s) * (1.0f / DM) + NORM_EPS);
#pragma unroll
        for (int j = 0; j < 4; ++j) xr[64 * j] = v[j] * rstd * *((const f32x4*)gf + F.lane + 64 * j);
    }
}


#define XB_TMO      128
#define XB_XCNT(j)  (256  + 64 * (j))
#define XB_XSUB(j)  (1280 + 64 * (j))
#define XB_XGEN(j)  (2304 + 64 * (j))
#define XB_TOP      3328
#define XB_TOPGEN   3392
#define XCD_BAR_WORDS 3456
#define XB_SPIN_CAP (1u << 22)
__device__ __forceinline__ unsigned xb_ld(unsigned* p)              { return __hip_atomic_load(p, __ATOMIC_RELAXED, __HIP_MEMORY_SCOPE_AGENT); }
__device__ __forceinline__ unsigned xb_add(unsigned* p, unsigned v) { return __hip_atomic_fetch_add(p, v, __ATOMIC_RELAXED, __HIP_MEMORY_SCOPE_AGENT); }
__device__ __forceinline__ unsigned xb_xcc_id() { return (unsigned)__builtin_amdgcn_s_getreg((3 << 11) | 20) & 0xFu; }
#define XB_SPIN(cond, bar) do { unsigned _sp = 0; while (cond) { __builtin_amdgcn_s_sleep(1); \
    if ((++_sp & 255u) == 0u) { if (xb_ld(&(bar)[XB_TMO])) break; if (_sp > XB_SPIN_CAP) { atomicAdd(&(bar)[XB_TMO], 1u); break; } } } } while (0)
struct XcdBarrier { unsigned* bar; unsigned x; volatile LAS unsigned* st; };
__device__ __forceinline__ XcdBarrier xcd_barrier_post(unsigned* bar, volatile LAS unsigned* st) {
    XcdBarrier b; b.bar = bar; b.x = xb_xcc_id(); b.st = st;
    if (threadIdx.x == 0) (void)xb_add(&bar[XB_XCNT(b.x)], 1u);
    return b;
}
__device__ __forceinline__ void xcd_barrier_complete(unsigned* bar, unsigned x, unsigned& nloc, unsigned& nx) {
    const unsigned G = gridDim.x * gridDim.y * gridDim.z;
    unsigned sum, cnt, mine, sp = 0u;
    for (;;) {
        sum = 0u; cnt = 0u; mine = 0u;
#pragma unroll
        for (unsigned j = 0; j < 16; ++j) { const unsigned c = xb_ld(&bar[XB_XCNT(j)]); sum += c; cnt += (c > 0u) ? 1u : 0u; mine = (j == x) ? c : mine; }
        if (sum == G) break;
        __builtin_amdgcn_s_sleep(1);
        if ((++sp & 255u) == 0u) { if (xb_ld(&bar[XB_TMO])) break; if (sp > XB_SPIN_CAP) { atomicAdd(&bar[XB_TMO], 1u); break; } }
    }
    nloc = mine > 0u ? mine : 1u; nx = cnt > 0u ? cnt : 1u;
}
__device__ __forceinline__ void xcd_barrier(const XcdBarrier& b, bool leader) {
    asm volatile("s_waitcnt vmcnt(0)" ::: "memory");
    __syncthreads();
    if (leader) {
        unsigned* bar = b.bar;
        __builtin_amdgcn_s_waitcnt(0);
        unsigned nloc = b.st[0], nx = b.st[1];
        if (nloc == 0u) { xcd_barrier_complete(bar, b.x, nloc, nx); b.st[0] = nloc; b.st[1] = nx; }
        const unsigned old = xb_add(&bar[XB_XSUB(b.x)], 1u);
        const unsigned gen = old / nloc;
        if (old + 1u == (gen + 1u) * nloc) {
            __builtin_amdgcn_fence(__ATOMIC_RELEASE, "agent");
            asm volatile("s_waitcnt vmcnt(0)" ::: "memory");
            const unsigned og = xb_add(&bar[XB_TOP], 1u);
            const unsigned tg = og / nx;
            if (og + 1u == (tg + 1u) * nx) xb_add(&bar[XB_TOPGEN], 1u);
            else XB_SPIN(xb_ld(&bar[XB_TOPGEN]) == tg, bar);
            __builtin_amdgcn_fence(__ATOMIC_ACQUIRE, "agent");
            xb_add(&bar[XB_XGEN(b.x)], 1u);
            asm volatile("s_waitcnt vmcnt(0)" ::: "memory");
        } else {
            XB_SPIN(xb_ld(&bar[XB_XGEN(b.x)]) == gen, bar);
            __builtin_amdgcn_fence(__ATOMIC_ACQUIRE, "agent");
            asm volatile("s_waitcnt vmcnt(0)" ::: "memory");
        }
    }
    __syncthreads();
}

constexpr int NPH = 23;
__device__ __forceinline__ unsigned char* opq(unsigned char* p) { asm volatile("" : "+s"(p)); return p; }
__global__ void __launch_bounds__(512, 2) mega_fwd(Args args) {
    extern __shared__ __attribute__((aligned(16))) unsigned char lds_raw[];
    Frame F;
    F.lds = (LAS unsigned char*)lds_raw; F.tid = 0; F.lane = 0; F.wave = __builtin_amdgcn_readfirstlane((int)threadIdx.x >> 6);
    F.G = gridDim.x; F.bid = blockIdx.x; F.ws = nullptr; F.ctl = nullptr;
    const int lo = args.ph_lo, hi = args.ph_hi;
    LAS unsigned* s_uid = (LAS unsigned*)(F.lds + LDS_USER + 64);
    if (threadIdx.x < 16) ((LAS unsigned*)(F.lds + LDS_USER))[threadIdx.x] = 0u;
    __syncthreads();
    (void)xcd_barrier_post((unsigned*)(args.ws + WS_CTL) + CW_BAR, (volatile LAS unsigned*)(F.lds + LDS_USER + 32));
#if MK_MULTI
#define GSYNC(k) do {} while (0)
#else
#define GSYNC(k) do { if ((k) + 1 < hi || rep_ + 1 < ((k) == REP_PH ? REP_N : 1)) { if ((k) == 0) cg::this_grid().sync(); else { XcdBarrier xb_; xb_.bar = (unsigned*)(KA->ws + WS_CTL) + CW_BAR; xb_.x = xb_xcc_id(); xb_.st = (volatile LAS unsigned*)(P.lds + LDS_USER + 32); xcd_barrier(xb_, P.tid == 0); } } } while (0)
#endif
#ifdef ONLY_PH
#define RUN(k) ((k) == ONLY_PH)
#else
#define RUN(k) (lo <= (k) && (k) < hi)
#endif
#define REPS(k) for (int rep_ = 0; rep_ < ((k) == REP_PH ? REP_N : 1); ++rep_)
#define PH_PTRS KArgs KA = kargs(); unsigned char* ws = KA->ws; float* out = KA->out; (void)out; \
    Frame P = F; asm volatile("" : "+s"(P.G), "+s"(P.bid), "+s"(P.wave)); asm volatile("v_mbcnt_lo_u32_b32 %0, -1, 0\n\tv_mbcnt_hi_u32_b32 %0, -1, %0" : "=v"(P.lane)); P.tid = P.wave * 64 + P.lane; \
    unsigned char* wa = ws + WS_WA + (size_t)L * WA_STRIDE; (void)wa; float* ssb = (float*)(ws + WS_SSP); \
    float* ss1 = ssb + (size_t)(2 * L) * T * 16; float* ss2 = ssb + (size_t)(2 * L + 1) * T * 16; float* ssn = ssb + (size_t)(2 * L + 2) * T * 16; (void)ss1; (void)ss2; (void)ssn; \
    bf16_t* XB = (bf16_t*)(ws + WS_XB); bf16_t* Y = (bf16_t*)(ws + WS_Y); bf16_t* U1 = (bf16_t*)(ws + WS_U1); (void)XB; (void)Y; (void)U1; \
    bf16_t* GATES = (bf16_t*)(ws + (L == 0 ? WS_WB : WS_GATES)); bf16_t* MERGED = (bf16_t*)(ws + WS_MERGED); bf16_t* PB = (bf16_t*)(ws + WS_PB); (void)GATES; (void)MERGED; (void)PB; \
    float* MISC = (float*)(ws + WS_MISC); float* SSQ = (float*)(ws + WS_SSQ); (void)MISC; (void)SSQ; \
    bf16_t* XB2 = (bf16_t*)(ws + (L == 0 ? WS_XB2_L0 : WS_XB2_L1)); (void)XB2;
    const size_t TILE1K = (size_t)256 * 1024 * 2;
    if (RUN(0)) REPS(0) { const int L = 0; PH_PTRS p0_prologue(KA, P); GSYNC(0); }
#pragma unroll 1
    for (int L = 0; L < 2; ++L) {
        const int pb0 = 1 + (L == 0 ? 0 : 9);
        if (RUN(pb0)) REPS(pb0) { PH_PTRS
            pg8::DenseSched S; S.so.init(64, 22, P.G, P.bid); S.A = (const char*)XB; S.B = (const char*)(wa + WA_IN); S.a_tile = TILE1K; S.b_tile = TILE1K;
            EpiIn E{U1, MISC, ss1};
            pg8::gemm_phase(P.lds, DM, DM, DM, S, E); GSYNC(pb0);
        }
        if (RUN(pb0 + 2)) REPS(pb0 + 2) {
            if (F.bid < 64) { PH_PTRS
#ifndef SKIP_RWKV
                rwkv_unit(P, P.bid, L, KA, U1, Y, nullptr);
#endif
            }
            if (F.bid >= 64 && F.bid < 128) { PH_PTRS
#ifndef SKIP_SSD
                ssd_unit(P, P.bid - 64, L, KA, U1, Y, MISC, SSQ, nullptr);
#endif
            }
            { PH_PTRS
                unsigned* dep = (unsigned*)(ws + WS_CTL) + CW_DEP + 16384 * L; unsigned* q = (unsigned*)(ws + WS_CTL) + CW_QMIX + 256 * L;
                for (;;) {
                    __syncthreads();
                    if (P.tid == 0) *s_uid = atomicAdd(q + 64, 1u);
                    __syncthreads();
                    const int t = (int)*s_uid;
                    if (t >= 256) break;
                    if (t < 128) compress_unit(P, t, L, U1, ws);
                    else rope_slice(P, U1, (const float*)(ws + WS_ROPE), (const float*)(ws + WS_ROPE) + (size_t)T * 32, t - 128);
                    dep_signal(dep + 64, nullptr, P.tid == 0);
                }
                dep_wait(dep + 64, 256u, P.tid == 0);
            }
            { PH_PTRS
            unsigned* q = (unsigned*)(ws + WS_CTL) + CW_QMIX + 256 * L;
            for (;;) {
                __syncthreads();
                if (P.tid == 0) *s_uid = atomicAdd(q + 128, 1u);
                __syncthreads();
                const int uid = (int)*s_uid;
                if (uid >= 512) break;
#ifndef SKIP_NSA
                nsa_unit(P, uid, U1, Y, MISC, ws);
#endif
            } }
            { PH_PTRS
            unsigned* q = (unsigned*)(ws + WS_CTL) + CW_QMIX + 256 * L;
            for (;;) {
                __syncthreads();
                if (P.tid == 0) *s_uid = atomicAdd(q + 192, 1u);
                __syncthreads();
                const int uid = (int)*s_uid;
                if (uid >= 512) break;
#ifndef SKIP_SWA
                swa_unit(P, uid, U1, Y, IN_F(25) + L * 8);
#endif
            } }
            if (L == 0) { PH_PTRS
                unsigned* qg = (unsigned*)(ws + WS_CTL) + CW_QMIX + 576 + 1024 * rep_;
                for (;;) {
                    __syncthreads();
                    if (P.tid == 0) *s_uid = atomicAdd(qg, 1u);
                    __syncthreads();
                    const int t = (int)*s_uid;
                    if (t >= 256) break;
                    BatchSched S; S.pm = t >> 2; S.pn0 = (t & 3) * 4; S.n = 4; S.A = (const char*)XB; S.B = (const char*)(wa + WA_GATE); S.a_tile = TILE1K; S.b_tile = TILE1K;
                    EpiGates E{GATES, ss1};
                    pg8::gemm_phase(P.lds, DM, DM, DM, S, E);
                }
            }
            { PH_PTRS
              if (L == 0) deferred_convert(KA, P, (unsigned*)(ws + WS_CTL) + CW_QMIX + 512 + 1024 * rep_, s_uid, 16, 32, 3472);
              else deferred_convert(KA, P, (unsigned*)(ws + WS_CTL) + CW_QMIX + 768 + 1024 * rep_, s_uid, 35, 59, 16896); }
            { PH_PTRS GSYNC(pb0 + 2); }
        }
        if (RUN(pb0 + 3)) REPS(pb0 + 3) { PH_PTRS
            if (L != 0) {
            pg8::DenseSched S; S.so.init(64, 16, P.G, P.bid); S.A = (const char*)XB; S.B = (const char*)(wa + WA_GATE); S.a_tile = TILE1K; S.b_tile = TILE1K;
            EpiGates E{GATES, ss1};
            pg8::gemm_phase(P.lds, DM, DM, DM, S, E);
            }
            ssd_fixup_and_pb(P, L, KA, Y, SSQ, PB);
            GSYNC(pb0 + 3);
        }
        if (RUN(pb0 + 4)) REPS(pb0 + 4) {
            { PH_PTRS pg8::DenseSched S; S.so.init(64, 4, P.G, P.bid); S.a_tile = (size_t)256 * YW * 2; S.b_tile = (size_t)256 * 512 * 2;
              S.A = (const char*)Y; S.B = (const char*)(wa + WA_PT);
              EpiBr<0> E{MERGED, GATES}; pg8::gemm_phase(P.lds, YW, 512, 512, S, E); }
            { PH_PTRS pg8::DenseSched S; S.so.init(64, 4, P.G, P.bid); S.a_tile = (size_t)256 * YW * 2; S.b_tile = (size_t)256 * 512 * 2;
              S.A = (const char*)(Y + 512); S.B = (const char*)(wa + WA_PT + 1 * MiB);
              EpiBr<1> E{MERGED, GATES}; pg8::gemm_phase(P.lds, YW, 512, 512, S, E); }
            { PH_PTRS pg8::DenseSched S; S.so.init(64, 4, P.G, P.bid); S.a_tile = (size_t)256 * YW * 2; S.b_tile = (size_t)256 * 512 * 2;
              S.A = (const char*)(Y + 1024); S.B = (const char*)(wa + WA_PT + 2 * MiB);
              EpiBr<2> E{MERGED, GATES}; pg8::gemm_phase(P.lds, YW, 512, 512, S, E); }
            { PH_PTRS pg8::DenseSched S; S.so.init(64, 4, P.G, P.bid); S.a_tile = (size_t)256 * YW * 2; S.b_tile = (size_t)256 * 512 * 2;
              S.A = (const char*)(Y + 1536); S.B = (const char*)(wa + WA_PT + 3 * MiB);
              EpiBr<3> E{MERGED, GATES}; pg8::gemm_phase(P.lds, YW, 512, 512, S, E); }
            { PH_PTRS GSYNC(pb0 + 4); }
        }
        if (RUN(pb0 + 5)) REPS(pb0 + 5) { PH_PTRS
            pg8::DenseSched S; S.so.init(64, 4, P.G, P.bid); S.A = (const char*)MERGED; S.B = (const char*)(wa + WA_OUT); S.a_tile = TILE1K; S.b_tile = TILE1K;
            if (L == 0) { EpiRes<true, true> E{IN_F(0), out, XB, ss2}; pg8::gemm_phase(P.lds, DM, DM, DM, S, E); }
            else { EpiRes<false, true> E{out, out, XB, ss2}; pg8::gemm_phase(P.lds, DM, DM, DM, S, E); }
            GSYNC(pb0 + 5);
        }
        if (L == 0) {
            if (RUN(7)) REPS(7) { PH_PTRS
                pg8::DenseSched S; S.so.init(64, 22, P.G, P.bid); S.A = (const char*)XB; S.B = (const char*)(ws + WS_FGU); S.a_tile = TILE1K; S.b_tile = TILE1K;
                EpiFfn1<false> E{(bf16_t*)(ws + WS_ACT0), ss2};
                pg8::gemm_phase(P.lds, DM, DM, DM, S, E); GSYNC(7);
            }
            if (RUN(8)) REPS(8) { PH_PTRS
                pg8::DenseSched S; S.so.init(64, 4, P.G, P.bid); S.A = (const char*)(ws + WS_ACT0); S.B = (const char*)(ws + WS_FDN); S.a_tile = (size_t)256 * D_FF * 2; S.b_tile = (size_t)256 * D_FF * 2;
                EpiRes<true, false> E{out, out, XB2, nullptr};
                pg8::gemm_phase(P.lds, D_FF, D_FF, D_FF, S, E); GSYNC(8);
            }
        } else {
#define MOE_PTRS unsigned* cnt = (unsigned*)(ws + WS_CTL) + CW_MOECNT; (void)cnt; int* toke = (int*)(ws + WS_TOKE); int* tokp = (int*)(ws + WS_TOKP); float* tokw = (float*)(ws + WS_TOKW); int* toks = (int*)(ws + WS_TOKS); \
            (void)toke; (void)tokp; (void)tokw; (void)toks; float* srstd = (float*)(ws + WS_SRSTD); (void)srstd; \
            bf16_t* XG = (bf16_t*)(ws + WS_XG); bf16_t* ACT1 = (bf16_t*)(ws + WS_ACT1); bf16_t* YB = (bf16_t*)(ws + WS_YB); (void)XG; (void)ACT1; (void)YB;
            if (RUN(16)) REPS(16) { PH_PTRS MOE_PTRS moe_router(P, KA, out, cnt, toke, tokp, tokw); GSYNC(16); }
            if (RUN(17)) REPS(17) { PH_PTRS MOE_PTRS moe_slots(P, out, ss2, cnt, toke, tokp, toks, XG, srstd); GSYNC(17); }
            if (RUN(18)) REPS(18) { PH_PTRS MOE_PTRS
                MoeSched S; int c[8]; moe_tables(cnt, S.mt, c); S.nN = 22; S.G = P.G; S.c = P.bid; S.A = (const char*)XG; S.B = (const char*)(ws + WS_WB); S.a_tile = TILE1K; S.b_tile = TILE1K; S.b_expert = WB_STRIDE;
                EpiFfn1<true> E{ACT1, srstd};
                pg8::gemm_phase(P.lds, DM, DM, DM, S, E); GSYNC(18);
            }
            if (RUN(19)) REPS(19) { PH_PTRS MOE_PTRS
                MoeSched S; int c[8]; moe_tables(cnt, S.mt, c); S.nN = 4; S.G = P.G; S.c = P.bid; S.A = (const char*)ACT1; S.B = (const char*)(ws + WS_WB + WB_DN); S.a_tile = (size_t)256 * D_FF * 2; S.b_tile = (size_t)256 * D_FF * 2; S.b_expert = WB_STRIDE;
                EpiBf16<false> E{YB};
                pg8::gemm_phase(P.lds, D_FF, D_FF, D_FF, S, E); GSYNC(19);
            }
            if (RUN(20)) REPS(20) { PH_PTRS MOE_PTRS moe_combine(P, out, YB, toks, tokw, XB2); GSYNC(20); }
        }
        const int pple = (L == 0) ? 9 : 21;
        if (RUN(pple)) REPS(pple) {
            { PH_PTRS pg8::DenseSched S; S.so.init(64, 4, P.G, P.bid); S.A = (const char*)XB2; S.B = (const char*)(wa + WA_PG); S.a_tile = TILE1K; S.b_tile = TILE1K;
              EpiBf16<true> E{MERGED}; pg8::gemm_phase(P.lds, DM, DM, DM, S, E); }
            { PH_PTRS pg8::DenseSched S; S.so.init(64, 4, P.G, P.bid);
              S.A = (const char*)PB; S.B = (const char*)(wa + WA_PP); S.a_tile = (size_t)256 * PLE * 2; S.b_tile = (size_t)256 * PLE * 2;
              if (L == 0) { EpiPle2<true> E{out, MERGED, XB, ssn}; pg8::gemm_phase(P.lds, PLE, PLE, PLE, S, E); }
              else { EpiPle2<false> E{out, MERGED, XB, ssn}; pg8::gemm_phase(P.lds, PLE, PLE, PLE, S, E); } }
            { PH_PTRS GSYNC(pple); }
        }
    }
    if (RUN(22)) REPS(22) { const int L = 0; PH_PTRS final_norm(P, KA, out); }
}

extern "C" void kernel_launch(void* const* d_in, const int* in_sizes, int n_in, void* d_out, int out_size, void* d_ws, size_t ws_size, hipStream_t stream) {
    static int grid = 0;
    if (grid == 0) {
        if (n_in != 42 || out_size != T * DM || ws_size < WS_END) { fprintf(stderr, "kernel_launch: unexpected problem (n_in %d out %d ws %zu)\n", n_in, out_size, ws_size); grid = -1; return; }
        int dev = 0, cus = 0, per_cu = 0;
        hipGetDevice(&dev); hipDeviceGetAttribute(&cus, hipDeviceAttributeMultiprocessorCount, dev);
        hipFuncSetAttribute((const void*)mega_fwd, hipFuncAttributeMaxDynamicSharedMemorySize, LDS_BYTES);
        hipOccupancyMaxActiveBlocksPerMultiprocessor(&per_cu, (const void*)mega_fwd, 512, LDS_BYTES);
        if (per_cu < 1) { fprintf(stderr, "kernel_launch: occupancy query says %d blocks per CU\n", per_cu); per_cu = 1; }
        (void)hipGetLastError();
        grid = cus;
    }
    if (grid < 0) return;
    hipMemsetAsync((char*)d_ws + WS_CTL, 0, CTL_BYTES, stream);
    Args a{};
    for (int i = 0; i < 42; ++i) a.in[i] = d_in[i];
    a.out = (float*)d_out; a.ws = (unsigned char*)d_ws;
#if MK_MULTI
    for (int k = 0; k < NPH; ++k) { a.ph_lo = k; a.ph_hi = k + 1; hipLaunchKernelGGL(mega_fwd, dim3(grid), dim3(512), LDS_BYTES, stream, a); }
#else
    a.ph_lo = 0; a.ph_hi = NPH;
    void* kargs[] = {&a};
    hipError_t e = hipLaunchCooperativeKernel((const void*)mega_fwd, dim3(grid), dim3(512), kargs, LDS_BYTES, stream);
    if (e != hipSuccess) fprintf(stderr, "kernel_launch: cooperative launch failed: %s\n", hipGetErrorString(e));
#endif
}
```

```cpp
#include <hip/hip_runtime.h>
#include <hip/hip_cooperative_groups.h>
#include <cstdio>
#include <cstdint>
namespace cg = cooperative_groups;

#define LAS __attribute__((address_space(3)))
#define GAS __attribute__((address_space(1)))
typedef unsigned short bf16_t;
typedef short bf16x8 __attribute__((ext_vector_type(8)));
typedef short s16x4 __attribute__((ext_vector_type(4)));
typedef float f32x2 __attribute__((ext_vector_type(2)));
typedef float f32x4 __attribute__((ext_vector_type(4)));
typedef float f32x16 __attribute__((ext_vector_type(16)));
typedef unsigned u32x2 __attribute__((ext_vector_type(2)));
typedef unsigned u32x4 __attribute__((ext_vector_type(4)));

#ifdef DIAG_NOINLINE
#define UNIT_INLINE __attribute__((noinline))
#else
#define UNIT_INLINE __forceinline__
#endif
#ifndef REP_PH
#define REP_PH -1
#endif
#ifndef REP_N
#define REP_N 1
#endif
#ifndef REP_UNIT
#define REP_UNIT -1
#endif
#ifndef MK_MULTI
#define MK_MULTI 0
#endif

constexpr int NB = 8, SEQ = 2048, T = NB * SEQ, DM = 1024, HD = 64;
constexpr int D_IN = 9504, D_FF = 2816, NEXP = 8, PLE = 256;
constexpr int UW = 5376;
constexpr int YW = 2048;
constexpr float NORM_EPS = 1e-6f;
constexpr float LOG2E = 1.4426950408889634f;
constexpr int UC_Z = 0, UC_XBC = 512, UC_XS = 512, UC_BM = 1024, UC_CM = 1280, UC_NQ = 1536, UC_NKV = 2048, UC_RW = 2816, UC_SQ = 4608, UC_SKV = 5120;
constexpr int MOE_MAXROWS = 34816;

constexpr size_t MiB = (size_t)1 << 20;
constexpr size_t WS_CTL = 0, CTL_BYTES = 1 * MiB;
constexpr size_t WS_ROPE = 1 * MiB;
constexpr size_t WS_MISC = 5 * MiB;
constexpr size_t WS_KC = 7 * MiB, WS_VC = 7 * MiB + 256 * 1024;
constexpr size_t WS_SSQ = 7 * MiB + 512 * 1024;
constexpr size_t WS_TOKE = 8 * MiB, WS_TOKP = WS_TOKE + 128 * 1024, WS_TOKW = WS_TOKP + 128 * 1024, WS_TOKS = WS_TOKW + 128 * 1024;
constexpr size_t WS_SRSTD = 8 * MiB + 512 * 1024;
constexpr size_t WS_W1T = 9 * MiB;
constexpr size_t WS_W2T = 10 * MiB;
constexpr size_t WS_PEB = 10 * MiB + 64 * 1024;
constexpr size_t WS_LW = 10 * MiB + 128 * 1024;
constexpr size_t WS_WA = 12 * MiB, WA_STRIDE = 28 * MiB;
constexpr size_t WA_IN = 0, WA_GATE = 11 * MiB, WA_PT = 19 * MiB, WA_OUT = 23 * MiB, WA_PG = 25 * MiB, WA_PP = 27 * MiB;
constexpr size_t WS_FGU = 68 * MiB, WS_FDN = 79 * MiB;
constexpr size_t WS_WB = 85 * MiB, WB_STRIDE = 16 * MiB + 512 * 1024, WB_DN = 11 * MiB;
constexpr size_t WS_XB = 217 * MiB;
constexpr size_t WS_Y = 249 * MiB;
constexpr size_t WS_BIG = 313 * MiB;
constexpr size_t WS_U1 = WS_BIG, WS_GATES = WS_BIG, WS_MERGED = WS_BIG + 128 * MiB, WS_PB = WS_BIG + 160 * MiB, WS_ACT0 = WS_BIG;
constexpr size_t WS_XG = WS_XB, WS_ACT1 = 285 * MiB, WS_YB = WS_XB;
constexpr size_t WS_XB2_L0 = WS_Y, WS_XB2_L1 = 300 * MiB;
constexpr size_t WS_SSP = 482 * MiB;
constexpr size_t WS_END = 488 * MiB;
constexpr int CW_BAR = 4096, CW_QMIX = 16384, CW_MOECNT = 9216;
constexpr int CW_DEP = 32768;

constexpr int RING_BYTES = 131072;
constexpr int LDS_BYTES = 147456;
constexpr int LDS_USER = LDS_BYTES - 1024;
constexpr int MISC_OFF = LDS_USER;

__device__ __forceinline__ float bf2f(unsigned b) { return __uint_as_float(b << 16); }
__device__ __forceinline__ unsigned f2bf(float f) { unsigned u = __float_as_uint(f); return (u + 0x7fffu + ((u >> 16) & 1u)) >> 16; }
__device__ __forceinline__ unsigned cvt_pk(float lo, float hi) { unsigned r; asm volatile("v_cvt_pk_bf16_f32 %0, %1, %2" : "=v"(r) : "v"(lo), "v"(hi)); return r; }
__device__ __forceinline__ float sigmoidf_(float x) { return 1.0f / (1.0f + __expf(-x)); }
__device__ __forceinline__ float siluf_(float x) { return x / (1.0f + __expf(-x)); }
__device__ __forceinline__ float softplusf_(float x) { return x > 20.f ? x : __logf(1.0f + __expf(x)); }
__device__ __forceinline__ float wave_sum(float v) {
#pragma unroll
    for (int o = 1; o < 64; o <<= 1) v += __shfl_xor(v, o);
    return v;
}
__device__ __forceinline__ float wave_max(float v) {
#pragma unroll
    for (int o = 1; o < 64; o <<= 1) v = fmaxf(v, __shfl_xor(v, o));
    return v;
}
#define RLX_AGENT __ATOMIC_RELAXED, __HIP_MEMORY_SCOPE_AGENT
__device__ __forceinline__ u32x2 ld_agent_u64(const void* p) {
    unsigned long long v = __hip_atomic_load((const unsigned long long*)p, RLX_AGENT);
    u32x2 r; r.x = (unsigned)v; r.y = (unsigned)(v >> 32); return r;
}

__device__ __forceinline__ float ss_total(const float* ssp, int row) {
    const f32x4* p = (const f32x4*)(ssp + (size_t)row * 16); const f32x4 a = p[0], b = p[1], c = p[2], d = p[3];
    return (((a[0] + a[1]) + (a[2] + a[3])) + ((b[0] + b[1]) + (b[2] + b[3]))) + (((c[0] + c[1]) + (c[2] + c[3])) + ((d[0] + d[1]) + (d[2] + d[3])));
}
__device__ __forceinline__ float rstd_of(const float* ssp, int row) { return rsqrtf(ss_total(ssp, row) * (1.0f / DM) + NORM_EPS); }

namespace pg8 {
constexpr int BM = 256, BK = 64, HALF = 128, HTB = HALF * BK * 2, STAGE_BYTES = 8 * HTB, NXCD = 8, WGM = 8;
__host__ __device__ __forceinline__ int lds_byte(int r, int c) { const int st = (r >> 4) * 2 + (c >> 5), rr = r & 15, cc = c & 31, ob = rr * 64 + cc * 2; return st * 1024 + (ob ^ (((ob >> 9) & 1) << 5)); }
__host__ __device__ __forceinline__ void stage_rc(int b, int& R, int& C) { const int st = b / 1024, sb = b % 1024, swz = sb ^ (((sb >> 9) & 1) << 5); R = (st >> 1) * 16 + swz / 64; C = (st & 1) * 32 + (swz % 64) / 2; }

struct Unit { int pm, pn; const char* pa; const char* pb; };

struct StaticOrder {
    int nM, nN, nwg, G, c;
    __device__ void init(int nM_, int nN_, int G_, int c_) { nM = nM_; nN = nN_; nwg = nM * nN; G = G_; c = c_; }
    __device__ bool next(int i, int& pm, int& pn) const {
        const long L = (long)i * G + c; if (L >= nwg) return false;
        int wgid = (int)L; { const int q = nwg / NXCD, r = nwg % NXCD, xcd = wgid % NXCD, off = wgid / NXCD; wgid = (xcd < r ? xcd * (q + 1) : r * (q + 1) + (xcd - r) * q) + off; }
        const int nig = WGM * nN, gid = wgid / nig, fm = gid * WGM, gsz = (nM - fm) < WGM ? (nM - fm) : WGM;
        pm = fm + ((wgid % nig) % gsz); pn = (wgid % nig) / gsz; return true;
    }
};
struct DenseSched {
    StaticOrder so; const char* A; const char* B; size_t a_tile, b_tile;
    __device__ bool next(int i, Unit& u) const { if (!so.next(i, u.pm, u.pn)) return false; u.pa = A + (size_t)u.pm * a_tile; u.pb = B + (size_t)u.pn * b_tile; return true; }
};

template <class Epi, class Sched>
__device__ __forceinline__ void gemm_phase(LAS unsigned char* lds, const int lda, const int ldb, const int K, const Sched& S, const Epi& E) {
    int tid_ = threadIdx.x; asm volatile("" : "+v"(tid_));
    const int tid = tid_, wid = __builtin_amdgcn_readfirstlane(tid >> 6), lane = tid & 63, wr = wid >> 2, wc = wid & 3, fr = lane & 15, fq = lane >> 4;
    int K_ = K; asm volatile("" : "+s"(K_));
    const int nt = K_ / BK;
    unsigned voffA[2], voffB[2];
#pragma unroll
    for (int i = 0; i < 2; ++i) { int R, C; stage_rc(tid * 16 + i * 8192, R, C); voffA[i] = (unsigned)(R * lda + C) * 2u; voffB[i] = (unsigned)(R * ldb + C) * 2u; }
    const size_t kstep = (size_t)(BK * 2);
    const size_t hstepA = (size_t)HALF * lda * 2, hstepB = (size_t)HALF * ldb * 2;
    const unsigned ldsw = (unsigned)wid * 1024u;
    const int aoff = lds_byte(wr * 64 + fr, fq * 8), boff = lds_byte(wc * 32 + fr, fq * 8);
#define PG8_SA(b, h) (((b) * 2 + (h)) * HTB)
#define PG8_SB(b, h) ((4 + (b) * 2 + (h)) * HTB)
#define PG8_STAGE(bufoff, gbase, voff) do { _Pragma("unroll") for (int _i = 0; _i < 2; ++_i) \
        __builtin_amdgcn_global_load_lds((const unsigned*)((const char*)(gbase) + (voff)[_i]), (LAS unsigned*)(lds + (bufoff) + ldsw + _i * 8192), 16, 0, 0); } while (0)
#define PG8_LDA(dst, b, h) do { _Pragma("unroll") for (int m = 0; m < 4; ++m) _Pragma("unroll") for (int k = 0; k < 2; ++k) dst[m][k] = *(const LAS bf16x8*)(lds + PG8_SA(b, h) + aoff + m * 2048 + k * 1024); } while (0)
#define PG8_LDB(dst, b, h) do { _Pragma("unroll") for (int n = 0; n < 2; ++n) _Pragma("unroll") for (int k = 0; k < 2; ++k) dst[n][k] = *(const LAS bf16x8*)(lds + PG8_SB(b, h) + boff + n * 2048 + k * 1024); } while (0)
#define PG8_MMA(ai, bj, At, Bt) do { __builtin_amdgcn_s_setprio(1); _Pragma("unroll") for (int m = 0; m < 4; ++m) _Pragma("unroll") for (int n = 0; n < 2; ++n) _Pragma("unroll") for (int k = 0; k < 2; ++k) \
        acc[ai][bj][m][n] = __builtin_amdgcn_mfma_f32_16x16x32_bf16(Bt[n][k], At[m][k], acc[ai][bj][m][n], 0, 0, 0); __builtin_amdgcn_s_setprio(0); } while (0)
#define PG8_WAIT_V(n) asm volatile("s_waitcnt vmcnt(" #n ")" ::: "memory")
#define PG8_WAIT_L(n) asm volatile("s_waitcnt lgkmcnt(" #n ")" ::: "memory")
#define PG8_BAR __builtin_amdgcn_s_barrier()
#define PG8_SCHED __builtin_amdgcn_sched_barrier(0)
    Unit cur, nxt; int ui = 0;
    if (!S.next(0, cur)) return;
    f32x4 acc[2][2][4][2];
#pragma unroll
    for (int a = 0; a < 2; ++a)
#pragma unroll
        for (int b = 0; b < 2; ++b)
#pragma unroll
            for (int m = 0; m < 4; ++m)
#pragma unroll
                for (int n = 0; n < 2; ++n) acc[a][b][m][n] = (f32x4){0.f, 0.f, 0.f, 0.f};
    bf16x8 At[4][2], B0[2][2], B1[2][2];
    const char* cA = cur.pa; const char* cB = cur.pb;
    PG8_STAGE(PG8_SB(0, 0), cB, voffB); PG8_STAGE(PG8_SB(0, 1), cB + hstepB, voffB); PG8_STAGE(PG8_SA(0, 0), cA, voffA); PG8_STAGE(PG8_SA(0, 1), cA + hstepA, voffA);
    if (wr == 1) PG8_BAR;
    PG8_WAIT_V(2); PG8_BAR;
    PG8_STAGE(PG8_SB(1, 0), cB + kstep, voffB); PG8_STAGE(PG8_SA(1, 0), cA + kstep, voffA); PG8_STAGE(PG8_SB(1, 1), cB + hstepB + kstep, voffB);
    PG8_WAIT_V(6); PG8_BAR;
    for (;;) {
        const bool has_next = S.next(ui + 1, nxt);
        const char* nA = has_next ? nxt.pa : cA; const char* nB = has_next ? nxt.pb : cB;
        for (int t = 0; t < nt; t += 2) {
            const bool last = (t == nt - 2);
            const char* a1 = cA + (size_t)(t + 1) * kstep;
            const char* a2 = last ? nA : cA + (size_t)(t + 2) * kstep; const char* b2 = last ? nB : cB + (size_t)(t + 2) * kstep;
            const char* a3 = a2 + kstep; const char* b3 = b2 + kstep;
            PG8_LDB(B0, 0, 0); PG8_LDB(B1, 0, 1); PG8_SCHED; PG8_LDA(At, 0, 0); PG8_STAGE(PG8_SA(1, 1), a1 + hstepA, voffA);
            PG8_WAIT_V(8); PG8_WAIT_L(0); PG8_BAR; PG8_MMA(0, 0, At, B0); PG8_MMA(0, 1, At, B1); PG8_BAR; PG8_SCHED;
            PG8_LDA(At, 0, 1); PG8_STAGE(PG8_SB(0, 0), b2, voffB); PG8_STAGE(PG8_SB(0, 1), b2 + hstepB, voffB); PG8_STAGE(PG8_SA(0, 0), a2, voffA);
            PG8_WAIT_V(8); PG8_WAIT_L(0); PG8_BAR; PG8_MMA(1, 0, At, B0); PG8_MMA(1, 1, At, B1); PG8_BAR; PG8_SCHED;
            PG8_LDB(B0, 1, 0); PG8_LDB(B1, 1, 1); PG8_SCHED; PG8_LDA(At, 1, 0); PG8_STAGE(PG8_SA(0, 1), a2 + hstepA, voffA);
            PG8_WAIT_V(8); PG8_WAIT_L(0); PG8_BAR; PG8_MMA(0, 0, At, B0); PG8_MMA(0, 1, At, B1); PG8_BAR; PG8_SCHED;
            PG8_LDA(At, 1, 1); PG8_STAGE(PG8_SB(1, 0), b3, voffB); PG8_STAGE(PG8_SB(1, 1), b3 + hstepB, voffB); PG8_STAGE(PG8_SA(1, 0), a3, voffA);
            PG8_WAIT_V(8); PG8_WAIT_L(0); PG8_BAR; PG8_MMA(1, 0, At, B0); PG8_MMA(1, 1, At, B1); PG8_BAR; PG8_SCHED;
        }
        if (wr == 0) PG8_BAR;
        E(acc, cur, wr, wc, fr, fq);
        if (!has_next) break;
#pragma unroll
        for (int a = 0; a < 2; ++a)
#pragma unroll
            for (int b = 0; b < 2; ++b)
#pragma unroll
                for (int m = 0; m < 4; ++m)
#pragma unroll
                    for (int n = 0; n < 2; ++n) acc[a][b][m][n] = (f32x4){0.f, 0.f, 0.f, 0.f};
        cur = nxt; cA = nA; cB = nB; ++ui;
        if (wr == 1) PG8_BAR;
    }
    PG8_WAIT_V(0);
    PG8_BAR;
#undef PG8_SA
#undef PG8_SB
#undef PG8_STAGE
#undef PG8_LDA
#undef PG8_LDB
#undef PG8_MMA
#undef PG8_WAIT_V
#undef PG8_WAIT_L
#undef PG8_BAR
#undef PG8_SCHED
}
}

#define EPI_ROW(u, ai, m) ((u).pm * 256 + (ai) * 128 + wr * 64 + (m) * 16 + fr)
#define EPI_COL(u, bj, n) ((u).pn * 256 + (bj) * 128 + wc * 32 + (n) * 16 + fq * 4)
typedef f32x4 Acc[2][2][4][2];

__device__ __forceinline__ u32x2 pack4(f32x4 v) { u32x2 w; w.x = cvt_pk(v[0], v[1]); w.y = cvt_pk(v[2], v[3]); return w; }
__device__ __forceinline__ f32x4 unpack4(u32x2 w) { f32x4 v; v[0] = bf2f(w.x & 0xffffu); v[1] = bf2f(w.x >> 16); v[2] = bf2f(w.y & 0xffffu); v[3] = bf2f(w.y >> 16); return v; }

template <bool WT> struct EpiInT {
    bf16_t* U; float* misc; const float* ss;
    __device__ __forceinline__ void st8(void* p, u32x2 v) const {
        if (WT) __hip_atomic_store((unsigned long long*)p, ((unsigned long long)v.y << 32) | v.x, RLX_AGENT); else *(u32x2*)p = v;
    }
    __device__ __forceinline__ void operator()(const Acc& acc, const pg8::Unit& u, int wr, int wc, int fr, int fq) const {
#pragma unroll
        for (int ai = 0; ai < 2; ++ai)
#pragma unroll
            for (int m = 0; m < 4; ++m) {
                const int row = EPI_ROW(u, ai, m); const float rs = rstd_of(ss, row);
                if (u.pn < 21) {
#pragma unroll
                    for (int bj = 0; bj < 2; ++bj)
#pragma unroll
                        for (int n = 0; n < 2; ++n) st8(U + (size_t)row * UW + EPI_COL(u, bj, n), pack4(acc[ai][bj][m][n] * rs));
                } else if (wc == 0) {
#pragma unroll
                    for (int n = 0; n < 2; ++n) { const f32x4 v = acc[ai][0][m][n] * rs; float* mp = misc + (size_t)row * 32 + n * 16 + fq * 4;
                        st8(mp, (u32x2){__float_as_uint(v[0]), __float_as_uint(v[1])}); st8(mp + 2, (u32x2){__float_as_uint(v[2]), __float_as_uint(v[3])}); }
                }
            }
    }
};
typedef EpiInT<false> EpiIn;
struct EpiGates {
    bf16_t* G; const float* ss;
    __device__ __forceinline__ void operator()(const Acc& acc, const pg8::Unit& u, int wr, int wc, int fr, int fq) const {
#pragma unroll
        for (int ai = 0; ai < 2; ++ai)
#pragma unroll
            for (int m = 0; m < 4; ++m) {
                const int row = EPI_ROW(u, ai, m); const float rs = rstd_of(ss, row);
#pragma unroll
                for (int bj = 0; bj < 2; ++bj)
#pragma unroll
                    for (int n = 0; n < 2; ++n) { f32x4 v = acc[ai][bj][m][n] * rs; v[0] = sigmoidf_(v[0]); v[1] = sigmoidf_(v[1]); v[2] = sigmoidf_(v[2]); v[3] = sigmoidf_(v[3]);
                        *(u32x2*)(G + (size_t)row * 4096 + EPI_COL(u, bj, n)) = pack4(v); }
            }
    }
};
struct EpiBrAll {
    bf16_t* MG; const bf16_t* G;
    __device__ __forceinline__ void operator()(const Acc& acc, const pg8::Unit& u, int wr, int wc, int fr, int fq) const {
        const int mb = u.pn >> 8, pn = u.pn & 255;
        if (mb > 0) asm volatile("s_waitcnt vmcnt(0)" ::: "memory");
#pragma unroll
        for (int ai = 0; ai < 2; ++ai)
#pragma unroll
            for (int m = 0; m < 4; ++m) {
                const int row = u.pm * 256 + ai * 128 + wr * 64 + m * 16 + fr;
#pragma unroll
                for (int bj = 0; bj < 2; ++bj)
#pragma unroll
                    for (int n = 0; n < 2; ++n) { const int col = pn * 256 + bj * 128 + wc * 32 + n * 16 + fq * 4;
                        const f32x4 g = unpack4(*(const u32x2*)(G + (size_t)row * 4096 + mb * 1024 + col));
                        f32x4 v = acc[ai][bj][m][n] * g;
                        bf16_t* mp = MG + (size_t)row * DM + col;
                        if (mb > 0) v += unpack4(ld_agent_u64(mp));
                        *(u32x2*)mp = pack4(v); }
                asm volatile("" ::: "memory");
            }
    }
};
template <bool WRITE_XB, bool ACC_SS> struct EpiRes {
    const float* xin; float* xo; bf16_t* xb; float* ss;
    __device__ __forceinline__ void operator()(const Acc& acc, const pg8::Unit& u, int wr, int wc, int fr, int fq) const {
#pragma unroll
        for (int ai = 0; ai < 2; ++ai)
#pragma unroll
            for (int m = 0; m < 4; ++m) {
                const int row = EPI_ROW(u, ai, m); float s = 0.f;
#pragma unroll
                for (int bj = 0; bj < 2; ++bj)
#pragma unroll
                    for (int n = 0; n < 2; ++n) { const size_t off = (size_t)row * DM + EPI_COL(u, bj, n);
                        const f32x4 v = *(const f32x4*)(xin + off) + acc[ai][bj][m][n];
                        *(f32x4*)(xo + off) = v;
                        if (WRITE_XB) *(u32x2*)(xb + off) = pack4(v);
                        if (ACC_SS) s += (v[0] * v[0] + v[1] * v[1]) + (v[2] * v[2] + v[3] * v[3]); }
                if (ACC_SS) { s += __shfl_xor(s, 16); s += __shfl_xor(s, 32); if (fq == 0) ss[(size_t)row * 16 + u.pn * 4 + wc] = s; }
                asm volatile("" ::: "memory");
            }
    }
};
template <bool MOE> struct EpiFfn1 {
    bf16_t* ACT; const float* ss;
    __device__ __forceinline__ void operator()(const Acc& acc, const pg8::Unit& u, int wr, int wc, int fr, int fq) const {
#pragma unroll
        for (int ai = 0; ai < 2; ++ai)
#pragma unroll
            for (int m = 0; m < 4; ++m) {
                const int row = EPI_ROW(u, ai, m); const float rs = MOE ? ss[row] : rstd_of(ss, row);
#pragma unroll
                for (int n = 0; n < 2; ++n) { const f32x4 g = acc[ai][0][m][n] * rs, up = acc[ai][1][m][n] * rs; f32x4 v;
                    v[0] = siluf_(g[0]) * up[0]; v[1] = siluf_(g[1]) * up[1]; v[2] = siluf_(g[2]) * up[2]; v[3] = siluf_(g[3]) * up[3];
                    *(u32x2*)(ACT + (size_t)row * D_FF + u.pn * 128 + wc * 32 + n * 16 + fq * 4) = pack4(v); }
            }
    }
};
template <bool SIG> struct EpiBf16 {
    bf16_t* O;
    __device__ __forceinline__ void operator()(const Acc& acc, const pg8::Unit& u, int wr, int wc, int fr, int fq) const {
#pragma unroll
        for (int ai = 0; ai < 2; ++ai)
#pragma unroll
            for (int m = 0; m < 4; ++m) {
                const int row = EPI_ROW(u, ai, m);
#pragma unroll
                for (int bj = 0; bj < 2; ++bj)
#pragma unroll
                    for (int n = 0; n < 2; ++n) { f32x4 v = acc[ai][bj][m][n];
                        if (SIG) { v[0] = sigmoidf_(v[0]); v[1] = sigmoidf_(v[1]); v[2] = sigmoidf_(v[2]); v[3] = sigmoidf_(v[3]); }
                        *(u32x2*)(O + (size_t)row * DM + EPI_COL(u, bj, n)) = pack4(v); }
            }
    }
};
template <bool WRITE_XB> struct EpiPle2 {
    float* xo; const bf16_t* G; bf16_t* xb; float* ss;
    __device__ __forceinline__ void operator()(const Acc& acc, const pg8::Unit& u, int wr, int wc, int fr, int fq) const {
#pragma unroll
        for (int ai = 0; ai < 2; ++ai)
#pragma unroll
            for (int m = 0; m < 4; ++m) {
                const int row = EPI_ROW(u, ai, m); float s = 0.f;
#pragma unroll
                for (int bj = 0; bj < 2; ++bj)
#pragma unroll
                    for (int n = 0; n < 2; ++n) { const size_t off = (size_t)row * DM + EPI_COL(u, bj, n);
                        const f32x4 g = unpack4(ld_agent_u64(G + off));
                        const f32x4 v = *(const f32x4*)(xo + off) + g * acc[ai][bj][m][n];
                        *(f32x4*)(xo + off) = v;
                        if (WRITE_XB) *(u32x2*)(xb + off) = pack4(v);
                        s += (v[0] * v[0] + v[1] * v[1]) + (v[2] * v[2] + v[3] * v[3]); }
                s += __shfl_xor(s, 16); s += __shfl_xor(s, 32); if (fq == 0) ss[(size_t)row * 16 + u.pn * 4 + wc] = s;
                asm volatile("" ::: "memory");
            }
    }
};

struct BatchSched {
    int pm, pn0, n; const char* A; const char* B; size_t a_tile, b_tile;
    __device__ bool next(int i, pg8::Unit& u) const { if (i >= n) return false; u.pm = pm; u.pn = pn0 + i; u.pa = A + (size_t)pm * a_tile; u.pb = B + (size_t)u.pn * b_tile; return true; }
};
struct InBatchSched {
    int pm, kind, i0, n; const char* A; const char* B; size_t a_tile, b_tile;
    __device__ bool next(int ii, pg8::Unit& u) const {
        if (ii >= n) return false;
        const int i = i0 + ii; int pn;
        if (kind == 0) pn = 11 + i;
        else if (kind == 1) pn = i < 6 ? i : 21;
        else pn = i < 5 ? 6 + i : 13 + i;
        u.pm = pm; u.pn = pn; u.pa = A + (size_t)pm * a_tile; u.pb = B + (size_t)pn * b_tile; return true;
    }
};
struct BranchSched {
    pg8::StaticOrder so; const char* Y; const char* PT; size_t a_tile, b_tile, a_br, b_br;
    __device__ bool next(int i, pg8::Unit& u) const {
        if (i >= 4) return false; int pm, pn; if (!so.next(0, pm, pn)) return false;
        u.pm = pm; u.pn = pn | (i << 8); u.pa = Y + (size_t)i * a_br + (size_t)pm * a_tile; u.pb = PT + (size_t)i * b_br + (size_t)pn * b_tile; return true;
    }
};
struct MoeTables { int ps1, ps2, ps3, ps4, ps5, ps6, ps7, ps8; };
__device__ __forceinline__ int moe_expert_of_row(const MoeTables& mt, int row) {
    return (row >= mt.ps1) + (row >= mt.ps2) + (row >= mt.ps3) + (row >= mt.ps4) + (row >= mt.ps5) + (row >= mt.ps6) + (row >= mt.ps7);
}
struct MoeSched {
    MoeTables mt; int nN, G, c; const char* A; const char* B; size_t a_tile, b_tile, b_expert;
    __device__ bool next(int i, pg8::Unit& u) const {
        const long L = (long)i * G + c; const int ntiles = mt.ps8 >> 8;
        if (L >= (long)ntiles * nN) return false;
        u.pm = (int)(L / nN); u.pn = (int)(L % nN);
        const int e = moe_expert_of_row(mt, u.pm * 256);
        u.pa = A + (size_t)u.pm * a_tile; u.pb = B + (size_t)e * b_expert + (size_t)u.pn * b_tile; return true;
    }
};

struct Args { const void* in[42]; float* out; unsigned char* ws; int ph_lo, ph_hi; };
typedef const __attribute__((address_space(4))) Args* KArgs;
__device__ __forceinline__ KArgs kargs() { KArgs p = (KArgs)__builtin_amdgcn_kernarg_segment_ptr(); asm volatile("" : "+s"(p)); return p; }
struct Frame {
    LAS unsigned char* lds; int tid, lane, wave, G, bid;
    unsigned char* ws; unsigned* ctl;
};
#define IN_F(k) ((const float*)KA->in[k])

constexpr int DEFER_ITEMS = 3472 + 16896;
struct TJob { const float* src; int ldw, K, ncols, ldt, mode; bf16_t* dst; const float* gain; };
__device__ __forceinline__ void tr_item(const TJob& J, LAS float* scr, int item, int lane) {
    const int nblk = J.ncols / 64, kb = item / nblk, nb = item % nblk, k0 = 64 * kb, n0 = 64 * nb;
    const int c = lane;
    const bool live = (J.mode != 3) || c < 32;
    const int scol = (J.mode == 3) ? (c < 8 ? 1536 + c : (c < 32 ? 2816 + c : 0)) : n0 + c;
    const float* sp = J.src + (size_t)k0 * J.ldw + scol;
    float v[64];
#pragma unroll
    for (int i = 0; i < 64; ++i) v[i] = sp[(size_t)i * J.ldw];
#pragma unroll
    for (int i = 0; i < 64; ++i) { float x = live ? v[i] : 0.f; if (J.gain) x *= J.gain[k0 + i]; scr[i * 65 + c] = x; }
    asm volatile("s_waitcnt lgkmcnt(0)" ::: "memory");
    int drow0 = n0;
    if (J.mode == 1 || J.mode == 2) drow0 = (n0 / 128) * 256 + (n0 % 128) + (J.mode == 2 ? 128 : 0);
    const int c8 = lane & 7;
#pragma unroll
    for (int j = 0; j < 8; ++j) { const int n = (lane >> 3) + 8 * j; const LAS float* sq = scr + (8 * c8) * 65 + n;
        u32x4 o; o.x = cvt_pk(sq[0 * 65], sq[1 * 65]); o.y = cvt_pk(sq[2 * 65], sq[3 * 65]); o.z = cvt_pk(sq[4 * 65], sq[5 * 65]); o.w = cvt_pk(sq[6 * 65], sq[7 * 65]);
        *(u32x4*)(J.dst + (size_t)(drow0 + n) * J.ldt + k0 + 8 * c8) = o; }
    asm volatile("s_waitcnt lgkmcnt(0)" ::: "memory");
}
constexpr int NJOBS = 32 + 3 + 24 + 8;
__device__ __forceinline__ bool job_deferred(int jid) { return (jid >= 16 && jid < 32) || (jid >= 35 && jid < 59); }
__device__ __forceinline__ bool get_job(KArgs KA, int jid, TJob& J) {
    unsigned char* ws = KA->ws;
    J.gain = nullptr; J.mode = 0;
    if (jid < 32) {
        const int L = jid >> 4, j = jid & 15;
        unsigned char* wa = ws + WS_WA + (size_t)L * WA_STRIDE;
        if (j <= 8) {
            const float* w = IN_F(4) + (size_t)L * DM * D_IN; J.ldw = D_IN; J.K = DM; J.ldt = DM; J.gain = IN_F(3) + L * DM;
            int sc, nc, dr;
            switch (j) { case 0: sc = 0; nc = 512; dr = 0; break; case 1: sc = 512; nc = 1024; dr = 512; break; case 2: sc = 1544; nc = 512; dr = 1536; break;
                case 3: sc = 2056; nc = 768; dr = 2048; break; case 4: sc = 2848; nc = 1792; dr = 2816; break; case 5: sc = 4640; nc = 512; dr = 4608; break;
                case 6: sc = 5152; nc = 256; dr = 5120; break; case 7: sc = 0; nc = 64; dr = 5376; J.mode = 3; break; default: sc = 5408; nc = 4096; dr = 0; break; }
            J.src = w + sc; J.ncols = nc; J.dst = (bf16_t*)(wa + (j == 8 ? WA_GATE : WA_IN)) + (size_t)dr * DM;
            return true;
        }
        if (j <= 12) { const int m = j - 9; J.src = IN_F(26 + m) + (size_t)L * 512 * DM; J.ldw = DM; J.K = 512; J.ncols = DM; J.ldt = 512; J.dst = (bf16_t*)(wa + WA_PT + (size_t)m * MiB); return true; }
        if (j == 13) { J.src = IN_F(30) + (size_t)L * DM * DM; J.ldw = DM; J.K = DM; J.ncols = DM; J.ldt = DM; J.dst = (bf16_t*)(wa + WA_OUT); return true; }
        if (j == 14) { J.src = IN_F(40) + (size_t)L * DM * DM; J.ldw = DM; J.K = DM; J.ncols = DM; J.ldt = DM; J.dst = (bf16_t*)(wa + WA_PG); return true; }
        J.src = IN_F(39) + (size_t)L * PLE * DM; J.ldw = DM; J.K = PLE; J.ncols = DM; J.ldt = PLE; J.dst = (bf16_t*)(wa + WA_PP); return true;
    }
    if (jid < 35) {
        const int j = jid - 32;
        if (j < 2) { J.src = IN_F(32 + j); J.ldw = D_FF; J.K = DM; J.ncols = D_FF; J.ldt = DM; J.gain = IN_F(31); J.mode = 1 + j; J.dst = (bf16_t*)(ws + WS_FGU); return true; }
        J.src = IN_F(34); J.ldw = DM; J.K = D_FF; J.ncols = DM; J.ldt = D_FF; J.dst = (bf16_t*)(ws + WS_FDN); return true;
    }
    if (jid < 59) {
        const int e = (jid - 35) / 3, j = (jid - 35) % 3;
        unsigned char* wb = ws + WS_WB + (size_t)e * WB_STRIDE;
        if (j < 2) { J.src = IN_F(36 + j) + (size_t)e * DM * D_FF; J.ldw = D_FF; J.K = DM; J.ncols = D_FF; J.ldt = DM; J.gain = IN_F(31) + DM; J.mode = 1 + j; J.dst = (bf16_t*)wb; return true; }
        J.src = IN_F(38) + (size_t)e * D_FF * DM; J.ldw = DM; J.K = D_FF; J.ncols = DM; J.ldt = D_FF; J.dst = (bf16_t*)(wb + WB_DN); return true;
    }
    {
        const int j = jid - 59, idx = j & 3;
        if (j < 4) { J.src = IN_F(12) + (size_t)idx * 2048 * 64; J.ldw = 64; J.K = 2048; J.ncols = 64; J.ldt = 2048; J.dst = (bf16_t*)(ws + WS_W1T) + (size_t)idx * 64 * 2048; return true; }
        J.src = IN_F(13) + (size_t)idx * 64 * 64; J.ldw = 64; J.K = 64; J.ncols = 64; J.ldt = 64; J.dst = (bf16_t*)(ws + WS_W2T) + (size_t)idx * 64 * 64; return true;
    }
}
__device__ UNIT_INLINE void p0_prologue(KArgs KA, Frame& F) {
    LAS float* scr = (LAS float*)(F.lds + F.wave * 16640);
    const int gw = F.bid * 8 + F.wave, NGW = F.G * 8;
    unsigned char* ws = KA->ws;
    {
        int jid = 0, loc = gw; TJob J; get_job(KA, 0, J); int nit = (J.K / 64) * (J.ncols / 64);
        for (;;) {
            while (jid < NJOBS && loc >= nit) { loc -= nit; ++jid; if (jid < NJOBS) { get_job(KA, jid, J); nit = job_deferred(jid) ? 0 : (J.K / 64) * (J.ncols / 64); } }
            if (jid >= NJOBS) break;
            tr_item(J, scr, loc, F.lane);
            loc += NGW;
        }
    }
    for (int L = 0; L < 2; ++L) {
        u32x4* z = (u32x4*)((bf16_t*)(ws + WS_WA + (size_t)L * WA_STRIDE + WA_IN) + (size_t)5440 * DM);
        const int n16 = 192 * DM * 2 / 16;
        for (int i = gw * 64 + F.lane; i < n16; i += NGW * 64) z[i] = (u32x4){0u, 0u, 0u, 0u};
    }
    for (int o = gw; o < 256; o += NGW) {
        const int idx = o >> 6, f = o & 63;
        const float* pe = IN_F(11) + (size_t)idx * 2048; const float* w1 = IN_F(12) + (size_t)idx * 2048 * 64 + f; float s = 0.f;
#pragma unroll 8
        for (int k = F.lane; k < 2048; k += 64) s += pe[k] * w1[(size_t)k * 64];
        s = wave_sum(s);
        if (F.lane == 0) ((float*)(ws + WS_PEB))[o] = s;
    }
    for (int i = gw * 64 + F.lane; i < 2 * 8 * 4 * 8 * 64; i += NGW * 64) {
        const int ln = i & 63, fr = (i >> 6) & 7, nt = (i >> 9) & 3, hh = (i >> 11) & 7, LL = i >> 14;
        const int cn = hh * 64 + 16 * nt + (ln & 15), kgl = ln >> 4;
        const float* W = (fr < 2) ? IN_F(16) + (size_t)LL * 64 * 512 : (fr < 4) ? IN_F(18) + (size_t)LL * 64 * 512 : IN_F(19) + (size_t)LL * 128 * 512;
        const int ks = (fr < 2) ? fr : (fr < 4) ? fr - 2 : fr - 4;
        u32x4 o;
#pragma unroll
        for (int j = 0; j < 4; ++j) { const int k = 32 * ks + 8 * kgl + 2 * j; o[j] = cvt_pk(W[(size_t)k * 512 + cn], W[(size_t)(k + 1) * 512 + cn]); }
        ((u32x4*)(ws + WS_LW))[i] = o;
    }
    {
        const float* x = IN_F(0); bf16_t* xb = (bf16_t*)(ws + WS_XB); float* ss = (float*)(ws + WS_SSP);
        for (int m = gw; m < T; m += NGW) {
            const f32x4* xr = (const f32x4*)(x + (size_t)m * DM) + F.lane; float s = 0.f;
            u32x2* o = (u32x2*)(xb + (size_t)m * DM) + F.lane;
#pragma unroll
            for (int j = 0; j < 4; ++j) { const f32x4 v = xr[64 * j]; s += (v[0] * v[0] + v[1] * v[1]) + (v[2] * v[2] + v[3] * v[3]); o[64 * j] = pack4(v); }
            s = wave_sum(s); if (F.lane < 16) ss[(size_t)m * 16 + F.lane] = (F.lane == 0) ? s : 0.f;
        }
    }
    {
        const int* pos = (const int*)KA->in[2]; float* rc = (float*)(ws + WS_ROPE); float* rsn = rc + (size_t)T * 32;
        for (int i = (gw * 64 + F.lane); i < T * 32; i += NGW * 64) {
            const int t = i >> 5, k = i & 31;
            const float inv = (float)exp2(-(double)k * (1.0 / 32.0) * 17.194602975157967);
            const float ang = (float)pos[t] * inv;
            rc[i] = cosf(ang); rsn[i] = sinf(ang);
        }
    }
}


__device__ UNIT_INLINE void deferred_convert(KArgs KA, Frame& F, unsigned* q, LAS unsigned* s_uid, int jlo, int jhi, int nitems) {
    LAS float* scr = (LAS float*)(F.lds + F.wave * 16640);
    for (;;) {
        __syncthreads();
        if (F.tid == 0) *s_uid = atomicAdd(q, 1u);
        __syncthreads();
        int loc = (int)*s_uid * 8 + F.wave;
        int jid = jlo; TJob J; bool found = false;
        for (; jid < jhi; ++jid) { if (!job_deferred(jid)) continue; get_job(KA, jid, J); const int nit = (J.K / 64) * (J.ncols / 64); if (loc < nit) { found = true; break; } loc -= nit; }
        if (found) tr_item(J, scr, loc, F.lane);
        if ((int)*s_uid * 8 >= nitems) break;
    }
}


__device__ __forceinline__ void dep_signal(unsigned* c0, unsigned* c1, bool leader) {
    asm volatile("s_waitcnt vmcnt(0)" ::: "memory");
    __syncthreads();
    if (leader) {
        __builtin_amdgcn_fence(__ATOMIC_RELEASE, "agent");
        asm volatile("s_waitcnt vmcnt(0)" ::: "memory");
        __hip_atomic_fetch_add(c0, 1u, __ATOMIC_RELAXED, __HIP_MEMORY_SCOPE_AGENT);
        if (c1) __hip_atomic_fetch_add(c1, 1u, __ATOMIC_RELAXED, __HIP_MEMORY_SCOPE_AGENT);
    }
}
__device__ __forceinline__ void dep_signal_wt(unsigned* c0, unsigned* c1, bool leader) {
    asm volatile("s_waitcnt vmcnt(0)" ::: "memory");
    __syncthreads();
    if (leader) { __hip_atomic_fetch_add(c0, 1u, __ATOMIC_RELAXED, __HIP_MEMORY_SCOPE_AGENT); if (c1) __hip_atomic_fetch_add(c1, 1u, __ATOMIC_RELAXED, __HIP_MEMORY_SCOPE_AGENT); }
}
__device__ __forceinline__ void dep_poll_lane(unsigned* c, unsigned target) {
    unsigned spins = 0;
    while (__hip_atomic_load(c, __ATOMIC_RELAXED, __HIP_MEMORY_SCOPE_AGENT) < target) { __builtin_amdgcn_s_sleep(2); if (++spins > (1u << 24)) break; }
}
__device__ __forceinline__ void dep_wait_lane(unsigned* c, unsigned target) {
    unsigned spins = 0;
    while (__hip_atomic_load(c, __ATOMIC_RELAXED, __HIP_MEMORY_SCOPE_AGENT) < target) { __builtin_amdgcn_s_sleep(2); if (++spins > (1u << 24)) break; }
    __builtin_amdgcn_fence(__ATOMIC_ACQUIRE, "agent");
    asm volatile("s_waitcnt vmcnt(0)" ::: "memory");
}
__device__ __forceinline__ void dep_wait(unsigned* c, unsigned target, bool leader) {
    if (leader) dep_poll_lane(c, target);
    __syncthreads();
}

__device__ UNIT_INLINE void rope_pass(Frame& F, bf16_t* U1, const float* rc, const float* rsn) {
    const int gt = F.bid * 512 + F.tid, NT = F.G * 512;
    for (int i = gt; i < T * 40; i += NT) {
        const int t = i / 40, r = i % 40, slot = r >> 2, ch = r & 3;
        bf16_t* base = U1 + (size_t)t * UW + (slot < 8 ? UC_SQ + slot * 64 : UC_SKV + (slot - 8) * 64) + ch * 8;
        const u32x4 a = *(const u32x4*)base, b = *(const u32x4*)(base + 32);
        const f32x4 c0 = *(const f32x4*)(rc + (size_t)t * 32 + ch * 8), c1 = *(const f32x4*)(rc + (size_t)t * 32 + ch * 8 + 4);
        const f32x4 s0 = *(const f32x4*)(rsn + (size_t)t * 32 + ch * 8), s1 = *(const f32x4*)(rsn + (size_t)t * 32 + ch * 8 + 4);
        float x1[8], x2[8], cs[8], sn[8];
#pragma unroll
        for (int j = 0; j < 4; ++j) { x1[2 * j] = bf2f(a[j] & 0xffffu); x1[2 * j + 1] = bf2f(a[j] >> 16); x2[2 * j] = bf2f(b[j] & 0xffffu); x2[2 * j + 1] = bf2f(b[j] >> 16);
            cs[j] = c0[j]; cs[4 + j] = c1[j]; sn[j] = s0[j]; sn[4 + j] = s1[j]; }
        u32x4 oa, ob;
#pragma unroll
        for (int j = 0; j < 4; ++j) {
            const float y1a = x1[2 * j] * cs[2 * j] - x2[2 * j] * sn[2 * j], y1b = x1[2 * j + 1] * cs[2 * j + 1] - x2[2 * j + 1] * sn[2 * j + 1];
            const float y2a = x2[2 * j] * cs[2 * j] + x1[2 * j] * sn[2 * j], y2b = x2[2 * j + 1] * cs[2 * j + 1] + x1[2 * j + 1] * sn[2 * j + 1];
            oa[j] = cvt_pk(y1a, y1b); ob[j] = cvt_pk(y2a, y2b);
        }
        *(u32x4*)base = oa; *(u32x4*)(base + 32) = ob;
    }
}
__device__ UNIT_INLINE void rope_slice(Frame& F, bf16_t* U1, const float* rc, const float* rsn, int slice) {
    for (int i = slice * 5120 + F.tid; i < (slice + 1) * 5120; i += 512) {
        const int t = i / 40, r = i % 40, slot = r >> 2, ch = r & 3;
        bf16_t* base = U1 + (size_t)t * UW + (slot < 8 ? UC_SQ + slot * 64 : UC_SKV + (slot - 8) * 64) + ch * 8;
        const u32x4 a = *(const u32x4*)base, b = *(const u32x4*)(base + 32);
        const f32x4 c0 = *(const f32x4*)(rc + (size_t)t * 32 + ch * 8), c1 = *(const f32x4*)(rc + (size_t)t * 32 + ch * 8 + 4);
        const f32x4 s0 = *(const f32x4*)(rsn + (size_t)t * 32 + ch * 8), s1 = *(const f32x4*)(rsn + (size_t)t * 32 + ch * 8 + 4);
        u32x4 oa, ob;
#pragma unroll
        for (int j = 0; j < 4; ++j) {
            const float xa = bf2f(a[j] & 0xffffu), xb = bf2f(a[j] >> 16), ya = bf2f(b[j] & 0xffffu), yb = bf2f(b[j] >> 16);
            const float ca = j < 2 ? c0[2 * j] : c1[2 * j - 4], cb = j < 2 ? c0[2 * j + 1] : c1[2 * j - 3], sa = j < 2 ? s0[2 * j] : s1[2 * j - 4], sb = j < 2 ? s0[2 * j + 1] : s1[2 * j - 3];
            oa[j] = cvt_pk(xa * ca - ya * sa, xb * cb - yb * sb); ob[j] = cvt_pk(ya * ca + xa * sa, yb * cb + xb * sb);
        }
        *(u32x4*)base = oa; *(u32x4*)(base + 32) = ob;
    }
}
__device__ UNIT_INLINE void compress_unit(Frame& F, int unit, int L, const bf16_t* U1, unsigned char* ws) {
    const int nc = unit & 3, kv = (unit >> 2) & 1, g = (unit >> 3) & 1, b = unit >> 4;
    const int n0 = nc * 32, tok0 = n0 * 16;
    LAS bf16_t* tok = (LAS bf16_t*)F.lds;
    LAS bf16_t* hid = (LAS bf16_t*)(F.lds + 528 * 72 * 2);
    const bf16_t* src = U1 + (size_t)(b * SEQ) * UW + UC_NKV + kv * 128 + g * 64;
    __syncthreads();
    for (int i = F.tid; i < 528 * 8; i += 512) { const int r = i >> 3, ch = i & 7; const int t = tok0 + r;
        u32x4 v = (u32x4){0u, 0u, 0u, 0u}; if (t < SEQ) v = *(const u32x4*)(src + (size_t)t * UW + ch * 8);
        *(LAS u32x4*)(tok + r * 72 + ch * 8) = v; }
    __syncthreads();
    const int idx = L * 2 + kv;
    const bf16_t* w1t = (const bf16_t*)(ws + WS_W1T) + (size_t)idx * 64 * 2048;
    const bf16_t* w2t = (const bf16_t*)(ws + WS_W2T) + (size_t)idx * 64 * 64;
    const float* peb = (const float*)(ws + WS_PEB) + idx * 64;
    const int mt = F.wave >> 2, ntile = F.wave & 3, r16 = F.lane & 15, kg = F.lane >> 4;
    f32x4 acc = (f32x4){0.f, 0.f, 0.f, 0.f};
    const int nl = mt * 16 + r16;
    const bf16_t* bp = w1t + (size_t)(ntile * 16 + r16) * 2048 + kg * 8;
#pragma unroll 4
    for (int ks = 0; ks < 64; ++ks) {
        const int l = ks >> 1, db = (ks & 1) * 32 + kg * 8;
        const bf16x8 a = *(const LAS bf16x8*)(tok + (16 * nl + l) * 72 + db);
        const bf16x8 bb = *(const bf16x8*)(bp + ks * 32);
        acc = __builtin_amdgcn_mfma_f32_16x16x32_bf16(a, bb, acc, 0, 0, 0);
    }
    { const int f = ntile * 16 + r16; const float pb = peb[f];
#pragma unroll
      for (int r = 0; r < 4; ++r) hid[(mt * 16 + 4 * kg + r) * 72 + f] = (bf16_t)f2bf(siluf_(acc[r] + pb)); }
    __syncthreads();
    f32x4 o = (f32x4){0.f, 0.f, 0.f, 0.f};
#pragma unroll
    for (int ks = 0; ks < 2; ++ks) {
        const bf16x8 a = *(const LAS bf16x8*)(hid + nl * 72 + ks * 32 + kg * 8);
        const bf16x8 bb = *(const bf16x8*)(w2t + (size_t)(ntile * 16 + r16) * 64 + ks * 32 + kg * 8);
        o = __builtin_amdgcn_mfma_f32_16x16x32_bf16(a, bb, o, 0, 0, 0);
    }
    bf16_t* dst = (bf16_t*)(ws + (kv ? WS_VC : WS_KC)) + (size_t)((b * 2 + g) * 128) * 64;
#pragma unroll
    for (int r = 0; r < 4; ++r) { const int n = n0 + mt * 16 + 4 * kg + r; dst[(size_t)n * 64 + ntile * 16 + r16] = (n < 127) ? (bf16_t)f2bf(o[r]) : (bf16_t)0; }
}

__device__ __forceinline__ int crow(int r, int hi) { return (r & 3) + 8 * (r >> 2) + 4 * hi; }
constexpr int KS_LD = 72;
struct AttnSt { float m, l; f32x16 o0, o1; };
__device__ __forceinline__ void attn_init(AttnSt& s) { s.m = -INFINITY; s.l = 0.f;
#pragma unroll
    for (int r = 0; r < 16; ++r) { s.o0[r] = 0.f; s.o1[r] = 0.f; } }
constexpr int TILE_EL = 64 * 64;
__device__ __forceinline__ void dma_kv(const bf16_t* Kg, int ldk, const bf16_t* Vg, int ldv, LAS bf16_t* Ks, LAS bf16_t* Vs, int wave, int lane) {
    const int key = 8 * wave + (lane >> 3), ch = (lane & 7) ^ (key & 7);
    __builtin_amdgcn_global_load_lds((const unsigned*)(Kg + (size_t)key * ldk + ch * 8), (LAS unsigned*)(Ks + wave * 512), 16, 0, 0);
    __builtin_amdgcn_global_load_lds((const unsigned*)(Vg + (size_t)key * ldv + ch * 8), (LAS unsigned*)(Vs + wave * 512), 16, 0, 0);
}
__device__ __forceinline__ int swz_el(int key, int chunk) { return key * 64 + ((chunk ^ (key & 7)) << 3); }
__device__ __forceinline__ void attn_scores(const LAS bf16_t* Ks, const bf16x8 (&qr)[4], f32x16& p0, f32x16& p1, int r32, int hi) {
#pragma unroll
    for (int r = 0; r < 16; ++r) { p0[r] = 0.f; p1[r] = 0.f; }
#pragma unroll
    for (int d0 = 0; d0 < 4; ++d0) {
        const bf16x8 k0 = *(const LAS bf16x8*)(Ks + swz_el(r32, 2 * d0 + hi));
        const bf16x8 k1 = *(const LAS bf16x8*)(Ks + swz_el(32 + r32, 2 * d0 + hi));
        p0 = __builtin_amdgcn_mfma_f32_32x32x16_bf16(k0, qr[d0], p0, 0, 0, 0);
        p1 = __builtin_amdgcn_mfma_f32_32x32x16_bf16(k1, qr[d0], p1, 0, 0, 0);
    }
}
typedef short v4i16_t __attribute__((ext_vector_type(4)));
__device__ __forceinline__ void attn_pv(const LAS bf16_t* Vs, const f32x16& p0, const f32x16& p1, f32x16& o0, f32x16& o1, int r32, int hi) {
    bf16x8 pa[4];
#pragma unroll
    for (int s = 0; s < 2; ++s) {
        u32x4 w0, w1;
#pragma unroll
        for (int j = 0; j < 4; ++j) { w0[j] = cvt_pk(p0[8 * s + 2 * j], p0[8 * s + 2 * j + 1]); w1[j] = cvt_pk(p1[8 * s + 2 * j], p1[8 * s + 2 * j + 1]); }
        pa[s] = __builtin_bit_cast(bf16x8, w0); pa[2 + s] = __builtin_bit_cast(bf16x8, w1);
    }
    const int lane = hi * 32 + r32;
    const int krow = 4 * hi + ((lane & 15) >> 2), cb = 2 * ((lane >> 4) & 1) + ((lane & 3) >> 1), sub = 4 * (lane & 1);
#pragma unroll
    for (int s = 0; s < 4; ++s) {
#pragma unroll
        for (int dh = 0; dh < 2; ++dh) {
            const int k0 = 16 * s + krow, k1 = k0 + 8;
            const s16x4 lo = __builtin_bit_cast(s16x4, __builtin_amdgcn_ds_read_tr16_b64_v4i16((LAS v4i16_t*)(Vs + swz_el(k0, 4 * dh + cb) + sub)));
            const s16x4 hi4 = __builtin_bit_cast(s16x4, __builtin_amdgcn_ds_read_tr16_b64_v4i16((LAS v4i16_t*)(Vs + swz_el(k1, 4 * dh + cb) + sub)));
            const bf16x8 vfr = (bf16x8){lo[0], lo[1], lo[2], lo[3], hi4[0], hi4[1], hi4[2], hi4[3]};
            if (dh == 0) o0 = __builtin_amdgcn_mfma_f32_32x32x16_bf16(pa[s], vfr, o0, 0, 0, 0);
            else         o1 = __builtin_amdgcn_mfma_f32_32x32x16_bf16(pa[s], vfr, o1, 0, 0, 0);
        }
    }
}
__device__ __forceinline__ void attn_online(const LAS bf16_t* Vt, f32x16& x0, f32x16& x1, AttnSt& st, LAS float* wsf, int r32, int hi) {
    float mx = -INFINITY;
#pragma unroll
    for (int r = 0; r < 16; ++r) mx = fmaxf(mx, fmaxf(x0[r], x1[r]));
    mx = fmaxf(mx, __shfl_xor(mx, 32));
    const float mn = fmaxf(st.m, mx), ms = (mn == -INFINITY) ? 0.f : mn;
    const float f = exp2f((st.m - ms) * LOG2E);
    if (hi == 0) wsf[r32] = f;
    float rs = 0.f;
#pragma unroll
    for (int r = 0; r < 16; ++r) { x0[r] = exp2f((x0[r] - ms) * LOG2E); x1[r] = exp2f((x1[r] - ms) * LOG2E); rs += x0[r] + x1[r]; }
    st.l = st.l * f + rs; st.m = mn;
    const LAS float* wr_ = wsf + 4 * hi;
#pragma unroll
    for (int r = 0; r < 16; ++r) { const float fr_ = wr_[(r & 3) + 8 * (r >> 2)]; st.o0[r] *= fr_; st.o1[r] *= fr_; }
    attn_pv(Vt, x0, x1, st.o0, st.o1, r32, hi);
}
__device__ __forceinline__ void attn_scale_rows(f32x16& o0, f32x16& o1, float inv, LAS float* wsf, int r32, int hi) {
    if (hi == 0) wsf[r32] = inv;
    const LAS float* wr_ = wsf + 4 * hi;
#pragma unroll
    for (int r = 0; r < 16; ++r) { const float f = wr_[(r & 3) + 8 * (r >> 2)]; o0[r] *= f; o1[r] *= f; }
}

__device__ UNIT_INLINE void swa_unit(Frame& F, int unit, const bf16_t* U1, bf16_t* Y, const float* sinks) {
    const int qb = unit & 31, g = (unit >> 5) & 1, b = unit >> 6;
    const int r32 = F.lane & 31, hi = F.lane >> 5, hr = F.wave >> 1, qs = F.wave & 1, head = g * 4 + hr;
    const int q0 = qb * 64, tq = q0 + qs * 32 + r32;
    LAS bf16_t* Ks = (LAS bf16_t*)F.lds; LAS bf16_t* Vt = Ks + TILE_EL; LAS bf16_t* Ks1 = Vt + TILE_EL; LAS bf16_t* Vt1 = Ks1 + TILE_EL;
    LAS float* wsf = (LAS float*)(F.lds + 4 * TILE_EL * 2) + F.wave * 32;
    const bf16_t* rowb = U1 + (size_t)(b * SEQ) * UW;
    bf16x8 qr[4];
#pragma unroll
    for (int d0 = 0; d0 < 4; ++d0) qr[d0] = *(const bf16x8*)(rowb + (size_t)tq * UW + UC_SQ + head * 64 + d0 * 16 + hi * 8);
    AttnSt st; attn_init(st);
    {
        const int kt0 = (qb >= 2 ? qb - 2 : 0);
        const bf16_t* kg = rowb + UC_SKV + g * 64; const bf16_t* vg = kg + 128;
        __syncthreads();
        dma_kv(kg + (size_t)(kt0 * 64) * UW, UW, vg + (size_t)(kt0 * 64) * UW, UW, Ks, Vt, F.wave, F.lane);
        __syncthreads();
        int cur = 0;
#pragma unroll 1
        for (int kt = kt0; kt <= qb; ++kt) {
            if (kt < qb) dma_kv(kg + (size_t)((kt + 1) * 64) * UW, UW, vg + (size_t)((kt + 1) * 64) * UW, UW, cur ? Ks : Ks1, cur ? Vt : Vt1, F.wave, F.lane);
            const LAS bf16_t* kc_ = cur ? Ks1 : Ks; const LAS bf16_t* vc_ = cur ? Vt1 : Vt;
            f32x16 x0, x1; attn_scores(kc_, qr, x0, x1, r32, hi);
#pragma unroll
            for (int r = 0; r < 16; ++r) { const int d0 = tq - (kt * 64 + crow(r, hi)), d1 = d0 - 32;
                x0[r] = (d0 >= 0 && d0 < 128) ? x0[r] * 0.125f : -INFINITY; x1[r] = (d1 >= 0 && d1 < 128) ? x1[r] * 0.125f : -INFINITY; }
            attn_online(vc_, x0, x1, st, wsf, r32, hi);
            __syncthreads();
            cur ^= 1;
        }
    }
    const float l = st.l + __shfl_xor(st.l, 32), sk = sinks[head];
    const float mf = fmaxf(st.m, sk), a = exp2f((st.m - mf) * LOG2E), inv = a / (l * a + exp2f((sk - mf) * LOG2E));
    attn_scale_rows(st.o0, st.o1, inv, wsf, r32, hi);
    bf16_t* yb = Y + (size_t)(b * SEQ + q0 + qs * 32) * YW + 3 * 512 + head * 64 + r32;
#pragma unroll
    for (int r = 0; r < 16; ++r) { bf16_t* yp = yb + (size_t)crow(r, hi) * YW; yp[0] = (bf16_t)f2bf(st.o0[r]); yp[32] = (bf16_t)f2bf(st.o1[r]); }
}

constexpr int NSA_K1_OFF = 2 * TILE_EL * 2;
constexpr int NSA_PS_OFF = 4 * TILE_EL * 2;
constexpr int NSA_IMP_OFF = NSA_PS_OFF + 64 * 128 * 4;
constexpr int NSA_SEL_OFF = NSA_IMP_OFF + 64 * 33 * 4;
__device__ __forceinline__ float nsa_gate(const float* gbase, int r, int i) { return sigmoidf_(gbase[((r & 3) + 8 * (r >> 2)) * 32 + i * 8]); }
__device__ UNIT_INLINE void nsa_unit(Frame& F, int unit, const bf16_t* U1, bf16_t* Y, const float* misc, const unsigned char* ws) {
    const int qb = 31 - (unit & 31), g = (unit >> 5) & 1, b = unit >> 6;
    const int r32 = F.lane & 31, hi = F.lane >> 5, hr = F.wave >> 1, qs = F.wave & 1, head = g * 4 + hr;
    const int q0 = qb * 64, ql = qs * 32 + r32, tq = q0 + ql;
    LAS bf16_t* Ks = (LAS bf16_t*)F.lds; LAS bf16_t* Vt = Ks + TILE_EL;
    LAS bf16_t* Ks1 = (LAS bf16_t*)(F.lds + NSA_K1_OFF); LAS bf16_t* Vt1 = Ks1 + TILE_EL;
    LAS unsigned* psum = (LAS unsigned*)(F.lds + NSA_PS_OFF);
    LAS float* impb = (LAS float*)(F.lds + NSA_IMP_OFF);
    LAS unsigned* selm = (LAS unsigned*)(F.lds + NSA_SEL_OFF);
    LAS float* wsf = (LAS float*)(F.lds + NSA_SEL_OFF + 256) + F.wave * 32;
    const bf16_t* rowb = U1 + (size_t)(b * SEQ) * UW;
    const int grow = b * SEQ + q0 + qs * 32;
    const float* gbase = misc + (size_t)(grow + 4 * hi) * 32 + 8 + head;
    bf16x8 qr[4];
#pragma unroll
    for (int d0 = 0; d0 < 4; ++d0) qr[d0] = *(const bf16x8*)(rowb + (size_t)tq * UW + UC_NQ + head * 64 + d0 * 16 + hi * 8);
    f32x16 ya0, ya1;
#pragma unroll
    for (int r = 0; r < 16; ++r) { ya0[r] = 0.f; ya1[r] = 0.f; }
    __syncthreads();
    for (int i = F.tid; i < 64 * 128; i += 512) psum[i] = 0u;
#ifndef NSA_NO_CMP
    {
        const bf16_t* kc = (const bf16_t*)(ws + WS_KC) + (size_t)((b * 2 + g) * 128) * 64;
        const bf16_t* vc = (const bf16_t*)(ws + WS_VC) + (size_t)((b * 2 + g) * 128) * 64;
        dma_kv(kc, 64, vc, 64, Ks, Vt, F.wave, F.lane);
        dma_kv(kc + 64 * 64, 64, vc + 64 * 64, 64, Ks1, Vt1, F.wave, F.lane);
        __syncthreads();
        float m = -INFINITY, l = 0.f;
#pragma unroll 1
        for (int tl = 0; tl < 2; ++tl) {
            f32x16 x0, x1; attn_scores(tl ? Ks1 : Ks, qr, x0, x1, r32, hi);
            float mx = -INFINITY;
#pragma unroll
            for (int r = 0; r < 16; ++r) { const int n0 = tl * 64 + crow(r, hi), n1 = n0 + 32;
                x0[r] = (16 * n0 + 31 <= tq) ? x0[r] * 0.125f : -INFINITY; x1[r] = (16 * n1 + 31 <= tq) ? x1[r] * 0.125f : -INFINITY; mx = fmaxf(mx, fmaxf(x0[r], x1[r])); }
            mx = fmaxf(mx, __shfl_xor(mx, 32));
            const float mn = fmaxf(m, mx), ms = (mn == -INFINITY) ? 0.f : mn;
            float rs = 0.f;
#pragma unroll
            for (int r = 0; r < 16; ++r) rs += exp2f((x0[r] - ms) * LOG2E) + exp2f((x1[r] - ms) * LOG2E);
            l = l * exp2f((m - ms) * LOG2E) + rs; m = mn;
        }
        l += __shfl_xor(l, 32);
        const float inv = l > 0.f ? 1.0f / l : 0.f, ms = (m == -INFINITY) ? 0.f : m;
        f32x16 oc0, oc1;
#pragma unroll
        for (int r = 0; r < 16; ++r) { oc0[r] = 0.f; oc1[r] = 0.f; }
#pragma unroll 1
        for (int tl = 0; tl < 2; ++tl) {
            f32x16 x0, x1; attn_scores(tl ? Ks1 : Ks, qr, x0, x1, r32, hi);
#pragma unroll
            for (int r = 0; r < 16; ++r) { const int n0 = tl * 64 + crow(r, hi), n1 = n0 + 32;
                x0[r] = (16 * n0 + 31 <= tq) ? exp2f((x0[r] * 0.125f - ms) * LOG2E) * inv : 0.f;
                x1[r] = (16 * n1 + 31 <= tq) ? exp2f((x1[r] * 0.125f - ms) * LOG2E) * inv : 0.f;
                atomicAdd((unsigned*)(psum + ql * 128 + n0), (unsigned)(x0[r] * 16777216.0f + 0.5f)); atomicAdd((unsigned*)(psum + ql * 128 + n1), (unsigned)(x1[r] * 16777216.0f + 0.5f)); }
            attn_pv(tl ? Vt1 : Vt, x0, x1, oc0, oc1, r32, hi);
        }
#pragma unroll
        for (int r = 0; r < 16; ++r) { const float gt = nsa_gate(gbase, r, 0); ya0[r] += gt * oc0[r]; ya1[r] += gt * oc1[r]; }
    }
#endif
    __syncthreads();
#ifndef NSA_NO_TOPK
    if (qb <= 7) { if (F.tid < 64) selm[F.tid] = (2u << qb) - 1u; }
    else {
        const int q = F.tid & 63, jg = F.tid >> 6;
#pragma unroll
        for (int jj = 0; jj < 4; ++jj) { const int j = jg * 4 + jj; unsigned sacc = 0u;
#pragma unroll
            for (int d = -1; d <= 3; ++d) { const int n = 4 * j + d; if (n >= 0 && n < 127) sacc += psum[q * 128 + n]; }
            impb[q * 33 + j] = (float)sacc; }
        if (jg == 0) selm[q] = 1u | (1u << qb);
        __syncthreads();
        unsigned bits = 0u;
#pragma unroll 1
        for (int jj = 0; jj < 4; ++jj) { const int j = jg * 4 + jj;
            if (j >= 1 && j < qb) { const float vj = impb[q * 33 + j]; int rank = 0;
#pragma unroll 1
                for (int i2 = 1; i2 < qb; ++i2) { const float vi = impb[q * 33 + i2]; rank += (vi > vj || (vi == vj && i2 < j)) ? 1 : 0; }
                if (rank < 6) bits |= 1u << j; } }
        if (bits) atomicOr((unsigned*)(selm + q), bits);
    }
#endif
    __syncthreads();
    unsigned uni;
    { unsigned v = selm[F.lane];
#pragma unroll
      for (int o = 1; o < 64; o <<= 1) v |= __shfl_xor(v, o);
      uni = __builtin_amdgcn_readfirstlane(v); }
    const unsigned mysel = selm[ql];
#pragma unroll 1
    for (int br = 0; br < 2; ++br) {
        const unsigned lowm = (qb >= 8) ? ~((1u << (qb - 8)) - 1u) : 0xffffffffu;
        const unsigned tmask = (br == 0) ? uni : (((2u << qb) - 1u) & lowm);
        const unsigned qsel = (br == 0) ? mysel : 0xffffffffu;
        const int wlim = (br == 0) ? (1 << 30) : 512;
        const int kcol = UC_NKV + (2 + 2 * br) * 128 + g * 64;
        AttnSt st; attn_init(st);
        {
            const bf16_t* kg = rowb + kcol; const bf16_t* vg = kg + 128;
            unsigned rem = tmask;
            int j = __builtin_ctz(rem); rem &= rem - 1u;
            __syncthreads();
            dma_kv(kg + (size_t)(j * 64) * UW, UW, vg + (size_t)(j * 64) * UW, UW, Ks, Vt, F.wave, F.lane);
            __syncthreads();
            int cur = 0;
#pragma unroll 1
            for (;;) {
                const int jn = rem ? __builtin_ctz(rem) : -1; rem &= rem - 1u;
                if (jn >= 0) dma_kv(kg + (size_t)(jn * 64) * UW, UW, vg + (size_t)(jn * 64) * UW, UW, cur ? Ks : Ks1, cur ? Vt : Vt1, F.wave, F.lane);
                const LAS bf16_t* kc_ = cur ? Ks1 : Ks; const LAS bf16_t* vc_ = cur ? Vt1 : Vt;
                f32x16 x0, x1; attn_scores(kc_, qr, x0, x1, r32, hi);
                const bool sel = (qsel >> j) & 1u;
#pragma unroll
                for (int r = 0; r < 16; ++r) { const int d0 = tq - (j * 64 + crow(r, hi)), d1 = d0 - 32;
                    x0[r] = (sel && d0 >= 0 && d0 < wlim) ? x0[r] * 0.125f : -INFINITY; x1[r] = (sel && d1 >= 0 && d1 < wlim) ? x1[r] * 0.125f : -INFINITY; }
                attn_online(vc_, x0, x1, st, wsf, r32, hi);
                __syncthreads();
                if (jn < 0) break;
                j = jn; cur ^= 1;
            }
        }
        const float l = st.l + __shfl_xor(st.l, 32), inv = l > 0.f ? 1.0f / l : 0.f;
        attn_scale_rows(st.o0, st.o1, inv, wsf, r32, hi);
#pragma unroll
        for (int r = 0; r < 16; ++r) { const float gt = nsa_gate(gbase, r, 1 + br); ya0[r] += gt * st.o0[r]; ya1[r] += gt * st.o1[r]; }
    }
    bf16_t* yb = Y + (size_t)grow * YW + 1 * 512 + head * 64 + r32;
#pragma unroll
    for (int r = 0; r < 16; ++r) { bf16_t* yp = yb + (size_t)crow(r, hi) * YW; yp[0] = (bf16_t)f2bf(ya0[r]); yp[32] = (bf16_t)f2bf(ya1[r]); }
}

__device__ __forceinline__ void ld4x16_sys(u32x4& a, u32x4& b, u32x4& c, u32x4& d, const void* pa, const void* pb, const void* pc, const void* pd) {
    asm volatile("global_load_dwordx4 %0, %4, off sc0 sc1\n\tglobal_load_dwordx4 %1, %5, off sc0 sc1\n\tglobal_load_dwordx4 %2, %6, off sc0 sc1\n\tglobal_load_dwordx4 %3, %7, off sc0 sc1\n\ts_waitcnt vmcnt(0)"
                 : "=&v"(a), "=&v"(b), "=&v"(c), "=&v"(d) : "v"(pa), "v"(pb), "v"(pc), "v"(pd) : "memory");
}
constexpr int SL = 136;
constexpr int SSD_CS = 0, SSD_BS = SSD_CS + 128 * SL * 2, SSD_BT = SSD_BS + 128 * SL * 2, SSD_XT = SSD_BT + 128 * SL * 2, SSD_PV = SSD_XT + 64 * SL * 2,
              SSD_DT = SSD_PV + 64 * SL * 2, SSD_AC = SSD_DT + 512, SSD_A = SSD_AC + 512, SSD_END = SSD_A + 512;
static_assert(SSD_END <= LDS_USER, "ssd lds");
__device__ UNIT_INLINE void ssd_unit(Frame& F, int unit, int L, KArgs KA, const bf16_t* U1, bf16_t* Y, const float* misc, float* ssq, unsigned* rdy) {
    const int h = unit & 7, b = unit >> 3, g = h >> 2;
    LAS bf16_t* Cs = (LAS bf16_t*)(F.lds + SSD_CS); LAS bf16_t* Bs = (LAS bf16_t*)(F.lds + SSD_BS); LAS bf16_t* Bt = (LAS bf16_t*)(F.lds + SSD_BT);
    LAS bf16_t* Xt = (LAS bf16_t*)(F.lds + SSD_XT); LAS bf16_t* Pv = (LAS bf16_t*)(F.lds + SSD_PV);
    LAS float* dts = (LAS float*)(F.lds + SSD_DT); LAS float* acs = (LAS float*)(F.lds + SSD_AC); LAS float* as_ = (LAS float*)(F.lds + SSD_A);
    const float* cw = IN_F(5) + (size_t)L * 4 * 1024; const float* cb = IN_F(6) + (size_t)L * 1024;
    const float dtb = IN_F(7)[L * 8 + h], Ah = -expf(IN_F(8)[L * 8 + h]), Dh = IN_F(9)[L * 8 + h];
    const int r16 = F.lane & 15, kg = F.lane >> 4, w = F.wave;
    const bf16_t* rowb = U1 + (size_t)(b * SEQ) * UW;
    f32x4 stt[4];
#pragma unroll
    for (int j = 0; j < 4; ++j) stt[j] = (f32x4){0.f, 0.f, 0.f, 0.f};
    __syncthreads();
    for (int i = F.tid; i < 64 * SL / 2; i += 512) ((LAS unsigned*)Pv)[i] = 0u;
    for (int c = 0; c < 16; ++c) {
        const int t0 = c * 128;
        __syncthreads();
        if (rdy && (c & 1) == 0) { if (F.tid == 0) dep_poll_lane(rdy + 64 * (8 * b + (c >> 1)), 7u); __syncthreads(); }
        for (int i = F.tid; i < 40 * 128; i += 512) {
            const int ch = i % 40, l = i / 40;
            const int cidx = (ch < 8) ? (h * 64 + ch * 8) : (ch < 24 ? 512 + g * 128 + (ch - 8) * 8 : 768 + g * 128 + (ch - 24) * 8);
            float a8[8];
            { const f32x4 b0 = *(const f32x4*)(cb + cidx), b1 = *(const f32x4*)(cb + cidx + 4);
#pragma unroll
              for (int j = 0; j < 4; ++j) { a8[j] = b0[j]; a8[4 + j] = b1[j]; } }
            u32x4 xq[4];
            { const int tb = t0 + l - 3; const bf16_t* pb_ = rowb + UC_XBC + cidx;
              xq[0] = *(const u32x4*)(pb_ + (size_t)(tb < 0 ? 0 : tb) * UW); xq[1] = *(const u32x4*)(pb_ + (size_t)(tb + 1 < 0 ? 0 : tb + 1) * UW); xq[2] = *(const u32x4*)(pb_ + (size_t)(tb + 2 < 0 ? 0 : tb + 2) * UW); xq[3] = *(const u32x4*)(pb_ + (size_t)(tb + 3) * UW); }
#pragma unroll
            for (int k = 0; k < 4; ++k) {
                const int t = t0 + l - 3 + k;
                if (t >= 0) {
                    const u32x4 xv = xq[k];
                    const f32x4 w0 = *(const f32x4*)(cw + k * 1024 + cidx), w1 = *(const f32x4*)(cw + k * 1024 + cidx + 4);
#pragma unroll
                    for (int j = 0; j < 4; ++j) { a8[2 * j] += bf2f(xv[j] & 0xffffu) * (j < 2 ? w0[2 * j] : w1[2 * j - 4]); a8[2 * j + 1] += bf2f(xv[j] >> 16) * (j < 2 ? w0[2 * j + 1] : w1[2 * j - 3]); }
                }
            }
            unsigned short o[8];
#pragma unroll
            for (int j = 0; j < 8; ++j) o[j] = (unsigned short)f2bf(siluf_(a8[j]));
            if (ch < 8) {
#pragma unroll
                for (int j = 0; j < 8; ++j) Xt[(ch * 8 + j) * SL + l] = o[j];
            } else if (ch < 24) {
                const int n0 = (ch - 8) * 8;
                u32x4 pk; pk.x = o[0] | ((unsigned)o[1] << 16); pk.y = o[2] | ((unsigned)o[3] << 16); pk.z = o[4] | ((unsigned)o[5] << 16); pk.w = o[6] | ((unsigned)o[7] << 16);
                *(LAS u32x4*)(Bs + l * SL + n0) = pk;
#pragma unroll
                for (int j = 0; j < 8; ++j) Bt[(n0 + j) * SL + l] = o[j];
            } else {
                const int n0 = (ch - 24) * 8;
                u32x4 pk; pk.x = o[0] | ((unsigned)o[1] << 16); pk.y = o[2] | ((unsigned)o[3] << 16); pk.z = o[4] | ((unsigned)o[5] << 16); pk.w = o[6] | ((unsigned)o[7] << 16);
                *(LAS u32x4*)(Cs + l * SL + n0) = pk;
            }
        }
        if (F.tid < 128) { const float dt = softplusf_(misc[(size_t)(b * SEQ + t0 + F.tid) * 32 + h] + dtb); dts[F.tid] = dt; as_[F.tid] = dt * Ah; }
        __syncthreads();
        if (F.tid < 128) { float s = 0.f; for (int j = 0; j <= F.tid; ++j) s += as_[j]; acs[F.tid] = s; }
        __syncthreads();
        f32x4 cbv[8];
#pragma unroll
        for (int j = 0; j < 8; ++j) cbv[j] = (f32x4){0.f, 0.f, 0.f, 0.f};
#pragma unroll
        for (int ks = 0; ks < 4; ++ks) {
            const bf16x8 a = *(const LAS bf16x8*)(Cs + (16 * w + r16) * SL + ks * 32 + kg * 8);
#pragma unroll
            for (int j = 0; j < 8; ++j) { const bf16x8 bb = *(const LAS bf16x8*)(Bs + (16 * j + r16) * SL + ks * 32 + kg * 8); cbv[j] = __builtin_amdgcn_mfma_f32_16x16x32_bf16(a, bb, cbv[j], 0, 0, 0); }
        }
        __syncthreads();
        LAS bf16_t* Ws = Bs;
#pragma unroll
        for (int j = 0; j < 8; ++j)
#pragma unroll
            for (int r = 0; r < 4; ++r) { const int l = 16 * w + 4 * kg + r, s = 16 * j + r16;
                const float wv = (s <= l) ? cbv[j][r] * __expf(acs[l] - acs[s]) * dts[s] : 0.f;
                Ws[l * SL + s] = (bf16_t)f2bf(wv); }
        __syncthreads();
        f32x4 yd[4], yo[4];
#pragma unroll
        for (int j = 0; j < 4; ++j) { yd[j] = (f32x4){0.f, 0.f, 0.f, 0.f}; yo[j] = (f32x4){0.f, 0.f, 0.f, 0.f}; }
#pragma unroll
        for (int ks = 0; ks < 4; ++ks) {
            const bf16x8 aw = *(const LAS bf16x8*)(Ws + (16 * w + r16) * SL + ks * 32 + kg * 8);
            const bf16x8 ac = *(const LAS bf16x8*)(Cs + (16 * w + r16) * SL + ks * 32 + kg * 8);
#pragma unroll
            for (int j = 0; j < 4; ++j) {
                const bf16x8 bx = *(const LAS bf16x8*)(Xt + (16 * j + r16) * SL + ks * 32 + kg * 8);
                const bf16x8 bp = *(const LAS bf16x8*)(Pv + (16 * j + r16) * SL + ks * 32 + kg * 8);
                yd[j] = __builtin_amdgcn_mfma_f32_16x16x32_bf16(aw, bx, yd[j], 0, 0, 0);
                yo[j] = __builtin_amdgcn_mfma_f32_16x16x32_bf16(ac, bp, yo[j], 0, 0, 0);
            }
        }
#pragma unroll
        for (int r = 0; r < 4; ++r) {
            const int l = 16 * w + 4 * kg + r; const float ea = __expf(acs[l]); const size_t trow = (size_t)(b * SEQ + t0 + l);
            float sq = 0.f;
#pragma unroll
            for (int j = 0; j < 4; ++j) { const int p = 16 * j + r16;
                const float x = bf2f(Xt[p * SL + l]);
                const float z = bf2f(rowb[(size_t)(t0 + l) * UW + UC_Z + h * 64 + p]);
                const float yv = (yd[j][r] + yo[j][r] * ea + Dh * x) * siluf_(z);
                sq += yv * yv;
                Y[trow * YW + h * 64 + p] = (bf16_t)f2bf(yv); }
            sq += __shfl_xor(sq, 1); sq += __shfl_xor(sq, 2); sq += __shfl_xor(sq, 4); sq += __shfl_xor(sq, 8);
            if (r16 == 0) ssq[trow * 8 + h] = sq;
        }
        __syncthreads();
        { const float aend = acs[127];
          for (int i = F.tid; i < 64 * 128; i += 512) { const int p = i >> 7, l = i & 127; Xt[p * SL + l] = (bf16_t)f2bf(bf2f(Xt[p * SL + l]) * dts[l] * __expf(aend - acs[l])); } }
        __syncthreads();
        { const float cd = __expf(acs[127]); const int pt = w & 3;
#pragma unroll
          for (int j = 0; j < 4; ++j) stt[j] *= cd;
#pragma unroll
          for (int ks = 0; ks < 4; ++ks) {
              const bf16x8 a = *(const LAS bf16x8*)(Xt + (16 * pt + r16) * SL + ks * 32 + kg * 8);
#pragma unroll
              for (int j = 0; j < 4; ++j) { const int nt = (w >> 2) * 4 + j; const bf16x8 bb = *(const LAS bf16x8*)(Bt + (16 * nt + r16) * SL + ks * 32 + kg * 8);
                  stt[j] = __builtin_amdgcn_mfma_f32_16x16x32_bf16(a, bb, stt[j], 0, 0, 0); }
          }
#pragma unroll
          for (int j = 0; j < 4; ++j) { const int nt = (w >> 2) * 4 + j;
#pragma unroll
              for (int r = 0; r < 4; ++r) Pv[(16 * pt + 4 * kg + r) * SL + 16 * nt + r16] = (bf16_t)f2bf(stt[j][r]); }
        }
    }
}

constexpr int RW_CT = 16, RW_NC = SEQ / RW_CT;
constexpr int RB_DEC = 0, RB_NB = 4096, RB_CC = 8192, RB_K = 12288, RB_R = 16384, RB_V = 20480, RB_G = 24576  , RB_BS = 26624, RB_SIZE = 26880;
constexpr int RW_OUT = 2 * RB_SIZE, RW_WDH = RW_OUT + 2 * 4096, RW_ADH = RW_WDH + 16 * 72 * 2, RW_GDH = RW_ADH + 16 * 72 * 2, RW_CONST = RW_GDH + 16 * 136 * 2  ,
              RW_MU = RW_CONST + 5 * 256  , RW_LW = RW_MU + 448 * 4  , RW_RAW = RW_LW + 32768,
              RAW_R = 0, RAW_K = 3072, RAW_V = 6144, RAW_L = 9216, RAW_SIZE = 18432, RW_END = RW_RAW + 2 * RAW_SIZE;
static_assert(RW_END <= LDS_USER && RW_RAW % 16 == 0 && RW_LW % 16 == 0, "rwkv lds");
template <int CTRL> __device__ __forceinline__ float dppf(float x) { return __int_as_float(__builtin_amdgcn_update_dpp(0, __float_as_int(x), CTRL, 0xf, 0xf, false)); }
__device__ __forceinline__ float reduce8(float x) { x += dppf<0xB1>(x); x += dppf<0x4E>(x); x += dppf<0x141>(x); return x; }
__device__ __forceinline__ float reduce16(float x) { x = reduce8(x); x += dppf<0x140>(x); return x; }
__device__ __forceinline__ float fast_tanh(float x) { const float e = __expf(2.0f * x); return 1.0f - 2.0f / (e + 1.0f); }
#define RW_BAR() do { asm volatile("s_waitcnt lgkmcnt(0)" ::: "memory"); __builtin_amdgcn_s_barrier(); asm volatile("" ::: "memory"); } while (0)
struct RwEarly { f32x2 nb[4], dc[4]; };
struct RwLate { f32x2 cc[4], kk[4], rr[4]; f32x2 vv; };
__device__ __forceinline__ void rw_load_early(RwEarly& v, const LAS unsigned char* buf, int ti, int kq) {
    const int o = (ti * 64 + kq * 8) * 4;
#pragma unroll
    for (int j = 0; j < 2; ++j) {
        const f32x4 a = *(const LAS f32x4*)(buf + RB_NB + o + 16 * j), b = *(const LAS f32x4*)(buf + RB_DEC + o + 16 * j);
        v.nb[2 * j] = (f32x2){a[0], a[1]}; v.nb[2 * j + 1] = (f32x2){a[2], a[3]}; v.dc[2 * j] = (f32x2){b[0], b[1]}; v.dc[2 * j + 1] = (f32x2){b[2], b[3]};
    }
}
__device__ __forceinline__ void rw_load_late(RwLate& v, const LAS unsigned char* buf, int ti, int kq, int rp) {
    const int o = (ti * 64 + kq * 8) * 4;
#pragma unroll
    for (int j = 0; j < 2; ++j) {
        const f32x4 c = *(const LAS f32x4*)(buf + RB_CC + o + 16 * j), d = *(const LAS f32x4*)(buf + RB_K + o + 16 * j), e = *(const LAS f32x4*)(buf + RB_R + o + 16 * j);
        v.cc[2 * j] = (f32x2){c[0], c[1]}; v.cc[2 * j + 1] = (f32x2){c[2], c[3]}; v.kk[2 * j] = (f32x2){d[0], d[1]}; v.kk[2 * j + 1] = (f32x2){d[2], d[3]};
        v.rr[2 * j] = (f32x2){e[0], e[1]}; v.rr[2 * j + 1] = (f32x2){e[2], e[3]};
    }
    v.vv = *(const LAS f32x2*)(buf + RB_V + (ti * 64 + 2 * rp) * 4);
}
__device__ __forceinline__ void rw_post(const LAS unsigned char* lds, const LAS unsigned char* buf, const LAS float* out, bf16_t* yrow0, int ti, int cg) {
    const int o = ti * 64 + cg * 4;
    const f32x4 x = *(const LAS f32x4*)(out + o), v = *(const LAS f32x4*)((const LAS float*)(buf + RB_V) + o);
    const u32x2 gq = *(const LAS u32x2*)((const LAS bf16_t*)(buf + RB_G) + o);
    const LAS float* cst = (const LAS float*)(lds + RW_CONST) + cg * 4;
    const f32x4 lw = *(const LAS f32x4*)(cst + 192), lb = *(const LAS f32x4*)(cst + 256);
    const float bs = ((const LAS float*)(buf + RB_BS))[ti];
    const float mean = reduce16((x[0] + x[1]) + (x[2] + x[3])) * (1.0f / 64.0f);
    const f32x4 d = x - mean;
    const float rstd = rsqrtf(reduce16((d[0] * d[0] + d[1] * d[1]) + (d[2] * d[2] + d[3] * d[3])) * (1.0f / 64.0f) + 64e-5f);
    const f32x4 g = unpack4(gq);
    const f32x4 y = (d * rstd * lw + lb + v * bs) * g;
    *(u32x2*)(yrow0 + (size_t)ti * YW + cg * 4) = pack4(y);
}
__device__ UNIT_INLINE void rwkv_unit(Frame& F, int unit, int L, KArgs KA, const bf16_t* U1, bf16_t* Y, unsigned* rdy) {
    const int h = unit & 7, b = unit >> 3;
    const bool scanner = F.wave < 4;
    LAS unsigned char* lds = F.lds;
    const bf16_t* rowb = U1 + (size_t)(b * SEQ) * UW + UC_RW;
    bf16_t* ybase = Y + (size_t)(b * SEQ) * YW + 2 * 512 + h * 64;
    const int rp = (F.tid >> 3) & 31, kq = F.tid & 7;
    f32x2 s0[4], s1[4];
#pragma unroll
    for (int j = 0; j < 4; ++j) { s0[j] = (f32x2){0.f, 0.f}; s1[j] = (f32x2){0.f, 0.f}; }
    const int ww = F.wave & 3, wtid = F.tid & 255, r16 = F.lane & 15, kg = F.lane >> 4;
    const int wti = wtid >> 4, wcg = wtid & 15;
    float w0n = 0.f, a0n = 0.f;
    __syncthreads();
    if (!scanner) { const int cn = h * 64 + 16 * ww + r16; w0n = IN_F(15)[L * 512 + cn]; a0n = IN_F(17)[L * 512 + cn]; }
    if (F.tid < 320) { const int v = F.tid >> 6; ((LAS float*)(lds + RW_CONST))[F.tid] = IN_F(20 + v)[L * 512 + h * 64 + (F.tid & 63)]; }
    if (F.tid < 448) { const int i = F.tid; const int col = i < 64 ? h * 64 + i : i < 128 ? 512 + h * 64 + (i - 64) : i < 192 ? 1024 + h * 64 + (i - 128) : 1536 + (i - 192);
        ((LAS float*)(lds + RW_MU))[i] = IN_F(14)[(size_t)L * 1792 + col]; }
    { const u32x4* lw = (const u32x4*)(KA->ws + WS_LW) + (size_t)((L * 8 + h) * 4) * 8 * 64;
      for (int i = F.tid; i < 2048; i += 512) *(LAS u32x4*)(lds + RW_LW + i * 16) = lw[i]; }
    asm volatile("s_waitcnt vmcnt(0)" ::: "memory");
    __syncthreads();
#define RW_DMA(cc) do { const int t0_ = (cc) * RW_CT - 1; LAS unsigned char* rb_ = lds + RW_RAW + ((cc) & 1) * RAW_SIZE; \
        _Pragma("unroll") for (int q_ = 0; q_ < 5; ++q_) { const int ix_ = ww + 4 * q_; if (ix_ < 18) { \
            int tok_, col_, dst_; \
            if (ix_ < 9) { const int kind_ = ix_ / 3, p_ = ix_ % 3; tok_ = 8 * p_ + (F.lane >> 3); col_ = kind_ * 512 + h * 64 + (F.lane & 7) * 8; dst_ = kind_ * 3072 + p_ * 1024; } \
            else { const int p_ = ix_ - 9; tok_ = 2 * p_ + (F.lane >> 5); col_ = 1536 + (F.lane & 31) * 8; dst_ = RAW_L + p_ * 1024; } \
            int t_ = t0_ + (tok_ > 16 ? 16 : tok_); t_ = t_ < 0 ? 0 : t_; \
            __builtin_amdgcn_global_load_lds((const unsigned*)(rowb + (size_t)t_ * UW + col_), (LAS unsigned*)(rb_ + dst_), 16, 0, 0); } } } while (0)
#pragma unroll 1
    for (int ck = -2; ck < RW_NC; ++ck) {
        LAS unsigned char* bcur = lds + (ck & 1) * RB_SIZE;
        LAS unsigned char* bnxt = lds + ((ck + 1) & 1) * RB_SIZE;
        LAS float* ocur = (LAS float*)(lds + RW_OUT + (ck & 1) * 4096); const LAS float* oprv = (const LAS float*)(lds + RW_OUT + ((ck + 1) & 1) * 4096);
        const bool do_scan = scanner && ck >= 0, do_post = !scanner && ck >= 1, do_prep = !scanner && ck + 1 >= 0 && ck + 1 < RW_NC, do_dma = !scanner && ck + 2 < RW_NC;
        RwEarly cur;
        if (do_scan) rw_load_early(cur, bcur, 0, kq);
#define RW_SCAN_SEG(T0) if (do_scan) { _Pragma("unroll") for (int ti = (T0); ti < (T0) + 4; ++ti) { \
            RwLate lt; rw_load_late(lt, bcur, ti, kq, rp); \
            RwEarly nx = cur; if (ti + 1 < RW_CT) rw_load_early(nx, bcur, ti + 1, kq); \
            f32x2 a0 = s0[0] * cur.nb[0], a1 = s1[0] * cur.nb[0]; \
            _Pragma("unroll") for (int j = 1; j < 4; ++j) { a0 += s0[j] * cur.nb[j]; a1 += s1[j] * cur.nb[j]; } \
            const float sa0 = reduce8(a0[0] + a0[1]), sa1 = reduce8(a1[0] + a1[1]); \
            _Pragma("unroll") for (int j = 0; j < 4; ++j) { s0[j] = s0[j] * cur.dc[j] + (lt.cc[j] * sa0 + lt.kk[j] * lt.vv[0]); s1[j] = s1[j] * cur.dc[j] + (lt.cc[j] * sa1 + lt.kk[j] * lt.vv[1]); } \
            f32x2 o0 = s0[0] * lt.rr[0], o1 = s1[0] * lt.rr[0]; \
            _Pragma("unroll") for (int j = 1; j < 4; ++j) { o0 += s0[j] * lt.rr[j]; o1 += s1[j] * lt.rr[j]; } \
            const float q0 = reduce8(o0[0] + o0[1]), q1 = reduce8(o1[0] + o1[1]); \
            if (kq == 0) *(LAS f32x2*)(ocur + ti * 64 + 2 * rp) = (f32x2){q0, q1}; \
            cur = nx; } }
        RW_SCAN_SEG(0)
        if (!scanner) asm volatile("s_waitcnt vmcnt(0)" ::: "memory");
        if (rdy && do_dma && ((ck + 2) & 15) == 0) dep_poll_lane(rdy + 64 * (8 * b + ((ck + 2) >> 4)), 7u);
        if (do_dma) RW_DMA(ck + 2);
        if (do_post) rw_post(lds, bnxt, oprv, ybase + (size_t)((ck - 1) * RW_CT) * YW, wti, wcg);
        RW_BAR();
        RW_SCAN_SEG(4)
        if (do_prep) {
            const LAS unsigned char* raw = lds + RW_RAW + ((ck + 1) & 1) * RAW_SIZE;
            const bool first = (ck + 1 == 0);
#pragma unroll
            for (int n = 0; n < 4; ++n) {
                const int i = wtid + 256 * n;
                if (i < 896) {
                    const int kind = i < 768 ? i >> 7 : 5;
                    const int idx = i - (kind < 5 ? kind * 128 : 640);
                    const int tok = kind < 5 ? idx >> 3 : idx >> 4, piece = kind < 5 ? idx & 7 : idx & 15;
                    int so, mo;
                    if (kind < 3) { so = kind * 3072 + (tok + 1) * 128 + piece * 16; mo = kind * 64 + piece * 8; }
                    else { const int lp = (kind == 3 ? 0 : kind == 4 ? 8 : 16) + piece; so = RAW_L + (tok + 1) * 512 + lp * 16; mo = 192 + lp * 8; }
                    const u32x4 rc = *(const LAS u32x4*)(raw + so);
                    u32x4 rv = *(const LAS u32x4*)(raw + so - (kind < 3 ? 128 : 512));
                    if (first && tok == 0) rv = (u32x4){0u, 0u, 0u, 0u};
                    const f32x4 m0 = *(const LAS f32x4*)((const LAS float*)(lds + RW_MU) + mo), m1 = *(const LAS f32x4*)((const LAS float*)(lds + RW_MU) + mo + 4);
                    float y[8];
#pragma unroll
                    for (int j = 0; j < 4; ++j) {
                        const float x0 = bf2f(rc[j] & 0xffffu), x1 = bf2f(rc[j] >> 16), p0 = bf2f(rv[j] & 0xffffu), p1 = bf2f(rv[j] >> 16);
                        y[2 * j] = x0 + (p0 - x0) * (j < 2 ? m0[2 * j] : m1[2 * j - 4]); y[2 * j + 1] = x1 + (p1 - x1) * (j < 2 ? m0[2 * j + 1] : m1[2 * j - 3]);
                    }
                    if (kind < 3) {
                        LAS float* dst = (LAS float*)(bnxt + (kind == 0 ? RB_R : kind == 1 ? RB_K : RB_V)) + tok * 64 + piece * 8;
                        *(LAS f32x4*)dst = (f32x4){y[0], y[1], y[2], y[3]}; *(LAS f32x4*)(dst + 4) = (f32x4){y[4], y[5], y[6], y[7]};
                    } else {
                        LAS bf16_t* dst;
                        if (kind == 3) { dst = (LAS bf16_t*)(lds + RW_WDH) + tok * 72 + piece * 8;
#pragma unroll
                            for (int j = 0; j < 8; ++j) y[j] = fast_tanh(y[j]); }
                        else if (kind == 4) dst = (LAS bf16_t*)(lds + RW_ADH) + tok * 72 + piece * 8;
                        else { dst = (LAS bf16_t*)(lds + RW_GDH) + tok * 136 + piece * 8;
#pragma unroll
                            for (int j = 0; j < 8; ++j) y[j] = sigmoidf_(y[j]); }
                        u32x4 pk; pk.x = cvt_pk(y[0], y[1]); pk.y = cvt_pk(y[2], y[3]); pk.z = cvt_pk(y[4], y[5]); pk.w = cvt_pk(y[6], y[7]);
                        *(LAS u32x4*)dst = pk;
                    }
                }
            }
        }
        RW_BAR();
        RW_SCAN_SEG(8)
        if (do_prep) {
            LAS float* sDEC = (LAS float*)(bnxt + RB_DEC); LAS float* sCC = (LAS float*)(bnxt + RB_CC); LAS bf16_t* sG = (LAS bf16_t*)(bnxt + RB_G);
            const LAS bf16_t* sWDh = (const LAS bf16_t*)(lds + RW_WDH); const LAS bf16_t* sADh = (const LAS bf16_t*)(lds + RW_ADH); const LAS bf16_t* sGDh = (const LAS bf16_t*)(lds + RW_GDH);
            const LAS bf16x8* Bf = (const LAS bf16x8*)(lds + RW_LW) + ww * 8 * 64 + F.lane;
            f32x4 aw = (f32x4){0.f, 0.f, 0.f, 0.f}, aa = aw, ag = aw;
#pragma unroll
            for (int ks = 0; ks < 2; ++ks) {
                const bf16x8 xw = *(const LAS bf16x8*)(sWDh + r16 * 72 + 32 * ks + 8 * kg), xa = *(const LAS bf16x8*)(sADh + r16 * 72 + 32 * ks + 8 * kg);
                aw = __builtin_amdgcn_mfma_f32_16x16x32_bf16(xw, Bf[ks * 64], aw, 0, 0, 0); aa = __builtin_amdgcn_mfma_f32_16x16x32_bf16(xa, Bf[(2 + ks) * 64], aa, 0, 0, 0);
            }
#pragma unroll
            for (int ks = 0; ks < 4; ++ks) { const bf16x8 xg = *(const LAS bf16x8*)(sGDh + r16 * 136 + 32 * ks + 8 * kg); ag = __builtin_amdgcn_mfma_f32_16x16x32_bf16(xg, Bf[(4 + ks) * 64], ag, 0, 0, 0); }
#pragma unroll
            for (int r = 0; r < 4; ++r) { const int o = (4 * kg + r) * 64 + 16 * ww + r16; sDEC[o] = aw[r] + w0n; sCC[o] = aa[r] + a0n; sG[o] = (bf16_t)f2bf(ag[r]); }
        }
        RW_BAR();
        RW_SCAN_SEG(12)
        if (do_prep) {
            const int o = wti * 64 + wcg * 4;
            LAS float* pDEC = (LAS float*)(bnxt + RB_DEC) + o; LAS float* pNB = (LAS float*)(bnxt + RB_NB) + o; LAS float* pCC = (LAS float*)(bnxt + RB_CC) + o;
            LAS float* pK = (LAS float*)(bnxt + RB_K) + o; const LAS float* pR = (const LAS float*)(bnxt + RB_R) + o;
            const LAS float* cst = (const LAS float*)(lds + RW_CONST) + wcg * 4;
            const f32x4 wp = *(const LAS f32x4*)pDEC, ap = *(const LAS f32x4*)pCC, kr = *(const LAS f32x4*)pK, rr = *(const LAS f32x4*)pR;
            const f32x4 ckk = *(const LAS f32x4*)cst, cka = *(const LAS f32x4*)(cst + 64), crk = *(const LAS f32x4*)(cst + 128);
            f32x4 dec, a, kk, k2;
#pragma unroll
            for (int j = 0; j < 4; ++j) {
                const float sp = (-wp[j] > 20.f) ? -wp[j] : __logf(1.0f + __expf(-wp[j]));
                dec[j] = __expf(-__expf(-sp - 0.5f)); a[j] = sigmoidf_(ap[j]);
            }
            kk = kr * ckk; k2 = kr * ((a - 1.0f) * cka + 1.0f);
            const f32x4 bb = rr * k2 * crk;
            const float sq = reduce16((kk[0] * kk[0] + kk[1] * kk[1]) + (kk[2] * kk[2] + kk[3] * kk[3]));
            const float bsum = reduce16((bb[0] + bb[1]) + (bb[2] + bb[3]));
            const float rn = 1.0f / fmaxf(sqrtf(sq), 1e-12f);
            const f32x4 kn = kk * rn;
            *(LAS f32x4*)pDEC = dec; *(LAS f32x4*)pNB = -kn; *(LAS f32x4*)pCC = kn * a; *(LAS f32x4*)pK = k2;
            if (wcg == 0) ((LAS float*)(bnxt + RB_BS))[wti] = bsum;
        }
        RW_BAR();
#undef RW_SCAN_SEG
    }
#undef RW_DMA
    if (!scanner) rw_post(lds, lds + RB_SIZE, (const LAS float*)(lds + RW_OUT + 4096), ybase + (size_t)(SEQ - RW_CT) * YW, wti, wcg);
}

__device__ UNIT_INLINE void ssd_fixup_and_pb(Frame& F, int L, KArgs KA, bf16_t* Y, const float* ssq, bf16_t* PB) {
    const int gt = F.bid * 512 + F.tid, NT = F.G * 512;
    const float* nw = IN_F(10) + (size_t)L * 512;
    for (int i = gt; i < T * 64; i += NT) {
        const int t = i >> 6, ch = i & 63, g = ch >> 5;
        const f32x4 q = *(const f32x4*)(ssq + (size_t)t * 8 + g * 4);
        const float rs = rsqrtf(((q[0] + q[1]) + (q[2] + q[3])) * (1.0f / 256.0f) + NORM_EPS);
        bf16_t* yp = Y + (size_t)t * YW + ch * 8;
        const u32x4 v = *(const u32x4*)yp; const f32x4 n0 = *(const f32x4*)(nw + ch * 8), n1 = *(const f32x4*)(nw + ch * 8 + 4);
        u32x4 o;
        o.x = cvt_pk(bf2f(v.x & 0xffffu) * rs * n0[0], bf2f(v.x >> 16) * rs * n0[1]); o.y = cvt_pk(bf2f(v.y & 0xffffu) * rs * n0[2], bf2f(v.y >> 16) * rs * n0[3]);
        o.z = cvt_pk(bf2f(v.z & 0xffffu) * rs * n1[0], bf2f(v.z >> 16) * rs * n1[1]); o.w = cvt_pk(bf2f(v.w & 0xffffu) * rs * n1[2], bf2f(v.w >> 16) * rs * n1[3]);
        *(u32x4*)yp = o;
    }
    const float* p = IN_F(1) + (size_t)L * T * PLE;
    for (int i = gt; i < T * PLE / 8; i += NT) {
        const f32x4 a = *(const f32x4*)(p + (size_t)i * 8), b = *(const f32x4*)(p + (size_t)i * 8 + 4);
        u32x4 o; o.x = cvt_pk(a[0], a[1]); o.y = cvt_pk(a[2], a[3]); o.z = cvt_pk(b[0], b[1]); o.w = cvt_pk(b[2], b[3]);
        *(u32x4*)(PB + (size_t)i * 8) = o;
    }
}
__device__ UNIT_INLINE void moe_router(Frame& F, KArgs KA, const float* xo, unsigned* cnt, int* toke, int* tokp, float* tokw) {
    const int gw = F.bid * 8 + F.wave, NGW = F.G * 8;
    const float* gff = IN_F(31) + DM; const float* router = IN_F(35);
    for (int m = gw; m < T; m += NGW) {
        const f32x4* xr = (const f32x4*)(xo + (size_t)m * DM) + F.lane; f32x4 v[4]; float s = 0.f;
#pragma unroll
        for (int j = 0; j < 4; ++j) { v[j] = xr[64 * j]; s += (v[j][0] * v[j][0] + v[j][1] * v[j][1]) + (v[j][2] * v[j][2] + v[j][3] * v[j][3]); }
        const float rstd = rsqrtf(wave_sum(s) * (1.0f / DM) + NORM_EPS);
        float lg[8];
#pragma unroll
        for (int e = 0; e < 8; ++e) lg[e] = 0.f;
#pragma unroll
        for (int j = 0; j < 4; ++j) { const f32x4 gg = *((const f32x4*)gff + F.lane + 64 * j);
#pragma unroll
            for (int i = 0; i < 4; ++i) { const int k = 4 * F.lane + 256 * j + i; const float hv = v[j][i] * rstd * gg[i];
                const f32x4 r0 = *(const f32x4*)(router + (size_t)k * 8), r1 = *(const f32x4*)(router + (size_t)k * 8 + 4);
                lg[0] += hv * r0[0]; lg[1] += hv * r0[1]; lg[2] += hv * r0[2]; lg[3] += hv * r0[3]; lg[4] += hv * r1[0]; lg[5] += hv * r1[1]; lg[6] += hv * r1[2]; lg[7] += hv * r1[3]; } }
#pragma unroll
        for (int e = 0; e < 8; ++e) lg[e] = wave_sum(lg[e]);
        if (F.lane == 0) {
            int e1 = 0; float v1 = lg[0];
#pragma unroll
            for (int e = 1; e < 8; ++e) if (lg[e] > v1) { v1 = lg[e]; e1 = e; }
            int e2 = -1; float v2 = -INFINITY;
#pragma unroll
            for (int e = 0; e < 8; ++e) if (e != e1 && lg[e] > v2) { v2 = lg[e]; e2 = e; }
            const float ex = __expf(v2 - v1), w1 = 1.0f / (1.0f + ex), w2 = ex / (1.0f + ex);
            const int p1 = (int)atomicAdd(cnt + 64 * e1, 1u), p2 = (int)atomicAdd(cnt + 64 * e2, 1u);
            toke[2 * m] = e1; toke[2 * m + 1] = e2; tokp[2 * m] = p1; tokp[2 * m + 1] = p2; tokw[2 * m] = w1; tokw[2 * m + 1] = w2;
        }
    }
}
__device__ __forceinline__ void moe_tables(const unsigned* cnt, MoeTables& mt, int (&c)[8]) {
#pragma unroll
    for (int e = 0; e < 8; ++e) c[e] = (int)__hip_atomic_load(cnt + 64 * e, RLX_AGENT);
    int ps = 0;
    ps += (c[0] + 255) & ~255; mt.ps1 = ps; ps += (c[1] + 255) & ~255; mt.ps2 = ps; ps += (c[2] + 255) & ~255; mt.ps3 = ps; ps += (c[3] + 255) & ~255; mt.ps4 = ps;
    ps += (c[4] + 255) & ~255; mt.ps5 = ps; ps += (c[5] + 255) & ~255; mt.ps6 = ps; ps += (c[6] + 255) & ~255; mt.ps7 = ps; ps += (c[7] + 255) & ~255; mt.ps8 = ps;
}
__device__ __forceinline__ int moe_pstart(const MoeTables& mt, int e) {
    return e == 0 ? 0 : e == 1 ? mt.ps1 : e == 2 ? mt.ps2 : e == 3 ? mt.ps3 : e == 4 ? mt.ps4 : e == 5 ? mt.ps5 : e == 6 ? mt.ps6 : mt.ps7;
}
__device__ UNIT_INLINE void moe_slots(Frame& F, const float* xo, const float* ss2, const unsigned* cnt, const int* toke, const int* tokp, int* toks, bf16_t* XG, float* srstd) {
    const int gw = F.bid * 8 + F.wave, NGW = F.G * 8;
    MoeTables mt; int c[8]; moe_tables(cnt, mt, c);
    for (int m = gw; m < T; m += NGW) {
        const f32x4* xr = (const f32x4*)(xo + (size_t)m * DM) + F.lane; u32x2 pk[4];
#pragma unroll
        for (int j = 0; j < 4; ++j) pk[j] = pack4(xr[64 * j]);
        const float rs = rstd_of(ss2, m);
#pragma unroll
        for (int k = 0; k < 2; ++k) {
            const int e = toke[2 * m + k], slot = moe_pstart(mt, e) + tokp[2 * m + k];
            u32x2* o = (u32x2*)(XG + (size_t)slot * DM) + F.lane;
#pragma unroll
            for (int j = 0; j < 4; ++j) o[64 * j] = pk[j];
            if (F.lane == 0) { toks[2 * m + k] = slot; srstd[slot] = rs; }
        }
    }
    for (int idx = gw; idx < 8 * 256; idx += NGW) {
        const int e = idx >> 8, r = idx & 255;
        int ce = 0;
#pragma unroll
        for (int q = 0; q < 8; ++q) if (q == e) ce = c[q];
        const int row = moe_pstart(mt, e) + ce + r, end = (e == 7) ? mt.ps8 : moe_pstart(mt, e + 1);
        if (row < end) { u32x2* o = (u32x2*)(XG + (size_t)row * DM) + F.lane;
#pragma unroll
            for (int j = 0; j < 4; ++j) o[64 * j] = (u32x2){0u, 0u};
            if (F.lane == 0) srstd[row] = 0.f; }
    }
}
__device__ UNIT_INLINE void moe_combine(Frame& F, float* xo, const bf16_t* YB, const int* toks, const float* tokw, bf16_t* XB2) {
    const int gw = F.bid * 8 + F.wave, NGW = F.G * 8;
    for (int m = gw; m < T; m += NGW) {
        const int s0 = toks[2 * m], s1 = toks[2 * m + 1]; const float w0 = tokw[2 * m], w1 = tokw[2 * m + 1];
        f32x4* xr = (f32x4*)(xo + (size_t)m * DM) + F.lane; const u32x2* y0 = (const u32x2*)(YB + (size_t)s0 * DM) + F.lane; const u32x2* y1 = (const u32x2*)(YB + (size_t)s1 * DM) + F.lane;
        u32x2* xb = (u32x2*)(XB2 + (size_t)m * DM) + F.lane;
#pragma unroll
        for (int j = 0; j < 4; ++j) { const f32x4 v = xr[64 * j] + (unpack4(y0[64 * j]) * w0 + unpack4(y1[64 * j]) * w1); xr[64 * j] = v; xb[64 * j] = pack4(v); }
    }
}
__device__ UNIT_INLINE void final_norm(Frame& F, KArgs KA, float* xo) {
    const int gw = F.bid * 8 + F.wave, NGW = F.G * 8; const float* gf = IN_F(41);
    for (int m = gw; m < T; m += NGW) {
        f32x4* xr = (f32x4*)(xo + (size_t)m * DM) + F.lane; f32x4 v[4]; float s = 0.f;
#pragma unroll
        for (int j = 0; j < 4; ++j) { v[j] = xr[64 * j]; s += (v[j][0] * v[j][0] + v[j][1] * v[j][1]) + (v[j][2] * v[j][2] + v[j][3] * v[j][3]); }
        const float rstd = rsqrtf(wave_sum(s) * (1.0f / DM) + NORM_EPS);
#pragma unroll
        for (int j = 0; j < 4; ++j) xr[64 * j] = v[j] * rstd * *((const f32x4*)gf + F.lane + 64 * j);
    }
}


#define XB_TMO      128
#define XB_XCNT(j)  (256  + 64 * (j))
#define XB_XSUB(j)  (1280 + 64 * (j))
#define XB_XGEN(j)  (2304 + 64 * (j))
#define XB_TOP      3328
#define XB_TOPGEN   3392
#define XCD_BAR_WORDS 3456
#define XB_SPIN_CAP (1u << 22)
__device__ __forceinline__ unsigned xb_ld(unsigned* p)              { return __hip_atomic_load(p, __ATOMIC_RELAXED, __HIP_MEMORY_SCOPE_AGENT); }
__device__ __forceinline__ unsigned xb_add(unsigned* p, unsigned v) { return __hip_atomic_fetch_add(p, v, __ATOMIC_RELAXED, __HIP_MEMORY_SCOPE_AGENT); }
__device__ __forceinline__ unsigned xb_xcc_id() { return (unsigned)__builtin_amdgcn_s_getreg((3 << 11) | 20) & 0xFu; }
#define XB_SPIN(cond, bar) do { unsigned _sp = 0; while (cond) { __builtin_amdgcn_s_sleep(1); \
    if ((++_sp & 255u) == 0u) { if (xb_ld(&(bar)[XB_TMO])) break; if (_sp > XB_SPIN_CAP) { atomicAdd(&(bar)[XB_TMO], 1u); break; } } } } while (0)
struct XcdBarrier { unsigned* bar; unsigned x; volatile LAS unsigned* st; };
__device__ __forceinline__ XcdBarrier xcd_barrier_post(unsigned* bar, volatile LAS unsigned* st) {
    XcdBarrier b; b.bar = bar; b.x = xb_xcc_id(); b.st = st;
    if (threadIdx.x == 0) (void)xb_add(&bar[XB_XCNT(b.x)], 1u);
    return b;
}
__device__ __forceinline__ void xcd_barrier_complete(unsigned* bar, unsigned x, unsigned& nloc, unsigned& nx) {
    const unsigned G = gridDim.x * gridDim.y * gridDim.z;
    unsigned sum, cnt, mine, sp = 0u;
    for (;;) {
        sum = 0u; cnt = 0u; mine = 0u;
#pragma unroll
        for (unsigned j = 0; j < 16; ++j) { const unsigned c = xb_ld(&bar[XB_XCNT(j)]); sum += c; cnt += (c > 0u) ? 1u : 0u; mine = (j == x) ? c : mine; }
        if (sum == G) break;
        __builtin_amdgcn_s_sleep(1);
        if ((++sp & 255u) == 0u) { if (xb_ld(&bar[XB_TMO])) break; if (sp > XB_SPIN_CAP) { atomicAdd(&bar[XB_TMO], 1u); break; } }
    }
    nloc = mine > 0u ? mine : 1u; nx = cnt > 0u ? cnt : 1u;
}
__device__ __forceinline__ void xcd_barrier(const XcdBarrier& b, bool leader) {
    asm volatile("s_waitcnt vmcnt(0)" ::: "memory");
    __syncthreads();
    if (leader) {
        unsigned* bar = b.bar;
        __builtin_amdgcn_s_waitcnt(0);
        unsigned nloc = b.st[0], nx = b.st[1];
        if (nloc == 0u) { xcd_barrier_complete(bar, b.x, nloc, nx); b.st[0] = nloc; b.st[1] = nx; }
        const unsigned old = xb_add(&bar[XB_XSUB(b.x)], 1u);
        const unsigned gen = old / nloc;
        if (old + 1u == (gen + 1u) * nloc) {
            __builtin_amdgcn_fence(__ATOMIC_RELEASE, "agent");
            asm volatile("s_waitcnt vmcnt(0)" ::: "memory");
            const unsigned og = xb_add(&bar[XB_TOP], 1u);
            const unsigned tg = og / nx;
            if (og + 1u == (tg + 1u) * nx) xb_add(&bar[XB_TOPGEN], 1u);
            else XB_SPIN(xb_ld(&bar[XB_TOPGEN]) == tg, bar);
            __builtin_amdgcn_fence(__ATOMIC_ACQUIRE, "agent");
            xb_add(&bar[XB_XGEN(b.x)], 1u);
            asm volatile("s_waitcnt vmcnt(0)" ::: "memory");
        } else {
            XB_SPIN(xb_ld(&bar[XB_XGEN(b.x)]) == gen, bar);
            __builtin_amdgcn_fence(__ATOMIC_ACQUIRE, "agent");
            asm volatile("s_waitcnt vmcnt(0)" ::: "memory");
        }
    }
    __syncthreads();
}

constexpr int NPH = 23;
__device__ __forceinline__ unsigned char* opq(unsigned char* p) { asm volatile("" : "+s"(p)); return p; }
__global__ void __launch_bounds__(512, 2) mega_fwd(Args args) {
    extern __shared__ __attribute__((aligned(16))) unsigned char lds_raw[];
    Frame F;
    F.lds = (LAS unsigned char*)lds_raw; F.tid = 0; F.lane = 0; F.wave = __builtin_amdgcn_readfirstlane((int)threadIdx.x >> 6);
    F.G = gridDim.x; F.bid = blockIdx.x; F.ws = nullptr; F.ctl = nullptr;
    const int lo = args.ph_lo, hi = args.ph_hi;
    LAS unsigned* s_uid = (LAS unsigned*)(F.lds + LDS_USER + 64);
    if (threadIdx.x < 16) ((LAS unsigned*)(F.lds + LDS_USER))[threadIdx.x] = 0u;
    __syncthreads();
    (void)xcd_barrier_post((unsigned*)(args.ws + WS_CTL) + CW_BAR, (volatile LAS unsigned*)(F.lds + LDS_USER + 32));
#if MK_MULTI
#define GSYNC(k) do {} while (0)
#else
#define GSYNC(k) do { if ((k) + 1 < hi || rep_ + 1 < ((k) == REP_PH ? REP_N : 1)) { if ((k) == 0) cg::this_grid().sync(); else { XcdBarrier xb_; xb_.bar = (unsigned*)(KA->ws + WS_CTL) + CW_BAR; xb_.x = xb_xcc_id(); xb_.st = (volatile LAS unsigned*)(P.lds + LDS_USER + 32); xcd_barrier(xb_, P.tid == 0); } } } while (0)
#endif
#ifdef ONLY_PH
#define RUN(k) ((k) == ONLY_PH)
#else
#define RUN(k) (lo <= (k) && (k) < hi)
#endif
#define REPS(k) for (int rep_ = 0; rep_ < ((k) == REP_PH ? REP_N : 1); ++rep_)
#define PH_PTRS KArgs KA = kargs(); unsigned char* ws = KA->ws; float* out = KA->out; (void)out; \
    Frame P = F; asm volatile("" : "+s"(P.G), "+s"(P.bid), "+s"(P.wave)); asm volatile("v_mbcnt_lo_u32_b32 %0, -1, 0\n\tv_mbcnt_hi_u32_b32 %0, -1, %0" : "=v"(P.lane)); P.tid = P.wave * 64 + P.lane; \
    unsigned char* wa = ws + WS_WA + (size_t)L * WA_STRIDE; (void)wa; float* ssb = (float*)(ws + WS_SSP); \
    float* ss1 = ssb + (size_t)(2 * L) * T * 16; float* ss2 = ssb + (size_t)(2 * L + 1) * T * 16; float* ssn = ssb + (size_t)(2 * L + 2) * T * 16; (void)ss1; (void)ss2; (void)ssn; \
    bf16_t* XB = (bf16_t*)(ws + WS_XB); bf16_t* Y = (bf16_t*)(ws + WS_Y); bf16_t* U1 = (bf16_t*)(ws + WS_U1); (void)XB; (void)Y; (void)U1; \
    bf16_t* GATES = (bf16_t*)(ws + (L == 0 ? WS_WB : WS_GATES)); bf16_t* MERGED = (bf16_t*)(ws + WS_MERGED); bf16_t* PB = (bf16_t*)(ws + WS_PB); (void)GATES; (void)MERGED; (void)PB; \
    float* MISC = (float*)(ws + WS_MISC); float* SSQ = (float*)(ws + WS_SSQ); (void)MISC; (void)SSQ; \
    bf16_t* XB2 = (bf16_t*)(ws + (L == 0 ? WS_XB2_L0 : WS_XB2_L1)); (void)XB2;
    const size_t TILE1K = (size_t)256 * 1024 * 2;
    if (RUN(0)) REPS(0) { const int L = 0; PH_PTRS p0_prologue(KA, P); GSYNC(0); }
#pragma unroll 1
    for (int L = 0; L < 2; ++L) {
        const int pb0 = 1 + (L == 0 ? 0 : 9);
        if (RUN(pb0)) REPS(pb0) { PH_PTRS
            pg8::DenseSched S; S.so.init(64, 22, P.G, P.bid); S.A = (const char*)XB; S.B = (const char*)(wa + WA_IN); S.a_tile = TILE1K; S.b_tile = TILE1K;
            EpiIn E{U1, MISC, ss1};
            pg8::gemm_phase(P.lds, DM, DM, DM, S, E); GSYNC(pb0);
        }
        if (RUN(pb0 + 2)) REPS(pb0 + 2) {
            if (F.bid < 64) { PH_PTRS
#ifndef SKIP_RWKV
                rwkv_unit(P, P.bid, L, KA, U1, Y, nullptr);
#endif
            }
            if (F.bid >= 64 && F.bid < 128) { PH_PTRS
#ifndef SKIP_SSD
                ssd_unit(P, P.bid - 64, L, KA, U1, Y, MISC, SSQ, nullptr);
#endif
            }
            { PH_PTRS
                unsigned* dep = (unsigned*)(ws + WS_CTL) + CW_DEP + 16384 * L; unsigned* q = (unsigned*)(ws + WS_CTL) + CW_QMIX + 256 * L;
                for (;;) {
                    __syncthreads();
                    if (P.tid == 0) *s_uid = atomicAdd(q + 64, 1u);
                    __syncthreads();
                    const int t = (int)*s_uid;
                    if (t >= 256) break;
                    if (t < 128) compress_unit(P, t, L, U1, ws);
                    else rope_slice(P, U1, (const float*)(ws + WS_ROPE), (const float*)(ws + WS_ROPE) + (size_t)T * 32, t - 128);
                    dep_signal(dep + 64, nullptr, P.tid == 0);
                }
                dep_wait(dep + 64, 256u, P.tid == 0);
            }
            { PH_PTRS
            unsigned* q = (unsigned*)(ws + WS_CTL) + CW_QMIX + 256 * L;
            for (;;) {
                __syncthreads();
                if (P.tid == 0) *s_uid = atomicAdd(q + 128, 1u);
                __syncthreads();
                const int uid = (int)*s_uid;
                if (uid >= 512) break;
#ifndef SKIP_NSA
                nsa_unit(P, uid, U1, Y, MISC, ws);
#endif
            } }
            { PH_PTRS
            unsigned* q = (unsigned*)(ws + WS_CTL) + CW_QMIX + 256 * L;
            for (;;) {
                __syncthreads();
                if (P.tid == 0) *s_uid = atomicAdd(q + 192, 1u);
                __syncthreads();
                const int uid = (int)*s_uid;
                if (uid >= 512) break;
#ifndef SKIP_SWA
                swa_unit(P, uid, U1, Y, IN_F(25) + L * 8);
#endif
            } }
            if (L == 0) { PH_PTRS
                unsigned* qg = (unsigned*)(ws + WS_CTL) + CW_QMIX + 576 + 1024 * rep_;
                for (;;) {
                    __syncthreads();
                    if (P.tid == 0) *s_uid = atomicAdd(qg, 1u);
                    __syncthreads();
                    const int t = (int)*s_uid;
                    if (t >= 256) break;
                    BatchSched S; S.pm = t >> 2; S.pn0 = (t & 3) * 4; S.n = 4; S.A = (const char*)XB; S.B = (const char*)(wa + WA_GATE); S.a_tile = TILE1K; S.b_tile = TILE1K;
                    EpiGates E{GATES, ss1};
                    pg8::gemm_phase(P.lds, DM, DM, DM, S, E);
                }
            }
            { PH_PTRS
              if (L == 0) deferred_convert(KA, P, (unsigned*)(ws + WS_CTL) + CW_QMIX + 512 + 1024 * rep_, s_uid, 16, 32, 3472);
              else deferred_convert(KA, P, (unsigned*)(ws + WS_CTL) + CW_QMIX + 768 + 1024 * rep_, s_uid, 35, 59, 16896); }
            { PH_PTRS GSYNC(pb0 + 2); }
        }
        if (RUN(pb0 + 3)) REPS(pb0 + 3) { PH_PTRS
            if (L != 0) {
            pg8::DenseSched S; S.so.init(64, 16, P.G, P.bid); S.A = (const char*)XB; S.B = (const char*)(wa + WA_GATE); S.a_tile = TILE1K; S.b_tile = TILE1K;
            EpiGates E{GATES, ss1};
            pg8::gemm_phase(P.lds, DM, DM, DM, S, E);
            }
            ssd_fixup_and_pb(P, L, KA, Y, SSQ, PB);
            GSYNC(pb0 + 3);
        }
        if (RUN(pb0 + 4)) REPS(pb0 + 4) {
            { PH_PTRS BranchSched S; S.so.init(64, 4, P.G, P.bid); S.Y = (const char*)Y; S.PT = (const char*)(wa + WA_PT); S.a_tile = (size_t)256 * YW * 2; S.b_tile = (size_t)256 * 512 * 2; S.a_br = 512 * 2; S.b_br = MiB;
              EpiBrAll E{MERGED, GATES}; pg8::gemm_phase(P.lds, YW, 512, 512, S, E); }
            { PH_PTRS GSYNC(pb0 + 4); }
        }
        if (RUN(pb0 + 5)) REPS(pb0 + 5) { PH_PTRS
            pg8::DenseSched S; S.so.init(64, 4, P.G, P.bid); S.A = (const char*)MERGED; S.B = (const char*)(wa + WA_OUT); S.a_tile = TILE1K; S.b_tile = TILE1K;
            if (L == 0) { EpiRes<true, true> E{IN_F(0), out, XB, ss2}; pg8::gemm_phase(P.lds, DM, DM, DM, S, E); }
            else { EpiRes<false, true> E{out, out, XB, ss2}; pg8::gemm_phase(P.lds, DM, DM, DM, S, E); }
            GSYNC(pb0 + 5);
        }
        if (L == 0) {
            if (RUN(7)) REPS(7) { PH_PTRS
                pg8::DenseSched S; S.so.init(64, 22, P.G, P.bid); S.A = (const char*)XB; S.B = (const char*)(ws + WS_FGU); S.a_tile = TILE1K; S.b_tile = TILE1K;
                EpiFfn1<false> E{(bf16_t*)(ws + WS_ACT0), ss2};
                pg8::gemm_phase(P.lds, DM, DM, DM, S, E); GSYNC(7);
            }
            if (RUN(8)) REPS(8) { PH_PTRS
                pg8::DenseSched S; S.so.init(64, 4, P.G, P.bid); S.A = (const char*)(ws + WS_ACT0); S.B = (const char*)(ws + WS_FDN); S.a_tile = (size_t)256 * D_FF * 2; S.b_tile = (size_t)256 * D_FF * 2;
                EpiRes<true, false> E{out, out, XB2, nullptr};
                pg8::gemm_phase(P.lds, D_FF, D_FF, D_FF, S, E); GSYNC(8);
            }
        } else {
#define MOE_PTRS unsigned* cnt = (unsigned*)(ws + WS_CTL) + CW_MOECNT; (void)cnt; int* toke = (int*)(ws + WS_TOKE); int* tokp = (int*)(ws + WS_TOKP); float* tokw = (float*)(ws + WS_TOKW); int* toks = (int*)(ws + WS_TOKS); \
            (void)toke; (void)tokp; (void)tokw; (void)toks; float* srstd = (float*)(ws + WS_SRSTD); (void)srstd; \
            bf16_t* XG = (bf16_t*)(ws + WS_XG); bf16_t* ACT1 = (bf16_t*)(ws + WS_ACT1); bf16_t* YB = (bf16_t*)(ws + WS_YB); (void)XG; (void)ACT1; (void)YB;
            if (RUN(16)) REPS(16) { PH_PTRS MOE_PTRS moe_router(P, KA, out, cnt, toke, tokp, tokw); GSYNC(16); }
            if (RUN(17)) REPS(17) { PH_PTRS MOE_PTRS moe_slots(P, out, ss2, cnt, toke, tokp, toks, XG, srstd); GSYNC(17); }
            if (RUN(18)) REPS(18) { PH_PTRS MOE_PTRS
                MoeSched S; int c[8]; moe_tables(cnt, S.mt, c); S.nN = 22; S.G = P.G; S.c = P.bid; S.A = (const char*)XG; S.B = (const char*)(ws + WS_WB); S.a_tile = TILE1K; S.b_tile = TILE1K; S.b_expert = WB_STRIDE;
                EpiFfn1<true> E{ACT1, srstd};
                pg8::gemm_phase(P.lds, DM, DM, DM, S, E); GSYNC(18);
            }
            if (RUN(19)) REPS(19) { PH_PTRS MOE_PTRS
                MoeSched S; int c[8]; moe_tables(cnt, S.mt, c); S.nN = 4; S.G = P.G; S.c = P.bid; S.A = (const char*)ACT1; S.B = (const char*)(ws + WS_WB + WB_DN); S.a_tile = (size_t)256 * D_FF * 2; S.b_tile = (size_t)256 * D_FF * 2; S.b_expert = WB_STRIDE;
                EpiBf16<false> E{YB};
                pg8::gemm_phase(P.lds, D_FF, D_FF, D_FF, S, E); GSYNC(19);
            }
            if (RUN(20)) REPS(20) { PH_PTRS MOE_PTRS moe_combine(P, out, YB, toks, tokw, XB2); GSYNC(20); }
        }
        const int pple = (L == 0) ? 9 : 21;
        if (RUN(pple)) REPS(pple) {
            { PH_PTRS pg8::DenseSched S; S.so.init(64, 4, P.G, P.bid); S.A = (const char*)XB2; S.B = (const char*)(wa + WA_PG); S.a_tile = TILE1K; S.b_tile = TILE1K;
              EpiBf16<true> E{MERGED}; pg8::gemm_phase(P.lds, DM, DM, DM, S, E); }
            { PH_PTRS pg8::DenseSched S; S.so.init(64, 4, P.G, P.bid);
              S.A = (const char*)PB; S.B = (const char*)(wa + WA_PP); S.a_tile = (size_t)256 * PLE * 2; S.b_tile = (size_t)256 * PLE * 2;
              if (L == 0) { EpiPle2<true> E{out, MERGED, XB, ssn}; pg8::gemm_phase(P.lds, PLE, PLE, PLE, S, E); }
              else { EpiPle2<false> E{out, MERGED, XB, ssn}; pg8::gemm_phase(P.lds, PLE, PLE, PLE, S, E); } }
            { PH_PTRS GSYNC(pple); }
        }
    }
    if (RUN(22)) REPS(22) { const int L = 0; PH_PTRS final_norm(P, KA, out); }
}

extern "C" void kernel_launch(void* const* d_in, const int* in_sizes, int n_in, void* d_out, int out_size, void* d_ws, size_t ws_size, hipStream_t stream) {
    static int grid = 0;
    if (grid == 0) {
        if (n_in != 42 || out_size != T * DM || ws_size < WS_END) { fprintf(stderr, "kernel_launch: unexpected problem (n_in %d out %d ws %zu)\n", n_in, out_size, ws_size); grid = -1; return; }
        int dev = 0, cus = 0, per_cu = 0;
        hipGetDevice(&dev); hipDeviceGetAttribute(&cus, hipDeviceAttributeMultiprocessorCount, dev);
        hipFuncSetAttribute((const void*)mega_fwd, hipFuncAttributeMaxDynamicSharedMemorySize, LDS_BYTES);
        hipOccupancyMaxActiveBlocksPerMultiprocessor(&per_cu, (const void*)mega_fwd, 512, LDS_BYTES);
        if (per_cu < 1) { fprintf(stderr, "kernel_launch: occupancy query says %d blocks per CU\n", per_cu); per_cu = 1; }
        (void)hipGetLastError();
        grid = cus;
    }
    if (grid < 0) return;
    hipMemsetAsync((char*)d_ws + WS_CTL, 0, CTL_BYTES, stream);
    Args a{};
    for (int i = 0; i < 42; ++i) a.in[i] = d_in[i];
    a.out = (float*)d_out; a.ws = (unsigned char*)d_ws;
#if MK_MULTI
    for (int k = 0; k < NPH; ++k) { a.ph_lo = k; a.ph_hi = k + 1; hipLaunchKernelGGL(mega_fwd, dim3(grid), dim3(512), LDS_BYTES, stream, a); }
#else
    a.ph_lo = 0; a.ph_hi = NPH;
    void* kargs[] = {&a};
    hipError_t e = hipLaunchCooperativeKernel((const void*)mega_fwd, dim3(grid), dim3(512), kargs, LDS_BYTES, stream);
    if (e != hipSuccess) fprintf(stderr, "kernel_launch: cooperative launch failed: %s\n", hipGetErrorString(e));
#endif
}
```

```cpp
#include <hip/hip_runtime.h>
#include <hip/hip_cooperative_groups.h>
#include <cstdio>
#include <cstdint>
namespace cg = cooperative_groups;

#define LAS __attribute__((address_space(3)))
#define GAS __attribute__((address_space(1)))
typedef unsigned short bf16_t;
typedef short bf16x8 __attribute__((ext_vector_type(8)));
typedef short s16x4 __attribute__((ext_vector_type(4)));
typedef float f32x2 __attribute__((ext_vector_type(2)));
typedef float f32x4 __attribute__((ext_vector_type(4)));
typedef float f32x16 __attribute__((ext_vector_type(16)));
typedef unsigned u32x2 __attribute__((ext_vector_type(2)));
typedef unsigned u32x4 __attribute__((ext_vector_type(4)));

#ifdef DIAG_NOINLINE
#define UNIT_INLINE __attribute__((noinline))
#else
#define UNIT_INLINE __forceinline__
#endif
#ifndef REP_PH
#define REP_PH -1
#endif
#ifndef REP_N
#define REP_N 1
#endif
#ifndef REP_UNIT
#define REP_UNIT -1
#endif
#ifndef MK_MULTI
#define MK_MULTI 0
#endif

constexpr int NB = 8, SEQ = 2048, T = NB * SEQ, DM = 1024, HD = 64;
constexpr int D_IN = 9504, D_FF = 2816, NEXP = 8, PLE = 256;
constexpr int UW = 5376;
constexpr int YW = 2048;
constexpr float NORM_EPS = 1e-6f;
constexpr float LOG2E = 1.4426950408889634f;
constexpr int UC_Z = 0, UC_XBC = 512, UC_XS = 512, UC_BM = 1024, UC_CM = 1280, UC_NQ = 1536, UC_NKV = 2048, UC_RW = 2816, UC_SQ = 4608, UC_SKV = 5120;
constexpr int MOE_MAXROWS = 34816;

constexpr size_t MiB = (size_t)1 << 20;
constexpr size_t WS_CTL = 0, CTL_BYTES = 1 * MiB;
constexpr size_t WS_ROPE = 1 * MiB;
constexpr size_t WS_MISC = 5 * MiB;
constexpr size_t WS_KC = 7 * MiB, WS_VC = 7 * MiB + 256 * 1024;
constexpr size_t WS_SSQ = 7 * MiB + 512 * 1024;
constexpr size_t WS_TOKE = 8 * MiB, WS_TOKP = WS_TOKE + 128 * 1024, WS_TOKW = WS_TOKP + 128 * 1024, WS_TOKS = WS_TOKW + 128 * 1024;
constexpr size_t WS_SRSTD = 8 * MiB + 512 * 1024;
constexpr size_t WS_W1T = 9 * MiB;
constexpr size_t WS_W2T = 10 * MiB;
constexpr size_t WS_PEB = 10 * MiB + 64 * 1024;
constexpr size_t WS_LW = 10 * MiB + 128 * 1024;
constexpr size_t WS_WA = 12 * MiB, WA_STRIDE = 28 * MiB;
constexpr size_t WA_IN = 0, WA_GATE = 11 * MiB, WA_PT = 19 * MiB, WA_OUT = 23 * MiB, WA_PG = 25 * MiB, WA_PP = 27 * MiB;
constexpr size_t WS_FGU = 68 * MiB, WS_FDN = 79 * MiB;
constexpr size_t WS_WB = 85 * MiB, WB_STRIDE = 16 * MiB + 512 * 1024, WB_DN = 11 * MiB;
constexpr size_t WS_XB = 217 * MiB;
constexpr size_t WS_Y = 249 * MiB;
constexpr size_t WS_BIG = 313 * MiB;
constexpr size_t WS_U1 = WS_BIG, WS_GATES = WS_BIG, WS_MERGED = WS_BIG + 128 * MiB, WS_PB = WS_BIG + 160 * MiB, WS_ACT0 = WS_BIG;
constexpr size_t WS_XG = WS_XB, WS_ACT1 = 285 * MiB, WS_YB = WS_XB;
constexpr size_t WS_XB2_L0 = WS_Y, WS_XB2_L1 = 300 * MiB;
constexpr size_t WS_SSP = 482 * MiB;
constexpr size_t WS_END = 488 * MiB;
constexpr int CW_BAR = 4096, CW_QMIX = 16384, CW_MOECNT = 9216;
constexpr int CW_DEP = 32768;

constexpr int RING_BYTES = 131072;
constexpr int LDS_BYTES = 147456;
constexpr int LDS_USER = LDS_BYTES - 1024;
constexpr int MISC_OFF = LDS_USER;

__device__ __forceinline__ float bf2f(unsigned b) { return __uint_as_float(b << 16); }
__device__ __forceinline__ unsigned f2bf(float f) { unsigned u = __float_as_uint(f); return (u + 0x7fffu + ((u >> 16) & 1u)) >> 16; }
__device__ __forceinline__ unsigned cvt_pk(float lo, float hi) { unsigned r; asm volatile("v_cvt_pk_bf16_f32 %0, %1, %2" : "=v"(r) : "v"(lo), "v"(hi)); return r; }
__device__ __forceinline__ float sigmoidf_(float x) { return 1.0f / (1.0f + __expf(-x)); }
__device__ __forceinline__ float siluf_(float x) { return x / (1.0f + __expf(-x)); }
__device__ __forceinline__ float softplusf_(float x) { return x > 20.f ? x : __logf(1.0f + __expf(x)); }
__device__ __forceinline__ float wave_sum(float v) {
#pragma unroll
    for (int o = 1; o < 64; o <<= 1) v += __shfl_xor(v, o);
    return v;
}
__device__ __forceinline__ float wave_max(float v) {
#pragma unroll
    for (int o = 1; o < 64; o <<= 1) v = fmaxf(v, __shfl_xor(v, o));
    return v;
}
#define RLX_AGENT __ATOMIC_RELAXED, __HIP_MEMORY_SCOPE_AGENT
__device__ __forceinline__ u32x2 ld_agent_u64(const void* p) {
    unsigned long long v = __hip_atomic_load((const unsigned long long*)p, RLX_AGENT);
    u32x2 r; r.x = (unsigned)v; r.y = (unsigned)(v >> 32); return r;
}

__device__ __forceinline__ float ss_total(const float* ssp, int row) {
    const f32x4* p = (const f32x4*)(ssp + (size_t)row * 16); const f32x4 a = p[0], b = p[1], c = p[2], d = p[3];
    return (((a[0] + a[1]) + (a[2] + a[3])) + ((b[0] + b[1]) + (b[2] + b[3]))) + (((c[0] + c[1]) + (c[2] + c[3])) + ((d[0] + d[1]) + (d[2] + d[3])));
}
__device__ __forceinline__ float rstd_of(const float* ssp, int row) { return rsqrtf(ss_total(ssp, row) * (1.0f / DM) + NORM_EPS); }

namespace pg8 {
constexpr int BM = 256, BK = 64, HALF = 128, HTB = HALF * BK * 2, STAGE_BYTES = 8 * HTB, NXCD = 8, WGM = 8;
__host__ __device__ __forceinline__ int lds_byte(int r, int c) { const int st = (r >> 4) * 2 + (c >> 5), rr = r & 15, cc = c & 31, ob = rr * 64 + cc * 2; return st * 1024 + (ob ^ (((ob >> 9) & 1) << 5)); }
__host__ __device__ __forceinline__ void stage_rc(int b, int& R, int& C) { const int st = b / 1024, sb = b % 1024, swz = sb ^ (((sb >> 9) & 1) << 5); R = (st >> 1) * 16 + swz / 64; C = (st & 1) * 32 + (swz % 64) / 2; }

struct Unit { int pm, pn; const char* pa; const char* pb; };

struct StaticOrder {
    int nM, nN, nwg, G, c;
    __device__ void init(int nM_, int nN_, int G_, int c_) { nM = nM_; nN = nN_; nwg = nM * nN; G = G_; c = c_; }
    __device__ bool next(int i, int& pm, int& pn) const {
        const long L = (long)i * G + c; if (L >= nwg) return false;
        int wgid = (int)L; { const int q = nwg / NXCD, r = nwg % NXCD, xcd = wgid % NXCD, off = wgid / NXCD; wgid = (xcd < r ? xcd * (q + 1) : r * (q + 1) + (xcd - r) * q) + off; }
        const int nig = WGM * nN, gid = wgid / nig, fm = gid * WGM, gsz = (nM - fm) < WGM ? (nM - fm) : WGM;
        pm = fm + ((wgid % nig) % gsz); pn = (wgid % nig) / gsz; return true;
    }
};
struct DenseSched {
    StaticOrder so; const char* A; const char* B; size_t a_tile, b_tile;
    __device__ bool next(int i, Unit& u) const { if (!so.next(i, u.pm, u.pn)) return false; u.pa = A + (size_t)u.pm * a_tile; u.pb = B + (size_t)u.pn * b_tile; return true; }
};

template <class Epi, class Sched>
__device__ __forceinline__ void gemm_phase(LAS unsigned char* lds, const int lda, const int ldb, const int K, const Sched& S, const Epi& E) {
    int tid_ = threadIdx.x; asm volatile("" : "+v"(tid_));
    const int tid = tid_, wid = __builtin_amdgcn_readfirstlane(tid >> 6), lane = tid & 63, wr = wid >> 2, wc = wid & 3, fr = lane & 15, fq = lane >> 4;
    int K_ = K; asm volatile("" : "+s"(K_));
    const int nt = K_ / BK;
    unsigned voffA[2], voffB[2];
#pragma unroll
    for (int i = 0; i < 2; ++i) { int R, C; stage_rc(tid * 16 + i * 8192, R, C); voffA[i] = (unsigned)(R * lda + C) * 2u; voffB[i] = (unsigned)(R * ldb + C) * 2u; }
    const size_t kstep = (size_t)(BK * 2);
    const size_t hstepA = (size_t)HALF * lda * 2, hstepB = (size_t)HALF * ldb * 2;
    const unsigned ldsw = (unsigned)wid * 1024u;
    const int aoff = lds_byte(wr * 64 + fr, fq * 8), boff = lds_byte(wc * 32 + fr, fq * 8);
#define PG8_SA(b, h) (((b) * 2 + (h)) * HTB)
#define PG8_SB(b, h) ((4 + (b) * 2 + (h)) * HTB)
#define PG8_STAGE(bufoff, gbase, voff) do { _Pragma("unroll") for (int _i = 0; _i < 2; ++_i) \
        __builtin_amdgcn_global_load_lds((const unsigned*)((const char*)(gbase) + (voff)[_i]), (LAS unsigned*)(lds + (bufoff) + ldsw + _i * 8192), 16, 0, 0); } while (0)
#define PG8_LDA(dst, b, h) do { _Pragma("unroll") for (int m = 0; m < 4; ++m) _Pragma("unroll") for (int k = 0; k < 2; ++k) dst[m][k] = *(const LAS bf16x8*)(lds + PG8_SA(b, h) + aoff + m * 2048 + k * 1024); } while (0)
#define PG8_LDB(dst, b, h) do { _Pragma("unroll") for (int n = 0; n < 2; ++n) _Pragma("unroll") for (int k = 0; k < 2; ++k) dst[n][k] = *(const LAS bf16x8*)(lds + PG8_SB(b, h) + boff + n * 2048 + k * 1024); } while (0)
#define PG8_MMA(ai, bj, At, Bt) do { __builtin_amdgcn_s_setprio(1); _Pragma("unroll") for (int m = 0; m < 4; ++m) _Pragma("unroll") for (int n = 0; n < 2; ++n) _Pragma("unroll") for (int k = 0; k < 2; ++k) \
        acc[ai][bj][m][n] = __builtin_amdgcn_mfma_f32_16x16x32_bf16(Bt[n][k], At[m][k], acc[ai][bj][m][n], 0, 0, 0); __builtin_amdgcn_s_setprio(0); } while (0)
#define PG8_WAIT_V(n) asm volatile("s_waitcnt vmcnt(" #n ")" ::: "memory")
#define PG8_WAIT_L(n) asm volatile("s_waitcnt lgkmcnt(" #n ")" ::: "memory")
#define PG8_BAR __builtin_amdgcn_s_barrier()
#define PG8_SCHED __builtin_amdgcn_sched_barrier(0)
    Unit cur, nxt; int ui = 0;
    if (!S.next(0, cur)) return;
    f32x4 acc[2][2][4][2];
#pragma unroll
    for (int a = 0; a < 2; ++a)
#pragma unroll
        for (int b = 0; b < 2; ++b)
#pragma unroll
            for (int m = 0; m < 4; ++m)
#pragma unroll
                for (int n = 0; n < 2; ++n) acc[a][b][m][n] = (f32x4){0.f, 0.f, 0.f, 0.f};
    bf16x8 At[4][2], B0[2][2], B1[2][2];
    const char* cA = cur.pa; const char* cB = cur.pb;
    PG8_STAGE(PG8_SB(0, 0), cB, voffB); PG8_STAGE(PG8_SB(0, 1), cB + hstepB, voffB); PG8_STAGE(PG8_SA(0, 0), cA, voffA); PG8_STAGE(PG8_SA(0, 1), cA + hstepA, voffA);
    if (wr == 1) PG8_BAR;
    PG8_WAIT_V(2); PG8_BAR;
    PG8_STAGE(PG8_SB(1, 0), cB + kstep, voffB); PG8_STAGE(PG8_SA(1, 0), cA + kstep, voffA); PG8_STAGE(PG8_SB(1, 1), cB + hstepB + kstep, voffB);
    PG8_WAIT_V(6); PG8_BAR;
    for (;;) {
        const bool has_next = S.next(ui + 1, nxt);
        const char* nA = has_next ? nxt.pa : cA; const char* nB = has_next ? nxt.pb : cB;
        for (int t = 0; t < nt; t += 2) {
            const bool last = (t == nt - 2);
            const char* a1 = cA + (size_t)(t + 1) * kstep;
            const char* a2 = last ? nA : cA + (size_t)(t + 2) * kstep; const char* b2 = last ? nB : cB + (size_t)(t + 2) * kstep;
            const char* a3 = a2 + kstep; const char* b3 = b2 + kstep;
            PG8_LDB(B0, 0, 0); PG8_LDB(B1, 0, 1); PG8_SCHED; PG8_LDA(At, 0, 0); PG8_STAGE(PG8_SA(1, 1), a1 + hstepA, voffA);
            PG8_WAIT_V(8); PG8_WAIT_L(0); PG8_BAR; PG8_MMA(0, 0, At, B0); PG8_MMA(0, 1, At, B1); PG8_BAR; PG8_SCHED;
            PG8_LDA(At, 0, 1); PG8_STAGE(PG8_SB(0, 0), b2, voffB); PG8_STAGE(PG8_SB(0, 1), b2 + hstepB, voffB); PG8_STAGE(PG8_SA(0, 0), a2, voffA);
            PG8_WAIT_V(8); PG8_WAIT_L(0); PG8_BAR; PG8_MMA(1, 0, At, B0); PG8_MMA(1, 1, At, B1); PG8_BAR; PG8_SCHED;
            PG8_LDB(B0, 1, 0); PG8_LDB(B1, 1, 1); PG8_SCHED; PG8_LDA(At, 1, 0); PG8_STAGE(PG8_SA(0, 1), a2 + hstepA, voffA);
            PG8_WAIT_V(8); PG8_WAIT_L(0); PG8_BAR; PG8_MMA(0, 0, At, B0); PG8_MMA(0, 1, At, B1); PG8_BAR; PG8_SCHED;
            PG8_LDA(At, 1, 1); PG8_STAGE(PG8_SB(1, 0), b3, voffB); PG8_STAGE(PG8_SB(1, 1), b3 + hstepB, voffB); PG8_STAGE(PG8_SA(1, 0), a3, voffA);
            PG8_WAIT_V(8); PG8_WAIT_L(0); PG8_BAR; PG8_MMA(1, 0, At, B0); PG8_MMA(1, 1, At, B1); PG8_BAR; PG8_SCHED;
        }
        if (wr == 0) PG8_BAR;
        E(acc, cur, wr, wc, fr, fq);
        if (!has_next) break;
#pragma unroll
        for (int a = 0; a < 2; ++a)
#pragma unroll
            for (int b = 0; b < 2; ++b)
#pragma unroll
                for (int m = 0; m < 4; ++m)
#pragma unroll
                    for (int n = 0; n < 2; ++n) acc[a][b][m][n] = (f32x4){0.f, 0.f, 0.f, 0.f};
        cur = nxt; cA = nA; cB = nB; ++ui;
        if (wr == 1) PG8_BAR;
    }
    PG8_WAIT_V(0);
    PG8_BAR;
#undef PG8_SA
#undef PG8_SB
#undef PG8_STAGE
#undef PG8_LDA
#undef PG8_LDB
#undef PG8_MMA
#undef PG8_WAIT_V
#undef PG8_WAIT_L
#undef PG8_BAR
#undef PG8_SCHED
}
}

#define EPI_ROW(u, ai, m) ((u).pm * 256 + (ai) * 128 + wr * 64 + (m) * 16 + fr)
#define EPI_COL(u, bj, n) ((u).pn * 256 + (bj) * 128 + wc * 32 + (n) * 16 + fq * 4)
typedef f32x4 Acc[2][2][4][2];

__device__ __forceinline__ u32x2 pack4(f32x4 v) { u32x2 w; w.x = cvt_pk(v[0], v[1]); w.y = cvt_pk(v[2], v[3]); return w; }
__device__ __forceinline__ f32x4 unpack4(u32x2 w) { f32x4 v; v[0] = bf2f(w.x & 0xffffu); v[1] = bf2f(w.x >> 16); v[2] = bf2f(w.y & 0xffffu); v[3] = bf2f(w.y >> 16); return v; }

template <bool WT> struct EpiInT {
    bf16_t* U; float* misc; const float* ss;
    __device__ __forceinline__ void st8(void* p, u32x2 v) const {
        if (WT) __hip_atomic_store((unsigned long long*)p, ((unsigned long long)v.y << 32) | v.x, RLX_AGENT); else *(u32x2*)p = v;
    }
    __device__ __forceinline__ void operator()(const Acc& acc, const pg8::Unit& u, int wr, int wc, int fr, int fq) const {
#pragma unroll
        for (int ai = 0; ai < 2; ++ai)
#pragma unroll
            for (int m = 0; m < 4; ++m) {
                const int row = EPI_ROW(u, ai, m); const float rs = rstd_of(ss, row);
                if (u.pn < 21) {
#pragma unroll
                    for (int bj = 0; bj < 2; ++bj)
#pragma unroll
                        for (int n = 0; n < 2; ++n) st8(U + (size_t)row * UW + EPI_COL(u, bj, n), pack4(acc[ai][bj][m][n] * rs));
                } else if (wc == 0) {
#pragma unroll
                    for (int n = 0; n < 2; ++n) { const f32x4 v = acc[ai][0][m][n] * rs; float* mp = misc + (size_t)row * 32 + n * 16 + fq * 4;
                        st8(mp, (u32x2){__float_as_uint(v[0]), __float_as_uint(v[1])}); st8(mp + 2, (u32x2){__float_as_uint(v[2]), __float_as_uint(v[3])}); }
                }
            }
    }
};
typedef EpiInT<false> EpiIn;
struct EpiGates {
    bf16_t* G; const float* ss;
    __device__ __forceinline__ void operator()(const Acc& acc, const pg8::Unit& u, int wr, int wc, int fr, int fq) const {
#pragma unroll
        for (int ai = 0; ai < 2; ++ai)
#pragma unroll
            for (int m = 0; m < 4; ++m) {
                const int row = EPI_ROW(u, ai, m); const float rs = rstd_of(ss, row);
#pragma unroll
                for (int bj = 0; bj < 2; ++bj)
#pragma unroll
                    for (int n = 0; n < 2; ++n) { f32x4 v = acc[ai][bj][m][n] * rs; v[0] = sigmoidf_(v[0]); v[1] = sigmoidf_(v[1]); v[2] = sigmoidf_(v[2]); v[3] = sigmoidf_(v[3]);
                        *(u32x2*)(G + (size_t)row * 4096 + EPI_COL(u, bj, n)) = pack4(v); }
            }
    }
};
struct EpiBrAll {
    bf16_t* MG; const bf16_t* G;
    __device__ __forceinline__ void operator()(const Acc& acc, const pg8::Unit& u, int wr, int wc, int fr, int fq) const {
        const int mb = u.pn >> 8, pn = u.pn & 255;
        if (mb > 0) asm volatile("s_waitcnt vmcnt(0)" ::: "memory");
#pragma unroll
        for (int ai = 0; ai < 2; ++ai)
#pragma unroll
            for (int m = 0; m < 4; ++m) {
                const int row = u.pm * 256 + ai * 128 + wr * 64 + m * 16 + fr;
#pragma unroll
                for (int bj = 0; bj < 2; ++bj)
#pragma unroll
                    for (int n = 0; n < 2; ++n) { const int col = pn * 256 + bj * 128 + wc * 32 + n * 16 + fq * 4;
                        const f32x4 g = unpack4(*(const u32x2*)(G + (size_t)row * 4096 + mb * 1024 + col));
                        f32x4 v = acc[ai][bj][m][n] * g;
                        bf16_t* mp = MG + (size_t)row * DM + col;
                        if (mb > 0) v += unpack4(ld_agent_u64(mp));
                        *(u32x2*)mp = pack4(v); }
                asm volatile("" ::: "memory");
            }
    }
};
template <bool WRITE_XB, bool ACC_SS> struct EpiRes {
    const float* xin; float* xo; bf16_t* xb; float* ss;
    __device__ __forceinline__ void operator()(const Acc& acc, const pg8::Unit& u, int wr, int wc, int fr, int fq) const {
#pragma unroll
        for (int ai = 0; ai < 2; ++ai)
#pragma unroll
            for (int m = 0; m < 4; ++m) {
                const int row = EPI_ROW(u, ai, m); float s = 0.f;
#pragma unroll
                for (int bj = 0; bj < 2; ++bj)
#pragma unroll
                    for (int n = 0; n < 2; ++n) { const size_t off = (size_t)row * DM + EPI_COL(u, bj, n);
                        const f32x4 v = *(const f32x4*)(xin + off) + acc[ai][bj][m][n];
                        *(f32x4*)(xo + off) = v;
                        if (WRITE_XB) *(u32x2*)(xb + off) = pack4(v);
                        if (ACC_SS) s += (v[0] * v[0] + v[1] * v[1]) + (v[2] * v[2] + v[3] * v[3]); }
                if (ACC_SS) { s += __shfl_xor(s, 16); s += __shfl_xor(s, 32); if (fq == 0) ss[(size_t)row * 16 + u.pn * 4 + wc] = s; }
                asm volatile("" ::: "memory");
            }
    }
};
template <bool MOE> struct EpiFfn1 {
    bf16_t* ACT; const float* ss;
    __device__ __forceinline__ void operator()(const Acc& acc, const pg8::Unit& u, int wr, int wc, int fr, int fq) const {
#pragma unroll
        for (int ai = 0; ai < 2; ++ai)
#pragma unroll
            for (int m = 0; m < 4; ++m) {
                const int row = EPI_ROW(u, ai, m); const float rs = MOE ? ss[row] : rstd_of(ss, row);
#pragma unroll
                for (int n = 0; n < 2; ++n) { const f32x4 g = acc[ai][0][m][n] * rs, up = acc[ai][1][m][n] * rs; f32x4 v;
                    v[0] = siluf_(g[0]) * up[0]; v[1] = siluf_(g[1]) * up[1]; v[2] = siluf_(g[2]) * up[2]; v[3] = siluf_(g[3]) * up[3];
                    *(u32x2*)(ACT + (size_t)row * D_FF + u.pn * 128 + wc * 32 + n * 16 + fq * 4) = pack4(v); }
            }
    }
};
template <bool SIG> struct EpiBf16 {
    bf16_t* O;
    __device__ __forceinline__ void operator()(const Acc& acc, const pg8::Unit& u, int wr, int wc, int fr, int fq) const {
#pragma unroll
        for (int ai = 0; ai < 2; ++ai)
#pragma unroll
            for (int m = 0; m < 4; ++m) {
                const int row = EPI_ROW(u, ai, m);
#pragma unroll
                for (int bj = 0; bj < 2; ++bj)
#pragma unroll
                    for (int n = 0; n < 2; ++n) { f32x4 v = acc[ai][bj][m][n];
                        if (SIG) { v[0] = sigmoidf_(v[0]); v[1] = sigmoidf_(v[1]); v[2] = sigmoidf_(v[2]); v[3] = sigmoidf_(v[3]); }
                        *(u32x2*)(O + (size_t)row * DM + EPI_COL(u, bj, n)) = pack4(v); }
            }
    }
};
template <bool WRITE_XB> struct EpiPle2 {
    float* xo; const bf16_t* G; bf16_t* xb; float* ss;
    __device__ __forceinline__ void operator()(const Acc& acc, const pg8::Unit& u, int wr, int wc, int fr, int fq) const {
#pragma unroll
        for (int ai = 0; ai < 2; ++ai)
#pragma unroll
            for (int m = 0; m < 4; ++m) {
                const int row = EPI_ROW(u, ai, m); float s = 0.f;
#pragma unroll
                for (int bj = 0; bj < 2; ++bj)
#pragma unroll
                    for (int n = 0; n < 2; ++n) { const size_t off = (size_t)row * DM + EPI_COL(u, bj, n);
                        const f32x4 g = unpack4(ld_agent_u64(G + off));
                        const f32x4 v = *(const f32x4*)(xo + off) + g * acc[ai][bj][m][n];
                        *(f32x4*)(xo + off) = v;
                        if (WRITE_XB) *(u32x2*)(xb + off) = pack4(v);
                        s += (v[0] * v[0] + v[1] * v[1]) + (v[2] * v[2] + v[3] * v[3]); }
                s += __shfl_xor(s, 16); s += __shfl_xor(s, 32); if (fq == 0) ss[(size_t)row * 16 + u.pn * 4 + wc] = s;
                asm volatile("" ::: "memory");
            }
    }
};

struct BatchSched {
    int pm, pn0, n; const char* A; const char* B; size_t a_tile, b_tile;
    __device__ bool next(int i, pg8::Unit& u) const { if (i >= n) return false; u.pm = pm; u.pn = pn0 + i; u.pa = A + (size_t)pm * a_tile; u.pb = B + (size_t)u.pn * b_tile; return true; }
};
struct InBatchSched {
    int pm, kind, i0, n; const char* A; const char* B; size_t a_tile, b_tile;
    __device__ bool next(int ii, pg8::Unit& u) const {
        if (ii >= n) return false;
        const int i = i0 + ii; int pn;
        if (kind == 0) pn = 11 + i;
        else if (kind == 1) pn = i < 6 ? i : 21;
        else pn = i < 5 ? 6 + i : 13 + i;
        u.pm = pm; u.pn = pn; u.pa = A + (size_t)pm * a_tile; u.pb = B + (size_t)pn * b_tile; return true;
    }
};
struct BranchSched {
    pg8::StaticOrder so; const char* Y; const char* PT; size_t a_tile, b_tile, a_br, b_br;
    __device__ bool next(int i, pg8::Unit& u) const {
        if (i >= 4) return false; int pm, pn; if (!so.next(0, pm, pn)) return false;
        u.pm = pm; u.pn = pn | (i << 8); u.pa = Y + (size_t)i * a_br + (size_t)pm * a_tile; u.pb = PT + (size_t)i * b_br + (size_t)pn * b_tile; return true;
    }
};
struct MoeTables { int ps1, ps2, ps3, ps4, ps5, ps6, ps7, ps8; };
__device__ __forceinline__ int moe_expert_of_row(const MoeTables& mt, int row) {
    return (row >= mt.ps1) + (row >= mt.ps2) + (row >= mt.ps3) + (row >= mt.ps4) + (row >= mt.ps5) + (row >= mt.ps6) + (row >= mt.ps7);
}
struct MoeSched {
    MoeTables mt; int nN, G, c; const char* A; const char* B; size_t a_tile, b_tile, b_expert;
    __device__ bool next(int i, pg8::Unit& u) const {
        const long L = (long)i * G + c; const int ntiles = mt.ps8 >> 8;
        if (L >= (long)ntiles * nN) return false;
        u.pm = (int)(L / nN); u.pn = (int)(L % nN);
        const int e = moe_expert_of_row(mt, u.pm * 256);
        u.pa = A + (size_t)u.pm * a_tile; u.pb = B + (size_t)e * b_expert + (size_t)u.pn * b_tile; return true;
    }
};

struct Args { const void* in[42]; float* out; unsigned char* ws; int ph_lo, ph_hi; };
typedef const __attribute__((address_space(4))) Args* KArgs;
__device__ __forceinline__ KArgs kargs() { KArgs p = (KArgs)__builtin_amdgcn_kernarg_segment_ptr(); asm volatile("" : "+s"(p)); return p; }
struct Frame {
    LAS unsigned char* lds; int tid, lane, wave, G, bid;
    unsigned char* ws; unsigned* ctl;
};
#define IN_F(k) ((const float*)KA->in[k])

constexpr int DEFER_ITEMS = 3472 + 16896;
struct TJob { const float* src; int ldw, K, ncols, ldt, mode; bf16_t* dst; const float* gain; };
__device__ __forceinline__ void tr_item(const TJob& J, LAS float* scr, int item, int lane) {
    const int nblk = J.ncols / 64, kb = item / nblk, nb = item % nblk, k0 = 64 * kb, n0 = 64 * nb;
    const int c = lane;
    const bool live = (J.mode != 3) || c < 32;
    const int scol = (J.mode == 3) ? (c < 8 ? 1536 + c : (c < 32 ? 2816 + c : 0)) : n0 + c;
    const float* sp = J.src + (size_t)k0 * J.ldw + scol;
    float v[64];
#pragma unroll
    for (int i = 0; i < 64; ++i) v[i] = sp[(size_t)i * J.ldw];
#pragma unroll
    for (int i = 0; i < 64; ++i) { float x = live ? v[i] : 0.f; if (J.gain) x *= J.gain[k0 + i]; scr[i * 65 + c] = x; }
    asm volatile("s_waitcnt lgkmcnt(0)" ::: "memory");
    int drow0 = n0;
    if (J.mode == 1 || J.mode == 2) drow0 = (n0 / 128) * 256 + (n0 % 128) + (J.mode == 2 ? 128 : 0);
    const int c8 = lane & 7;
#pragma unroll
    for (int j = 0; j < 8; ++j) { const int n = (lane >> 3) + 8 * j; const LAS float* sq = scr + (8 * c8) * 65 + n;
        u32x4 o; o.x = cvt_pk(sq[0 * 65], sq[1 * 65]); o.y = cvt_pk(sq[2 * 65], sq[3 * 65]); o.z = cvt_pk(sq[4 * 65], sq[5 * 65]); o.w = cvt_pk(sq[6 * 65], sq[7 * 65]);
        *(u32x4*)(J.dst + (size_t)(drow0 + n) * J.ldt + k0 + 8 * c8) = o; }
    asm volatile("s_waitcnt lgkmcnt(0)" ::: "memory");
}
constexpr int NJOBS = 32 + 3 + 24 + 8;
__device__ __forceinline__ bool job_deferred(int jid) { return (jid >= 16 && jid < 32) || (jid >= 35 && jid < 59); }
__device__ __forceinline__ bool get_job(KArgs KA, int jid, TJob& J) {
    unsigned char* ws = KA->ws;
    J.gain = nullptr; J.mode = 0;
    if (jid < 32) {
        const int L = jid >> 4, j = jid & 15;
        unsigned char* wa = ws + WS_WA + (size_t)L * WA_STRIDE;
        if (j <= 8) {
            const float* w = IN_F(4) + (size_t)L * DM * D_IN; J.ldw = D_IN; J.K = DM; J.ldt = DM; J.gain = IN_F(3) + L * DM;
            int sc, nc, dr;
            switch (j) { case 0: sc = 0; nc = 512; dr = 0; break; case 1: sc = 512; nc = 1024; dr = 512; break; case 2: sc = 1544; nc = 512; dr = 1536; break;
                case 3: sc = 2056; nc = 768; dr = 2048; break; case 4: sc = 2848; nc = 1792; dr = 2816; break; case 5: sc = 4640; nc = 512; dr = 4608; break;
                case 6: sc = 5152; nc = 256; dr = 5120; break; case 7: sc = 0; nc = 64; dr = 5376; J.mode = 3; break; default: sc = 5408; nc = 4096; dr = 0; break; }
            J.src = w + sc; J.ncols = nc; J.dst = (bf16_t*)(wa + (j == 8 ? WA_GATE : WA_IN)) + (size_t)dr * DM;
            return true;
        }
        if (j <= 12) { const int m = j - 9; J.src = IN_F(26 + m) + (size_t)L * 512 * DM; J.ldw = DM; J.K = 512; J.ncols = DM; J.ldt = 512; J.dst = (bf16_t*)(wa + WA_PT + (size_t)m * MiB); return true; }
        if (j == 13) { J.src = IN_F(30) + (size_t)L * DM * DM; J.ldw = DM; J.K = DM; J.ncols = DM; J.ldt = DM; J.dst = (bf16_t*)(wa + WA_OUT); return true; }
        if (j == 14) { J.src = IN_F(40) + (size_t)L * DM * DM; J.ldw = DM; J.K = DM; J.ncols = DM; J.ldt = DM; J.dst = (bf16_t*)(wa + WA_PG); return true; }
        J.src = IN_F(39) + (size_t)L * PLE * DM; J.ldw = DM; J.K = PLE; J.ncols = DM; J.ldt = PLE; J.dst = (bf16_t*)(wa + WA_PP); return true;
    }
    if (jid < 35) {
        const int j = jid - 32;
        if (j < 2) { J.src = IN_F(32 + j); J.ldw = D_FF; J.K = DM; J.ncols = D_FF; J.ldt = DM; J.gain = IN_F(31); J.mode = 1 + j; J.dst = (bf16_t*)(ws + WS_FGU); return true; }
        J.src = IN_F(34); J.ldw = DM; J.K = D_FF; J.ncols = DM; J.ldt = D_FF; J.dst = (bf16_t*)(ws + WS_FDN); return true;
    }
    if (jid < 59) {
        const int e = (jid - 35) / 3, j = (jid - 35) % 3;
        unsigned char* wb = ws + WS_WB + (size_t)e * WB_STRIDE;
        if (j < 2) { J.src = IN_F(36 + j) + (size_t)e * DM * D_FF; J.ldw = D_FF; J.K = DM; J.ncols = D_FF; J.ldt = DM; J.gain = IN_F(31) + DM; J.mode = 1 + j; J.dst = (bf16_t*)wb; return true; }
        J.src = IN_F(38) + (size_t)e * D_FF * DM; J.ldw = DM; J.K = D_FF; J.ncols = DM; J.ldt = D_FF; J.dst = (bf16_t*)(wb + WB_DN); return true;
    }
    {
        const int j = jid - 59, idx = j & 3;
        if (j < 4) { J.src = IN_F(12) + (size_t)idx * 2048 * 64; J.ldw = 64; J.K = 2048; J.ncols = 64; J.ldt = 2048; J.dst = (bf16_t*)(ws + WS_W1T) + (size_t)idx * 64 * 2048; return true; }
        J.src = IN_F(13) + (size_t)idx * 64 * 64; J.ldw = 64; J.K = 64; J.ncols = 64; J.ldt = 64; J.dst = (bf16_t*)(ws + WS_W2T) + (size_t)idx * 64 * 64; return true;
    }
}
__device__ UNIT_INLINE void p0_prologue(KArgs KA, Frame& F) {
    LAS float* scr = (LAS float*)(F.lds + F.wave * 16640);
    const int gw = F.bid * 8 + F.wave, NGW = F.G * 8;
    unsigned char* ws = KA->ws;
    {
        int jid = 0, loc = gw; TJob J; get_job(KA, 0, J); int nit = (J.K / 64) * (J.ncols / 64);
        for (;;) {
            while (jid < NJOBS && loc >= nit) { loc -= nit; ++jid; if (jid < NJOBS) { get_job(KA, jid, J); nit = job_deferred(jid) ? 0 : (J.K / 64) * (J.ncols / 64); } }
            if (jid >= NJOBS) break;
            tr_item(J, scr, loc, F.lane);
            loc += NGW;
        }
    }
    for (int L = 0; L < 2; ++L) {
        u32x4* z = (u32x4*)((bf16_t*)(ws + WS_WA + (size_t)L * WA_STRIDE + WA_IN) + (size_t)5440 * DM);
        const int n16 = 192 * DM * 2 / 16;
        for (int i = gw * 64 + F.lane; i < n16; i += NGW * 64) z[i] = (u32x4){0u, 0u, 0u, 0u};
    }
    for (int o = gw; o < 256; o += NGW) {
        const int idx = o >> 6, f = o & 63;
        const float* pe = IN_F(11) + (size_t)idx * 2048; const float* w1 = IN_F(12) + (size_t)idx * 2048 * 64 + f; float s = 0.f;
#pragma unroll 8
        for (int k = F.lane; k < 2048; k += 64) s += pe[k] * w1[(size_t)k * 64];
        s = wave_sum(s);
        if (F.lane == 0) ((float*)(ws + WS_PEB))[o] = s;
    }
    for (int i = gw * 64 + F.lane; i < 2 * 8 * 4 * 8 * 64; i += NGW * 64) {
        const int ln = i & 63, fr = (i >> 6) & 7, nt = (i >> 9) & 3, hh = (i >> 11) & 7, LL = i >> 14;
        const int cn = hh * 64 + 16 * nt + (ln & 15), kgl = ln >> 4;
        const float* W = (fr < 2) ? IN_F(16) + (size_t)LL * 64 * 512 : (fr < 4) ? IN_F(18) + (size_t)LL * 64 * 512 : IN_F(19) + (size_t)LL * 128 * 512;
        const int ks = (fr < 2) ? fr : (fr < 4) ? fr - 2 : fr - 4;
        u32x4 o;
#pragma unroll
        for (int j = 0; j < 4; ++j) { const int k = 32 * ks + 8 * kgl + 2 * j; o[j] = cvt_pk(W[(size_t)k * 512 + cn], W[(size_t)(k + 1) * 512 + cn]); }
        ((u32x4*)(ws + WS_LW))[i] = o;
    }
    {
        const float* x = IN_F(0); bf16_t* xb = (bf16_t*)(ws + WS_XB); float* ss = (float*)(ws + WS_SSP);
        for (int m = gw; m < T; m += NGW) {
            const f32x4* xr = (const f32x4*)(x + (size_t)m * DM) + F.lane; float s = 0.f;
            u32x2* o = (u32x2*)(xb + (size_t)m * DM) + F.lane;
#pragma unroll
            for (int j = 0; j < 4; ++j) { const f32x4 v = xr[64 * j]; s += (v[0] * v[0] + v[1] * v[1]) + (v[2] * v[2] + v[3] * v[3]); o[64 * j] = pack4(v); }
            s = wave_sum(s); if (F.lane < 16) ss[(size_t)m * 16 + F.lane] = (F.lane == 0) ? s : 0.f;
        }
    }
    {
        const int* pos = (const int*)KA->in[2]; float* rc = (float*)(ws + WS_ROPE); float* rsn = rc + (size_t)T * 32;
        for (int i = (gw * 64 + F.lane); i < T * 32; i += NGW * 64) {
            const int t = i >> 5, k = i & 31;
            const float inv = (float)exp2(-(double)k * (1.0 / 32.0) * 17.194602975157967);
            const float ang = (float)pos[t] * inv;
            rc[i] = cosf(ang); rsn[i] = sinf(ang);
        }
    }
}


__device__ UNIT_INLINE void deferred_convert(KArgs KA, Frame& F, unsigned* q, LAS unsigned* s_uid, int jlo, int jhi, int nitems) {
    LAS float* scr = (LAS float*)(F.lds + F.wave * 16640);
    for (;;) {
        __syncthreads();
        if (F.tid == 0) *s_uid = atomicAdd(q, 1u);
        __syncthreads();
        int loc = (int)*s_uid * 8 + F.wave;
        int jid = jlo; TJob J; bool found = false;
        for (; jid < jhi; ++jid) { if (!job_deferred(jid)) continue; get_job(KA, jid, J); const int nit = (J.K / 64) * (J.ncols / 64); if (loc < nit) { found = true; break; } loc -= nit; }
        if (found) tr_item(J, scr, loc, F.lane);
        if ((int)*s_uid * 8 >= nitems) break;
    }
}


__device__ __forceinline__ void dep_signal(unsigned* c0, unsigned* c1, bool leader) {
    asm volatile("s_waitcnt vmcnt(0)" ::: "memory");
    __syncthreads();
    if (leader) {
        __builtin_amdgcn_fence(__ATOMIC_RELEASE, "agent");
        asm volatile("s_waitcnt vmcnt(0)" ::: "memory");
        __hip_atomic_fetch_add(c0, 1u, __ATOMIC_RELAXED, __HIP_MEMORY_SCOPE_AGENT);
        if (c1) __hip_atomic_fetch_add(c1, 1u, __ATOMIC_RELAXED, __HIP_MEMORY_SCOPE_AGENT);
    }
}
__device__ __forceinline__ void dep_signal_wt(unsigned* c0, unsigned* c1, bool leader) {
    asm volatile("s_waitcnt vmcnt(0)" ::: "memory");
    __syncthreads();
    if (leader) { __hip_atomic_fetch_add(c0, 1u, __ATOMIC_RELAXED, __HIP_MEMORY_SCOPE_AGENT); if (c1) __hip_atomic_fetch_add(c1, 1u, __ATOMIC_RELAXED, __HIP_MEMORY_SCOPE_AGENT); }
}
__device__ __forceinline__ void dep_poll_lane(unsigned* c, unsigned target) {
    unsigned spins = 0;
    while (__hip_atomic_load(c, __ATOMIC_RELAXED, __HIP_MEMORY_SCOPE_AGENT) < target) { __builtin_amdgcn_s_sleep(2); if (++spins > (1u << 24)) break; }
}
__device__ __forceinline__ void dep_wait_lane(unsigned* c, unsigned target) {
    unsigned spins = 0;
    while (__hip_atomic_load(c, __ATOMIC_RELAXED, __HIP_MEMORY_SCOPE_AGENT) < target) { __builtin_amdgcn_s_sleep(2); if (++spins > (1u << 24)) break; }
    __builtin_amdgcn_fence(__ATOMIC_ACQUIRE, "agent");
    asm volatile("s_waitcnt vmcnt(0)" ::: "memory");
}
__device__ __forceinline__ void dep_wait(unsigned* c, unsigned target, bool leader) {
    if (leader) dep_poll_lane(c, target);
    __syncthreads();
}

__device__ UNIT_INLINE void rope_pass(Frame& F, bf16_t* U1, const float* rc, const float* rsn) {
    const int gt = F.bid * 512 + F.tid, NT = F.G * 512;
    for (int i = gt; i < T * 40; i += NT) {
        const int t = i / 40, r = i % 40, slot = r >> 2, ch = r & 3;
        bf16_t* base = U1 + (size_t)t * UW + (slot < 8 ? UC_SQ + slot * 64 : UC_SKV + (slot - 8) * 64) + ch * 8;
        const u32x4 a = *(const u32x4*)base, b = *(const u32x4*)(base + 32);
        const f32x4 c0 = *(const f32x4*)(rc + (size_t)t * 32 + ch * 8), c1 = *(const f32x4*)(rc + (size_t)t * 32 + ch * 8 + 4);
        const f32x4 s0 = *(const f32x4*)(rsn + (size_t)t * 32 + ch * 8), s1 = *(const f32x4*)(rsn + (size_t)t * 32 + ch * 8 + 4);
        float x1[8], x2[8], cs[8], sn[8];
#pragma unroll
        for (int j = 0; j < 4; ++j) { x1[2 * j] = bf2f(a[j] & 0xffffu); x1[2 * j + 1] = bf2f(a[j] >> 16); x2[2 * j] = bf2f(b[j] & 0xffffu); x2[2 * j + 1] = bf2f(b[j] >> 16);
            cs[j] = c0[j]; cs[4 + j] = c1[j]; sn[j] = s0[j]; sn[4 + j] = s1[j]; }
        u32x4 oa, ob;
#pragma unroll
        for (int j = 0; j < 4; ++j) {
            const float y1a = x1[2 * j] * cs[2 * j] - x2[2 * j] * sn[2 * j], y1b = x1[2 * j + 1] * cs[2 * j + 1] - x2[2 * j + 1] * sn[2 * j + 1];
            const float y2a = x2[2 * j] * cs[2 * j] + x1[2 * j] * sn[2 * j], y2b = x2[2 * j + 1] * cs[2 * j + 1] + x1[2 * j + 1] * sn[2 * j + 1];
            oa[j] = cvt_pk(y1a, y1b); ob[j] = cvt_pk(y2a, y2b);
        }
        *(u32x4*)base = oa; *(u32x4*)(base + 32) = ob;
    }
}
__device__ UNIT_INLINE void rope_slice(Frame& F, bf16_t* U1, const float* rc, const float* rsn, int slice) {
    for (int i = slice * 5120 + F.tid; i < (slice + 1) * 5120; i += 512) {
        const int t = i / 40, r = i % 40, slot = r >> 2, ch = r & 3;
        bf16_t* base = U1 + (size_t)t * UW + (slot < 8 ? UC_SQ + slot * 64 : UC_SKV + (slot - 8) * 64) + ch * 8;
        const u32x4 a = *(const u32x4*)base, b = *(const u32x4*)(base + 32);
        const f32x4 c0 = *(const f32x4*)(rc + (size_t)t * 32 + ch * 8), c1 = *(const f32x4*)(rc + (size_t)t * 32 + ch * 8 + 4);
        const f32x4 s0 = *(const f32x4*)(rsn + (size_t)t * 32 + ch * 8), s1 = *(const f32x4*)(rsn + (size_t)t * 32 + ch * 8 + 4);
        u32x4 oa, ob;
#pragma unroll
        for (int j = 0; j < 4; ++j) {
            const float xa = bf2f(a[j] & 0xffffu), xb = bf2f(a[j] >> 16), ya = bf2f(b[j] & 0xffffu), yb = bf2f(b[j] >> 16);
            const float ca = j < 2 ? c0[2 * j] : c1[2 * j - 4], cb = j < 2 ? c0[2 * j + 1] : c1[2 * j - 3], sa = j < 2 ? s0[2 * j] : s1[2 * j - 4], sb = j < 2 ? s0[2 * j + 1] : s1[2 * j - 3];
            oa[j] = cvt_pk(xa * ca - ya * sa, xb * cb - yb * sb); ob[j] = cvt_pk(ya * ca + xa * sa, yb * cb + xb * sb);
        }
        *(u32x4*)base = oa; *(u32x4*)(base + 32) = ob;
    }
}
__device__ UNIT_INLINE void compress_unit(Frame& F, int unit, int L, const bf16_t* U1, unsigned char* ws) {
    const int nc = unit & 3, kv = (unit >> 2) & 1, g = (unit >> 3) & 1, b = unit >> 4;
    const int n0 = nc * 32, tok0 = n0 * 16;
    LAS bf16_t* tok = (LAS bf16_t*)F.lds;
    LAS bf16_t* hid = (LAS bf16_t*)(F.lds + 528 * 72 * 2);
    const bf16_t* src = U1 + (size_t)(b * SEQ) * UW + UC_NKV + kv * 128 + g * 64;
    __syncthreads();
    for (int i = F.tid; i < 528 * 8; i += 512) { const int r = i >> 3, ch = i & 7; const int t = tok0 + r;
        u32x4 v = (u32x4){0u, 0u, 0u, 0u}; if (t < SEQ) v = *(const u32x4*)(src + (size_t)t * UW + ch * 8);
        *(LAS u32x4*)(tok + r * 72 + ch * 8) = v; }
    __syncthreads();
    const int idx = L * 2 + kv;
    const bf16_t* w1t = (const bf16_t*)(ws + WS_W1T) + (size_t)idx * 64 * 2048;
    const bf16_t* w2t = (const bf16_t*)(ws + WS_W2T) + (size_t)idx * 64 * 64;
    const float* peb = (const float*)(ws + WS_PEB) + idx * 64;
    const int mt = F.wave >> 2, ntile = F.wave & 3, r16 = F.lane & 15, kg = F.lane >> 4;
    f32x4 acc = (f32x4){0.f, 0.f, 0.f, 0.f};
    const int nl = mt * 16 + r16;
    const bf16_t* bp = w1t + (size_t)(ntile * 16 + r16) * 2048 + kg * 8;
#pragma unroll 4
    for (int ks = 0; ks < 64; ++ks) {
        const int l = ks >> 1, db = (ks & 1) * 32 + kg * 8;
        const bf16x8 a = *(const LAS bf16x8*)(tok + (16 * nl + l) * 72 + db);
        const bf16x8 bb = *(const bf16x8*)(bp + ks * 32);
        acc = __builtin_amdgcn_mfma_f32_16x16x32_bf16(a, bb, acc, 0, 0, 0);
    }
    { const int f = ntile * 16 + r16; const float pb = peb[f];
#pragma unroll
      for (int r = 0; r < 4; ++r) hid[(mt * 16 + 4 * kg + r) * 72 + f] = (bf16_t)f2bf(siluf_(acc[r] + pb)); }
    __syncthreads();
    f32x4 o = (f32x4){0.f, 0.f, 0.f, 0.f};
#pragma unroll
    for (int ks = 0; ks < 2; ++ks) {
        const bf16x8 a = *(const LAS bf16x8*)(hid + nl * 72 + ks * 32 + kg * 8);
        const bf16x8 bb = *(const bf16x8*)(w2t + (size_t)(ntile * 16 + r16) * 64 + ks * 32 + kg * 8);
        o = __builtin_amdgcn_mfma_f32_16x16x32_bf16(a, bb, o, 0, 0, 0);
    }
    bf16_t* dst = (bf16_t*)(ws + (kv ? WS_VC : WS_KC)) + (size_t)((b * 2 + g) * 128) * 64;
#pragma unroll
    for (int r = 0; r < 4; ++r) { const int n = n0 + mt * 16 + 4 * kg + r; dst[(size_t)n * 64 + ntile * 16 + r16] = (n < 127) ? (bf16_t)f2bf(o[r]) : (bf16_t)0; }
}

__device__ __forceinline__ int crow(int r, int hi) { return (r & 3) + 8 * (r >> 2) + 4 * hi; }
constexpr int KS_LD = 72;
struct AttnSt { float m, l; f32x16 o0, o1; };
__device__ __forceinline__ void attn_init(AttnSt& s) { s.m = -INFINITY; s.l = 0.f;
#pragma unroll
    for (int r = 0; r < 16; ++r) { s.o0[r] = 0.f; s.o1[r] = 0.f; } }
constexpr int TILE_EL = 64 * 64;
__device__ __forceinline__ void dma_kv(const bf16_t* Kg, int ldk, const bf16_t* Vg, int ldv, LAS bf16_t* Ks, LAS bf16_t* Vs, int wave, int lane) {
    const int key = 8 * wave + (lane >> 3), ch = (lane & 7) ^ (key & 7);
    __builtin_amdgcn_global_load_lds((const unsigned*)(Kg + (size_t)key * ldk + ch * 8), (LAS unsigned*)(Ks + wave * 512), 16, 0, 0);
    __builtin_amdgcn_global_load_lds((const unsigned*)(Vg + (size_t)key * ldv + ch * 8), (LAS unsigned*)(Vs + wave * 512), 16, 0, 0);
}
__device__ __forceinline__ int swz_el(int key, int chunk) { return key * 64 + ((chunk ^ (key & 7)) << 3); }
__device__ __forceinline__ void attn_scores(const LAS bf16_t* Ks, const bf16x8 (&qr)[4], f32x16& p0, f32x16& p1, int r32, int hi) {
#pragma unroll
    for (int r = 0; r < 16; ++r) { p0[r] = 0.f; p1[r] = 0.f; }
#pragma unroll
    for (int d0 = 0; d0 < 4; ++d0) {
        const bf16x8 k0 = *(const LAS bf16x8*)(Ks + swz_el(r32, 2 * d0 + hi));
        const bf16x8 k1 = *(const LAS bf16x8*)(Ks + swz_el(32 + r32, 2 * d0 + hi));
        p0 = __builtin_amdgcn_mfma_f32_32x32x16_bf16(k0, qr[d0], p0, 0, 0, 0);
        p1 = __builtin_amdgcn_mfma_f32_32x32x16_bf16(k1, qr[d0], p1, 0, 0, 0);
    }
}
typedef short v4i16_t __attribute__((ext_vector_type(4)));
__device__ __forceinline__ void attn_pv(const LAS bf16_t* Vs, const f32x16& p0, const f32x16& p1, f32x16& o0, f32x16& o1, int r32, int hi) {
    bf16x8 pa[4];
#pragma unroll
    for (int s = 0; s < 2; ++s) {
        u32x4 w0, w1;
#pragma unroll
        for (int j = 0; j < 4; ++j) { w0[j] = cvt_pk(p0[8 * s + 2 * j], p0[8 * s + 2 * j + 1]); w1[j] = cvt_pk(p1[8 * s + 2 * j], p1[8 * s + 2 * j + 1]); }
        pa[s] = __builtin_bit_cast(bf16x8, w0); pa[2 + s] = __builtin_bit_cast(bf16x8, w1);
    }
    const int lane = hi * 32 + r32;
    const int krow = 4 * hi + ((lane & 15) >> 2), cb = 2 * ((lane >> 4) & 1) + ((lane & 3) >> 1), sub = 4 * (lane & 1);
#pragma unroll
    for (int s = 0; s < 4; ++s) {
#pragma unroll
        for (int dh = 0; dh < 2; ++dh) {
            const int k0 = 16 * s + krow, k1 = k0 + 8;
            const s16x4 lo = __builtin_bit_cast(s16x4, __builtin_amdgcn_ds_read_tr16_b64_v4i16((LAS v4i16_t*)(Vs + swz_el(k0, 4 * dh + cb) + sub)));
            const s16x4 hi4 = __builtin_bit_cast(s16x4, __builtin_amdgcn_ds_read_tr16_b64_v4i16((LAS v4i16_t*)(Vs + swz_el(k1, 4 * dh + cb) + sub)));
            const bf16x8 vfr = (bf16x8){lo[0], lo[1], lo[2], lo[3], hi4[0], hi4[1], hi4[2], hi4[3]};
            if (dh == 0) o0 = __builtin_amdgcn_mfma_f32_32x32x16_bf16(pa[s], vfr, o0, 0, 0, 0);
            else         o1 = __builtin_amdgcn_mfma_f32_32x32x16_bf16(pa[s], vfr, o1, 0, 0, 0);
        }
    }
}
__device__ __forceinline__ void attn_online(const LAS bf16_t* Vt, f32x16& x0, f32x16& x1, AttnSt& st, LAS float* wsf, int r32, int hi) {
    float mx = -INFINITY;
#pragma unroll
    for (int r = 0; r < 16; ++r) mx = fmaxf(mx, fmaxf(x0[r], x1[r]));
    mx = fmaxf(mx, __shfl_xor(mx, 32));
    const float mn = fmaxf(st.m, mx), ms = (mn == -INFINITY) ? 0.f : mn;
    const float f = exp2f((st.m - ms) * LOG2E);
    if (hi == 0) wsf[r32] = f;
    float rs = 0.f;
#pragma unroll
    for (int r = 0; r < 16; ++r) { x0[r] = exp2f((x0[r] - ms) * LOG2E); x1[r] = exp2f((x1[r] - ms) * LOG2E); rs += x0[r] + x1[r]; }
    st.l = st.l * f + rs; st.m = mn;
    const LAS float* wr_ = wsf + 4 * hi;
#pragma unroll
    for (int r = 0; r < 16; ++r) { const float fr_ = wr_[(r & 3) + 8 * (r >> 2)]; st.o0[r] *= fr_; st.o1[r] *= fr_; }
    attn_pv(Vt, x0, x1, st.o0, st.o1, r32, hi);
}
__device__ __forceinline__ void attn_scale_rows(f32x16& o0, f32x16& o1, float inv, LAS float* wsf, int r32, int hi) {
    if (hi == 0) wsf[r32] = inv;
    const LAS float* wr_ = wsf + 4 * hi;
#pragma unroll
    for (int r = 0; r < 16; ++r) { const float f = wr_[(r & 3) + 8 * (r >> 2)]; o0[r] *= f; o1[r] *= f; }
}

__device__ UNIT_INLINE void swa_unit(Frame& F, int unit, const bf16_t* U1, bf16_t* Y, const float* sinks) {
    const int qb = unit & 31, g = (unit >> 5) & 1, b = unit >> 6;
    const int r32 = F.lane & 31, hi = F.lane >> 5, hr = F.wave >> 1, qs = F.wave & 1, head = g * 4 + hr;
    const int q0 = qb * 64, tq = q0 + qs * 32 + r32;
    LAS bf16_t* Ks = (LAS bf16_t*)F.lds; LAS bf16_t* Vt = Ks + TILE_EL; LAS bf16_t* Ks1 = Vt + TILE_EL; LAS bf16_t* Vt1 = Ks1 + TILE_EL;
    LAS float* wsf = (LAS float*)(F.lds + 4 * TILE_EL * 2) + F.wave * 32;
    const bf16_t* rowb = U1 + (size_t)(b * SEQ) * UW;
    bf16x8 qr[4];
#pragma unroll
    for (int d0 = 0; d0 < 4; ++d0) qr[d0] = *(const bf16x8*)(rowb + (size_t)tq * UW + UC_SQ + head * 64 + d0 * 16 + hi * 8);
    AttnSt st; attn_init(st);
    {
        const int kt0 = (qb >= 2 ? qb - 2 : 0);
        const bf16_t* kg = rowb + UC_SKV + g * 64; const bf16_t* vg = kg + 128;
        __syncthreads();
        dma_kv(kg + (size_t)(kt0 * 64) * UW, UW, vg + (size_t)(kt0 * 64) * UW, UW, Ks, Vt, F.wave, F.lane);
        __syncthreads();
        int cur = 0;
#pragma unroll 1
        for (int kt = kt0; kt <= qb; ++kt) {
            if (kt < qb) dma_kv(kg + (size_t)((kt + 1) * 64) * UW, UW, vg + (size_t)((kt + 1) * 64) * UW, UW, cur ? Ks : Ks1, cur ? Vt : Vt1, F.wave, F.lane);
            const LAS bf16_t* kc_ = cur ? Ks1 : Ks; const LAS bf16_t* vc_ = cur ? Vt1 : Vt;
            f32x16 x0, x1; attn_scores(kc_, qr, x0, x1, r32, hi);
#pragma unroll
            for (int r = 0; r < 16; ++r) { const int d0 = tq - (kt * 64 + crow(r, hi)), d1 = d0 - 32;
                x0[r] = (d0 >= 0 && d0 < 128) ? x0[r] * 0.125f : -INFINITY; x1[r] = (d1 >= 0 && d1 < 128) ? x1[r] * 0.125f : -INFINITY; }
            attn_online(vc_, x0, x1, st, wsf, r32, hi);
            __syncthreads();
            cur ^= 1;
        }
    }
    const float l = st.l + __shfl_xor(st.l, 32), sk = sinks[head];
    const float mf = fmaxf(st.m, sk), a = exp2f((st.m - mf) * LOG2E), inv = a / (l * a + exp2f((sk - mf) * LOG2E));
    attn_scale_rows(st.o0, st.o1, inv, wsf, r32, hi);
    bf16_t* yb = Y + (size_t)(b * SEQ + q0 + qs * 32) * YW + 3 * 512 + head * 64 + r32;
#pragma unroll
    for (int r = 0; r < 16; ++r) { bf16_t* yp = yb + (size_t)crow(r, hi) * YW; yp[0] = (bf16_t)f2bf(st.o0[r]); yp[32] = (bf16_t)f2bf(st.o1[r]); }
}

constexpr int NSA_K1_OFF = 2 * TILE_EL * 2;
constexpr int NSA_PS_OFF = 4 * TILE_EL * 2;
constexpr int NSA_IMP_OFF = NSA_PS_OFF + 64 * 128 * 4;
constexpr int NSA_SEL_OFF = NSA_IMP_OFF + 64 * 33 * 4;
__device__ __forceinline__ float nsa_gate(const float* gbase, int r, int i) { return sigmoidf_(gbase[((r & 3) + 8 * (r >> 2)) * 32 + i * 8]); }
__device__ UNIT_INLINE void nsa_unit(Frame& F, int unit, const bf16_t* U1, bf16_t* Y, const float* misc, const unsigned char* ws) {
    const int qb = 31 - (unit & 31), g = (unit >> 5) & 1, b = unit >> 6;
    const int r32 = F.lane & 31, hi = F.lane >> 5, hr = F.wave >> 1, qs = F.wave & 1, head = g * 4 + hr;
    const int q0 = qb * 64, ql = qs * 32 + r32, tq = q0 + ql;
    LAS bf16_t* Ks = (LAS bf16_t*)F.lds; LAS bf16_t* Vt = Ks + TILE_EL;
    LAS bf16_t* Ks1 = (LAS bf16_t*)(F.lds + NSA_K1_OFF); LAS bf16_t* Vt1 = Ks1 + TILE_EL;
    LAS unsigned* psum = (LAS unsigned*)(F.lds + NSA_PS_OFF);
    LAS float* impb = (LAS float*)(F.lds + NSA_IMP_OFF);
    LAS unsigned* selm = (LAS unsigned*)(F.lds + NSA_SEL_OFF);
    LAS float* wsf = (LAS float*)(F.lds + NSA_SEL_OFF + 256) + F.wave * 32;
    const bf16_t* rowb = U1 + (size_t)(b * SEQ) * UW;
    const int grow = b * SEQ + q0 + qs * 32;
    const float* gbase = misc + (size_t)(grow + 4 * hi) * 32 + 8 + head;
    bf16x8 qr[4];
#pragma unroll
    for (int d0 = 0; d0 < 4; ++d0) qr[d0] = *(const bf16x8*)(rowb + (size_t)tq * UW + UC_NQ + head * 64 + d0 * 16 + hi * 8);
    f32x16 ya0, ya1;
#pragma unroll
    for (int r = 0; r < 16; ++r) { ya0[r] = 0.f; ya1[r] = 0.f; }
    __syncthreads();
    for (int i = F.tid; i < 64 * 128; i += 512) psum[i] = 0u;
#ifndef NSA_NO_CMP
    {
        const bf16_t* kc = (const bf16_t*)(ws + WS_KC) + (size_t)((b * 2 + g) * 128) * 64;
        const bf16_t* vc = (const bf16_t*)(ws + WS_VC) + (size_t)((b * 2 + g) * 128) * 64;
        dma_kv(kc, 64, vc, 64, Ks, Vt, F.wave, F.lane);
        dma_kv(kc + 64 * 64, 64, vc + 64 * 64, 64, Ks1, Vt1, F.wave, F.lane);
        __syncthreads();
        float m = -INFINITY, l = 0.f;
#pragma unroll 1
        for (int tl = 0; tl < 2; ++tl) {
            f32x16 x0, x1; attn_scores(tl ? Ks1 : Ks, qr, x0, x1, r32, hi);
            float mx = -INFINITY;
#pragma unroll
            for (int r = 0; r < 16; ++r) { const int n0 = tl * 64 + crow(r, hi), n1 = n0 + 32;
                x0[r] = (16 * n0 + 31 <= tq) ? x0[r] * 0.125f : -INFINITY; x1[r] = (16 * n1 + 31 <= tq) ? x1[r] * 0.125f : -INFINITY; mx = fmaxf(mx, fmaxf(x0[r], x1[r])); }
            mx = fmaxf(mx, __shfl_xor(mx, 32));
            const float mn = fmaxf(m, mx), ms = (mn == -INFINITY) ? 0.f : mn;
            float rs = 0.f;
#pragma unroll
            for (int r = 0; r < 16; ++r) rs += exp2f((x0[r] - ms) * LOG2E) + exp2f((x1[r] - ms) * LOG2E);
            l = l * exp2f((m - ms) * LOG2E) + rs; m = mn;
        }
        l += __shfl_xor(l, 32);
        const float inv = l > 0.f ? 1.0f / l : 0.f, ms = (m == -INFINITY) ? 0.f : m;
        f32x16 oc0, oc1;
#pragma unroll
        for (int r = 0; r < 16; ++r) { oc0[r] = 0.f; oc1[r] = 0.f; }
#pragma unroll 1
        for (int tl = 0; tl < 2; ++tl) {
            f32x16 x0, x1; attn_scores(tl ? Ks1 : Ks, qr, x0, x1, r32, hi);
#pragma unroll
            for (int r = 0; r < 16; ++r) { const int n0 = tl * 64 + crow(r, hi), n1 = n0 + 32;
                x0[r] = (16 * n0 + 31 <= tq) ? exp2f((x0[r] * 0.125f - ms) * LOG2E) * inv : 0.f;
                x1[r] = (16 * n1 + 31 <= tq) ? exp2f((x1[r] * 0.125f - ms) * LOG2E) * inv : 0.f;
                atomicAdd((unsigned*)(psum + ql * 128 + n0), (unsigned)(x0[r] * 16777216.0f + 0.5f)); atomicAdd((unsigned*)(psum + ql * 128 + n1), (unsigned)(x1[r] * 16777216.0f + 0.5f)); }
            attn_pv(tl ? Vt1 : Vt, x0, x1, oc0, oc1, r32, hi);
        }
#pragma unroll
        for (int r = 0; r < 16; ++r) { const float gt = nsa_gate(gbase, r, 0); ya0[r] += gt * oc0[r]; ya1[r] += gt * oc1[r]; }
    }
#endif
    __syncthreads();
#ifndef NSA_NO_TOPK
    if (qb <= 7) { if (F.tid < 64) selm[F.tid] = (2u << qb) - 1u; }
    else {
        const int q = F.tid & 63, jg = F.tid >> 6;
#pragma unroll
        for (int jj = 0; jj < 4; ++jj) { const int j = jg * 4 + jj; unsigned sacc = 0u;
#pragma unroll
            for (int d = -1; d <= 3; ++d) { const int n = 4 * j + d; if (n >= 0 && n < 127) sacc += psum[q * 128 + n]; }
            impb[q * 33 + j] = (float)sacc; }
        if (jg == 0) selm[q] = 1u | (1u << qb);
        __syncthreads();
        unsigned bits = 0u;
#pragma unroll 1
        for (int jj = 0; jj < 4; ++jj) { const int j = jg * 4 + jj;
            if (j >= 1 && j < qb) { const float vj = impb[q * 33 + j]; int rank = 0;
#pragma unroll 1
                for (int i2 = 1; i2 < qb; ++i2) { const float vi = impb[q * 33 + i2]; rank += (vi > vj || (vi == vj && i2 < j)) ? 1 : 0; }
                if (rank < 6) bits |= 1u << j; } }
        if (bits) atomicOr((unsigned*)(selm + q), bits);
    }
#endif
    __syncthreads();
    unsigned uni;
    { unsigned v = selm[F.lane];
#pragma unroll
      for (int o = 1; o < 64; o <<= 1) v |= __shfl_xor(v, o);
      uni = __builtin_amdgcn_readfirstlane(v); }
    const unsigned mysel = selm[ql];
#pragma unroll 1
    for (int br = 0; br < 2; ++br) {
        const unsigned lowm = (qb >= 8) ? ~((1u << (qb - 8)) - 1u) : 0xffffffffu;
        const unsigned tmask = (br == 0) ? uni : (((2u << qb) - 1u) & lowm);
        const unsigned qsel = (br == 0) ? mysel : 0xffffffffu;
        const int wlim = (br == 0) ? (1 << 30) : 512;
        const int kcol = UC_NKV + (2 + 2 * br) * 128 + g * 64;
        AttnSt st; attn_init(st);
        {
            const bf16_t* kg = rowb + kcol; const bf16_t* vg = kg + 128;
            unsigned rem = tmask;
            int j = __builtin_ctz(rem); rem &= rem - 1u;
            __syncthreads();
            dma_kv(kg + (size_t)(j * 64) * UW, UW, vg + (size_t)(j * 64) * UW, UW, Ks, Vt, F.wave, F.lane);
            __syncthreads();
            int cur = 0;
#pragma unroll 1
            for (;;) {
                const int jn = rem ? __builtin_ctz(rem) : -1; rem &= rem - 1u;
                if (jn >= 0) dma_kv(kg + (size_t)(jn * 64) * UW, UW, vg + (size_t)(jn * 64) * UW, UW, cur ? Ks : Ks1, cur ? Vt : Vt1, F.wave, F.lane);
                const LAS bf16_t* kc_ = cur ? Ks1 : Ks; const LAS bf16_t* vc_ = cur ? Vt1 : Vt;
                f32x16 x0, x1; attn_scores(kc_, qr, x0, x1, r32, hi);
                const bool sel = (qsel >> j) & 1u;
#pragma unroll
                for (int r = 0; r < 16; ++r) { const int d0 = tq - (j * 64 + crow(r, hi)), d1 = d0 - 32;
                    x0[r] = (sel && d0 >= 0 && d0 < wlim) ? x0[r] * 0.125f : -INFINITY; x1[r] = (sel && d1 >= 0 && d1 < wlim) ? x1[r] * 0.125f : -INFINITY; }
                attn_online(vc_, x0, x1, st, wsf, r32, hi);
                __syncthreads();
                if (jn < 0) break;
                j = jn; cur ^= 1;
            }
        }
        const float l = st.l + __shfl_xor(st.l, 32), inv = l > 0.f ? 1.0f / l : 0.f;
        attn_scale_rows(st.o0, st.o1, inv, wsf, r32, hi);
#pragma unroll
        for (int r = 0; r < 16; ++r) { const float gt = nsa_gate(gbase, r, 1 + br); ya0[r] += gt * st.o0[r]; ya1[r] += gt * st.o1[r]; }
    }
    bf16_t* yb = Y + (size_t)grow * YW + 1 * 512 + head * 64 + r32;
#pragma unroll
    for (int r = 0; r < 16; ++r) { bf16_t* yp = yb + (size_t)crow(r, hi) * YW; yp[0] = (bf16_t)f2bf(ya0[r]); yp[32] = (bf16_t)f2bf(ya1[r]); }
}

__device__ __forceinline__ void ld4x16_sys(u32x4& a, u32x4& b, u32x4& c, u32x4& d, const void* pa, const void* pb, const void* pc, const void* pd) {
    asm volatile("global_load_dwordx4 %0, %4, off sc0 sc1\n\tglobal_load_dwordx4 %1, %5, off sc0 sc1\n\tglobal_load_dwordx4 %2, %6, off sc0 sc1\n\tglobal_load_dwordx4 %3, %7, off sc0 sc1\n\ts_waitcnt vmcnt(0)"
                 : "=&v"(a), "=&v"(b), "=&v"(c), "=&v"(d) : "v"(pa), "v"(pb), "v"(pc), "v"(pd) : "memory");
}
constexpr int SL = 136;
constexpr int SSD_CS = 0, SSD_BS = SSD_CS + 128 * SL * 2, SSD_BT = SSD_BS + 128 * SL * 2, SSD_XT = SSD_BT + 128 * SL * 2, SSD_PV = SSD_XT + 64 * SL * 2,
              SSD_DT = SSD_PV + 64 * SL * 2, SSD_AC = SSD_DT + 512, SSD_A = SSD_AC + 512, SSD_END = SSD_A + 512;
static_assert(SSD_END <= LDS_USER, "ssd lds");
__device__ UNIT_INLINE void ssd_unit(Frame& F, int unit, int L, KArgs KA, const bf16_t* U1, bf16_t* Y, const float* misc, float* ssq, unsigned* rdy) {
    const int h = unit & 7, b = unit >> 3, g = h >> 2;
    LAS bf16_t* Cs = (LAS bf16_t*)(F.lds + SSD_CS); LAS bf16_t* Bs = (LAS bf16_t*)(F.lds + SSD_BS); LAS bf16_t* Bt = (LAS bf16_t*)(F.lds + SSD_BT);
    LAS bf16_t* Xt = (LAS bf16_t*)(F.lds + SSD_XT); LAS bf16_t* Pv = (LAS bf16_t*)(F.lds + SSD_PV);
    LAS float* dts = (LAS float*)(F.lds + SSD_DT); LAS float* acs = (LAS float*)(F.lds + SSD_AC); LAS float* as_ = (LAS float*)(F.lds + SSD_A);
    const float* cw = IN_F(5) + (size_t)L * 4 * 1024; const float* cb = IN_F(6) + (size_t)L * 1024;
    const float dtb = IN_F(7)[L * 8 + h], Ah = -expf(IN_F(8)[L * 8 + h]), Dh = IN_F(9)[L * 8 + h];
    const int r16 = F.lane & 15, kg = F.lane >> 4, w = F.wave;
    const bf16_t* rowb = U1 + (size_t)(b * SEQ) * UW;
    f32x4 stt[4];
#pragma unroll
    for (int j = 0; j < 4; ++j) stt[j] = (f32x4){0.f, 0.f, 0.f, 0.f};
    __syncthreads();
    for (int i = F.tid; i < 64 * SL / 2; i += 512) ((LAS unsigned*)Pv)[i] = 0u;
    for (int c = 0; c < 16; ++c) {
        const int t0 = c * 128;
        __syncthreads();
        if (rdy && (c & 1) == 0) { if (F.tid == 0) dep_poll_lane(rdy + 64 * (8 * b + (c >> 1)), 7u); __syncthreads(); }
        for (int i = F.tid; i < 40 * 128; i += 512) {
            const int ch = i % 40, l = i / 40;
            const int cidx = (ch < 8) ? (h * 64 + ch * 8) : (ch < 24 ? 512 + g * 128 + (ch - 8) * 8 : 768 + g * 128 + (ch - 24) * 8);
            float a8[8];
            { const f32x4 b0 = *(const f32x4*)(cb + cidx), b1 = *(const f32x4*)(cb + cidx + 4);
#pragma unroll
              for (int j = 0; j < 4; ++j) { a8[j] = b0[j]; a8[4 + j] = b1[j]; } }
            u32x4 xq[4];
            { const int tb = t0 + l - 3; const bf16_t* pb_ = rowb + UC_XBC + cidx;
              xq[0] = *(const u32x4*)(pb_ + (size_t)(tb < 0 ? 0 : tb) * UW); xq[1] = *(const u32x4*)(pb_ + (size_t)(tb + 1 < 0 ? 0 : tb + 1) * UW); xq[2] = *(const u32x4*)(pb_ + (size_t)(tb + 2 < 0 ? 0 : tb + 2) * UW); xq[3] = *(const u32x4*)(pb_ + (size_t)(tb + 3) * UW); }
#pragma unroll
            for (int k = 0; k < 4; ++k) {
                const int t = t0 + l - 3 + k;
                if (t >= 0) {
                    const u32x4 xv = xq[k];
                    const f32x4 w0 = *(const f32x4*)(cw + k * 1024 + cidx), w1 = *(const f32x4*)(cw + k * 1024 + cidx + 4);
#pragma unroll
                    for (int j = 0; j < 4; ++j) { a8[2 * j] += bf2f(xv[j] & 0xffffu) * (j < 2 ? w0[2 * j] : w1[2 * j - 4]); a8[2 * j + 1] += bf2f(xv[j] >> 16) * (j < 2 ? w0[2 * j + 1] : w1[2 * j - 3]); }
                }
            }
            unsigned short o[8];
#pragma unroll
            for (int j = 0; j < 8; ++j) o[j] = (unsigned short)f2bf(siluf_(a8[j]));
            if (ch < 8) {
#pragma unroll
                for (int j = 0; j < 8; ++j) Xt[(ch * 8 + j) * SL + l] = o[j];
            } else if (ch < 24) {
                const int n0 = (ch - 8) * 8;
                u32x4 pk; pk.x = o[0] | ((unsigned)o[1] << 16); pk.y = o[2] | ((unsigned)o[3] << 16); pk.z = o[4] | ((unsigned)o[5] << 16); pk.w = o[6] | ((unsigned)o[7] << 16);
                *(LAS u32x4*)(Bs + l * SL + n0) = pk;
#pragma unroll
                for (int j = 0; j < 8; ++j) Bt[(n0 + j) * SL + l] = o[j];
            } else {
                const int n0 = (ch - 24) * 8;
                u32x4 pk; pk.x = o[0] | ((unsigned)o[1] << 16); pk.y = o[2] | ((unsigned)o[3] << 16); pk.z = o[4] | ((unsigned)o[5] << 16); pk.w = o[6] | ((unsigned)o[7] << 16);
                *(LAS u32x4*)(Cs + l * SL + n0) = pk;
            }
        }
        if (F.tid < 128) { const float dt = softplusf_(misc[(size_t)(b * SEQ + t0 + F.tid) * 32 + h] + dtb); dts[F.tid] = dt; as_[F.tid] = dt * Ah; }
        __syncthreads();
        if (F.tid < 128) { float s = 0.f; for (int j = 0; j <= F.tid; ++j) s += as_[j]; acs[F.tid] = s; }
        __syncthreads();
        f32x4 cbv[8];
#pragma unroll
        for (int j = 0; j < 8; ++j) cbv[j] = (f32x4){0.f, 0.f, 0.f, 0.f};
#pragma unroll
        for (int ks = 0; ks < 4; ++ks) {
            const bf16x8 a = *(const LAS bf16x8*)(Cs + (16 * w + r16) * SL + ks * 32 + kg * 8);
#pragma unroll
            for (int j = 0; j < 8; ++j) { const bf16x8 bb = *(const LAS bf16x8*)(Bs + (16 * j + r16) * SL + ks * 32 + kg * 8); cbv[j] = __builtin_amdgcn_mfma_f32_16x16x32_bf16(a, bb, cbv[j], 0, 0, 0); }
        }
        __syncthreads();
        LAS bf16_t* Ws = Bs;
#pragma unroll
        for (int j = 0; j < 8; ++j)
#pragma unroll
            for (int r = 0; r < 4; ++r) { const int l = 16 * w + 4 * kg + r, s = 16 * j + r16;
                const float wv = (s <= l) ? cbv[j][r] * __expf(acs[l] - acs[s]) * dts[s] : 0.f;
                Ws[l * SL + s] = (bf16_t)f2bf(wv); }
        __syncthreads();
        f32x4 yd[4], yo[4];
#pragma unroll
        for (int j = 0; j < 4; ++j) { yd[j] = (f32x4){0.f, 0.f, 0.f, 0.f}; yo[j] = (f32x4){0.f, 0.f, 0.f, 0.f}; }
#pragma unroll
        for (int ks = 0; ks < 4; ++ks) {
            const bf16x8 aw = *(const LAS bf16x8*)(Ws + (16 * w + r16) * SL + ks * 32 + kg * 8);
            const bf16x8 ac = *(const LAS bf16x8*)(Cs + (16 * w + r16) * SL + ks * 32 + kg * 8);
#pragma unroll
            for (int j = 0; j < 4; ++j) {
                const bf16x8 bx = *(const LAS bf16x8*)(Xt + (16 * j + r16) * SL + ks * 32 + kg * 8);
                const bf16x8 bp = *(const LAS bf16x8*)(Pv + (16 * j + r16) * SL + ks * 32 + kg * 8);
                yd[j] = __builtin_amdgcn_mfma_f32_16x16x32_bf16(aw, bx, yd[j], 0, 0, 0);
                yo[j] = __builtin_amdgcn_mfma_f32_16x16x32_bf16(ac, bp, yo[j], 0, 0, 0);
            }
        }
#pragma unroll
        for (int r = 0; r < 4; ++r) {
            const int l = 16 * w + 4 * kg + r; const float ea = __expf(acs[l]); const size_t trow = (size_t)(b * SEQ + t0 + l);
            float sq = 0.f;
#pragma unroll
            for (int j = 0; j < 4; ++j) { const int p = 16 * j + r16;
                const float x = bf2f(Xt[p * SL + l]);
                const float z = bf2f(rowb[(size_t)(t0 + l) * UW + UC_Z + h * 64 + p]);
                const float yv = (yd[j][r] + yo[j][r] * ea + Dh * x) * siluf_(z);
                sq += yv * yv;
                Y[trow * YW + h * 64 + p] = (bf16_t)f2bf(yv); }
            sq += __shfl_xor(sq, 1); sq += __shfl_xor(sq, 2); sq += __shfl_xor(sq, 4); sq += __shfl_xor(sq, 8);
            if (r16 == 0) ssq[trow * 8 + h] = sq;
        }
        __syncthreads();
        { const float aend = acs[127];
          for (int i = F.tid; i < 64 * 128; i += 512) { const int p = i >> 7, l = i & 127; Xt[p * SL + l] = (bf16_t)f2bf(bf2f(Xt[p * SL + l]) * dts[l] * __expf(aend - acs[l])); } }
        __syncthreads();
        { const float cd = __expf(acs[127]); const int pt = w & 3;
#pragma unroll
          for (int j = 0; j < 4; ++j) stt[j] *= cd;
#pragma unroll
          for (int ks = 0; ks < 4; ++ks) {
              const bf16x8 a = *(const LAS bf16x8*)(Xt + (16 * pt + r16) * SL + ks * 32 + kg * 8);
#pragma unroll
              for (int j = 0; j < 4; ++j) { const int nt = (w >> 2) * 4 + j; const bf16x8 bb = *(const LAS bf16x8*)(Bt + (16 * nt + r16) * SL + ks * 32 + kg * 8);
                  stt[j] = __builtin_amdgcn_mfma_f32_16x16x32_bf16(a, bb, stt[j], 0, 0, 0); }
          }
#pragma unroll
          for (int j = 0; j < 4; ++j) { const int nt = (w >> 2) * 4 + j;
#pragma unroll
              for (int r = 0; r < 4; ++r) Pv[(16 * pt + 4 * kg + r) * SL + 16 * nt + r16] = (bf16_t)f2bf(stt[j][r]); }
        }
    }
}

constexpr int RW_CT = 16, RW_NC = SEQ / RW_CT;
constexpr int SB_BT = 0, SB_RT = 2304, SB_VT = 4608, SB_MT = 6656  , SB_CHT = 8704, SB_KHT = 10752, SB_G16 = 12800,
              SB_V = 13056  , SB_G = 17152  , SB_BS = 19200, SB_SIZE = 19456;
constexpr int RW_OUT = 2 * SB_SIZE;
constexpr int TR_R = RW_OUT + 2 * 4096, TR_K = TR_R + 4096, TR_DEC = TR_K + 4096, TR_NB = TR_DEC + 4096, TR_CC = TR_NB + 4096,
              TR_CH = TR_CC + 4096, TR_KH = TR_CH + 2304  , TR_ACB = TR_KH + 2304  ,
              RW_WDH = TR_ACB + 1024, RW_ADH = RW_WDH + 16 * 72 * 2, RW_GDH = RW_ADH + 16 * 72 * 2, RW_CONST = RW_GDH + 16 * 136 * 2  ,
              RW_MU = RW_CONST + 5 * 256  , RW_RAW = RW_MU + 448 * 4,
              RAW_R = 0, RAW_K = 3072, RAW_V = 6144, RAW_L = 9216, RAW_SIZE = 18432, RW_END = RW_RAW + 2 * RAW_SIZE;
static_assert(RW_END <= LDS_USER && RW_RAW % 16 == 0 && TR_CH % 16 == 0 && RW_WDH % 16 == 0, "rwkv lds");
template <int CTRL> __device__ __forceinline__ float dppf(float x) { return __int_as_float(__builtin_amdgcn_update_dpp(0, __float_as_int(x), CTRL, 0xf, 0xf, false)); }
__device__ __forceinline__ float reduce8(float x) { x += dppf<0xB1>(x); x += dppf<0x4E>(x); x += dppf<0x141>(x); return x; }
__device__ __forceinline__ float reduce16(float x) { x = reduce8(x); x += dppf<0x140>(x); return x; }
__device__ __forceinline__ float fast_tanh(float x) { const float e = __expf(2.0f * x); return 1.0f - 2.0f / (e + 1.0f); }
#define RW_BAR() do { asm volatile("s_waitcnt lgkmcnt(0)" ::: "memory"); __builtin_amdgcn_s_barrier(); asm volatile("" ::: "memory"); } while (0)
typedef float f32x2_t_ __attribute__((ext_vector_type(2))); typedef __bf16 bf16x2_t_ __attribute__((ext_vector_type(2)));
__device__ __forceinline__ unsigned cvtpk_c(float lo, float hi) { const f32x2_t_ v = {lo, hi}; const bf16x2_t_ b = __builtin_convertvector(v, bf16x2_t_); return __builtin_bit_cast(unsigned, b); }
__device__ __forceinline__ u32x2 pack4c(f32x4 v) { u32x2 w; w.x = cvtpk_c(v[0], v[1]); w.y = cvtpk_c(v[2], v[3]); return w; }
__device__ __forceinline__ bf16x8 mk8(u32x2 lo, u32x2 hi) { return __builtin_bit_cast(bf16x8, (u32x4){lo.x, lo.y, hi.x, hi.y}); }
__device__ __forceinline__ void rw_post(const LAS unsigned char* lds, const LAS unsigned char* sb, const LAS float* out, bf16_t* yrow0, int ti, int cg) {
    const int o = ti * 64 + cg * 4;
    const f32x4 x = *(const LAS f32x4*)(out + o), v = *(const LAS f32x4*)((const LAS float*)(sb + SB_V) + o);
    const u32x2 gq = *(const LAS u32x2*)((const LAS bf16_t*)(sb + SB_G) + o);
    const LAS float* cst = (const LAS float*)(lds + RW_CONST) + cg * 4;
    const f32x4 lw = *(const LAS f32x4*)(cst + 192), lb = *(const LAS f32x4*)(cst + 256);
    const float bs = ((const LAS float*)(sb + SB_BS))[ti];
    const float mean = reduce16((x[0] + x[1]) + (x[2] + x[3])) * (1.0f / 64.0f);
    const f32x4 d = x - mean;
    const float rstd = rsqrtf(reduce16((d[0] * d[0] + d[1] * d[1]) + (d[2] * d[2] + d[3] * d[3])) * (1.0f / 64.0f) + 64e-5f);
    const f32x4 g = unpack4(gq);
    const f32x4 y = (d * rstd * lw + lb + v * bs) * g;
    *(u32x2*)(yrow0 + (size_t)ti * YW + cg * 4) = pack4(y);
}
__device__ UNIT_INLINE void rwkv_unit(Frame& F, int unit, int L, KArgs KA, const bf16_t* U1, bf16_t* Y, unsigned* rdy) {
    (void)rdy;
    const int h = unit & 7, b = unit >> 3;
    const bool scanner = F.wave < 4;
    LAS unsigned char* lds = F.lds;
    const bf16_t* rowb = U1 + (size_t)(b * SEQ) * UW + UC_RW;
    bf16_t* ybase = Y + (size_t)(b * SEQ) * YW + 2 * 512 + h * 64;
    const int ww = F.wave & 3, wtid = F.tid & 255, r16 = F.lane & 15, kg = F.lane >> 4;
    const int wti = wtid >> 4, wcg = wtid & 15;
    f32x4 X0 = (f32x4){0.f, 0.f, 0.f, 0.f}, X1 = X0, X2 = X0, X3 = X0;
    float w0n = 0.f, a0n = 0.f;
    __syncthreads();
    if (!scanner) { const int cn = h * 64 + 16 * ww + r16; w0n = IN_F(15)[L * 512 + cn]; a0n = IN_F(17)[L * 512 + cn]; }
    if (F.tid < 320) { const int v = F.tid >> 6; ((LAS float*)(lds + RW_CONST))[F.tid] = IN_F(20 + v)[L * 512 + h * 64 + (F.tid & 63)]; }
    if (F.tid < 448) { const int i = F.tid; const int col = i < 64 ? h * 64 + i : i < 128 ? 512 + h * 64 + (i - 64) : i < 192 ? 1024 + h * 64 + (i - 128) : 1536 + (i - 192);
        ((LAS float*)(lds + RW_MU))[i] = IN_F(14)[(size_t)L * 1792 + col]; }
    const u32x4* lwf = (const u32x4*)(KA->ws + WS_LW) + ((size_t)((L * 8 + h) * 4 + ww) * 8) * 64 + F.lane;
    asm volatile("s_waitcnt vmcnt(0)" ::: "memory");
    __syncthreads();
#define RW_DMA(cc) do { const int t0_ = (cc) * RW_CT - 1; LAS unsigned char* rb_ = lds + RW_RAW + ((cc) & 1) * RAW_SIZE; \
        _Pragma("unroll") for (int q_ = 0; q_ < 5; ++q_) { const int ix_ = ww + 4 * q_; if (ix_ < 18) { \
            int tok_, col_, dst_; \
            if (ix_ < 9) { const int kind_ = ix_ / 3, p_ = ix_ % 3; tok_ = 8 * p_ + (F.lane >> 3); col_ = kind_ * 512 + h * 64 + (F.lane & 7) * 8; dst_ = kind_ * 3072 + p_ * 1024; } \
            else { const int p_ = ix_ - 9; tok_ = 2 * p_ + (F.lane >> 5); col_ = 1536 + (F.lane & 31) * 8; dst_ = RAW_L + p_ * 1024; } \
            int t_ = t0_ + (tok_ > 16 ? 16 : tok_); t_ = t_ < 0 ? 0 : t_; \
            __builtin_amdgcn_global_load_lds((const unsigned*)(rowb + (size_t)t_ * UW + col_), (LAS unsigned*)(rb_ + dst_), 16, 0, 0); } } } while (0)
#pragma unroll 1
    for (int ck = -2; ck < RW_NC; ++ck) {
        const LAS unsigned char* sbc = lds + (ck & 1) * SB_SIZE;
        LAS unsigned char* sbn = lds + ((ck + 1) & 1) * SB_SIZE;
        LAS float* ocur = (LAS float*)(lds + RW_OUT + (ck & 1) * 4096); const LAS float* oprv = (const LAS float*)(lds + RW_OUT + ((ck + 1) & 1) * 4096);
        const bool do_scan = scanner && ck >= 0, do_post = !scanner && ck >= 1, do_prep = !scanner && ck + 1 >= 0 && ck + 1 < RW_NC, do_dma = !scanner && ck + 2 < RW_NC;
        if (do_scan) {
            const LAS bf16_t* BT = (const LAS bf16_t*)(sbc + SB_BT) + r16 * 72 + 4 * kg; const LAS bf16_t* RT = (const LAS bf16_t*)(sbc + SB_RT) + r16 * 72 + 4 * kg;
            const LAS bf16_t* MT = (const LAS bf16_t*)(sbc + SB_MT) + r16 * 16 + 4 * kg;
            const u32x2 vt = *(const LAS u32x2*)((const LAS bf16_t*)(sbc + SB_VT) + (16 * ww + r16) * 16 + 4 * kg);
            const u32x2 z2 = (u32x2){0u, 0u};
            const bf16x8 bx0 = mk8(pack4c(X0), pack4c(X1)), bx1 = mk8(pack4c(X2), pack4c(X3));
            f32x4 U = (f32x4){0.f, 0.f, 0.f, 0.f}, O = U;
            U = __builtin_amdgcn_mfma_f32_16x16x32_bf16(mk8(*(const LAS u32x2*)BT, *(const LAS u32x2*)(BT + 16)), bx0, U, 0, 0, 0);
            O = __builtin_amdgcn_mfma_f32_16x16x32_bf16(mk8(*(const LAS u32x2*)RT, *(const LAS u32x2*)(RT + 16)), bx0, O, 0, 0, 0);
            U = __builtin_amdgcn_mfma_f32_16x16x32_bf16(mk8(*(const LAS u32x2*)(BT + 32), *(const LAS u32x2*)(BT + 48)), bx1, U, 0, 0, 0);
            O = __builtin_amdgcn_mfma_f32_16x16x32_bf16(mk8(*(const LAS u32x2*)(RT + 32), *(const LAS u32x2*)(RT + 48)), bx1, O, 0, 0, 0);
            U = __builtin_amdgcn_mfma_f32_16x16x32_bf16(mk8(z2, *(const LAS u32x2*)MT), mk8(z2, vt), U, 0, 0, 0);
            f32x4 SA = __builtin_amdgcn_mfma_f32_16x16x32_bf16(mk8(*(const LAS u32x2*)(MT + 256), z2), mk8(pack4c(U), vt), (f32x4){0.f, 0.f, 0.f, 0.f}, 0, 0, 0);
            const bf16x8 b3 = mk8(pack4c(SA), vt);
            O = __builtin_amdgcn_mfma_f32_16x16x32_bf16(mk8(*(const LAS u32x2*)(MT + 512), *(const LAS u32x2*)(MT + 768)), b3, O, 0, 0, 0);
#pragma unroll
            for (int r = 0; r < 4; ++r) ocur[(4 * kg + r) * 64 + 16 * ww + r16] = O[r];
            const LAS bf16_t* CT = (const LAS bf16_t*)(sbc + SB_CHT) + r16 * 16 + 4 * kg; const LAS bf16_t* KT = (const LAS bf16_t*)(sbc + SB_KHT) + r16 * 16 + 4 * kg;
            const LAS float* g16 = (const LAS float*)(sbc + SB_G16) + 4 * kg;
            X0 = __builtin_amdgcn_mfma_f32_16x16x32_bf16(mk8(*(const LAS u32x2*)CT, *(const LAS u32x2*)KT), b3, X0, 0, 0, 0) * *(const LAS f32x4*)g16;
            X1 = __builtin_amdgcn_mfma_f32_16x16x32_bf16(mk8(*(const LAS u32x2*)(CT + 256), *(const LAS u32x2*)(KT + 256)), b3, X1, 0, 0, 0) * *(const LAS f32x4*)(g16 + 16);
            X2 = __builtin_amdgcn_mfma_f32_16x16x32_bf16(mk8(*(const LAS u32x2*)(CT + 512), *(const LAS u32x2*)(KT + 512)), b3, X2, 0, 0, 0) * *(const LAS f32x4*)(g16 + 32);
            X3 = __builtin_amdgcn_mfma_f32_16x16x32_bf16(mk8(*(const LAS u32x2*)(CT + 768), *(const LAS u32x2*)(KT + 768)), b3, X3, 0, 0, 0) * *(const LAS f32x4*)(g16 + 48);
        }
        if (do_post) rw_post(lds, sbn, oprv, ybase + (size_t)((ck - 1) * RW_CT) * YW, wti, wcg);
        if (!scanner) asm volatile("s_waitcnt vmcnt(0)" ::: "memory");
        if (do_dma) RW_DMA(ck + 2);
        RW_BAR();
        if (do_prep) {
            const LAS unsigned char* raw = lds + RW_RAW + ((ck + 1) & 1) * RAW_SIZE;
            const bool first = (ck + 1 == 0);
#pragma unroll
            for (int n = 0; n < 4; ++n) {
                const int i = wtid + 256 * n;
                if (i < 896) {
                    const int kind = i < 768 ? i >> 7 : 5;
                    const int idx = i - (kind < 5 ? kind * 128 : 640);
                    const int tok = kind < 5 ? idx >> 3 : idx >> 4, piece = kind < 5 ? idx & 7 : idx & 15;
                    int so, mo;
                    if (kind < 3) { so = kind * 3072 + (tok + 1) * 128 + piece * 16; mo = kind * 64 + piece * 8; }
                    else { const int lp = (kind == 3 ? 0 : kind == 4 ? 8 : 16) + piece; so = RAW_L + (tok + 1) * 512 + lp * 16; mo = 192 + lp * 8; }
                    const u32x4 rc = *(const LAS u32x4*)(raw + so);
                    u32x4 rv = *(const LAS u32x4*)(raw + so - (kind < 3 ? 128 : 512));
                    if (first && tok == 0) rv = (u32x4){0u, 0u, 0u, 0u};
                    const f32x4 m0 = *(const LAS f32x4*)((const LAS float*)(lds + RW_MU) + mo), m1 = *(const LAS f32x4*)((const LAS float*)(lds + RW_MU) + mo + 4);
                    float y[8];
#pragma unroll
                    for (int j = 0; j < 4; ++j) {
                        const float x0 = bf2f(rc[j] & 0xffffu), x1 = bf2f(rc[j] >> 16), p0 = bf2f(rv[j] & 0xffffu), p1 = bf2f(rv[j] >> 16);
                        y[2 * j] = x0 + (p0 - x0) * (j < 2 ? m0[2 * j] : m1[2 * j - 4]); y[2 * j + 1] = x1 + (p1 - x1) * (j < 2 ? m0[2 * j + 1] : m1[2 * j - 3]);
                    }
                    if (kind < 3) {
                        LAS float* dst = (kind == 0 ? (LAS float*)(lds + TR_R) : kind == 1 ? (LAS float*)(lds + TR_K) : (LAS float*)(sbn + SB_V)) + tok * 64 + piece * 8;
                        *(LAS f32x4*)dst = (f32x4){y[0], y[1], y[2], y[3]}; *(LAS f32x4*)(dst + 4) = (f32x4){y[4], y[5], y[6], y[7]};
                    } else {
                        LAS bf16_t* dst;
                        if (kind == 3) { dst = (LAS bf16_t*)(lds + RW_WDH) + tok * 72 + piece * 8;
#pragma unroll
                            for (int j = 0; j < 8; ++j) y[j] = fast_tanh(y[j]); }
                        else if (kind == 4) dst = (LAS bf16_t*)(lds + RW_ADH) + tok * 72 + piece * 8;
                        else { dst = (LAS bf16_t*)(lds + RW_GDH) + tok * 136 + piece * 8;
#pragma unroll
                            for (int j = 0; j < 8; ++j) y[j] = sigmoidf_(y[j]); }
                        u32x4 pk; pk.x = cvt_pk(y[0], y[1]); pk.y = cvt_pk(y[2], y[3]); pk.z = cvt_pk(y[4], y[5]); pk.w = cvt_pk(y[6], y[7]);
                        *(LAS u32x4*)dst = pk;
                    }
                }
            }
        }
        RW_BAR();
        if (do_prep) {
            LAS float* sDEC = (LAS float*)(lds + TR_DEC); LAS float* sCC = (LAS float*)(lds + TR_CC); LAS bf16_t* sG = (LAS bf16_t*)(sbn + SB_G);
            const LAS bf16_t* sWDh = (const LAS bf16_t*)(lds + RW_WDH); const LAS bf16_t* sADh = (const LAS bf16_t*)(lds + RW_ADH); const LAS bf16_t* sGDh = (const LAS bf16_t*)(lds + RW_GDH);
            bf16x8 Bf[8];
#pragma unroll
            for (int q = 0; q < 8; ++q) Bf[q] = __builtin_bit_cast(bf16x8, lwf[q * 64]);
            f32x4 aw = (f32x4){0.f, 0.f, 0.f, 0.f}, aa = aw, ag = aw;
#pragma unroll
            for (int ks = 0; ks < 2; ++ks) {
                const bf16x8 xw = *(const LAS bf16x8*)(sWDh + r16 * 72 + 32 * ks + 8 * kg), xa = *(const LAS bf16x8*)(sADh + r16 * 72 + 32 * ks + 8 * kg);
                aw = __builtin_amdgcn_mfma_f32_16x16x32_bf16(xw, Bf[ks], aw, 0, 0, 0); aa = __builtin_amdgcn_mfma_f32_16x16x32_bf16(xa, Bf[2 + ks], aa, 0, 0, 0);
            }
#pragma unroll
            for (int ks = 0; ks < 4; ++ks) { const bf16x8 xg = *(const LAS bf16x8*)(sGDh + r16 * 136 + 32 * ks + 8 * kg); ag = __builtin_amdgcn_mfma_f32_16x16x32_bf16(xg, Bf[4 + ks], ag, 0, 0, 0); }
#pragma unroll
            for (int r = 0; r < 4; ++r) { const int o = (4 * kg + r) * 64 + 16 * ww + r16; sDEC[o] = aw[r] + w0n; sCC[o] = aa[r] + a0n; sG[o] = (bf16_t)f2bf(ag[r]); }
        }
        RW_BAR();
        if (do_prep) {
            const int o = wti * 64 + wcg * 4;
            LAS float* pDEC = (LAS float*)(lds + TR_DEC) + o; LAS float* pNB = (LAS float*)(lds + TR_NB) + o; LAS float* pCC = (LAS float*)(lds + TR_CC) + o;
            LAS float* pK = (LAS float*)(lds + TR_K) + o; const LAS float* pR = (const LAS float*)(lds + TR_R) + o;
            const LAS float* cst = (const LAS float*)(lds + RW_CONST) + wcg * 4;
            const f32x4 wp = *(const LAS f32x4*)pDEC, ap = *(const LAS f32x4*)pCC, kr = *(const LAS f32x4*)pK, rr = *(const LAS f32x4*)pR;
            const f32x4 ckk = *(const LAS f32x4*)cst, cka = *(const LAS f32x4*)(cst + 64), crk = *(const LAS f32x4*)(cst + 128);
            f32x4 dec, a, kk, k2;
#pragma unroll
            for (int j = 0; j < 4; ++j) {
                const float sp = (-wp[j] > 20.f) ? -wp[j] : __logf(1.0f + __expf(-wp[j]));
                dec[j] = __expf(-__expf(-sp - 0.5f)); a[j] = sigmoidf_(ap[j]);
            }
            kk = kr * ckk; k2 = kr * ((a - 1.0f) * cka + 1.0f);
            const f32x4 bb = rr * k2 * crk;
            const float sq = reduce16((kk[0] * kk[0] + kk[1] * kk[1]) + (kk[2] * kk[2] + kk[3] * kk[3]));
            const float bsum = reduce16((bb[0] + bb[1]) + (bb[2] + bb[3]));
            const float rn = 1.0f / fmaxf(sqrtf(sq), 1e-12f);
            const f32x4 kn = kk * rn;
            *(LAS f32x4*)pDEC = dec; *(LAS f32x4*)pNB = -kn; *(LAS f32x4*)pCC = kn * a; *(LAS f32x4*)pK = k2;
            if (wcg == 0) ((LAS float*)(sbn + SB_BS))[wti] = bsum;
        }
        RW_BAR();
        if (do_prep) {
            const int kch = F.lane;
            const LAS float* pD = (const LAS float*)(lds + TR_DEC) + kch;
            if (ww == 0) {
                const LAS float* pN = (const LAS float*)(lds + TR_NB) + kch; LAS bf16_t* pO = (LAS bf16_t*)(sbn + SB_BT) + kch; float g = 1.0f;
#pragma unroll
                for (int t = 0; t < 16; ++t) { pO[t * 72] = (bf16_t)f2bf(g * pN[t * 64]); g *= pD[t * 64]; }
                ((LAS float*)(sbn + SB_G16))[kch] = g;
            } else if (ww == 1) {
                const LAS float* pRr = (const LAS float*)(lds + TR_R) + kch; LAS bf16_t* pO = (LAS bf16_t*)(sbn + SB_RT) + kch; float g = 1.0f;
                const LAS float* pV = (const LAS float*)(sbn + SB_V) + kch; unsigned vt[8];
#pragma unroll
                for (int t = 0; t < 16; ++t) { g *= pD[t * 64]; pO[t * 72] = (bf16_t)f2bf(g * pRr[t * 64]); }
#pragma unroll
                for (int t = 0; t < 8; ++t) vt[t] = cvt_pk(pV[(2 * t) * 64], pV[(2 * t + 1) * 64]);
                LAS u32x4* pVT = (LAS u32x4*)((LAS bf16_t*)(sbn + SB_VT) + kch * 16);
                pVT[0] = (u32x4){vt[0], vt[1], vt[2], vt[3]}; pVT[1] = (u32x4){vt[4], vt[5], vt[6], vt[7]};
            } else {
                const LAS float* pS = (const LAS float*)(lds + (ww == 2 ? TR_CC : TR_K)) + kch;
                LAS bf16_t* pRow = (LAS bf16_t*)(lds + (ww == 2 ? TR_CH : TR_KH)) + kch; float g = 1.0f; float q[16];
#pragma unroll
                for (int t = 0; t < 16; ++t) { g *= pD[t * 64]; q[t] = pS[t * 64] * __builtin_amdgcn_rcpf(g); pRow[t * 72] = (bf16_t)f2bf(q[t]); }
                LAS u32x4* pT = (LAS u32x4*)((LAS bf16_t*)(sbn + (ww == 2 ? SB_CHT : SB_KHT)) + kch * 16);
                pT[0] = (u32x4){cvt_pk(q[0], q[1]), cvt_pk(q[2], q[3]), cvt_pk(q[4], q[5]), cvt_pk(q[6], q[7])};
                pT[1] = (u32x4){cvt_pk(q[8], q[9]), cvt_pk(q[10], q[11]), cvt_pk(q[12], q[13]), cvt_pk(q[14], q[15])};
            }
        }
        RW_BAR();
        if (do_prep) {
            const LAS bf16_t* Am = (const LAS bf16_t*)(lds + ((ww & 1) ? TR_KH : TR_CH)) + r16 * 72 + 8 * kg;
            const LAS bf16_t* Bm = (const LAS bf16_t*)(sbn + (ww < 2 ? SB_BT : SB_RT)) + r16 * 72 + 8 * kg;
            f32x4 gm = (f32x4){0.f, 0.f, 0.f, 0.f};
            gm = __builtin_amdgcn_mfma_f32_16x16x32_bf16(*(const LAS bf16x8*)Am, *(const LAS bf16x8*)Bm, gm, 0, 0, 0);
            gm = __builtin_amdgcn_mfma_f32_16x16x32_bf16(*(const LAS bf16x8*)(Am + 32), *(const LAS bf16x8*)(Bm + 32), gm, 0, 0, 0);
#pragma unroll
            for (int r = 0; r < 4; ++r) { const int i = 4 * kg + r; const bool keep = (ww < 2) ? (i < r16) : (i <= r16); gm[r] = keep ? gm[r] : 0.f; }
            if (ww == 0) {
                LAS float* acb = (LAS float*)(lds + TR_ACB);
#pragma unroll
                for (int r = 0; r < 4; ++r) acb[(4 * kg + r) * 16 + r16] = gm[r];
                asm volatile("s_waitcnt lgkmcnt(0)" ::: "memory");
                const int j = F.lane & 15;
                float inv[16];
#pragma unroll
                for (int i = 0; i < 16; ++i) inv[i] = (i == j) ? 1.0f : 0.0f;
#pragma unroll
                for (int i = 14; i >= 0; --i) {
                    float sacc = 0.f;
#pragma unroll
                    for (int l = i + 1; l < 16; ++l) sacc += acb[i * 16 + l] * inv[l];
                    inv[i] = (i < j) ? sacc : inv[i];
                }
                if (F.lane < 16) {
                    LAS u32x4* pI = (LAS u32x4*)((LAS bf16_t*)(sbn + SB_MT) + 256 + j * 16);
                    pI[0] = (u32x4){cvt_pk(inv[0], inv[1]), cvt_pk(inv[2], inv[3]), cvt_pk(inv[4], inv[5]), cvt_pk(inv[6], inv[7])};
                    pI[1] = (u32x4){cvt_pk(inv[8], inv[9]), cvt_pk(inv[10], inv[11]), cvt_pk(inv[12], inv[13]), cvt_pk(inv[14], inv[15])};
                }
            } else {
                const int slot = (ww == 1) ? 0 : ww;
                *(LAS u32x2*)((LAS bf16_t*)(sbn + SB_MT) + slot * 256 + r16 * 16 + 4 * kg) = pack4c(gm);
            }
        }
        RW_BAR();
    }
#undef RW_DMA
    if (!scanner) rw_post(lds, lds + SB_SIZE, (const LAS float*)(lds + RW_OUT + 4096), ybase + (size_t)(SEQ - RW_CT) * YW, wti, wcg);
}

__device__ UNIT_INLINE void ssd_fixup_and_pb(Frame& F, int L, KArgs KA, bf16_t* Y, const float* ssq, bf16_t* PB) {
    const int gt = F.bid * 512 + F.tid, NT = F.G * 512;
    const float* nw = IN_F(10) + (size_t)L * 512;
    for (int i = gt; i < T * 64; i += NT) {
        const int t = i >> 6, ch = i & 63, g = ch >> 5;
        const f32x4 q = *(const f32x4*)(ssq + (size_t)t * 8 + g * 4);
        const float rs = rsqrtf(((q[0] + q[1]) + (q[2] + q[3])) * (1.0f / 256.0f) + NORM_EPS);
        bf16_t* yp = Y + (size_t)t * YW + ch * 8;
        const u32x4 v = *(const u32x4*)yp; const f32x4 n0 = *(const f32x4*)(nw + ch * 8), n1 = *(const f32x4*)(nw + ch * 8 + 4);
        u32x4 o;
        o.x = cvt_pk(bf2f(v.x & 0xffffu) * rs * n0[0], bf2f(v.x >> 16) * rs * n0[1]); o.y = cvt_pk(bf2f(v.y & 0xffffu) * rs * n0[2], bf2f(v.y >> 16) * rs * n0[3]);
        o.z = cvt_pk(bf2f(v.z & 0xffffu) * rs * n1[0], bf2f(v.z >> 16) * rs * n1[1]); o.w = cvt_pk(bf2f(v.w & 0xffffu) * rs * n1[2], bf2f(v.w >> 16) * rs * n1[3]);
        *(u32x4*)yp = o;
    }
    const float* p = IN_F(1) + (size_t)L * T * PLE;
    for (int i = gt; i < T * PLE / 8; i += NT) {
        const f32x4 a = *(const f32x4*)(p + (size_t)i * 8), b = *(const f32x4*)(p + (size_t)i * 8 + 4);
        u32x4 o; o.x = cvt_pk(a[0], a[1]); o.y = cvt_pk(a[2], a[3]); o.z = cvt_pk(b[0], b[1]); o.w = cvt_pk(b[2], b[3]);
        *(u32x4*)(PB + (size_t)i * 8) = o;
    }
}
__device__ UNIT_INLINE void moe_router(Frame& F, KArgs KA, const float* xo, unsigned* cnt, int* toke, int* tokp, float* tokw) {
    const int gw = F.bid * 8 + F.wave, NGW = F.G * 8;
    const float* gff = IN_F(31) + DM; const float* router = IN_F(35);
    for (int m = gw; m < T; m += NGW) {
        const f32x4* xr = (const f32x4*)(xo + (size_t)m * DM) + F.lane; f32x4 v[4]; float s = 0.f;
#pragma unroll
        for (int j = 0; j < 4; ++j) { v[j] = xr[64 * j]; s += (v[j][0] * v[j][0] + v[j][1] * v[j][1]) + (v[j][2] * v[j][2] + v[j][3] * v[j][3]); }
        const float rstd = rsqrtf(wave_sum(s) * (1.0f / DM) + NORM_EPS);
        float lg[8];
#pragma unroll
        for (int e = 0; e < 8; ++e) lg[e] = 0.f;
#pragma unroll
        for (int j = 0; j < 4; ++j) { const f32x4 gg = *((const f32x4*)gff + F.lane + 64 * j);
#pragma unroll
            for (int i = 0; i < 4; ++i) { const int k = 4 * F.lane + 256 * j + i; const float hv = v[j][i] * rstd * gg[i];
                const f32x4 r0 = *(const f32x4*)(router + (size_t)k * 8), r1 = *(const f32x4*)(router + (size_t)k * 8 + 4);
                lg[0] += hv * r0[0]; lg[1] += hv * r0[1]; lg[2] += hv * r0[2]; lg[3] += hv * r0[3]; lg[4] += hv * r1[0]; lg[5] += hv * r1[1]; lg[6] += hv * r1[2]; lg[7] += hv * r1[3]; } }
#pragma unroll
        for (int e = 0; e < 8; ++e) lg[e] = wave_sum(lg[e]);
        if (F.lane == 0) {
            int e1 = 0; float v1 = lg[0];
#pragma unroll
            for (int e = 1; e < 8; ++e) if (lg[e] > v1) { v1 = lg[e]; e1 = e; }
            int e2 = -1; float v2 = -INFINITY;
#pragma unroll
            for (int e = 0; e < 8; ++e) if (e != e1 && lg[e] > v2) { v2 = lg[e]; e2 = e; }
            const float ex = __expf(v2 - v1), w1 = 1.0f / (1.0f + ex), w2 = ex / (1.0f + ex);
            const int p1 = (int)atomicAdd(cnt + 64 * e1, 1u), p2 = (int)atomicAdd(cnt + 64 * e2, 1u);
            toke[2 * m] = e1; toke[2 * m + 1] = e2; tokp[2 * m] = p1; tokp[2 * m + 1] = p2; tokw[2 * m] = w1; tokw[2 * m + 1] = w2;
        }
    }
}
__device__ __forceinline__ void moe_tables(const unsigned* cnt, MoeTables& mt, int (&c)[8]) {
#pragma unroll
    for (int e = 0; e < 8; ++e) c[e] = (int)__hip_atomic_load(cnt + 64 * e, RLX_AGENT);
    int ps = 0;
    ps += (c[0] + 255) & ~255; mt.ps1 = ps; ps += (c[1] + 255) & ~255; mt.ps2 = ps; ps += (c[2] + 255) & ~255; mt.ps3 = ps; ps += (c[3] + 255) & ~255; mt.ps4 = ps;
    ps += (c[4] + 255) & ~255; mt.ps5 = ps; ps += (c[5] + 255) & ~255; mt.ps6 = ps; ps += (c[6] + 255) & ~255; mt.ps7 = ps; ps += (c[7] + 255) & ~255; mt.ps8 = ps;
}
__device__ __forceinline__ int moe_pstart(const MoeTables& mt, int e) {
    return e == 0 ? 0 : e == 1 ? mt.ps1 : e == 2 ? mt.ps2 : e == 3 ? mt.ps3 : e == 4 ? mt.ps4 : e == 5 ? mt.ps5 : e == 6 ? mt.ps6 : mt.ps7;
}
__device__ UNIT_INLINE void moe_slots(Frame& F, const float* xo, const float* ss2, const unsigned* cnt, const int* toke, const int* tokp, int* toks, bf16_t* XG, float* srstd) {
    const int gw = F.bid * 8 + F.wave, NGW = F.G * 8;
    MoeTables mt; int c[8]; moe_tables(cnt, mt, c);
    for (int m = gw; m < T; m += NGW) {
        const f32x4* xr = (const f32x4*)(xo + (size_t)m * DM) + F.lane; u32x2 pk[4];
#pragma unroll
        for (int j = 0; j < 4; ++j) pk[j] = pack4(xr[64 * j]);
        const float rs = rstd_of(ss2, m);
#pragma unroll
        for (int k = 0; k < 2; ++k) {
            const int e = toke[2 * m + k], slot = moe_pstart(mt, e) + tokp[2 * m + k];
            u32x2* o = (u32x2*)(XG + (size_t)slot * DM) + F.lane;
#pragma unroll
            for (int j = 0; j < 4; ++j) o[64 * j] = pk[j];
            if (F.lane == 0) { toks[2 * m + k] = slot; srstd[slot] = rs; }
        }
    }
    for (int idx = gw; idx < 8 * 256; idx += NGW) {
        const int e = idx >> 8, r = idx & 255;
        int ce = 0;
#pragma unroll
        for (int q = 0; q < 8; ++q) if (q == e) ce = c[q];
        const int row = moe_pstart(mt, e) + ce + r, end = (e == 7) ? mt.ps8 : moe_pstart(mt, e + 1);
        if (row < end) { u32x2* o = (u32x2*)(XG + (size_t)row * DM) + F.lane;
#pragma unroll
            for (int j = 0; j < 4; ++j) o[64 * j] = (u32x2){0u, 0u};
            if (F.lane == 0) srstd[row] = 0.f; }
    }
}
__device__ UNIT_INLINE void moe_combine(Frame& F, float* xo, const bf16_t* YB, const int* toks, const float* tokw, bf16_t* XB2) {
    const int gw = F.bid * 8 + F.wave, NGW = F.G * 8;
    for (int m = gw; m < T; m += NGW) {
        const int s0 = toks[2 * m], s1 = toks[2 * m + 1]; const float w0 = tokw[2 * m], w1 = tokw[2 * m + 1];
        f32x4* xr = (f32x4*)(xo + (size_t)m * DM) + F.lane; const u32x2* y0 = (const u32x2*)(YB + (size_t)s0 * DM) + F.lane; const u32x2* y1 = (const u32x2*)(YB + (size_t)s1 * DM) + F.lane;
        u32x2* xb = (u32x2*)(XB2 + (size_t)m * DM) + F.lane;
#pragma unroll
        for (int j = 0; j < 4; ++j) { const f32x4 v = xr[64 * j] + (unpack4(y0[64 * j]) * w0 + unpack4(y1[64 * j]) * w1); xr[64 * j] = v; xb[64 * j] = pack4(v); }
    }
}
__device__ UNIT_INLINE void final_norm(Frame& F, KArgs KA, float* xo) {
    const int gw = F.bid * 8 + F.wave, NGW = F.G * 8; const float* gf = IN_F(41);
    for (int m = gw; m < T; m += NGW) {
        f32x4* xr = (f32x4*)(xo + (size_t)m * DM) + F.lane; f32x4 v[4]; float s = 0.f;
#pragma unroll
        for (int j = 0; j < 4; ++j) { v[j] = xr[64 * j]; s += (v[j][0] * v[j][0] + v[j][1] * v[j][1]) + (v[j][2] * v[j][2] + v[j][3] * v[j][3]); }
        const float rstd = rsqrtf(wave_sum(s) * (1.0f / DM) + NORM_EPS);
#pragma unroll
        for (int j = 0; j < 4; ++j) xr[64 * j] = v[j] * rstd * *((const f32x4*)gf + F.lane + 64 * j);
    }
}


#define XB_TMO      128
#define XB_XCNT(j)  (256  + 64 * (j))
#define XB_XSUB(j)  (1280 + 64 * (j))
#define XB_XGEN(j)  (2304 + 64 * (j))
#define XB_TOP      3328
#define XB_TOPGEN   3392
#define XCD_BAR_WORDS 3456
#define XB_SPIN_CAP (1u << 22)
__device__ __forceinline__ unsigned xb_ld(unsigned* p)              { return __hip_atomic_load(p, __ATOMIC_RELAXED, __HIP_MEMORY_SCOPE_AGENT); }
__device__ __forceinline__ unsigned xb_add(unsigned* p, unsigned v) { return __hip_atomic_fetch_add(p, v, __ATOMIC_RELAXED, __HIP_MEMORY_SCOPE_AGENT); }
__device__ __forceinline__ unsigned xb_xcc_id() { return (unsigned)__builtin_amdgcn_s_getreg((3 << 11) | 20) & 0xFu; }
#define XB_SPIN(cond, bar) do { unsigned _sp = 0; while (cond) { __builtin_amdgcn_s_sleep(1); \
    if ((++_sp & 255u) == 0u) { if (xb_ld(&(bar)[XB_TMO])) break; if (_sp > XB_SPIN_CAP) { atomicAdd(&(bar)[XB_TMO], 1u); break; } } } } while (0)
struct XcdBarrier { unsigned* bar; unsigned x; volatile LAS unsigned* st; };
__device__ __forceinline__ XcdBarrier xcd_barrier_post(unsigned* bar, volatile LAS unsigned* st) {
    XcdBarrier b; b.bar = bar; b.x = xb_xcc_id(); b.st = st;
    if (threadIdx.x == 0) (void)xb_add(&bar[XB_XCNT(b.x)], 1u);
    return b;
}
__device__ __forceinline__ void xcd_barrier_complete(unsigned* bar, unsigned x, unsigned& nloc, unsigned& nx) {
    const unsigned G = gridDim.x * gridDim.y * gridDim.z;
    unsigned sum, cnt, mine, sp = 0u;
    for (;;) {
        sum = 0u; cnt = 0u; mine = 0u;
#pragma unroll
        for (unsigned j = 0; j < 16; ++j) { const unsigned c = xb_ld(&bar[XB_XCNT(j)]); sum += c; cnt += (c > 0u) ? 1u : 0u; mine = (j == x) ? c : mine; }
        if (sum == G) break;
        __builtin_amdgcn_s_sleep(1);
        if ((++sp & 255u) == 0u) { if (xb_ld(&bar[XB_TMO])) break; if (sp > XB_SPIN_CAP) { atomicAdd(&bar[XB_TMO], 1u); break; } }
    }
    nloc = mine > 0u ? mine : 1u; nx = cnt > 0u ? cnt : 1u;
}
__device__ __forceinline__ void xcd_barrier(const XcdBarrier& b, bool leader) {
    asm volatile("s_waitcnt vmcnt(0)" ::: "memory");
    __syncthreads();
    if (leader) {
        unsigned* bar = b.bar;
        __builtin_amdgcn_s_waitcnt(0);
        unsigned nloc = b.st[0], nx = b.st[1];
        if (nloc == 0u) { xcd_barrier_complete(bar, b.x, nloc, nx); b.st[0] = nloc; b.st[1] = nx; }
        const unsigned old = xb_add(&bar[XB_XSUB(b.x)], 1u);
        const unsigned gen = old / nloc;
        if (old + 1u == (gen + 1u) * nloc) {
            __builtin_amdgcn_fence(__ATOMIC_RELEASE, "agent");
            asm volatile("s_waitcnt vmcnt(0)" ::: "memory");
            const unsigned og = xb_add(&bar[XB_TOP], 1u);
            const unsigned tg = og / nx;
            if (og + 1u == (tg + 1u) * nx) xb_add(&bar[XB_TOPGEN], 1u);
            else XB_SPIN(xb_ld(&bar[XB_TOPGEN]) == tg, bar);
            __builtin_amdgcn_fence(__ATOMIC_ACQUIRE, "agent");
            xb_add(&bar[XB_XGEN(b.x)], 1u);
            asm volatile("s_waitcnt vmcnt(0)" ::: "memory");
        } else {
            XB_SPIN(xb_ld(&bar[XB_XGEN(b.x)]) == gen, bar);
            __builtin_amdgcn_fence(__ATOMIC_ACQUIRE, "agent");
            asm volatile("s_waitcnt vmcnt(0)" ::: "memory");
        }
    }
    __syncthreads();
}

constexpr int NPH = 23;
__device__ __forceinline__ unsigned char* opq(unsigned char* p) { asm volatile("" : "+s"(p)); return p; }
__global__ void __launch_bounds__(512, 2) mega_fwd(Args args) {
    extern __shared__ __attribute__((aligned(16))) unsigned char lds_raw[];
    Frame F;
    F.lds = (LAS unsigned char*)lds_raw; F.tid = 0; F.lane = 0; F.wave = __builtin_amdgcn_readfirstlane((int)threadIdx.x >> 6);
    F.G = gridDim.x; F.bid = blockIdx.x; F.ws = nullptr; F.ctl = nullptr;
    const int lo = args.ph_lo, hi = args.ph_hi;
    LAS unsigned* s_uid = (LAS unsigned*)(F.lds + LDS_USER + 64);
    if (threadIdx.x < 16) ((LAS unsigned*)(F.lds + LDS_USER))[threadIdx.x] = 0u;
    __syncthreads();
    (void)xcd_barrier_post((unsigned*)(args.ws + WS_CTL) + CW_BAR, (volatile LAS unsigned*)(F.lds + LDS_USER + 32));
#if MK_MULTI
#define GSYNC(k) do {} while (0)
#else
#define GSYNC(k) do { if ((k) + 1 < hi || rep_ + 1 < ((k) == REP_PH ? REP_N : 1)) { if ((k) == 0) cg::this_grid().sync(); else { XcdBarrier xb_; xb_.bar = (unsigned*)(KA->ws + WS_CTL) + CW_BAR; xb_.x = xb_xcc_id(); xb_.st = (volatile LAS unsigned*)(P.lds + LDS_USER + 32); xcd_barrier(xb_, P.tid == 0); } } } while (0)
#endif
#ifdef ONLY_PH
#define RUN(k) ((k) == ONLY_PH)
#else
#define RUN(k) (lo <= (k) && (k) < hi)
#endif
#define REPS(k) for (int rep_ = 0; rep_ < ((k) == REP_PH ? REP_N : 1); ++rep_)
#define PH_PTRS KArgs KA = kargs(); unsigned char* ws = KA->ws; float* out = KA->out; (void)out; \
    Frame P = F; asm volatile("" : "+s"(P.G), "+s"(P.bid), "+s"(P.wave)); asm volatile("v_mbcnt_lo_u32_b32 %0, -1, 0\n\tv_mbcnt_hi_u32_b32 %0, -1, %0" : "=v"(P.lane)); P.tid = P.wave * 64 + P.lane; \
    unsigned char* wa = ws + WS_WA + (size_t)L * WA_STRIDE; (void)wa; float* ssb = (float*)(ws + WS_SSP); \
    float* ss1 = ssb + (size_t)(2 * L) * T * 16; float* ss2 = ssb + (size_t)(2 * L + 1) * T * 16; float* ssn = ssb + (size_t)(2 * L + 2) * T * 16; (void)ss1; (void)ss2; (void)ssn; \
    bf16_t* XB = (bf16_t*)(ws + WS_XB); bf16_t* Y = (bf16_t*)(ws + WS_Y); bf16_t* U1 = (bf16_t*)(ws + WS_U1); (void)XB; (void)Y; (void)U1; \
    bf16_t* GATES = (bf16_t*)(ws + (L == 0 ? WS_WB : WS_GATES)); bf16_t* MERGED = (bf16_t*)(ws + WS_MERGED); bf16_t* PB = (bf16_t*)(ws + WS_PB); (void)GATES; (void)MERGED; (void)PB; \
    float* MISC = (float*)(ws + WS_MISC); float* SSQ = (float*)(ws + WS_SSQ); (void)MISC; (void)SSQ; \
    bf16_t* XB2 = (bf16_t*)(ws + (L == 0 ? WS_XB2_L0 : WS_XB2_L1)); (void)XB2;
    const size_t TILE1K = (size_t)256 * 1024 * 2;
    if (RUN(0)) REPS(0) { const int L = 0; PH_PTRS p0_prologue(KA, P); GSYNC(0); }
#pragma unroll 1
    for (int L = 0; L < 2; ++L) {
        const int pb0 = 1 + (L == 0 ? 0 : 9);
        if (RUN(pb0)) REPS(pb0) { PH_PTRS
            pg8::DenseSched S; S.so.init(64, 22, P.G, P.bid); S.A = (const char*)XB; S.B = (const char*)(wa + WA_IN); S.a_tile = TILE1K; S.b_tile = TILE1K;
            EpiIn E{U1, MISC, ss1};
            pg8::gemm_phase(P.lds, DM, DM, DM, S, E); GSYNC(pb0);
        }
        if (RUN(pb0 + 2)) REPS(pb0 + 2) {
            if (F.bid < 64) { PH_PTRS
#ifndef SKIP_RWKV
                rwkv_unit(P, P.bid, L, KA, U1, Y, nullptr);
#endif
            }
            if (F.bid >= 64 && F.bid < 128) { PH_PTRS
#ifndef SKIP_SSD
                ssd_unit(P, P.bid - 64, L, KA, U1, Y, MISC, SSQ, nullptr);
#endif
            }
            { PH_PTRS
                unsigned* dep = (unsigned*)(ws + WS_CTL) + CW_DEP + 16384 * L; unsigned* q = (unsigned*)(ws + WS_CTL) + CW_QMIX + 256 * L;
                for (;;) {
                    __syncthreads();
                    if (P.tid == 0) *s_uid = atomicAdd(q + 64, 1u);
                    __syncthreads();
                    const int t = (int)*s_uid;
                    if (t >= 256) break;
                    if (t < 128) compress_unit(P, t, L, U1, ws);
                    else rope_slice(P, U1, (const float*)(ws + WS_ROPE), (const float*)(ws + WS_ROPE) + (size_t)T * 32, t - 128);
                    dep_signal(dep + 64, nullptr, P.tid == 0);
                }
                dep_wait(dep + 64, 256u, P.tid == 0);
            }
            { PH_PTRS
            unsigned* q = (unsigned*)(ws + WS_CTL) + CW_QMIX + 256 * L;
            for (;;) {
                __syncthreads();
                if (P.tid == 0) *s_uid = atomicAdd(q + 128, 1u);
                __syncthreads();
                const int uid = (int)*s_uid;
                if (uid >= 512) break;
#ifndef SKIP_NSA
                nsa_unit(P, uid, U1, Y, MISC, ws);
#endif
            } }
            { PH_PTRS
            unsigned* q = (unsigned*)(ws + WS_CTL) + CW_QMIX + 256 * L;
            for (;;) {
                __syncthreads();
                if (P.tid == 0) *s_uid = atomicAdd(q + 192, 1u);
                __syncthreads();
                const int uid = (int)*s_uid;
                if (uid >= 512) break;
#ifndef SKIP_SWA
                swa_unit(P, uid, U1, Y, IN_F(25) + L * 8);
#endif
            } }
            if (L == 0) { PH_PTRS
                unsigned* qg = (unsigned*)(ws + WS_CTL) + CW_QMIX + 576 + 1024 * rep_;
                for (;;) {
                    __syncthreads();
                    if (P.tid == 0) *s_uid = atomicAdd(qg, 1u);
                    __syncthreads();
                    const int t = (int)*s_uid;
                    if (t >= 256) break;
                    BatchSched S; S.pm = t >> 2; S.pn0 = (t & 3) * 4; S.n = 4; S.A = (const char*)XB; S.B = (const char*)(wa + WA_GATE); S.a_tile = TILE1K; S.b_tile = TILE1K;
                    EpiGates E{GATES, ss1};
                    pg8::gemm_phase(P.lds, DM, DM, DM, S, E);
                }
            }
            { PH_PTRS
              if (L == 0) deferred_convert(KA, P, (unsigned*)(ws + WS_CTL) + CW_QMIX + 512 + 1024 * rep_, s_uid, 16, 32, 3472);
              else deferred_convert(KA, P, (unsigned*)(ws + WS_CTL) + CW_QMIX + 768 + 1024 * rep_, s_uid, 35, 59, 16896); }
            { PH_PTRS GSYNC(pb0 + 2); }
        }
        if (RUN(pb0 + 3)) REPS(pb0 + 3) { PH_PTRS
            if (L != 0) {
            pg8::DenseSched S; S.so.init(64, 16, P.G, P.bid); S.A = (const char*)XB; S.B = (const char*)(wa + WA_GATE); S.a_tile = TILE1K; S.b_tile = TILE1K;
            EpiGates E{GATES, ss1};
            pg8::gemm_phase(P.lds, DM, DM, DM, S, E);
            }
            ssd_fixup_and_pb(P, L, KA, Y, SSQ, PB);
            GSYNC(pb0 + 3);
        }
        if (RUN(pb0 + 4)) REPS(pb0 + 4) {
            { PH_PTRS BranchSched S; S.so.init(64, 4, P.G, P.bid); S.Y = (const char*)Y; S.PT = (const char*)(wa + WA_PT); S.a_tile = (size_t)256 * YW * 2; S.b_tile = (size_t)256 * 512 * 2; S.a_br = 512 * 2; S.b_br = MiB;
              EpiBrAll E{MERGED, GATES}; pg8::gemm_phase(P.lds, YW, 512, 512, S, E); }
            { PH_PTRS GSYNC(pb0 + 4); }
        }
        if (RUN(pb0 + 5)) REPS(pb0 + 5) { PH_PTRS
            pg8::DenseSched S; S.so.init(64, 4, P.G, P.bid); S.A = (const char*)MERGED; S.B = (const char*)(wa + WA_OUT); S.a_tile = TILE1K; S.b_tile = TILE1K;
            if (L == 0) { EpiRes<true, true> E{IN_F(0), out, XB, ss2}; pg8::gemm_phase(P.lds, DM, DM, DM, S, E); }
            else { EpiRes<false, true> E{out, out, XB, ss2}; pg8::gemm_phase(P.lds, DM, DM, DM, S, E); }
            GSYNC(pb0 + 5);
        }
        if (L == 0) {
            if (RUN(7)) REPS(7) { PH_PTRS
                pg8::DenseSched S; S.so.init(64, 22, P.G, P.bid); S.A = (const char*)XB; S.B = (const char*)(ws + WS_FGU); S.a_tile = TILE1K; S.b_tile = TILE1K;
                EpiFfn1<false> E{(bf16_t*)(ws + WS_ACT0), ss2};
                pg8::gemm_phase(P.lds, DM, DM, DM, S, E); GSYNC(7);
            }
            if (RUN(8)) REPS(8) { PH_PTRS
                pg8::DenseSched S; S.so.init(64, 4, P.G, P.bid); S.A = (const char*)(ws + WS_ACT0); S.B = (const char*)(ws + WS_FDN); S.a_tile = (size_t)256 * D_FF * 2; S.b_tile = (size_t)256 * D_FF * 2;
                EpiRes<true, false> E{out, out, XB2, nullptr};
                pg8::gemm_phase(P.lds, D_FF, D_FF, D_FF, S, E); GSYNC(8);
            }
        } else {
#define MOE_PTRS unsigned* cnt = (unsigned*)(ws + WS_CTL) + CW_MOECNT; (void)cnt; int* toke = (int*)(ws + WS_TOKE); int* tokp = (int*)(ws + WS_TOKP); float* tokw = (float*)(ws + WS_TOKW); int* toks = (int*)(ws + WS_TOKS); \
            (void)toke; (void)tokp; (void)tokw; (void)toks; float* srstd = (float*)(ws + WS_SRSTD); (void)srstd; \
            bf16_t* XG = (bf16_t*)(ws + WS_XG); bf16_t* ACT1 = (bf16_t*)(ws + WS_ACT1); bf16_t* YB = (bf16_t*)(ws + WS_YB); (void)XG; (void)ACT1; (void)YB;
            if (RUN(16)) REPS(16) { PH_PTRS MOE_PTRS moe_router(P, KA, out, cnt, toke, tokp, tokw); GSYNC(16); }
            if (RUN(17)) REPS(17) { PH_PTRS MOE_PTRS moe_slots(P, out, ss2, cnt, toke, tokp, toks, XG, srstd); GSYNC(17); }
            if (RUN(18)) REPS(18) { PH_PTRS MOE_PTRS
                MoeSched S; int c[8]; moe_tables(cnt, S.mt, c); S.nN = 22; S.G = P.G; S.c = P.bid; S.A = (const char*)XG; S.B = (const char*)(ws + WS_WB); S.a_tile = TILE1K; S.b_tile = TILE1K; S.b_expert = WB_STRIDE;
                EpiFfn1<true> E{ACT1, srstd};
                pg8::gemm_phase(P.lds, DM, DM, DM, S, E); GSYNC(18);
            }
            if (RUN(19)) REPS(19) { PH_PTRS MOE_PTRS
                MoeSched S; int c[8]; moe_tables(cnt, S.mt, c); S.nN = 4; S.G = P.G; S.c = P.bid; S.A = (const char*)ACT1; S.B = (const char*)(ws + WS_WB + WB_DN); S.a_tile = (size_t)256 * D_FF * 2; S.b_tile = (size_t)256 * D_FF * 2; S.b_expert = WB_STRIDE;
                EpiBf16<false> E{YB};
                pg8::gemm_phase(P.lds, D_FF, D_FF, D_FF, S, E); GSYNC(19);
            }
            if (RUN(20)) REPS(20) { PH_PTRS MOE_PTRS moe_combine(P, out, YB, toks, tokw, XB2); GSYNC(20); }
        }
        const int pple = (L == 0) ? 9 : 21;
        if (RUN(pple)) REPS(pple) {
            { PH_PTRS pg8::DenseSched S; S.so.init(64, 4, P.G, P.bid); S.A = (const char*)XB2; S.B = (const char*)(wa + WA_PG); S.a_tile = TILE1K; S.b_tile = TILE1K;
              EpiBf16<true> E{MERGED}; pg8::gemm_phase(P.lds, DM, DM, DM, S, E); }
            { PH_PTRS pg8::DenseSched S; S.so.init(64, 4, P.G, P.bid);
              S.A = (const char*)PB; S.B = (const char*)(wa + WA_PP); S.a_tile = (size_t)256 * PLE * 2; S.b_tile = (size_t)256 * PLE * 2;
              if (L == 0) { EpiPle2<true> E{out, MERGED, XB, ssn}; pg8::gemm_phase(P.lds, PLE, PLE, PLE, S, E); }
              else { EpiPle2<false> E{out, MERGED, XB, ssn}; pg8::gemm_phase(P.lds, PLE, PLE, PLE, S, E); } }
            { PH_PTRS GSYNC(pple); }
        }
    }
    if (RUN(22)) REPS(22) { const int L = 0; PH_PTRS final_norm(P, KA, out); }
}

extern "C" void kernel_launch(void* const* d_in, const int* in_sizes, int n_in, void* d_out, int out_size, void* d_ws, size_t ws_size, hipStream_t stream) {
    static int grid = 0;
    if (grid == 0) {
        if (n_in != 42 || out_size != T * DM || ws_size < WS_END) { fprintf(stderr, "kernel_launch: unexpected problem (n_in %d out %d ws %zu)\n", n_in, out_size, ws_size); grid = -1; return; }
        int dev = 0, cus = 0, per_cu = 0;
        hipGetDevice(&dev); hipDeviceGetAttribute(&cus, hipDeviceAttributeMultiprocessorCount, dev);
        hipFuncSetAttribute((const void*)mega_fwd, hipFuncAttributeMaxDynamicSharedMemorySize, LDS_BYTES);
        hipOccupancyMaxActiveBlocksPerMultiprocessor(&per_cu, (const void*)mega_fwd, 512, LDS_BYTES);
        if (per_cu < 1) { fprintf(stderr, "kernel_launch: occupancy query says %d blocks per CU\n", per_cu); per_cu = 1; }
        (void)hipGetLastError();
        grid = cus;
    }
    if (grid < 0) return;
    hipMemsetAsync((char*)d_ws + WS_CTL, 0, CTL_BYTES, stream);
    Args a{};
    for (int i = 0; i < 42; ++i) a.in[i] = d_in[i];
    a.out = (float*)d_out; a.ws = (unsigned char*)d_ws;
#if MK_MULTI
    for (int k = 0; k < NPH; ++k) { a.ph_lo = k; a.ph_hi = k + 1; hipLaunchKernelGGL(mega_fwd, dim3(grid), dim3(512), LDS_BYTES, stream, a); }
#else
    a.ph_lo = 0; a.ph_hi = NPH;
    void* kargs[] = {&a};
    hipError_t e = hipLaunchCooperativeKernel((const void*)mega_fwd, dim3(grid), dim3(512), kargs, LDS_BYTES, stream);
    if (e != hipSuccess) fprintf(stderr, "kernel_launch: cooperative launch failed: %s\n", hipGetErrorString(e));
#endif
}
```

```cpp
#include <hip/hip_runtime.h>
#include <hip/hip_cooperative_groups.h>
#include <cstdio>
#include <cstdint>
namespace cg = cooperative_groups;

#define LAS __attribute__((address_space(3)))
#define GAS __attribute__((address_space(1)))
typedef unsigned short bf16_t;
typedef short bf16x8 __attribute__((ext_vector_type(8)));
typedef short s16x4 __attribute__((ext_vector_type(4)));
typedef float f32x2 __attribute__((ext_vector_type(2)));
typedef float f32x4 __attribute__((ext_vector_type(4)));
typedef float f32x16 __attribute__((ext_vector_type(16)));
typedef unsigned u32x2 __attribute__((ext_vector_type(2)));
typedef unsigned u32x4 __attribute__((ext_vector_type(4)));

#ifdef DIAG_NOINLINE
#define UNIT_INLINE __attribute__((noinline))
#else
#define UNIT_INLINE __forceinline__
#endif
#ifndef REP_PH
#define REP_PH -1
#endif
#ifndef REP_N
#define REP_N 1
#endif
#ifndef REP_UNIT
#define REP_UNIT -1
#endif
#ifndef MK_MULTI
#define MK_MULTI 0
#endif

constexpr int NB = 8, SEQ = 2048, T = NB * SEQ, DM = 1024, HD = 64;
constexpr int D_IN = 9504, D_FF = 2816, NEXP = 8, PLE = 256;
constexpr int UW = 5376;
constexpr int YW = 2048;
constexpr float NORM_EPS = 1e-6f;
constexpr float LOG2E = 1.4426950408889634f;
constexpr int UC_Z = 0, UC_XBC = 512, UC_XS = 512, UC_BM = 1024, UC_CM = 1280, UC_NQ = 1536, UC_NKV = 2048, UC_RW = 2816, UC_SQ = 4608, UC_SKV = 5120;
constexpr int MOE_MAXROWS = 34816;

constexpr size_t MiB = (size_t)1 << 20;
constexpr size_t WS_CTL = 0, CTL_BYTES = 1 * MiB;
constexpr size_t WS_ROPE = 1 * MiB;
constexpr size_t WS_MISC = 5 * MiB;
constexpr size_t WS_KC = 7 * MiB, WS_VC = 7 * MiB + 256 * 1024;
constexpr size_t WS_SSQ = 7 * MiB + 512 * 1024;
constexpr size_t WS_TOKE = 8 * MiB, WS_TOKP = WS_TOKE + 128 * 1024, WS_TOKW = WS_TOKP + 128 * 1024, WS_TOKS = WS_TOKW + 128 * 1024;
constexpr size_t WS_SRSTD = 8 * MiB + 512 * 1024;
constexpr size_t WS_W1T = 9 * MiB;
constexpr size_t WS_W2T = 10 * MiB;
constexpr size_t WS_PEB = 10 * MiB + 64 * 1024;
constexpr size_t WS_LW = 10 * MiB + 128 * 1024;
constexpr size_t WS_WA = 12 * MiB, WA_STRIDE = 28 * MiB;
constexpr size_t WA_IN = 0, WA_GATE = 11 * MiB, WA_PT = 19 * MiB, WA_OUT = 23 * MiB, WA_PG = 25 * MiB, WA_PP = 27 * MiB;
constexpr size_t WS_FGU = 68 * MiB, WS_FDN = 79 * MiB;
constexpr size_t WS_WB = 85 * MiB, WB_STRIDE = 16 * MiB + 512 * 1024, WB_DN = 11 * MiB;
constexpr size_t WS_REC = WS_WB;
constexpr size_t WS_XB = 217 * MiB;
constexpr size_t WS_Y = 249 * MiB;
constexpr size_t WS_BIG = 313 * MiB;
constexpr size_t WS_U1 = WS_BIG, WS_GATES = WS_BIG, WS_MERGED = WS_BIG + 128 * MiB, WS_PB = WS_BIG + 160 * MiB, WS_ACT0 = WS_BIG;
constexpr size_t WS_XG = WS_XB, WS_ACT1 = 285 * MiB, WS_YB = WS_XB;
constexpr size_t WS_XB2_L0 = WS_Y, WS_XB2_L1 = 300 * MiB;
constexpr size_t WS_SSP = 482 * MiB;
constexpr size_t WS_SSDC = 205 * MiB;
constexpr size_t WS_SSDA = 213 * MiB;
constexpr size_t WS_SSDS = 488 * MiB;
constexpr size_t WS_END = 504 * MiB;
constexpr int CW_BAR = 4096, CW_QMIX = 16384, CW_MOECNT = 9216;
constexpr int CW_DEP = 32768;

constexpr int RING_BYTES = 131072;
constexpr int LDS_BYTES = 147456;
constexpr int LDS_USER = LDS_BYTES - 1024;
constexpr int MISC_OFF = LDS_USER;

__device__ __forceinline__ float bf2f(unsigned b) { return __uint_as_float(b << 16); }
__device__ __forceinline__ unsigned f2bf(float f) { unsigned u = __float_as_uint(f); return (u + 0x7fffu + ((u >> 16) & 1u)) >> 16; }
__device__ __forceinline__ unsigned cvt_pk(float lo, float hi) { unsigned r; asm volatile("v_cvt_pk_bf16_f32 %0, %1, %2" : "=v"(r) : "v"(lo), "v"(hi)); return r; }
__device__ __forceinline__ float sigmoidf_(float x) { return 1.0f / (1.0f + __expf(-x)); }
__device__ __forceinline__ float siluf_(float x) { return x / (1.0f + __expf(-x)); }
__device__ __forceinline__ float softplusf_(float x) { return x > 20.f ? x : __logf(1.0f + __expf(x)); }
__device__ __forceinline__ float wave_sum(float v) {
#pragma unroll
    for (int o = 1; o < 64; o <<= 1) v += __shfl_xor(v, o);
    return v;
}
__device__ __forceinline__ float wave_max(float v) {
#pragma unroll
    for (int o = 1; o < 64; o <<= 1) v = fmaxf(v, __shfl_xor(v, o));
    return v;
}
#define RLX_AGENT __ATOMIC_RELAXED, __HIP_MEMORY_SCOPE_AGENT
__device__ __forceinline__ u32x2 ld_agent_u64(const void* p) {
    unsigned long long v = __hip_atomic_load((const unsigned long long*)p, RLX_AGENT);
    u32x2 r; r.x = (unsigned)v; r.y = (unsigned)(v >> 32); return r;
}

__device__ __forceinline__ float ss_total(const float* ssp, int row) {
    const f32x4* p = (const f32x4*)(ssp + (size_t)row * 16); const f32x4 a = p[0], b = p[1], c = p[2], d = p[3];
    return (((a[0] + a[1]) + (a[2] + a[3])) + ((b[0] + b[1]) + (b[2] + b[3]))) + (((c[0] + c[1]) + (c[2] + c[3])) + ((d[0] + d[1]) + (d[2] + d[3])));
}
__device__ __forceinline__ float rstd_of(const float* ssp, int row) { return rsqrtf(ss_total(ssp, row) * (1.0f / DM) + NORM_EPS); }

namespace pg8 {
constexpr int BM = 256, BK = 64, HALF = 128, HTB = HALF * BK * 2, STAGE_BYTES = 8 * HTB, NXCD = 8, WGM = 8;
__host__ __device__ __forceinline__ int lds_byte(int r, int c) { const int st = (r >> 4) * 2 + (c >> 5), rr = r & 15, cc = c & 31, ob = rr * 64 + cc * 2; return st * 1024 + (ob ^ (((ob >> 9) & 1) << 5)); }
__host__ __device__ __forceinline__ void stage_rc(int b, int& R, int& C) { const int st = b / 1024, sb = b % 1024, swz = sb ^ (((sb >> 9) & 1) << 5); R = (st >> 1) * 16 + swz / 64; C = (st & 1) * 32 + (swz % 64) / 2; }

struct Unit { int pm, pn; const char* pa; const char* pb; };

struct StaticOrder {
    int nM, nN, nwg, G, c;
    __device__ void init(int nM_, int nN_, int G_, int c_) { nM = nM_; nN = nN_; nwg = nM * nN; G = G_; c = c_; }
    __device__ bool next(int i, int& pm, int& pn) const {
        const long L = (long)i * G + c; if (L >= nwg) return false;
        int wgid = (int)L; { const int q = nwg / NXCD, r = nwg % NXCD, xcd = wgid % NXCD, off = wgid / NXCD; wgid = (xcd < r ? xcd * (q + 1) : r * (q + 1) + (xcd - r) * q) + off; }
        const int nig = WGM * nN, gid = wgid / nig, fm = gid * WGM, gsz = (nM - fm) < WGM ? (nM - fm) : WGM;
        pm = fm + ((wgid % nig) % gsz); pn = (wgid % nig) / gsz; return true;
    }
};
struct DenseSched {
    StaticOrder so; const char* A; const char* B; size_t a_tile, b_tile;
    __device__ bool next(int i, Unit& u) const { if (!so.next(i, u.pm, u.pn)) return false; u.pa = A + (size_t)u.pm * a_tile; u.pb = B + (size_t)u.pn * b_tile; return true; }
};

template <class Epi, class Sched>
__device__ __forceinline__ void gemm_phase(LAS unsigned char* lds, const int lda, const int ldb, const int K, const Sched& S, const Epi& E) {
    int tid_ = threadIdx.x; asm volatile("" : "+v"(tid_));
    const int tid = tid_, wid = __builtin_amdgcn_readfirstlane(tid >> 6), lane = tid & 63, wr = wid >> 2, wc = wid & 3, fr = lane & 15, fq = lane >> 4;
    int K_ = K; asm volatile("" : "+s"(K_));
    const int nt = K_ / BK;
    unsigned voffA[2], voffB[2];
#pragma unroll
    for (int i = 0; i < 2; ++i) { int R, C; stage_rc(tid * 16 + i * 8192, R, C); voffA[i] = (unsigned)(R * lda + C) * 2u; voffB[i] = (unsigned)(R * ldb + C) * 2u; }
    const size_t kstep = (size_t)(BK * 2);
    const size_t hstepA = (size_t)HALF * lda * 2, hstepB = (size_t)HALF * ldb * 2;
    const unsigned ldsw = (unsigned)wid * 1024u;
    const int aoff = lds_byte(wr * 64 + fr, fq * 8), boff = lds_byte(wc * 32 + fr, fq * 8);
#define PG8_SA(b, h) (((b) * 2 + (h)) * HTB)
#define PG8_SB(b, h) ((4 + (b) * 2 + (h)) * HTB)
#define PG8_STAGE(bufoff, gbase, voff) do { _Pragma("unroll") for (int _i = 0; _i < 2; ++_i) \
        __builtin_amdgcn_global_load_lds((const unsigned*)((const char*)(gbase) + (voff)[_i]), (LAS unsigned*)(lds + (bufoff) + ldsw + _i * 8192), 16, 0, 0); } while (0)
#define PG8_LDA(dst, b, h) do { _Pragma("unroll") for (int m = 0; m < 4; ++m) _Pragma("unroll") for (int k = 0; k < 2; ++k) dst[m][k] = *(const LAS bf16x8*)(lds + PG8_SA(b, h) + aoff + m * 2048 + k * 1024); } while (0)
#define PG8_LDB(dst, b, h) do { _Pragma("unroll") for (int n = 0; n < 2; ++n) _Pragma("unroll") for (int k = 0; k < 2; ++k) dst[n][k] = *(const LAS bf16x8*)(lds + PG8_SB(b, h) + boff + n * 2048 + k * 1024); } while (0)
#define PG8_MMA(ai, bj, At, Bt) do { __builtin_amdgcn_s_setprio(1); _Pragma("unroll") for (int m = 0; m < 4; ++m) _Pragma("unroll") for (int n = 0; n < 2; ++n) _Pragma("unroll") for (int k = 0; k < 2; ++k) \
        acc[ai][bj][m][n] = __builtin_amdgcn_mfma_f32_16x16x32_bf16(Bt[n][k], At[m][k], acc[ai][bj][m][n], 0, 0, 0); __builtin_amdgcn_s_setprio(0); } while (0)
#define PG8_WAIT_V(n) asm volatile("s_waitcnt vmcnt(" #n ")" ::: "memory")
#define PG8_WAIT_L(n) asm volatile("s_waitcnt lgkmcnt(" #n ")" ::: "memory")
#define PG8_BAR __builtin_amdgcn_s_barrier()
#define PG8_SCHED __builtin_amdgcn_sched_barrier(0)
    Unit cur, nxt; int ui = 0;
    if (!S.next(0, cur)) return;
    f32x4 acc[2][2][4][2];
#pragma unroll
    for (int a = 0; a < 2; ++a)
#pragma unroll
        for (int b = 0; b < 2; ++b)
#pragma unroll
            for (int m = 0; m < 4; ++m)
#pragma unroll
                for (int n = 0; n < 2; ++n) acc[a][b][m][n] = (f32x4){0.f, 0.f, 0.f, 0.f};
    bf16x8 At[4][2], B0[2][2], B1[2][2];
    const char* cA = cur.pa; const char* cB = cur.pb;
    PG8_STAGE(PG8_SB(0, 0), cB, voffB); PG8_STAGE(PG8_SB(0, 1), cB + hstepB, voffB); PG8_STAGE(PG8_SA(0, 0), cA, voffA); PG8_STAGE(PG8_SA(0, 1), cA + hstepA, voffA);
    if (wr == 1) PG8_BAR;
    PG8_WAIT_V(2); PG8_BAR;
    PG8_STAGE(PG8_SB(1, 0), cB + kstep, voffB); PG8_STAGE(PG8_SA(1, 0), cA + kstep, voffA); PG8_STAGE(PG8_SB(1, 1), cB + hstepB + kstep, voffB);
    PG8_WAIT_V(6); PG8_BAR;
    for (;;) {
        const bool has_next = S.next(ui + 1, nxt);
        const char* nA = has_next ? nxt.pa : cA; const char* nB = has_next ? nxt.pb : cB;
        for (int t = 0; t < nt; t += 2) {
            const bool last = (t == nt - 2);
            const char* a1 = cA + (size_t)(t + 1) * kstep;
            const char* a2 = last ? nA : cA + (size_t)(t + 2) * kstep; const char* b2 = last ? nB : cB + (size_t)(t + 2) * kstep;
            const char* a3 = a2 + kstep; const char* b3 = b2 + kstep;
            PG8_LDB(B0, 0, 0); PG8_LDB(B1, 0, 1); PG8_SCHED; PG8_LDA(At, 0, 0); PG8_STAGE(PG8_SA(1, 1), a1 + hstepA, voffA);
            PG8_WAIT_V(8); PG8_WAIT_L(0); PG8_BAR; PG8_MMA(0, 0, At, B0); PG8_MMA(0, 1, At, B1); PG8_BAR; PG8_SCHED;
            PG8_LDA(At, 0, 1); PG8_STAGE(PG8_SB(0, 0), b2, voffB); PG8_STAGE(PG8_SB(0, 1), b2 + hstepB, voffB); PG8_STAGE(PG8_SA(0, 0), a2, voffA);
            PG8_WAIT_V(8); PG8_WAIT_L(0); PG8_BAR; PG8_MMA(1, 0, At, B0); PG8_MMA(1, 1, At, B1); PG8_BAR; PG8_SCHED;
            PG8_LDB(B0, 1, 0); PG8_LDB(B1, 1, 1); PG8_SCHED; PG8_LDA(At, 1, 0); PG8_STAGE(PG8_SA(0, 1), a2 + hstepA, voffA);
            PG8_WAIT_V(8); PG8_WAIT_L(0); PG8_BAR; PG8_MMA(0, 0, At, B0); PG8_MMA(0, 1, At, B1); PG8_BAR; PG8_SCHED;
            PG8_LDA(At, 1, 1); PG8_STAGE(PG8_SB(1, 0), b3, voffB); PG8_STAGE(PG8_SB(1, 1), b3 + hstepB, voffB); PG8_STAGE(PG8_SA(1, 0), a3, voffA);
            PG8_WAIT_V(8); PG8_WAIT_L(0); PG8_BAR; PG8_MMA(1, 0, At, B0); PG8_MMA(1, 1, At, B1); PG8_BAR; PG8_SCHED;
        }
        if (wr == 0) PG8_BAR;
        E(acc, cur, wr, wc, fr, fq);
        if (!has_next) break;
#pragma unroll
        for (int a = 0; a < 2; ++a)
#pragma unroll
            for (int b = 0; b < 2; ++b)
#pragma unroll
                for (int m = 0; m < 4; ++m)
#pragma unroll
                    for (int n = 0; n < 2; ++n) acc[a][b][m][n] = (f32x4){0.f, 0.f, 0.f, 0.f};
        cur = nxt; cA = nA; cB = nB; ++ui;
        if (wr == 1) PG8_BAR;
    }
    PG8_WAIT_V(0);
    PG8_BAR;
#undef PG8_SA
#undef PG8_SB
#undef PG8_STAGE
#undef PG8_LDA
#undef PG8_LDB
#undef PG8_MMA
#undef PG8_WAIT_V
#undef PG8_WAIT_L
#undef PG8_BAR
#undef PG8_SCHED
}
}

#define EPI_ROW(u, ai, m) ((u).pm * 256 + (ai) * 128 + wr * 64 + (m) * 16 + fr)
#define EPI_COL(u, bj, n) ((u).pn * 256 + (bj) * 128 + wc * 32 + (n) * 16 + fq * 4)
typedef f32x4 Acc[2][2][4][2];

__device__ __forceinline__ u32x2 pack4(f32x4 v) { u32x2 w; w.x = cvt_pk(v[0], v[1]); w.y = cvt_pk(v[2], v[3]); return w; }
__device__ __forceinline__ f32x4 unpack4(u32x2 w) { f32x4 v; v[0] = bf2f(w.x & 0xffffu); v[1] = bf2f(w.x >> 16); v[2] = bf2f(w.y & 0xffffu); v[3] = bf2f(w.y >> 16); return v; }

template <bool WT> struct EpiInT {
    bf16_t* U; float* misc; const float* ss;
    __device__ __forceinline__ void st8(void* p, u32x2 v) const {
        if (WT) __hip_atomic_store((unsigned long long*)p, ((unsigned long long)v.y << 32) | v.x, RLX_AGENT); else *(u32x2*)p = v;
    }
    __device__ __forceinline__ void operator()(const Acc& acc, const pg8::Unit& u, int wr, int wc, int fr, int fq) const {
#pragma unroll
        for (int ai = 0; ai < 2; ++ai)
#pragma unroll
            for (int m = 0; m < 4; ++m) {
                const int row = EPI_ROW(u, ai, m); const float rs = rstd_of(ss, row);
                if (u.pn < 21) {
#pragma unroll
                    for (int bj = 0; bj < 2; ++bj)
#pragma unroll
                        for (int n = 0; n < 2; ++n) st8(U + (size_t)row * UW + EPI_COL(u, bj, n), pack4(acc[ai][bj][m][n] * rs));
                } else if (wc == 0) {
#pragma unroll
                    for (int n = 0; n < 2; ++n) { const f32x4 v = acc[ai][0][m][n] * rs; float* mp = misc + (size_t)row * 32 + n * 16 + fq * 4;
                        st8(mp, (u32x2){__float_as_uint(v[0]), __float_as_uint(v[1])}); st8(mp + 2, (u32x2){__float_as_uint(v[2]), __float_as_uint(v[3])}); }
                }
            }
    }
};
typedef EpiInT<false> EpiIn;
struct EpiGates {
    bf16_t* G; const float* ss;
    __device__ __forceinline__ void operator()(const Acc& acc, const pg8::Unit& u, int wr, int wc, int fr, int fq) const {
#pragma unroll
        for (int ai = 0; ai < 2; ++ai)
#pragma unroll
            for (int m = 0; m < 4; ++m) {
                const int row = EPI_ROW(u, ai, m); const float rs = rstd_of(ss, row);
#pragma unroll
                for (int bj = 0; bj < 2; ++bj)
#pragma unroll
                    for (int n = 0; n < 2; ++n) { f32x4 v = acc[ai][bj][m][n] * rs; v[0] = sigmoidf_(v[0]); v[1] = sigmoidf_(v[1]); v[2] = sigmoidf_(v[2]); v[3] = sigmoidf_(v[3]);
                        *(u32x2*)(G + (size_t)row * 4096 + EPI_COL(u, bj, n)) = pack4(v); }
            }
    }
};
struct EpiBrAll {
    bf16_t* MG; const bf16_t* G;
    __device__ __forceinline__ void operator()(const Acc& acc, const pg8::Unit& u, int wr, int wc, int fr, int fq) const {
        const int mb = u.pn >> 8, pn = u.pn & 255;
        if (mb > 0) asm volatile("s_waitcnt vmcnt(0)" ::: "memory");
#pragma unroll
        for (int ai = 0; ai < 2; ++ai)
#pragma unroll
            for (int m = 0; m < 4; ++m) {
                const int row = u.pm * 256 + ai * 128 + wr * 64 + m * 16 + fr;
#pragma unroll
                for (int bj = 0; bj < 2; ++bj)
#pragma unroll
                    for (int n = 0; n < 2; ++n) { const int col = pn * 256 + bj * 128 + wc * 32 + n * 16 + fq * 4;
                        const f32x4 g = unpack4(*(const u32x2*)(G + (size_t)row * 4096 + mb * 1024 + col));
                        f32x4 v = acc[ai][bj][m][n] * g;
                        bf16_t* mp = MG + (size_t)row * DM + col;
                        if (mb > 0) v += unpack4(ld_agent_u64(mp));
                        *(u32x2*)mp = pack4(v); }
                asm volatile("" ::: "memory");
            }
    }
};
template <bool WRITE_XB, bool ACC_SS> struct EpiRes {
    const float* xin; float* xo; bf16_t* xb; float* ss;
    __device__ __forceinline__ void operator()(const Acc& acc, const pg8::Unit& u, int wr, int wc, int fr, int fq) const {
#pragma unroll
        for (int ai = 0; ai < 2; ++ai)
#pragma unroll
            for (int m = 0; m < 4; ++m) {
                const int row = EPI_ROW(u, ai, m); float s = 0.f;
#pragma unroll
                for (int bj = 0; bj < 2; ++bj)
#pragma unroll
                    for (int n = 0; n < 2; ++n) { const size_t off = (size_t)row * DM + EPI_COL(u, bj, n);
                        const f32x4 v = *(const f32x4*)(xin + off) + acc[ai][bj][m][n];
                        *(f32x4*)(xo + off) = v;
                        if (WRITE_XB) *(u32x2*)(xb + off) = pack4(v);
                        if (ACC_SS) s += (v[0] * v[0] + v[1] * v[1]) + (v[2] * v[2] + v[3] * v[3]); }
                if (ACC_SS) { s += __shfl_xor(s, 16); s += __shfl_xor(s, 32); if (fq == 0) ss[(size_t)row * 16 + u.pn * 4 + wc] = s; }
                asm volatile("" ::: "memory");
            }
    }
};
template <bool MOE> struct EpiFfn1 {
    bf16_t* ACT; const float* ss;
    __device__ __forceinline__ void operator()(const Acc& acc, const pg8::Unit& u, int wr, int wc, int fr, int fq) const {
#pragma unroll
        for (int ai = 0; ai < 2; ++ai)
#pragma unroll
            for (int m = 0; m < 4; ++m) {
                const int row = EPI_ROW(u, ai, m); const float rs = MOE ? ss[row] : rstd_of(ss, row);
#pragma unroll
                for (int n = 0; n < 2; ++n) { const f32x4 g = acc[ai][0][m][n] * rs, up = acc[ai][1][m][n] * rs; f32x4 v;
                    v[0] = siluf_(g[0]) * up[0]; v[1] = siluf_(g[1]) * up[1]; v[2] = siluf_(g[2]) * up[2]; v[3] = siluf_(g[3]) * up[3];
                    *(u32x2*)(ACT + (size_t)row * D_FF + u.pn * 128 + wc * 32 + n * 16 + fq * 4) = pack4(v); }
            }
    }
};
template <bool SIG> struct EpiBf16 {
    bf16_t* O;
    __device__ __forceinline__ void operator()(const Acc& acc, const pg8::Unit& u, int wr, int wc, int fr, int fq) const {
#pragma unroll
        for (int ai = 0; ai < 2; ++ai)
#pragma unroll
            for (int m = 0; m < 4; ++m) {
                const int row = EPI_ROW(u, ai, m);
#pragma unroll
                for (int bj = 0; bj < 2; ++bj)
#pragma unroll
                    for (int n = 0; n < 2; ++n) { f32x4 v = acc[ai][bj][m][n];
                        if (SIG) { v[0] = sigmoidf_(v[0]); v[1] = sigmoidf_(v[1]); v[2] = sigmoidf_(v[2]); v[3] = sigmoidf_(v[3]); }
                        *(u32x2*)(O + (size_t)row * DM + EPI_COL(u, bj, n)) = pack4(v); }
            }
    }
};
template <bool WRITE_XB> struct EpiPle2 {
    float* xo; const bf16_t* G; bf16_t* xb; float* ss;
    __device__ __forceinline__ void operator()(const Acc& acc, const pg8::Unit& u, int wr, int wc, int fr, int fq) const {
#pragma unroll
        for (int ai = 0; ai < 2; ++ai)
#pragma unroll
            for (int m = 0; m < 4; ++m) {
                const int row = EPI_ROW(u, ai, m); float s = 0.f;
#pragma unroll
                for (int bj = 0; bj < 2; ++bj)
#pragma unroll
                    for (int n = 0; n < 2; ++n) { const size_t off = (size_t)row * DM + EPI_COL(u, bj, n);
                        const f32x4 g = unpack4(ld_agent_u64(G + off));
                        const f32x4 v = *(const f32x4*)(xo + off) + g * acc[ai][bj][m][n];
                        *(f32x4*)(xo + off) = v;
                        if (WRITE_XB) *(u32x2*)(xb + off) = pack4(v);
                        s += (v[0] * v[0] + v[1] * v[1]) + (v[2] * v[2] + v[3] * v[3]); }
                s += __shfl_xor(s, 16); s += __shfl_xor(s, 32); if (fq == 0) ss[(size_t)row * 16 + u.pn * 4 + wc] = s;
                asm volatile("" ::: "memory");
            }
    }
};

struct BatchSched {
    int pm, pn0, n; const char* A; const char* B; size_t a_tile, b_tile;
    __device__ bool next(int i, pg8::Unit& u) const { if (i >= n) return false; u.pm = pm; u.pn = pn0 + i; u.pa = A + (size_t)pm * a_tile; u.pb = B + (size_t)u.pn * b_tile; return true; }
};
struct InBatchSched {
    int pm, kind, i0, n; const char* A; const char* B; size_t a_tile, b_tile;
    __device__ bool next(int ii, pg8::Unit& u) const {
        if (ii >= n) return false;
        const int i = i0 + ii; int pn;
        if (kind == 0) pn = 11 + i;
        else if (kind == 1) pn = i < 6 ? i : 21;
        else pn = i < 5 ? 6 + i : 13 + i;
        u.pm = pm; u.pn = pn; u.pa = A + (size_t)pm * a_tile; u.pb = B + (size_t)pn * b_tile; return true;
    }
};
struct BranchSched {
    pg8::StaticOrder so; const char* Y; const char* PT; size_t a_tile, b_tile, a_br, b_br;
    __device__ bool next(int i, pg8::Unit& u) const {
        if (i >= 4) return false; int pm, pn; if (!so.next(0, pm, pn)) return false;
        u.pm = pm; u.pn = pn | (i << 8); u.pa = Y + (size_t)i * a_br + (size_t)pm * a_tile; u.pb = PT + (size_t)i * b_br + (size_t)pn * b_tile; return true;
    }
};
struct MoeTables { int ps1, ps2, ps3, ps4, ps5, ps6, ps7, ps8; };
__device__ __forceinline__ int moe_expert_of_row(const MoeTables& mt, int row) {
    return (row >= mt.ps1) + (row >= mt.ps2) + (row >= mt.ps3) + (row >= mt.ps4) + (row >= mt.ps5) + (row >= mt.ps6) + (row >= mt.ps7);
}
struct MoeSched {
    MoeTables mt; int nN, G, c; const char* A; const char* B; size_t a_tile, b_tile, b_expert;
    __device__ bool next(int i, pg8::Unit& u) const {
        const long L = (long)i * G + c; const int ntiles = mt.ps8 >> 8;
        if (L >= (long)ntiles * nN) return false;
        u.pm = (int)(L / nN); u.pn = (int)(L % nN);
        const int e = moe_expert_of_row(mt, u.pm * 256);
        u.pa = A + (size_t)u.pm * a_tile; u.pb = B + (size_t)e * b_expert + (size_t)u.pn * b_tile; return true;
    }
};

struct Args { const void* in[42]; float* out; unsigned char* ws; int ph_lo, ph_hi; };
typedef const __attribute__((address_space(4))) Args* KArgs;
__device__ __forceinline__ KArgs kargs() { KArgs p = (KArgs)__builtin_amdgcn_kernarg_segment_ptr(); asm volatile("" : "+s"(p)); return p; }
struct Frame {
    LAS unsigned char* lds; int tid, lane, wave, G, bid;
    unsigned char* ws; unsigned* ctl;
};
#define IN_F(k) ((const float*)KA->in[k])

constexpr int DEFER_ITEMS = 3472 + 16896;
struct TJob { const float* src; int ldw, K, ncols, ldt, mode; bf16_t* dst; const float* gain; };
__device__ __forceinline__ void tr_item(const TJob& J, LAS float* scr, int item, int lane) {
    const int nblk = J.ncols / 64, kb = item / nblk, nb = item % nblk, k0 = 64 * kb, n0 = 64 * nb;
    const int c = lane;
    const bool live = (J.mode != 3) || c < 32;
    const int scol = (J.mode == 3) ? (c < 8 ? 1536 + c : (c < 32 ? 2816 + c : 0)) : n0 + c;
    const float* sp = J.src + (size_t)k0 * J.ldw + scol;
    float v[64];
#pragma unroll
    for (int i = 0; i < 64; ++i) v[i] = sp[(size_t)i * J.ldw];
#pragma unroll
    for (int i = 0; i < 64; ++i) { float x = live ? v[i] : 0.f; if (J.gain) x *= J.gain[k0 + i]; scr[i * 65 + c] = x; }
    asm volatile("s_waitcnt lgkmcnt(0)" ::: "memory");
    int drow0 = n0;
    if (J.mode == 1 || J.mode == 2) drow0 = (n0 / 128) * 256 + (n0 % 128) + (J.mode == 2 ? 128 : 0);
    const int c8 = lane & 7;
#pragma unroll
    for (int j = 0; j < 8; ++j) { const int n = (lane >> 3) + 8 * j; const LAS float* sq = scr + (8 * c8) * 65 + n;
        u32x4 o; o.x = cvt_pk(sq[0 * 65], sq[1 * 65]); o.y = cvt_pk(sq[2 * 65], sq[3 * 65]); o.z = cvt_pk(sq[4 * 65], sq[5 * 65]); o.w = cvt_pk(sq[6 * 65], sq[7 * 65]);
        *(u32x4*)(J.dst + (size_t)(drow0 + n) * J.ldt + k0 + 8 * c8) = o; }
    asm volatile("s_waitcnt lgkmcnt(0)" ::: "memory");
}
constexpr int NJOBS = 32 + 3 + 24 + 8;
__device__ __forceinline__ bool job_deferred(int jid) { return (jid >= 16 && jid < 32) || (jid >= 35 && jid < 59); }
__device__ __forceinline__ bool get_job(KArgs KA, int jid, TJob& J) {
    unsigned char* ws = KA->ws;
    J.gain = nullptr; J.mode = 0;
    if (jid < 32) {
        const int L = jid >> 4, j = jid & 15;
        unsigned char* wa = ws + WS_WA + (size_t)L * WA_STRIDE;
        if (j <= 8) {
            const float* w = IN_F(4) + (size_t)L * DM * D_IN; J.ldw = D_IN; J.K = DM; J.ldt = DM; J.gain = IN_F(3) + L * DM;
            int sc, nc, dr;
            switch (j) { case 0: sc = 0; nc = 512; dr = 0; break; case 1: sc = 512; nc = 1024; dr = 512; break; case 2: sc = 1544; nc = 512; dr = 1536; break;
                case 3: sc = 2056; nc = 768; dr = 2048; break; case 4: sc = 2848; nc = 1792; dr = 2816; break; case 5: sc = 4640; nc = 512; dr = 4608; break;
                case 6: sc = 5152; nc = 256; dr = 5120; break; case 7: sc = 0; nc = 64; dr = 5376; J.mode = 3; break; default: sc = 5408; nc = 4096; dr = 0; break; }
            J.src = w + sc; J.ncols = nc; J.dst = (bf16_t*)(wa + (j == 8 ? WA_GATE : WA_IN)) + (size_t)dr * DM;
            return true;
        }
        if (j <= 12) { const int m = j - 9; J.src = IN_F(26 + m) + (size_t)L * 512 * DM; J.ldw = DM; J.K = 512; J.ncols = DM; J.ldt = 512; J.dst = (bf16_t*)(wa + WA_PT + (size_t)m * MiB); return true; }
        if (j == 13) { J.src = IN_F(30) + (size_t)L * DM * DM; J.ldw = DM; J.K = DM; J.ncols = DM; J.ldt = DM; J.dst = (bf16_t*)(wa + WA_OUT); return true; }
        if (j == 14) { J.src = IN_F(40) + (size_t)L * DM * DM; J.ldw = DM; J.K = DM; J.ncols = DM; J.ldt = DM; J.dst = (bf16_t*)(wa + WA_PG); return true; }
        J.src = IN_F(39) + (size_t)L * PLE * DM; J.ldw = DM; J.K = PLE; J.ncols = DM; J.ldt = PLE; J.dst = (bf16_t*)(wa + WA_PP); return true;
    }
    if (jid < 35) {
        const int j = jid - 32;
        if (j < 2) { J.src = IN_F(32 + j); J.ldw = D_FF; J.K = DM; J.ncols = D_FF; J.ldt = DM; J.gain = IN_F(31); J.mode = 1 + j; J.dst = (bf16_t*)(ws + WS_FGU); return true; }
        J.src = IN_F(34); J.ldw = DM; J.K = D_FF; J.ncols = DM; J.ldt = D_FF; J.dst = (bf16_t*)(ws + WS_FDN); return true;
    }
    if (jid < 59) {
        const int e = (jid - 35) / 3, j = (jid - 35) % 3;
        unsigned char* wb = ws + WS_WB + (size_t)e * WB_STRIDE;
        if (j < 2) { J.src = IN_F(36 + j) + (size_t)e * DM * D_FF; J.ldw = D_FF; J.K = DM; J.ncols = D_FF; J.ldt = DM; J.gain = IN_F(31) + DM; J.mode = 1 + j; J.dst = (bf16_t*)wb; return true; }
        J.src = IN_F(38) + (size_t)e * D_FF * DM; J.ldw = DM; J.K = D_FF; J.ncols = DM; J.ldt = D_FF; J.dst = (bf16_t*)(wb + WB_DN); return true;
    }
    {
        const int j = jid - 59, idx = j & 3;
        if (j < 4) { J.src = IN_F(12) + (size_t)idx * 2048 * 64; J.ldw = 64; J.K = 2048; J.ncols = 64; J.ldt = 2048; J.dst = (bf16_t*)(ws + WS_W1T) + (size_t)idx * 64 * 2048; return true; }
        J.src = IN_F(13) + (size_t)idx * 64 * 64; J.ldw = 64; J.K = 64; J.ncols = 64; J.ldt = 64; J.dst = (bf16_t*)(ws + WS_W2T) + (size_t)idx * 64 * 64; return true;
    }
}
__device__ UNIT_INLINE void p0_prologue(KArgs KA, Frame& F) {
    LAS float* scr = (LAS float*)(F.lds + F.wave * 16640);
    const int gw = F.bid * 8 + F.wave, NGW = F.G * 8;
    unsigned char* ws = KA->ws;
    {
        int jid = 0, loc = gw; TJob J; get_job(KA, 0, J); int nit = (J.K / 64) * (J.ncols / 64);
        for (;;) {
            while (jid < NJOBS && loc >= nit) { loc -= nit; ++jid; if (jid < NJOBS) { get_job(KA, jid, J); nit = job_deferred(jid) ? 0 : (J.K / 64) * (J.ncols / 64); } }
            if (jid >= NJOBS) break;
            tr_item(J, scr, loc, F.lane);
            loc += NGW;
        }
    }
    for (int L = 0; L < 2; ++L) {
        u32x4* z = (u32x4*)((bf16_t*)(ws + WS_WA + (size_t)L * WA_STRIDE + WA_IN) + (size_t)5440 * DM);
        const int n16 = 192 * DM * 2 / 16;
        for (int i = gw * 64 + F.lane; i < n16; i += NGW * 64) z[i] = (u32x4){0u, 0u, 0u, 0u};
    }
    for (int o = gw; o < 256; o += NGW) {
        const int idx = o >> 6, f = o & 63;
        const float* pe = IN_F(11) + (size_t)idx * 2048; const float* w1 = IN_F(12) + (size_t)idx * 2048 * 64 + f; float s = 0.f;
#pragma unroll 8
        for (int k = F.lane; k < 2048; k += 64) s += pe[k] * w1[(size_t)k * 64];
        s = wave_sum(s);
        if (F.lane == 0) ((float*)(ws + WS_PEB))[o] = s;
    }
    for (int i = gw * 64 + F.lane; i < 2 * 8 * 4 * 8 * 64; i += NGW * 64) {
        const int ln = i & 63, fr = (i >> 6) & 7, nt = (i >> 9) & 3, hh = (i >> 11) & 7, LL = i >> 14;
        const int cn = hh * 64 + 16 * nt + (ln & 15), kgl = ln >> 4;
        const float* W = (fr < 2) ? IN_F(16) + (size_t)LL * 64 * 512 : (fr < 4) ? IN_F(18) + (size_t)LL * 64 * 512 : IN_F(19) + (size_t)LL * 128 * 512;
        const int ks = (fr < 2) ? fr : (fr < 4) ? fr - 2 : fr - 4;
        u32x4 o;
#pragma unroll
        for (int j = 0; j < 4; ++j) { const int k = 32 * ks + 8 * kgl + 2 * j; o[j] = cvt_pk(W[(size_t)k * 512 + cn], W[(size_t)(k + 1) * 512 + cn]); }
        ((u32x4*)(ws + WS_LW))[i] = o;
    }
    {
        const float* x = IN_F(0); bf16_t* xb = (bf16_t*)(ws + WS_XB); float* ss = (float*)(ws + WS_SSP);
        for (int m = gw; m < T; m += NGW) {
            const f32x4* xr = (const f32x4*)(x + (size_t)m * DM) + F.lane; float s = 0.f;
            u32x2* o = (u32x2*)(xb + (size_t)m * DM) + F.lane;
#pragma unroll
            for (int j = 0; j < 4; ++j) { const f32x4 v = xr[64 * j]; s += (v[0] * v[0] + v[1] * v[1]) + (v[2] * v[2] + v[3] * v[3]); o[64 * j] = pack4(v); }
            s = wave_sum(s); if (F.lane < 16) ss[(size_t)m * 16 + F.lane] = (F.lane == 0) ? s : 0.f;
        }
    }
    {
        const int* pos = (const int*)KA->in[2]; float* rc = (float*)(ws + WS_ROPE); float* rsn = rc + (size_t)T * 32;
        for (int i = (gw * 64 + F.lane); i < T * 32; i += NGW * 64) {
            const int t = i >> 5, k = i & 31;
            const float inv = (float)exp2(-(double)k * (1.0 / 32.0) * 17.194602975157967);
            const float ang = (float)pos[t] * inv;
            rc[i] = cosf(ang); rsn[i] = sinf(ang);
        }
    }
}


__device__ UNIT_INLINE void deferred_convert(KArgs KA, Frame& F, unsigned* q, LAS unsigned* s_uid, int jlo, int jhi, int nitems) {
    LAS float* scr = (LAS float*)(F.lds + F.wave * 16640);
    for (;;) {
        __syncthreads();
        if (F.tid == 0) *s_uid = atomicAdd(q, 1u);
        __syncthreads();
        int loc = (int)*s_uid * 8 + F.wave;
        int jid = jlo; TJob J; bool found = false;
        for (; jid < jhi; ++jid) { if (!job_deferred(jid)) continue; get_job(KA, jid, J); const int nit = (J.K / 64) * (J.ncols / 64); if (loc < nit) { found = true; break; } loc -= nit; }
        if (found) tr_item(J, scr, loc, F.lane);
        if ((int)*s_uid * 8 >= nitems) break;
    }
}


__device__ __forceinline__ void dep_signal(unsigned* c0, unsigned* c1, bool leader) {
    asm volatile("s_waitcnt vmcnt(0)" ::: "memory");
    __syncthreads();
    if (leader) {
        __builtin_amdgcn_fence(__ATOMIC_RELEASE, "agent");
        asm volatile("s_waitcnt vmcnt(0)" ::: "memory");
        __hip_atomic_fetch_add(c0, 1u, __ATOMIC_RELAXED, __HIP_MEMORY_SCOPE_AGENT);
        if (c1) __hip_atomic_fetch_add(c1, 1u, __ATOMIC_RELAXED, __HIP_MEMORY_SCOPE_AGENT);
    }
}
__device__ __forceinline__ void dep_signal_wt(unsigned* c0, unsigned* c1, bool leader) {
    asm volatile("s_waitcnt vmcnt(0)" ::: "memory");
    __syncthreads();
    if (leader) { __hip_atomic_fetch_add(c0, 1u, __ATOMIC_RELAXED, __HIP_MEMORY_SCOPE_AGENT); if (c1) __hip_atomic_fetch_add(c1, 1u, __ATOMIC_RELAXED, __HIP_MEMORY_SCOPE_AGENT); }
}
__device__ __forceinline__ void dep_poll_lane(unsigned* c, unsigned target) {
    unsigned spins = 0;
    while (__hip_atomic_load(c, __ATOMIC_RELAXED, __HIP_MEMORY_SCOPE_AGENT) < target) { __builtin_amdgcn_s_sleep(2); if (++spins > (1u << 24)) break; }
}
__device__ __forceinline__ void dep_wait_lane(unsigned* c, unsigned target) {
    unsigned spins = 0;
    while (__hip_atomic_load(c, __ATOMIC_RELAXED, __HIP_MEMORY_SCOPE_AGENT) < target) { __builtin_amdgcn_s_sleep(2); if (++spins > (1u << 24)) break; }
    __builtin_amdgcn_fence(__ATOMIC_ACQUIRE, "agent");
    asm volatile("s_waitcnt vmcnt(0)" ::: "memory");
}
__device__ __forceinline__ void dep_wait(unsigned* c, unsigned target, bool leader) {
    if (leader) dep_poll_lane(c, target);
    __syncthreads();
}

__device__ UNIT_INLINE void rope_pass(Frame& F, bf16_t* U1, const float* rc, const float* rsn) {
    const int gt = F.bid * 512 + F.tid, NT = F.G * 512;
    for (int i = gt; i < T * 40; i += NT) {
        const int t = i / 40, r = i % 40, slot = r >> 2, ch = r & 3;
        bf16_t* base = U1 + (size_t)t * UW + (slot < 8 ? UC_SQ + slot * 64 : UC_SKV + (slot - 8) * 64) + ch * 8;
        const u32x4 a = *(const u32x4*)base, b = *(const u32x4*)(base + 32);
        const f32x4 c0 = *(const f32x4*)(rc + (size_t)t * 32 + ch * 8), c1 = *(const f32x4*)(rc + (size_t)t * 32 + ch * 8 + 4);
        const f32x4 s0 = *(const f32x4*)(rsn + (size_t)t * 32 + ch * 8), s1 = *(const f32x4*)(rsn + (size_t)t * 32 + ch * 8 + 4);
        float x1[8], x2[8], cs[8], sn[8];
#pragma unroll
        for (int j = 0; j < 4; ++j) { x1[2 * j] = bf2f(a[j] & 0xffffu); x1[2 * j + 1] = bf2f(a[j] >> 16); x2[2 * j] = bf2f(b[j] & 0xffffu); x2[2 * j + 1] = bf2f(b[j] >> 16);
            cs[j] = c0[j]; cs[4 + j] = c1[j]; sn[j] = s0[j]; sn[4 + j] = s1[j]; }
        u32x4 oa, ob;
#pragma unroll
        for (int j = 0; j < 4; ++j) {
            const float y1a = x1[2 * j] * cs[2 * j] - x2[2 * j] * sn[2 * j], y1b = x1[2 * j + 1] * cs[2 * j + 1] - x2[2 * j + 1] * sn[2 * j + 1];
            const float y2a = x2[2 * j] * cs[2 * j] + x1[2 * j] * sn[2 * j], y2b = x2[2 * j + 1] * cs[2 * j + 1] + x1[2 * j + 1] * sn[2 * j + 1];
            oa[j] = cvt_pk(y1a, y1b); ob[j] = cvt_pk(y2a, y2b);
        }
        *(u32x4*)base = oa; *(u32x4*)(base + 32) = ob;
    }
}
__device__ UNIT_INLINE void rope_slice(Frame& F, bf16_t* U1, const float* rc, const float* rsn, int slice) {
    for (int i = slice * 5120 + F.tid; i < (slice + 1) * 5120; i += 512) {
        const int t = i / 40, r = i % 40, slot = r >> 2, ch = r & 3;
        bf16_t* base = U1 + (size_t)t * UW + (slot < 8 ? UC_SQ + slot * 64 : UC_SKV + (slot - 8) * 64) + ch * 8;
        const u32x4 a = *(const u32x4*)base, b = *(const u32x4*)(base + 32);
        const f32x4 c0 = *(const f32x4*)(rc + (size_t)t * 32 + ch * 8), c1 = *(const f32x4*)(rc + (size_t)t * 32 + ch * 8 + 4);
        const f32x4 s0 = *(const f32x4*)(rsn + (size_t)t * 32 + ch * 8), s1 = *(const f32x4*)(rsn + (size_t)t * 32 + ch * 8 + 4);
        u32x4 oa, ob;
#pragma unroll
        for (int j = 0; j < 4; ++j) {
            const float xa = bf2f(a[j] & 0xffffu), xb = bf2f(a[j] >> 16), ya = bf2f(b[j] & 0xffffu), yb = bf2f(b[j] >> 16);
            const float ca = j < 2 ? c0[2 * j] : c1[2 * j - 4], cb = j < 2 ? c0[2 * j + 1] : c1[2 * j - 3], sa = j < 2 ? s0[2 * j] : s1[2 * j - 4], sb = j < 2 ? s0[2 * j + 1] : s1[2 * j - 3];
            oa[j] = cvt_pk(xa * ca - ya * sa, xb * cb - yb * sb); ob[j] = cvt_pk(ya * ca + xa * sa, yb * cb + xb * sb);
        }
        *(u32x4*)base = oa; *(u32x4*)(base + 32) = ob;
    }
}
__device__ UNIT_INLINE void compress_unit(Frame& F, int unit, int L, const bf16_t* U1, unsigned char* ws) {
    const int nc = unit & 3, kv = (unit >> 2) & 1, g = (unit >> 3) & 1, b = unit >> 4;
    const int n0 = nc * 32, tok0 = n0 * 16;
    LAS bf16_t* tok = (LAS bf16_t*)F.lds;
    LAS bf16_t* hid = (LAS bf16_t*)(F.lds + 528 * 72 * 2);
    const bf16_t* src = U1 + (size_t)(b * SEQ) * UW + UC_NKV + kv * 128 + g * 64;
    __syncthreads();
    for (int i = F.tid; i < 528 * 8; i += 512) { const int r = i >> 3, ch = i & 7; const int t = tok0 + r;
        u32x4 v = (u32x4){0u, 0u, 0u, 0u}; if (t < SEQ) v = *(const u32x4*)(src + (size_t)t * UW + ch * 8);
        *(LAS u32x4*)(tok + r * 72 + ch * 8) = v; }
    __syncthreads();
    const int idx = L * 2 + kv;
    const bf16_t* w1t = (const bf16_t*)(ws + WS_W1T) + (size_t)idx * 64 * 2048;
    const bf16_t* w2t = (const bf16_t*)(ws + WS_W2T) + (size_t)idx * 64 * 64;
    const float* peb = (const float*)(ws + WS_PEB) + idx * 64;
    const int mt = F.wave >> 2, ntile = F.wave & 3, r16 = F.lane & 15, kg = F.lane >> 4;
    f32x4 acc = (f32x4){0.f, 0.f, 0.f, 0.f};
    const int nl = mt * 16 + r16;
    const bf16_t* bp = w1t + (size_t)(ntile * 16 + r16) * 2048 + kg * 8;
#pragma unroll 4
    for (int ks = 0; ks < 64; ++ks) {
        const int l = ks >> 1, db = (ks & 1) * 32 + kg * 8;
        const bf16x8 a = *(const LAS bf16x8*)(tok + (16 * nl + l) * 72 + db);
        const bf16x8 bb = *(const bf16x8*)(bp + ks * 32);
        acc = __builtin_amdgcn_mfma_f32_16x16x32_bf16(a, bb, acc, 0, 0, 0);
    }
    { const int f = ntile * 16 + r16; const float pb = peb[f];
#pragma unroll
      for (int r = 0; r < 4; ++r) hid[(mt * 16 + 4 * kg + r) * 72 + f] = (bf16_t)f2bf(siluf_(acc[r] + pb)); }
    __syncthreads();
    f32x4 o = (f32x4){0.f, 0.f, 0.f, 0.f};
#pragma unroll
    for (int ks = 0; ks < 2; ++ks) {
        const bf16x8 a = *(const LAS bf16x8*)(hid + nl * 72 + ks * 32 + kg * 8);
        const bf16x8 bb = *(const bf16x8*)(w2t + (size_t)(ntile * 16 + r16) * 64 + ks * 32 + kg * 8);
        o = __builtin_amdgcn_mfma_f32_16x16x32_bf16(a, bb, o, 0, 0, 0);
    }
    bf16_t* dst = (bf16_t*)(ws + (kv ? WS_VC : WS_KC)) + (size_t)((b * 2 + g) * 128) * 64;
#pragma unroll
    for (int r = 0; r < 4; ++r) { const int n = n0 + mt * 16 + 4 * kg + r; dst[(size_t)n * 64 + ntile * 16 + r16] = (n < 127) ? (bf16_t)f2bf(o[r]) : (bf16_t)0; }
}

__device__ __forceinline__ int crow(int r, int hi) { return (r & 3) + 8 * (r >> 2) + 4 * hi; }
constexpr int KS_LD = 72;
struct AttnSt { float m, l; f32x16 o0, o1; };
__device__ __forceinline__ void attn_init(AttnSt& s) { s.m = -INFINITY; s.l = 0.f;
#pragma unroll
    for (int r = 0; r < 16; ++r) { s.o0[r] = 0.f; s.o1[r] = 0.f; } }
constexpr int TILE_EL = 64 * 64;
__device__ __forceinline__ void dma_kv(const bf16_t* Kg, int ldk, const bf16_t* Vg, int ldv, LAS bf16_t* Ks, LAS bf16_t* Vs, int wave, int lane) {
    const int key = 8 * wave + (lane >> 3), ch = (lane & 7) ^ (key & 7);
    __builtin_amdgcn_global_load_lds((const unsigned*)(Kg + (size_t)key * ldk + ch * 8), (LAS unsigned*)(Ks + wave * 512), 16, 0, 0);
    __builtin_amdgcn_global_load_lds((const unsigned*)(Vg + (size_t)key * ldv + ch * 8), (LAS unsigned*)(Vs + wave * 512), 16, 0, 0);
}
__device__ __forceinline__ int swz_el(int key, int chunk) { return key * 64 + ((chunk ^ (key & 7)) << 3); }
__device__ __forceinline__ void attn_scores(const LAS bf16_t* Ks, const bf16x8 (&qr)[4], f32x16& p0, f32x16& p1, int r32, int hi) {
#pragma unroll
    for (int r = 0; r < 16; ++r) { p0[r] = 0.f; p1[r] = 0.f; }
#pragma unroll
    for (int d0 = 0; d0 < 4; ++d0) {
        const bf16x8 k0 = *(const LAS bf16x8*)(Ks + swz_el(r32, 2 * d0 + hi));
        const bf16x8 k1 = *(const LAS bf16x8*)(Ks + swz_el(32 + r32, 2 * d0 + hi));
        p0 = __builtin_amdgcn_mfma_f32_32x32x16_bf16(k0, qr[d0], p0, 0, 0, 0);
        p1 = __builtin_amdgcn_mfma_f32_32x32x16_bf16(k1, qr[d0], p1, 0, 0, 0);
    }
}
typedef short v4i16_t __attribute__((ext_vector_type(4)));
__device__ __forceinline__ void attn_pv(const LAS bf16_t* Vs, const f32x16& p0, const f32x16& p1, f32x16& o0, f32x16& o1, int r32, int hi) {
    bf16x8 pa[4];
#pragma unroll
    for (int s = 0; s < 2; ++s) {
        u32x4 w0, w1;
#pragma unroll
        for (int j = 0; j < 4; ++j) { w0[j] = cvt_pk(p0[8 * s + 2 * j], p0[8 * s + 2 * j + 1]); w1[j] = cvt_pk(p1[8 * s + 2 * j], p1[8 * s + 2 * j + 1]); }
        pa[s] = __builtin_bit_cast(bf16x8, w0); pa[2 + s] = __builtin_bit_cast(bf16x8, w1);
    }
    const int lane = hi * 32 + r32;
    const int krow = 4 * hi + ((lane & 15) >> 2), cb = 2 * ((lane >> 4) & 1) + ((lane & 3) >> 1), sub = 4 * (lane & 1);
#pragma unroll
    for (int s = 0; s < 4; ++s) {
#pragma unroll
        for (int dh = 0; dh < 2; ++dh) {
            const int k0 = 16 * s + krow, k1 = k0 + 8;
            const s16x4 lo = __builtin_bit_cast(s16x4, __builtin_amdgcn_ds_read_tr16_b64_v4i16((LAS v4i16_t*)(Vs + swz_el(k0, 4 * dh + cb) + sub)));
            const s16x4 hi4 = __builtin_bit_cast(s16x4, __builtin_amdgcn_ds_read_tr16_b64_v4i16((LAS v4i16_t*)(Vs + swz_el(k1, 4 * dh + cb) + sub)));
            const bf16x8 vfr = (bf16x8){lo[0], lo[1], lo[2], lo[3], hi4[0], hi4[1], hi4[2], hi4[3]};
            if (dh == 0) o0 = __builtin_amdgcn_mfma_f32_32x32x16_bf16(pa[s], vfr, o0, 0, 0, 0);
            else         o1 = __builtin_amdgcn_mfma_f32_32x32x16_bf16(pa[s], vfr, o1, 0, 0, 0);
        }
    }
}
__device__ __forceinline__ void attn_online(const LAS bf16_t* Vt, f32x16& x0, f32x16& x1, AttnSt& st, LAS float* wsf, int r32, int hi) {
    float mx = -INFINITY;
#pragma unroll
    for (int r = 0; r < 16; ++r) mx = fmaxf(mx, fmaxf(x0[r], x1[r]));
    mx = fmaxf(mx, __shfl_xor(mx, 32));
    const float mn = fmaxf(st.m, mx), ms = (mn == -INFINITY) ? 0.f : mn;
    const float f = exp2f((st.m - ms) * LOG2E);
    if (hi == 0) wsf[r32] = f;
    float rs = 0.f;
#pragma unroll
    for (int r = 0; r < 16; ++r) { x0[r] = exp2f((x0[r] - ms) * LOG2E); x1[r] = exp2f((x1[r] - ms) * LOG2E); rs += x0[r] + x1[r]; }
    st.l = st.l * f + rs; st.m = mn;
    const LAS float* wr_ = wsf + 4 * hi;
#pragma unroll
    for (int r = 0; r < 16; ++r) { const float fr_ = wr_[(r & 3) + 8 * (r >> 2)]; st.o0[r] *= fr_; st.o1[r] *= fr_; }
    attn_pv(Vt, x0, x1, st.o0, st.o1, r32, hi);
}
__device__ __forceinline__ void attn_scale_rows(f32x16& o0, f32x16& o1, float inv, LAS float* wsf, int r32, int hi) {
    if (hi == 0) wsf[r32] = inv;
    const LAS float* wr_ = wsf + 4 * hi;
#pragma unroll
    for (int r = 0; r < 16; ++r) { const float f = wr_[(r & 3) + 8 * (r >> 2)]; o0[r] *= f; o1[r] *= f; }
}

__device__ UNIT_INLINE void swa_unit(Frame& F, int unit, const bf16_t* U1, bf16_t* Y, const float* sinks) {
    const int qb = unit & 31, g = (unit >> 5) & 1, b = unit >> 6;
    const int r32 = F.lane & 31, hi = F.lane >> 5, hr = F.wave >> 1, qs = F.wave & 1, head = g * 4 + hr;
    const int q0 = qb * 64, tq = q0 + qs * 32 + r32;
    LAS bf16_t* Ks = (LAS bf16_t*)F.lds; LAS bf16_t* Vt = Ks + TILE_EL; LAS bf16_t* Ks1 = Vt + TILE_EL; LAS bf16_t* Vt1 = Ks1 + TILE_EL;
    LAS float* wsf = (LAS float*)(F.lds + 4 * TILE_EL * 2) + F.wave * 32;
    const bf16_t* rowb = U1 + (size_t)(b * SEQ) * UW;
    bf16x8 qr[4];
#pragma unroll
    for (int d0 = 0; d0 < 4; ++d0) qr[d0] = *(const bf16x8*)(rowb + (size_t)tq * UW + UC_SQ + head * 64 + d0 * 16 + hi * 8);
    AttnSt st; attn_init(st);
    {
        const int kt0 = (qb >= 2 ? qb - 2 : 0);
        const bf16_t* kg = rowb + UC_SKV + g * 64; const bf16_t* vg = kg + 128;
        __syncthreads();
        dma_kv(kg + (size_t)(kt0 * 64) * UW, UW, vg + (size_t)(kt0 * 64) * UW, UW, Ks, Vt, F.wave, F.lane);
        __syncthreads();
        int cur = 0;
#pragma unroll 1
        for (int kt = kt0; kt <= qb; ++kt) {
            if (kt < qb) dma_kv(kg + (size_t)((kt + 1) * 64) * UW, UW, vg + (size_t)((kt + 1) * 64) * UW, UW, cur ? Ks : Ks1, cur ? Vt : Vt1, F.wave, F.lane);
            const LAS bf16_t* kc_ = cur ? Ks1 : Ks; const LAS bf16_t* vc_ = cur ? Vt1 : Vt;
            f32x16 x0, x1; attn_scores(kc_, qr, x0, x1, r32, hi);
#pragma unroll
            for (int r = 0; r < 16; ++r) { const int d0 = tq - (kt * 64 + crow(r, hi)), d1 = d0 - 32;
                x0[r] = (d0 >= 0 && d0 < 128) ? x0[r] * 0.125f : -INFINITY; x1[r] = (d1 >= 0 && d1 < 128) ? x1[r] * 0.125f : -INFINITY; }
            attn_online(vc_, x0, x1, st, wsf, r32, hi);
            __syncthreads();
            cur ^= 1;
        }
    }
    const float l = st.l + __shfl_xor(st.l, 32), sk = sinks[head];
    const float mf = fmaxf(st.m, sk), a = exp2f((st.m - mf) * LOG2E), inv = a / (l * a + exp2f((sk - mf) * LOG2E));
    attn_scale_rows(st.o0, st.o1, inv, wsf, r32, hi);
    bf16_t* yb = Y + (size_t)(b * SEQ + q0 + qs * 32) * YW + 3 * 512 + head * 64 + r32;
#pragma unroll
    for (int r = 0; r < 16; ++r) { bf16_t* yp = yb + (size_t)crow(r, hi) * YW; yp[0] = (bf16_t)f2bf(st.o0[r]); yp[32] = (bf16_t)f2bf(st.o1[r]); }
}

constexpr int NSA_K1_OFF = 2 * TILE_EL * 2;
constexpr int NSA_PS_OFF = 4 * TILE_EL * 2;
constexpr int NSA_IMP_OFF = NSA_PS_OFF + 64 * 128 * 4;
constexpr int NSA_SEL_OFF = NSA_IMP_OFF + 64 * 33 * 4;
__device__ __forceinline__ float nsa_gate(const float* gbase, int r, int i) { return sigmoidf_(gbase[((r & 3) + 8 * (r >> 2)) * 32 + i * 8]); }
__device__ UNIT_INLINE void nsa_unit(Frame& F, int unit, const bf16_t* U1, bf16_t* Y, const float* misc, const unsigned char* ws) {
    const int qb = 31 - (unit & 31), g = (unit >> 5) & 1, b = unit >> 6;
    const int r32 = F.lane & 31, hi = F.lane >> 5, hr = F.wave >> 1, qs = F.wave & 1, head = g * 4 + hr;
    const int q0 = qb * 64, ql = qs * 32 + r32, tq = q0 + ql;
    LAS bf16_t* Ks = (LAS bf16_t*)F.lds; LAS bf16_t* Vt = Ks + TILE_EL;
    LAS bf16_t* Ks1 = (LAS bf16_t*)(F.lds + NSA_K1_OFF); LAS bf16_t* Vt1 = Ks1 + TILE_EL;
    LAS unsigned* psum = (LAS unsigned*)(F.lds + NSA_PS_OFF);
    LAS float* impb = (LAS float*)(F.lds + NSA_IMP_OFF);
    LAS unsigned* selm = (LAS unsigned*)(F.lds + NSA_SEL_OFF);
    LAS float* wsf = (LAS float*)(F.lds + NSA_SEL_OFF + 256) + F.wave * 32;
    const bf16_t* rowb = U1 + (size_t)(b * SEQ) * UW;
    const int grow = b * SEQ + q0 + qs * 32;
    const float* gbase = misc + (size_t)(grow + 4 * hi) * 32 + 8 + head;
    bf16x8 qr[4];
#pragma unroll
    for (int d0 = 0; d0 < 4; ++d0) qr[d0] = *(const bf16x8*)(rowb + (size_t)tq * UW + UC_NQ + head * 64 + d0 * 16 + hi * 8);
    f32x16 ya0, ya1;
#pragma unroll
    for (int r = 0; r < 16; ++r) { ya0[r] = 0.f; ya1[r] = 0.f; }
    __syncthreads();
    for (int i = F.tid; i < 64 * 128; i += 512) psum[i] = 0u;
#ifndef NSA_NO_CMP
    {
        const bf16_t* kc = (const bf16_t*)(ws + WS_KC) + (size_t)((b * 2 + g) * 128) * 64;
        const bf16_t* vc = (const bf16_t*)(ws + WS_VC) + (size_t)((b * 2 + g) * 128) * 64;
        dma_kv(kc, 64, vc, 64, Ks, Vt, F.wave, F.lane);
        dma_kv(kc + 64 * 64, 64, vc + 64 * 64, 64, Ks1, Vt1, F.wave, F.lane);
        __syncthreads();
        float m = -INFINITY, l = 0.f;
#pragma unroll 1
        for (int tl = 0; tl < 2; ++tl) {
            f32x16 x0, x1; attn_scores(tl ? Ks1 : Ks, qr, x0, x1, r32, hi);
            float mx = -INFINITY;
#pragma unroll
            for (int r = 0; r < 16; ++r) { const int n0 = tl * 64 + crow(r, hi), n1 = n0 + 32;
                x0[r] = (16 * n0 + 31 <= tq) ? x0[r] * 0.125f : -INFINITY; x1[r] = (16 * n1 + 31 <= tq) ? x1[r] * 0.125f : -INFINITY; mx = fmaxf(mx, fmaxf(x0[r], x1[r])); }
            mx = fmaxf(mx, __shfl_xor(mx, 32));
            const float mn = fmaxf(m, mx), ms = (mn == -INFINITY) ? 0.f : mn;
            float rs = 0.f;
#pragma unroll
            for (int r = 0; r < 16; ++r) rs += exp2f((x0[r] - ms) * LOG2E) + exp2f((x1[r] - ms) * LOG2E);
            l = l * exp2f((m - ms) * LOG2E) + rs; m = mn;
        }
        l += __shfl_xor(l, 32);
        const float inv = l > 0.f ? 1.0f / l : 0.f, ms = (m == -INFINITY) ? 0.f : m;
        f32x16 oc0, oc1;
#pragma unroll
        for (int r = 0; r < 16; ++r) { oc0[r] = 0.f; oc1[r] = 0.f; }
#pragma unroll 1
        for (int tl = 0; tl < 2; ++tl) {
            f32x16 x0, x1; attn_scores(tl ? Ks1 : Ks, qr, x0, x1, r32, hi);
#pragma unroll
            for (int r = 0; r < 16; ++r) { const int n0 = tl * 64 + crow(r, hi), n1 = n0 + 32;
                x0[r] = (16 * n0 + 31 <= tq) ? exp2f((x0[r] * 0.125f - ms) * LOG2E) * inv : 0.f;
                x1[r] = (16 * n1 + 31 <= tq) ? exp2f((x1[r] * 0.125f - ms) * LOG2E) * inv : 0.f;
                atomicAdd((unsigned*)(psum + ql * 128 + n0), (unsigned)(x0[r] * 16777216.0f + 0.5f)); atomicAdd((unsigned*)(psum + ql * 128 + n1), (unsigned)(x1[r] * 16777216.0f + 0.5f)); }
            attn_pv(tl ? Vt1 : Vt, x0, x1, oc0, oc1, r32, hi);
        }
#pragma unroll
        for (int r = 0; r < 16; ++r) { const float gt = nsa_gate(gbase, r, 0); ya0[r] += gt * oc0[r]; ya1[r] += gt * oc1[r]; }
    }
#endif
    __syncthreads();
#ifndef NSA_NO_TOPK
    if (qb <= 7) { if (F.tid < 64) selm[F.tid] = (2u << qb) - 1u; }
    else {
        const int q = F.tid & 63, jg = F.tid >> 6;
#pragma unroll
        for (int jj = 0; jj < 4; ++jj) { const int j = jg * 4 + jj; unsigned sacc = 0u;
#pragma unroll
            for (int d = -1; d <= 3; ++d) { const int n = 4 * j + d; if (n >= 0 && n < 127) sacc += psum[q * 128 + n]; }
            impb[q * 33 + j] = (float)sacc; }
        if (jg == 0) selm[q] = 1u | (1u << qb);
        __syncthreads();
        unsigned bits = 0u;
#pragma unroll 1
        for (int jj = 0; jj < 4; ++jj) { const int j = jg * 4 + jj;
            if (j >= 1 && j < qb) { const float vj = impb[q * 33 + j]; int rank = 0;
#pragma unroll 1
                for (int i2 = 1; i2 < qb; ++i2) { const float vi = impb[q * 33 + i2]; rank += (vi > vj || (vi == vj && i2 < j)) ? 1 : 0; }
                if (rank < 6) bits |= 1u << j; } }
        if (bits) atomicOr((unsigned*)(selm + q), bits);
    }
#endif
    __syncthreads();
    unsigned uni;
    { unsigned v = selm[F.lane];
#pragma unroll
      for (int o = 1; o < 64; o <<= 1) v |= __shfl_xor(v, o);
      uni = __builtin_amdgcn_readfirstlane(v); }
    const unsigned mysel = selm[ql];
#pragma unroll 1
    for (int br = 0; br < 2; ++br) {
        const unsigned lowm = (qb >= 8) ? ~((1u << (qb - 8)) - 1u) : 0xffffffffu;
        const unsigned tmask = (br == 0) ? uni : (((2u << qb) - 1u) & lowm);
        const unsigned qsel = (br == 0) ? mysel : 0xffffffffu;
        const int wlim = (br == 0) ? (1 << 30) : 512;
        const int kcol = UC_NKV + (2 + 2 * br) * 128 + g * 64;
        AttnSt st; attn_init(st);
        {
            const bf16_t* kg = rowb + kcol; const bf16_t* vg = kg + 128;
            unsigned rem = tmask;
            int j = __builtin_ctz(rem); rem &= rem - 1u;
            __syncthreads();
            dma_kv(kg + (size_t)(j * 64) * UW, UW, vg + (size_t)(j * 64) * UW, UW, Ks, Vt, F.wave, F.lane);
            __syncthreads();
            int cur = 0;
#pragma unroll 1
            for (;;) {
                const int jn = rem ? __builtin_ctz(rem) : -1; rem &= rem - 1u;
                if (jn >= 0) dma_kv(kg + (size_t)(jn * 64) * UW, UW, vg + (size_t)(jn * 64) * UW, UW, cur ? Ks : Ks1, cur ? Vt : Vt1, F.wave, F.lane);
                const LAS bf16_t* kc_ = cur ? Ks1 : Ks; const LAS bf16_t* vc_ = cur ? Vt1 : Vt;
                f32x16 x0, x1; attn_scores(kc_, qr, x0, x1, r32, hi);
                const bool sel = (qsel >> j) & 1u;
#pragma unroll
                for (int r = 0; r < 16; ++r) { const int d0 = tq - (j * 64 + crow(r, hi)), d1 = d0 - 32;
                    x0[r] = (sel && d0 >= 0 && d0 < wlim) ? x0[r] * 0.125f : -INFINITY; x1[r] = (sel && d1 >= 0 && d1 < wlim) ? x1[r] * 0.125f : -INFINITY; }
                attn_online(vc_, x0, x1, st, wsf, r32, hi);
                __syncthreads();
                if (jn < 0) break;
                j = jn; cur ^= 1;
            }
        }
        const float l = st.l + __shfl_xor(st.l, 32), inv = l > 0.f ? 1.0f / l : 0.f;
        attn_scale_rows(st.o0, st.o1, inv, wsf, r32, hi);
#pragma unroll
        for (int r = 0; r < 16; ++r) { const float gt = nsa_gate(gbase, r, 1 + br); ya0[r] += gt * st.o0[r]; ya1[r] += gt * st.o1[r]; }
    }
    bf16_t* yb = Y + (size_t)grow * YW + 1 * 512 + head * 64 + r32;
#pragma unroll
    for (int r = 0; r < 16; ++r) { bf16_t* yp = yb + (size_t)crow(r, hi) * YW; yp[0] = (bf16_t)f2bf(ya0[r]); yp[32] = (bf16_t)f2bf(ya1[r]); }
}

__device__ __forceinline__ void ld4x16_sys(u32x4& a, u32x4& b, u32x4& c, u32x4& d, const void* pa, const void* pb, const void* pc, const void* pd) {
    asm volatile("global_load_dwordx4 %0, %4, off sc0 sc1\n\tglobal_load_dwordx4 %1, %5, off sc0 sc1\n\tglobal_load_dwordx4 %2, %6, off sc0 sc1\n\tglobal_load_dwordx4 %3, %7, off sc0 sc1\n\ts_waitcnt vmcnt(0)"
                 : "=&v"(a), "=&v"(b), "=&v"(c), "=&v"(d) : "v"(pa), "v"(pb), "v"(pc), "v"(pd) : "memory");
}
constexpr int RW_CT = 16, RW_NC = SEQ / RW_CT;
constexpr int SB_BT = 0, SB_RT = 2304, SB_VT = 4608, SB_MT = 6656  , SB_CHT = 8704, SB_KHT = 10752, SB_G16 = 12800,
              SB_G = 13056  , SB_BS = 15104, SB_SIZE = 15360;
constexpr int PH_SB = 0, PH_V = SB_SIZE  , PH_R = PH_V + 4096, PH_K = PH_R + 4096, PH_DEC = PH_K + 4096, PH_NB = PH_DEC + 4096, PH_CC = PH_NB + 4096,
              PH_WDH = PH_CC + 4096, PH_ADH = PH_WDH + 16 * 72 * 2, PH_GDH = PH_ADH + 16 * 72 * 2,
              PH_CH = PH_WDH  , PH_KH = PH_CH + 2304, PH_ACB = PH_KH + 2304,
              PH_RAW = PH_GDH + 16 * 136 * 2, RAW_R = 0, RAW_K = 3072, RAW_V = 6144, RAW_L = 9216, RAW_SIZE = 18432, PH_SIZE = PH_RAW + RAW_SIZE,
              RP_CONST = 2 * PH_SIZE  , RP_MU = RP_CONST + 5 * 256  , RP_END = RP_MU + 448 * 4;
static_assert(RP_END <= LDS_USER && PH_RAW % 16 == 0 && PH_SIZE % 16 == 0 && PH_WDH % 16 == 0 && PH_ACB + 1024 <= PH_RAW, "rwkv prep lds");
constexpr int RW_JOBS = NB * 8 * (RW_NC / 2);
template <int CTRL> __device__ __forceinline__ float dppf(float x) { return __int_as_float(__builtin_amdgcn_update_dpp(0, __float_as_int(x), CTRL, 0xf, 0xf, false)); }
__device__ __forceinline__ float reduce8(float x) { x += dppf<0xB1>(x); x += dppf<0x4E>(x); x += dppf<0x141>(x); return x; }
__device__ __forceinline__ float reduce16(float x) { x = reduce8(x); x += dppf<0x140>(x); return x; }
__device__ __forceinline__ float fast_tanh(float x) { const float e = __expf(2.0f * x); return 1.0f - 2.0f / (e + 1.0f); }
#define RW_BAR() do { asm volatile("s_waitcnt lgkmcnt(0)" ::: "memory"); __builtin_amdgcn_s_barrier(); asm volatile("" ::: "memory"); } while (0)
typedef float f32x2_t_ __attribute__((ext_vector_type(2))); typedef __bf16 bf16x2_t_ __attribute__((ext_vector_type(2)));
__device__ __forceinline__ unsigned cvtpk_c(float lo, float hi) { const f32x2_t_ v = {lo, hi}; const bf16x2_t_ b = __builtin_convertvector(v, bf16x2_t_); return __builtin_bit_cast(unsigned, b); }
__device__ __forceinline__ u32x2 pack4c(f32x4 v) { u32x2 w; w.x = cvtpk_c(v[0], v[1]); w.y = cvtpk_c(v[2], v[3]); return w; }
__device__ __forceinline__ bf16x8 mk8(u32x2 lo, u32x2 hi) { return __builtin_bit_cast(bf16x8, (u32x4){lo.x, lo.y, hi.x, hi.y}); }

__device__ UNIT_INLINE void rwkv_prep(Frame& F, int L, KArgs KA, const bf16_t* U1, unsigned char* rec) {
    LAS unsigned char* lds = F.lds;
    const int half = F.wave >> 2, ww = F.wave & 3, wtid = F.tid & 255, r16 = F.lane & 15, kg = F.lane >> 4;
    const int wti = wtid >> 4, wcg = wtid & 15;
    LAS unsigned char* hb = lds + half * PH_SIZE;
    const int JPB = (RW_JOBS + F.G - 1) / F.G, j0 = F.bid * JPB, j1 = (j0 + JPB < RW_JOBS) ? j0 + JPB : RW_JOBS;
    int cur_bh = -1; float w0n = 0.f, a0n = 0.f;
    u32x4 Bq[8];
#pragma unroll
    for (int q = 0; q < 8; ++q) Bq[q] = (u32x4){0u, 0u, 0u, 0u};
#define RP_DMA(jj) do { const int bh_ = (jj) >> 6, h_ = bh_ & 7; const int t0_ = (2 * ((jj) & 63) + half) * RW_CT - 1; const bf16_t* rowb_ = U1 + (size_t)((bh_ >> 3) * SEQ) * UW + UC_RW; \
        _Pragma("unroll") for (int q_ = 0; q_ < 5; ++q_) { const int ix_ = ww + 4 * q_; if (ix_ < 18) { \
            int tok_, col_, dst_; \
            if (ix_ < 9) { const int kind_ = ix_ / 3, p_ = ix_ % 3; tok_ = 8 * p_ + (F.lane >> 3); col_ = kind_ * 512 + h_ * 64 + (F.lane & 7) * 8; dst_ = kind_ * 3072 + p_ * 1024; } \
            else { const int p_ = ix_ - 9; tok_ = 2 * p_ + (F.lane >> 5); col_ = 1536 + (F.lane & 31) * 8; dst_ = RAW_L + p_ * 1024; } \
            int t_ = t0_ + (tok_ > 16 ? 16 : tok_); t_ = t_ < 0 ? 0 : t_; \
            __builtin_amdgcn_global_load_lds((const unsigned*)(rowb_ + (size_t)t_ * UW + col_), (LAS unsigned*)(hb + PH_RAW + dst_), 16, 0, 0); } } } while (0)
    __syncthreads();
    if (j0 < j1) RP_DMA(j0);
#pragma unroll 1
    for (int j = j0; j < j1; ++j) {
        const int bh = j >> 6, h = bh & 7, ck = 2 * (j & 63) + half;
        if (bh != cur_bh) {
            __syncthreads();
            const int cn = h * 64 + 16 * ww + r16; w0n = IN_F(15)[L * 512 + cn]; a0n = IN_F(17)[L * 512 + cn];
            if (F.tid < 320) { const int v = F.tid >> 6; ((LAS float*)(lds + RP_CONST))[F.tid] = IN_F(20 + v)[L * 512 + h * 64 + (F.tid & 63)]; }
            if (F.tid < 448) { const int i = F.tid; const int col = i < 64 ? h * 64 + i : i < 128 ? 512 + h * 64 + (i - 64) : i < 192 ? 1024 + h * 64 + (i - 128) : 1536 + (i - 192);
                ((LAS float*)(lds + RP_MU))[i] = IN_F(14)[(size_t)L * 1792 + col]; }
            const u32x4* lwf = (const u32x4*)(KA->ws + WS_LW) + ((size_t)((L * 8 + h) * 4 + ww) * 8) * 64 + F.lane;
#pragma unroll
            for (int q = 0; q < 8; ++q) Bq[q] = lwf[q * 64];
            cur_bh = bh;
        }
        if (j == j0) asm volatile("s_waitcnt vmcnt(0)" ::: "memory");
        else asm volatile("s_waitcnt vmcnt(4)" ::: "memory");
        RW_BAR();
        {
            const LAS unsigned char* raw = hb + PH_RAW;
            const bool first = (ck == 0);
#pragma unroll
            for (int n = 0; n < 4; ++n) {
                const int i = wtid + 256 * n;
                if (i < 896) {
                    const int kind = i < 768 ? i >> 7 : 5;
                    const int idx = i - (kind < 5 ? kind * 128 : 640);
                    const int tok = kind < 5 ? idx >> 3 : idx >> 4, piece = kind < 5 ? idx & 7 : idx & 15;
                    int so, mo;
                    if (kind < 3) { so = kind * 3072 + (tok + 1) * 128 + piece * 16; mo = kind * 64 + piece * 8; }
                    else { const int lp = (kind == 3 ? 0 : kind == 4 ? 8 : 16) + piece; so = RAW_L + (tok + 1) * 512 + lp * 16; mo = 192 + lp * 8; }
                    const u32x4 rc = *(const LAS u32x4*)(raw + so);
                    u32x4 rv = *(const LAS u32x4*)(raw + so - (kind < 3 ? 128 : 512));
                    if (first && tok == 0) rv = (u32x4){0u, 0u, 0u, 0u};
                    const f32x4 m0 = *(const LAS f32x4*)((const LAS float*)(lds + RP_MU) + mo), m1 = *(const LAS f32x4*)((const LAS float*)(lds + RP_MU) + mo + 4);
                    float y[8];
#pragma unroll
                    for (int jj = 0; jj < 4; ++jj) {
                        const float x0 = bf2f(rc[jj] & 0xffffu), x1 = bf2f(rc[jj] >> 16), p0 = bf2f(rv[jj] & 0xffffu), p1 = bf2f(rv[jj] >> 16);
                        y[2 * jj] = x0 + (p0 - x0) * (jj < 2 ? m0[2 * jj] : m1[2 * jj - 4]); y[2 * jj + 1] = x1 + (p1 - x1) * (jj < 2 ? m0[2 * jj + 1] : m1[2 * jj - 3]);
                    }
                    if (kind < 3) {
                        LAS float* dst = (LAS float*)(hb + (kind == 0 ? PH_R : kind == 1 ? PH_K : PH_V)) + tok * 64 + piece * 8;
                        *(LAS f32x4*)dst = (f32x4){y[0], y[1], y[2], y[3]}; *(LAS f32x4*)(dst + 4) = (f32x4){y[4], y[5], y[6], y[7]};
                    } else {
                        LAS bf16_t* dst;
                        if (kind == 3) { dst = (LAS bf16_t*)(hb + PH_WDH) + tok * 72 + piece * 8;
#pragma unroll
                            for (int jj = 0; jj < 8; ++jj) y[jj] = fast_tanh(y[jj]); }
                        else if (kind == 4) dst = (LAS bf16_t*)(hb + PH_ADH) + tok * 72 + piece * 8;
                        else { dst = (LAS bf16_t*)(hb + PH_GDH) + tok * 136 + piece * 8;
#pragma unroll
                            for (int jj = 0; jj < 8; ++jj) y[jj] = sigmoidf_(y[jj]); }
                        u32x4 pk; pk.x = cvt_pk(y[0], y[1]); pk.y = cvt_pk(y[2], y[3]); pk.z = cvt_pk(y[4], y[5]); pk.w = cvt_pk(y[6], y[7]);
                        *(LAS u32x4*)dst = pk;
                    }
                }
            }
        }
        RW_BAR();
        if (j + 1 < j1) RP_DMA(j + 1);
        {
            LAS float* sDEC = (LAS float*)(hb + PH_DEC); LAS float* sCC = (LAS float*)(hb + PH_CC); LAS bf16_t* sG = (LAS bf16_t*)(hb + PH_SB + SB_G);
            const LAS bf16_t* sWDh = (const LAS bf16_t*)(hb + PH_WDH); const LAS bf16_t* sADh = (const LAS bf16_t*)(hb + PH_ADH); const LAS bf16_t* sGDh = (const LAS bf16_t*)(hb + PH_GDH);
            f32x4 aw = (f32x4){0.f, 0.f, 0.f, 0.f}, aa = aw, ag = aw;
#pragma unroll
            for (int ks = 0; ks < 2; ++ks) {
                const bf16x8 xw = *(const LAS bf16x8*)(sWDh + r16 * 72 + 32 * ks + 8 * kg), xa = *(const LAS bf16x8*)(sADh + r16 * 72 + 32 * ks + 8 * kg);
                aw = __builtin_amdgcn_mfma_f32_16x16x32_bf16(xw, __builtin_bit_cast(bf16x8, Bq[ks]), aw, 0, 0, 0); aa = __builtin_amdgcn_mfma_f32_16x16x32_bf16(xa, __builtin_bit_cast(bf16x8, Bq[2 + ks]), aa, 0, 0, 0);
            }
#pragma unroll
            for (int ks = 0; ks < 4; ++ks) { const bf16x8 xg = *(const LAS bf16x8*)(sGDh + r16 * 136 + 32 * ks + 8 * kg); ag = __builtin_amdgcn_mfma_f32_16x16x32_bf16(xg, __builtin_bit_cast(bf16x8, Bq[4 + ks]), ag, 0, 0, 0); }
#pragma unroll
            for (int r = 0; r < 4; ++r) { const int o = (4 * kg + r) * 64 + 16 * ww + r16; sDEC[o] = aw[r] + w0n; sCC[o] = aa[r] + a0n; sG[o] = (bf16_t)f2bf(ag[r]); }
        }
        RW_BAR();
        {
            const int o = wti * 64 + wcg * 4;
            LAS float* pDEC = (LAS float*)(hb + PH_DEC) + o; LAS float* pNB = (LAS float*)(hb + PH_NB) + o; LAS float* pCC = (LAS float*)(hb + PH_CC) + o;
            LAS float* pK = (LAS float*)(hb + PH_K) + o; const LAS float* pR = (const LAS float*)(hb + PH_R) + o;
            const LAS float* cst = (const LAS float*)(lds + RP_CONST) + wcg * 4;
            const f32x4 wp = *(const LAS f32x4*)pDEC, ap = *(const LAS f32x4*)pCC, kr = *(const LAS f32x4*)pK, rr = *(const LAS f32x4*)pR;
            const f32x4 ckk = *(const LAS f32x4*)cst, cka = *(const LAS f32x4*)(cst + 64), crk = *(const LAS f32x4*)(cst + 128);
            f32x4 dec, a, kk, k2;
#pragma unroll
            for (int jj = 0; jj < 4; ++jj) {
                const float sp = (-wp[jj] > 20.f) ? -wp[jj] : __logf(1.0f + __expf(-wp[jj]));
                dec[jj] = __expf(-__expf(-sp - 0.5f)); a[jj] = sigmoidf_(ap[jj]);
            }
            kk = kr * ckk; k2 = kr * ((a - 1.0f) * cka + 1.0f);
            const f32x4 bb = rr * k2 * crk;
            const float sq = reduce16((kk[0] * kk[0] + kk[1] * kk[1]) + (kk[2] * kk[2] + kk[3] * kk[3]));
            const float bsum = reduce16((bb[0] + bb[1]) + (bb[2] + bb[3]));
            const float rn = 1.0f / fmaxf(sqrtf(sq), 1e-12f);
            const f32x4 kn = kk * rn;
            *(LAS f32x4*)pDEC = dec; *(LAS f32x4*)pNB = -kn; *(LAS f32x4*)pCC = kn * a; *(LAS f32x4*)pK = k2;
            if (wcg == 0) ((LAS float*)(hb + PH_SB + SB_BS))[wti] = bsum;
        }
        RW_BAR();
        {
            const int kch = F.lane;
            const LAS float* pD = (const LAS float*)(hb + PH_DEC) + kch;
            if (ww == 0) {
                const LAS float* pN = (const LAS float*)(hb + PH_NB) + kch; LAS bf16_t* pO = (LAS bf16_t*)(hb + PH_SB + SB_BT) + kch; float g = 1.0f;
#pragma unroll
                for (int t = 0; t < 16; ++t) { pO[t * 72] = (bf16_t)f2bf(g * pN[t * 64]); g *= pD[t * 64]; }
                ((LAS float*)(hb + PH_SB + SB_G16))[kch] = g;
            } else if (ww == 1) {
                const LAS float* pRr = (const LAS float*)(hb + PH_R) + kch; LAS bf16_t* pO = (LAS bf16_t*)(hb + PH_SB + SB_RT) + kch; float g = 1.0f;
                const LAS float* pV = (const LAS float*)(hb + PH_V) + kch; unsigned vt[8];
#pragma unroll
                for (int t = 0; t < 16; ++t) { g *= pD[t * 64]; pO[t * 72] = (bf16_t)f2bf(g * pRr[t * 64]); }
#pragma unroll
                for (int t = 0; t < 8; ++t) vt[t] = cvt_pk(pV[(2 * t) * 64], pV[(2 * t + 1) * 64]);
                LAS u32x4* pVT = (LAS u32x4*)((LAS bf16_t*)(hb + PH_SB + SB_VT) + kch * 16);
                pVT[0] = (u32x4){vt[0], vt[1], vt[2], vt[3]}; pVT[1] = (u32x4){vt[4], vt[5], vt[6], vt[7]};
            } else {
                const LAS float* pS = (const LAS float*)(hb + (ww == 2 ? PH_CC : PH_K)) + kch;
                LAS bf16_t* pRow = (LAS bf16_t*)(hb + (ww == 2 ? PH_CH : PH_KH)) + kch; float g = 1.0f; float q[16];
#pragma unroll
                for (int t = 0; t < 16; ++t) { g *= pD[t * 64]; q[t] = pS[t * 64] * __builtin_amdgcn_rcpf(g); pRow[t * 72] = (bf16_t)f2bf(q[t]); }
                LAS u32x4* pT = (LAS u32x4*)((LAS bf16_t*)(hb + PH_SB + (ww == 2 ? SB_CHT : SB_KHT)) + kch * 16);
                pT[0] = (u32x4){cvt_pk(q[0], q[1]), cvt_pk(q[2], q[3]), cvt_pk(q[4], q[5]), cvt_pk(q[6], q[7])};
                pT[1] = (u32x4){cvt_pk(q[8], q[9]), cvt_pk(q[10], q[11]), cvt_pk(q[12], q[13]), cvt_pk(q[14], q[15])};
            }
        }
        RW_BAR();
        {
            const LAS bf16_t* Am = (const LAS bf16_t*)(hb + ((ww & 1) ? PH_KH : PH_CH)) + r16 * 72 + 8 * kg;
            const LAS bf16_t* Bm = (const LAS bf16_t*)(hb + PH_SB + (ww < 2 ? SB_BT : SB_RT)) + r16 * 72 + 8 * kg;
            f32x4 gm = (f32x4){0.f, 0.f, 0.f, 0.f};
            gm = __builtin_amdgcn_mfma_f32_16x16x32_bf16(*(const LAS bf16x8*)Am, *(const LAS bf16x8*)Bm, gm, 0, 0, 0);
            gm = __builtin_amdgcn_mfma_f32_16x16x32_bf16(*(const LAS bf16x8*)(Am + 32), *(const LAS bf16x8*)(Bm + 32), gm, 0, 0, 0);
#pragma unroll
            for (int r = 0; r < 4; ++r) { const int i = 4 * kg + r; const bool keep = (ww < 2) ? (i < r16) : (i <= r16); gm[r] = keep ? gm[r] : 0.f; }
            if (ww == 0) {
                LAS float* acbT = (LAS float*)(hb + PH_ACB);
                *(LAS f32x4*)(acbT + r16 * 16 + 4 * kg) = gm;
                asm volatile("s_waitcnt lgkmcnt(0)" ::: "memory");
                const int jc = F.lane & 15;
                float inv[16];
#pragma unroll
                for (int i = 0; i < 16; ++i) inv[i] = (i == jc) ? 1.0f : 0.0f;
#pragma unroll
                for (int l = 15; l >= 1; --l) {
#pragma unroll
                    for (int q = 0; q < (l + 3) / 4; ++q) {
                        const f32x4 c = *(const LAS f32x4*)(acbT + l * 16 + 4 * q);
#pragma unroll
                        for (int e = 0; e < 4; ++e) if (4 * q + e < l) inv[4 * q + e] += c[e] * inv[l];
                    }
                }
                if (F.lane < 16) {
                    LAS u32x4* pI = (LAS u32x4*)((LAS bf16_t*)(hb + PH_SB + SB_MT) + 256 + jc * 16);
                    pI[0] = (u32x4){cvt_pk(inv[0], inv[1]), cvt_pk(inv[2], inv[3]), cvt_pk(inv[4], inv[5]), cvt_pk(inv[6], inv[7])};
                    pI[1] = (u32x4){cvt_pk(inv[8], inv[9]), cvt_pk(inv[10], inv[11]), cvt_pk(inv[12], inv[13]), cvt_pk(inv[14], inv[15])};
                }
            } else {
                const int slot = (ww == 1) ? 0 : ww;
                *(LAS u32x2*)((LAS bf16_t*)(hb + PH_SB + SB_MT) + slot * 256 + r16 * 16 + 4 * kg) = pack4c(gm);
            }
        }
        RW_BAR();
        {
            unsigned char* g = rec + ((size_t)bh * RW_NC + ck) * SB_SIZE;
#pragma unroll
            for (int n = 0; n < 4; ++n) { int i = wtid + 256 * n; i = i < SB_SIZE / 16 ? i : SB_SIZE / 16 - 1; *(u32x4*)(g + i * 16) = *(const LAS u32x4*)(hb + PH_SB + i * 16); }
        }
    }
#undef RP_DMA
}

__device__ __forceinline__ void rw_post(const LAS float* lnw, const LAS unsigned char* sb, const LAS float* out, bf16_t* yrow0, int ti, int cg) {
    const int o = ti * 64 + cg * 4;
    const f32x4 x = *(const LAS f32x4*)(out + o);
    const LAS bf16_t* vt = (const LAS bf16_t*)(sb + SB_VT) + (cg * 4) * 16 + ti;
    const f32x4 v = (f32x4){bf2f(vt[0]), bf2f(vt[16]), bf2f(vt[32]), bf2f(vt[48])};
    const u32x2 gq = *(const LAS u32x2*)((const LAS bf16_t*)(sb + SB_G) + o);
    const f32x4 lw = *(const LAS f32x4*)(lnw + cg * 4), lb = *(const LAS f32x4*)(lnw + 64 + cg * 4);
    const float bs = ((const LAS float*)(sb + SB_BS))[ti];
    const float mean = reduce16((x[0] + x[1]) + (x[2] + x[3])) * (1.0f / 64.0f);
    const f32x4 d = x - mean;
    const float rstd = rsqrtf(reduce16((d[0] * d[0] + d[1] * d[1]) + (d[2] * d[2] + d[3] * d[3])) * (1.0f / 64.0f) + 64e-5f);
    const f32x4 g = unpack4(gq);
    const f32x4 y = (d * rstd * lw + lb + v * bs) * g;
    *(u32x2*)(yrow0 + (size_t)ti * YW + cg * 4) = pack4(y);
}
constexpr int SC_NR = 6, SC_PD = 4, SC_OUT = SC_NR * SB_SIZE, SC_LN = SC_OUT + 2 * 4096, SC_END = SC_LN + 512;
static_assert(SC_END <= LDS_USER && SB_SIZE % 1024 == 0, "rwkv scan lds");
__device__ UNIT_INLINE void rwkv_scan(Frame& F, int unit, int L, KArgs KA, const unsigned char* rec, bf16_t* Y) {
    const int h = unit & 7, b = unit >> 3;
    const bool scanner = F.wave < 4;
    LAS unsigned char* lds = F.lds;
    bf16_t* ybase = Y + (size_t)(b * SEQ) * YW + 2 * 512 + h * 64;
    const unsigned char* rbase = rec + (size_t)unit * RW_NC * SB_SIZE + F.lane * 16;
    const int ww = F.wave & 3, wtid = F.tid & 255, r16 = F.lane & 15, kg = F.lane >> 4;
    const int wti = wtid >> 4, wcg = wtid & 15;
    f32x4 X0 = (f32x4){0.f, 0.f, 0.f, 0.f}, X1 = X0, X2 = X0, X3 = X0;
    __syncthreads();
    if (F.tid < 128) ((LAS float*)(lds + SC_LN))[F.tid] = IN_F(23 + (F.tid >> 6))[L * 512 + h * 64 + (F.tid & 63)];
#define SC_DMA(cc) do { const unsigned char* src_ = rbase + (size_t)(cc) * SB_SIZE; LAS unsigned char* dst_ = lds + ((cc) % SC_NR) * SB_SIZE; \
        _Pragma("unroll") for (int q_ = 0; q_ < 4; ++q_) { int pc_ = ww * 4 + q_; pc_ = pc_ > 14 ? 14 : pc_; \
            __builtin_amdgcn_global_load_lds((const unsigned*)(src_ + pc_ * 1024), (LAS unsigned*)(dst_ + pc_ * 1024), 16, 0, 0); } } while (0)
    if (!scanner) {
#pragma unroll
        for (int c = 0; c < SC_PD; ++c) SC_DMA(c);
    }
    asm volatile("s_waitcnt vmcnt(0)" ::: "memory");
    __syncthreads();
#pragma unroll 1
    for (int ck = 0; ck <= RW_NC; ++ck) {
        const LAS unsigned char* sbc = lds + (ck % SC_NR) * SB_SIZE;
        LAS float* ocur = (LAS float*)(lds + SC_OUT + (ck & 1) * 4096); const LAS float* oprv = (const LAS float*)(lds + SC_OUT + ((ck + 1) & 1) * 4096);
        if (scanner) {
            if (ck < RW_NC) {
            const LAS bf16_t* BT = (const LAS bf16_t*)(sbc + SB_BT) + r16 * 72 + 4 * kg; const LAS bf16_t* RT = (const LAS bf16_t*)(sbc + SB_RT) + r16 * 72 + 4 * kg;
            const LAS bf16_t* MT = (const LAS bf16_t*)(sbc + SB_MT) + r16 * 16 + 4 * kg;
            const u32x2 vt = *(const LAS u32x2*)((const LAS bf16_t*)(sbc + SB_VT) + (16 * ww + r16) * 16 + 4 * kg);
            const u32x2 z2 = (u32x2){0u, 0u};
            const bf16x8 bx0 = mk8(pack4c(X0), pack4c(X1)), bx1 = mk8(pack4c(X2), pack4c(X3));
            f32x4 U = (f32x4){0.f, 0.f, 0.f, 0.f}, O = U;
            U = __builtin_amdgcn_mfma_f32_16x16x32_bf16(mk8(*(const LAS u32x2*)BT, *(const LAS u32x2*)(BT + 16)), bx0, U, 0, 0, 0);
            O = __builtin_amdgcn_mfma_f32_16x16x32_bf16(mk8(*(const LAS u32x2*)RT, *(const LAS u32x2*)(RT + 16)), bx0, O, 0, 0, 0);
            U = __builtin_amdgcn_mfma_f32_16x16x32_bf16(mk8(*(const LAS u32x2*)(BT + 32), *(const LAS u32x2*)(BT + 48)), bx1, U, 0, 0, 0);
            O = __builtin_amdgcn_mfma_f32_16x16x32_bf16(mk8(*(const LAS u32x2*)(RT + 32), *(const LAS u32x2*)(RT + 48)), bx1, O, 0, 0, 0);
            U = __builtin_amdgcn_mfma_f32_16x16x32_bf16(mk8(z2, *(const LAS u32x2*)MT), mk8(z2, vt), U, 0, 0, 0);
            f32x4 SA = __builtin_amdgcn_mfma_f32_16x16x32_bf16(mk8(*(const LAS u32x2*)(MT + 256), z2), mk8(pack4c(U), vt), (f32x4){0.f, 0.f, 0.f, 0.f}, 0, 0, 0);
            const bf16x8 b3 = mk8(pack4c(SA), vt);
            O = __builtin_amdgcn_mfma_f32_16x16x32_bf16(mk8(*(const LAS u32x2*)(MT + 512), *(const LAS u32x2*)(MT + 768)), b3, O, 0, 0, 0);
#pragma unroll
            for (int r = 0; r < 4; ++r) ocur[(4 * kg + r) * 64 + 16 * ww + r16] = O[r];
            const LAS bf16_t* CT = (const LAS bf16_t*)(sbc + SB_CHT) + r16 * 16 + 4 * kg; const LAS bf16_t* KT = (const LAS bf16_t*)(sbc + SB_KHT) + r16 * 16 + 4 * kg;
            const LAS float* g16 = (const LAS float*)(sbc + SB_G16) + 4 * kg;
            X0 = __builtin_amdgcn_mfma_f32_16x16x32_bf16(mk8(*(const LAS u32x2*)CT, *(const LAS u32x2*)KT), b3, X0, 0, 0, 0) * *(const LAS f32x4*)g16;
            X1 = __builtin_amdgcn_mfma_f32_16x16x32_bf16(mk8(*(const LAS u32x2*)(CT + 256), *(const LAS u32x2*)(KT + 256)), b3, X1, 0, 0, 0) * *(const LAS f32x4*)(g16 + 16);
            X2 = __builtin_amdgcn_mfma_f32_16x16x32_bf16(mk8(*(const LAS u32x2*)(CT + 512), *(const LAS u32x2*)(KT + 512)), b3, X2, 0, 0, 0) * *(const LAS f32x4*)(g16 + 32);
            X3 = __builtin_amdgcn_mfma_f32_16x16x32_bf16(mk8(*(const LAS u32x2*)(CT + 768), *(const LAS u32x2*)(KT + 768)), b3, X3, 0, 0, 0) * *(const LAS f32x4*)(g16 + 48);
            }
        } else {
            if (ck >= 1) rw_post((const LAS float*)(lds + SC_LN), lds + ((ck - 1) % SC_NR) * SB_SIZE, oprv, ybase + (size_t)((ck - 1) * RW_CT) * YW, wti, wcg);
            if (ck + SC_PD < RW_NC) { SC_DMA(ck + SC_PD); asm volatile("s_waitcnt vmcnt(12)" ::: "memory"); }
            else asm volatile("s_waitcnt vmcnt(0)" ::: "memory");
        }
        RW_BAR();
    }
#undef SC_DMA
}

constexpr int SL = 136;
constexpr int SP_CS = 0, SP_BS = SP_CS + 128 * SL * 2, SP_BT = SP_BS + 128 * SL * 2, SP_XT = SP_BT + 128 * SL * 2, SP_DT = SP_XT + 128 * SL * 2,
              SP_AC = SP_DT + 2048, SP_SC = SP_AC + 2048, SP_END = SP_SC + 2048;
static_assert(SP_END <= LDS_USER, "ssd prep lds");
__device__ __forceinline__ float silu_fast(float x) { return x * __builtin_amdgcn_rcpf(1.0f + __expf(-x)); }
__device__ UNIT_INLINE void ssd_prep(Frame& F, int job, int L, KArgs KA, const bf16_t* U1, bf16_t* Y, const float* misc, unsigned char* ws) {
    const int c = job & 15, g = (job >> 4) & 1, b = job >> 5, t0 = c * 128;
    LAS bf16_t* Cs = (LAS bf16_t*)(F.lds + SP_CS); LAS bf16_t* Bs = (LAS bf16_t*)(F.lds + SP_BS); LAS bf16_t* Bt = (LAS bf16_t*)(F.lds + SP_BT); LAS bf16_t* Xt = (LAS bf16_t*)(F.lds + SP_XT);
    LAS float* dts = (LAS float*)(F.lds + SP_DT); LAS float* acs = (LAS float*)(F.lds + SP_AC); LAS float* scl = (LAS float*)(F.lds + SP_SC);
    const float* cw = IN_F(5) + (size_t)L * 4 * 1024; const float* cbias = IN_F(6) + (size_t)L * 1024;
    const int r16 = F.lane & 15, kg = F.lane >> 4, w = F.wave;
    const bf16_t* rowb = U1 + (size_t)(b * SEQ) * UW;
    __syncthreads();
    if (w < 4) {
        const int h = 4 * g + w, l0 = 2 * F.lane;
        const float dtb = IN_F(7)[L * 8 + h], Ah = -expf(IN_F(8)[L * 8 + h]);
        const float d0 = softplusf_(misc[(size_t)(b * SEQ + t0 + l0) * 32 + h] + dtb), d1 = softplusf_(misc[(size_t)(b * SEQ + t0 + l0 + 1) * 32 + h] + dtb);
        const float a0 = d0 * Ah, a1 = d1 * Ah;
        float s = a0 + a1;
#pragma unroll
        for (int o = 1; o < 64; o <<= 1) { const float v = __shfl_up(s, o); if (F.lane >= o) s += v; }
        const float e1 = s, e0 = s - a1, aend = __shfl(s, 63);
        dts[w * 128 + l0] = d0; dts[w * 128 + l0 + 1] = d1; acs[w * 128 + l0] = e0; acs[w * 128 + l0 + 1] = e1;
        scl[w * 128 + l0] = d0 * __expf(aend - e0); scl[w * 128 + l0 + 1] = d1 * __expf(aend - e1);
        *(f32x2*)((float*)(ws + WS_SSDA) + (size_t)(b * 8 + h) * SEQ + t0 + l0) = (f32x2){e0, e1};
    }
    auto stage = [&](const int q) {
        const int ck16 = F.tid & 15, run = F.tid >> 4;
        const int cidx = (q == 0) ? 512 + g * 128 + ck16 * 8 : (q == 1) ? 768 + g * 128 + ck16 * 8 : g * 256 + (q - 2) * 128 + ck16 * 8;
        f32x4 wt[4][2], bs8[2];
        bs8[0] = *(const f32x4*)(cbias + cidx); bs8[1] = *(const f32x4*)(cbias + cidx + 4);
#pragma unroll
        for (int k = 0; k < 4; ++k) { wt[k][0] = *(const f32x4*)(cw + k * 1024 + cidx); wt[k][1] = *(const f32x4*)(cw + k * 1024 + cidx + 4); }
        u32x4 xq[7];
        const bf16_t* pb_ = rowb + UC_XBC + cidx;
#pragma unroll
        for (int k = 0; k < 7; ++k) { const int t = t0 + 4 * run - 3 + k; xq[k] = *(const u32x4*)(pb_ + (size_t)(t < 0 ? 0 : t) * UW); if (t < 0) xq[k] = (u32x4){0u, 0u, 0u, 0u}; }
        unsigned o[4][4];
#pragma unroll
        for (int r = 0; r < 4; ++r) {
            f32x4 a0 = bs8[0], a1 = bs8[1];
#pragma unroll
            for (int k = 0; k < 4; ++k) {
                const u32x4 xv = xq[r + k];
                a0[0] += bf2f(xv[0] & 0xffffu) * wt[k][0][0]; a0[1] += bf2f(xv[0] >> 16) * wt[k][0][1]; a0[2] += bf2f(xv[1] & 0xffffu) * wt[k][0][2]; a0[3] += bf2f(xv[1] >> 16) * wt[k][0][3];
                a1[0] += bf2f(xv[2] & 0xffffu) * wt[k][1][0]; a1[1] += bf2f(xv[2] >> 16) * wt[k][1][1]; a1[2] += bf2f(xv[3] & 0xffffu) * wt[k][1][2]; a1[3] += bf2f(xv[3] >> 16) * wt[k][1][3];
            }
            o[r][0] = cvt_pk(silu_fast(a0[0]), silu_fast(a0[1])); o[r][1] = cvt_pk(silu_fast(a0[2]), silu_fast(a0[3]));
            o[r][2] = cvt_pk(silu_fast(a1[0]), silu_fast(a1[1])); o[r][3] = cvt_pk(silu_fast(a1[2]), silu_fast(a1[3]));
        }
        if (q < 2) {
            LAS bf16_t* dstR = (q == 0 ? Bs : Cs) + (4 * run) * SL + ck16 * 8;
#pragma unroll
            for (int r = 0; r < 4; ++r) *(LAS u32x4*)(dstR + r * SL) = (u32x4){o[r][0], o[r][1], o[r][2], o[r][3]};
        }
        if (q != 1) {
            LAS bf16_t* dstT; int rbase;
            if (q == 0) { dstT = Bt; rbase = 64 * (ck16 >> 3) + 2 * (ck16 & 7); }
            else { dstT = (q == 2 ? Xt : Cs) + (ck16 >> 3) * 64 * SL; rbase = 2 * (ck16 & 7); }
#pragma unroll
            for (int j = 0; j < 8; ++j) {
                const int row = rbase + 16 * (j & 3) + (j >> 2);
                const unsigned lo0 = (j & 1) ? (o[0][j >> 1] >> 16) : (o[0][j >> 1] & 0xffffu), lo1 = (j & 1) ? (o[1][j >> 1] >> 16) : (o[1][j >> 1] & 0xffffu);
                const unsigned lo2 = (j & 1) ? (o[2][j >> 1] >> 16) : (o[2][j >> 1] & 0xffffu), lo3 = (j & 1) ? (o[3][j >> 1] >> 16) : (o[3][j >> 1] & 0xffffu);
                *(LAS u32x2*)(dstT + row * SL + 4 * run) = (u32x2){lo0 | (lo1 << 16), lo2 | (lo3 << 16)};
            }
        }
    };
    stage(0); stage(1); stage(2);
    __syncthreads();
    f32x4 cbv[8];
#pragma unroll
    for (int j = 0; j < 8; ++j) cbv[j] = (f32x4){0.f, 0.f, 0.f, 0.f};
#pragma unroll
    for (int ks = 0; ks < 4; ++ks) {
        const bf16x8 a = *(const LAS bf16x8*)(Cs + (16 * w + r16) * SL + ks * 32 + kg * 8);
#pragma unroll
        for (int j = 0; j < 8; ++j) { const bf16x8 bb = *(const LAS bf16x8*)(Bs + (16 * j + r16) * SL + ks * 32 + kg * 8); cbv[j] = __builtin_amdgcn_mfma_f32_16x16x32_bf16(a, bb, cbv[j], 0, 0, 0); }
    }
    { unsigned char* ct = ws + WS_SSDC + (size_t)job * 32768;
#pragma unroll
      for (int n = 0; n < 4; ++n) { const int i = F.tid + 512 * n, row = i >> 4, pc = i & 15;
          *(u32x4*)(ct + row * 256 + ((pc ^ (row & 15)) << 4)) = *(const LAS u32x4*)(Cs + row * SL + pc * 8); } }
    __syncthreads();
    stage(3);
    LAS bf16_t* Ws = Bs;
#pragma unroll 1
    for (int hh = 0; hh < 4; ++hh) {
        const int h = 4 * g + hh;
        LAS bf16_t* Xh = (hh < 2 ? Xt : Cs) + (hh & 1) * 64 * SL;
        const float Dh = IN_F(9)[L * 8 + h];
        const LAS float* ac = acs + hh * 128; const LAS float* dt = dts + hh * 128;
        { float al[4], as8[8], ds8[8];
#pragma unroll
          for (int r = 0; r < 4; ++r) al[r] = ac[16 * w + 4 * kg + r];
#pragma unroll
          for (int j = 0; j < 8; ++j) { as8[j] = ac[16 * j + r16]; ds8[j] = dt[16 * j + r16]; }
#pragma unroll
          for (int j = 0; j < 8; ++j)
#pragma unroll
              for (int r = 0; r < 4; ++r) { const int l = 16 * w + 4 * kg + r, s = 16 * j + r16;
                  const float wv = (s <= l) ? cbv[j][r] * __expf(al[r] - as8[j]) * ds8[j] : 0.f;
                  Ws[l * SL + s] = (bf16_t)f2bf(wv); } }
        __syncthreads();
        { f32x4 yd[4];
#pragma unroll
          for (int j = 0; j < 4; ++j) yd[j] = (f32x4){0.f, 0.f, 0.f, 0.f};
#pragma unroll
          for (int ks = 0; ks < 4; ++ks) {
              const bf16x8 aw = *(const LAS bf16x8*)(Ws + (16 * w + r16) * SL + ks * 32 + kg * 8);
#pragma unroll
              for (int j = 0; j < 4; ++j) { const bf16x8 bx = *(const LAS bf16x8*)(Xh + (16 * j + r16) * SL + ks * 32 + kg * 8); yd[j] = __builtin_amdgcn_mfma_f32_16x16x32_bf16(aw, bx, yd[j], 0, 0, 0); }
          }
#pragma unroll
          for (int r = 0; r < 4; ++r) {
              const int l = 16 * w + 4 * kg + r; const size_t trow = (size_t)(b * SEQ + t0 + l);
              f32x4 yv;
#pragma unroll
              for (int j = 0; j < 4; ++j) yv[j] = yd[j][r] + Dh * bf2f(Xh[(16 * j + r16) * SL + l]);
              *(u32x2*)(Y + trow * YW + h * 64 + 4 * r16) = pack4c(yv);
          } }
        __syncthreads();
        { const int row = F.tid >> 3, l0 = (F.tid & 7) * 16; LAS bf16_t* px = Xh + row * SL + l0; const LAS float* sc = scl + hh * 128 + l0;
#pragma unroll
          for (int q = 0; q < 2; ++q) { const u32x4 xv = *(const LAS u32x4*)(px + 8 * q); const f32x4 s0 = *(const LAS f32x4*)(sc + 8 * q), s1 = *(const LAS f32x4*)(sc + 8 * q + 4);
              u32x4 ov; ov.x = cvt_pk(bf2f(xv.x & 0xffffu) * s0[0], bf2f(xv.x >> 16) * s0[1]); ov.y = cvt_pk(bf2f(xv.y & 0xffffu) * s0[2], bf2f(xv.y >> 16) * s0[3]);
              ov.z = cvt_pk(bf2f(xv.z & 0xffffu) * s1[0], bf2f(xv.z >> 16) * s1[1]); ov.w = cvt_pk(bf2f(xv.w & 0xffffu) * s1[2], bf2f(xv.w >> 16) * s1[3]);
              *(LAS u32x4*)(px + 8 * q) = ov; } }
        __syncthreads();
        { const int pt = w & 3; f32x4 st[4];
#pragma unroll
          for (int j = 0; j < 4; ++j) st[j] = (f32x4){0.f, 0.f, 0.f, 0.f};
#pragma unroll
          for (int ks = 0; ks < 4; ++ks) {
              const bf16x8 a = *(const LAS bf16x8*)(Xh + (16 * pt + r16) * SL + ks * 32 + kg * 8);
#pragma unroll
              for (int j = 0; j < 4; ++j) { const int nt = (w >> 2) * 4 + j; const bf16x8 bb = *(const LAS bf16x8*)(Bt + (16 * nt + r16) * SL + ks * 32 + kg * 8);
                  st[j] = __builtin_amdgcn_mfma_f32_16x16x32_bf16(a, bb, st[j], 0, 0, 0); }
          }
          unsigned char* sg = ws + WS_SSDS + (size_t)((b * 8 + h) * 16 + c) * 16384;
#pragma unroll
          for (int r = 0; r < 4; ++r) { const int p = 4 * (4 * kg + r) + pt; const f32x4 sv = (f32x4){st[0][r], st[1][r], st[2][r], st[3][r]};
              *(u32x2*)(sg + p * 256 + (64 * (w >> 2) + 4 * r16) * 2) = pack4c(sv); } }
    }
}
constexpr int ST_C = 0, ST_PV = 65536, ST_END = ST_PV + 64 * SL * 2;
static_assert(ST_END <= LDS_USER, "ssd state lds");
__device__ UNIT_INLINE void ssd_state(Frame& F, int unit, const bf16_t* U1, bf16_t* Y, float* ssq, const unsigned char* ws) {
    const int h = unit & 7, b = unit >> 3, g = h >> 2;
    const int r16 = F.lane & 15, kg = F.lane >> 4, w = F.wave;
    const unsigned char* ctile = ws + WS_SSDC + (size_t)((b * 2 + g) * 16) * 32768 + F.lane * 16;
    const unsigned char* sg = ws + WS_SSDS + (size_t)((b * 8 + h) * 16) * 16384;
    const float* acsg = (const float*)(ws + WS_SSDA) + (size_t)(b * 8 + h) * SEQ;
    LAS bf16_t* Pv = (LAS bf16_t*)(F.lds + ST_PV);
    const int prow = F.tid >> 3, n0 = (F.tid & 7) * 16, pp = 4 * (prow & 15) + (prow >> 4);
    float pv[16];
#pragma unroll
    for (int i = 0; i < 16; ++i) pv[i] = 0.f;
    __syncthreads();
    *(LAS u32x4*)(Pv + prow * SL + n0) = (u32x4){0u, 0u, 0u, 0u}; *(LAS u32x4*)(Pv + prow * SL + n0 + 8) = (u32x4){0u, 0u, 0u, 0u};
#define ST_DMA(cc) do { _Pragma("unroll") for (int q_ = 0; q_ < 4; ++q_) { const int pc_ = w * 4 + q_; \
        __builtin_amdgcn_global_load_lds((const unsigned*)(ctile + (size_t)(cc) * 32768 + pc_ * 1024), (LAS unsigned*)(F.lds + ST_C + ((cc) & 1) * 32768 + pc_ * 1024), 16, 0, 0); } } while (0)
    ST_DMA(0);
#pragma unroll 1
    for (int c = 0; c < 16; ++c) {
        const int t0 = c * 128;
        asm volatile("s_waitcnt vmcnt(0)" ::: "memory");
        RW_BAR();
        const u32x4 s0 = *(const u32x4*)(sg + (size_t)c * 16384 + pp * 256 + n0 * 2), s1 = *(const u32x4*)(sg + (size_t)c * 16384 + pp * 256 + n0 * 2 + 16);
        const f32x4 al = *(const f32x4*)(acsg + t0 + 16 * w + 4 * kg); const float aend = acsg[t0 + 127];
        u32x2 yq[4], zq[4];
#pragma unroll
        for (int r = 0; r < 4; ++r) { const size_t trow = (size_t)(b * SEQ + t0 + 16 * w + 4 * kg + r);
            yq[r] = *(const u32x2*)(Y + trow * YW + h * 64 + 4 * r16); zq[r] = *(const u32x2*)(U1 + trow * UW + UC_Z + h * 64 + 4 * r16); }
        if (c + 1 < 16) ST_DMA(c + 1);
        f32x4 yo[4];
#pragma unroll
        for (int j = 0; j < 4; ++j) yo[j] = (f32x4){0.f, 0.f, 0.f, 0.f};
        { const LAS unsigned char* cs = F.lds + ST_C + (c & 1) * 32768 + (16 * w + r16) * 256;
#pragma unroll
          for (int ks = 0; ks < 4; ++ks) {
              const bf16x8 ac = *(const LAS bf16x8*)(cs + (((ks * 4 + kg) ^ r16) << 4));
#pragma unroll
              for (int j = 0; j < 4; ++j) { const bf16x8 bp = *(const LAS bf16x8*)(Pv + (16 * j + r16) * SL + ks * 32 + kg * 8); yo[j] = __builtin_amdgcn_mfma_f32_16x16x32_bf16(ac, bp, yo[j], 0, 0, 0); }
          } }
#pragma unroll
        for (int r = 0; r < 4; ++r) {
            const size_t trow = (size_t)(b * SEQ + t0 + 16 * w + 4 * kg + r);
            const float ea = __expf(al[r]);
            const f32x4 yp = unpack4(yq[r]), z = unpack4(zq[r]);
            f32x4 yv; float sq = 0.f;
#pragma unroll
            for (int j = 0; j < 4; ++j) { yv[j] = (yp[j] + yo[j][r] * ea) * silu_fast(z[j]); sq += yv[j] * yv[j]; }
            *(u32x2*)(Y + trow * YW + h * 64 + 4 * r16) = pack4c(yv);
            sq += __shfl_xor(sq, 1); sq += __shfl_xor(sq, 2); sq += __shfl_xor(sq, 4); sq += __shfl_xor(sq, 8);
            if (r16 == 0) ssq[trow * 8 + h] = sq;
        }
        RW_BAR();
        { const float cd = __expf(aend);
          const f32x4 a = unpack4((u32x2){s0.x, s0.y}), bq = unpack4((u32x2){s0.z, s0.w}), cq = unpack4((u32x2){s1.x, s1.y}), dq = unpack4((u32x2){s1.z, s1.w});
#pragma unroll
          for (int i = 0; i < 4; ++i) { pv[i] = pv[i] * cd + a[i]; pv[4 + i] = pv[4 + i] * cd + bq[i]; pv[8 + i] = pv[8 + i] * cd + cq[i]; pv[12 + i] = pv[12 + i] * cd + dq[i]; }
          *(LAS u32x4*)(Pv + prow * SL + n0) = (u32x4){cvt_pk(pv[0], pv[1]), cvt_pk(pv[2], pv[3]), cvt_pk(pv[4], pv[5]), cvt_pk(pv[6], pv[7])};
          *(LAS u32x4*)(Pv + prow * SL + n0 + 8) = (u32x4){cvt_pk(pv[8], pv[9]), cvt_pk(pv[10], pv[11]), cvt_pk(pv[12], pv[13]), cvt_pk(pv[14], pv[15])}; }
    }
#undef ST_DMA
}

__device__ UNIT_INLINE void ssd_fixup_and_pb(Frame& F, int L, KArgs KA, bf16_t* Y, const float* ssq, bf16_t* PB) {
    const int gt = F.bid * 512 + F.tid, NT = F.G * 512;
    const float* nw = IN_F(10) + (size_t)L * 512;
    for (int i = gt; i < T * 64; i += NT) {
        const int t = i >> 6, ch = i & 63, g = ch >> 5;
        const f32x4 q = *(const f32x4*)(ssq + (size_t)t * 8 + g * 4);
        const float rs = rsqrtf(((q[0] + q[1]) + (q[2] + q[3])) * (1.0f / 256.0f) + NORM_EPS);
        bf16_t* yp = Y + (size_t)t * YW + ch * 8;
        const u32x4 v = *(const u32x4*)yp; const f32x4 n0 = *(const f32x4*)(nw + ch * 8), n1 = *(const f32x4*)(nw + ch * 8 + 4);
        u32x4 o;
        o.x = cvt_pk(bf2f(v.x & 0xffffu) * rs * n0[0], bf2f(v.x >> 16) * rs * n0[1]); o.y = cvt_pk(bf2f(v.y & 0xffffu) * rs * n0[2], bf2f(v.y >> 16) * rs * n0[3]);
        o.z = cvt_pk(bf2f(v.z & 0xffffu) * rs * n1[0], bf2f(v.z >> 16) * rs * n1[1]); o.w = cvt_pk(bf2f(v.w & 0xffffu) * rs * n1[2], bf2f(v.w >> 16) * rs * n1[3]);
        *(u32x4*)yp = o;
    }
    const float* p = IN_F(1) + (size_t)L * T * PLE;
    for (int i = gt; i < T * PLE / 8; i += NT) {
        const f32x4 a = *(const f32x4*)(p + (size_t)i * 8), b = *(const f32x4*)(p + (size_t)i * 8 + 4);
        u32x4 o; o.x = cvt_pk(a[0], a[1]); o.y = cvt_pk(a[2], a[3]); o.z = cvt_pk(b[0], b[1]); o.w = cvt_pk(b[2], b[3]);
        *(u32x4*)(PB + (size_t)i * 8) = o;
    }
}
__device__ UNIT_INLINE void moe_router(Frame& F, KArgs KA, const float* xo, unsigned* cnt, int* toke, int* tokp, float* tokw) {
    const int gw = F.bid * 8 + F.wave, NGW = F.G * 8;
    const float* gff = IN_F(31) + DM; const float* router = IN_F(35);
    for (int m = gw; m < T; m += NGW) {
        const f32x4* xr = (const f32x4*)(xo + (size_t)m * DM) + F.lane; f32x4 v[4]; float s = 0.f;
#pragma unroll
        for (int j = 0; j < 4; ++j) { v[j] = xr[64 * j]; s += (v[j][0] * v[j][0] + v[j][1] * v[j][1]) + (v[j][2] * v[j][2] + v[j][3] * v[j][3]); }
        const float rstd = rsqrtf(wave_sum(s) * (1.0f / DM) + NORM_EPS);
        float lg[8];
#pragma unroll
        for (int e = 0; e < 8; ++e) lg[e] = 0.f;
#pragma unroll
        for (int j = 0; j < 4; ++j) { const f32x4 gg = *((const f32x4*)gff + F.lane + 64 * j);
#pragma unroll
            for (int i = 0; i < 4; ++i) { const int k = 4 * F.lane + 256 * j + i; const float hv = v[j][i] * rstd * gg[i];
                const f32x4 r0 = *(const f32x4*)(router + (size_t)k * 8), r1 = *(const f32x4*)(router + (size_t)k * 8 + 4);
                lg[0] += hv * r0[0]; lg[1] += hv * r0[1]; lg[2] += hv * r0[2]; lg[3] += hv * r0[3]; lg[4] += hv * r1[0]; lg[5] += hv * r1[1]; lg[6] += hv * r1[2]; lg[7] += hv * r1[3]; } }
#pragma unroll
        for (int e = 0; e < 8; ++e) lg[e] = wave_sum(lg[e]);
        if (F.lane == 0) {
            int e1 = 0; float v1 = lg[0];
#pragma unroll
            for (int e = 1; e < 8; ++e) if (lg[e] > v1) { v1 = lg[e]; e1 = e; }
            int e2 = -1; float v2 = -INFINITY;
#pragma unroll
            for (int e = 0; e < 8; ++e) if (e != e1 && lg[e] > v2) { v2 = lg[e]; e2 = e; }
            const float ex = __expf(v2 - v1), w1 = 1.0f / (1.0f + ex), w2 = ex / (1.0f + ex);
            const int p1 = (int)atomicAdd(cnt + 64 * e1, 1u), p2 = (int)atomicAdd(cnt + 64 * e2, 1u);
            toke[2 * m] = e1; toke[2 * m + 1] = e2; tokp[2 * m] = p1; tokp[2 * m + 1] = p2; tokw[2 * m] = w1; tokw[2 * m + 1] = w2;
        }
    }
}
__device__ __forceinline__ void moe_tables(const unsigned* cnt, MoeTables& mt, int (&c)[8]) {
#pragma unroll
    for (int e = 0; e < 8; ++e) c[e] = (int)__hip_atomic_load(cnt + 64 * e, RLX_AGENT);
    int ps = 0;
    ps += (c[0] + 255) & ~255; mt.ps1 = ps; ps += (c[1] + 255) & ~255; mt.ps2 = ps; ps += (c[2] + 255) & ~255; mt.ps3 = ps; ps += (c[3] + 255) & ~255; mt.ps4 = ps;
    ps += (c[4] + 255) & ~255; mt.ps5 = ps; ps += (c[5] + 255) & ~255; mt.ps6 = ps; ps += (c[6] + 255) & ~255; mt.ps7 = ps; ps += (c[7] + 255) & ~255; mt.ps8 = ps;
}
__device__ __forceinline__ int moe_pstart(const MoeTables& mt, int e) {
    return e == 0 ? 0 : e == 1 ? mt.ps1 : e == 2 ? mt.ps2 : e == 3 ? mt.ps3 : e == 4 ? mt.ps4 : e == 5 ? mt.ps5 : e == 6 ? mt.ps6 : mt.ps7;
}
__device__ UNIT_INLINE void moe_slots(Frame& F, const float* xo, const float* ss2, const unsigned* cnt, const int* toke, const int* tokp, int* toks, bf16_t* XG, float* srstd) {
    const int gw = F.bid * 8 + F.wave, NGW = F.G * 8;
    MoeTables mt; int c[8]; moe_tables(cnt, mt, c);
    for (int m = gw; m < T; m += NGW) {
        const f32x4* xr = (const f32x4*)(xo + (size_t)m * DM) + F.lane; u32x2 pk[4];
#pragma unroll
        for (int j = 0; j < 4; ++j) pk[j] = pack4(xr[64 * j]);
        const float rs = rstd_of(ss2, m);
#pragma unroll
        for (int k = 0; k < 2; ++k) {
            const int e = toke[2 * m + k], slot = moe_pstart(mt, e) + tokp[2 * m + k];
            u32x2* o = (u32x2*)(XG + (size_t)slot * DM) + F.lane;
#pragma unroll
            for (int j = 0; j < 4; ++j) o[64 * j] = pk[j];
            if (F.lane == 0) { toks[2 * m + k] = slot; srstd[slot] = rs; }
        }
    }
    for (int idx = gw; idx < 8 * 256; idx += NGW) {
        const int e = idx >> 8, r = idx & 255;
        int ce = 0;
#pragma unroll
        for (int q = 0; q < 8; ++q) if (q == e) ce = c[q];
        const int row = moe_pstart(mt, e) + ce + r, end = (e == 7) ? mt.ps8 : moe_pstart(mt, e + 1);
        if (row < end) { u32x2* o = (u32x2*)(XG + (size_t)row * DM) + F.lane;
#pragma unroll
            for (int j = 0; j < 4; ++j) o[64 * j] = (u32x2){0u, 0u};
            if (F.lane == 0) srstd[row] = 0.f; }
    }
}
__device__ UNIT_INLINE void moe_combine(Frame& F, float* xo, const bf16_t* YB, const int* toks, const float* tokw, bf16_t* XB2) {
    const int gw = F.bid * 8 + F.wave, NGW = F.G * 8;
    for (int m = gw; m < T; m += NGW) {
        const int s0 = toks[2 * m], s1 = toks[2 * m + 1]; const float w0 = tokw[2 * m], w1 = tokw[2 * m + 1];
        f32x4* xr = (f32x4*)(xo + (size_t)m * DM) + F.lane; const u32x2* y0 = (const u32x2*)(YB + (size_t)s0 * DM) + F.lane; const u32x2* y1 = (const u32x2*)(YB + (size_t)s1 * DM) + F.lane;
        u32x2* xb = (u32x2*)(XB2 + (size_t)m * DM) + F.lane;
#pragma unroll
        for (int j = 0; j < 4; ++j) { const f32x4 v = xr[64 * j] + (unpack4(y0[64 * j]) * w0 + unpack4(y1[64 * j]) * w1); xr[64 * j] = v; xb[64 * j] = pack4(v); }
    }
}
__device__ UNIT_INLINE void final_norm(Frame& F, KArgs KA, float* xo) {
    const int gw = F.bid * 8 + F.wave, NGW = F.G * 8; const float* gf = IN_F(41);
    for (int m = gw; m < T; m += NGW) {
        f32x4* xr = (f32x4*)(xo + (size_t)m * DM) + F.lane; f32x4 v[4]; float s = 0.f;
#pragma unroll
        for (int j = 0; j < 4; ++j) { v[j] = xr[64 * j]; s += (v[j][0] * v[j][0] + v[j][1] * v[j][1]) + (v[j][2] * v[j][2] + v[j][3] * v[j][3]); }
        const float rstd = rsqrtf(wave_sum(s) * (1.0f / DM) + NORM_EPS);
#pragma unroll
        for (int j = 0; j < 4; ++j) xr[64 * j] = v[j] * rstd * *((const f32x4*)gf + F.lane + 64 * j);
    }
}


#define XB_TMO      128
#define XB_XCNT(j)  (256  + 64 * (j))
#define XB_XSUB(j)  (1280 + 64 * (j))
#define XB_XGEN(j)  (2304 + 64 * (j))
#define XB_TOP      3328
#define XB_TOPGEN   3392
#define XCD_BAR_WORDS 3456
#define XB_SPIN_CAP (1u << 22)
__device__ __forceinline__ unsigned xb_ld(unsigned* p)              { return __hip_atomic_load(p, __ATOMIC_RELAXED, __HIP_MEMORY_SCOPE_AGENT); }
__device__ __forceinline__ unsigned xb_add(unsigned* p, unsigned v) { return __hip_atomic_fetch_add(p, v, __ATOMIC_RELAXED, __HIP_MEMORY_SCOPE_AGENT); }
__device__ __forceinline__ unsigned xb_xcc_id() { return (unsigned)__builtin_amdgcn_s_getreg((3 << 11) | 20) & 0xFu; }
#define XB_SPIN(cond, bar) do { unsigned _sp = 0; while (cond) { __builtin_amdgcn_s_sleep(1); \
    if ((++_sp & 255u) == 0u) { if (xb_ld(&(bar)[XB_TMO])) break; if (_sp > XB_SPIN_CAP) { atomicAdd(&(bar)[XB_TMO], 1u); break; } } } } while (0)
struct XcdBarrier { unsigned* bar; unsigned x; volatile LAS unsigned* st; };
__device__ __forceinline__ XcdBarrier xcd_barrier_post(unsigned* bar, volatile LAS unsigned* st) {
    XcdBarrier b; b.bar = bar; b.x = xb_xcc_id(); b.st = st;
    if (threadIdx.x == 0) (void)xb_add(&bar[XB_XCNT(b.x)], 1u);
    return b;
}
__device__ __forceinline__ void xcd_barrier_complete(unsigned* bar, unsigned x, unsigned& nloc, unsigned& nx) {
    const unsigned G = gridDim.x * gridDim.y * gridDim.z;
    unsigned sum, cnt, mine, sp = 0u;
    for (;;) {
        sum = 0u; cnt = 0u; mine = 0u;
#pragma unroll
        for (unsigned j = 0; j < 16; ++j) { const unsigned c = xb_ld(&bar[XB_XCNT(j)]); sum += c; cnt += (c > 0u) ? 1u : 0u; mine = (j == x) ? c : mine; }
        if (sum == G) break;
        __builtin_amdgcn_s_sleep(1);
        if ((++sp & 255u) == 0u) { if (xb_ld(&bar[XB_TMO])) break; if (sp > XB_SPIN_CAP) { atomicAdd(&bar[XB_TMO], 1u); break; } }
    }
    nloc = mine > 0u ? mine : 1u; nx = cnt > 0u ? cnt : 1u;
}
__device__ __forceinline__ void xcd_barrier(const XcdBarrier& b, bool leader) {
    asm volatile("s_waitcnt vmcnt(0)" ::: "memory");
    __syncthreads();
    if (leader) {
        unsigned* bar = b.bar;
        __builtin_amdgcn_s_waitcnt(0);
        unsigned nloc = b.st[0], nx = b.st[1];
        if (nloc == 0u) { xcd_barrier_complete(bar, b.x, nloc, nx); b.st[0] = nloc; b.st[1] = nx; }
        const unsigned old = xb_add(&bar[XB_XSUB(b.x)], 1u);
        const unsigned gen = old / nloc;
        if (old + 1u == (gen + 1u) * nloc) {
            __builtin_amdgcn_fence(__ATOMIC_RELEASE, "agent");
            asm volatile("s_waitcnt vmcnt(0)" ::: "memory");
            const unsigned og = xb_add(&bar[XB_TOP], 1u);
            const unsigned tg = og / nx;
            if (og + 1u == (tg + 1u) * nx) xb_add(&bar[XB_TOPGEN], 1u);
            else XB_SPIN(xb_ld(&bar[XB_TOPGEN]) == tg, bar);
            __builtin_amdgcn_fence(__ATOMIC_ACQUIRE, "agent");
            xb_add(&bar[XB_XGEN(b.x)], 1u);
            asm volatile("s_waitcnt vmcnt(0)" ::: "memory");
        } else {
            XB_SPIN(xb_ld(&bar[XB_XGEN(b.x)]) == gen, bar);
            __builtin_amdgcn_fence(__ATOMIC_ACQUIRE, "agent");
            asm volatile("s_waitcnt vmcnt(0)" ::: "memory");
        }
    }
    __syncthreads();
}

constexpr int NPH = 23;
__device__ __forceinline__ unsigned char* opq(unsigned char* p) { asm volatile("" : "+s"(p)); return p; }
__global__ void __launch_bounds__(512, 2) mega_fwd(Args args) {
    extern __shared__ __attribute__((aligned(16))) unsigned char lds_raw[];
    Frame F;
    F.lds = (LAS unsigned char*)lds_raw; F.tid = 0; F.lane = 0; F.wave = __builtin_amdgcn_readfirstlane((int)threadIdx.x >> 6);
    F.G = gridDim.x; F.bid = blockIdx.x; F.ws = nullptr; F.ctl = nullptr;
    const int lo = args.ph_lo, hi = args.ph_hi;
    LAS unsigned* s_uid = (LAS unsigned*)(F.lds + LDS_USER + 64);
    if (threadIdx.x < 16) ((LAS unsigned*)(F.lds + LDS_USER))[threadIdx.x] = 0u;
    __syncthreads();
    (void)xcd_barrier_post((unsigned*)(args.ws + WS_CTL) + CW_BAR, (volatile LAS unsigned*)(F.lds + LDS_USER + 32));
#if MK_MULTI
#define GSYNC(k) do {} while (0)
#else
#define GSYNC(k) do { if ((k) + 1 < hi || rep_ + 1 < ((k) == REP_PH ? REP_N : 1)) { if ((k) == 0) cg::this_grid().sync(); else { XcdBarrier xb_; xb_.bar = (unsigned*)(KA->ws + WS_CTL) + CW_BAR; xb_.x = xb_xcc_id(); xb_.st = (volatile LAS unsigned*)(P.lds + LDS_USER + 32); xcd_barrier(xb_, P.tid == 0); } } } while (0)
#endif
#ifdef ONLY_PH
#define RUN(k) ((k) == ONLY_PH)
#else
#define RUN(k) (lo <= (k) && (k) < hi)
#endif
#define REPS(k) for (int rep_ = 0; rep_ < ((k) == REP_PH ? REP_N : 1); ++rep_)
#define PH_PTRS KArgs KA = kargs(); unsigned char* ws = KA->ws; float* out = KA->out; (void)out; \
    Frame P = F; asm volatile("" : "+s"(P.G), "+s"(P.bid), "+s"(P.wave)); asm volatile("v_mbcnt_lo_u32_b32 %0, -1, 0\n\tv_mbcnt_hi_u32_b32 %0, -1, %0" : "=v"(P.lane)); P.tid = P.wave * 64 + P.lane; \
    unsigned char* wa = ws + WS_WA + (size_t)L * WA_STRIDE; (void)wa; float* ssb = (float*)(ws + WS_SSP); \
    float* ss1 = ssb + (size_t)(2 * L) * T * 16; float* ss2 = ssb + (size_t)(2 * L + 1) * T * 16; float* ssn = ssb + (size_t)(2 * L + 2) * T * 16; (void)ss1; (void)ss2; (void)ssn; \
    bf16_t* XB = (bf16_t*)(ws + WS_XB); bf16_t* Y = (bf16_t*)(ws + WS_Y); bf16_t* U1 = (bf16_t*)(ws + WS_U1); (void)XB; (void)Y; (void)U1; \
    bf16_t* GATES = (bf16_t*)(ws + WS_GATES); bf16_t* MERGED = (bf16_t*)(ws + WS_MERGED); bf16_t* PB = (bf16_t*)(ws + WS_PB); (void)GATES; (void)MERGED; (void)PB; \
    float* MISC = (float*)(ws + WS_MISC); float* SSQ = (float*)(ws + WS_SSQ); (void)MISC; (void)SSQ; \
    bf16_t* XB2 = (bf16_t*)(ws + (L == 0 ? WS_XB2_L0 : WS_XB2_L1)); (void)XB2;
    const size_t TILE1K = (size_t)256 * 1024 * 2;
    if (RUN(0)) REPS(0) { const int L = 0; PH_PTRS p0_prologue(KA, P); GSYNC(0); }
#pragma unroll 1
    for (int L = 0; L < 2; ++L) {
        const int pb0 = 1 + (L == 0 ? 0 : 9);
        if (RUN(pb0)) REPS(pb0) { PH_PTRS
            pg8::DenseSched S; S.so.init(64, 22, P.G, P.bid); S.A = (const char*)XB; S.B = (const char*)(wa + WA_IN); S.a_tile = TILE1K; S.b_tile = TILE1K;
            EpiIn E{U1, MISC, ss1};
            pg8::gemm_phase(P.lds, DM, DM, DM, S, E); GSYNC(pb0);
        }
        if (RUN(pb0 + 1)) REPS(pb0 + 1) {
            { PH_PTRS rwkv_prep(P, L, KA, U1, ws + WS_REC); }
            { PH_PTRS for (int job = P.bid; job < 256; job += P.G) ssd_prep(P, job, L, KA, U1, Y, MISC, ws); }
            { PH_PTRS
              for (int t = P.bid; t < 256; t += P.G) {
                  __syncthreads();
                  if (t < 128) compress_unit(P, t, L, U1, ws);
                  else rope_slice(P, U1, (const float*)(ws + WS_ROPE), (const float*)(ws + WS_ROPE) + (size_t)T * 32, t - 128);
              } }
            { PH_PTRS GSYNC(pb0 + 1); }
        }
        if (RUN(pb0 + 2)) REPS(pb0 + 2) {
            if (F.bid < 64) { PH_PTRS
#ifndef SKIP_RWKV
                rwkv_scan(P, P.bid, L, KA, ws + WS_REC, Y);
#endif
            }
            if (F.bid >= 64 && F.bid < 128) { PH_PTRS
#ifndef SKIP_SSD
                ssd_state(P, P.bid - 64, U1, Y, SSQ, ws);
#endif
            }
            { PH_PTRS
            unsigned* q = (unsigned*)(ws + WS_CTL) + CW_QMIX + 256 * L;
            for (;;) {
                __syncthreads();
                if (P.tid == 0) *s_uid = atomicAdd(q + 128, 1u);
                __syncthreads();
                const int uid = (int)*s_uid;
                if (uid >= 512) break;
#ifndef SKIP_NSA
                nsa_unit(P, uid, U1, Y, MISC, ws);
#endif
            } }
            { PH_PTRS
            unsigned* q = (unsigned*)(ws + WS_CTL) + CW_QMIX + 256 * L;
            for (;;) {
                __syncthreads();
                if (P.tid == 0) *s_uid = atomicAdd(q + 192, 1u);
                __syncthreads();
                const int uid = (int)*s_uid;
                if (uid >= 512) break;
#ifndef SKIP_SWA
                swa_unit(P, uid, U1, Y, IN_F(25) + L * 8);
#endif
            } }
            if (L == 0) { PH_PTRS deferred_convert(KA, P, (unsigned*)(ws + WS_CTL) + CW_QMIX + 512 + 1024 * rep_, s_uid, 16, 32, 3472); }
            { PH_PTRS GSYNC(pb0 + 2); }
        }
        if (RUN(pb0 + 3)) REPS(pb0 + 3) { PH_PTRS
            { pg8::DenseSched S; S.so.init(64, 16, P.G, P.bid); S.A = (const char*)XB; S.B = (const char*)(wa + WA_GATE); S.a_tile = TILE1K; S.b_tile = TILE1K;
              EpiGates E{GATES, ss1};
              pg8::gemm_phase(P.lds, DM, DM, DM, S, E); }
            ssd_fixup_and_pb(P, L, KA, Y, SSQ, PB);
            if (L != 0) deferred_convert(KA, P, (unsigned*)(ws + WS_CTL) + CW_QMIX + 768 + 1024 * rep_, s_uid, 35, 59, 16896);
            GSYNC(pb0 + 3);
        }
        if (RUN(pb0 + 4)) REPS(pb0 + 4) {
            { PH_PTRS BranchSched S; S.so.init(64, 4, P.G, P.bid); S.Y = (const char*)Y; S.PT = (const char*)(wa + WA_PT); S.a_tile = (size_t)256 * YW * 2; S.b_tile = (size_t)256 * 512 * 2; S.a_br = 512 * 2; S.b_br = MiB;
              EpiBrAll E{MERGED, GATES}; pg8::gemm_phase(P.lds, YW, 512, 512, S, E); }
            { PH_PTRS GSYNC(pb0 + 4); }
        }
        if (RUN(pb0 + 5)) REPS(pb0 + 5) { PH_PTRS
            pg8::DenseSched S; S.so.init(64, 4, P.G, P.bid); S.A = (const char*)MERGED; S.B = (const char*)(wa + WA_OUT); S.a_tile = TILE1K; S.b_tile = TILE1K;
            if (L == 0) { EpiRes<true, true> E{IN_F(0), out, XB, ss2}; pg8::gemm_phase(P.lds, DM, DM, DM, S, E); }
            else { EpiRes<false, true> E{out, out, XB, ss2}; pg8::gemm_phase(P.lds, DM, DM, DM, S, E); }
            GSYNC(pb0 + 5);
        }
        if (L == 0) {
            if (RUN(7)) REPS(7) { PH_PTRS
                pg8::DenseSched S; S.so.init(64, 22, P.G, P.bid); S.A = (const char*)XB; S.B = (const char*)(ws + WS_FGU); S.a_tile = TILE1K; S.b_tile = TILE1K;
                EpiFfn1<false> E{(bf16_t*)(ws + WS_ACT0), ss2};
                pg8::gemm_phase(P.lds, DM, DM, DM, S, E); GSYNC(7);
            }
            if (RUN(8)) REPS(8) { PH_PTRS
                pg8::DenseSched S; S.so.init(64, 4, P.G, P.bid); S.A = (const char*)(ws + WS_ACT0); S.B = (const char*)(ws + WS_FDN); S.a_tile = (size_t)256 * D_FF * 2; S.b_tile = (size_t)256 * D_FF * 2;
                EpiRes<true, false> E{out, out, XB2, nullptr};
                pg8::gemm_phase(P.lds, D_FF, D_FF, D_FF, S, E); GSYNC(8);
            }
        } else {
#define MOE_PTRS unsigned* cnt = (unsigned*)(ws + WS_CTL) + CW_MOECNT; (void)cnt; int* toke = (int*)(ws + WS_TOKE); int* tokp = (int*)(ws + WS_TOKP); float* tokw = (float*)(ws + WS_TOKW); int* toks = (int*)(ws + WS_TOKS); \
            (void)toke; (void)tokp; (void)tokw; (void)toks; float* srstd = (float*)(ws + WS_SRSTD); (void)srstd; \
            bf16_t* XG = (bf16_t*)(ws + WS_XG); bf16_t* ACT1 = (bf16_t*)(ws + WS_ACT1); bf16_t* YB = (bf16_t*)(ws + WS_YB); (void)XG; (void)ACT1; (void)YB;
            if (RUN(16)) REPS(16) { PH_PTRS MOE_PTRS moe_router(P, KA, out, cnt, toke, tokp, tokw); GSYNC(16); }
            if (RUN(17)) REPS(17) { PH_PTRS MOE_PTRS moe_slots(P, out, ss2, cnt, toke, tokp, toks, XG, srstd); GSYNC(17); }
            if (RUN(18)) REPS(18) { PH_PTRS MOE_PTRS
                MoeSched S; int c[8]; moe_tables(cnt, S.mt, c); S.nN = 22; S.G = P.G; S.c = P.bid; S.A = (const char*)XG; S.B = (const char*)(ws + WS_WB); S.a_tile = TILE1K; S.b_tile = TILE1K; S.b_expert = WB_STRIDE;
                EpiFfn1<true> E{ACT1, srstd};
                pg8::gemm_phase(P.lds, DM, DM, DM, S, E); GSYNC(18);
            }
            if (RUN(19)) REPS(19) { PH_PTRS MOE_PTRS
                MoeSched S; int c[8]; moe_tables(cnt, S.mt, c); S.nN = 4; S.G = P.G; S.c = P.bid; S.A = (const char*)ACT1; S.B = (const char*)(ws + WS_WB + WB_DN); S.a_tile = (size_t)256 * D_FF * 2; S.b_tile = (size_t)256 * D_FF * 2; S.b_expert = WB_STRIDE;
                EpiBf16<false> E{YB};
                pg8::gemm_phase(P.lds, D_FF, D_FF, D_FF, S, E); GSYNC(19);
            }
            if (RUN(20)) REPS(20) { PH_PTRS MOE_PTRS moe_combine(P, out, YB, toks, tokw, XB2); GSYNC(20); }
        }
        const int pple = (L == 0) ? 9 : 21;
        if (RUN(pple)) REPS(pple) {
            { PH_PTRS pg8::DenseSched S; S.so.init(64, 4, P.G, P.bid); S.A = (const char*)XB2; S.B = (const char*)(wa + WA_PG); S.a_tile = TILE1K; S.b_tile = TILE1K;
              EpiBf16<true> E{MERGED}; pg8::gemm_phase(P.lds, DM, DM, DM, S, E); }
            { PH_PTRS pg8::DenseSched S; S.so.init(64, 4, P.G, P.bid);
              S.A = (const char*)PB; S.B = (const char*)(wa + WA_PP); S.a_tile = (size_t)256 * PLE * 2; S.b_tile = (size_t)256 * PLE * 2;
              if (L == 0) { EpiPle2<true> E{out, MERGED, XB, ssn}; pg8::gemm_phase(P.lds, PLE, PLE, PLE, S, E); }
              else { EpiPle2<false> E{out, MERGED, XB, ssn}; pg8::gemm_phase(P.lds, PLE, PLE, PLE, S, E); } }
            { PH_PTRS GSYNC(pple); }
        }
    }
    if (RUN(22)) REPS(22) { const int L = 0; PH_PTRS final_norm(P, KA, out); }
}

extern "C" void kernel_launch(void* const* d_in, const int* in_sizes, int n_in, void* d_out, int out_size, void* d_ws, size_t ws_size, hipStream_t stream) {
    static int grid = 0;
    if (grid == 0) {
        if (n_in != 42 || out_size != T * DM || ws_size < WS_END) { fprintf(stderr, "kernel_launch: unexpected problem (n_in %d out %d ws %zu)\n", n_in, out_size, ws_size); grid = -1; return; }
        int dev = 0, cus = 0, per_cu = 0;
        hipGetDevice(&dev); hipDeviceGetAttribute(&cus, hipDeviceAttributeMultiprocessorCount, dev);
        hipFuncSetAttribute((const void*)mega_fwd, hipFuncAttributeMaxDynamicSharedMemorySize, LDS_BYTES);
        hipOccupancyMaxActiveBlocksPerMultiprocessor(&per_cu, (const void*)mega_fwd, 512, LDS_BYTES);
        if (per_cu < 1) { fprintf(stderr, "kernel_launch: occupancy query says %d blocks per CU\n", per_cu); per_cu = 1; }
        (void)hipGetLastError();
        grid = cus;
    }
    if (grid < 0) return;
    hipMemsetAsync((char*)d_ws + WS_CTL, 0, CTL_BYTES, stream);
    Args a{};
    for (int i = 0; i < 42; ++i) a.in[i] = d_in[i];
    a.out = (float*)d_out; a.ws = (unsigned char*)d_ws;
#if MK_MULTI
    for (int k = 0; k < NPH; ++k) { a.ph_lo = k; a.ph_hi = k + 1; hipLaunchKernelGGL(mega_fwd, dim3(grid), dim3(512), LDS_BYTES, stream, a); }
#else
    a.ph_lo = 0; a.ph_hi = NPH;
    void* kargs[] = {&a};
    hipError_t e = hipLaunchCooperativeKernel((const void*)mega_fwd, dim3(grid), dim3(512), kargs, LDS_BYTES, stream);
    if (e != hipSuccess) fprintf(stderr, "kernel_launch: cooperative launch failed: %s\n", hipGetErrorString(e));
#endif
}
```

```cpp
#include <hip/hip_runtime.h>
#include <hip/hip_cooperative_groups.h>
#include <cstdio>
#include <cstdint>
namespace cg = cooperative_groups;

#define LAS __attribute__((address_space(3)))
#define GAS __attribute__((address_space(1)))
typedef unsigned short bf16_t;
typedef short bf16x8 __attribute__((ext_vector_type(8)));
typedef short s16x4 __attribute__((ext_vector_type(4)));
typedef float f32x2 __attribute__((ext_vector_type(2)));
typedef float f32x4 __attribute__((ext_vector_type(4)));
typedef float f32x16 __attribute__((ext_vector_type(16)));
typedef unsigned u32x2 __attribute__((ext_vector_type(2)));
typedef unsigned u32x4 __attribute__((ext_vector_type(4)));

#ifdef DIAG_NOINLINE
#define UNIT_INLINE __attribute__((noinline))
#else
#define UNIT_INLINE __forceinline__
#endif
#ifndef REP_PH
#define REP_PH -1
#endif
#ifndef REP_N
#define REP_N 1
#endif
#ifndef REP_UNIT
#define REP_UNIT -1
#endif
#ifndef MK_MULTI
#define MK_MULTI 0
#endif

constexpr int NB = 8, SEQ = 2048, T = NB * SEQ, DM = 1024, HD = 64;
constexpr int D_IN = 9504, D_FF = 2816, NEXP = 8, PLE = 256;
constexpr int UW = 5376;
constexpr int YW = 2048;
constexpr float NORM_EPS = 1e-6f;
constexpr float LOG2E = 1.4426950408889634f;
constexpr int UC_Z = 0, UC_XBC = 512, UC_XS = 512, UC_BM = 1024, UC_CM = 1280, UC_NQ = 1536, UC_NKV = 2048, UC_RW = 2816, UC_SQ = 4608, UC_SKV = 5120;
constexpr int MOE_MAXROWS = 34816;

constexpr size_t MiB = (size_t)1 << 20;
constexpr size_t WS_CTL = 0, CTL_BYTES = 1 * MiB;
constexpr size_t WS_ROPE = 1 * MiB;
constexpr size_t WS_MISC = 5 * MiB;
constexpr size_t WS_KC = 7 * MiB, WS_VC = 7 * MiB + 256 * 1024;
constexpr size_t WS_SSQ = 7 * MiB + 512 * 1024;
constexpr size_t WS_TOKE = 8 * MiB, WS_TOKP = WS_TOKE + 128 * 1024, WS_TOKW = WS_TOKP + 128 * 1024, WS_TOKS = WS_TOKW + 128 * 1024;
constexpr size_t WS_SRSTD = 8 * MiB + 512 * 1024;
constexpr size_t WS_W1T = 9 * MiB;
constexpr size_t WS_W2T = 10 * MiB;
constexpr size_t WS_PEB = 10 * MiB + 64 * 1024;
constexpr size_t WS_LW = 10 * MiB + 128 * 1024;
constexpr size_t WS_WA = 12 * MiB, WA_STRIDE = 28 * MiB;
constexpr size_t WA_IN = 0, WA_GATE = 11 * MiB, WA_PT = 19 * MiB, WA_OUT = 23 * MiB, WA_PG = 25 * MiB, WA_PP = 27 * MiB;
constexpr size_t WS_FGU = 68 * MiB, WS_FDN = 79 * MiB;
constexpr size_t WS_WB = 85 * MiB, WB_STRIDE = 16 * MiB + 512 * 1024, WB_DN = 11 * MiB;
constexpr size_t WS_REC = WS_WB;
constexpr size_t WS_XB = 217 * MiB;
constexpr size_t WS_Y = 249 * MiB;
constexpr size_t WS_BIG = 313 * MiB;
constexpr size_t WS_U1 = WS_BIG, WS_GATES = WS_BIG, WS_MERGED = WS_BIG + 128 * MiB, WS_PB = WS_BIG + 160 * MiB, WS_ACT0 = WS_BIG;
constexpr size_t WS_XG = WS_XB, WS_ACT1 = 285 * MiB, WS_YB = WS_XB;
constexpr size_t WS_XB2_L0 = WS_Y, WS_XB2_L1 = 300 * MiB;
constexpr size_t WS_SSP = 482 * MiB;
constexpr size_t WS_SSDC = 205 * MiB;
constexpr size_t WS_SSDA = 213 * MiB;
constexpr size_t WS_SSDS = 488 * MiB;
constexpr size_t WS_END = 504 * MiB;
constexpr int CW_BAR = 4096, CW_QMIX = 16384, CW_MOECNT = 9216;
constexpr int CW_DEP = 32768;

constexpr int RING_BYTES = 131072;
constexpr int LDS_BYTES = 147456;
constexpr int LDS_USER = LDS_BYTES - 1024;
constexpr int MISC_OFF = LDS_USER;

__device__ __forceinline__ float bf2f(unsigned b) { return __uint_as_float(b << 16); }
__device__ __forceinline__ unsigned f2bf(float f) { unsigned u = __float_as_uint(f); return (u + 0x7fffu + ((u >> 16) & 1u)) >> 16; }
__device__ __forceinline__ unsigned cvt_pk(float lo, float hi) { unsigned r; asm volatile("v_cvt_pk_bf16_f32 %0, %1, %2" : "=v"(r) : "v"(lo), "v"(hi)); return r; }
__device__ __forceinline__ float sigmoidf_(float x) { return 1.0f / (1.0f + __expf(-x)); }
__device__ __forceinline__ float siluf_(float x) { return x / (1.0f + __expf(-x)); }
__device__ __forceinline__ float softplusf_(float x) { return x > 20.f ? x : __logf(1.0f + __expf(x)); }
__device__ __forceinline__ float wave_sum(float v) {
#pragma unroll
    for (int o = 1; o < 64; o <<= 1) v += __shfl_xor(v, o);
    return v;
}
__device__ __forceinline__ float wave_max(float v) {
#pragma unroll
    for (int o = 1; o < 64; o <<= 1) v = fmaxf(v, __shfl_xor(v, o));
    return v;
}
#define RLX_AGENT __ATOMIC_RELAXED, __HIP_MEMORY_SCOPE_AGENT
__device__ __forceinline__ u32x2 ld_agent_u64(const void* p) {
    unsigned long long v = __hip_atomic_load((const unsigned long long*)p, RLX_AGENT);
    u32x2 r; r.x = (unsigned)v; r.y = (unsigned)(v >> 32); return r;
}

__device__ __forceinline__ float ss_total(const float* ssp, int row) {
    const f32x4* p = (const f32x4*)(ssp + (size_t)row * 16); const f32x4 a = p[0], b = p[1], c = p[2], d = p[3];
    return (((a[0] + a[1]) + (a[2] + a[3])) + ((b[0] + b[1]) + (b[2] + b[3]))) + (((c[0] + c[1]) + (c[2] + c[3])) + ((d[0] + d[1]) + (d[2] + d[3])));
}
__device__ __forceinline__ float rstd_of(const float* ssp, int row) { return rsqrtf(ss_total(ssp, row) * (1.0f / DM) + NORM_EPS); }

namespace pg8 {
constexpr int BM = 256, BK = 64, HALF = 128, HTB = HALF * BK * 2, STAGE_BYTES = 8 * HTB, NXCD = 8, WGM = 8;
__host__ __device__ __forceinline__ int lds_byte(int r, int c) { const int st = (r >> 4) * 2 + (c >> 5), rr = r & 15, cc = c & 31, ob = rr * 64 + cc * 2; return st * 1024 + (ob ^ (((ob >> 9) & 1) << 5)); }
__host__ __device__ __forceinline__ void stage_rc(int b, int& R, int& C) { const int st = b / 1024, sb = b % 1024, swz = sb ^ (((sb >> 9) & 1) << 5); R = (st >> 1) * 16 + swz / 64; C = (st & 1) * 32 + (swz % 64) / 2; }

struct Unit { int pm, pn; const char* pa; const char* pb; };

struct StaticOrder {
    int nM, nN, nwg, G, c;
    __device__ void init(int nM_, int nN_, int G_, int c_) { nM = nM_; nN = nN_; nwg = nM * nN; G = G_; c = c_; }
    __device__ bool next(int i, int& pm, int& pn) const {
        const long L = (long)i * G + c; if (L >= nwg) return false;
        int wgid = (int)L; { const int q = nwg / NXCD, r = nwg % NXCD, xcd = wgid % NXCD, off = wgid / NXCD; wgid = (xcd < r ? xcd * (q + 1) : r * (q + 1) + (xcd - r) * q) + off; }
        const int nig = WGM * nN, gid = wgid / nig, fm = gid * WGM, gsz = (nM - fm) < WGM ? (nM - fm) : WGM;
        pm = fm + ((wgid % nig) % gsz); pn = (wgid % nig) / gsz; return true;
    }
};
struct DenseSched {
    StaticOrder so; const char* A; const char* B; size_t a_tile, b_tile;
    __device__ bool next(int i, Unit& u) const { if (!so.next(i, u.pm, u.pn)) return false; u.pa = A + (size_t)u.pm * a_tile; u.pb = B + (size_t)u.pn * b_tile; return true; }
};

template <class Epi, class Sched>
__device__ __forceinline__ void gemm_phase(LAS unsigned char* lds, const int lda, const int ldb, const int K, const Sched& S, const Epi& E) {
    int tid_ = threadIdx.x; asm volatile("" : "+v"(tid_));
    const int tid = tid_, wid = __builtin_amdgcn_readfirstlane(tid >> 6), lane = tid & 63, wr = wid >> 2, wc = wid & 3, fr = lane & 15, fq = lane >> 4;
    int K_ = K; asm volatile("" : "+s"(K_));
    const int nt = K_ / BK;
    unsigned voffA[2], voffB[2];
#pragma unroll
    for (int i = 0; i < 2; ++i) { int R, C; stage_rc(tid * 16 + i * 8192, R, C); voffA[i] = (unsigned)(R * lda + C) * 2u; voffB[i] = (unsigned)(R * ldb + C) * 2u; }
    const size_t kstep = (size_t)(BK * 2);
    const size_t hstepA = (size_t)HALF * lda * 2, hstepB = (size_t)HALF * ldb * 2;
    const unsigned ldsw = (unsigned)wid * 1024u;
    const int aoff = lds_byte(wr * 64 + fr, fq * 8), boff = lds_byte(wc * 32 + fr, fq * 8);
#define PG8_SA(b, h) (((b) * 2 + (h)) * HTB)
#define PG8_SB(b, h) ((4 + (b) * 2 + (h)) * HTB)
#define PG8_STAGE(bufoff, gbase, voff) do { _Pragma("unroll") for (int _i = 0; _i < 2; ++_i) \
        __builtin_amdgcn_global_load_lds((const unsigned*)((const char*)(gbase) + (voff)[_i]), (LAS unsigned*)(lds + (bufoff) + ldsw + _i * 8192), 16, 0, 0); } while (0)
#define PG8_LDA(dst, b, h) do { _Pragma("unroll") for (int m = 0; m < 4; ++m) _Pragma("unroll") for (int k = 0; k < 2; ++k) dst[m][k] = *(const LAS bf16x8*)(lds + PG8_SA(b, h) + aoff + m * 2048 + k * 1024); } while (0)
#define PG8_LDB(dst, b, h) do { _Pragma("unroll") for (int n = 0; n < 2; ++n) _Pragma("unroll") for (int k = 0; k < 2; ++k) dst[n][k] = *(const LAS bf16x8*)(lds + PG8_SB(b, h) + boff + n * 2048 + k * 1024); } while (0)
#define PG8_MMA(ai, bj, At, Bt) do { __builtin_amdgcn_s_setprio(1); _Pragma("unroll") for (int m = 0; m < 4; ++m) _Pragma("unroll") for (int n = 0; n < 2; ++n) _Pragma("unroll") for (int k = 0; k < 2; ++k) \
        acc[ai][bj][m][n] = __builtin_amdgcn_mfma_f32_16x16x32_bf16(Bt[n][k], At[m][k], acc[ai][bj][m][n], 0, 0, 0); __builtin_amdgcn_s_setprio(0); } while (0)
#define PG8_WAIT_V(n) asm volatile("s_waitcnt vmcnt(" #n ")" ::: "memory")
#define PG8_WAIT_L(n) asm volatile("s_waitcnt lgkmcnt(" #n ")" ::: "memory")
#define PG8_BAR __builtin_amdgcn_s_barrier()
#define PG8_SCHED __builtin_amdgcn_sched_barrier(0)
    Unit cur, nxt; int ui = 0;
    if (!S.next(0, cur)) return;
    f32x4 acc[2][2][4][2];
#pragma unroll
    for (int a = 0; a < 2; ++a)
#pragma unroll
        for (int b = 0; b < 2; ++b)
#pragma unroll
            for (int m = 0; m < 4; ++m)
#pragma unroll
                for (int n = 0; n < 2; ++n) acc[a][b][m][n] = (f32x4){0.f, 0.f, 0.f, 0.f};
    bf16x8 At[4][2], B0[2][2], B1[2][2];
    const char* cA = cur.pa; const char* cB = cur.pb;
    PG8_STAGE(PG8_SB(0, 0), cB, voffB); PG8_STAGE(PG8_SB(0, 1), cB + hstepB, voffB); PG8_STAGE(PG8_SA(0, 0), cA, voffA); PG8_STAGE(PG8_SA(0, 1), cA + hstepA, voffA);
    if (wr == 1) PG8_BAR;
    PG8_WAIT_V(2); PG8_BAR;
    PG8_STAGE(PG8_SB(1, 0), cB + kstep, voffB); PG8_STAGE(PG8_SA(1, 0), cA + kstep, voffA); PG8_STAGE(PG8_SB(1, 1), cB + hstepB + kstep, voffB);
    PG8_WAIT_V(6); PG8_BAR;
    for (;;) {
        const bool has_next = S.next(ui + 1, nxt);
        const char* nA = has_next ? nxt.pa : cA; const char* nB = has_next ? nxt.pb : cB;
        for (int t = 0; t < nt; t += 2) {
            const bool last = (t == nt - 2);
            const char* a1 = cA + (size_t)(t + 1) * kstep;
            const char* a2 = last ? nA : cA + (size_t)(t + 2) * kstep; const char* b2 = last ? nB : cB + (size_t)(t + 2) * kstep;
            const char* a3 = a2 + kstep; const char* b3 = b2 + kstep;
            PG8_LDB(B0, 0, 0); PG8_LDB(B1, 0, 1); PG8_SCHED; PG8_LDA(At, 0, 0); PG8_STAGE(PG8_SA(1, 1), a1 + hstepA, voffA);
            PG8_WAIT_V(8); PG8_WAIT_L(0); PG8_BAR; PG8_MMA(0, 0, At, B0); PG8_MMA(0, 1, At, B1); PG8_BAR; PG8_SCHED;
            PG8_LDA(At, 0, 1); PG8_STAGE(PG8_SB(0, 0), b2, voffB); PG8_STAGE(PG8_SB(0, 1), b2 + hstepB, voffB); PG8_STAGE(PG8_SA(0, 0), a2, voffA);
            PG8_WAIT_V(8); PG8_WAIT_L(0); PG8_BAR; PG8_MMA(1, 0, At, B0); PG8_MMA(1, 1, At, B1); PG8_BAR; PG8_SCHED;
            PG8_LDB(B0, 1, 0); PG8_LDB(B1, 1, 1); PG8_SCHED; PG8_LDA(At, 1, 0); PG8_STAGE(PG8_SA(0, 1), a2 + hstepA, voffA);
            PG8_WAIT_V(8); PG8_WAIT_L(0); PG8_BAR; PG8_MMA(0, 0, At, B0); PG8_MMA(0, 1, At, B1); PG8_BAR; PG8_SCHED;
            PG8_LDA(At, 1, 1); PG8_STAGE(PG8_SB(1, 0), b3, voffB); PG8_STAGE(PG8_SB(1, 1), b3 + hstepB, voffB); PG8_STAGE(PG8_SA(1, 0), a3, voffA);
            PG8_WAIT_V(8); PG8_WAIT_L(0); PG8_BAR; PG8_MMA(1, 0, At, B0); PG8_MMA(1, 1, At, B1); PG8_BAR; PG8_SCHED;
        }
        if (wr == 0) PG8_BAR;
        E(acc, cur, wr, wc, fr, fq);
        if (!has_next) break;
#pragma unroll
        for (int a = 0; a < 2; ++a)
#pragma unroll
            for (int b = 0; b < 2; ++b)
#pragma unroll
                for (int m = 0; m < 4; ++m)
#pragma unroll
                    for (int n = 0; n < 2; ++n) acc[a][b][m][n] = (f32x4){0.f, 0.f, 0.f, 0.f};
        cur = nxt; cA = nA; cB = nB; ++ui;
        if (wr == 1) PG8_BAR;
    }
    PG8_WAIT_V(0);
    PG8_BAR;
#undef PG8_SA
#undef PG8_SB
#undef PG8_STAGE
#undef PG8_LDA
#undef PG8_LDB
#undef PG8_MMA
#undef PG8_WAIT_V
#undef PG8_WAIT_L
#undef PG8_BAR
#undef PG8_SCHED
}
}

#define EPI_ROW(u, ai, m) ((u).pm * 256 + (ai) * 128 + wr * 64 + (m) * 16 + fr)
#define EPI_COL(u, bj, n) ((u).pn * 256 + (bj) * 128 + wc * 32 + (n) * 16 + fq * 4)
typedef f32x4 Acc[2][2][4][2];

__device__ __forceinline__ u32x2 pack4(f32x4 v) { u32x2 w; w.x = cvt_pk(v[0], v[1]); w.y = cvt_pk(v[2], v[3]); return w; }
__device__ __forceinline__ f32x4 unpack4(u32x2 w) { f32x4 v; v[0] = bf2f(w.x & 0xffffu); v[1] = bf2f(w.x >> 16); v[2] = bf2f(w.y & 0xffffu); v[3] = bf2f(w.y >> 16); return v; }

template <bool WT> struct EpiInT {
    bf16_t* U; float* misc; const float* ss;
    __device__ __forceinline__ void st8(void* p, u32x2 v) const {
        if (WT) __hip_atomic_store((unsigned long long*)p, ((unsigned long long)v.y << 32) | v.x, RLX_AGENT); else *(u32x2*)p = v;
    }
    __device__ __forceinline__ void operator()(const Acc& acc, const pg8::Unit& u, int wr, int wc, int fr, int fq) const {
#pragma unroll
        for (int ai = 0; ai < 2; ++ai)
#pragma unroll
            for (int m = 0; m < 4; ++m) {
                const int row = EPI_ROW(u, ai, m); const float rs = rstd_of(ss, row);
                if (u.pn < 21) {
#pragma unroll
                    for (int bj = 0; bj < 2; ++bj)
#pragma unroll
                        for (int n = 0; n < 2; ++n) st8(U + (size_t)row * UW + EPI_COL(u, bj, n), pack4(acc[ai][bj][m][n] * rs));
                } else if (wc == 0) {
#pragma unroll
                    for (int n = 0; n < 2; ++n) { const f32x4 v = acc[ai][0][m][n] * rs; float* mp = misc + (size_t)row * 32 + n * 16 + fq * 4;
                        st8(mp, (u32x2){__float_as_uint(v[0]), __float_as_uint(v[1])}); st8(mp + 2, (u32x2){__float_as_uint(v[2]), __float_as_uint(v[3])}); }
                }
            }
    }
};
typedef EpiInT<false> EpiIn;
struct EpiGates {
    bf16_t* G; const float* ss;
    __device__ __forceinline__ void operator()(const Acc& acc, const pg8::Unit& u, int wr, int wc, int fr, int fq) const {
#pragma unroll
        for (int ai = 0; ai < 2; ++ai)
#pragma unroll
            for (int m = 0; m < 4; ++m) {
                const int row = EPI_ROW(u, ai, m); const float rs = rstd_of(ss, row);
#pragma unroll
                for (int bj = 0; bj < 2; ++bj)
#pragma unroll
                    for (int n = 0; n < 2; ++n) { f32x4 v = acc[ai][bj][m][n] * rs; v[0] = sigmoidf_(v[0]); v[1] = sigmoidf_(v[1]); v[2] = sigmoidf_(v[2]); v[3] = sigmoidf_(v[3]);
                        *(u32x2*)(G + (size_t)row * 4096 + EPI_COL(u, bj, n)) = pack4(v); }
            }
    }
};
struct EpiBrAll {
    bf16_t* MG; const bf16_t* G;
    __device__ __forceinline__ void operator()(const Acc& acc, const pg8::Unit& u, int wr, int wc, int fr, int fq) const {
        const int mb = u.pn >> 8, pn = u.pn & 255;
        if (mb > 0) asm volatile("s_waitcnt vmcnt(0)" ::: "memory");
#pragma unroll
        for (int ai = 0; ai < 2; ++ai)
#pragma unroll
            for (int m = 0; m < 4; ++m) {
                const int row = u.pm * 256 + ai * 128 + wr * 64 + m * 16 + fr;
#pragma unroll
                for (int bj = 0; bj < 2; ++bj)
#pragma unroll
                    for (int n = 0; n < 2; ++n) { const int col = pn * 256 + bj * 128 + wc * 32 + n * 16 + fq * 4;
                        const f32x4 g = unpack4(*(const u32x2*)(G + (size_t)row * 4096 + mb * 1024 + col));
                        f32x4 v = acc[ai][bj][m][n] * g;
                        bf16_t* mp = MG + (size_t)row * DM + col;
                        if (mb > 0) v += unpack4(ld_agent_u64(mp));
                        *(u32x2*)mp = pack4(v); }
                asm volatile("" ::: "memory");
            }
    }
};
template <bool WRITE_XB, bool ACC_SS> struct EpiRes {
    const float* xin; float* xo; bf16_t* xb; float* ss;
    __device__ __forceinline__ void operator()(const Acc& acc, const pg8::Unit& u, int wr, int wc, int fr, int fq) const {
#pragma unroll
        for (int ai = 0; ai < 2; ++ai)
#pragma unroll
            for (int m = 0; m < 4; ++m) {
                const int row = EPI_ROW(u, ai, m); float s = 0.f;
#pragma unroll
                for (int bj = 0; bj < 2; ++bj)
#pragma unroll
                    for (int n = 0; n < 2; ++n) { const size_t off = (size_t)row * DM + EPI_COL(u, bj, n);
                        const f32x4 v = *(const f32x4*)(xin + off) + acc[ai][bj][m][n];
                        *(f32x4*)(xo + off) = v;
                        if (WRITE_XB) *(u32x2*)(xb + off) = pack4(v);
                        if (ACC_SS) s += (v[0] * v[0] + v[1] * v[1]) + (v[2] * v[2] + v[3] * v[3]); }
                if (ACC_SS) { s += __shfl_xor(s, 16); s += __shfl_xor(s, 32); if (fq == 0) ss[(size_t)row * 16 + u.pn * 4 + wc] = s; }
                asm volatile("" ::: "memory");
            }
    }
};
template <bool MOE> struct EpiFfn1 {
    bf16_t* ACT; const float* ss;
    __device__ __forceinline__ void operator()(const Acc& acc, const pg8::Unit& u, int wr, int wc, int fr, int fq) const {
#pragma unroll
        for (int ai = 0; ai < 2; ++ai)
#pragma unroll
            for (int m = 0; m < 4; ++m) {
                const int row = EPI_ROW(u, ai, m); const float rs = MOE ? ss[row] : rstd_of(ss, row);
#pragma unroll
                for (int n = 0; n < 2; ++n) { const f32x4 g = acc[ai][0][m][n] * rs, up = acc[ai][1][m][n] * rs; f32x4 v;
                    v[0] = siluf_(g[0]) * up[0]; v[1] = siluf_(g[1]) * up[1]; v[2] = siluf_(g[2]) * up[2]; v[3] = siluf_(g[3]) * up[3];
                    *(u32x2*)(ACT + (size_t)row * D_FF + u.pn * 128 + wc * 32 + n * 16 + fq * 4) = pack4(v); }
            }
    }
};
template <bool SIG> struct EpiBf16 {
    bf16_t* O;
    __device__ __forceinline__ void operator()(const Acc& acc, const pg8::Unit& u, int wr, int wc, int fr, int fq) const {
#pragma unroll
        for (int ai = 0; ai < 2; ++ai)
#pragma unroll
            for (int m = 0; m < 4; ++m) {
                const int row = EPI_ROW(u, ai, m);
#pragma unroll
                for (int bj = 0; bj < 2; ++bj)
#pragma unroll
                    for (int n = 0; n < 2; ++n) { f32x4 v = acc[ai][bj][m][n];
                        if (SIG) { v[0] = sigmoidf_(v[0]); v[1] = sigmoidf_(v[1]); v[2] = sigmoidf_(v[2]); v[3] = sigmoidf_(v[3]); }
                        *(u32x2*)(O + (size_t)row * DM + EPI_COL(u, bj, n)) = pack4(v); }
            }
    }
};
template <bool WRITE_XB> struct EpiPle2 {
    float* xo; const bf16_t* G; bf16_t* xb; float* ss;
    __device__ __forceinline__ void operator()(const Acc& acc, const pg8::Unit& u, int wr, int wc, int fr, int fq) const {
#pragma unroll
        for (int ai = 0; ai < 2; ++ai)
#pragma unroll
            for (int m = 0; m < 4; ++m) {
                const int row = EPI_ROW(u, ai, m); float s = 0.f;
#pragma unroll
                for (int bj = 0; bj < 2; ++bj)
#pragma unroll
                    for (int n = 0; n < 2; ++n) { const size_t off = (size_t)row * DM + EPI_COL(u, bj, n);
                        const f32x4 g = unpack4(ld_agent_u64(G + off));
                        const f32x4 v = *(const f32x4*)(xo + off) + g * acc[ai][bj][m][n];
                        *(f32x4*)(xo + off) = v;
                        if (WRITE_XB) *(u32x2*)(xb + off) = pack4(v);
                        s += (v[0] * v[0] + v[1] * v[1]) + (v[2] * v[2] + v[3] * v[3]); }
                s += __shfl_xor(s, 16); s += __shfl_xor(s, 32); if (fq == 0) ss[(size_t)row * 16 + u.pn * 4 + wc] = s;
                asm volatile("" ::: "memory");
            }
    }
};

struct BatchSched {
    int pm, pn0, n; const char* A; const char* B; size_t a_tile, b_tile;
    __device__ bool next(int i, pg8::Unit& u) const { if (i >= n) return false; u.pm = pm; u.pn = pn0 + i; u.pa = A + (size_t)pm * a_tile; u.pb = B + (size_t)u.pn * b_tile; return true; }
};
struct InBatchSched {
    int pm, kind, i0, n; const char* A; const char* B; size_t a_tile, b_tile;
    __device__ bool next(int ii, pg8::Unit& u) const {
        if (ii >= n) return false;
        const int i = i0 + ii; int pn;
        if (kind == 0) pn = 11 + i;
        else if (kind == 1) pn = i < 6 ? i : 21;
        else pn = i < 5 ? 6 + i : 13 + i;
        u.pm = pm; u.pn = pn; u.pa = A + (size_t)pm * a_tile; u.pb = B + (size_t)pn * b_tile; return true;
    }
};
struct BranchSched {
    pg8::StaticOrder so; const char* Y; const char* PT; size_t a_tile, b_tile, a_br, b_br;
    __device__ bool next(int i, pg8::Unit& u) const {
        if (i >= 4) return false; int pm, pn; if (!so.next(0, pm, pn)) return false;
        u.pm = pm; u.pn = pn | (i << 8); u.pa = Y + (size_t)i * a_br + (size_t)pm * a_tile; u.pb = PT + (size_t)i * b_br + (size_t)pn * b_tile; return true;
    }
};
struct MoeTables { int ps1, ps2, ps3, ps4, ps5, ps6, ps7, ps8; };
__device__ __forceinline__ int moe_expert_of_row(const MoeTables& mt, int row) {
    return (row >= mt.ps1) + (row >= mt.ps2) + (row >= mt.ps3) + (row >= mt.ps4) + (row >= mt.ps5) + (row >= mt.ps6) + (row >= mt.ps7);
}
struct MoeSched {
    MoeTables mt; int nN, G, c; const char* A; const char* B; size_t a_tile, b_tile, b_expert;
    __device__ bool next(int i, pg8::Unit& u) const {
        const long L = (long)i * G + c; const int ntiles = mt.ps8 >> 8;
        if (L >= (long)ntiles * nN) return false;
        u.pm = (int)(L / nN); u.pn = (int)(L % nN);
        const int e = moe_expert_of_row(mt, u.pm * 256);
        u.pa = A + (size_t)u.pm * a_tile; u.pb = B + (size_t)e * b_expert + (size_t)u.pn * b_tile; return true;
    }
};

struct Args { const void* in[42]; float* out; unsigned char* ws; int ph_lo, ph_hi; };
typedef const __attribute__((address_space(4))) Args* KArgs;
__device__ __forceinline__ KArgs kargs() { KArgs p = (KArgs)__builtin_amdgcn_kernarg_segment_ptr(); asm volatile("" : "+s"(p)); return p; }
struct Frame {
    LAS unsigned char* lds; int tid, lane, wave, G, bid;
    unsigned char* ws; unsigned* ctl;
};
#define IN_F(k) ((const float*)KA->in[k])

constexpr int DEFER_ITEMS = 3472 + 16896;
struct TJob { const float* src; int ldw, K, ncols, ldt, mode; bf16_t* dst; const float* gain; };
__device__ __forceinline__ void tr_item(const TJob& J, LAS float* scr, int item, int lane) {
    const int nblk = J.ncols / 64, kb = item / nblk, nb = item % nblk, k0 = 64 * kb, n0 = 64 * nb;
    const int c = lane;
    const bool live = (J.mode != 3) || c < 32;
    const int scol = (J.mode == 3) ? (c < 8 ? 1536 + c : (c < 32 ? 2816 + c : 0)) : n0 + c;
    const float* sp = J.src + (size_t)k0 * J.ldw + scol;
    float v[64];
#pragma unroll
    for (int i = 0; i < 64; ++i) v[i] = sp[(size_t)i * J.ldw];
#pragma unroll
    for (int i = 0; i < 64; ++i) { float x = live ? v[i] : 0.f; if (J.gain) x *= J.gain[k0 + i]; scr[i * 65 + c] = x; }
    asm volatile("s_waitcnt lgkmcnt(0)" ::: "memory");
    int drow0 = n0;
    if (J.mode == 1 || J.mode == 2) drow0 = (n0 / 128) * 256 + (n0 % 128) + (J.mode == 2 ? 128 : 0);
    const int c8 = lane & 7;
#pragma unroll
    for (int j = 0; j < 8; ++j) { const int n = (lane >> 3) + 8 * j; const LAS float* sq = scr + (8 * c8) * 65 + n;
        u32x4 o; o.x = cvt_pk(sq[0 * 65], sq[1 * 65]); o.y = cvt_pk(sq[2 * 65], sq[3 * 65]); o.z = cvt_pk(sq[4 * 65], sq[5 * 65]); o.w = cvt_pk(sq[6 * 65], sq[7 * 65]);
        *(u32x4*)(J.dst + (size_t)(drow0 + n) * J.ldt + k0 + 8 * c8) = o; }
    asm volatile("s_waitcnt lgkmcnt(0)" ::: "memory");
}
constexpr int NJOBS = 32 + 3 + 24 + 8;
__device__ __forceinline__ bool job_deferred(int jid) { return (jid >= 16 && jid < 32) || (jid >= 35 && jid < 59); }
__device__ __forceinline__ bool get_job(KArgs KA, int jid, TJob& J) {
    unsigned char* ws = KA->ws;
    J.gain = nullptr; J.mode = 0;
    if (jid < 32) {
        const int L = jid >> 4, j = jid & 15;
        unsigned char* wa = ws + WS_WA + (size_t)L * WA_STRIDE;
        if (j <= 8) {
            const float* w = IN_F(4) + (size_t)L * DM * D_IN; J.ldw = D_IN; J.K = DM; J.ldt = DM; J.gain = IN_F(3) + L * DM;
            int sc, nc, dr;
            switch (j) { case 0: sc = 0; nc = 512; dr = 0; break; case 1: sc = 512; nc = 1024; dr = 512; break; case 2: sc = 1544; nc = 512; dr = 1536; break;
                case 3: sc = 2056; nc = 768; dr = 2048; break; case 4: sc = 2848; nc = 1792; dr = 2816; break; case 5: sc = 4640; nc = 512; dr = 4608; break;
                case 6: sc = 5152; nc = 256; dr = 5120; break; case 7: sc = 0; nc = 64; dr = 5376; J.mode = 3; break; default: sc = 5408; nc = 4096; dr = 0; break; }
            J.src = w + sc; J.ncols = nc; J.dst = (bf16_t*)(wa + (j == 8 ? WA_GATE : WA_IN)) + (size_t)dr * DM;
            return true;
        }
        if (j <= 12) { const int m = j - 9; J.src = IN_F(26 + m) + (size_t)L * 512 * DM; J.ldw = DM; J.K = 512; J.ncols = DM; J.ldt = 512; J.dst = (bf16_t*)(wa + WA_PT + (size_t)m * MiB); return true; }
        if (j == 13) { J.src = IN_F(30) + (size_t)L * DM * DM; J.ldw = DM; J.K = DM; J.ncols = DM; J.ldt = DM; J.dst = (bf16_t*)(wa + WA_OUT); return true; }
        if (j == 14) { J.src = IN_F(40) + (size_t)L * DM * DM; J.ldw = DM; J.K = DM; J.ncols = DM; J.ldt = DM; J.dst = (bf16_t*)(wa + WA_PG); return true; }
        J.src = IN_F(39) + (size_t)L * PLE * DM; J.ldw = DM; J.K = PLE; J.ncols = DM; J.ldt = PLE; J.dst = (bf16_t*)(wa + WA_PP); return true;
    }
    if (jid < 35) {
        const int j = jid - 32;
        if (j < 2) { J.src = IN_F(32 + j); J.ldw = D_FF; J.K = DM; J.ncols = D_FF; J.ldt = DM; J.gain = IN_F(31); J.mode = 1 + j; J.dst = (bf16_t*)(ws + WS_FGU); return true; }
        J.src = IN_F(34); J.ldw = DM; J.K = D_FF; J.ncols = DM; J.ldt = D_FF; J.dst = (bf16_t*)(ws + WS_FDN); return true;
    }
    if (jid < 59) {
        const int e = (jid - 35) / 3, j = (jid - 35) % 3;
        unsigned char* wb = ws + WS_WB + (size_t)e * WB_STRIDE;
        if (j < 2) { J.src = IN_F(36 + j) + (size_t)e * DM * D_FF; J.ldw = D_FF; J.K = DM; J.ncols = D_FF; J.ldt = DM; J.gain = IN_F(31) + DM; J.mode = 1 + j; J.dst = (bf16_t*)wb; return true; }
        J.src = IN_F(38) + (size_t)e * D_FF * DM; J.ldw = DM; J.K = D_FF; J.ncols = DM; J.ldt = D_FF; J.dst = (bf16_t*)(wb + WB_DN); return true;
    }
    {
        const int j = jid - 59, idx = j & 3;
        if (j < 4) { J.src = IN_F(12) + (size_t)idx * 2048 * 64; J.ldw = 64; J.K = 2048; J.ncols = 64; J.ldt = 2048; J.dst = (bf16_t*)(ws + WS_W1T) + (size_t)idx * 64 * 2048; return true; }
        J.src = IN_F(13) + (size_t)idx * 64 * 64; J.ldw = 64; J.K = 64; J.ncols = 64; J.ldt = 64; J.dst = (bf16_t*)(ws + WS_W2T) + (size_t)idx * 64 * 64; return true;
    }
}
__device__ UNIT_INLINE void p0_prologue(KArgs KA, Frame& F) {
    LAS float* scr = (LAS float*)(F.lds + F.wave * 16640);
    const int gw = F.bid * 8 + F.wave, NGW = F.G * 8;
    unsigned char* ws = KA->ws;
    {
        int jid = 0, loc = gw; TJob J; get_job(KA, 0, J); int nit = (J.K / 64) * (J.ncols / 64);
        for (;;) {
            while (jid < NJOBS && loc >= nit) { loc -= nit; ++jid; if (jid < NJOBS) { get_job(KA, jid, J); nit = job_deferred(jid) ? 0 : (J.K / 64) * (J.ncols / 64); } }
            if (jid >= NJOBS) break;
            tr_item(J, scr, loc, F.lane);
            loc += NGW;
        }
    }
    for (int L = 0; L < 2; ++L) {
        u32x4* z = (u32x4*)((bf16_t*)(ws + WS_WA + (size_t)L * WA_STRIDE + WA_IN) + (size_t)5440 * DM);
        const int n16 = 192 * DM * 2 / 16;
        for (int i = gw * 64 + F.lane; i < n16; i += NGW * 64) z[i] = (u32x4){0u, 0u, 0u, 0u};
    }
    for (int o = gw; o < 256; o += NGW) {
        const int idx = o >> 6, f = o & 63;
        const float* pe = IN_F(11) + (size_t)idx * 2048; const float* w1 = IN_F(12) + (size_t)idx * 2048 * 64 + f; float s = 0.f;
#pragma unroll 8
        for (int k = F.lane; k < 2048; k += 64) s += pe[k] * w1[(size_t)k * 64];
        s = wave_sum(s);
        if (F.lane == 0) ((float*)(ws + WS_PEB))[o] = s;
    }
    for (int i = gw * 64 + F.lane; i < 2 * 8 * 4 * 8 * 64; i += NGW * 64) {
        const int ln = i & 63, fr = (i >> 6) & 7, nt = (i >> 9) & 3, hh = (i >> 11) & 7, LL = i >> 14;
        const int cn = hh * 64 + 16 * nt + (ln & 15), kgl = ln >> 4;
        const float* W = (fr < 2) ? IN_F(16) + (size_t)LL * 64 * 512 : (fr < 4) ? IN_F(18) + (size_t)LL * 64 * 512 : IN_F(19) + (size_t)LL * 128 * 512;
        const int ks = (fr < 2) ? fr : (fr < 4) ? fr - 2 : fr - 4;
        u32x4 o;
#pragma unroll
        for (int j = 0; j < 4; ++j) { const int k = 32 * ks + 8 * kgl + 2 * j; o[j] = cvt_pk(W[(size_t)k * 512 + cn], W[(size_t)(k + 1) * 512 + cn]); }
        ((u32x4*)(ws + WS_LW))[i] = o;
    }
    {
        const float* x = IN_F(0); bf16_t* xb = (bf16_t*)(ws + WS_XB); float* ss = (float*)(ws + WS_SSP);
        for (int m = gw; m < T; m += NGW) {
            const f32x4* xr = (const f32x4*)(x + (size_t)m * DM) + F.lane; float s = 0.f;
            u32x2* o = (u32x2*)(xb + (size_t)m * DM) + F.lane;
#pragma unroll
            for (int j = 0; j < 4; ++j) { const f32x4 v = xr[64 * j]; s += (v[0] * v[0] + v[1] * v[1]) + (v[2] * v[2] + v[3] * v[3]); o[64 * j] = pack4(v); }
            s = wave_sum(s); if (F.lane < 16) ss[(size_t)m * 16 + F.lane] = (F.lane == 0) ? s : 0.f;
        }
    }
    {
        const int* pos = (const int*)KA->in[2]; float* rc = (float*)(ws + WS_ROPE); float* rsn = rc + (size_t)T * 32;
        for (int i = (gw * 64 + F.lane); i < T * 32; i += NGW * 64) {
            const int t = i >> 5, k = i & 31;
            const float inv = (float)exp2(-(double)k * (1.0 / 32.0) * 17.194602975157967);
            const float ang = (float)pos[t] * inv;
            rc[i] = cosf(ang); rsn[i] = sinf(ang);
        }
    }
}


__device__ UNIT_INLINE void deferred_convert(KArgs KA, Frame& F, unsigned* q, LAS unsigned* s_uid, int jlo, int jhi, int nitems) {
    LAS float* scr = (LAS float*)(F.lds + F.wave * 16640);
    for (;;) {
        __syncthreads();
        if (F.tid == 0) *s_uid = atomicAdd(q, 1u);
        __syncthreads();
        int loc = (int)*s_uid * 8 + F.wave;
        int jid = jlo; TJob J; bool found = false;
        for (; jid < jhi; ++jid) { if (!job_deferred(jid)) continue; get_job(KA, jid, J); const int nit = (J.K / 64) * (J.ncols / 64); if (loc < nit) { found = true; break; } loc -= nit; }
        if (found) tr_item(J, scr, loc, F.lane);
        if ((int)*s_uid * 8 >= nitems) break;
    }
}


__device__ __forceinline__ void dep_signal(unsigned* c0, unsigned* c1, bool leader) {
    asm volatile("s_waitcnt vmcnt(0)" ::: "memory");
    __syncthreads();
    if (leader) {
        __builtin_amdgcn_fence(__ATOMIC_RELEASE, "agent");
        asm volatile("s_waitcnt vmcnt(0)" ::: "memory");
        __hip_atomic_fetch_add(c0, 1u, __ATOMIC_RELAXED, __HIP_MEMORY_SCOPE_AGENT);
        if (c1) __hip_atomic_fetch_add(c1, 1u, __ATOMIC_RELAXED, __HIP_MEMORY_SCOPE_AGENT);
    }
}
__device__ __forceinline__ void dep_signal_wt(unsigned* c0, unsigned* c1, bool leader) {
    asm volatile("s_waitcnt vmcnt(0)" ::: "memory");
    __syncthreads();
    if (leader) { __hip_atomic_fetch_add(c0, 1u, __ATOMIC_RELAXED, __HIP_MEMORY_SCOPE_AGENT); if (c1) __hip_atomic_fetch_add(c1, 1u, __ATOMIC_RELAXED, __HIP_MEMORY_SCOPE_AGENT); }
}
__device__ __forceinline__ void dep_poll_lane(unsigned* c, unsigned target) {
    unsigned spins = 0;
    while (__hip_atomic_load(c, __ATOMIC_RELAXED, __HIP_MEMORY_SCOPE_AGENT) < target) { __builtin_amdgcn_s_sleep(2); if (++spins > (1u << 24)) break; }
}
__device__ __forceinline__ void dep_wait_lane(unsigned* c, unsigned target) {
    unsigned spins = 0;
    while (__hip_atomic_load(c, __ATOMIC_RELAXED, __HIP_MEMORY_SCOPE_AGENT) < target) { __builtin_amdgcn_s_sleep(2); if (++spins > (1u << 24)) break; }
    __builtin_amdgcn_fence(__ATOMIC_ACQUIRE, "agent");
    asm volatile("s_waitcnt vmcnt(0)" ::: "memory");
}
__device__ __forceinline__ void dep_wait(unsigned* c, unsigned target, bool leader) {
    if (leader) dep_poll_lane(c, target);
    __syncthreads();
}

__device__ UNIT_INLINE void rope_pass(Frame& F, bf16_t* U1, const float* rc, const float* rsn) {
    const int gt = F.bid * 512 + F.tid, NT = F.G * 512;
    for (int i = gt; i < T * 40; i += NT) {
        const int t = i / 40, r = i % 40, slot = r >> 2, ch = r & 3;
        bf16_t* base = U1 + (size_t)t * UW + (slot < 8 ? UC_SQ + slot * 64 : UC_SKV + (slot - 8) * 64) + ch * 8;
        const u32x4 a = *(const u32x4*)base, b = *(const u32x4*)(base + 32);
        const f32x4 c0 = *(const f32x4*)(rc + (size_t)t * 32 + ch * 8), c1 = *(const f32x4*)(rc + (size_t)t * 32 + ch * 8 + 4);
        const f32x4 s0 = *(const f32x4*)(rsn + (size_t)t * 32 + ch * 8), s1 = *(const f32x4*)(rsn + (size_t)t * 32 + ch * 8 + 4);
        float x1[8], x2[8], cs[8], sn[8];
#pragma unroll
        for (int j = 0; j < 4; ++j) { x1[2 * j] = bf2f(a[j] & 0xffffu); x1[2 * j + 1] = bf2f(a[j] >> 16); x2[2 * j] = bf2f(b[j] & 0xffffu); x2[2 * j + 1] = bf2f(b[j] >> 16);
            cs[j] = c0[j]; cs[4 + j] = c1[j]; sn[j] = s0[j]; sn[4 + j] = s1[j]; }
        u32x4 oa, ob;
#pragma unroll
        for (int j = 0; j < 4; ++j) {
            const float y1a = x1[2 * j] * cs[2 * j] - x2[2 * j] * sn[2 * j], y1b = x1[2 * j + 1] * cs[2 * j + 1] - x2[2 * j + 1] * sn[2 * j + 1];
            const float y2a = x2[2 * j] * cs[2 * j] + x1[2 * j] * sn[2 * j], y2b = x2[2 * j + 1] * cs[2 * j + 1] + x1[2 * j + 1] * sn[2 * j + 1];
            oa[j] = cvt_pk(y1a, y1b); ob[j] = cvt_pk(y2a, y2b);
        }
        *(u32x4*)base = oa; *(u32x4*)(base + 32) = ob;
    }
}
__device__ UNIT_INLINE void rope_slice(Frame& F, bf16_t* U1, const float* rc, const float* rsn, int slice) {
    for (int i = slice * 5120 + F.tid; i < (slice + 1) * 5120; i += 512) {
        const int t = i / 40, r = i % 40, slot = r >> 2, ch = r & 3;
        bf16_t* base = U1 + (size_t)t * UW + (slot < 8 ? UC_SQ + slot * 64 : UC_SKV + (slot - 8) * 64) + ch * 8;
        const u32x4 a = *(const u32x4*)base, b = *(const u32x4*)(base + 32);
        const f32x4 c0 = *(const f32x4*)(rc + (size_t)t * 32 + ch * 8), c1 = *(const f32x4*)(rc + (size_t)t * 32 + ch * 8 + 4);
        const f32x4 s0 = *(const f32x4*)(rsn + (size_t)t * 32 + ch * 8), s1 = *(const f32x4*)(rsn + (size_t)t * 32 + ch * 8 + 4);
        u32x4 oa, ob;
#pragma unroll
        for (int j = 0; j < 4; ++j) {
            const float xa = bf2f(a[j] & 0xffffu), xb = bf2f(a[j] >> 16), ya = bf2f(b[j] & 0xffffu), yb = bf2f(b[j] >> 16);
            const float ca = j < 2 ? c0[2 * j] : c1[2 * j - 4], cb = j < 2 ? c0[2 * j + 1] : c1[2 * j - 3], sa = j < 2 ? s0[2 * j] : s1[2 * j - 4], sb = j < 2 ? s0[2 * j + 1] : s1[2 * j - 3];
            oa[j] = cvt_pk(xa * ca - ya * sa, xb * cb - yb * sb); ob[j] = cvt_pk(ya * ca + xa * sa, yb * cb + xb * sb);
        }
        *(u32x4*)base = oa; *(u32x4*)(base + 32) = ob;
    }
}
__device__ UNIT_INLINE void compress_unit(Frame& F, int unit, int L, const bf16_t* U1, unsigned char* ws) {
    const int nc = unit & 3, kv = (unit >> 2) & 1, g = (unit >> 3) & 1, b = unit >> 4;
    const int n0 = nc * 32, tok0 = n0 * 16;
    LAS bf16_t* tok = (LAS bf16_t*)F.lds;
    LAS bf16_t* hid = (LAS bf16_t*)(F.lds + 528 * 72 * 2);
    const bf16_t* src = U1 + (size_t)(b * SEQ) * UW + UC_NKV + kv * 128 + g * 64;
    __syncthreads();
    for (int i = F.tid; i < 528 * 8; i += 512) { const int r = i >> 3, ch = i & 7; const int t = tok0 + r;
        u32x4 v = (u32x4){0u, 0u, 0u, 0u}; if (t < SEQ) v = *(const u32x4*)(src + (size_t)t * UW + ch * 8);
        *(LAS u32x4*)(tok + r * 72 + ch * 8) = v; }
    __syncthreads();
    const int idx = L * 2 + kv;
    const bf16_t* w1t = (const bf16_t*)(ws + WS_W1T) + (size_t)idx * 64 * 2048;
    const bf16_t* w2t = (const bf16_t*)(ws + WS_W2T) + (size_t)idx * 64 * 64;
    const float* peb = (const float*)(ws + WS_PEB) + idx * 64;
    const int mt = F.wave >> 2, ntile = F.wave & 3, r16 = F.lane & 15, kg = F.lane >> 4;
    f32x4 acc = (f32x4){0.f, 0.f, 0.f, 0.f};
    const int nl = mt * 16 + r16;
    const bf16_t* bp = w1t + (size_t)(ntile * 16 + r16) * 2048 + kg * 8;
#pragma unroll 4
    for (int ks = 0; ks < 64; ++ks) {
        const int l = ks >> 1, db = (ks & 1) * 32 + kg * 8;
        const bf16x8 a = *(const LAS bf16x8*)(tok + (16 * nl + l) * 72 + db);
        const bf16x8 bb = *(const bf16x8*)(bp + ks * 32);
        acc = __builtin_amdgcn_mfma_f32_16x16x32_bf16(a, bb, acc, 0, 0, 0);
    }
    { const int f = ntile * 16 + r16; const float pb = peb[f];
#pragma unroll
      for (int r = 0; r < 4; ++r) hid[(mt * 16 + 4 * kg + r) * 72 + f] = (bf16_t)f2bf(siluf_(acc[r] + pb)); }
    __syncthreads();
    f32x4 o = (f32x4){0.f, 0.f, 0.f, 0.f};
#pragma unroll
    for (int ks = 0; ks < 2; ++ks) {
        const bf16x8 a = *(const LAS bf16x8*)(hid + nl * 72 + ks * 32 + kg * 8);
        const bf16x8 bb = *(const bf16x8*)(w2t + (size_t)(ntile * 16 + r16) * 64 + ks * 32 + kg * 8);
        o = __builtin_amdgcn_mfma_f32_16x16x32_bf16(a, bb, o, 0, 0, 0);
    }
    bf16_t* dst = (bf16_t*)(ws + (kv ? WS_VC : WS_KC)) + (size_t)((b * 2 + g) * 128) * 64;
#pragma unroll
    for (int r = 0; r < 4; ++r) { const int n = n0 + mt * 16 + 4 * kg + r; dst[(size_t)n * 64 + ntile * 16 + r16] = (n < 127) ? (bf16_t)f2bf(o[r]) : (bf16_t)0; }
}

__device__ __forceinline__ int crow(int r, int hi) { return (r & 3) + 8 * (r >> 2) + 4 * hi; }
constexpr int KS_LD = 72;
struct AttnSt { float m, l; f32x16 o0, o1; };
__device__ __forceinline__ void attn_init(AttnSt& s) { s.m = -INFINITY; s.l = 0.f;
#pragma unroll
    for (int r = 0; r < 16; ++r) { s.o0[r] = 0.f; s.o1[r] = 0.f; } }
constexpr int TILE_EL = 64 * 64;
__device__ __forceinline__ void dma_kv(const bf16_t* Kg, int ldk, const bf16_t* Vg, int ldv, LAS bf16_t* Ks, LAS bf16_t* Vs, int wave, int lane) {
    const int key = 8 * wave + (lane >> 3), ch = (lane & 7) ^ (key & 7);
    __builtin_amdgcn_global_load_lds((const unsigned*)(Kg + (size_t)key * ldk + ch * 8), (LAS unsigned*)(Ks + wave * 512), 16, 0, 0);
    __builtin_amdgcn_global_load_lds((const unsigned*)(Vg + (size_t)key * ldv + ch * 8), (LAS unsigned*)(Vs + wave * 512), 16, 0, 0);
}
__device__ __forceinline__ int swz_el(int key, int chunk) { return key * 64 + ((chunk ^ (key & 7)) << 3); }
__device__ __forceinline__ void attn_scores(const LAS bf16_t* Ks, const bf16x8 (&qr)[4], f32x16& p0, f32x16& p1, int r32, int hi) {
#pragma unroll
    for (int r = 0; r < 16; ++r) { p0[r] = 0.f; p1[r] = 0.f; }
#pragma unroll
    for (int d0 = 0; d0 < 4; ++d0) {
        const bf16x8 k0 = *(const LAS bf16x8*)(Ks + swz_el(r32, 2 * d0 + hi));
        const bf16x8 k1 = *(const LAS bf16x8*)(Ks + swz_el(32 + r32, 2 * d0 + hi));
        p0 = __builtin_amdgcn_mfma_f32_32x32x16_bf16(k0, qr[d0], p0, 0, 0, 0);
        p1 = __builtin_amdgcn_mfma_f32_32x32x16_bf16(k1, qr[d0], p1, 0, 0, 0);
    }
}
typedef short v4i16_t __attribute__((ext_vector_type(4)));
__device__ __forceinline__ void attn_pv(const LAS bf16_t* Vs, const f32x16& p0, const f32x16& p1, f32x16& o0, f32x16& o1, int r32, int hi) {
    bf16x8 pa[4];
#pragma unroll
    for (int s = 0; s < 2; ++s) {
        u32x4 w0, w1;
#pragma unroll
        for (int j = 0; j < 4; ++j) { w0[j] = cvt_pk(p0[8 * s + 2 * j], p0[8 * s + 2 * j + 1]); w1[j] = cvt_pk(p1[8 * s + 2 * j], p1[8 * s + 2 * j + 1]); }
        pa[s] = __builtin_bit_cast(bf16x8, w0); pa[2 + s] = __builtin_bit_cast(bf16x8, w1);
    }
    const int lane = hi * 32 + r32;
    const int krow = 4 * hi + ((lane & 15) >> 2), cb = 2 * ((lane >> 4) & 1) + ((lane & 3) >> 1), sub = 4 * (lane & 1);
#pragma unroll
    for (int s = 0; s < 4; ++s) {
#pragma unroll
        for (int dh = 0; dh < 2; ++dh) {
            const int k0 = 16 * s + krow, k1 = k0 + 8;
            const s16x4 lo = __builtin_bit_cast(s16x4, __builtin_amdgcn_ds_read_tr16_b64_v4i16((LAS v4i16_t*)(Vs + swz_el(k0, 4 * dh + cb) + sub)));
            const s16x4 hi4 = __builtin_bit_cast(s16x4, __builtin_amdgcn_ds_read_tr16_b64_v4i16((LAS v4i16_t*)(Vs + swz_el(k1, 4 * dh + cb) + sub)));
            const bf16x8 vfr = (bf16x8){lo[0], lo[1], lo[2], lo[3], hi4[0], hi4[1], hi4[2], hi4[3]};
            if (dh == 0) o0 = __builtin_amdgcn_mfma_f32_32x32x16_bf16(pa[s], vfr, o0, 0, 0, 0);
            else         o1 = __builtin_amdgcn_mfma_f32_32x32x16_bf16(pa[s], vfr, o1, 0, 0, 0);
        }
    }
}
__device__ __forceinline__ void attn_online(const LAS bf16_t* Vt, f32x16& x0, f32x16& x1, AttnSt& st, LAS float* wsf, int r32, int hi) {
    float mx = -INFINITY;
#pragma unroll
    for (int r = 0; r < 16; ++r) mx = fmaxf(mx, fmaxf(x0[r], x1[r]));
    mx = fmaxf(mx, __shfl_xor(mx, 32));
    const float mn = fmaxf(st.m, mx), ms = (mn == -INFINITY) ? 0.f : mn;
    const float f = exp2f((st.m - ms) * LOG2E);
    if (hi == 0) wsf[r32] = f;
    float rs = 0.f;
#pragma unroll
    for (int r = 0; r < 16; ++r) { x0[r] = exp2f((x0[r] - ms) * LOG2E); x1[r] = exp2f((x1[r] - ms) * LOG2E); rs += x0[r] + x1[r]; }
    st.l = st.l * f + rs; st.m = mn;
    const LAS float* wr_ = wsf + 4 * hi;
#pragma unroll
    for (int r = 0; r < 16; ++r) { const float fr_ = wr_[(r & 3) + 8 * (r >> 2)]; st.o0[r] *= fr_; st.o1[r] *= fr_; }
    attn_pv(Vt, x0, x1, st.o0, st.o1, r32, hi);
}
constexpr float SC_L2 = 0.125f * LOG2E, TAU_RAW = 32.0f;
__device__ __forceinline__ void attn_tile(const int mode  , const LAS bf16_t* Kc, const LAS bf16_t* Vc, const bf16x8 (&qr)[4], AttnSt& st, LAS float* wsf, int r32, int hi, bool sel, int dbase, int wlim) {
    f32x16 x0, x1; attn_scores(Kc, qr, x0, x1, r32, hi);
    if (mode == 2) {
#pragma unroll
        for (int r = 0; r < 16; ++r) { const int d0 = dbase - crow(r, hi), d1 = d0 - 32;
            x0[r] = (sel && d0 >= 0 && d0 < wlim) ? x0[r] : -INFINITY; x1[r] = (sel && d1 >= 0 && d1 < wlim) ? x1[r] : -INFINITY; }
    } else if (mode == 1) {
#pragma unroll
        for (int r = 0; r < 16; ++r) { x0[r] = sel ? x0[r] : -INFINITY; x1[r] = sel ? x1[r] : -INFINITY; }
    }
    float mx = fmaxf(x0[0], x1[0]);
#pragma unroll
    for (int r = 1; r < 16; ++r) mx = fmaxf(mx, fmaxf(x0[r], x1[r]));
    mx = fmaxf(mx, __shfl_xor(mx, 32));
    const float mref = (mx > st.m + TAU_RAW) ? mx : st.m;
    const float msc = (mref == -INFINITY) ? 0.f : mref * SC_L2;
    const float f = __builtin_amdgcn_exp2f(st.m * SC_L2 - msc);
    float rs = 0.f;
#pragma unroll
    for (int r = 0; r < 16; ++r) { x0[r] = __builtin_amdgcn_exp2f(__builtin_fmaf(x0[r], SC_L2, -msc)); x1[r] = __builtin_amdgcn_exp2f(__builtin_fmaf(x1[r], SC_L2, -msc)); rs += x0[r] + x1[r]; }
    st.l = st.l * f + rs; st.m = mref;
    if (__builtin_amdgcn_ballot_w64(f != 1.0f) != 0ull) {
        if (hi == 0) wsf[r32] = f;
        const LAS float* wr_ = wsf + 4 * hi;
#pragma unroll
        for (int r = 0; r < 16; ++r) { const float fr_ = wr_[(r & 3) + 8 * (r >> 2)]; st.o0[r] *= fr_; st.o1[r] *= fr_; }
    }
    attn_pv(Vc, x0, x1, st.o0, st.o1, r32, hi);
}
__device__ __forceinline__ void attn_scale_rows(f32x16& o0, f32x16& o1, float inv, LAS float* wsf, int r32, int hi) {
    if (hi == 0) wsf[r32] = inv;
    const LAS float* wr_ = wsf + 4 * hi;
#pragma unroll
    for (int r = 0; r < 16; ++r) { const float f = wr_[(r & 3) + 8 * (r >> 2)]; o0[r] *= f; o1[r] *= f; }
}

__device__ UNIT_INLINE void swa_unit(Frame& F, int unit, const bf16_t* U1, bf16_t* Y, const float* sinks) {
    const int qb = unit & 31, g = (unit >> 5) & 1, b = unit >> 6;
    const int r32 = F.lane & 31, hi = F.lane >> 5, hr = F.wave >> 1, qs = F.wave & 1, head = g * 4 + hr;
    const int q0 = qb * 64, tq = q0 + qs * 32 + r32;
    LAS bf16_t* Ks = (LAS bf16_t*)F.lds; LAS bf16_t* Vt = Ks + TILE_EL; LAS bf16_t* Ks1 = Vt + TILE_EL; LAS bf16_t* Vt1 = Ks1 + TILE_EL;
    LAS float* wsf = (LAS float*)(F.lds + 4 * TILE_EL * 2) + F.wave * 32;
    const bf16_t* rowb = U1 + (size_t)(b * SEQ) * UW;
    bf16x8 qr[4];
#pragma unroll
    for (int d0 = 0; d0 < 4; ++d0) qr[d0] = *(const bf16x8*)(rowb + (size_t)tq * UW + UC_SQ + head * 64 + d0 * 16 + hi * 8);
    AttnSt st; attn_init(st);
    {
        const int kt0 = (qb >= 2 ? qb - 2 : 0);
        const bf16_t* kg = rowb + UC_SKV + g * 64; const bf16_t* vg = kg + 128;
        __syncthreads();
        dma_kv(kg + (size_t)(kt0 * 64) * UW, UW, vg + (size_t)(kt0 * 64) * UW, UW, Ks, Vt, F.wave, F.lane);
        __syncthreads();
        int cur = 0;
#pragma unroll 1
        for (int kt = kt0; kt <= qb; ++kt) {
            if (kt < qb) dma_kv(kg + (size_t)((kt + 1) * 64) * UW, UW, vg + (size_t)((kt + 1) * 64) * UW, UW, cur ? Ks : Ks1, cur ? Vt : Vt1, F.wave, F.lane);
            const LAS bf16_t* kc_ = cur ? Ks1 : Ks; const LAS bf16_t* vc_ = cur ? Vt1 : Vt;
            attn_tile(kt == qb - 1 ? 0 : 2, kc_, vc_, qr, st, wsf, r32, hi, true, tq - kt * 64, 128);
            __syncthreads();
            cur ^= 1;
        }
    }
    const float l = st.l + __shfl_xor(st.l, 32), sk = sinks[head];
    const float mnat = st.m * 0.125f, mf = fmaxf(mnat, sk), a = exp2f((mnat - mf) * LOG2E), inv = a / (l * a + exp2f((sk - mf) * LOG2E));
    attn_scale_rows(st.o0, st.o1, inv, wsf, r32, hi);
    bf16_t* yb = Y + (size_t)(b * SEQ + q0 + qs * 32) * YW + 3 * 512 + head * 64 + r32;
#pragma unroll
    for (int r = 0; r < 16; ++r) { bf16_t* yp = yb + (size_t)crow(r, hi) * YW; yp[0] = (bf16_t)f2bf(st.o0[r]); yp[32] = (bf16_t)f2bf(st.o1[r]); }
}

constexpr int NSA_K1_OFF = 2 * TILE_EL * 2;
constexpr int NSA_PS_OFF = 4 * TILE_EL * 2;
constexpr int NSA_IMP_OFF = NSA_PS_OFF + 64 * 128 * 4;
constexpr int NSA_SEL_OFF = NSA_IMP_OFF + 64 * 33 * 4;
__device__ __forceinline__ float nsa_gate(const float* gbase, int r, int i) { return sigmoidf_(gbase[((r & 3) + 8 * (r >> 2)) * 32 + i * 8]); }
__device__ UNIT_INLINE void nsa_unit(Frame& F, int unit, const bf16_t* U1, bf16_t* Y, const float* misc, const unsigned char* ws) {
    const int qb = 31 - (unit & 31), g = (unit >> 5) & 1, b = unit >> 6;
    const int r32 = F.lane & 31, hi = F.lane >> 5, hr = F.wave >> 1, qs = F.wave & 1, head = g * 4 + hr;
    const int q0 = qb * 64, ql = qs * 32 + r32, tq = q0 + ql;
    LAS bf16_t* Ks = (LAS bf16_t*)F.lds; LAS bf16_t* Vt = Ks + TILE_EL;
    LAS bf16_t* Ks1 = (LAS bf16_t*)(F.lds + NSA_K1_OFF); LAS bf16_t* Vt1 = Ks1 + TILE_EL;
    LAS unsigned* psum = (LAS unsigned*)(F.lds + NSA_PS_OFF);
    LAS float* impb = (LAS float*)(F.lds + NSA_IMP_OFF);
    LAS unsigned* selm = (LAS unsigned*)(F.lds + NSA_SEL_OFF);
    LAS float* wsf = (LAS float*)(F.lds + NSA_SEL_OFF + 256) + F.wave * 32;
    const bf16_t* rowb = U1 + (size_t)(b * SEQ) * UW;
    const int grow = b * SEQ + q0 + qs * 32;
    const float* gbase = misc + (size_t)(grow + 4 * hi) * 32 + 8 + head;
    bf16x8 qr[4];
#pragma unroll
    for (int d0 = 0; d0 < 4; ++d0) qr[d0] = *(const bf16x8*)(rowb + (size_t)tq * UW + UC_NQ + head * 64 + d0 * 16 + hi * 8);
    unsigned yap[16];
#pragma unroll
    for (int r = 0; r < 16; ++r) yap[r] = 0u;
    __syncthreads();
    for (int i = F.tid; i < 64 * 128; i += 512) psum[i] = 0u;
#ifndef NSA_NO_CMP
    {
        const bf16_t* kc = (const bf16_t*)(ws + WS_KC) + (size_t)((b * 2 + g) * 128) * 64;
        const bf16_t* vc = (const bf16_t*)(ws + WS_VC) + (size_t)((b * 2 + g) * 128) * 64;
        dma_kv(kc, 64, vc, 64, Ks, Vt, F.wave, F.lane);
        dma_kv(kc + 64 * 64, 64, vc + 64 * 64, 64, Ks1, Vt1, F.wave, F.lane);
        __syncthreads();
        float m = -INFINITY, l = 0.f;
#pragma unroll 1
        for (int tl = 0; tl < 2; ++tl) {
            f32x16 x0, x1; attn_scores(tl ? Ks1 : Ks, qr, x0, x1, r32, hi);
            float mx = -INFINITY;
#pragma unroll
            for (int r = 0; r < 16; ++r) { const int n0 = tl * 64 + crow(r, hi), n1 = n0 + 32;
                x0[r] = (16 * n0 + 31 <= tq) ? x0[r] * 0.125f : -INFINITY; x1[r] = (16 * n1 + 31 <= tq) ? x1[r] * 0.125f : -INFINITY; mx = fmaxf(mx, fmaxf(x0[r], x1[r])); }
            mx = fmaxf(mx, __shfl_xor(mx, 32));
            const float mn = fmaxf(m, mx), ms = (mn == -INFINITY) ? 0.f : mn;
            float rs = 0.f;
#pragma unroll
            for (int r = 0; r < 16; ++r) rs += exp2f((x0[r] - ms) * LOG2E) + exp2f((x1[r] - ms) * LOG2E);
            l = l * exp2f((m - ms) * LOG2E) + rs; m = mn;
        }
        l += __shfl_xor(l, 32);
        const float inv = l > 0.f ? 1.0f / l : 0.f, ms = (m == -INFINITY) ? 0.f : m;
        f32x16 oc0, oc1;
#pragma unroll
        for (int r = 0; r < 16; ++r) { oc0[r] = 0.f; oc1[r] = 0.f; }
#pragma unroll 1
        for (int tl = 0; tl < 2; ++tl) {
            f32x16 x0, x1; attn_scores(tl ? Ks1 : Ks, qr, x0, x1, r32, hi);
#pragma unroll
            for (int r = 0; r < 16; ++r) { const int n0 = tl * 64 + crow(r, hi), n1 = n0 + 32;
                x0[r] = (16 * n0 + 31 <= tq) ? exp2f((x0[r] * 0.125f - ms) * LOG2E) * inv : 0.f;
                x1[r] = (16 * n1 + 31 <= tq) ? exp2f((x1[r] * 0.125f - ms) * LOG2E) * inv : 0.f;
                atomicAdd((unsigned*)(psum + ql * 128 + n0), (unsigned)(x0[r] * 16777216.0f + 0.5f)); atomicAdd((unsigned*)(psum + ql * 128 + n1), (unsigned)(x1[r] * 16777216.0f + 0.5f)); }
            attn_pv(tl ? Vt1 : Vt, x0, x1, oc0, oc1, r32, hi);
        }
#pragma unroll
        for (int r = 0; r < 16; ++r) { const float gt = nsa_gate(gbase, r, 0); yap[r] = cvt_pk(gt * oc0[r], gt * oc1[r]); }
    }
#endif
    __syncthreads();
#ifndef NSA_NO_TOPK
    if (qb <= 7) { if (F.tid < 64) selm[F.tid] = (2u << qb) - 1u; }
    else {
        const int q = F.tid & 63, jg = F.tid >> 6;
#pragma unroll
        for (int jj = 0; jj < 4; ++jj) { const int j = jg * 4 + jj; unsigned sacc = 0u;
#pragma unroll
            for (int d = -1; d <= 3; ++d) { const int n = 4 * j + d; if (n >= 0 && n < 127) sacc += psum[q * 128 + n]; }
            impb[q * 33 + j] = (float)sacc; }
        if (jg == 0) selm[q] = 1u | (1u << qb);
        __syncthreads();
        unsigned bits = 0u;
#pragma unroll 1
        for (int jj = 0; jj < 4; ++jj) { const int j = jg * 4 + jj;
            if (j >= 1 && j < qb) { const float vj = impb[q * 33 + j]; int rank = 0;
#pragma unroll 1
                for (int i2 = 1; i2 < qb; ++i2) { const float vi = impb[q * 33 + i2]; rank += (vi > vj || (vi == vj && i2 < j)) ? 1 : 0; }
                if (rank < 6) bits |= 1u << j; } }
        if (bits) atomicOr((unsigned*)(selm + q), bits);
    }
#endif
    __syncthreads();
    unsigned uni;
    { unsigned v = selm[F.lane];
#pragma unroll
      for (int o = 1; o < 64; o <<= 1) v |= __shfl_xor(v, o);
      uni = __builtin_amdgcn_readfirstlane(v); }
    const unsigned mysel = selm[ql];
#pragma unroll 1
    for (int br = 0; br < 2; ++br) {
        const unsigned lowm = (qb >= 8) ? ~((1u << (qb - 8)) - 1u) : 0xffffffffu;
        const unsigned tmask = (br == 0) ? uni : (((2u << qb) - 1u) & lowm);
        const unsigned qsel = (br == 0) ? mysel : 0xffffffffu;
        const int wlim = (br == 0) ? (1 << 30) : 512;
        const int kcol = UC_NKV + (2 + 2 * br) * 128 + g * 64;
        AttnSt st; attn_init(st);
        {
            const bf16_t* kg = rowb + kcol; const bf16_t* vg = kg + 128;
            unsigned rem = tmask;
            int j = __builtin_ctz(rem); rem &= rem - 1u;
            __syncthreads();
            dma_kv(kg + (size_t)(j * 64) * UW, UW, vg + (size_t)(j * 64) * UW, UW, Ks, Vt, F.wave, F.lane);
            __syncthreads();
            int cur = 0;
#pragma unroll 1
            for (;;) {
                const int jn = rem ? __builtin_ctz(rem) : -1; rem &= rem - 1u;
                if (jn >= 0) dma_kv(kg + (size_t)(jn * 64) * UW, UW, vg + (size_t)(jn * 64) * UW, UW, cur ? Ks : Ks1, cur ? Vt : Vt1, F.wave, F.lane);
                const LAS bf16_t* kc_ = cur ? Ks1 : Ks; const LAS bf16_t* vc_ = cur ? Vt1 : Vt;
                const bool sel = (qsel >> j) & 1u;
                attn_tile((j == qb || (br == 1 && j == qb - 8)) ? 2 : (br == 0 ? 1 : 0), kc_, vc_, qr, st, wsf, r32, hi, sel, tq - j * 64, wlim);
                __syncthreads();
                if (jn < 0) break;
                j = jn; cur ^= 1;
            }
        }
        const float l = st.l + __shfl_xor(st.l, 32), inv = l > 0.f ? 1.0f / l : 0.f;
        attn_scale_rows(st.o0, st.o1, inv, wsf, r32, hi);
#pragma unroll
        for (int r = 0; r < 16; ++r) { const float gt = nsa_gate(gbase, r, 1 + br); yap[r] = cvt_pk(bf2f(yap[r] & 0xffffu) + gt * st.o0[r], bf2f(yap[r] >> 16) + gt * st.o1[r]); }
    }
    bf16_t* yb = Y + (size_t)grow * YW + 1 * 512 + head * 64 + r32;
#pragma unroll
    for (int r = 0; r < 16; ++r) { bf16_t* yp = yb + (size_t)crow(r, hi) * YW; yp[0] = (bf16_t)(yap[r] & 0xffffu); yp[32] = (bf16_t)(yap[r] >> 16); }
}

__device__ __forceinline__ void ld4x16_sys(u32x4& a, u32x4& b, u32x4& c, u32x4& d, const void* pa, const void* pb, const void* pc, const void* pd) {
    asm volatile("global_load_dwordx4 %0, %4, off sc0 sc1\n\tglobal_load_dwordx4 %1, %5, off sc0 sc1\n\tglobal_load_dwordx4 %2, %6, off sc0 sc1\n\tglobal_load_dwordx4 %3, %7, off sc0 sc1\n\ts_waitcnt vmcnt(0)"
                 : "=&v"(a), "=&v"(b), "=&v"(c), "=&v"(d) : "v"(pa), "v"(pb), "v"(pc), "v"(pd) : "memory");
}
constexpr int RW_CT = 16, RW_NC = SEQ / RW_CT;
constexpr int SB_BT = 0, SB_RT = 2304, SB_VT = 4608, SB_MT = 6656  , SB_CHT = 8704, SB_KHT = 10752, SB_G16 = 12800,
              SB_G = 13056  , SB_BS = 15104, SB_SIZE = 15360;
constexpr int PH_SB = 0, PH_V = SB_SIZE  , PH_R = PH_V + 4096, PH_K = PH_R + 4096, PH_DEC = PH_K + 4096, PH_NB = PH_DEC + 4096, PH_CC = PH_NB + 4096,
              PH_WDH = PH_CC + 4096, PH_ADH = PH_WDH + 16 * 72 * 2, PH_GDH = PH_ADH + 16 * 72 * 2,
              PH_CH = PH_WDH  , PH_KH = PH_CH + 2304, PH_ACB = PH_KH + 2304,
              PH_RAW = PH_GDH + 16 * 136 * 2, RAW_R = 0, RAW_K = 3072, RAW_V = 6144, RAW_L = 9216, RAW_SIZE = 18432, PH_SIZE = PH_RAW + RAW_SIZE,
              RP_CONST = 2 * PH_SIZE  , RP_MU = RP_CONST + 5 * 256  , RP_END = RP_MU + 448 * 4;
static_assert(RP_END <= LDS_USER && PH_RAW % 16 == 0 && PH_SIZE % 16 == 0 && PH_WDH % 16 == 0 && PH_ACB + 1024 <= PH_RAW, "rwkv prep lds");
constexpr int RW_JOBS = NB * 8 * (RW_NC / 2);
template <int CTRL> __device__ __forceinline__ float dppf(float x) { return __int_as_float(__builtin_amdgcn_update_dpp(0, __float_as_int(x), CTRL, 0xf, 0xf, false)); }
__device__ __forceinline__ float reduce8(float x) { x += dppf<0xB1>(x); x += dppf<0x4E>(x); x += dppf<0x141>(x); return x; }
__device__ __forceinline__ float reduce16(float x) { x = reduce8(x); x += dppf<0x140>(x); return x; }
__device__ __forceinline__ float fast_tanh(float x) { const float e = __expf(2.0f * x); return 1.0f - 2.0f / (e + 1.0f); }
#define RW_BAR() do { asm volatile("s_waitcnt lgkmcnt(0)" ::: "memory"); __builtin_amdgcn_s_barrier(); asm volatile("" ::: "memory"); } while (0)
typedef float f32x2_t_ __attribute__((ext_vector_type(2))); typedef __bf16 bf16x2_t_ __attribute__((ext_vector_type(2)));
__device__ __forceinline__ unsigned cvtpk_c(float lo, float hi) { const f32x2_t_ v = {lo, hi}; const bf16x2_t_ b = __builtin_convertvector(v, bf16x2_t_); return __builtin_bit_cast(unsigned, b); }
__device__ __forceinline__ u32x2 pack4c(f32x4 v) { u32x2 w; w.x = cvtpk_c(v[0], v[1]); w.y = cvtpk_c(v[2], v[3]); return w; }
__device__ __forceinline__ bf16x8 mk8(u32x2 lo, u32x2 hi) { return __builtin_bit_cast(bf16x8, (u32x4){lo.x, lo.y, hi.x, hi.y}); }

__device__ UNIT_INLINE void rwkv_prep(Frame& F, int L, KArgs KA, const bf16_t* U1, unsigned char* rec) {
    LAS unsigned char* lds = F.lds;
    const int half = F.wave >> 2, ww = F.wave & 3, wtid = F.tid & 255, r16 = F.lane & 15, kg = F.lane >> 4;
    const int wti = wtid >> 4, wcg = wtid & 15;
    LAS unsigned char* hb = lds + half * PH_SIZE;
    const int JPB = (RW_JOBS + F.G - 1) / F.G, j0 = F.bid * JPB, j1 = (j0 + JPB < RW_JOBS) ? j0 + JPB : RW_JOBS;
    int cur_bh = -1; float w0n = 0.f, a0n = 0.f;
    u32x4 Bq[8];
#pragma unroll
    for (int q = 0; q < 8; ++q) Bq[q] = (u32x4){0u, 0u, 0u, 0u};
#define RP_DMA(jj) do { const int bh_ = (jj) >> 6, h_ = bh_ & 7; const int t0_ = (2 * ((jj) & 63) + half) * RW_CT - 1; const bf16_t* rowb_ = U1 + (size_t)((bh_ >> 3) * SEQ) * UW + UC_RW; \
        _Pragma("unroll") for (int q_ = 0; q_ < 5; ++q_) { const int ix_ = ww + 4 * q_; if (ix_ < 18) { \
            int tok_, col_, dst_; \
            if (ix_ < 9) { const int kind_ = ix_ / 3, p_ = ix_ % 3; tok_ = 8 * p_ + (F.lane >> 3); col_ = kind_ * 512 + h_ * 64 + (F.lane & 7) * 8; dst_ = kind_ * 3072 + p_ * 1024; } \
            else { const int p_ = ix_ - 9; tok_ = 2 * p_ + (F.lane >> 5); col_ = 1536 + (F.lane & 31) * 8; dst_ = RAW_L + p_ * 1024; } \
            int t_ = t0_ + (tok_ > 16 ? 16 : tok_); t_ = t_ < 0 ? 0 : t_; \
            __builtin_amdgcn_global_load_lds((const unsigned*)(rowb_ + (size_t)t_ * UW + col_), (LAS unsigned*)(hb + PH_RAW + dst_), 16, 0, 0); } } } while (0)
    __syncthreads();
    if (j0 < j1) RP_DMA(j0);
#pragma unroll 1
    for (int j = j0; j < j1; ++j) {
        const int bh = j >> 6, h = bh & 7, ck = 2 * (j & 63) + half;
        if (bh != cur_bh) {
            __syncthreads();
            const int cn = h * 64 + 16 * ww + r16; w0n = IN_F(15)[L * 512 + cn]; a0n = IN_F(17)[L * 512 + cn];
            if (F.tid < 320) { const int v = F.tid >> 6; ((LAS float*)(lds + RP_CONST))[F.tid] = IN_F(20 + v)[L * 512 + h * 64 + (F.tid & 63)]; }
            if (F.tid < 448) { const int i = F.tid; const int col = i < 64 ? h * 64 + i : i < 128 ? 512 + h * 64 + (i - 64) : i < 192 ? 1024 + h * 64 + (i - 128) : 1536 + (i - 192);
                ((LAS float*)(lds + RP_MU))[i] = IN_F(14)[(size_t)L * 1792 + col]; }
            const u32x4* lwf = (const u32x4*)(KA->ws + WS_LW) + ((size_t)((L * 8 + h) * 4 + ww) * 8) * 64 + F.lane;
#pragma unroll
            for (int q = 0; q < 8; ++q) Bq[q] = lwf[q * 64];
            cur_bh = bh;
        }
        if (j == j0) asm volatile("s_waitcnt vmcnt(0)" ::: "memory");
        else asm volatile("s_waitcnt vmcnt(4)" ::: "memory");
        RW_BAR();
        {
            const LAS unsigned char* raw = hb + PH_RAW;
            const bool first = (ck == 0);
#pragma unroll
            for (int n = 0; n < 4; ++n) {
                const int i = wtid + 256 * n;
                if (i < 896) {
                    const int kind = i < 768 ? i >> 7 : 5;
                    const int idx = i - (kind < 5 ? kind * 128 : 640);
                    const int tok = kind < 5 ? idx >> 3 : idx >> 4, piece = kind < 5 ? idx & 7 : idx & 15;
                    int so, mo;
                    if (kind < 3) { so = kind * 3072 + (tok + 1) * 128 + piece * 16; mo = kind * 64 + piece * 8; }
                    else { const int lp = (kind == 3 ? 0 : kind == 4 ? 8 : 16) + piece; so = RAW_L + (tok + 1) * 512 + lp * 16; mo = 192 + lp * 8; }
                    const u32x4 rc = *(const LAS u32x4*)(raw + so);
                    u32x4 rv = *(const LAS u32x4*)(raw + so - (kind < 3 ? 128 : 512));
                    if (first && tok == 0) rv = (u32x4){0u, 0u, 0u, 0u};
                    const f32x4 m0 = *(const LAS f32x4*)((const LAS float*)(lds + RP_MU) + mo), m1 = *(const LAS f32x4*)((const LAS float*)(lds + RP_MU) + mo + 4);
                    float y[8];
#pragma unroll
                    for (int jj = 0; jj < 4; ++jj) {
                        const float x0 = bf2f(rc[jj] & 0xffffu), x1 = bf2f(rc[jj] >> 16), p0 = bf2f(rv[jj] & 0xffffu), p1 = bf2f(rv[jj] >> 16);
                        y[2 * jj] = x0 + (p0 - x0) * (jj < 2 ? m0[2 * jj] : m1[2 * jj - 4]); y[2 * jj + 1] = x1 + (p1 - x1) * (jj < 2 ? m0[2 * jj + 1] : m1[2 * jj - 3]);
                    }
                    if (kind < 3) {
                        LAS float* dst = (LAS float*)(hb + (kind == 0 ? PH_R : kind == 1 ? PH_K : PH_V)) + tok * 64 + piece * 8;
                        *(LAS f32x4*)dst = (f32x4){y[0], y[1], y[2], y[3]}; *(LAS f32x4*)(dst + 4) = (f32x4){y[4], y[5], y[6], y[7]};
                    } else {
                        LAS bf16_t* dst;
                        if (kind == 3) { dst = (LAS bf16_t*)(hb + PH_WDH) + tok * 72 + piece * 8;
#pragma unroll
                            for (int jj = 0; jj < 8; ++jj) y[jj] = fast_tanh(y[jj]); }
                        else if (kind == 4) dst = (LAS bf16_t*)(hb + PH_ADH) + tok * 72 + piece * 8;
                        else { dst = (LAS bf16_t*)(hb + PH_GDH) + tok * 136 + piece * 8;
#pragma unroll
                            for (int jj = 0; jj < 8; ++jj) y[jj] = sigmoidf_(y[jj]); }
                        u32x4 pk; pk.x = cvt_pk(y[0], y[1]); pk.y = cvt_pk(y[2], y[3]); pk.z = cvt_pk(y[4], y[5]); pk.w = cvt_pk(y[6], y[7]);
                        *(LAS u32x4*)dst = pk;
                    }
                }
            }
        }
        RW_BAR();
        if (j + 1 < j1) RP_DMA(j + 1);
        {
            LAS float* sDEC = (LAS float*)(hb + PH_DEC); LAS float* sCC = (LAS float*)(hb + PH_CC); LAS bf16_t* sG = (LAS bf16_t*)(hb + PH_SB + SB_G);
            const LAS bf16_t* sWDh = (const LAS bf16_t*)(hb + PH_WDH); const LAS bf16_t* sADh = (const LAS bf16_t*)(hb + PH_ADH); const LAS bf16_t* sGDh = (const LAS bf16_t*)(hb + PH_GDH);
            f32x4 aw = (f32x4){0.f, 0.f, 0.f, 0.f}, aa = aw, ag = aw;
#pragma unroll
            for (int ks = 0; ks < 2; ++ks) {
                const bf16x8 xw = *(const LAS bf16x8*)(sWDh + r16 * 72 + 32 * ks + 8 * kg), xa = *(const LAS bf16x8*)(sADh + r16 * 72 + 32 * ks + 8 * kg);
                aw = __builtin_amdgcn_mfma_f32_16x16x32_bf16(xw, __builtin_bit_cast(bf16x8, Bq[ks]), aw, 0, 0, 0); aa = __builtin_amdgcn_mfma_f32_16x16x32_bf16(xa, __builtin_bit_cast(bf16x8, Bq[2 + ks]), aa, 0, 0, 0);
            }
#pragma unroll
            for (int ks = 0; ks < 4; ++ks) { const bf16x8 xg = *(const LAS bf16x8*)(sGDh + r16 * 136 + 32 * ks + 8 * kg); ag = __builtin_amdgcn_mfma_f32_16x16x32_bf16(xg, __builtin_bit_cast(bf16x8, Bq[4 + ks]), ag, 0, 0, 0); }
#pragma unroll
            for (int r = 0; r < 4; ++r) { const int o = (4 * kg + r) * 64 + 16 * ww + r16; sDEC[o] = aw[r] + w0n; sCC[o] = aa[r] + a0n; sG[o] = (bf16_t)f2bf(ag[r]); }
        }
        RW_BAR();
        {
            const int o = wti * 64 + wcg * 4;
            LAS float* pDEC = (LAS float*)(hb + PH_DEC) + o; LAS float* pNB = (LAS float*)(hb + PH_NB) + o; LAS float* pCC = (LAS float*)(hb + PH_CC) + o;
            LAS float* pK = (LAS float*)(hb + PH_K) + o; const LAS float* pR = (const LAS float*)(hb + PH_R) + o;
            const LAS float* cst = (const LAS float*)(lds + RP_CONST) + wcg * 4;
            const f32x4 wp = *(const LAS f32x4*)pDEC, ap = *(const LAS f32x4*)pCC, kr = *(const LAS f32x4*)pK, rr = *(const LAS f32x4*)pR;
            const f32x4 ckk = *(const LAS f32x4*)cst, cka = *(const LAS f32x4*)(cst + 64), crk = *(const LAS f32x4*)(cst + 128);
            f32x4 dec, a, kk, k2;
#pragma unroll
            for (int jj = 0; jj < 4; ++jj) {
                const float sp = (-wp[jj] > 20.f) ? -wp[jj] : __logf(1.0f + __expf(-wp[jj]));
                dec[jj] = __expf(-__expf(-sp - 0.5f)); a[jj] = sigmoidf_(ap[jj]);
            }
            kk = kr * ckk; k2 = kr * ((a - 1.0f) * cka + 1.0f);
            const f32x4 bb = rr * k2 * crk;
            const float sq = reduce16((kk[0] * kk[0] + kk[1] * kk[1]) + (kk[2] * kk[2] + kk[3] * kk[3]));
            const float bsum = reduce16((bb[0] + bb[1]) + (bb[2] + bb[3]));
            const float rn = 1.0f / fmaxf(sqrtf(sq), 1e-12f);
            const f32x4 kn = kk * rn;
            *(LAS f32x4*)pDEC = dec; *(LAS f32x4*)pNB = -kn; *(LAS f32x4*)pCC = kn * a; *(LAS f32x4*)pK = k2;
            if (wcg == 0) ((LAS float*)(hb + PH_SB + SB_BS))[wti] = bsum;
        }
        RW_BAR();
        {
            const int kch = F.lane;
            const LAS float* pD = (const LAS float*)(hb + PH_DEC) + kch;
            if (ww == 0) {
                const LAS float* pN = (const LAS float*)(hb + PH_NB) + kch; LAS bf16_t* pO = (LAS bf16_t*)(hb + PH_SB + SB_BT) + kch; float g = 1.0f;
#pragma unroll
                for (int t = 0; t < 16; ++t) { pO[t * 72] = (bf16_t)f2bf(g * pN[t * 64]); g *= pD[t * 64]; }
                ((LAS float*)(hb + PH_SB + SB_G16))[kch] = g;
            } else if (ww == 1) {
                const LAS float* pRr = (const LAS float*)(hb + PH_R) + kch; LAS bf16_t* pO = (LAS bf16_t*)(hb + PH_SB + SB_RT) + kch; float g = 1.0f;
                const LAS float* pV = (const LAS float*)(hb + PH_V) + kch; unsigned vt[8];
#pragma unroll
                for (int t = 0; t < 16; ++t) { g *= pD[t * 64]; pO[t * 72] = (bf16_t)f2bf(g * pRr[t * 64]); }
#pragma unroll
                for (int t = 0; t < 8; ++t) vt[t] = cvt_pk(pV[(2 * t) * 64], pV[(2 * t + 1) * 64]);
                LAS u32x4* pVT = (LAS u32x4*)((LAS bf16_t*)(hb + PH_SB + SB_VT) + kch * 16);
                pVT[0] = (u32x4){vt[0], vt[1], vt[2], vt[3]}; pVT[1] = (u32x4){vt[4], vt[5], vt[6], vt[7]};
            } else {
                const LAS float* pS = (const LAS float*)(hb + (ww == 2 ? PH_CC : PH_K)) + kch;
                LAS bf16_t* pRow = (LAS bf16_t*)(hb + (ww == 2 ? PH_CH : PH_KH)) + kch; float g = 1.0f; float q[16];
#pragma unroll
                for (int t = 0; t < 16; ++t) { g *= pD[t * 64]; q[t] = pS[t * 64] * __builtin_amdgcn_rcpf(g); pRow[t * 72] = (bf16_t)f2bf(q[t]); }
                LAS u32x4* pT = (LAS u32x4*)((LAS bf16_t*)(hb + PH_SB + (ww == 2 ? SB_CHT : SB_KHT)) + kch * 16);
                pT[0] = (u32x4){cvt_pk(q[0], q[1]), cvt_pk(q[2], q[3]), cvt_pk(q[4], q[5]), cvt_pk(q[6], q[7])};
                pT[1] = (u32x4){cvt_pk(q[8], q[9]), cvt_pk(q[10], q[11]), cvt_pk(q[12], q[13]), cvt_pk(q[14], q[15])};
            }
        }
        RW_BAR();
        {
            const LAS bf16_t* Am = (const LAS bf16_t*)(hb + ((ww & 1) ? PH_KH : PH_CH)) + r16 * 72 + 8 * kg;
            const LAS bf16_t* Bm = (const LAS bf16_t*)(hb + PH_SB + (ww < 2 ? SB_BT : SB_RT)) + r16 * 72 + 8 * kg;
            f32x4 gm = (f32x4){0.f, 0.f, 0.f, 0.f};
            gm = __builtin_amdgcn_mfma_f32_16x16x32_bf16(*(const LAS bf16x8*)Am, *(const LAS bf16x8*)Bm, gm, 0, 0, 0);
            gm = __builtin_amdgcn_mfma_f32_16x16x32_bf16(*(const LAS bf16x8*)(Am + 32), *(const LAS bf16x8*)(Bm + 32), gm, 0, 0, 0);
#pragma unroll
            for (int r = 0; r < 4; ++r) { const int i = 4 * kg + r; const bool keep = (ww < 2) ? (i < r16) : (i <= r16); gm[r] = keep ? gm[r] : 0.f; }
            if (ww == 0) {
                LAS float* acbT = (LAS float*)(hb + PH_ACB);
                *(LAS f32x4*)(acbT + r16 * 16 + 4 * kg) = gm;
                asm volatile("s_waitcnt lgkmcnt(0)" ::: "memory");
                const int jc = F.lane & 15;
                float inv[16];
#pragma unroll
                for (int i = 0; i < 16; ++i) inv[i] = (i == jc) ? 1.0f : 0.0f;
#pragma unroll
                for (int l = 15; l >= 1; --l) {
#pragma unroll
                    for (int q = 0; q < (l + 3) / 4; ++q) {
                        const f32x4 c = *(const LAS f32x4*)(acbT + l * 16 + 4 * q);
#pragma unroll
                        for (int e = 0; e < 4; ++e) if (4 * q + e < l) inv[4 * q + e] += c[e] * inv[l];
                    }
                }
                if (F.lane < 16) {
                    LAS u32x4* pI = (LAS u32x4*)((LAS bf16_t*)(hb + PH_SB + SB_MT) + 256 + jc * 16);
                    pI[0] = (u32x4){cvt_pk(inv[0], inv[1]), cvt_pk(inv[2], inv[3]), cvt_pk(inv[4], inv[5]), cvt_pk(inv[6], inv[7])};
                    pI[1] = (u32x4){cvt_pk(inv[8], inv[9]), cvt_pk(inv[10], inv[11]), cvt_pk(inv[12], inv[13]), cvt_pk(inv[14], inv[15])};
                }
            } else {
                const int slot = (ww == 1) ? 0 : ww;
                *(LAS u32x2*)((LAS bf16_t*)(hb + PH_SB + SB_MT) + slot * 256 + r16 * 16 + 4 * kg) = pack4c(gm);
            }
        }
        RW_BAR();
        {
            unsigned char* g = rec + ((size_t)bh * RW_NC + ck) * SB_SIZE;
#pragma unroll
            for (int n = 0; n < 4; ++n) { int i = wtid + 256 * n; i = i < SB_SIZE / 16 ? i : SB_SIZE / 16 - 1; *(u32x4*)(g + i * 16) = *(const LAS u32x4*)(hb + PH_SB + i * 16); }
        }
    }
#undef RP_DMA
}

__device__ __forceinline__ void rw_post(const LAS float* lnw, const LAS unsigned char* sb, const LAS float* out, bf16_t* yrow0, int ti, int cg) {
    const int o = ti * 64 + cg * 4;
    const f32x4 x = *(const LAS f32x4*)(out + o);
    const LAS bf16_t* vt = (const LAS bf16_t*)(sb + SB_VT) + (cg * 4) * 16 + ti;
    const f32x4 v = (f32x4){bf2f(vt[0]), bf2f(vt[16]), bf2f(vt[32]), bf2f(vt[48])};
    const u32x2 gq = *(const LAS u32x2*)((const LAS bf16_t*)(sb + SB_G) + o);
    const f32x4 lw = *(const LAS f32x4*)(lnw + cg * 4), lb = *(const LAS f32x4*)(lnw + 64 + cg * 4);
    const float bs = ((const LAS float*)(sb + SB_BS))[ti];
    const float mean = reduce16((x[0] + x[1]) + (x[2] + x[3])) * (1.0f / 64.0f);
    const f32x4 d = x - mean;
    const float rstd = rsqrtf(reduce16((d[0] * d[0] + d[1] * d[1]) + (d[2] * d[2] + d[3] * d[3])) * (1.0f / 64.0f) + 64e-5f);
    const f32x4 g = unpack4(gq);
    const f32x4 y = (d * rstd * lw + lb + v * bs) * g;
    *(u32x2*)(yrow0 + (size_t)ti * YW + cg * 4) = pack4(y);
}
constexpr int SC_NR = 6, SC_PD = 4, SC_OUT = SC_NR * SB_SIZE, SC_LN = SC_OUT + 2 * 4096, SC_END = SC_LN + 512;
static_assert(SC_END <= LDS_USER && SB_SIZE % 1024 == 0, "rwkv scan lds");
__device__ UNIT_INLINE void rwkv_scan(Frame& F, int unit, int L, KArgs KA, const unsigned char* rec, bf16_t* Y) {
    const int h = unit & 7, b = unit >> 3;
    const bool scanner = F.wave < 4;
    LAS unsigned char* lds = F.lds;
    bf16_t* ybase = Y + (size_t)(b * SEQ) * YW + 2 * 512 + h * 64;
    const unsigned char* rbase = rec + (size_t)unit * RW_NC * SB_SIZE + F.lane * 16;
    const int ww = F.wave & 3, wtid = F.tid & 255, r16 = F.lane & 15, kg = F.lane >> 4;
    const int wti = wtid >> 4, wcg = wtid & 15;
    f32x4 X0 = (f32x4){0.f, 0.f, 0.f, 0.f}, X1 = X0, X2 = X0, X3 = X0;
    __syncthreads();
    if (F.tid < 128) ((LAS float*)(lds + SC_LN))[F.tid] = IN_F(23 + (F.tid >> 6))[L * 512 + h * 64 + (F.tid & 63)];
#define SC_DMA(cc) do { const unsigned char* src_ = rbase + (size_t)(cc) * SB_SIZE; LAS unsigned char* dst_ = lds + ((cc) % SC_NR) * SB_SIZE; \
        _Pragma("unroll") for (int q_ = 0; q_ < 4; ++q_) { int pc_ = ww * 4 + q_; pc_ = pc_ > 14 ? 14 : pc_; \
            __builtin_amdgcn_global_load_lds((const unsigned*)(src_ + pc_ * 1024), (LAS unsigned*)(dst_ + pc_ * 1024), 16, 0, 0); } } while (0)
    if (!scanner) {
#pragma unroll
        for (int c = 0; c < SC_PD; ++c) SC_DMA(c);
    }
    asm volatile("s_waitcnt vmcnt(0)" ::: "memory");
    __syncthreads();
#pragma unroll 1
    for (int ck = 0; ck <= RW_NC; ++ck) {
        const LAS unsigned char* sbc = lds + (ck % SC_NR) * SB_SIZE;
        LAS float* ocur = (LAS float*)(lds + SC_OUT + (ck & 1) * 4096); const LAS float* oprv = (const LAS float*)(lds + SC_OUT + ((ck + 1) & 1) * 4096);
        if (scanner) {
            if (ck < RW_NC) {
            const LAS bf16_t* BT = (const LAS bf16_t*)(sbc + SB_BT) + r16 * 72 + 4 * kg; const LAS bf16_t* RT = (const LAS bf16_t*)(sbc + SB_RT) + r16 * 72 + 4 * kg;
            const LAS bf16_t* MT = (const LAS bf16_t*)(sbc + SB_MT) + r16 * 16 + 4 * kg;
            const u32x2 vt = *(const LAS u32x2*)((const LAS bf16_t*)(sbc + SB_VT) + (16 * ww + r16) * 16 + 4 * kg);
            const u32x2 z2 = (u32x2){0u, 0u};
            const bf16x8 bx0 = mk8(pack4c(X0), pack4c(X1)), bx1 = mk8(pack4c(X2), pack4c(X3));
            f32x4 U = (f32x4){0.f, 0.f, 0.f, 0.f}, O = U;
            U = __builtin_amdgcn_mfma_f32_16x16x32_bf16(mk8(*(const LAS u32x2*)BT, *(const LAS u32x2*)(BT + 16)), bx0, U, 0, 0, 0);
            O = __builtin_amdgcn_mfma_f32_16x16x32_bf16(mk8(*(const LAS u32x2*)RT, *(const LAS u32x2*)(RT + 16)), bx0, O, 0, 0, 0);
            U = __builtin_amdgcn_mfma_f32_16x16x32_bf16(mk8(*(const LAS u32x2*)(BT + 32), *(const LAS u32x2*)(BT + 48)), bx1, U, 0, 0, 0);
            O = __builtin_amdgcn_mfma_f32_16x16x32_bf16(mk8(*(const LAS u32x2*)(RT + 32), *(const LAS u32x2*)(RT + 48)), bx1, O, 0, 0, 0);
            U = __builtin_amdgcn_mfma_f32_16x16x32_bf16(mk8(z2, *(const LAS u32x2*)MT), mk8(z2, vt), U, 0, 0, 0);
            f32x4 SA = __builtin_amdgcn_mfma_f32_16x16x32_bf16(mk8(*(const LAS u32x2*)(MT + 256), z2), mk8(pack4c(U), vt), (f32x4){0.f, 0.f, 0.f, 0.f}, 0, 0, 0);
            const bf16x8 b3 = mk8(pack4c(SA), vt);
            O = __builtin_amdgcn_mfma_f32_16x16x32_bf16(mk8(*(const LAS u32x2*)(MT + 512), *(const LAS u32x2*)(MT + 768)), b3, O, 0, 0, 0);
#pragma unroll
            for (int r = 0; r < 4; ++r) ocur[(4 * kg + r) * 64 + 16 * ww + r16] = O[r];
            const LAS bf16_t* CT = (const LAS bf16_t*)(sbc + SB_CHT) + r16 * 16 + 4 * kg; const LAS bf16_t* KT = (const LAS bf16_t*)(sbc + SB_KHT) + r16 * 16 + 4 * kg;
            const LAS float* g16 = (const LAS float*)(sbc + SB_G16) + 4 * kg;
            X0 = __builtin_amdgcn_mfma_f32_16x16x32_bf16(mk8(*(const LAS u32x2*)CT, *(const LAS u32x2*)KT), b3, X0, 0, 0, 0) * *(const LAS f32x4*)g16;
            X1 = __builtin_amdgcn_mfma_f32_16x16x32_bf16(mk8(*(const LAS u32x2*)(CT + 256), *(const LAS u32x2*)(KT + 256)), b3, X1, 0, 0, 0) * *(const LAS f32x4*)(g16 + 16);
            X2 = __builtin_amdgcn_mfma_f32_16x16x32_bf16(mk8(*(const LAS u32x2*)(CT + 512), *(const LAS u32x2*)(KT + 512)), b3, X2, 0, 0, 0) * *(const LAS f32x4*)(g16 + 32);
            X3 = __builtin_amdgcn_mfma_f32_16x16x32_bf16(mk8(*(const LAS u32x2*)(CT + 768), *(const LAS u32x2*)(KT + 768)), b3, X3, 0, 0, 0) * *(const LAS f32x4*)(g16 + 48);
            }
        } else {
            if (ck >= 1) rw_post((const LAS float*)(lds + SC_LN), lds + ((ck - 1) % SC_NR) * SB_SIZE, oprv, ybase + (size_t)((ck - 1) * RW_CT) * YW, wti, wcg);
            if (ck + SC_PD < RW_NC) { SC_DMA(ck + SC_PD); asm volatile("s_waitcnt vmcnt(12)" ::: "memory"); }
            else asm volatile("s_waitcnt vmcnt(0)" ::: "memory");
        }
        RW_BAR();
    }
#undef SC_DMA
}

constexpr int SL = 136;
constexpr int SP_CS = 0, SP_BS = SP_CS + 128 * SL * 2, SP_BT = SP_BS + 128 * SL * 2, SP_XT = SP_BT + 128 * SL * 2, SP_DT = SP_XT + 128 * SL * 2,
              SP_AC = SP_DT + 2048, SP_SC = SP_AC + 2048, SP_END = SP_SC + 2048;
static_assert(SP_END <= LDS_USER, "ssd prep lds");
__device__ __forceinline__ float silu_fast(float x) { return x * __builtin_amdgcn_rcpf(1.0f + __expf(-x)); }
__device__ UNIT_INLINE void ssd_prep(Frame& F, int job, int L, KArgs KA, const bf16_t* U1, bf16_t* Y, const float* misc, unsigned char* ws) {
    const int c = job & 15, g = (job >> 4) & 1, b = job >> 5, t0 = c * 128;
    LAS bf16_t* Cs = (LAS bf16_t*)(F.lds + SP_CS); LAS bf16_t* Bs = (LAS bf16_t*)(F.lds + SP_BS); LAS bf16_t* Bt = (LAS bf16_t*)(F.lds + SP_BT); LAS bf16_t* Xt = (LAS bf16_t*)(F.lds + SP_XT);
    LAS float* dts = (LAS float*)(F.lds + SP_DT); LAS float* acs = (LAS float*)(F.lds + SP_AC); LAS float* scl = (LAS float*)(F.lds + SP_SC);
    const float* cw = IN_F(5) + (size_t)L * 4 * 1024; const float* cbias = IN_F(6) + (size_t)L * 1024;
    const int r16 = F.lane & 15, kg = F.lane >> 4, w = F.wave;
    const bf16_t* rowb = U1 + (size_t)(b * SEQ) * UW;
    __syncthreads();
    if (w < 4) {
        const int h = 4 * g + w, l0 = 2 * F.lane;
        const float dtb = IN_F(7)[L * 8 + h], Ah = -expf(IN_F(8)[L * 8 + h]);
        const float d0 = softplusf_(misc[(size_t)(b * SEQ + t0 + l0) * 32 + h] + dtb), d1 = softplusf_(misc[(size_t)(b * SEQ + t0 + l0 + 1) * 32 + h] + dtb);
        const float a0 = d0 * Ah, a1 = d1 * Ah;
        float s = a0 + a1;
#pragma unroll
        for (int o = 1; o < 64; o <<= 1) { const float v = __shfl_up(s, o); if (F.lane >= o) s += v; }
        const float e1 = s, e0 = s - a1, aend = __shfl(s, 63);
        dts[w * 128 + l0] = d0; dts[w * 128 + l0 + 1] = d1; acs[w * 128 + l0] = e0; acs[w * 128 + l0 + 1] = e1;
        scl[w * 128 + l0] = d0 * __expf(aend - e0); scl[w * 128 + l0 + 1] = d1 * __expf(aend - e1);
        *(f32x2*)((float*)(ws + WS_SSDA) + (size_t)(b * 8 + h) * SEQ + t0 + l0) = (f32x2){e0, e1};
    }
    auto stage = [&](const int q) {
        const int ck16 = F.tid & 15, run = F.tid >> 4;
        const int cidx = (q == 0) ? 512 + g * 128 + ck16 * 8 : (q == 1) ? 768 + g * 128 + ck16 * 8 : g * 256 + (q - 2) * 128 + ck16 * 8;
        f32x4 wt[4][2], bs8[2];
        bs8[0] = *(const f32x4*)(cbias + cidx); bs8[1] = *(const f32x4*)(cbias + cidx + 4);
#pragma unroll
        for (int k = 0; k < 4; ++k) { wt[k][0] = *(const f32x4*)(cw + k * 1024 + cidx); wt[k][1] = *(const f32x4*)(cw + k * 1024 + cidx + 4); }
        u32x4 xq[7];
        const bf16_t* pb_ = rowb + UC_XBC + cidx;
#pragma unroll
        for (int k = 0; k < 7; ++k) { const int t = t0 + 4 * run - 3 + k; xq[k] = *(const u32x4*)(pb_ + (size_t)(t < 0 ? 0 : t) * UW); if (t < 0) xq[k] = (u32x4){0u, 0u, 0u, 0u}; }
        unsigned o[4][4];
#pragma unroll
        for (int r = 0; r < 4; ++r) {
            f32x4 a0 = bs8[0], a1 = bs8[1];
#pragma unroll
            for (int k = 0; k < 4; ++k) {
                const u32x4 xv = xq[r + k];
                a0[0] += bf2f(xv[0] & 0xffffu) * wt[k][0][0]; a0[1] += bf2f(xv[0] >> 16) * wt[k][0][1]; a0[2] += bf2f(xv[1] & 0xffffu) * wt[k][0][2]; a0[3] += bf2f(xv[1] >> 16) * wt[k][0][3];
                a1[0] += bf2f(xv[2] & 0xffffu) * wt[k][1][0]; a1[1] += bf2f(xv[2] >> 16) * wt[k][1][1]; a1[2] += bf2f(xv[3] & 0xffffu) * wt[k][1][2]; a1[3] += bf2f(xv[3] >> 16) * wt[k][1][3];
            }
            o[r][0] = cvt_pk(silu_fast(a0[0]), silu_fast(a0[1])); o[r][1] = cvt_pk(silu_fast(a0[2]), silu_fast(a0[3]));
            o[r][2] = cvt_pk(silu_fast(a1[0]), silu_fast(a1[1])); o[r][3] = cvt_pk(silu_fast(a1[2]), silu_fast(a1[3]));
        }
        if (q < 2) {
            LAS bf16_t* dstR = (q == 0 ? Bs : Cs) + (4 * run) * SL + ck16 * 8;
#pragma unroll
            for (int r = 0; r < 4; ++r) *(LAS u32x4*)(dstR + r * SL) = (u32x4){o[r][0], o[r][1], o[r][2], o[r][3]};
        }
        if (q != 1) {
            LAS bf16_t* dstT; int rbase;
            if (q == 0) { dstT = Bt; rbase = 64 * (ck16 >> 3) + 2 * (ck16 & 7); }
            else { dstT = (q == 2 ? Xt : Cs) + (ck16 >> 3) * 64 * SL; rbase = 2 * (ck16 & 7); }
#pragma unroll
            for (int j = 0; j < 8; ++j) {
                const int row = rbase + 16 * (j & 3) + (j >> 2);
                const unsigned lo0 = (j & 1) ? (o[0][j >> 1] >> 16) : (o[0][j >> 1] & 0xffffu), lo1 = (j & 1) ? (o[1][j >> 1] >> 16) : (o[1][j >> 1] & 0xffffu);
                const unsigned lo2 = (j & 1) ? (o[2][j >> 1] >> 16) : (o[2][j >> 1] & 0xffffu), lo3 = (j & 1) ? (o[3][j >> 1] >> 16) : (o[3][j >> 1] & 0xffffu);
                *(LAS u32x2*)(dstT + row * SL + 4 * run) = (u32x2){lo0 | (lo1 << 16), lo2 | (lo3 << 16)};
            }
        }
    };
    stage(0); stage(1); stage(2);
    __syncthreads();
    f32x4 cbv[8];
#pragma unroll
    for (int j = 0; j < 8; ++j) cbv[j] = (f32x4){0.f, 0.f, 0.f, 0.f};
#pragma unroll
    for (int ks = 0; ks < 4; ++ks) {
        const bf16x8 a = *(const LAS bf16x8*)(Cs + (16 * w + r16) * SL + ks * 32 + kg * 8);
#pragma unroll
        for (int j = 0; j < 8; ++j) { const bf16x8 bb = *(const LAS bf16x8*)(Bs + (16 * j + r16) * SL + ks * 32 + kg * 8); cbv[j] = __builtin_amdgcn_mfma_f32_16x16x32_bf16(a, bb, cbv[j], 0, 0, 0); }
    }
    { unsigned char* ct = ws + WS_SSDC + (size_t)job * 32768;
#pragma unroll
      for (int n = 0; n < 4; ++n) { const int i = F.tid + 512 * n, row = i >> 4, pc = i & 15;
          *(u32x4*)(ct + row * 256 + ((pc ^ (row & 15)) << 4)) = *(const LAS u32x4*)(Cs + row * SL + pc * 8); } }
    __syncthreads();
    stage(3);
    LAS bf16_t* Ws = Bs;
#pragma unroll 1
    for (int hh = 0; hh < 4; ++hh) {
        const int h = 4 * g + hh;
        LAS bf16_t* Xh = (hh < 2 ? Xt : Cs) + (hh & 1) * 64 * SL;
        const float Dh = IN_F(9)[L * 8 + h];
        const LAS float* ac = acs + hh * 128; const LAS float* dt = dts + hh * 128;
        { float al[4], as8[8], ds8[8];
#pragma unroll
          for (int r = 0; r < 4; ++r) al[r] = ac[16 * w + 4 * kg + r];
#pragma unroll
          for (int j = 0; j < 8; ++j) { as8[j] = ac[16 * j + r16]; ds8[j] = dt[16 * j + r16]; }
#pragma unroll
          for (int j = 0; j < 8; ++j)
#pragma unroll
              for (int r = 0; r < 4; ++r) { const int l = 16 * w + 4 * kg + r, s = 16 * j + r16;
                  const float wv = (s <= l) ? cbv[j][r] * __expf(al[r] - as8[j]) * ds8[j] : 0.f;
                  Ws[l * SL + s] = (bf16_t)f2bf(wv); } }
        __syncthreads();
        { f32x4 yd[4];
#pragma unroll
          for (int j = 0; j < 4; ++j) yd[j] = (f32x4){0.f, 0.f, 0.f, 0.f};
#pragma unroll
          for (int ks = 0; ks < 4; ++ks) {
              const bf16x8 aw = *(const LAS bf16x8*)(Ws + (16 * w + r16) * SL + ks * 32 + kg * 8);
#pragma unroll
              for (int j = 0; j < 4; ++j) { const bf16x8 bx = *(const LAS bf16x8*)(Xh + (16 * j + r16) * SL + ks * 32 + kg * 8); yd[j] = __builtin_amdgcn_mfma_f32_16x16x32_bf16(aw, bx, yd[j], 0, 0, 0); }
          }
#pragma unroll
          for (int r = 0; r < 4; ++r) {
              const int l = 16 * w + 4 * kg + r; const size_t trow = (size_t)(b * SEQ + t0 + l);
              f32x4 yv;
#pragma unroll
              for (int j = 0; j < 4; ++j) yv[j] = yd[j][r] + Dh * bf2f(Xh[(16 * j + r16) * SL + l]);
              *(u32x2*)(Y + trow * YW + h * 64 + 4 * r16) = pack4c(yv);
          } }
        __syncthreads();
        { const int row = F.tid >> 3, l0 = (F.tid & 7) * 16; LAS bf16_t* px = Xh + row * SL + l0; const LAS float* sc = scl + hh * 128 + l0;
#pragma unroll
          for (int q = 0; q < 2; ++q) { const u32x4 xv = *(const LAS u32x4*)(px + 8 * q); const f32x4 s0 = *(const LAS f32x4*)(sc + 8 * q), s1 = *(const LAS f32x4*)(sc + 8 * q + 4);
              u32x4 ov; ov.x = cvt_pk(bf2f(xv.x & 0xffffu) * s0[0], bf2f(xv.x >> 16) * s0[1]); ov.y = cvt_pk(bf2f(xv.y & 0xffffu) * s0[2], bf2f(xv.y >> 16) * s0[3]);
              ov.z = cvt_pk(bf2f(xv.z & 0xffffu) * s1[0], bf2f(xv.z >> 16) * s1[1]); ov.w = cvt_pk(bf2f(xv.w & 0xffffu) * s1[2], bf2f(xv.w >> 16) * s1[3]);
              *(LAS u32x4*)(px + 8 * q) = ov; } }
        __syncthreads();
        { const int pt = w & 3; f32x4 st[4];
#pragma unroll
          for (int j = 0; j < 4; ++j) st[j] = (f32x4){0.f, 0.f, 0.f, 0.f};
#pragma unroll
          for (int ks = 0; ks < 4; ++ks) {
              const bf16x8 a = *(const LAS bf16x8*)(Xh + (16 * pt + r16) * SL + ks * 32 + kg * 8);
#pragma unroll
              for (int j = 0; j < 4; ++j) { const int nt = (w >> 2) * 4 + j; const bf16x8 bb = *(const LAS bf16x8*)(Bt + (16 * nt + r16) * SL + ks * 32 + kg * 8);
                  st[j] = __builtin_amdgcn_mfma_f32_16x16x32_bf16(a, bb, st[j], 0, 0, 0); }
          }
          unsigned char* sg = ws + WS_SSDS + (size_t)((b * 8 + h) * 16 + c) * 16384;
#pragma unroll
          for (int r = 0; r < 4; ++r) { const int p = 4 * (4 * kg + r) + pt; const f32x4 sv = (f32x4){st[0][r], st[1][r], st[2][r], st[3][r]};
              *(u32x2*)(sg + p * 256 + (64 * (w >> 2) + 4 * r16) * 2) = pack4c(sv); } }
    }
}
constexpr int ST_C = 0, ST_PV = 65536, ST_END = ST_PV + 64 * SL * 2;
static_assert(ST_END <= LDS_USER, "ssd state lds");
__device__ UNIT_INLINE void ssd_state(Frame& F, int unit, const bf16_t* U1, bf16_t* Y, float* ssq, const unsigned char* ws) {
    const int h = unit & 7, b = unit >> 3, g = h >> 2;
    const int r16 = F.lane & 15, kg = F.lane >> 4, w = F.wave;
    const unsigned char* ctile = ws + WS_SSDC + (size_t)((b * 2 + g) * 16) * 32768 + F.lane * 16;
    const unsigned char* sg = ws + WS_SSDS + (size_t)((b * 8 + h) * 16) * 16384;
    const float* acsg = (const float*)(ws + WS_SSDA) + (size_t)(b * 8 + h) * SEQ;
    LAS bf16_t* Pv = (LAS bf16_t*)(F.lds + ST_PV);
    const int prow = F.tid >> 3, n0 = (F.tid & 7) * 16, pp = 4 * (prow & 15) + (prow >> 4);
    float pv[16];
#pragma unroll
    for (int i = 0; i < 16; ++i) pv[i] = 0.f;
    __syncthreads();
    *(LAS u32x4*)(Pv + prow * SL + n0) = (u32x4){0u, 0u, 0u, 0u}; *(LAS u32x4*)(Pv + prow * SL + n0 + 8) = (u32x4){0u, 0u, 0u, 0u};
#define ST_DMA(cc) do { _Pragma("unroll") for (int q_ = 0; q_ < 4; ++q_) { const int pc_ = w * 4 + q_; \
        __builtin_amdgcn_global_load_lds((const unsigned*)(ctile + (size_t)(cc) * 32768 + pc_ * 1024), (LAS unsigned*)(F.lds + ST_C + ((cc) & 1) * 32768 + pc_ * 1024), 16, 0, 0); } } while (0)
    ST_DMA(0);
#pragma unroll 1
    for (int c = 0; c < 16; ++c) {
        const int t0 = c * 128;
        asm volatile("s_waitcnt vmcnt(0)" ::: "memory");
        RW_BAR();
        const u32x4 s0 = *(const u32x4*)(sg + (size_t)c * 16384 + pp * 256 + n0 * 2), s1 = *(const u32x4*)(sg + (size_t)c * 16384 + pp * 256 + n0 * 2 + 16);
        const f32x4 al = *(const f32x4*)(acsg + t0 + 16 * w + 4 * kg); const float aend = acsg[t0 + 127];
        u32x2 yq[4], zq[4];
#pragma unroll
        for (int r = 0; r < 4; ++r) { const size_t trow = (size_t)(b * SEQ + t0 + 16 * w + 4 * kg + r);
            yq[r] = *(const u32x2*)(Y + trow * YW + h * 64 + 4 * r16); zq[r] = *(const u32x2*)(U1 + trow * UW + UC_Z + h * 64 + 4 * r16); }
        if (c + 1 < 16) ST_DMA(c + 1);
        f32x4 yo[4];
#pragma unroll
        for (int j = 0; j < 4; ++j) yo[j] = (f32x4){0.f, 0.f, 0.f, 0.f};
        { const LAS unsigned char* cs = F.lds + ST_C + (c & 1) * 32768 + (16 * w + r16) * 256;
#pragma unroll
          for (int ks = 0; ks < 4; ++ks) {
              const bf16x8 ac = *(const LAS bf16x8*)(cs + (((ks * 4 + kg) ^ r16) << 4));
#pragma unroll
              for (int j = 0; j < 4; ++j) { const bf16x8 bp = *(const LAS bf16x8*)(Pv + (16 * j + r16) * SL + ks * 32 + kg * 8); yo[j] = __builtin_amdgcn_mfma_f32_16x16x32_bf16(ac, bp, yo[j], 0, 0, 0); }
          } }
#pragma unroll
        for (int r = 0; r < 4; ++r) {
            const size_t trow = (size_t)(b * SEQ + t0 + 16 * w + 4 * kg + r);
            const float ea = __expf(al[r]);
            const f32x4 yp = unpack4(yq[r]), z = unpack4(zq[r]);
            f32x4 yv; float sq = 0.f;
#pragma unroll
            for (int j = 0; j < 4; ++j) { yv[j] = (yp[j] + yo[j][r] * ea) * silu_fast(z[j]); sq += yv[j] * yv[j]; }
            *(u32x2*)(Y + trow * YW + h * 64 + 4 * r16) = pack4c(yv);
            sq += __shfl_xor(sq, 1); sq += __shfl_xor(sq, 2); sq += __shfl_xor(sq, 4); sq += __shfl_xor(sq, 8);
            if (r16 == 0) ssq[trow * 8 + h] = sq;
        }
        RW_BAR();
        { const float cd = __expf(aend);
          const f32x4 a = unpack4((u32x2){s0.x, s0.y}), bq = unpack4((u32x2){s0.z, s0.w}), cq = unpack4((u32x2){s1.x, s1.y}), dq = unpack4((u32x2){s1.z, s1.w});
#pragma unroll
          for (int i = 0; i < 4; ++i) { pv[i] = pv[i] * cd + a[i]; pv[4 + i] = pv[4 + i] * cd + bq[i]; pv[8 + i] = pv[8 + i] * cd + cq[i]; pv[12 + i] = pv[12 + i] * cd + dq[i]; }
          *(LAS u32x4*)(Pv + prow * SL + n0) = (u32x4){cvt_pk(pv[0], pv[1]), cvt_pk(pv[2], pv[3]), cvt_pk(pv[4], pv[5]), cvt_pk(pv[6], pv[7])};
          *(LAS u32x4*)(Pv + prow * SL + n0 + 8) = (u32x4){cvt_pk(pv[8], pv[9]), cvt_pk(pv[10], pv[11]), cvt_pk(pv[12], pv[13]), cvt_pk(pv[14], pv[15])}; }
    }
#undef ST_DMA
}

__device__ UNIT_INLINE void ssd_fixup_and_pb(Frame& F, int L, KArgs KA, bf16_t* Y, const float* ssq, bf16_t* PB) {
    const int gt = F.bid * 512 + F.tid, NT = F.G * 512;
    const float* nw = IN_F(10) + (size_t)L * 512;
    for (int i = gt; i < T * 64; i += NT) {
        const int t = i >> 6, ch = i & 63, g = ch >> 5;
        const f32x4 q = *(const f32x4*)(ssq + (size_t)t * 8 + g * 4);
        const float rs = rsqrtf(((q[0] + q[1]) + (q[2] + q[3])) * (1.0f / 256.0f) + NORM_EPS);
        bf16_t* yp = Y + (size_t)t * YW + ch * 8;
        const u32x4 v = *(const u32x4*)yp; const f32x4 n0 = *(const f32x4*)(nw + ch * 8), n1 = *(const f32x4*)(nw + ch * 8 + 4);
        u32x4 o;
        o.x = cvt_pk(bf2f(v.x & 0xffffu) * rs * n0[0], bf2f(v.x >> 16) * rs * n0[1]); o.y = cvt_pk(bf2f(v.y & 0xffffu) * rs * n0[2], bf2f(v.y >> 16) * rs * n0[3]);
        o.z = cvt_pk(bf2f(v.z & 0xffffu) * rs * n1[0], bf2f(v.z >> 16) * rs * n1[1]); o.w = cvt_pk(bf2f(v.w & 0xffffu) * rs * n1[2], bf2f(v.w >> 16) * rs * n1[3]);
        *(u32x4*)yp = o;
    }
    const float* p = IN_F(1) + (size_t)L * T * PLE;
    for (int i = gt; i < T * PLE / 8; i += NT) {
        const f32x4 a = *(const f32x4*)(p + (size_t)i * 8), b = *(const f32x4*)(p + (size_t)i * 8 + 4);
        u32x4 o; o.x = cvt_pk(a[0], a[1]); o.y = cvt_pk(a[2], a[3]); o.z = cvt_pk(b[0], b[1]); o.w = cvt_pk(b[2], b[3]);
        *(u32x4*)(PB + (size_t)i * 8) = o;
    }
}
__device__ UNIT_INLINE void moe_router(Frame& F, KArgs KA, const float* xo, unsigned* cnt, int* toke, int* tokp, float* tokw) {
    const int gw = F.bid * 8 + F.wave, NGW = F.G * 8;
    const float* gff = IN_F(31) + DM; const float* router = IN_F(35);
    for (int m = gw; m < T; m += NGW) {
        const f32x4* xr = (const f32x4*)(xo + (size_t)m * DM) + F.lane; f32x4 v[4]; float s = 0.f;
#pragma unroll
        for (int j = 0; j < 4; ++j) { v[j] = xr[64 * j]; s += (v[j][0] * v[j][0] + v[j][1] * v[j][1]) + (v[j][2] * v[j][2] + v[j][3] * v[j][3]); }
        const float rstd = rsqrtf(wave_sum(s) * (1.0f / DM) + NORM_EPS);
        float lg[8];
#pragma unroll
        for (int e = 0; e < 8; ++e) lg[e] = 0.f;
#pragma unroll
        for (int j = 0; j < 4; ++j) { const f32x4 gg = *((const f32x4*)gff + F.lane + 64 * j);
#pragma unroll
            for (int i = 0; i < 4; ++i) { const int k = 4 * F.lane + 256 * j + i; const float hv = v[j][i] * rstd * gg[i];
                const f32x4 r0 = *(const f32x4*)(router + (size_t)k * 8), r1 = *(const f32x4*)(router + (size_t)k * 8 + 4);
                lg[0] += hv * r0[0]; lg[1] += hv * r0[1]; lg[2] += hv * r0[2]; lg[3] += hv * r0[3]; lg[4] += hv * r1[0]; lg[5] += hv * r1[1]; lg[6] += hv * r1[2]; lg[7] += hv * r1[3]; } }
#pragma unroll
        for (int e = 0; e < 8; ++e) lg[e] = wave_sum(lg[e]);
        if (F.lane == 0) {
            int e1 = 0; float v1 = lg[0];
#pragma unroll
            for (int e = 1; e < 8; ++e) if (lg[e] > v1) { v1 = lg[e]; e1 = e; }
            int e2 = -1; float v2 = -INFINITY;
#pragma unroll
            for (int e = 0; e < 8; ++e) if (e != e1 && lg[e] > v2) { v2 = lg[e]; e2 = e; }
            const float ex = __expf(v2 - v1), w1 = 1.0f / (1.0f + ex), w2 = ex / (1.0f + ex);
            const int p1 = (int)atomicAdd(cnt + 64 * e1, 1u), p2 = (int)atomicAdd(cnt + 64 * e2, 1u);
            toke[2 * m] = e1; toke[2 * m + 1] = e2; tokp[2 * m] = p1; tokp[2 * m + 1] = p2; tokw[2 * m] = w1; tokw[2 * m + 1] = w2;
        }
    }
}
__device__ __forceinline__ void moe_tables(const unsigned* cnt, MoeTables& mt, int (&c)[8]) {
#pragma unroll
    for (int e = 0; e < 8; ++e) c[e] = (int)__hip_atomic_load(cnt + 64 * e, RLX_AGENT);
    int ps = 0;
    ps += (c[0] + 255) & ~255; mt.ps1 = ps; ps += (c[1] + 255) & ~255; mt.ps2 = ps; ps += (c[2] + 255) & ~255; mt.ps3 = ps; ps += (c[3] + 255) & ~255; mt.ps4 = ps;
    ps += (c[4] + 255) & ~255; mt.ps5 = ps; ps += (c[5] + 255) & ~255; mt.ps6 = ps; ps += (c[6] + 255) & ~255; mt.ps7 = ps; ps += (c[7] + 255) & ~255; mt.ps8 = ps;
}
__device__ __forceinline__ int moe_pstart(const MoeTables& mt, int e) {
    return e == 0 ? 0 : e == 1 ? mt.ps1 : e == 2 ? mt.ps2 : e == 3 ? mt.ps3 : e == 4 ? mt.ps4 : e == 5 ? mt.ps5 : e == 6 ? mt.ps6 : mt.ps7;
}
__device__ UNIT_INLINE void moe_slots(Frame& F, const float* xo, const float* ss2, const unsigned* cnt, const int* toke, const int* tokp, int* toks, bf16_t* XG, float* srstd) {
    const int gw = F.bid * 8 + F.wave, NGW = F.G * 8;
    MoeTables mt; int c[8]; moe_tables(cnt, mt, c);
    for (int m = gw; m < T; m += NGW) {
        const f32x4* xr = (const f32x4*)(xo + (size_t)m * DM) + F.lane; u32x2 pk[4];
#pragma unroll
        for (int j = 0; j < 4; ++j) pk[j] = pack4(xr[64 * j]);
        const float rs = rstd_of(ss2, m);
#pragma unroll
        for (int k = 0; k < 2; ++k) {
            const int e = toke[2 * m + k], slot = moe_pstart(mt, e) + tokp[2 * m + k];
            u32x2* o = (u32x2*)(XG + (size_t)slot * DM) + F.lane;
#pragma unroll
            for (int j = 0; j < 4; ++j) o[64 * j] = pk[j];
            if (F.lane == 0) { toks[2 * m + k] = slot; srstd[slot] = rs; }
        }
    }
    for (int idx = gw; idx < 8 * 256; idx += NGW) {
        const int e = idx >> 8, r = idx & 255;
        int ce = 0;
#pragma unroll
        for (int q = 0; q < 8; ++q) if (q == e) ce = c[q];
        const int row = moe_pstart(mt, e) + ce + r, end = (e == 7) ? mt.ps8 : moe_pstart(mt, e + 1);
        if (row < end) { u32x2* o = (u32x2*)(XG + (size_t)row * DM) + F.lane;
#pragma unroll
            for (int j = 0; j < 4; ++j) o[64 * j] = (u32x2){0u, 0u};
            if (F.lane == 0) srstd[row] = 0.f; }
    }
}
__device__ UNIT_INLINE void moe_combine(Frame& F, float* xo, const bf16_t* YB, const int* toks, const float* tokw, bf16_t* XB2) {
    const int gw = F.bid * 8 + F.wave, NGW = F.G * 8;
    for (int m = gw; m < T; m += NGW) {
        const int s0 = toks[2 * m], s1 = toks[2 * m + 1]; const float w0 = tokw[2 * m], w1 = tokw[2 * m + 1];
        f32x4* xr = (f32x4*)(xo + (size_t)m * DM) + F.lane; const u32x2* y0 = (const u32x2*)(YB + (size_t)s0 * DM) + F.lane; const u32x2* y1 = (const u32x2*)(YB + (size_t)s1 * DM) + F.lane;
        u32x2* xb = (u32x2*)(XB2 + (size_t)m * DM) + F.lane;
#pragma unroll
        for (int j = 0; j < 4; ++j) { const f32x4 v = xr[64 * j] + (unpack4(y0[64 * j]) * w0 + unpack4(y1[64 * j]) * w1); xr[64 * j] = v; xb[64 * j] = pack4(v); }
    }
}
__device__ UNIT_INLINE void final_norm(Frame& F, KArgs KA, float* xo) {
    const int gw = F.bid * 8 + F.wave, NGW = F.G * 8; const float* gf = IN_F(41);
    for (int m = gw; m < T; m += NGW) {
        f32x4* xr = (f32x4*)(xo + (size_t)m * DM) + F.lane; f32x4 v[4]; float s = 0.f;
#pragma unroll
        for (int j = 0; j < 4; ++j) { v[j] = xr[64 * j]; s += (v[j][0] * v[j][0] + v[j][1] * v[j][1]) + (v[j][2] * v[j][2] + v[j][3] * v[j][3]); }
        const float rstd = rsqrtf(wave_sum(s) * (1.0f / DM) + NORM_EPS);
#pragma unroll
        for (int j = 0; j < 4; ++j) xr[64 * j] = v[j] * rstd * *((const f32x4*)gf + F.lane + 64 * j);
    }
}


#define XB_TMO      128
#define XB_XCNT(j)  (256  + 64 * (j))
#define XB_XSUB(j)  (1280 + 64 * (j))
#define XB_XGEN(j)  (2304 + 64 * (j))
#define XB_TOP      3328
#define XB_TOPGEN   3392
#define XCD_BAR_WORDS 3456
#define XB_SPIN_CAP (1u << 22)
__device__ __forceinline__ unsigned xb_ld(unsigned* p)              { return __hip_atomic_load(p, __ATOMIC_RELAXED, __HIP_MEMORY_SCOPE_AGENT); }
__device__ __forceinline__ unsigned xb_add(unsigned* p, unsigned v) { return __hip_atomic_fetch_add(p, v, __ATOMIC_RELAXED, __HIP_MEMORY_SCOPE_AGENT); }
__device__ __forceinline__ unsigned xb_xcc_id() { return (unsigned)__builtin_amdgcn_s_getreg((3 << 11) | 20) & 0xFu; }
#define XB_SPIN(cond, bar) do { unsigned _sp = 0; while (cond) { __builtin_amdgcn_s_sleep(1); \
    if ((++_sp & 255u) == 0u) { if (xb_ld(&(bar)[XB_TMO])) break; if (_sp > XB_SPIN_CAP) { atomicAdd(&(bar)[XB_TMO], 1u); break; } } } } while (0)
struct XcdBarrier { unsigned* bar; unsigned x; volatile LAS unsigned* st; };
__device__ __forceinline__ XcdBarrier xcd_barrier_post(unsigned* bar, volatile LAS unsigned* st) {
    XcdBarrier b; b.bar = bar; b.x = xb_xcc_id(); b.st = st;
    if (threadIdx.x == 0) (void)xb_add(&bar[XB_XCNT(b.x)], 1u);
    return b;
}
__device__ __forceinline__ void xcd_barrier_complete(unsigned* bar, unsigned x, unsigned& nloc, unsigned& nx) {
    const unsigned G = gridDim.x * gridDim.y * gridDim.z;
    unsigned sum, cnt, mine, sp = 0u;
    for (;;) {
        sum = 0u; cnt = 0u; mine = 0u;
#pragma unroll
        for (unsigned j = 0; j < 16; ++j) { const unsigned c = xb_ld(&bar[XB_XCNT(j)]); sum += c; cnt += (c > 0u) ? 1u : 0u; mine = (j == x) ? c : mine; }
        if (sum == G) break;
        __builtin_amdgcn_s_sleep(1);
        if ((++sp & 255u) == 0u) { if (xb_ld(&bar[XB_TMO])) break; if (sp > XB_SPIN_CAP) { atomicAdd(&bar[XB_TMO], 1u); break; } }
    }
    nloc = mine > 0u ? mine : 1u; nx = cnt > 0u ? cnt : 1u;
}
__device__ __forceinline__ void xcd_barrier(const XcdBarrier& b, bool leader) {
    asm volatile("s_waitcnt vmcnt(0)" ::: "memory");
    __syncthreads();
    if (leader) {
        unsigned* bar = b.bar;
        __builtin_amdgcn_s_waitcnt(0);
        unsigned nloc = b.st[0], nx = b.st[1];
        if (nloc == 0u) { xcd_barrier_complete(bar, b.x, nloc, nx); b.st[0] = nloc; b.st[1] = nx; }
        const unsigned old = xb_add(&bar[XB_XSUB(b.x)], 1u);
        const unsigned gen = old / nloc;
        if (old + 1u == (gen + 1u) * nloc) {
            __builtin_amdgcn_fence(__ATOMIC_RELEASE, "agent");
            asm volatile("s_waitcnt vmcnt(0)" ::: "memory");
            const unsigned og = xb_add(&bar[XB_TOP], 1u);
            const unsigned tg = og / nx;
            if (og + 1u == (tg + 1u) * nx) xb_add(&bar[XB_TOPGEN], 1u);
            else XB_SPIN(xb_ld(&bar[XB_TOPGEN]) == tg, bar);
            __builtin_amdgcn_fence(__ATOMIC_ACQUIRE, "agent");
            xb_add(&bar[XB_XGEN(b.x)], 1u);
            asm volatile("s_waitcnt vmcnt(0)" ::: "memory");
        } else {
            XB_SPIN(xb_ld(&bar[XB_XGEN(b.x)]) == gen, bar);
            __builtin_amdgcn_fence(__ATOMIC_ACQUIRE, "agent");
            asm volatile("s_waitcnt vmcnt(0)" ::: "memory");
        }
    }
    __syncthreads();
}

constexpr int NPH = 23;
__device__ __forceinline__ unsigned char* opq(unsigned char* p) { asm volatile("" : "+s"(p)); return p; }
__global__ void __launch_bounds__(512, 2) mega_fwd(Args args) {
    extern __shared__ __attribute__((aligned(16))) unsigned char lds_raw[];
    Frame F;
    F.lds = (LAS unsigned char*)lds_raw; F.tid = 0; F.lane = 0; F.wave = __builtin_amdgcn_readfirstlane((int)threadIdx.x >> 6);
    F.G = gridDim.x; F.bid = blockIdx.x; F.ws = nullptr; F.ctl = nullptr;
    const int lo = args.ph_lo, hi = args.ph_hi;
    LAS unsigned* s_uid = (LAS unsigned*)(F.lds + LDS_USER + 64);
    if (threadIdx.x < 16) ((LAS unsigned*)(F.lds + LDS_USER))[threadIdx.x] = 0u;
    __syncthreads();
    (void)xcd_barrier_post((unsigned*)(args.ws + WS_CTL) + CW_BAR, (volatile LAS unsigned*)(F.lds + LDS_USER + 32));
#if MK_MULTI
#define GSYNC(k) do {} while (0)
#else
#define GSYNC(k) do { if ((k) + 1 < hi || rep_ + 1 < ((k) == REP_PH ? REP_N : 1)) { if ((k) == 0) cg::this_grid().sync(); else { XcdBarrier xb_; xb_.bar = (unsigned*)(KA->ws + WS_CTL) + CW_BAR; xb_.x = xb_xcc_id(); xb_.st = (volatile LAS unsigned*)(P.lds + LDS_USER + 32); xcd_barrier(xb_, P.tid == 0); } } } while (0)
#endif
#ifdef ONLY_PH
#define RUN(k) ((k) == ONLY_PH)
#else
#define RUN(k) (lo <= (k) && (k) < hi)
#endif
#define REPS(k) for (int rep_ = 0; rep_ < ((k) == REP_PH ? REP_N : 1); ++rep_)
#define PH_PTRS KArgs KA = kargs(); unsigned char* ws = KA->ws; float* out = KA->out; (void)out; \
    Frame P = F; asm volatile("" : "+s"(P.G), "+s"(P.bid), "+s"(P.wave)); asm volatile("v_mbcnt_lo_u32_b32 %0, -1, 0\n\tv_mbcnt_hi_u32_b32 %0, -1, %0" : "=v"(P.lane)); P.tid = P.wave * 64 + P.lane; \
    unsigned char* wa = ws + WS_WA + (size_t)L * WA_STRIDE; (void)wa; float* ssb = (float*)(ws + WS_SSP); \
    float* ss1 = ssb + (size_t)(2 * L) * T * 16; float* ss2 = ssb + (size_t)(2 * L + 1) * T * 16; float* ssn = ssb + (size_t)(2 * L + 2) * T * 16; (void)ss1; (void)ss2; (void)ssn; \
    bf16_t* XB = (bf16_t*)(ws + WS_XB); bf16_t* Y = (bf16_t*)(ws + WS_Y); bf16_t* U1 = (bf16_t*)(ws + WS_U1); (void)XB; (void)Y; (void)U1; \
    bf16_t* GATES = (bf16_t*)(ws + WS_GATES); bf16_t* MERGED = (bf16_t*)(ws + WS_MERGED); bf16_t* PB = (bf16_t*)(ws + WS_PB); (void)GATES; (void)MERGED; (void)PB; \
    float* MISC = (float*)(ws + WS_MISC); float* SSQ = (float*)(ws + WS_SSQ); (void)MISC; (void)SSQ; \
    bf16_t* XB2 = (bf16_t*)(ws + (L == 0 ? WS_XB2_L0 : WS_XB2_L1)); (void)XB2;
    const size_t TILE1K = (size_t)256 * 1024 * 2;
    if (RUN(0)) REPS(0) { const int L = 0; PH_PTRS p0_prologue(KA, P); GSYNC(0); }
#pragma unroll 1
    for (int L = 0; L < 2; ++L) {
        const int pb0 = 1 + (L == 0 ? 0 : 9);
        if (RUN(pb0)) REPS(pb0) { PH_PTRS
            pg8::DenseSched S; S.so.init(64, 22, P.G, P.bid); S.A = (const char*)XB; S.B = (const char*)(wa + WA_IN); S.a_tile = TILE1K; S.b_tile = TILE1K;
            EpiIn E{U1, MISC, ss1};
            pg8::gemm_phase(P.lds, DM, DM, DM, S, E); GSYNC(pb0);
        }
        if (RUN(pb0 + 1)) REPS(pb0 + 1) {
            { PH_PTRS rwkv_prep(P, L, KA, U1, ws + WS_REC); }
            { PH_PTRS for (int job = P.bid; job < 256; job += P.G) ssd_prep(P, job, L, KA, U1, Y, MISC, ws); }
            { PH_PTRS
              for (int t = P.bid; t < 256; t += P.G) {
                  __syncthreads();
                  if (t < 128) compress_unit(P, t, L, U1, ws);
                  else rope_slice(P, U1, (const float*)(ws + WS_ROPE), (const float*)(ws + WS_ROPE) + (size_t)T * 32, t - 128);
              } }
            { PH_PTRS GSYNC(pb0 + 1); }
        }
        if (RUN(pb0 + 2)) REPS(pb0 + 2) {
            if (F.bid < 64) { PH_PTRS
#ifndef SKIP_RWKV
                rwkv_scan(P, P.bid, L, KA, ws + WS_REC, Y);
#endif
            }
            if (F.bid >= 64 && F.bid < 128) { PH_PTRS
#ifndef SKIP_SSD
                ssd_state(P, P.bid - 64, U1, Y, SSQ, ws);
#endif
            }
            { PH_PTRS
            unsigned* q = (unsigned*)(ws + WS_CTL) + CW_QMIX + 256 * L;
            for (;;) {
                __syncthreads();
                if (P.tid == 0) *s_uid = atomicAdd(q + 128, 1u);
                __syncthreads();
                const int uid = (int)*s_uid;
                if (uid >= 512) break;
#ifndef SKIP_NSA
                nsa_unit(P, uid, U1, Y, MISC, ws);
#endif
            } }
            { PH_PTRS
            unsigned* q = (unsigned*)(ws + WS_CTL) + CW_QMIX + 256 * L;
            for (;;) {
                __syncthreads();
                if (P.tid == 0) *s_uid = atomicAdd(q + 192, 1u);
                __syncthreads();
                const int uid = (int)*s_uid;
                if (uid >= 512) break;
#ifndef SKIP_SWA
                swa_unit(P, uid, U1, Y, IN_F(25) + L * 8);
#endif
            } }
            if (L == 0) { PH_PTRS deferred_convert(KA, P, (unsigned*)(ws + WS_CTL) + CW_QMIX + 512 + 1024 * rep_, s_uid, 16, 32, 3472); }
            { PH_PTRS GSYNC(pb0 + 2); }
        }
        if (RUN(pb0 + 3)) REPS(pb0 + 3) { PH_PTRS
            { pg8::DenseSched S; S.so.init(64, 16, P.G, P.bid); S.A = (const char*)XB; S.B = (const char*)(wa + WA_GATE); S.a_tile = TILE1K; S.b_tile = TILE1K;
              EpiGates E{GATES, ss1};
              pg8::gemm_phase(P.lds, DM, DM, DM, S, E); }
            ssd_fixup_and_pb(P, L, KA, Y, SSQ, PB);
            if (L != 0) deferred_convert(KA, P, (unsigned*)(ws + WS_CTL) + CW_QMIX + 768 + 1024 * rep_, s_uid, 35, 59, 16896);
            GSYNC(pb0 + 3);
        }
        if (RUN(pb0 + 4)) REPS(pb0 + 4) {
            { PH_PTRS BranchSched S; S.so.init(64, 4, P.G, P.bid); S.Y = (const char*)Y; S.PT = (const char*)(wa + WA_PT); S.a_tile = (size_t)256 * YW * 2; S.b_tile = (size_t)256 * 512 * 2; S.a_br = 512 * 2; S.b_br = MiB;
              EpiBrAll E{MERGED, GATES}; pg8::gemm_phase(P.lds, YW, 512, 512, S, E); }
            { PH_PTRS GSYNC(pb0 + 4); }
        }
        if (RUN(pb0 + 5)) REPS(pb0 + 5) { PH_PTRS
            pg8::DenseSched S; S.so.init(64, 4, P.G, P.bid); S.A = (const char*)MERGED; S.B = (const char*)(wa + WA_OUT); S.a_tile = TILE1K; S.b_tile = TILE1K;
            if (L == 0) { EpiRes<true, true> E{IN_F(0), out, XB, ss2}; pg8::gemm_phase(P.lds, DM, DM, DM, S, E); }
            else { EpiRes<false, true> E{out, out, XB, ss2}; pg8::gemm_phase(P.lds, DM, DM, DM, S, E); }
            GSYNC(pb0 + 5);
        }
        if (L == 0) {
            if (RUN(7)) REPS(7) { PH_PTRS
                pg8::DenseSched S; S.so.init(64, 22, P.G, P.bid); S.A = (const char*)XB; S.B = (const char*)(ws + WS_FGU); S.a_tile = TILE1K; S.b_tile = TILE1K;
                EpiFfn1<false> E{(bf16_t*)(ws + WS_ACT0), ss2};
                pg8::gemm_phase(P.lds, DM, DM, DM, S, E); GSYNC(7);
            }
            if (RUN(8)) REPS(8) { PH_PTRS
                pg8::DenseSched S; S.so.init(64, 4, P.G, P.bid); S.A = (const char*)(ws + WS_ACT0); S.B = (const char*)(ws + WS_FDN); S.a_tile = (size_t)256 * D_FF * 2; S.b_tile = (size_t)256 * D_FF * 2;
                EpiRes<true, false> E{out, out, XB2, nullptr};
                pg8::gemm_phase(P.lds, D_FF, D_FF, D_FF, S, E); GSYNC(8);
            }
        } else {
#define MOE_PTRS unsigned* cnt = (unsigned*)(ws + WS_CTL) + CW_MOECNT; (void)cnt; int* toke = (int*)(ws + WS_TOKE); int* tokp = (int*)(ws + WS_TOKP); float* tokw = (float*)(ws + WS_TOKW); int* toks = (int*)(ws + WS_TOKS); \
            (void)toke; (void)tokp; (void)tokw; (void)toks; float* srstd = (float*)(ws + WS_SRSTD); (void)srstd; \
            bf16_t* XG = (bf16_t*)(ws + WS_XG); bf16_t* ACT1 = (bf16_t*)(ws + WS_ACT1); bf16_t* YB = (bf16_t*)(ws + WS_YB); (void)XG; (void)ACT1; (void)YB;
            if (RUN(16)) REPS(16) { PH_PTRS MOE_PTRS moe_router(P, KA, out, cnt, toke, tokp, tokw); GSYNC(16); }
            if (RUN(17)) REPS(17) { PH_PTRS MOE_PTRS moe_slots(P, out, ss2, cnt, toke, tokp, toks, XG, srstd); GSYNC(17); }
            if (RUN(18)) REPS(18) { PH_PTRS MOE_PTRS
                MoeSched S; int c[8]; moe_tables(cnt, S.mt, c); S.nN = 22; S.G = P.G; S.c = P.bid; S.A = (const char*)XG; S.B = (const char*)(ws + WS_WB); S.a_tile = TILE1K; S.b_tile = TILE1K; S.b_expert = WB_STRIDE;
                EpiFfn1<true> E{ACT1, srstd};
                pg8::gemm_phase(P.lds, DM, DM, DM, S, E); GSYNC(18);
            }
            if (RUN(19)) REPS(19) { PH_PTRS MOE_PTRS
                MoeSched S; int c[8]; moe_tables(cnt, S.mt, c); S.nN = 4; S.G = P.G; S.c = P.bid; S.A = (const char*)ACT1; S.B = (const char*)(ws + WS_WB + WB_DN); S.a_tile = (size_t)256 * D_FF * 2; S.b_tile = (size_t)256 * D_FF * 2; S.b_expert = WB_STRIDE;
                EpiBf16<false> E{YB};
                pg8::gemm_phase(P.lds, D_FF, D_FF, D_FF, S, E); GSYNC(19);
            }
            if (RUN(20)) REPS(20) { PH_PTRS MOE_PTRS moe_combine(P, out, YB, toks, tokw, XB2); GSYNC(20); }
        }
        const int pple = (L == 0) ? 9 : 21;
        if (RUN(pple)) REPS(pple) {
            { PH_PTRS pg8::DenseSched S; S.so.init(64, 4, P.G, P.bid); S.A = (const char*)XB2; S.B = (const char*)(wa + WA_PG); S.a_tile = TILE1K; S.b_tile = TILE1K;
              EpiBf16<true> E{MERGED}; pg8::gemm_phase(P.lds, DM, DM, DM, S, E); }
            { PH_PTRS pg8::DenseSched S; S.so.init(64, 4, P.G, P.bid);
              S.A = (const char*)PB; S.B = (const char*)(wa + WA_PP); S.a_tile = (size_t)256 * PLE * 2; S.b_tile = (size_t)256 * PLE * 2;
              if (L == 0) { EpiPle2<true> E{out, MERGED, XB, ssn}; pg8::gemm_phase(P.lds, PLE, PLE, PLE, S, E); }
              else { EpiPle2<false> E{out, MERGED, XB, ssn}; pg8::gemm_phase(P.lds, PLE, PLE, PLE, S, E); } }
            { PH_PTRS GSYNC(pple); }
        }
    }
    if (RUN(22)) REPS(22) { const int L = 0; PH_PTRS final_norm(P, KA, out); }
}

extern "C" void kernel_launch(void* const* d_in, const int* in_sizes, int n_in, void* d_out, int out_size, void* d_ws, size_t ws_size, hipStream_t stream) {
    static int grid = 0;
    if (grid == 0) {
        if (n_in != 42 || out_size != T * DM || ws_size < WS_END) { fprintf(stderr, "kernel_launch: unexpected problem (n_in %d out %d ws %zu)\n", n_in, out_size, ws_size); grid = -1; return; }
        int dev = 0, cus = 0, per_cu = 0;
        hipGetDevice(&dev); hipDeviceGetAttribute(&cus, hipDeviceAttributeMultiprocessorCount, dev);
        hipFuncSetAttribute((const void*)mega_fwd, hipFuncAttributeMaxDynamicSharedMemorySize, LDS_BYTES);
        hipOccupancyMaxActiveBlocksPerMultiprocessor(&per_cu, (const void*)mega_fwd, 512, LDS_BYTES);
        if (per_cu < 1) { fprintf(stderr, "kernel_launch: occupancy query says %d blocks per CU\n", per_cu); per_cu = 1; }
        (void)hipGetLastError();
        grid = cus;
    }
    if (grid < 0) return;
    hipMemsetAsync((char*)d_ws + WS_CTL, 0, CTL_BYTES, stream);
    Args a{};
    for (int i = 0; i < 42; ++i) a.in[i] = d_in[i];
    a.out = (float*)d_out; a.ws = (unsigned char*)d_ws;
#if MK_MULTI
    for (int k = 0; k < NPH; ++k) { a.ph_lo = k; a.ph_hi = k + 1; hipLaunchKernelGGL(mega_fwd, dim3(grid), dim3(512), LDS_BYTES, stream, a); }
#else
    a.ph_lo = 0; a.ph_hi = NPH;
    void* kargs[] = {&a};
    hipError_t e = hipLaunchCooperativeKernel((const void*)mega_fwd, dim3(grid), dim3(512), kargs, LDS_BYTES, stream);
    if (e != hipSuccess) fprintf(stderr, "kernel_launch: cooperative launch failed: %s\n", hipGetErrorString(e));
#endif
}
```
